# Optimizing an MI355X kernel written in HIP

```python
import math
import jax, jax.numpy as jnp
from jax import lax
import numpy as np


D_MODEL = 1024
BATCH = 8
SEQ = 4096
DEPTH = 4

RW_HEAD_DIM = 64
RW_WIDTH = D_MODEL // 2
RW_HEADS = RW_WIDTH // RW_HEAD_DIM
RW_DECAY_LORA = 64
RW_A_LORA = 64
RW_GATE_LORA = 160
RW_LN_EPS = 64e-5
GLA_HEADS = 4
GLA_VW = D_MODEL // 2
GLA_DV = GLA_VW // GLA_HEADS
GLA_DK = GLA_DV // 2
GLA_KW = GLA_HEADS * GLA_DK
GLA_GATE_LORA = 16
GLA_GATE_NORMALIZER = 16.0
GLA_CHUNK = 64
GLA_NORM_EPS = 1e-5
AB_IN = 3 * RW_WIDTH + 2 * GLA_KW + 2 * GLA_VW
AB_OUT = RW_WIDTH + GLA_VW
DA_QK_DIM = 64
DA_V_DIM = 2 * DA_QK_DIM
DA_HEADS = D_MODEL // DA_V_DIM
DA_QK_WIDTH = DA_HEADS * 2 * DA_QK_DIM
DA_V_WIDTH = DA_HEADS * DA_V_DIM
DA_Q_BLOCK = 128
DA_SUBLN_EPS = 1e-5
NEG_INF = -1e30
REL_BUCKETS = 32
REL_MAX_DIST = 128
FFN_HIDDEN = ((-(-8 * D_MODEL // 3) + 255) // 256) * 256
NORM_EPS = 1e-6
N_EVEN = (DEPTH + 1) // 2
N_ODD = DEPTH // 2

kernel_name = "hybrid_rwkv7_gla_diffattn_swiglu"


def rms_norm(x, g, eps=NORM_EPS):
    xf = x.astype(jnp.float32)
    y = xf * lax.rsqrt(jnp.mean(xf * xf, axis=-1, keepdims=True) + eps)
    return (y * g.astype(jnp.float32)).astype(x.dtype)


def token_shift(t):
    return jnp.pad(t, ((0, 0), (1, 0), (0, 0)))[:, :-1]


def swiglu(h, w_gate, w_up, w_down):
    return (jax.nn.silu(h @ w_gate) * (h @ w_up)) @ w_down


def t5_causal_buckets(dist):
    max_exact = REL_BUCKETS // 2
    ratio = jnp.maximum(dist, max_exact).astype(jnp.float32) / max_exact
    large = max_exact + (jnp.log(ratio) / math.log(REL_MAX_DIST / max_exact)
                         * (REL_BUCKETS - max_exact)).astype(jnp.int32)
    large = jnp.minimum(large, REL_BUCKETS - 1)
    return jnp.where(dist < max_exact, dist, large)


def diff_lambda_init(layer):
    return 0.8 - 0.6 * math.exp(-0.3 * layer)


def rwkv7_recurrence(r, w, k, v, a, b):
    Bsz, T, H, N = r.shape

    def step(S, inp):
        r_t, w_t, k_t, v_t, a_t, b_t = inp
        sa = jnp.einsum('bhvk,bhk->bhv', S, a_t)
        S = S * w_t[:, :, None, :] + sa[..., None] * b_t[:, :, None, :] + v_t[..., None] * k_t[:, :, None, :]
        return S, jnp.einsum('bhvk,bhk->bhv', S, r_t)

    xs = tuple(jnp.swapaxes(t, 0, 1) for t in (r, w, k, v, a, b))
    _, y = lax.scan(step, jnp.zeros((Bsz, H, N, N), jnp.float32), xs)
    return jnp.swapaxes(y, 0, 1)


def gla_chunked(q, k, v, log_a):
    Bsz, H, T, dk = q.shape
    dv = v.shape[-1]
    C = GLA_CHUNK
    n = T // C
    q, k, log_a = (t.reshape(Bsz, H, n, C, dk) for t in (q, k, log_a))
    v = v.reshape(Bsz, H, n, C, dv)
    b = jnp.cumsum(log_a, axis=3)
    b_last = b[:, :, :, -1:, :]
    q_dec = q * jnp.exp(b)
    scores = jnp.einsum('bhncd,bhnsd->bhncs', q_dec, k * jnp.exp(-b))
    causal = jnp.tril(jnp.ones((C, C), dtype=bool))
    o_intra = jnp.einsum('bhncs,bhnse->bhnce', jnp.where(causal, scores, 0.0), v)
    chunk_kv = jnp.einsum('bhnsd,bhnse->bhnde', k * jnp.exp(b_last - b), v)
    chunk_decay = jnp.exp(b_last[:, :, :, 0, :])

    def step(S, inp):
        kv, dec = inp
        return S * dec[..., None] + kv, S

    _, S_prev = lax.scan(step, jnp.zeros((Bsz, H, dk, dv), jnp.float32),
                         (jnp.moveaxis(chunk_kv, 2, 0), jnp.moveaxis(chunk_decay, 2, 0)))
    o_inter = jnp.einsum('bhncd,nbhde->bhnce', q_dec, S_prev)
    return (o_intra + o_inter).reshape(Bsz, H, T, dv)


def rwkv_gla_mixer(h, w_in, w_out, mu_rkv, mu_wag, w0, w1, w2, a0, a1, a2, g1, g2,
                   k_k, k_a, r_k, ln_w, ln_b, wa1, wa2, ba, gla_norm):
    f32 = jnp.float32
    Bsz, T, _ = h.shape
    proj = h @ w_in
    p_rkv = proj[..., :3 * RW_WIDTH]
    gq, gk, gv, gg = jnp.split(proj[..., 3 * RW_WIDTH:],
                               [GLA_KW, 2 * GLA_KW, 2 * GLA_KW + GLA_VW], axis=-1)

    rkv = p_rkv + (token_shift(p_rkv) - p_rkv) * mu_rkv.reshape(-1)
    r, k, v = [t.astype(f32) for t in jnp.split(rkv, 3, axis=-1)]
    dh = token_shift(h) - h
    xw = h + dh * mu_wag[0]
    xa = h + dh * mu_wag[1]
    xg = h + dh * mu_wag[2]
    w_raw = -jax.nn.softplus(-(w0 + jnp.tanh(xw @ w1) @ w2).astype(f32)) - 0.5
    decay = jnp.exp(-jnp.exp(w_raw))
    a = jax.nn.sigmoid((a0 + (xa @ a1) @ a2).astype(f32))
    g = jax.nn.sigmoid(xg @ g1) @ g2

    def heads(t):
        return t.reshape(Bsz, T, RW_HEADS, RW_HEAD_DIM)

    kk = heads(k * k_k.astype(f32))
    kk = kk / jnp.maximum(jnp.sqrt(jnp.sum(kk * kk, axis=-1, keepdims=True)), 1e-12)
    k = k * (1.0 + (a - 1.0) * k_a.astype(f32))
    rh, kh, vh = heads(r), heads(k), heads(v)
    y = rwkv7_recurrence(rh, heads(decay), kh, vh, -kk, kk * heads(a))
    mean = jnp.mean(y, axis=-1, keepdims=True)
    var = jnp.mean(jnp.square(y - mean), axis=-1, keepdims=True)
    y = ((y - mean) * lax.rsqrt(var + RW_LN_EPS)).reshape(Bsz, T, RW_WIDTH)
    y = y * ln_w.astype(f32) + ln_b.astype(f32)
    bonus = jnp.sum(rh * kh * r_k.astype(f32), axis=-1, keepdims=True) * vh
    o_a = (y + bonus.reshape(Bsz, T, RW_WIDTH)).astype(h.dtype) * g

    def gheads(t, d):
        return t.reshape(Bsz, T, GLA_HEADS, d).transpose(0, 2, 1, 3).astype(f32)

    log_a = jax.nn.log_sigmoid(((h @ wa1) @ wa2 + ba).astype(f32)) / GLA_GATE_NORMALIZER
    o = gla_chunked(gheads(gq, GLA_DK) * (GLA_DK ** -0.5), gheads(gk, GLA_DK),
                    gheads(gv, GLA_DV), gheads(log_a, GLA_DK))
    o = o.transpose(0, 2, 1, 3)
    o = o * lax.rsqrt(jnp.mean(o * o, axis=-1, keepdims=True) + GLA_NORM_EPS)
    o = o * gla_norm.astype(f32).reshape(GLA_HEADS, GLA_DV)
    o_b = o.reshape(Bsz, T, GLA_VW).astype(h.dtype) * jax.nn.silu(gg)

    return jnp.concatenate([o_a, o_b], axis=-1) @ w_out


def diff_attention_core(q1, q2, k1, k2, v, lam, bias_by_dist):
    Bsz, H, T, d = q1.shape
    nb = T // DA_Q_BLOCK
    scale = d ** -0.5

    def to_blocks(t):
        return t.reshape(Bsz, H, nb, DA_Q_BLOCK, d).transpose(2, 0, 1, 3, 4)

    starts = jnp.arange(nb, dtype=jnp.int32) * DA_Q_BLOCK
    k_pos = jnp.arange(T, dtype=jnp.int32)

    def block(args):
        q1b, q2b, start = args
        dist = start + jnp.arange(DA_Q_BLOCK, dtype=jnp.int32)[:, None] - k_pos[None, :]
        causal = dist >= 0
        bias = jnp.transpose(bias_by_dist[jnp.clip(dist, 0, T - 1)], (2, 0, 1)).astype(jnp.float32)

        def probs(qb, kb):
            s = jnp.einsum('bhqd,bhkd->bhqk', qb, kb, preferred_element_type=jnp.float32) * scale + bias
            return jax.nn.softmax(jnp.where(causal, s, NEG_INF), axis=-1)

        attn = probs(q1b, k1) - lam * probs(q2b, k2)
        return jnp.einsum('bhqk,bhke->bhqe', attn.astype(v.dtype), v)

    out = lax.map(block, (to_blocks(q1), to_blocks(q2), starts))
    return out.transpose(1, 2, 0, 3, 4).reshape(Bsz, H, T, v.shape[-1])


def diff_attn_mixer(h, w_qkv, w_out, lam_q1, lam_k1, lam_q2, lam_k2, subln, bias_by_dist, lam_init):
    f32 = jnp.float32
    Bsz, T, _ = h.shape
    q, k, v = jnp.split(h @ w_qkv, [DA_QK_WIDTH, 2 * DA_QK_WIDTH], axis=-1)
    q = q.reshape(Bsz, T, DA_HEADS, 2, DA_QK_DIM).transpose(3, 0, 2, 1, 4)
    k = k.reshape(Bsz, T, DA_HEADS, 2, DA_QK_DIM).transpose(3, 0, 2, 1, 4)
    v = v.reshape(Bsz, T, DA_HEADS, DA_V_DIM).transpose(0, 2, 1, 3)
    lam = (jnp.exp(jnp.sum(lam_q1.astype(f32) * lam_k1.astype(f32)))
           - jnp.exp(jnp.sum(lam_q2.astype(f32) * lam_k2.astype(f32))) + lam_init)
    o = diff_attention_core(q[0], q[1], k[0], k[1], v, lam, bias_by_dist).astype(f32)
    o = o * lax.rsqrt(jnp.mean(o * o, axis=-1, keepdims=True) + DA_SUBLN_EPS)
    o = o * subln.astype(f32) * (1.0 - lam_init)
    o = o.astype(h.dtype).transpose(0, 2, 1, 3).reshape(Bsz, T, DA_V_WIDTH)
    return o @ w_out


def setup_inputs(seed: int = 0) -> dict:
    key = jax.random.key(seed)
    ks = jax.random.split(key, 48)
    counter = [0]
    f32 = jnp.float32

    def nxt():
        kk = ks[counter[0]]
        counter[0] += 1
        return kk

    def nrm(shape, scale):
        return jax.random.normal(nxt(), shape, f32) * scale

    def unif(shape, lo, hi):
        return jax.random.uniform(nxt(), shape, f32, lo, hi)

    def gain(shape):
        return 1.0 + nrm(shape, 0.02)

    D, E, O = D_MODEL, N_EVEN, N_ODD
    return {
        "x": nrm((BATCH, SEQ, D), 1.0),
        "rel_bias": nrm((REL_BUCKETS, DA_HEADS), 0.5),
        "norm_mix": gain((DEPTH, D)),
        "norm_ffn": gain((DEPTH, D)),
        "norm_final": gain((D,)),
        "ab_w_in": nrm((E, D, AB_IN), D ** -0.5),
        "ab_w_out": nrm((E, AB_OUT, D), AB_OUT ** -0.5),
        "rw_mu_rkv": unif((E, 3, RW_WIDTH), 0.0, 1.0),
        "rw_mu_wag": unif((E, 3, D), 0.0, 1.0),
        "rw_w0": unif((E, RW_WIDTH), -6.0, -1.0),
        "rw_w1": nrm((E, D, RW_DECAY_LORA), D ** -0.5),
        "rw_w2": nrm((E, RW_DECAY_LORA, RW_WIDTH), 0.5 * RW_DECAY_LORA ** -0.5),
        "rw_a0": nrm((E, RW_WIDTH), 0.1),
        "rw_a1": nrm((E, D, RW_A_LORA), D ** -0.5),
        "rw_a2": nrm((E, RW_A_LORA, RW_WIDTH), 0.5 * RW_A_LORA ** -0.5),
        "rw_g1": nrm((E, D, RW_GATE_LORA), D ** -0.5),
        "rw_g2": nrm((E, RW_GATE_LORA, RW_WIDTH), RW_GATE_LORA ** -0.5),
        "rw_k_k": 0.85 + nrm((E, RW_WIDTH), 0.02),
        "rw_k_a": 1.0 + nrm((E, RW_WIDTH), 0.02),
        "rw_r_k": -0.04 + nrm((E, RW_HEADS, RW_HEAD_DIM), 0.1),
        "rw_ln_w": gain((E, RW_WIDTH)),
        "rw_ln_b": nrm((E, RW_WIDTH), 0.02),
        "gla_wa1": nrm((E, D, GLA_GATE_LORA), D ** -0.5),
        "gla_wa2": nrm((E, GLA_GATE_LORA, GLA_KW), GLA_GATE_LORA ** -0.5),
        "gla_ba": nrm((E, GLA_KW), 0.1),
        "gla_norm": gain((E, GLA_VW)),
        "da_w_qkv": nrm((O, D, 2 * DA_QK_WIDTH + DA_V_WIDTH), D ** -0.5),
        "da_w_out": nrm((O, DA_V_WIDTH, D), DA_V_WIDTH ** -0.5),
        "da_lam_q1": nrm((O, DA_QK_DIM), 0.1),
        "da_lam_k1": nrm((O, DA_QK_DIM), 0.1),
        "da_lam_q2": nrm((O, DA_QK_DIM), 0.1),
        "da_lam_k2": nrm((O, DA_QK_DIM), 0.1),
        "da_subln": gain((O, DA_V_DIM)),
        "ffn_w_gate": nrm((DEPTH, D, FFN_HIDDEN), D ** -0.5),
        "ffn_w_up": nrm((DEPTH, D, FFN_HIDDEN), D ** -0.5),
        "ffn_w_down": nrm((DEPTH, FFN_HIDDEN, D), FFN_HIDDEN ** -0.5),
    }


def reference(x, rel_bias, norm_mix, norm_ffn, norm_final, ab_w_in, ab_w_out,
              rw_mu_rkv, rw_mu_wag, rw_w0, rw_w1, rw_w2, rw_a0, rw_a1, rw_a2, rw_g1, rw_g2,
              rw_k_k, rw_k_a, rw_r_k, rw_ln_w, rw_ln_b, gla_wa1, gla_wa2, gla_ba, gla_norm,
              da_w_qkv, da_w_out, da_lam_q1, da_lam_k1, da_lam_q2, da_lam_k2, da_subln,
              ffn_w_gate, ffn_w_up, ffn_w_down):
    T = x.shape[1]
    bias_by_dist = rel_bias[t5_causal_buckets(jnp.arange(T, dtype=jnp.int32))]
    for layer in range(DEPTH):
        i = layer // 2
        h = rms_norm(x, norm_mix[layer])
        if layer % 2 == 0:
            mix = rwkv_gla_mixer(h, ab_w_in[i], ab_w_out[i], rw_mu_rkv[i], rw_mu_wag[i],
                                 rw_w0[i], rw_w1[i], rw_w2[i], rw_a0[i], rw_a1[i], rw_a2[i],
                                 rw_g1[i], rw_g2[i], rw_k_k[i], rw_k_a[i], rw_r_k[i],
                                 rw_ln_w[i], rw_ln_b[i], gla_wa1[i], gla_wa2[i], gla_ba[i], gla_norm[i])
        else:
            mix = diff_attn_mixer(h, da_w_qkv[i], da_w_out[i], da_lam_q1[i], da_lam_k1[i],
                                  da_lam_q2[i], da_lam_k2[i], da_subln[i], bias_by_dist,
                                  diff_lambda_init(layer))
        x = x + mix
        x = x + swiglu(rms_norm(x, norm_ffn[layer]), ffn_w_gate[layer], ffn_w_up[layer], ffn_w_down[layer])
    return rms_norm(x, norm_final)
```

```cpp
#include <hip/hip_runtime.h>
#include <cstdio>
#include <cstdint>
__device__ __forceinline__ float silu_f(float x) { return x * __builtin_amdgcn_rcpf(1.0f + __builtin_amdgcn_exp2f(-1.4426950408889634f * x)); }
namespace pg8 {
#define PG8_LAS __attribute__((address_space(3)))
typedef unsigned short bf16_t;
typedef short bf16x8 __attribute__((ext_vector_type(8)));
typedef float f32x4 __attribute__((ext_vector_type(4)));
typedef unsigned u32x4 __attribute__((ext_vector_type(4)));
constexpr int BM = 256, BK = 64, HALF = 128, HTB = HALF * BK * 2  , STAGE_BYTES = 8 * HTB, NXCD = 8, WGM = 8;

__host__ __device__ __forceinline__ int lds_byte(int r, int c) { const int st = (r >> 4) * 2 + (c >> 5), rr = r & 15, cc = c & 31, ob = rr * 64 + cc * 2; return st * 1024 + (ob ^ (((ob >> 9) & 1) << 5)); }
__host__ __device__ __forceinline__ void stage_rc(int b, int& R, int& C) { const int st = b / 1024, sb = b % 1024, swz = sb ^ (((sb >> 9) & 1) << 5); R = (st >> 1) * 16 + swz / 64; C = (st & 1) * 32 + (swz % 64) / 2; }
__host__ __device__ __forceinline__ int perm32(int rho) { const int n = rho >> 4, i = rho & 15; return 8 * (i >> 2) + 4 * n + (i & 3); }

struct Unit { int pm, pn; };
struct Gemm { const bf16_t* A; const bf16_t* Bt; int M, N, K; };

struct StaticOrder {
    int nM, nN, nwg, G, c;
    __host__ __device__ void init(int M, int N, int G_, int c_) { nM = M / BM; nN = N / BM; nwg = nM * nN; G = G_; c = c_; }
    __host__ __device__ bool next(int i, Unit& u) const {
        const long L = (long)i * G + c; if (L >= nwg) return false;
        int wgid = (int)L; { const int q = nwg / NXCD, r = nwg % NXCD, xcd = wgid % NXCD, off = wgid / NXCD; wgid = (xcd < r ? xcd * (q + 1) : r * (q + 1) + (xcd - r) * q) + off; }
        const int nig = WGM * nN, gid = wgid / nig, fm = gid * WGM, gsz = (nM - fm) < WGM ? (nM - fm) : WGM;
        u.pm = fm + ((wgid % nig) % gsz); u.pn = (wgid % nig) / gsz; return true;
    }
    __device__ __forceinline__ void a_ready(const Unit&) const {}
    __device__ __forceinline__ void done(const Unit&) const {}
};

__device__ __forceinline__ unsigned cvt_pk_bf16(float lo, float hi) { unsigned r; asm volatile("v_cvt_pk_bf16_f32 %0, %1, %2" : "=v"(r) : "v"(lo), "v"(hi)); return r; }
typedef float f32x2 __attribute__((ext_vector_type(2)));
struct EpiStoreBf16 {
    static constexpr bool PERM = true, AFTER_DRAIN = false;
    bf16_t* O; int ldc;
    __device__ __forceinline__ void operator()(const f32x4 (&acc)[2][2][4][2], const Unit& u, int wr, int wc, int fr, int fq) const {
        const int row0 = u.pm * BM + wr * 64 + fr, col0 = u.pn * BM + wc * 32 + 8 * fq;
#pragma unroll
        for (int ai = 0; ai < 2; ++ai)
#pragma unroll
            for (int m = 0; m < 4; ++m) { bf16_t* rowp = O + (size_t)(row0 + ai * HALF + m * 16) * ldc + col0;
#pragma unroll
                for (int bj = 0; bj < 2; ++bj) { const f32x4 v0 = acc[ai][bj][m][0], v1 = acc[ai][bj][m][1];
                    u32x4 w; w.x = cvt_pk_bf16(v0[0], v0[1]); w.y = cvt_pk_bf16(v0[2], v0[3]); w.z = cvt_pk_bf16(v1[0], v1[1]); w.w = cvt_pk_bf16(v1[2], v1[3]);
                    *(u32x4*)(rowp + bj * HALF) = w; } }
    }
};
struct EpiResF32 {
    static constexpr bool PERM = false, AFTER_DRAIN = false;
    const float* base; float* out; int ldc;
    __device__ __forceinline__ void operator()(const f32x4 (&acc)[2][2][4][2], const Unit& u, int wr, int wc, int fr, int fq) const {
        const int row0 = u.pm * BM + wr * 64 + fr, col0 = u.pn * BM + wc * 32 + 4 * fq;
#pragma unroll
        for (int ai = 0; ai < 2; ++ai)
#pragma unroll
            for (int m = 0; m < 4; ++m) { const size_t off = (size_t)(row0 + ai * HALF + m * 16) * ldc + col0;
#pragma unroll
                for (int bj = 0; bj < 2; ++bj)
#pragma unroll
                    for (int n = 0; n < 2; ++n) { const f32x4 b = *(const f32x4*)(base + off + bj * HALF + n * 16); *(f32x4*)(out + off + bj * HALF + n * 16) = b + acc[ai][bj][m][n]; }
                asm volatile("" ::: "memory"); }
    }
};
struct EpiSwiglu {
    static constexpr bool PERM = true, AFTER_DRAIN = false;
    bf16_t* H; int ldc;
    __device__ __forceinline__ void operator()(const f32x4 (&acc)[2][2][4][2], const Unit& u, int wr, int wc, int fr, int fq) const {
        const int row0 = u.pm * BM + wr * 64 + fr, colh = u.pn * HALF + wc * 32 + 8 * fq;
#pragma unroll
        for (int ai = 0; ai < 2; ++ai)
#pragma unroll
            for (int m = 0; m < 4; ++m) { bf16_t* rowp = H + (size_t)(row0 + ai * HALF + m * 16) * ldc + colh;
                const f32x4 g0 = acc[ai][0][m][0], g1 = acc[ai][0][m][1], u0 = acc[ai][1][m][0], u1 = acc[ai][1][m][1];
                float h[8];
#pragma unroll
                for (int e = 0; e < 4; ++e) { h[e] = silu_f(g0[e]) * u0[e]; h[4 + e] = silu_f(g1[e]) * u1[e]; }
                u32x4 w; w.x = cvt_pk_bf16(h[0], h[1]); w.y = cvt_pk_bf16(h[2], h[3]); w.z = cvt_pk_bf16(h[4], h[5]); w.w = cvt_pk_bf16(h[6], h[7]);
                *(u32x4*)rowp = w; }
    }
};
template <int M_, int N_> struct StaticOrderC {
    static constexpr int nM = M_ / BM, nN = N_ / BM, nwg = nM * nN;
    int G, c;
    __device__ __forceinline__ void init(int G_, int c_) { G = G_; c = c_; }
    __device__ __forceinline__ bool next(int i, Unit& u) const {
        const int L = i * G + c; if (L >= nwg) return false;
        int wgid = L; { constexpr int q = nwg / NXCD, r = nwg % NXCD; const int xcd = wgid % NXCD, off = wgid / NXCD; wgid = (xcd < r ? xcd * (q + 1) : r * (q + 1) + (xcd - r) * q) + off; }
        constexpr int nig = WGM * nN; const int gid = wgid / nig, fm = gid * WGM, gsz = (nM - fm) < WGM ? (nM - fm) : WGM;
        u.pm = fm + ((wgid % nig) % gsz); u.pn = (wgid % nig) / gsz; return true;
    }
    __device__ __forceinline__ void a_ready(const Unit&) const {}
    __device__ __forceinline__ void done(const Unit&) const {}
};
template <class Epi, class Sched, bool ALIGN_EPI = false, bool SP2 = false>
__device__ __forceinline__ void gemm_phase(PG8_LAS unsigned char* lds, const Gemm g, const Sched& S, const Epi& E) {
    int tid_ = threadIdx.x; asm volatile("" : "+v"(tid_));
    float zz_ = 0.f; asm volatile("" : "+v"(zz_));
    const int tid = tid_, wid = __builtin_amdgcn_readfirstlane(tid >> 6), lane = tid & 63, wr = wid >> 2, wc = wid & 3, fr = lane & 15, fq = lane >> 4;
    const int K = g.K, nt = K / BK;
    unsigned voffA[2], voffB[2];
#pragma unroll
    for (int i = 0; i < 2; ++i) { int R, C; stage_rc(tid * 16 + i * 8192, R, C); const int Rb = Epi::PERM ? ((R & ~31) + perm32(R & 31)) : R;
        voffA[i] = (unsigned)(R * K + C) * 2u; voffB[i] = (unsigned)(Rb * K + C) * 2u; }
    const size_t kstep = (size_t)(BK * 2);
    const size_t hstep = (size_t)HALF * K * 2;
    const size_t tstep = 2 * hstep;
    const unsigned ldsw = (unsigned)wid * 1024u;
    const int aoff = lds_byte(wr * 64 + fr, fq * 8), boff = lds_byte(wc * 32 + fr, fq * 8);
#define PG8_SA(b, h) (((b) * 2 + (h)) * HTB)
#define PG8_SB(b, h) ((4 + (b) * 2 + (h)) * HTB)
#define PG8_STAGE(bufoff, gbase, voff) do { _Pragma("unroll") for (int _i = 0; _i < 2; ++_i) \
        __builtin_amdgcn_global_load_lds((const unsigned*)((const char*)(gbase) + (voff)[_i]), (PG8_LAS unsigned*)(lds + (bufoff) + ldsw + _i * 8192), 16, 0, 0); } while (0)
#define PG8_LDA(dst, b, h) do { _Pragma("unroll") for (int m = 0; m < 4; ++m) _Pragma("unroll") for (int k = 0; k < 2; ++k) dst[m][k] = *(const PG8_LAS bf16x8*)(lds + PG8_SA(b, h) + aoff + m * 2048 + k * 1024); } while (0)
#define PG8_LDB(dst, b, h) do { _Pragma("unroll") for (int n = 0; n < 2; ++n) _Pragma("unroll") for (int k = 0; k < 2; ++k) dst[n][k] = *(const PG8_LAS bf16x8*)(lds + PG8_SB(b, h) + boff + n * 2048 + k * 1024); } while (0)
#define PG8_MMA(ai, bj, At, Bt) do { __builtin_amdgcn_s_setprio(1); _Pragma("unroll") for (int m = 0; m < 4; ++m) _Pragma("unroll") for (int n = 0; n < 2; ++n) _Pragma("unroll") for (int k = 0; k < 2; ++k) \
        acc[ai][bj][m][n] = __builtin_amdgcn_mfma_f32_16x16x32_bf16(Bt[n][k], At[m][k], acc[ai][bj][m][n], 0, 0, 0); __builtin_amdgcn_s_setprio(0); } while (0)
#define PG8_WAIT_V(n) asm volatile("s_waitcnt vmcnt(" #n ")" ::: "memory")
#define PG8_WAIT_L(n) asm volatile("s_waitcnt lgkmcnt(" #n ")" ::: "memory")
#define PG8_BAR __builtin_amdgcn_s_barrier()
#define PG8_SCHED __builtin_amdgcn_sched_barrier(0)
    Unit cur, nxt; int ui = 0;
    if (!S.next(0, cur)) return;
    f32x4 acc[2][2][4][2];
#pragma unroll
    for (int a = 0; a < 2; ++a)
#pragma unroll
        for (int b = 0; b < 2; ++b)
#pragma unroll
            for (int m = 0; m < 4; ++m)
#pragma unroll
                for (int n = 0; n < 2; ++n) acc[a][b][m][n] = (f32x4){zz_, zz_, zz_, zz_};
    bf16x8 At[4][2], B0[2][2], B1[2][2];
    const char* cA = (const char*)g.A + (size_t)cur.pm * tstep; const char* cB = (const char*)g.Bt + (size_t)cur.pn * tstep;
    S.a_ready(cur);
    if constexpr (SP2) {
        PG8_STAGE(PG8_SB(0, 0), cB, voffB); PG8_STAGE(PG8_SB(0, 1), cB + hstep, voffB); PG8_STAGE(PG8_SA(0, 0), cA, voffA); PG8_STAGE(PG8_SA(0, 1), cA + hstep, voffA);
        if (wr == 1) PG8_BAR;
        PG8_WAIT_V(2); PG8_BAR;
        PG8_STAGE(PG8_SB(1, 0), cB + kstep, voffB); PG8_STAGE(PG8_SA(1, 0), cA + kstep, voffA); PG8_STAGE(PG8_SB(1, 1), cB + hstep + kstep, voffB);
        PG8_WAIT_V(6); PG8_BAR;
    } else {
        PG8_STAGE(PG8_SB(0, 0), cB, voffB); PG8_STAGE(PG8_SA(0, 0), cA, voffA); PG8_STAGE(PG8_SB(0, 1), cB + hstep, voffB); PG8_STAGE(PG8_SA(0, 1), cA + hstep, voffA);
        if (wr == 1) PG8_BAR;
        PG8_WAIT_V(4); PG8_BAR;
        PG8_STAGE(PG8_SB(1, 0), cB + kstep, voffB); PG8_STAGE(PG8_SA(1, 0), cA + kstep, voffA); PG8_STAGE(PG8_SB(1, 1), cB + hstep + kstep, voffB);
        PG8_WAIT_V(6); PG8_BAR;
    }
    for (;;) {
        const bool has_next = S.next(ui + 1, nxt);
        const char* nA = has_next ? (const char*)g.A + (size_t)nxt.pm * tstep : cA; const char* nB = has_next ? (const char*)g.Bt + (size_t)nxt.pn * tstep : cB;
        for (int t = 0; t < nt; t += 2) {
            const bool last = (t == nt - 2);
            const char* a1 = cA + (size_t)(t + 1) * kstep;
            const char* a2 = last ? nA : cA + (size_t)(t + 2) * kstep; const char* b2 = last ? nB : cB + (size_t)(t + 2) * kstep;
            const char* a3 = a2 + kstep; const char* b3 = b2 + kstep;
            if (last && has_next) S.a_ready(nxt);
            if constexpr (SP2) {
            PG8_LDB(B0, 0, 0); PG8_LDB(B1, 0, 1); PG8_SCHED; PG8_LDA(At, 0, 0); PG8_STAGE(PG8_SA(1, 1), a1 + hstep, voffA);
            PG8_WAIT_V(8); PG8_WAIT_L(0); PG8_BAR; PG8_MMA(0, 0, At, B0); PG8_MMA(0, 1, At, B1); PG8_BAR; PG8_SCHED;
            PG8_LDA(At, 0, 1); PG8_STAGE(PG8_SB(0, 0), b2, voffB); PG8_STAGE(PG8_SB(0, 1), b2 + hstep, voffB); PG8_STAGE(PG8_SA(0, 0), a2, voffA);
            PG8_WAIT_V(8); PG8_WAIT_L(0); PG8_BAR; PG8_MMA(1, 0, At, B0); PG8_MMA(1, 1, At, B1); PG8_BAR; PG8_SCHED;
            PG8_LDB(B0, 1, 0); PG8_LDB(B1, 1, 1); PG8_SCHED; PG8_LDA(At, 1, 0); PG8_STAGE(PG8_SA(0, 1), a2 + hstep, voffA);
            PG8_WAIT_V(8); PG8_WAIT_L(0); PG8_BAR; PG8_MMA(0, 0, At, B0); PG8_MMA(0, 1, At, B1); PG8_BAR; PG8_SCHED;
            PG8_LDA(At, 1, 1); PG8_STAGE(PG8_SB(1, 0), b3, voffB); PG8_STAGE(PG8_SB(1, 1), b3 + hstep, voffB); PG8_STAGE(PG8_SA(1, 0), a3, voffA);
            PG8_WAIT_V(8); PG8_WAIT_L(0); PG8_BAR; PG8_MMA(1, 0, At, B0); PG8_MMA(1, 1, At, B1); PG8_BAR; PG8_SCHED;
            } else {
            PG8_LDB(B0, 0, 0); PG8_SCHED; PG8_LDA(At, 0, 0); PG8_STAGE(PG8_SA(1, 1), a1 + hstep, voffA);
            PG8_WAIT_L(8); PG8_BAR; PG8_WAIT_L(0); PG8_MMA(0, 0, At, B0); PG8_BAR; PG8_SCHED;
            PG8_LDB(B1, 0, 1); PG8_STAGE(PG8_SB(0, 0), b2, voffB);
            PG8_BAR; PG8_WAIT_L(0); PG8_MMA(0, 1, At, B1); PG8_BAR;
            PG8_LDA(At, 0, 1); PG8_STAGE(PG8_SA(0, 0), a2, voffA);
            PG8_BAR; PG8_WAIT_L(0); PG8_MMA(1, 0, At, B0); PG8_BAR; PG8_SCHED;
            PG8_STAGE(PG8_SB(0, 1), b2 + hstep, voffB);
            PG8_WAIT_V(6); PG8_BAR; PG8_MMA(1, 1, At, B1); PG8_BAR;
            PG8_LDB(B0, 1, 0); PG8_SCHED; PG8_LDA(At, 1, 0); PG8_STAGE(PG8_SA(0, 1), a2 + hstep, voffA);
            PG8_WAIT_L(8); PG8_BAR; PG8_WAIT_L(0); PG8_MMA(0, 0, At, B0); PG8_BAR; PG8_SCHED;
            PG8_LDB(B1, 1, 1); PG8_STAGE(PG8_SB(1, 0), b3, voffB);
            PG8_BAR; PG8_WAIT_L(0); PG8_MMA(0, 1, At, B1); PG8_BAR;
            PG8_LDA(At, 1, 1); PG8_STAGE(PG8_SA(1, 0), a3, voffA);
            PG8_BAR; PG8_WAIT_L(0); PG8_MMA(1, 0, At, B0); PG8_BAR; PG8_SCHED;
            PG8_STAGE(PG8_SB(1, 1), b3 + hstep, voffB);
            PG8_WAIT_V(6); PG8_BAR; PG8_MMA(1, 1, At, B1); PG8_BAR;
            }
        }
        if constexpr (ALIGN_EPI) { if (wr == 0) PG8_BAR; }
        if constexpr (!Epi::AFTER_DRAIN) { E(acc, cur, wr, wc, fr, fq); S.done(cur); }
        if (!has_next) break;
#pragma unroll
        for (int a = 0; a < 2; ++a)
#pragma unroll
            for (int b = 0; b < 2; ++b)
#pragma unroll
                for (int m = 0; m < 4; ++m)
#pragma unroll
                    for (int n = 0; n < 2; ++n) acc[a][b][m][n] = (f32x4){zz_, zz_, zz_, zz_};
        cur = nxt; cA = nA; cB = nB; ++ui;
        if constexpr (ALIGN_EPI) { if (wr == 1) PG8_BAR; }
    }
    PG8_WAIT_V(0);
    if constexpr (!ALIGN_EPI) { if (wr == 0) PG8_BAR; }
    PG8_BAR;
    if constexpr (Epi::AFTER_DRAIN) { E.fused(acc, cur, wr, wc, fr, fq, lds, wid, lane); S.done(cur); }
#undef PG8_SA
#undef PG8_SB
#undef PG8_STAGE
#undef PG8_LDA
#undef PG8_LDB
#undef PG8_MMA
#undef PG8_WAIT_V
#undef PG8_WAIT_L
#undef PG8_BAR
#undef PG8_SCHED
}
}
#ifndef PG8_SP2
#define PG8_SP2 true
#endif
#ifndef PG8_ALIGN
#define PG8_ALIGN true
#endif
constexpr int NWAVES = 8, NTHREADS = NWAVES * 64;
constexpr int BATCH = 8, T = 4096, D = 1024, M = BATCH * T;
constexpr int NIN_E = 3840, NIN_O = 3072, FF = 2816, NGU = 2 * FF;
constexpr int PC_R = 0, PC_K = 512, PC_V = 1024, PC_GQ = 1536, PC_GK = 1792, PC_GV = 2048, PC_GG = 2560;
constexpr int PC_W1A = 3072, PC_W1B = 3136, PC_A1A = 3200, PC_A1B = 3264, PC_G1A = 3328, PC_G1B = 3488, PC_WA1 = 3648, PC_PAD = 3664;
constexpr int NLORA = 304;
constexpr size_t MiB = 1u << 20;
constexpr size_t WS_CTL = 0, CTL_ZERO_BYTES = 1 * MiB;
constexpr size_t WS_WIN = 2 * MiB, WS_WOUT = 10 * MiB, WS_WGU = 12 * MiB, WS_WDN = 23 * MiB;
constexpr size_t WS_XN = 32 * MiB;
constexpr size_t WS_P = 96 * MiB;
constexpr size_t WS_WLOG = 336 * MiB;
constexpr size_t WS_ASIG = 400 * MiB;
constexpr size_t WS_LA = 464 * MiB;
constexpr size_t WS_END = 496 * MiB;
constexpr int CW_BAR = 4096;
constexpr int RING_BYTES = 131072, LDSCTL_OFF = RING_BYTES, MISC_OFF = LDSCTL_OFF + 320, LDS_BYTES = 147456;

#define GAS __attribute__((address_space(1)))
#define LAS __attribute__((address_space(3)))
typedef unsigned short bf16;
typedef unsigned v4u __attribute__((ext_vector_type(4)));
typedef unsigned v2u __attribute__((ext_vector_type(2)));
typedef float f32x4 __attribute__((ext_vector_type(4)));
#define LDS_WAIT() asm volatile("s_waitcnt lgkmcnt(0)" ::: "memory")
#define VM_WAIT() asm volatile("s_waitcnt vmcnt(0)" ::: "memory")
__device__ __forceinline__ unsigned f2bf(float f) { unsigned u = __builtin_bit_cast(unsigned, f); return (u + 0x7fffu + ((u >> 16) & 1u)) >> 16; }
__device__ __forceinline__ unsigned pk2(float lo, float hi) { return f2bf(lo) | (f2bf(hi) << 16); }
__device__ __forceinline__ float bf2f(bf16 u) { return __builtin_bit_cast(float, (unsigned)u << 16); }
__device__ __forceinline__ float bflo(unsigned w) { return __builtin_bit_cast(float, w << 16); }
__device__ __forceinline__ float bfhi(unsigned w) { return __builtin_bit_cast(float, w & 0xffff0000u); }
__device__ __forceinline__ float wave_sum(float v) {
#pragma unroll
    for (int o = 1; o < 64; o <<= 1) v += __shfl_xor(v, o);
    return v;
}
__device__ __forceinline__ float wave_max(float v) {
#pragma unroll
    for (int o = 1; o < 64; o <<= 1) v = fmaxf(v, __shfl_xor(v, o));
    return v;
}
__device__ __forceinline__ float fexp(float x) { return __builtin_amdgcn_exp2f(x * 1.4426950408889634f); }
__device__ __forceinline__ float flog(float x) { return __builtin_amdgcn_logf(x) * 0.6931471805599453f; }
__device__ __forceinline__ float frcp(float x) { return __builtin_amdgcn_rcpf(x); }
__device__ __forceinline__ float frsq(float x) { return __builtin_amdgcn_rsqf(x); }
__device__ __forceinline__ float fsqrt(float x) { return __builtin_amdgcn_sqrtf(x); }
__device__ __forceinline__ float sigmoid_f(float x) { return frcp(1.0f + fexp(-x)); }
__device__ __forceinline__ float softplus_f(float x) { return fmaxf(x, 0.f) + flog(1.0f + fexp(-fabsf(x))); }
__device__ __forceinline__ float tanh_f(float x) { return 1.0f - 2.0f * frcp(1.0f + fexp(2.0f * x)); }
#define XB_TMO      128
#define XB_XCNT(j)  (256  + 64 * (j))
#define XB_XSUB(j)  (1280 + 64 * (j))
#define XB_XGEN(j)  (2304 + 64 * (j))
#define XB_TOP      3328
#define XB_TOPGEN   3392
#define XCD_BAR_WORDS 3456
#define XB_SPIN_CAP (1u << 23)

__device__ __forceinline__ unsigned xb_ld(unsigned* p)              { return __hip_atomic_load(p, __ATOMIC_RELAXED, __HIP_MEMORY_SCOPE_AGENT); }
__device__ __forceinline__ unsigned xb_add(unsigned* p, unsigned v) { return __hip_atomic_fetch_add(p, v, __ATOMIC_RELAXED, __HIP_MEMORY_SCOPE_AGENT); }
__device__ __forceinline__ unsigned xb_xcc_id() { return (unsigned)__builtin_amdgcn_s_getreg((3 << 11) | 20) & 0xFu; }
#define XB_SPIN(cond, bar) do { unsigned _sp = 0; while (cond) { __builtin_amdgcn_s_sleep(1); \
    if ((++_sp & 255u) == 0u) { if (xb_ld(&(bar)[XB_TMO])) break; if (_sp > XB_SPIN_CAP) { atomicAdd(&(bar)[XB_TMO], 1u); break; } } } } while (0)

struct XcdBarrier {
    unsigned* bar; unsigned x;
    volatile LAS unsigned* st;
};

__device__ __forceinline__ XcdBarrier xcd_barrier_post(unsigned* bar, volatile LAS unsigned* st) {
    XcdBarrier b; b.bar = bar; b.x = xb_xcc_id(); b.st = st;
    if (threadIdx.x == 0) (void)xb_add(&bar[XB_XCNT(b.x)], 1u);
    return b;
}
__device__ __forceinline__ void xcd_barrier_complete(unsigned* bar, unsigned x, unsigned& nloc, unsigned& nx) {
    const unsigned G = gridDim.x * gridDim.y * gridDim.z;
    unsigned sum, cnt, mine, sp = 0u;
    for (;;) {
        sum = 0u; cnt = 0u; mine = 0u;
#pragma unroll
        for (unsigned j = 0; j < 16; ++j) { const unsigned c = xb_ld(&bar[XB_XCNT(j)]); sum += c; cnt += (c > 0u) ? 1u : 0u; mine = (j == x) ? c : mine; }
        if (sum == G) break;
        __builtin_amdgcn_s_sleep(1);
        if ((++sp & 255u) == 0u) { if (xb_ld(&bar[XB_TMO])) break; if (sp > XB_SPIN_CAP) { atomicAdd(&bar[XB_TMO], 1u); break; } }
    }
    nloc = mine > 0u ? mine : 1u; nx = cnt > 0u ? cnt : 1u;
}

__device__ __forceinline__ void xcd_barrier(const XcdBarrier& b) {
    asm volatile("s_waitcnt vmcnt(0)" ::: "memory");
    __syncthreads();
    if (threadIdx.x == 0) {
        unsigned blo_ = __builtin_amdgcn_readfirstlane((unsigned)(unsigned long long)b.bar), bhi_ = __builtin_amdgcn_readfirstlane((unsigned)((unsigned long long)b.bar >> 32)), bx = __builtin_amdgcn_readfirstlane(b.x); asm volatile("" : "+s"(blo_), "+s"(bhi_), "+s"(bx)); unsigned* bar = (unsigned*)(((unsigned long long)bhi_ << 32) | blo_);
        __builtin_amdgcn_s_waitcnt(0);
        unsigned nloc = b.st[0], nx = b.st[1];
        if (nloc == 0u) { xcd_barrier_complete(bar, bx, nloc, nx); b.st[0] = nloc; b.st[1] = nx; }
        const unsigned old = xb_add(&bar[XB_XSUB(bx)], 1u);
        const unsigned gen = old / nloc;
        if (old + 1u == (gen + 1u) * nloc) {
            __builtin_amdgcn_fence(__ATOMIC_RELEASE, "agent");
            asm volatile("s_waitcnt vmcnt(0)" ::: "memory");
            const unsigned og = xb_add(&bar[XB_TOP], 1u);
            const unsigned tg = og / nx;
            if (og + 1u == (tg + 1u) * nx) xb_add(&bar[XB_TOPGEN], 1u);
            else XB_SPIN(xb_ld(&bar[XB_TOPGEN]) == tg, bar);
            __builtin_amdgcn_fence(__ATOMIC_ACQUIRE, "agent");
            xb_add(&bar[XB_XGEN(bx)], 1u);
            asm volatile("s_waitcnt vmcnt(0)" ::: "memory");
        } else {
            XB_SPIN(xb_ld(&bar[XB_XGEN(bx)]) == gen, bar);
            __builtin_amdgcn_fence(__ATOMIC_ACQUIRE, "agent");
            asm volatile("s_waitcnt vmcnt(0)" ::: "memory");
        }
    }
    __syncthreads();
}
__device__ __forceinline__ void tr_item(const float* __restrict__ W, int K, int N, bf16* WT, int dst_row0, LAS float* scr, int k0, int n0, int lane,
                                        const float* __restrict__ mu, float sc0, float sc1) {
    const int nn = n0 + (lane & 31); const bool nv = nn < N;
#pragma unroll 8
    for (int i = 0; i < 32; ++i) { const int kk = 2 * i + (lane >> 5); float v = nv ? W[(size_t)(k0 + kk) * N + nn] : 0.f; if (mu) v *= sc0 + sc1 * mu[k0 + kk]; scr[kk * 33 + (lane & 31)] = v; }
    LDS_WAIT(); asm volatile("" ::: "memory");
    const int c = lane & 7;
#pragma unroll
    for (int j = 0; j < 4; ++j) { const int n = (lane >> 3) + 8 * j; const LAS float* s = scr + (8 * c) * 33 + n;
        v4u o; o.x = pk2(s[0 * 33], s[1 * 33]); o.y = pk2(s[2 * 33], s[3 * 33]); o.z = pk2(s[4 * 33], s[5 * 33]); o.w = pk2(s[6 * 33], s[7 * 33]);
        if (n0 + n < N) *(GAS v4u*)(WT + (size_t)(dst_row0 + n) * K + k0 + 8 * c) = o; }
    LDS_WAIT(); asm volatile("" ::: "memory");
}
__device__ __forceinline__ void rms_row_bf16(const float* xrow, const float* g, bf16* orow, int lane) {
    const GAS f32x4* xr = (const GAS f32x4*)xrow + lane; const GAS f32x4* gr = (const GAS f32x4*)g + lane;
    f32x4 v[4]; float s = 0.f;
#pragma unroll
    for (int j = 0; j < 4; ++j) { v[j] = xr[64 * j]; s += (v[j].x * v[j].x + v[j].y * v[j].y) + (v[j].z * v[j].z + v[j].w * v[j].w); }
    const float rs = frsq(wave_sum(s) * (1.f / D) + 1e-6f);
    GAS v2u* o8 = (GAS v2u*)orow + lane;
#pragma unroll
    for (int j = 0; j < 4; ++j) { const f32x4 gv = gr[64 * j]; v2u o; o.x = pk2(v[j].x * rs * gv.x, v[j].y * rs * gv.y); o.y = pk2(v[j].z * rs * gv.z, v[j].w * rs * gv.w); o8[64 * j] = o; }
}
__device__ __forceinline__ void rms_row_f32(const float* xrow, const float* g, float* orow, int lane) {
    const GAS f32x4* xr = (const GAS f32x4*)xrow + lane; const GAS f32x4* gr = (const GAS f32x4*)g + lane;
    f32x4 v[4]; float s = 0.f;
#pragma unroll
    for (int j = 0; j < 4; ++j) { v[j] = xr[64 * j]; s += (v[j].x * v[j].x + v[j].y * v[j].y) + (v[j].z * v[j].z + v[j].w * v[j].w); }
    const float rs = frsq(wave_sum(s) * (1.f / D) + 1e-6f);
    GAS f32x4* o = (GAS f32x4*)orow + lane;
#pragma unroll
    for (int j = 0; j < 4; ++j) { const f32x4 gv = gr[64 * j]; o[64 * j] = v[j] * rs * gv; }
}

struct Args { const float* in[36]; float* out; unsigned char* ws; int lo, hi; };
typedef const __attribute__((address_space(4))) Args* ArgP;
#define FRESH_ARGS() ({ ArgP p_ = (ArgP)__builtin_amdgcn_kernarg_segment_ptr(); asm volatile("" : "+s"(p_)); p_; })
#define FRESH_V(x) asm volatile("" : "+v"(x))
#define FRESH_S(x) asm volatile("" : "+s"(x))

__device__ __forceinline__ void phase_convert_norm(ArgP A, int L, const float* xin, LAS unsigned char* lds, int wave, int lane, int G, int bid) {
    const int i = L >> 1; const bool even = !(L & 1);
    bf16* Win = (bf16*)(A->ws + WS_WIN); bf16* Wout = (bf16*)(A->ws + WS_WOUT); bf16* Wgu = (bf16*)(A->ws + WS_WGU); bf16* Wdn = (bf16*)(A->ws + WS_WDN);
    LAS float* scr = (LAS float*)(lds + wave * 16384);
    const int gw = bid * NWAVES + wave, NGW = G * NWAVES;
    const float* w_in = even ? A->in[5] + (size_t)i * D * 3072 : A->in[26] + (size_t)i * D * 3072;
    const float* w_out = even ? A->in[6] + (size_t)i * D * D : A->in[27] + (size_t)i * D * D;
    const float* mu_w = A->in[8] + (size_t)i * 3 * D, *mu_a = mu_w + D, *mu_g = mu_w + 2 * D;
    const float* w1 = A->in[10] + (size_t)i * D * 64, *a1 = A->in[13] + (size_t)i * D * 64, *g1 = A->in[15] + (size_t)i * D * 160, *wa1 = A->in[22] + (size_t)i * D * 16;
    const float* wg = A->in[33] + (size_t)L * D * FF, *wu = A->in[34] + (size_t)L * D * FF, *wd = A->in[35] + (size_t)L * FF * D;
    const int I_IN = 16 * 96, I_L64 = 16 * 2, I_L160 = 16 * 5, I_L16 = 16 * 1, I_OUT = 16 * 32, I_GU = 16 * 88, I_DN = 44 * 32;
    const int n_lora = even ? (4 * I_L64 + 2 * I_L160 + I_L16) : 0;
    const int NITEMS = I_IN + n_lora + I_OUT + 2 * I_GU + I_DN;
#define TR_JOB(items, nblk, Wp, Kd, Nd, DST, ROW0, MU, S0, S1) if (r < (items)) { const int kb = r / (nblk), nb = r % (nblk), n0 = 32 * nb; tr_item(Wp, Kd, Nd, DST, ROW0, scr, 64 * kb, n0, lane, MU, S0, S1); continue; } r -= (items);
    for (int it = gw; it < NITEMS; it += NGW) {
        int r = it;
        TR_JOB(I_IN, 96, w_in, D, 3072, Win, n0, nullptr, 1.f, 0.f)
        if (even) {
            TR_JOB(I_L64, 2, w1, D, 64, Win, PC_W1A + n0, mu_w, 1.f, -1.f)
            TR_JOB(I_L64, 2, w1, D, 64, Win, PC_W1B + n0, mu_w, 0.f, 1.f)
            TR_JOB(I_L64, 2, a1, D, 64, Win, PC_A1A + n0, mu_a, 1.f, -1.f)
            TR_JOB(I_L64, 2, a1, D, 64, Win, PC_A1B + n0, mu_a, 0.f, 1.f)
            TR_JOB(I_L160, 5, g1, D, 160, Win, PC_G1A + n0, mu_g, 1.f, -1.f)
            TR_JOB(I_L160, 5, g1, D, 160, Win, PC_G1B + n0, mu_g, 0.f, 1.f)
            TR_JOB(I_L16, 1, wa1, D, 16, Win, PC_WA1 + n0, nullptr, 1.f, 0.f)
        }
        TR_JOB(I_OUT, 32, w_out, D, D, Wout, n0, nullptr, 1.f, 0.f)
        TR_JOB(I_GU, 88, wg, D, FF, Wgu, 256 * (n0 >> 7) + (n0 & 127), nullptr, 1.f, 0.f)
        TR_JOB(I_GU, 88, wu, D, FF, Wgu, 256 * (n0 >> 7) + (n0 & 127) + 128, nullptr, 1.f, 0.f)
        TR_JOB(I_DN, 32, wd, FF, D, Wdn, n0, nullptr, 1.f, 0.f)
    }
#undef TR_JOB
    if (even) {
        const int gt = bid * NTHREADS + wave * 64 + lane, NT = G * NTHREADS;
        for (int e = gt; e < (NIN_E - PC_PAD) * D / 8; e += NT) ((GAS v4u*)(Win + (size_t)PC_PAD * D))[e] = (v4u){0u, 0u, 0u, 0u};
    }
    bf16* XN = (bf16*)(A->ws + WS_XN); const float* gain = A->in[2] + (size_t)L * D;
    for (int m = gw; m < M; m += NGW) rms_row_bf16(xin + (size_t)m * D, gain, XN + (size_t)m * D, lane);
}

__device__ __forceinline__ void phase_prep(ArgP A, int L, LAS unsigned char* lds, int G, int tid, int bid) {
    const int i = L >> 1;
    const bf16* P = (const bf16*)(A->ws + WS_P); float* WLOG = (float*)(A->ws + WS_WLOG); float* ASIG = (float*)(A->ws + WS_ASIG); float* LA = (float*)(A->ws + WS_LA); bf16* XN = (bf16*)(A->ws + WS_XN);
    const float* w0 = A->in[9] + i * 512, *w2 = A->in[11] + (size_t)i * 64 * 512, *a0 = A->in[12] + i * 512, *a2 = A->in[14] + (size_t)i * 64 * 512, *g2 = A->in[16] + (size_t)i * 160 * 512;
    const float* wa2 = A->in[23] + (size_t)i * 16 * 256, *ba = A->in[24] + i * 256;
    LAS float* sl = (LAS float*)lds;
    for (int item = bid; item < M / 32; item += G) {
        const int row0 = item * 32;
        for (int e = tid; e < NLORA * 32; e += NTHREADS) {
            const int tok = e / NLORA, jj = e % NLORA; const int row = row0 + tok; const bool has_prev = (row % T) != 0;
            const bf16* pr = P + (size_t)row * NIN_E; const bf16* pp = pr - NIN_E;
            float v;
            if (jj < 64) { v = bf2f(pr[PC_W1A + jj]) + (has_prev ? bf2f(pp[PC_W1B + jj]) : 0.f); v = tanh_f(v); }
            else if (jj < 128) { const int j = jj - 64; v = bf2f(pr[PC_A1A + j]) + (has_prev ? bf2f(pp[PC_A1B + j]) : 0.f); }
            else if (jj < 288) { const int j = jj - 128; v = bf2f(pr[PC_G1A + j]) + (has_prev ? bf2f(pp[PC_G1B + j]) : 0.f); v = sigmoid_f(v); }
            else { const int j = jj - 288; v = bf2f(pr[PC_WA1 + j]); }
            sl[jj * 32 + tok] = v;
        }
        __syncthreads();
        const int c = tid;
        {
            float acc[32];
#pragma unroll
            for (int t = 0; t < 32; ++t) acc[t] = 0.f;
            for (int j = 0; j < 64; ++j) { const float w = w2[j * 512 + c];
#pragma unroll
                for (int t4 = 0; t4 < 8; ++t4) { const f32x4 x = *(const LAS f32x4*)(sl + j * 32 + 4 * t4); acc[4 * t4] += x.x * w; acc[4 * t4 + 1] += x.y * w; acc[4 * t4 + 2] += x.z * w; acc[4 * t4 + 3] += x.w * w; } }
            const float b0 = w0[c]; float* op = WLOG + (size_t)row0 * 512 + c;
#pragma unroll
            for (int t = 0; t < 32; ++t) { const float x = b0 + acc[t]; const float wraw = -softplus_f(-x) - 0.5f; *op = -fexp(wraw); op += 512; FRESH_V(op); }
        }
        {
            float acc[32];
#pragma unroll
            for (int t = 0; t < 32; ++t) acc[t] = 0.f;
            for (int j = 0; j < 64; ++j) { const float w = a2[j * 512 + c];
#pragma unroll
                for (int t4 = 0; t4 < 8; ++t4) { const f32x4 x = *(const LAS f32x4*)(sl + (64 + j) * 32 + 4 * t4); acc[4 * t4] += x.x * w; acc[4 * t4 + 1] += x.y * w; acc[4 * t4 + 2] += x.z * w; acc[4 * t4 + 3] += x.w * w; } }
            const float b0 = a0[c]; float* op = ASIG + (size_t)row0 * 512 + c;
#pragma unroll
            for (int t = 0; t < 32; ++t) { *op = sigmoid_f(b0 + acc[t]); op += 512; FRESH_V(op); }
        }
        {
            float acc[32];
#pragma unroll
            for (int t = 0; t < 32; ++t) acc[t] = 0.f;
            for (int j = 0; j < 160; ++j) { const float w = g2[j * 512 + c];
#pragma unroll
                for (int t4 = 0; t4 < 8; ++t4) { const f32x4 x = *(const LAS f32x4*)(sl + (128 + j) * 32 + 4 * t4); acc[4 * t4] += x.x * w; acc[4 * t4 + 1] += x.y * w; acc[4 * t4 + 2] += x.z * w; acc[4 * t4 + 3] += x.w * w; } }
            bf16* op = XN + (size_t)row0 * D + c;
#pragma unroll
            for (int t = 0; t < 32; ++t) { *op = (bf16)f2bf(acc[t]); op += D; FRESH_V(op); }
        }
        if (c < 256) {
            float acc[32];
#pragma unroll
            for (int t = 0; t < 32; ++t) acc[t] = 0.f;
            for (int j = 0; j < 16; ++j) { const float w = wa2[j * 256 + c];
#pragma unroll
                for (int t4 = 0; t4 < 8; ++t4) { const f32x4 x = *(const LAS f32x4*)(sl + (288 + j) * 32 + 4 * t4); acc[4 * t4] += x.x * w; acc[4 * t4 + 1] += x.y * w; acc[4 * t4 + 2] += x.z * w; acc[4 * t4 + 3] += x.w * w; } }
            const float b0 = ba[c]; float* op = LA + (size_t)row0 * 256 + c;
#pragma unroll
            for (int t = 0; t < 32; ++t) { *op = -softplus_f(-(b0 + acc[t])) * (1.0f / 16.0f); op += 256; FRESH_V(op); }
        }
        __syncthreads();
    }
}

__device__ __noinline__ void rwkv_scan_seq(ArgP A, int L, int b, int h, LAS float* sc, int lane) {
    const int i = L >> 1, c = h * 64 + lane;
    const bf16* P = (const bf16*)(A->ws + WS_P); const float* WLOG = (const float*)(A->ws + WS_WLOG); const float* ASIG = (const float*)(A->ws + WS_ASIG); bf16* OAB = (bf16*)(A->ws + WS_XN);
    const float* mu = A->in[7] + (size_t)i * 1536;
    const float mur = mu[c], muk = mu[512 + c], muv = mu[1024 + c];
    const float kkc = A->in[17][i * 512 + c], kac = A->in[18][i * 512 + c], rkc = A->in[19][i * 512 + c], lnw = A->in[20][i * 512 + c], lnb = A->in[21][i * 512 + c];
    float S[64];
#pragma unroll
    for (int k = 0; k < 64; ++k) S[k] = 0.f;
    float pr_prev = 0.f, pk_prev = 0.f, pv_prev = 0.f;
    const size_t row0 = (size_t)b * T;
    float npr = bf2f(P[row0 * NIN_E + PC_R + c]), npk = bf2f(P[row0 * NIN_E + PC_K + c]), npv = bf2f(P[row0 * NIN_E + PC_V + c]);
    float nwl = WLOG[row0 * 512 + c], nas = ASIG[row0 * 512 + c], ng = bf2f(OAB[row0 * D + c]);
#pragma unroll 1
    for (int t = 0; t < T; ++t) {
        const float pr = npr, pk = npk, pv = npv, wl = nwl, as = nas, g = ng;
        if (t + 1 < T) { const size_t rw = row0 + t + 1; npr = bf2f(P[rw * NIN_E + PC_R + c]); npk = bf2f(P[rw * NIN_E + PC_K + c]); npv = bf2f(P[rw * NIN_E + PC_V + c]);
            nwl = WLOG[rw * 512 + c]; nas = ASIG[rw * 512 + c]; ng = bf2f(OAB[rw * D + c]); }
        const float r = pr + (pr_prev - pr) * mur, k = pk + (pk_prev - pk) * muk, v = pv + (pv_prev - pv) * muv;
        pr_prev = pr; pk_prev = pk; pv_prev = pv;
        float kk = k * kkc; const float n2 = wave_sum(kk * kk); kk = kk * frcp(fmaxf(fsqrt(n2), 1e-12f));
        const float kmod = k * (1.f + (as - 1.f) * kac);
        sc[lane] = -kk; sc[64 + lane] = fexp(wl); sc[128 + lane] = kk * as; sc[192 + lane] = kmod; sc[256 + lane] = r;
        LDS_WAIT(); asm volatile("" ::: "memory");
        float sa = 0.f;
#pragma unroll
        for (int k4 = 0; k4 < 16; ++k4) { const f32x4 a4 = *(const LAS f32x4*)(sc + 4 * k4); sa += S[4 * k4] * a4.x; sa += S[4 * k4 + 1] * a4.y; sa += S[4 * k4 + 2] * a4.z; sa += S[4 * k4 + 3] * a4.w; }
        float y = 0.f;
#pragma unroll
        for (int k4 = 0; k4 < 16; ++k4) {
            const f32x4 w4 = *(const LAS f32x4*)(sc + 64 + 4 * k4), b4 = *(const LAS f32x4*)(sc + 128 + 4 * k4), kq = *(const LAS f32x4*)(sc + 192 + 4 * k4), r4 = *(const LAS f32x4*)(sc + 256 + 4 * k4);
            S[4 * k4] = S[4 * k4] * w4.x + sa * b4.x + v * kq.x; y += S[4 * k4] * r4.x;
            S[4 * k4 + 1] = S[4 * k4 + 1] * w4.y + sa * b4.y + v * kq.y; y += S[4 * k4 + 1] * r4.y;
            S[4 * k4 + 2] = S[4 * k4 + 2] * w4.z + sa * b4.z + v * kq.z; y += S[4 * k4 + 2] * r4.z;
            S[4 * k4 + 3] = S[4 * k4 + 3] * w4.w + sa * b4.w + v * kq.w; y += S[4 * k4 + 3] * r4.w;
        }
        asm volatile("" ::: "memory");
        const float bonus = wave_sum(r * kmod * rkc);
        const float mean = wave_sum(y) * (1.f / 64.f); const float d = y - mean; const float var = wave_sum(d * d) * (1.f / 64.f);
        float o = d * frsq(var + 64e-5f) * lnw + lnb;
        o = (o + bonus * v) * g;
        OAB[(row0 + t) * D + c] = (bf16)f2bf(o);
    }
}
__device__ __noinline__ void gla_scan_half(ArgP A, int b, int h, int half, LAS float* sc, int lane) {
    const bf16* P = (const bf16*)(A->ws + WS_P); const float* LA = (const float*)(A->ws + WS_LA); bf16* OAB = (bf16*)(A->ws + WS_XN);
    float S0[64];
#pragma unroll
    for (int k = 0; k < 64; ++k) S0[k] = 0.f;
    const size_t row0 = (size_t)b * T;
#pragma unroll 1
    for (int t = 0; t < T; ++t) {
        const size_t rw = row0 + t; const bf16* pr = P + rw * NIN_E;
        const float q = bf2f(pr[PC_GQ + h * 64 + lane]) * 0.125f, kx = bf2f(pr[PC_GK + h * 64 + lane]), la = LA[rw * 256 + h * 64 + lane];
        const float v0 = bf2f(pr[PC_GV + h * 128 + half * 64 + lane]);
        sc[lane] = fexp(la); sc[64 + lane] = kx; sc[128 + lane] = q;
        LDS_WAIT(); asm volatile("" ::: "memory");
        float o0 = 0.f;
#pragma unroll
        for (int k4 = 0; k4 < 16; ++k4) {
            const f32x4 a4 = *(const LAS f32x4*)(sc + 4 * k4), k4v = *(const LAS f32x4*)(sc + 64 + 4 * k4), q4 = *(const LAS f32x4*)(sc + 128 + 4 * k4);
            S0[4 * k4] = S0[4 * k4] * a4.x + k4v.x * v0; o0 += q4.x * S0[4 * k4];
            S0[4 * k4 + 1] = S0[4 * k4 + 1] * a4.y + k4v.y * v0; o0 += q4.y * S0[4 * k4 + 1];
            S0[4 * k4 + 2] = S0[4 * k4 + 2] * a4.z + k4v.z * v0; o0 += q4.z * S0[4 * k4 + 2];
            S0[4 * k4 + 3] = S0[4 * k4 + 3] * a4.w + k4v.w * v0; o0 += q4.w * S0[4 * k4 + 3];
        }
        asm volatile("" ::: "memory");
        OAB[rw * D + 512 + h * 128 + half * 64 + lane] = (bf16)f2bf(o0);
    }
}
__device__ __noinline__ void gla_norm_rows(ArgP A, int L, int b, int h, int wave, int lane) {
    const int i = L >> 1;
    const bf16* P = (const bf16*)(A->ws + WS_P); bf16* OAB = (bf16*)(A->ws + WS_XN);
    const float gn0 = A->in[25][i * 512 + h * 128 + 2 * lane], gn1 = A->in[25][i * 512 + h * 128 + 2 * lane + 1];
    for (int t = wave; t < T; t += NWAVES) {
        const size_t rw = (size_t)b * T + t;
        GAS unsigned* op = (GAS unsigned*)(OAB + rw * D + 512 + h * 128 + 2 * lane);
        const unsigned ov = *op, gv = *(const GAS unsigned*)(P + rw * NIN_E + PC_GG + h * 128 + 2 * lane);
        const float o0 = bflo(ov), o1 = bfhi(ov);
        const float rs = frsq(wave_sum(o0 * o0 + o1 * o1) * (1.f / 128.f) + 1e-5f);
        *op = pk2(o0 * rs * gn0 * silu_f(bflo(gv)), o1 * rs * gn1 * silu_f(bfhi(gv)));
    }
}

__device__ __forceinline__ int t5_bucket(int d) {
    if (d < 16) return d;
    const float r = (float)d / 16.0f; int l = 16 + (int)(flog(r) / 2.0794415416798357f * 16.0f);
    return l < 31 ? l : 31;
}
__device__ __noinline__ void attn_row_simple(ArgP A, int L, int b, int h, int t, float lam, float lam_init, LAS float* qs  , LAS float* bd  , int lane) {
    const int i = L >> 1;
    const bf16* QKV = (const bf16*)(A->ws + WS_P); bf16* O = (bf16*)(A->ws + WS_XN);
    const bf16* qrow = QKV + (size_t)(b * T + t) * NIN_O + h * 128;
    qs[lane] = bf2f(qrow[lane]) * 0.125f; qs[64 + lane] = bf2f(qrow[64 + lane]) * 0.125f;
    bd[lane] = A->in[1][t5_bucket(lane) * 8 + h]; bd[64 + lane] = A->in[1][t5_bucket(64 + lane) * 8 + h];
    LDS_WAIT(); asm volatile("" ::: "memory");
    float m1 = -1e30f, m2 = -1e30f, l1 = 0.f, l2 = 0.f, o1a = 0.f, o1b = 0.f, o2a = 0.f, o2b = 0.f;
#pragma unroll 1
    for (int j0 = 0; j0 <= t; j0 += 64) {
        const int j = j0 + lane; const bool valid = j <= t;
        const bf16* krow = QKV + (size_t)(b * T + j) * NIN_O + 1024 + h * 128;
        float s1 = 0.f, s2 = 0.f;
#pragma unroll 2
        for (int c8 = 0; c8 < 8; ++c8) { const v4u kv = *(const GAS v4u*)(krow + 8 * c8); const f32x4 qa = *(const LAS f32x4*)(qs + 8 * c8), qb = *(const LAS f32x4*)(qs + 8 * c8 + 4);
            s1 += qa.x * bflo(kv.x) + qa.y * bfhi(kv.x) + qa.z * bflo(kv.y) + qa.w * bfhi(kv.y) + qb.x * bflo(kv.z) + qb.y * bfhi(kv.z) + qb.z * bflo(kv.w) + qb.w * bfhi(kv.w); }
#pragma unroll 2
        for (int c8 = 0; c8 < 8; ++c8) { const v4u kv = *(const GAS v4u*)(krow + 64 + 8 * c8); const f32x4 qa = *(const LAS f32x4*)(qs + 64 + 8 * c8), qb = *(const LAS f32x4*)(qs + 64 + 8 * c8 + 4);
            s2 += qa.x * bflo(kv.x) + qa.y * bfhi(kv.x) + qa.z * bflo(kv.y) + qa.w * bfhi(kv.y) + qb.x * bflo(kv.z) + qb.y * bfhi(kv.z) + qb.z * bflo(kv.w) + qb.w * bfhi(kv.w); }
        const int dist = valid ? (t - j) : 0; const float bias = bd[dist < 127 ? dist : 127];
        s1 = valid ? s1 + bias : -1e30f; s2 = valid ? s2 + bias : -1e30f;
        const float mn1 = fmaxf(m1, wave_max(s1)), mn2 = fmaxf(m2, wave_max(s2));
        const float c1 = fexp(m1 - mn1), c2 = fexp(m2 - mn2);
        const float p1 = valid ? fexp(s1 - mn1) : 0.f, p2 = valid ? fexp(s2 - mn2) : 0.f;
        l1 = l1 * c1 + wave_sum(p1); l2 = l2 * c2 + wave_sum(p2); m1 = mn1; m2 = mn2;
        o1a *= c1; o1b *= c1; o2a *= c2; o2b *= c2;
        const bf16* vbase = QKV + (size_t)(b * T + j0) * NIN_O + 2048 + h * 128 + 2 * lane;
#pragma unroll 4
        for (int jj = 0; jj < 64; ++jj) {
            const float pj1 = __builtin_bit_cast(float, __builtin_amdgcn_readlane(__builtin_bit_cast(int, p1), jj)), pj2 = __builtin_bit_cast(float, __builtin_amdgcn_readlane(__builtin_bit_cast(int, p2), jj));
            const unsigned vv = *(const GAS unsigned*)(vbase + (size_t)jj * NIN_O); const float v0 = bflo(vv), v1 = bfhi(vv);
            o1a += pj1 * v0; o1b += pj1 * v1; o2a += pj2 * v0; o2b += pj2 * v1;
        }
    }
    const float il1 = frcp(l1), il2 = frcp(l2); float oa = o1a * il1 - lam * (o2a * il2), ob = o1b * il1 - lam * (o2b * il2);
    const float ms = wave_sum(oa * oa + ob * ob) * (1.f / 128.f); const float rs = frsq(ms + 1e-5f);
    const float sc = 1.0f - lam_init; const float* sl = A->in[32] + i * 128;
    oa = oa * rs * sl[2 * lane] * sc; ob = ob * rs * sl[2 * lane + 1] * sc;
    *(GAS unsigned*)(O + (size_t)(b * T + t) * D + h * 128 + 2 * lane) = pk2(oa, ob);
}
constexpr int N_STEPS = 33;
#ifndef MK_ONE_LAUNCH
#define MK_ONE_LAUNCH 1
#endif
__global__ void __launch_bounds__(NTHREADS, 2) hybrid_fwd(Args args) {
    extern __shared__ __attribute__((aligned(16))) unsigned char lds_raw[];
    LAS unsigned char* lds = (LAS unsigned char*)lds_raw;
    ArgP A0 = (ArgP)__builtin_amdgcn_kernarg_segment_ptr();
    { const int tid = threadIdx.x; for (int u = tid; u < (LDS_BYTES - LDSCTL_OFF) / 4; u += NTHREADS) ((LAS unsigned*)(lds + LDSCTL_OFF))[u] = 0u; }
    __syncthreads();
    const int lo = A0->lo, hi = A0->hi;
    if (hi - lo > 1) (void)xcd_barrier_post((unsigned*)(A0->ws + WS_CTL) + CW_BAR, (volatile LAS unsigned*)(lds + MISC_OFF) + 8);
#ifndef PHM
#define PHM 0xff
#endif
#define RUN(s) (lo <= (s) && (s) < hi)
#define EN(b) ((PHM >> (b)) & 1)
#define GRID_BARRIER() do { ArgP Ab_ = FRESH_ARGS(); XcdBarrier b_; b_.bar = (unsigned*)(Ab_->ws + WS_CTL) + CW_BAR; b_.x = xb_xcc_id(); b_.st = (volatile LAS unsigned*)(lds + MISC_OFF) + 8; xcd_barrier(b_); } while (0)
#define SEAM(s) do { if (RUN(s) && RUN((s) + 1)) GRID_BARRIER(); } while (0)
#define PHASE_VARS() ArgP A = FRESH_ARGS(); int L = Lq; FRESH_S(L); int tid = threadIdx.x; FRESH_V(tid); const int lane = tid & 63, wave = __builtin_amdgcn_readfirstlane(tid >> 6); int G = gridDim.x, bid = blockIdx.x; FRESH_S(G); FRESH_S(bid); (void)lane; (void)wave; (void)G; (void)A; (void)bid; \
    bf16* XN = (bf16*)(A->ws + WS_XN); bf16* PB = (bf16*)(A->ws + WS_P); (void)XN; (void)PB

    for (int Lq = 0; Lq < 4; ++Lq) {
        const int s0 = 8 * Lq; const bool even = !(Lq & 1);
        if (EN(0) && RUN(s0 + 0)) { PHASE_VARS(); const float* xin = (L == 0) ? A->in[0] : A->out; phase_convert_norm(A, L, xin, lds, wave, lane, G, bid); }
        SEAM(s0 + 0);
        if (EN(1) && RUN(s0 + 1)) {
            PHASE_VARS(); bf16* Win = (bf16*)(A->ws + WS_WIN);
            if (even) {
                pg8::Gemm g{XN, Win, M, NIN_E, D}; pg8::StaticOrderC<M, NIN_E> S; S.init(G, bid);
                pg8::EpiStoreBf16 E{PB, NIN_E};
                pg8::gemm_phase<pg8::EpiStoreBf16, pg8::StaticOrderC<M, NIN_E>, PG8_ALIGN, PG8_SP2>(lds, g, S, E);
            } else {
                pg8::Gemm g{XN, Win, M, NIN_O, D}; pg8::StaticOrderC<M, NIN_O> S; S.init(G, bid);
                pg8::EpiStoreBf16 E{PB, NIN_O};
                pg8::gemm_phase<pg8::EpiStoreBf16, pg8::StaticOrderC<M, NIN_O>, PG8_ALIGN, PG8_SP2>(lds, g, S, E);
            }
        }
        SEAM(s0 + 1);
        if (even) {
            if (EN(2) && RUN(s0 + 2)) { PHASE_VARS(); phase_prep(A, L, lds, G, tid, bid); }
            SEAM(s0 + 2);
            if (EN(3) && RUN(s0 + 3)) {
                PHASE_VARS();
                const int task = bid;
                if (task < 64) { if (wave == 0) rwkv_scan_seq(A, L, task >> 3, task & 7, (LAS float*)lds, lane); }
                else if (task < 96) { if (wave < 2) gla_scan_half(A, (task - 64) >> 2, (task - 64) & 3, wave, (LAS float*)lds + wave * 192, lane); }
                __syncthreads();
                if (task >= 64 && task < 96) gla_norm_rows(A, L, (task - 64) >> 2, (task - 64) & 3, wave, lane);
            }
        } else {
            if (EN(4) && RUN(s0 + 3)) {
                PHASE_VARS();
                const int i = L >> 1;
                const float lam_init = 0.8f - 0.6f * fexp(-0.3f * (float)L);
                const float lam = fexp(wave_sum(A->in[28][i * 64 + lane] * A->in[29][i * 64 + lane])) - fexp(wave_sum(A->in[30][i * 64 + lane] * A->in[31][i * 64 + lane])) + lam_init;
                LAS float* qs = (LAS float*)lds + wave * 256; LAS float* bd = qs + 128;
                for (int it = bid; it < BATCH * 8 * (T / 8); it += G) {
                    const int bh = it / (T / 8), rg = it % (T / 8);
                    attn_row_simple(A, L, bh >> 3, bh & 7, rg * 8 + wave, lam, lam_init, qs, bd, lane);
                }
            }
        }
        if (RUN(s0 + 3) && RUN(s0 + 4)) GRID_BARRIER();
        if (EN(5) && RUN(s0 + 4)) {
            PHASE_VARS(); bf16* Wout = (bf16*)(A->ws + WS_WOUT); const float* xin = (L == 0) ? A->in[0] : A->out;
            pg8::Gemm g{XN, Wout, M, D, D}; pg8::StaticOrderC<M, D> S; S.init(G, bid);
            pg8::EpiResF32 E{xin, A->out, D};
            pg8::gemm_phase<pg8::EpiResF32, pg8::StaticOrderC<M, D>, PG8_ALIGN, PG8_SP2>(lds, g, S, E);
        }
        SEAM(s0 + 4);
        if (RUN(s0 + 5)) {
            PHASE_VARS();
            const int gw = bid * NWAVES + wave, NGW = G * NWAVES; const float* gain = A->in[3] + (size_t)L * D;
            for (int m = gw; m < M; m += NGW) rms_row_bf16(A->out + (size_t)m * D, gain, XN + (size_t)m * D, lane);
        }
        SEAM(s0 + 5);
        if (EN(6) && RUN(s0 + 6)) {
            PHASE_VARS(); bf16* Wgu = (bf16*)(A->ws + WS_WGU);
            pg8::Gemm g{XN, Wgu, M, NGU, D}; pg8::StaticOrderC<M, NGU> S; S.init(G, bid);
            pg8::EpiSwiglu E{PB, FF};
            pg8::gemm_phase<pg8::EpiSwiglu, pg8::StaticOrderC<M, NGU>, PG8_ALIGN, PG8_SP2>(lds, g, S, E);
        }
        SEAM(s0 + 6);
        if (EN(7) && RUN(s0 + 7)) {
            PHASE_VARS(); bf16* Wdn = (bf16*)(A->ws + WS_WDN);
            pg8::Gemm g{PB, Wdn, M, D, FF}; pg8::StaticOrderC<M, D> S; S.init(G, bid);
            pg8::EpiResF32 E{A->out, A->out, D};
            pg8::gemm_phase<pg8::EpiResF32, pg8::StaticOrderC<M, D>, PG8_ALIGN, PG8_SP2>(lds, g, S, E);
        }
        SEAM(s0 + 7);
    }
    if (RUN(32)) {
        int Lq = 0; PHASE_VARS();
        const int gw = bid * NWAVES + wave, NGW = G * NWAVES;
        for (int m = gw; m < M; m += NGW) rms_row_f32(A->out + (size_t)m * D, A->in[4], A->out + (size_t)m * D, lane);
    }
#undef RUN
#undef SEAM
}

extern "C" void kernel_launch(void* const* d_in, const int* in_sizes, int n_in, void* d_out, int out_size, void* d_ws, size_t ws_size, hipStream_t stream) {
    static int grid = 0;
    if (grid == 0) {
        if (n_in != 36 || in_sizes[0] != M * D || out_size != M * D || ws_size < WS_END) { fprintf(stderr, "kernel_launch: unexpected shapes (n_in %d, in0 %d, out %d, ws %zu); nothing launched\n", n_in, n_in > 0 ? in_sizes[0] : -1, out_size, ws_size); grid = -1; return; }
        int dev = 0, cus = 0, per_cu = 0;
        if (hipGetDevice(&dev) != hipSuccess || hipDeviceGetAttribute(&cus, hipDeviceAttributeMultiprocessorCount, dev) != hipSuccess) { grid = -1; return; }
        if (hipFuncSetAttribute((const void*)hybrid_fwd, hipFuncAttributeMaxDynamicSharedMemorySize, LDS_BYTES) != hipSuccess) { fprintf(stderr, "kernel_launch: hipFuncSetAttribute failed\n"); grid = -1; return; }
        if (hipOccupancyMaxActiveBlocksPerMultiprocessor(&per_cu, (const void*)hybrid_fwd, NTHREADS, LDS_BYTES) != hipSuccess || per_cu < 1) fprintf(stderr, "kernel_launch: occupancy query reports %d\n", per_cu);
        (void)hipGetLastError();
        grid = cus;
    }
    if (grid < 0) return;
    if (hipMemsetAsync((char*)d_ws + WS_CTL, 0, CTL_ZERO_BYTES, stream) != hipSuccess) return;
    Args a{};
    for (int i = 0; i < 36; ++i) a.in[i] = (const float*)d_in[i];
    a.out = (float*)d_out; a.ws = (unsigned char*)d_ws;
#if MK_ONE_LAUNCH
    a.lo = 0; a.hi = N_STEPS;
    hipLaunchKernelGGL(hybrid_fwd, dim3(grid), dim3(NTHREADS), LDS_BYTES, stream, a);
#else
    for (int s = 0; s < N_STEPS; ++s) {
        if (s < 32 && (s & 7) == 2 && ((s >> 3) & 1)) continue;
        a.lo = s; a.hi = s + 1;
        hipLaunchKernelGGL(hybrid_fwd, dim3(grid), dim3(NTHREADS), LDS_BYTES, stream, a);
    }
#endif
}
```

```cpp
#include <hip/hip_runtime.h>
#include <cstdio>
#include <cstdint>
__device__ __forceinline__ float silu_f(float x) { return x * __builtin_amdgcn_rcpf(1.0f + __builtin_amdgcn_exp2f(-1.4426950408889634f * x)); }
namespace pg8 {
#define PG8_LAS __attribute__((address_space(3)))
typedef unsigned short bf16_t;
typedef short bf16x8 __attribute__((ext_vector_type(8)));
typedef float f32x4 __attribute__((ext_vector_type(4)));
typedef unsigned u32x4 __attribute__((ext_vector_type(4)));
constexpr int BM = 256, BK = 64, HALF = 128, HTB = HALF * BK * 2  , STAGE_BYTES = 8 * HTB, NXCD = 8, WGM = 8;

__host__ __device__ __forceinline__ int lds_byte(int r, int c) { const int st = (r >> 4) * 2 + (c >> 5), rr = r & 15, cc = c & 31, ob = rr * 64 + cc * 2; return st * 1024 + (ob ^ (((ob >> 9) & 1) << 5)); }
__host__ __device__ __forceinline__ void stage_rc(int b, int& R, int& C) { const int st = b / 1024, sb = b % 1024, swz = sb ^ (((sb >> 9) & 1) << 5); R = (st >> 1) * 16 + swz / 64; C = (st & 1) * 32 + (swz % 64) / 2; }
__host__ __device__ __forceinline__ int perm32(int rho) { const int n = rho >> 4, i = rho & 15; return 8 * (i >> 2) + 4 * n + (i & 3); }

struct Unit { int pm, pn; };
struct Gemm { const bf16_t* A; const bf16_t* Bt; int M, N, K; };

struct StaticOrder {
    int nM, nN, nwg, G, c;
    __host__ __device__ void init(int M, int N, int G_, int c_) { nM = M / BM; nN = N / BM; nwg = nM * nN; G = G_; c = c_; }
    __host__ __device__ bool next(int i, Unit& u) const {
        const long L = (long)i * G + c; if (L >= nwg) return false;
        int wgid = (int)L; { const int q = nwg / NXCD, r = nwg % NXCD, xcd = wgid % NXCD, off = wgid / NXCD; wgid = (xcd < r ? xcd * (q + 1) : r * (q + 1) + (xcd - r) * q) + off; }
        const int nig = WGM * nN, gid = wgid / nig, fm = gid * WGM, gsz = (nM - fm) < WGM ? (nM - fm) : WGM;
        u.pm = fm + ((wgid % nig) % gsz); u.pn = (wgid % nig) / gsz; return true;
    }
    __device__ __forceinline__ void a_ready(const Unit&) const {}
    __device__ __forceinline__ void done(const Unit&) const {}
};

__device__ __forceinline__ unsigned cvt_pk_bf16(float lo, float hi) { unsigned r; asm volatile("v_cvt_pk_bf16_f32 %0, %1, %2" : "=v"(r) : "v"(lo), "v"(hi)); return r; }
typedef float f32x2 __attribute__((ext_vector_type(2)));
struct EpiStoreBf16 {
    static constexpr bool PERM = true, AFTER_DRAIN = false;
    bf16_t* O; int ldc; int qtiles; float qscale;
    __device__ __forceinline__ void operator()(const f32x4 (&acc)[2][2][4][2], const Unit& u, int wr, int wc, int fr, int fq) const {
        const int row0 = u.pm * BM + wr * 64 + fr, col0 = u.pn * BM + wc * 32 + 8 * fq;
        const float sc = u.pn < qtiles ? qscale : 1.0f;
#pragma unroll
        for (int ai = 0; ai < 2; ++ai)
#pragma unroll
            for (int m = 0; m < 4; ++m) { bf16_t* rowp = O + (size_t)(row0 + ai * HALF + m * 16) * ldc + col0;
#pragma unroll
                for (int bj = 0; bj < 2; ++bj) { const f32x4 v0 = acc[ai][bj][m][0] * sc, v1 = acc[ai][bj][m][1] * sc;
                    u32x4 w; w.x = cvt_pk_bf16(v0[0], v0[1]); w.y = cvt_pk_bf16(v0[2], v0[3]); w.z = cvt_pk_bf16(v1[0], v1[1]); w.w = cvt_pk_bf16(v1[2], v1[3]);
                    *(u32x4*)(rowp + bj * HALF) = w; } }
    }
};
struct EpiResF32 {
    static constexpr bool PERM = false, AFTER_DRAIN = false;
    const float* base; float* out; int ldc;
    __device__ __forceinline__ void operator()(const f32x4 (&acc)[2][2][4][2], const Unit& u, int wr, int wc, int fr, int fq) const {
        const int row0 = u.pm * BM + wr * 64 + fr, col0 = u.pn * BM + wc * 32 + 4 * fq;
#pragma unroll
        for (int ai = 0; ai < 2; ++ai)
#pragma unroll
            for (int m = 0; m < 4; ++m) { const size_t off = (size_t)(row0 + ai * HALF + m * 16) * ldc + col0;
#pragma unroll
                for (int bj = 0; bj < 2; ++bj)
#pragma unroll
                    for (int n = 0; n < 2; ++n) { const f32x4 b = *(const f32x4*)(base + off + bj * HALF + n * 16); *(f32x4*)(out + off + bj * HALF + n * 16) = b + acc[ai][bj][m][n]; }
                asm volatile("" ::: "memory"); }
    }
};
struct EpiSwiglu {
    static constexpr bool PERM = true, AFTER_DRAIN = false;
    bf16_t* H; int ldc;
    __device__ __forceinline__ void operator()(const f32x4 (&acc)[2][2][4][2], const Unit& u, int wr, int wc, int fr, int fq) const {
        const int row0 = u.pm * BM + wr * 64 + fr, colh = u.pn * HALF + wc * 32 + 8 * fq;
#pragma unroll
        for (int ai = 0; ai < 2; ++ai)
#pragma unroll
            for (int m = 0; m < 4; ++m) { bf16_t* rowp = H + (size_t)(row0 + ai * HALF + m * 16) * ldc + colh;
                const f32x4 g0 = acc[ai][0][m][0], g1 = acc[ai][0][m][1], u0 = acc[ai][1][m][0], u1 = acc[ai][1][m][1];
                float h[8];
#pragma unroll
                for (int e = 0; e < 4; ++e) { h[e] = silu_f(g0[e]) * u0[e]; h[4 + e] = silu_f(g1[e]) * u1[e]; }
                u32x4 w; w.x = cvt_pk_bf16(h[0], h[1]); w.y = cvt_pk_bf16(h[2], h[3]); w.z = cvt_pk_bf16(h[4], h[5]); w.w = cvt_pk_bf16(h[6], h[7]);
                *(u32x4*)rowp = w; }
    }
};
template <int M_, int N_> struct StaticOrderC {
    static constexpr int nM = M_ / BM, nN = N_ / BM, nwg = nM * nN;
    int G, c;
    __device__ __forceinline__ void init(int G_, int c_) { G = G_; c = c_; }
    __device__ __forceinline__ bool next(int i, Unit& u) const {
        const int L = i * G + c; if (L >= nwg) return false;
        int wgid = L; { constexpr int q = nwg / NXCD, r = nwg % NXCD; const int xcd = wgid % NXCD, off = wgid / NXCD; wgid = (xcd < r ? xcd * (q + 1) : r * (q + 1) + (xcd - r) * q) + off; }
        constexpr int nig = WGM * nN; const int gid = wgid / nig, fm = gid * WGM, gsz = (nM - fm) < WGM ? (nM - fm) : WGM;
        u.pm = fm + ((wgid % nig) % gsz); u.pn = (wgid % nig) / gsz; return true;
    }
    __device__ __forceinline__ void a_ready(const Unit&) const {}
    __device__ __forceinline__ void done(const Unit&) const {}
};
template <class Epi, class Sched, bool ALIGN_EPI = false, bool SP2 = false>
__device__ __forceinline__ void gemm_phase(PG8_LAS unsigned char* lds, const Gemm g, const Sched& S, const Epi& E) {
    int tid_ = threadIdx.x; asm volatile("" : "+v"(tid_));
    float zz_ = 0.f; asm volatile("" : "+v"(zz_));
    const int tid = tid_, wid = __builtin_amdgcn_readfirstlane(tid >> 6), lane = tid & 63, wr = wid >> 2, wc = wid & 3, fr = lane & 15, fq = lane >> 4;
    const int K = g.K, nt = K / BK;
    unsigned voffA[2], voffB[2];
#pragma unroll
    for (int i = 0; i < 2; ++i) { int R, C; stage_rc(tid * 16 + i * 8192, R, C); const int Rb = Epi::PERM ? ((R & ~31) + perm32(R & 31)) : R;
        voffA[i] = (unsigned)(R * K + C) * 2u; voffB[i] = (unsigned)(Rb * K + C) * 2u; }
    const size_t kstep = (size_t)(BK * 2);
    const size_t hstep = (size_t)HALF * K * 2;
    const size_t tstep = 2 * hstep;
    const unsigned ldsw = (unsigned)wid * 1024u;
    const int aoff = lds_byte(wr * 64 + fr, fq * 8), boff = lds_byte(wc * 32 + fr, fq * 8);
#define PG8_SA(b, h) (((b) * 2 + (h)) * HTB)
#define PG8_SB(b, h) ((4 + (b) * 2 + (h)) * HTB)
#define PG8_STAGE(bufoff, gbase, voff) do { _Pragma("unroll") for (int _i = 0; _i < 2; ++_i) \
        __builtin_amdgcn_global_load_lds((const unsigned*)((const char*)(gbase) + (voff)[_i]), (PG8_LAS unsigned*)(lds + (bufoff) + ldsw + _i * 8192), 16, 0, 0); } while (0)
#define PG8_LDA(dst, b, h) do { _Pragma("unroll") for (int m = 0; m < 4; ++m) _Pragma("unroll") for (int k = 0; k < 2; ++k) dst[m][k] = *(const PG8_LAS bf16x8*)(lds + PG8_SA(b, h) + aoff + m * 2048 + k * 1024); } while (0)
#define PG8_LDB(dst, b, h) do { _Pragma("unroll") for (int n = 0; n < 2; ++n) _Pragma("unroll") for (int k = 0; k < 2; ++k) dst[n][k] = *(const PG8_LAS bf16x8*)(lds + PG8_SB(b, h) + boff + n * 2048 + k * 1024); } while (0)
#define PG8_MMA(ai, bj, At, Bt) do { __builtin_amdgcn_s_setprio(1); _Pragma("unroll") for (int m = 0; m < 4; ++m) _Pragma("unroll") for (int n = 0; n < 2; ++n) _Pragma("unroll") for (int k = 0; k < 2; ++k) \
        acc[ai][bj][m][n] = __builtin_amdgcn_mfma_f32_16x16x32_bf16(Bt[n][k], At[m][k], acc[ai][bj][m][n], 0, 0, 0); __builtin_amdgcn_s_setprio(0); } while (0)
#define PG8_WAIT_V(n) asm volatile("s_waitcnt vmcnt(" #n ")" ::: "memory")
#define PG8_WAIT_L(n) asm volatile("s_waitcnt lgkmcnt(" #n ")" ::: "memory")
#define PG8_BAR __builtin_amdgcn_s_barrier()
#define PG8_SCHED __builtin_amdgcn_sched_barrier(0)
    Unit cur, nxt; int ui = 0;
    if (!S.next(0, cur)) return;
    f32x4 acc[2][2][4][2];
#pragma unroll
    for (int a = 0; a < 2; ++a)
#pragma unroll
        for (int b = 0; b < 2; ++b)
#pragma unroll
            for (int m = 0; m < 4; ++m)
#pragma unroll
                for (int n = 0; n < 2; ++n) acc[a][b][m][n] = (f32x4){zz_, zz_, zz_, zz_};
    bf16x8 At[4][2], B0[2][2], B1[2][2];
    const char* cA = (const char*)g.A + (size_t)cur.pm * tstep; const char* cB = (const char*)g.Bt + (size_t)cur.pn * tstep;
    S.a_ready(cur);
    if constexpr (SP2) {
        PG8_STAGE(PG8_SB(0, 0), cB, voffB); PG8_STAGE(PG8_SB(0, 1), cB + hstep, voffB); PG8_STAGE(PG8_SA(0, 0), cA, voffA); PG8_STAGE(PG8_SA(0, 1), cA + hstep, voffA);
        if (wr == 1) PG8_BAR;
        PG8_WAIT_V(2); PG8_BAR;
        PG8_STAGE(PG8_SB(1, 0), cB + kstep, voffB); PG8_STAGE(PG8_SA(1, 0), cA + kstep, voffA); PG8_STAGE(PG8_SB(1, 1), cB + hstep + kstep, voffB);
        PG8_WAIT_V(6); PG8_BAR;
    } else {
        PG8_STAGE(PG8_SB(0, 0), cB, voffB); PG8_STAGE(PG8_SA(0, 0), cA, voffA); PG8_STAGE(PG8_SB(0, 1), cB + hstep, voffB); PG8_STAGE(PG8_SA(0, 1), cA + hstep, voffA);
        if (wr == 1) PG8_BAR;
        PG8_WAIT_V(4); PG8_BAR;
        PG8_STAGE(PG8_SB(1, 0), cB + kstep, voffB); PG8_STAGE(PG8_SA(1, 0), cA + kstep, voffA); PG8_STAGE(PG8_SB(1, 1), cB + hstep + kstep, voffB);
        PG8_WAIT_V(6); PG8_BAR;
    }
    for (;;) {
        const bool has_next = S.next(ui + 1, nxt);
        const char* nA = has_next ? (const char*)g.A + (size_t)nxt.pm * tstep : cA; const char* nB = has_next ? (const char*)g.Bt + (size_t)nxt.pn * tstep : cB;
        for (int t = 0; t < nt; t += 2) {
            const bool last = (t == nt - 2);
            const char* a1 = cA + (size_t)(t + 1) * kstep;
            const char* a2 = last ? nA : cA + (size_t)(t + 2) * kstep; const char* b2 = last ? nB : cB + (size_t)(t + 2) * kstep;
            const char* a3 = a2 + kstep; const char* b3 = b2 + kstep;
            if (last && has_next) S.a_ready(nxt);
            if constexpr (SP2) {
            PG8_LDB(B0, 0, 0); PG8_LDB(B1, 0, 1); PG8_SCHED; PG8_LDA(At, 0, 0); PG8_STAGE(PG8_SA(1, 1), a1 + hstep, voffA);
            PG8_WAIT_V(8); PG8_WAIT_L(0); PG8_BAR; PG8_MMA(0, 0, At, B0); PG8_MMA(0, 1, At, B1); PG8_BAR; PG8_SCHED;
            PG8_LDA(At, 0, 1); PG8_STAGE(PG8_SB(0, 0), b2, voffB); PG8_STAGE(PG8_SB(0, 1), b2 + hstep, voffB); PG8_STAGE(PG8_SA(0, 0), a2, voffA);
            PG8_WAIT_V(8); PG8_WAIT_L(0); PG8_BAR; PG8_MMA(1, 0, At, B0); PG8_MMA(1, 1, At, B1); PG8_BAR; PG8_SCHED;
            PG8_LDB(B0, 1, 0); PG8_LDB(B1, 1, 1); PG8_SCHED; PG8_LDA(At, 1, 0); PG8_STAGE(PG8_SA(0, 1), a2 + hstep, voffA);
            PG8_WAIT_V(8); PG8_WAIT_L(0); PG8_BAR; PG8_MMA(0, 0, At, B0); PG8_MMA(0, 1, At, B1); PG8_BAR; PG8_SCHED;
            PG8_LDA(At, 1, 1); PG8_STAGE(PG8_SB(1, 0), b3, voffB); PG8_STAGE(PG8_SB(1, 1), b3 + hstep, voffB); PG8_STAGE(PG8_SA(1, 0), a3, voffA);
            PG8_WAIT_V(8); PG8_WAIT_L(0); PG8_BAR; PG8_MMA(1, 0, At, B0); PG8_MMA(1, 1, At, B1); PG8_BAR; PG8_SCHED;
            } else {
            PG8_LDB(B0, 0, 0); PG8_SCHED; PG8_LDA(At, 0, 0); PG8_STAGE(PG8_SA(1, 1), a1 + hstep, voffA);
            PG8_WAIT_L(8); PG8_BAR; PG8_WAIT_L(0); PG8_MMA(0, 0, At, B0); PG8_BAR; PG8_SCHED;
            PG8_LDB(B1, 0, 1); PG8_STAGE(PG8_SB(0, 0), b2, voffB);
            PG8_BAR; PG8_WAIT_L(0); PG8_MMA(0, 1, At, B1); PG8_BAR;
            PG8_LDA(At, 0, 1); PG8_STAGE(PG8_SA(0, 0), a2, voffA);
            PG8_BAR; PG8_WAIT_L(0); PG8_MMA(1, 0, At, B0); PG8_BAR; PG8_SCHED;
            PG8_STAGE(PG8_SB(0, 1), b2 + hstep, voffB);
            PG8_WAIT_V(6); PG8_BAR; PG8_MMA(1, 1, At, B1); PG8_BAR;
            PG8_LDB(B0, 1, 0); PG8_SCHED; PG8_LDA(At, 1, 0); PG8_STAGE(PG8_SA(0, 1), a2 + hstep, voffA);
            PG8_WAIT_L(8); PG8_BAR; PG8_WAIT_L(0); PG8_MMA(0, 0, At, B0); PG8_BAR; PG8_SCHED;
            PG8_LDB(B1, 1, 1); PG8_STAGE(PG8_SB(1, 0), b3, voffB);
            PG8_BAR; PG8_WAIT_L(0); PG8_MMA(0, 1, At, B1); PG8_BAR;
            PG8_LDA(At, 1, 1); PG8_STAGE(PG8_SA(1, 0), a3, voffA);
            PG8_BAR; PG8_WAIT_L(0); PG8_MMA(1, 0, At, B0); PG8_BAR; PG8_SCHED;
            PG8_STAGE(PG8_SB(1, 1), b3 + hstep, voffB);
            PG8_WAIT_V(6); PG8_BAR; PG8_MMA(1, 1, At, B1); PG8_BAR;
            }
        }
        if constexpr (ALIGN_EPI) { if (wr == 0) PG8_BAR; }
        if constexpr (!Epi::AFTER_DRAIN) { E(acc, cur, wr, wc, fr, fq); S.done(cur); }
        if (!has_next) break;
#pragma unroll
        for (int a = 0; a < 2; ++a)
#pragma unroll
            for (int b = 0; b < 2; ++b)
#pragma unroll
                for (int m = 0; m < 4; ++m)
#pragma unroll
                    for (int n = 0; n < 2; ++n) acc[a][b][m][n] = (f32x4){zz_, zz_, zz_, zz_};
        cur = nxt; cA = nA; cB = nB; ++ui;
        if constexpr (ALIGN_EPI) { if (wr == 1) PG8_BAR; }
    }
    PG8_WAIT_V(0);
    if constexpr (!ALIGN_EPI) { if (wr == 0) PG8_BAR; }
    PG8_BAR;
    if constexpr (Epi::AFTER_DRAIN) { E.fused(acc, cur, wr, wc, fr, fq, lds, wid, lane); S.done(cur); }
#undef PG8_SA
#undef PG8_SB
#undef PG8_STAGE
#undef PG8_LDA
#undef PG8_LDB
#undef PG8_MMA
#undef PG8_WAIT_V
#undef PG8_WAIT_L
#undef PG8_BAR
#undef PG8_SCHED
}
}
#ifndef PG8_SP2
#define PG8_SP2 true
#endif
#ifndef PG8_ALIGN
#define PG8_ALIGN true
#endif
constexpr int NWAVES = 8, NTHREADS = NWAVES * 64;
constexpr int BATCH = 8, T = 4096, D = 1024, M = BATCH * T;
constexpr int NIN_E = 3840, NIN_O = 3072, FF = 2816, NGU = 2 * FF;
constexpr int PC_R = 0, PC_K = 512, PC_V = 1024, PC_GQ = 1536, PC_GK = 1792, PC_GV = 2048, PC_GG = 2560;
constexpr int PC_W1A = 3072, PC_W1B = 3136, PC_A1A = 3200, PC_A1B = 3264, PC_G1A = 3328, PC_G1B = 3488, PC_WA1 = 3648, PC_PAD = 3664;
constexpr int NLORA = 304;
constexpr size_t MiB = 1u << 20;
constexpr size_t WS_CTL = 0, CTL_ZERO_BYTES = 1 * MiB;
constexpr size_t WS_WIN = 2 * MiB, WS_WOUT = 10 * MiB, WS_WGU = 12 * MiB, WS_WDN = 23 * MiB;
constexpr size_t WS_XN = 32 * MiB;
constexpr size_t WS_P = 96 * MiB;
constexpr size_t WS_WLOG = 336 * MiB;
constexpr size_t WS_ASIG = 400 * MiB;
constexpr size_t WS_LA = 464 * MiB;
constexpr size_t WS_END = 496 * MiB;
constexpr int CW_BAR = 4096;
constexpr int RING_BYTES = 131072, LDSCTL_OFF = RING_BYTES, MISC_OFF = LDSCTL_OFF + 320, LDS_BYTES = 147456;

#define GAS __attribute__((address_space(1)))
#define LAS __attribute__((address_space(3)))
typedef unsigned short bf16;
typedef unsigned v4u __attribute__((ext_vector_type(4)));
typedef unsigned v2u __attribute__((ext_vector_type(2)));
typedef float f32x4 __attribute__((ext_vector_type(4)));
#define LDS_WAIT() asm volatile("s_waitcnt lgkmcnt(0)" ::: "memory")
#define VM_WAIT() asm volatile("s_waitcnt vmcnt(0)" ::: "memory")
__device__ __forceinline__ unsigned f2bf(float f) { unsigned u = __builtin_bit_cast(unsigned, f); return (u + 0x7fffu + ((u >> 16) & 1u)) >> 16; }
__device__ __forceinline__ unsigned pk2(float lo, float hi) { return f2bf(lo) | (f2bf(hi) << 16); }
__device__ __forceinline__ float bf2f(bf16 u) { return __builtin_bit_cast(float, (unsigned)u << 16); }
__device__ __forceinline__ float bflo(unsigned w) { return __builtin_bit_cast(float, w << 16); }
__device__ __forceinline__ float bfhi(unsigned w) { return __builtin_bit_cast(float, w & 0xffff0000u); }
__device__ __forceinline__ float wave_sum(float v) {
#pragma unroll
    for (int o = 1; o < 64; o <<= 1) v += __shfl_xor(v, o);
    return v;
}
__device__ __forceinline__ float wave_max(float v) {
#pragma unroll
    for (int o = 1; o < 64; o <<= 1) v = fmaxf(v, __shfl_xor(v, o));
    return v;
}
__device__ __forceinline__ float fexp(float x) { return __builtin_amdgcn_exp2f(x * 1.4426950408889634f); }
__device__ __forceinline__ float flog(float x) { return __builtin_amdgcn_logf(x) * 0.6931471805599453f; }
__device__ __forceinline__ float frcp(float x) { return __builtin_amdgcn_rcpf(x); }
__device__ __forceinline__ float frsq(float x) { return __builtin_amdgcn_rsqf(x); }
__device__ __forceinline__ float fsqrt(float x) { return __builtin_amdgcn_sqrtf(x); }
__device__ __forceinline__ float sigmoid_f(float x) { return frcp(1.0f + fexp(-x)); }
__device__ __forceinline__ float softplus_f(float x) { return fmaxf(x, 0.f) + flog(1.0f + fexp(-fabsf(x))); }
__device__ __forceinline__ float tanh_f(float x) { return 1.0f - 2.0f * frcp(1.0f + fexp(2.0f * x)); }
#define XB_TMO      128
#define XB_XCNT(j)  (256  + 64 * (j))
#define XB_XSUB(j)  (1280 + 64 * (j))
#define XB_XGEN(j)  (2304 + 64 * (j))
#define XB_TOP      3328
#define XB_TOPGEN   3392
#define XCD_BAR_WORDS 3456
#define XB_SPIN_CAP (1u << 23)

__device__ __forceinline__ unsigned xb_ld(unsigned* p)              { return __hip_atomic_load(p, __ATOMIC_RELAXED, __HIP_MEMORY_SCOPE_AGENT); }
__device__ __forceinline__ unsigned xb_add(unsigned* p, unsigned v) { return __hip_atomic_fetch_add(p, v, __ATOMIC_RELAXED, __HIP_MEMORY_SCOPE_AGENT); }
__device__ __forceinline__ unsigned xb_xcc_id() { return (unsigned)__builtin_amdgcn_s_getreg((3 << 11) | 20) & 0xFu; }
#define XB_SPIN(cond, bar) do { unsigned _sp = 0; while (cond) { __builtin_amdgcn_s_sleep(1); \
    if ((++_sp & 255u) == 0u) { if (xb_ld(&(bar)[XB_TMO])) break; if (_sp > XB_SPIN_CAP) { atomicAdd(&(bar)[XB_TMO], 1u); break; } } } } while (0)

struct XcdBarrier {
    unsigned* bar; unsigned x;
    volatile LAS unsigned* st;
};

__device__ __forceinline__ XcdBarrier xcd_barrier_post(unsigned* bar, volatile LAS unsigned* st) {
    XcdBarrier b; b.bar = bar; b.x = xb_xcc_id(); b.st = st;
    if (threadIdx.x == 0) (void)xb_add(&bar[XB_XCNT(b.x)], 1u);
    return b;
}
__device__ __forceinline__ void xcd_barrier_complete(unsigned* bar, unsigned x, unsigned& nloc, unsigned& nx) {
    const unsigned G = gridDim.x * gridDim.y * gridDim.z;
    unsigned sum, cnt, mine, sp = 0u;
    for (;;) {
        sum = 0u; cnt = 0u; mine = 0u;
#pragma unroll
        for (unsigned j = 0; j < 16; ++j) { const unsigned c = xb_ld(&bar[XB_XCNT(j)]); sum += c; cnt += (c > 0u) ? 1u : 0u; mine = (j == x) ? c : mine; }
        if (sum == G) break;
        __builtin_amdgcn_s_sleep(1);
        if ((++sp & 255u) == 0u) { if (xb_ld(&bar[XB_TMO])) break; if (sp > XB_SPIN_CAP) { atomicAdd(&bar[XB_TMO], 1u); break; } }
    }
    nloc = mine > 0u ? mine : 1u; nx = cnt > 0u ? cnt : 1u;
}

__device__ __forceinline__ void xcd_barrier(const XcdBarrier& b) {
    asm volatile("s_waitcnt vmcnt(0)" ::: "memory");
    __syncthreads();
    if (threadIdx.x == 0) {
        unsigned blo_ = __builtin_amdgcn_readfirstlane((unsigned)(unsigned long long)b.bar), bhi_ = __builtin_amdgcn_readfirstlane((unsigned)((unsigned long long)b.bar >> 32)), bx = __builtin_amdgcn_readfirstlane(b.x); asm volatile("" : "+s"(blo_), "+s"(bhi_), "+s"(bx)); unsigned* bar = (unsigned*)(((unsigned long long)bhi_ << 32) | blo_);
        __builtin_amdgcn_s_waitcnt(0);
        unsigned nloc = b.st[0], nx = b.st[1];
        if (nloc == 0u) { xcd_barrier_complete(bar, bx, nloc, nx); b.st[0] = nloc; b.st[1] = nx; }
        const unsigned old = xb_add(&bar[XB_XSUB(bx)], 1u);
        const unsigned gen = old / nloc;
        if (old + 1u == (gen + 1u) * nloc) {
            __builtin_amdgcn_fence(__ATOMIC_RELEASE, "agent");
            asm volatile("s_waitcnt vmcnt(0)" ::: "memory");
            const unsigned og = xb_add(&bar[XB_TOP], 1u);
            const unsigned tg = og / nx;
            if (og + 1u == (tg + 1u) * nx) xb_add(&bar[XB_TOPGEN], 1u);
            else XB_SPIN(xb_ld(&bar[XB_TOPGEN]) == tg, bar);
            __builtin_amdgcn_fence(__ATOMIC_ACQUIRE, "agent");
            xb_add(&bar[XB_XGEN(bx)], 1u);
            asm volatile("s_waitcnt vmcnt(0)" ::: "memory");
        } else {
            XB_SPIN(xb_ld(&bar[XB_XGEN(bx)]) == gen, bar);
            __builtin_amdgcn_fence(__ATOMIC_ACQUIRE, "agent");
            asm volatile("s_waitcnt vmcnt(0)" ::: "memory");
        }
    }
    __syncthreads();
}
__device__ __forceinline__ void tr_item(const float* __restrict__ W, int K, int N, bf16* WT, int dst_row0, LAS float* scr, int k0, int n0, int lane,
                                        const float* __restrict__ mu, float sc0, float sc1) {
    const int nn = n0 + (lane & 31); const bool nv = nn < N;
#pragma unroll 8
    for (int i = 0; i < 32; ++i) { const int kk = 2 * i + (lane >> 5); float v = nv ? W[(size_t)(k0 + kk) * N + nn] : 0.f; if (mu) v *= sc0 + sc1 * mu[k0 + kk]; scr[kk * 33 + (lane & 31)] = v; }
    LDS_WAIT(); asm volatile("" ::: "memory");
    const int c = lane & 7;
#pragma unroll
    for (int j = 0; j < 4; ++j) { const int n = (lane >> 3) + 8 * j; const LAS float* s = scr + (8 * c) * 33 + n;
        v4u o; o.x = pk2(s[0 * 33], s[1 * 33]); o.y = pk2(s[2 * 33], s[3 * 33]); o.z = pk2(s[4 * 33], s[5 * 33]); o.w = pk2(s[6 * 33], s[7 * 33]);
        if (n0 + n < N) *(GAS v4u*)(WT + (size_t)(dst_row0 + n) * K + k0 + 8 * c) = o; }
    LDS_WAIT(); asm volatile("" ::: "memory");
}
__device__ __forceinline__ void rms_row_bf16(const float* xrow, const float* g, bf16* orow, int lane) {
    const GAS f32x4* xr = (const GAS f32x4*)xrow + lane; const GAS f32x4* gr = (const GAS f32x4*)g + lane;
    f32x4 v[4]; float s = 0.f;
#pragma unroll
    for (int j = 0; j < 4; ++j) { v[j] = xr[64 * j]; s += (v[j].x * v[j].x + v[j].y * v[j].y) + (v[j].z * v[j].z + v[j].w * v[j].w); }
    const float rs = frsq(wave_sum(s) * (1.f / D) + 1e-6f);
    GAS v2u* o8 = (GAS v2u*)orow + lane;
#pragma unroll
    for (int j = 0; j < 4; ++j) { const f32x4 gv = gr[64 * j]; v2u o; o.x = pk2(v[j].x * rs * gv.x, v[j].y * rs * gv.y); o.y = pk2(v[j].z * rs * gv.z, v[j].w * rs * gv.w); o8[64 * j] = o; }
}
__device__ __forceinline__ void rms_row_f32(const float* xrow, const float* g, float* orow, int lane) {
    const GAS f32x4* xr = (const GAS f32x4*)xrow + lane; const GAS f32x4* gr = (const GAS f32x4*)g + lane;
    f32x4 v[4]; float s = 0.f;
#pragma unroll
    for (int j = 0; j < 4; ++j) { v[j] = xr[64 * j]; s += (v[j].x * v[j].x + v[j].y * v[j].y) + (v[j].z * v[j].z + v[j].w * v[j].w); }
    const float rs = frsq(wave_sum(s) * (1.f / D) + 1e-6f);
    GAS f32x4* o = (GAS f32x4*)orow + lane;
#pragma unroll
    for (int j = 0; j < 4; ++j) { const f32x4 gv = gr[64 * j]; o[64 * j] = v[j] * rs * gv; }
}

struct Args { const float* in[36]; float* out; unsigned char* ws; int lo, hi; };
typedef const __attribute__((address_space(4))) Args* ArgP;
#define FRESH_ARGS() ({ ArgP p_ = (ArgP)__builtin_amdgcn_kernarg_segment_ptr(); asm volatile("" : "+s"(p_)); p_; })
#define FRESH_V(x) asm volatile("" : "+v"(x))
#define FRESH_S(x) asm volatile("" : "+s"(x))

__device__ __forceinline__ void phase_convert_norm(ArgP A, int L, const float* xin, LAS unsigned char* lds, int wave, int lane, int G, int bid) {
    const int i = L >> 1; const bool even = !(L & 1);
    bf16* Win = (bf16*)(A->ws + WS_WIN); bf16* Wout = (bf16*)(A->ws + WS_WOUT); bf16* Wgu = (bf16*)(A->ws + WS_WGU); bf16* Wdn = (bf16*)(A->ws + WS_WDN);
    LAS float* scr = (LAS float*)(lds + wave * 16384);
    const int gw = bid * NWAVES + wave, NGW = G * NWAVES;
    const float* w_in = even ? A->in[5] + (size_t)i * D * 3072 : A->in[26] + (size_t)i * D * 3072;
    const float* w_out = even ? A->in[6] + (size_t)i * D * D : A->in[27] + (size_t)i * D * D;
    const float* mu_w = A->in[8] + (size_t)i * 3 * D, *mu_a = mu_w + D, *mu_g = mu_w + 2 * D;
    const float* w1 = A->in[10] + (size_t)i * D * 64, *a1 = A->in[13] + (size_t)i * D * 64, *g1 = A->in[15] + (size_t)i * D * 160, *wa1 = A->in[22] + (size_t)i * D * 16;
    const float* wg = A->in[33] + (size_t)L * D * FF, *wu = A->in[34] + (size_t)L * D * FF, *wd = A->in[35] + (size_t)L * FF * D;
    const int I_IN = 16 * 96, I_L64 = 16 * 2, I_L160 = 16 * 5, I_L16 = 16 * 1, I_OUT = 16 * 32, I_GU = 16 * 88, I_DN = 44 * 32;
    const int n_lora = even ? (4 * I_L64 + 2 * I_L160 + I_L16) : 0;
    const int NITEMS = I_IN + n_lora + I_OUT + 2 * I_GU + I_DN;
#define TR_JOB(items, nblk, Wp, Kd, Nd, DST, ROW0, MU, S0, S1) if (r < (items)) { const int kb = r / (nblk), nb = r % (nblk), n0 = 32 * nb; tr_item(Wp, Kd, Nd, DST, ROW0, scr, 64 * kb, n0, lane, MU, S0, S1); continue; } r -= (items);
    for (int it = gw; it < NITEMS; it += NGW) {
        int r = it;
        TR_JOB(I_IN, 96, w_in, D, 3072, Win, n0, nullptr, 1.f, 0.f)
        if (even) {
            TR_JOB(I_L64, 2, w1, D, 64, Win, PC_W1A + n0, mu_w, 1.f, -1.f)
            TR_JOB(I_L64, 2, w1, D, 64, Win, PC_W1B + n0, mu_w, 0.f, 1.f)
            TR_JOB(I_L64, 2, a1, D, 64, Win, PC_A1A + n0, mu_a, 1.f, -1.f)
            TR_JOB(I_L64, 2, a1, D, 64, Win, PC_A1B + n0, mu_a, 0.f, 1.f)
            TR_JOB(I_L160, 5, g1, D, 160, Win, PC_G1A + n0, mu_g, 1.f, -1.f)
            TR_JOB(I_L160, 5, g1, D, 160, Win, PC_G1B + n0, mu_g, 0.f, 1.f)
            TR_JOB(I_L16, 1, wa1, D, 16, Win, PC_WA1 + n0, nullptr, 1.f, 0.f)
        }
        TR_JOB(I_OUT, 32, w_out, D, D, Wout, n0, nullptr, 1.f, 0.f)
        TR_JOB(I_GU, 88, wg, D, FF, Wgu, 256 * (n0 >> 7) + (n0 & 127), nullptr, 1.f, 0.f)
        TR_JOB(I_GU, 88, wu, D, FF, Wgu, 256 * (n0 >> 7) + (n0 & 127) + 128, nullptr, 1.f, 0.f)
        TR_JOB(I_DN, 32, wd, FF, D, Wdn, n0, nullptr, 1.f, 0.f)
    }
#undef TR_JOB
    if (even) {
        const int gt = bid * NTHREADS + wave * 64 + lane, NT = G * NTHREADS;
        for (int e = gt; e < (NIN_E - PC_PAD) * D / 8; e += NT) ((GAS v4u*)(Win + (size_t)PC_PAD * D))[e] = (v4u){0u, 0u, 0u, 0u};
    }
    bf16* XN = (bf16*)(A->ws + WS_XN); const float* gain = A->in[2] + (size_t)L * D;
    for (int m = gw; m < M; m += NGW) rms_row_bf16(xin + (size_t)m * D, gain, XN + (size_t)m * D, lane);
}

__device__ __forceinline__ void phase_prep(ArgP A, int L, LAS unsigned char* lds, int G, int tid, int bid) {
    const int i = L >> 1;
    const bf16* P = (const bf16*)(A->ws + WS_P); float* WLOG = (float*)(A->ws + WS_WLOG); float* ASIG = (float*)(A->ws + WS_ASIG); float* LA = (float*)(A->ws + WS_LA); bf16* XN = (bf16*)(A->ws + WS_XN);
    const float* w0 = A->in[9] + i * 512, *w2 = A->in[11] + (size_t)i * 64 * 512, *a0 = A->in[12] + i * 512, *a2 = A->in[14] + (size_t)i * 64 * 512, *g2 = A->in[16] + (size_t)i * 160 * 512;
    const float* wa2 = A->in[23] + (size_t)i * 16 * 256, *ba = A->in[24] + i * 256;
    LAS float* sl = (LAS float*)lds;
    for (int item = bid; item < M / 32; item += G) {
        const int row0 = item * 32;
        for (int e = tid; e < NLORA * 32; e += NTHREADS) {
            const int tok = e / NLORA, jj = e % NLORA; const int row = row0 + tok; const bool has_prev = (row % T) != 0;
            const bf16* pr = P + (size_t)row * NIN_E; const bf16* pp = pr - NIN_E;
            float v;
            if (jj < 64) { v = bf2f(pr[PC_W1A + jj]) + (has_prev ? bf2f(pp[PC_W1B + jj]) : 0.f); v = tanh_f(v); }
            else if (jj < 128) { const int j = jj - 64; v = bf2f(pr[PC_A1A + j]) + (has_prev ? bf2f(pp[PC_A1B + j]) : 0.f); }
            else if (jj < 288) { const int j = jj - 128; v = bf2f(pr[PC_G1A + j]) + (has_prev ? bf2f(pp[PC_G1B + j]) : 0.f); v = sigmoid_f(v); }
            else { const int j = jj - 288; v = bf2f(pr[PC_WA1 + j]); }
            sl[jj * 32 + tok] = v;
        }
        __syncthreads();
        const int c = tid;
        {
            float acc[32];
#pragma unroll
            for (int t = 0; t < 32; ++t) acc[t] = 0.f;
            for (int j = 0; j < 64; ++j) { const float w = w2[j * 512 + c];
#pragma unroll
                for (int t4 = 0; t4 < 8; ++t4) { const f32x4 x = *(const LAS f32x4*)(sl + j * 32 + 4 * t4); acc[4 * t4] += x.x * w; acc[4 * t4 + 1] += x.y * w; acc[4 * t4 + 2] += x.z * w; acc[4 * t4 + 3] += x.w * w; } }
            const float b0 = w0[c]; float* op = WLOG + (size_t)row0 * 512 + c;
#pragma unroll
            for (int t = 0; t < 32; ++t) { const float x = b0 + acc[t]; const float wraw = -softplus_f(-x) - 0.5f; *op = -fexp(wraw); op += 512; FRESH_V(op); }
        }
        {
            float acc[32];
#pragma unroll
            for (int t = 0; t < 32; ++t) acc[t] = 0.f;
            for (int j = 0; j < 64; ++j) { const float w = a2[j * 512 + c];
#pragma unroll
                for (int t4 = 0; t4 < 8; ++t4) { const f32x4 x = *(const LAS f32x4*)(sl + (64 + j) * 32 + 4 * t4); acc[4 * t4] += x.x * w; acc[4 * t4 + 1] += x.y * w; acc[4 * t4 + 2] += x.z * w; acc[4 * t4 + 3] += x.w * w; } }
            const float b0 = a0[c]; float* op = ASIG + (size_t)row0 * 512 + c;
#pragma unroll
            for (int t = 0; t < 32; ++t) { *op = sigmoid_f(b0 + acc[t]); op += 512; FRESH_V(op); }
        }
        {
            float acc[32];
#pragma unroll
            for (int t = 0; t < 32; ++t) acc[t] = 0.f;
            for (int j = 0; j < 160; ++j) { const float w = g2[j * 512 + c];
#pragma unroll
                for (int t4 = 0; t4 < 8; ++t4) { const f32x4 x = *(const LAS f32x4*)(sl + (128 + j) * 32 + 4 * t4); acc[4 * t4] += x.x * w; acc[4 * t4 + 1] += x.y * w; acc[4 * t4 + 2] += x.z * w; acc[4 * t4 + 3] += x.w * w; } }
            bf16* op = XN + (size_t)row0 * D + c;
#pragma unroll
            for (int t = 0; t < 32; ++t) { *op = (bf16)f2bf(acc[t]); op += D; FRESH_V(op); }
        }
        if (c < 256) {
            float acc[32];
#pragma unroll
            for (int t = 0; t < 32; ++t) acc[t] = 0.f;
            for (int j = 0; j < 16; ++j) { const float w = wa2[j * 256 + c];
#pragma unroll
                for (int t4 = 0; t4 < 8; ++t4) { const f32x4 x = *(const LAS f32x4*)(sl + (288 + j) * 32 + 4 * t4); acc[4 * t4] += x.x * w; acc[4 * t4 + 1] += x.y * w; acc[4 * t4 + 2] += x.z * w; acc[4 * t4 + 3] += x.w * w; } }
            const float b0 = ba[c]; float* op = LA + (size_t)row0 * 256 + c;
#pragma unroll
            for (int t = 0; t < 32; ++t) { *op = -softplus_f(-(b0 + acc[t])) * (1.0f / 16.0f); op += 256; FRESH_V(op); }
        }
        __syncthreads();
    }
}

__device__ __noinline__ void rwkv_scan_seq(ArgP A, int L, int b, int h, LAS float* sc, int lane) {
    const int i = L >> 1, c = h * 64 + lane;
    const bf16* P = (const bf16*)(A->ws + WS_P); const float* WLOG = (const float*)(A->ws + WS_WLOG); const float* ASIG = (const float*)(A->ws + WS_ASIG); bf16* OAB = (bf16*)(A->ws + WS_XN);
    const float* mu = A->in[7] + (size_t)i * 1536;
    const float mur = mu[c], muk = mu[512 + c], muv = mu[1024 + c];
    const float kkc = A->in[17][i * 512 + c], kac = A->in[18][i * 512 + c], rkc = A->in[19][i * 512 + c], lnw = A->in[20][i * 512 + c], lnb = A->in[21][i * 512 + c];
    float S[64];
#pragma unroll
    for (int k = 0; k < 64; ++k) S[k] = 0.f;
    float pr_prev = 0.f, pk_prev = 0.f, pv_prev = 0.f;
    const size_t row0 = (size_t)b * T;
    float npr = bf2f(P[row0 * NIN_E + PC_R + c]), npk = bf2f(P[row0 * NIN_E + PC_K + c]), npv = bf2f(P[row0 * NIN_E + PC_V + c]);
    float nwl = WLOG[row0 * 512 + c], nas = ASIG[row0 * 512 + c], ng = bf2f(OAB[row0 * D + c]);
#pragma unroll 1
    for (int t = 0; t < T; ++t) {
        const float pr = npr, pk = npk, pv = npv, wl = nwl, as = nas, g = ng;
        if (t + 1 < T) { const size_t rw = row0 + t + 1; npr = bf2f(P[rw * NIN_E + PC_R + c]); npk = bf2f(P[rw * NIN_E + PC_K + c]); npv = bf2f(P[rw * NIN_E + PC_V + c]);
            nwl = WLOG[rw * 512 + c]; nas = ASIG[rw * 512 + c]; ng = bf2f(OAB[rw * D + c]); }
        const float r = pr + (pr_prev - pr) * mur, k = pk + (pk_prev - pk) * muk, v = pv + (pv_prev - pv) * muv;
        pr_prev = pr; pk_prev = pk; pv_prev = pv;
        float kk = k * kkc; const float n2 = wave_sum(kk * kk); kk = kk * frcp(fmaxf(fsqrt(n2), 1e-12f));
        const float kmod = k * (1.f + (as - 1.f) * kac);
        sc[lane] = -kk; sc[64 + lane] = fexp(wl); sc[128 + lane] = kk * as; sc[192 + lane] = kmod; sc[256 + lane] = r;
        LDS_WAIT(); asm volatile("" ::: "memory");
        float sa = 0.f;
#pragma unroll
        for (int k4 = 0; k4 < 16; ++k4) { const f32x4 a4 = *(const LAS f32x4*)(sc + 4 * k4); sa += S[4 * k4] * a4.x; sa += S[4 * k4 + 1] * a4.y; sa += S[4 * k4 + 2] * a4.z; sa += S[4 * k4 + 3] * a4.w; }
        float y = 0.f;
#pragma unroll
        for (int k4 = 0; k4 < 16; ++k4) {
            const f32x4 w4 = *(const LAS f32x4*)(sc + 64 + 4 * k4), b4 = *(const LAS f32x4*)(sc + 128 + 4 * k4), kq = *(const LAS f32x4*)(sc + 192 + 4 * k4), r4 = *(const LAS f32x4*)(sc + 256 + 4 * k4);
            S[4 * k4] = S[4 * k4] * w4.x + sa * b4.x + v * kq.x; y += S[4 * k4] * r4.x;
            S[4 * k4 + 1] = S[4 * k4 + 1] * w4.y + sa * b4.y + v * kq.y; y += S[4 * k4 + 1] * r4.y;
            S[4 * k4 + 2] = S[4 * k4 + 2] * w4.z + sa * b4.z + v * kq.z; y += S[4 * k4 + 2] * r4.z;
            S[4 * k4 + 3] = S[4 * k4 + 3] * w4.w + sa * b4.w + v * kq.w; y += S[4 * k4 + 3] * r4.w;
        }
        asm volatile("" ::: "memory");
        const float bonus = wave_sum(r * kmod * rkc);
        const float mean = wave_sum(y) * (1.f / 64.f); const float d = y - mean; const float var = wave_sum(d * d) * (1.f / 64.f);
        float o = d * frsq(var + 64e-5f) * lnw + lnb;
        o = (o + bonus * v) * g;
        OAB[(row0 + t) * D + c] = (bf16)f2bf(o);
    }
}
__device__ __noinline__ void gla_scan_half(ArgP A, int b, int h, int half, LAS float* sc, int lane) {
    const bf16* P = (const bf16*)(A->ws + WS_P); const float* LA = (const float*)(A->ws + WS_LA); bf16* OAB = (bf16*)(A->ws + WS_XN);
    float S0[64];
#pragma unroll
    for (int k = 0; k < 64; ++k) S0[k] = 0.f;
    const size_t row0 = (size_t)b * T;
#pragma unroll 1
    for (int t = 0; t < T; ++t) {
        const size_t rw = row0 + t; const bf16* pr = P + rw * NIN_E;
        const float q = bf2f(pr[PC_GQ + h * 64 + lane]) * 0.125f, kx = bf2f(pr[PC_GK + h * 64 + lane]), la = LA[rw * 256 + h * 64 + lane];
        const float v0 = bf2f(pr[PC_GV + h * 128 + half * 64 + lane]);
        sc[lane] = fexp(la); sc[64 + lane] = kx; sc[128 + lane] = q;
        LDS_WAIT(); asm volatile("" ::: "memory");
        float o0 = 0.f;
#pragma unroll
        for (int k4 = 0; k4 < 16; ++k4) {
            const f32x4 a4 = *(const LAS f32x4*)(sc + 4 * k4), k4v = *(const LAS f32x4*)(sc + 64 + 4 * k4), q4 = *(const LAS f32x4*)(sc + 128 + 4 * k4);
            S0[4 * k4] = S0[4 * k4] * a4.x + k4v.x * v0; o0 += q4.x * S0[4 * k4];
            S0[4 * k4 + 1] = S0[4 * k4 + 1] * a4.y + k4v.y * v0; o0 += q4.y * S0[4 * k4 + 1];
            S0[4 * k4 + 2] = S0[4 * k4 + 2] * a4.z + k4v.z * v0; o0 += q4.z * S0[4 * k4 + 2];
            S0[4 * k4 + 3] = S0[4 * k4 + 3] * a4.w + k4v.w * v0; o0 += q4.w * S0[4 * k4 + 3];
        }
        asm volatile("" ::: "memory");
        OAB[rw * D + 512 + h * 128 + half * 64 + lane] = (bf16)f2bf(o0);
    }
}
__device__ __noinline__ void gla_norm_rows(ArgP A, int L, int b, int h, int wave, int lane) {
    const int i = L >> 1;
    const bf16* P = (const bf16*)(A->ws + WS_P); bf16* OAB = (bf16*)(A->ws + WS_XN);
    const float gn0 = A->in[25][i * 512 + h * 128 + 2 * lane], gn1 = A->in[25][i * 512 + h * 128 + 2 * lane + 1];
    for (int t = wave; t < T; t += NWAVES) {
        const size_t rw = (size_t)b * T + t;
        GAS unsigned* op = (GAS unsigned*)(OAB + rw * D + 512 + h * 128 + 2 * lane);
        const unsigned ov = *op, gv = *(const GAS unsigned*)(P + rw * NIN_E + PC_GG + h * 128 + 2 * lane);
        const float o0 = bflo(ov), o1 = bfhi(ov);
        const float rs = frsq(wave_sum(o0 * o0 + o1 * o1) * (1.f / 128.f) + 1e-5f);
        *op = pk2(o0 * rs * gn0 * silu_f(bflo(gv)), o1 * rs * gn1 * silu_f(bfhi(gv)));
    }
}

__device__ __forceinline__ int t5_bucket(int d) {
    if (d < 16) return d;
    const float r = (float)d / 16.0f; int l = 16 + (int)(flog(r) / 2.0794415416798357f * 16.0f);
    return l < 31 ? l : 31;
}
__device__ __noinline__ void attn_row_simple(ArgP A, int L, int b, int h, int t, float lam, float lam_init, LAS float* qs  , LAS float* bd  , int lane) {
    const int i = L >> 1;
    const bf16* QKV = (const bf16*)(A->ws + WS_P); bf16* O = (bf16*)(A->ws + WS_XN);
    const bf16* qrow = QKV + (size_t)(b * T + t) * NIN_O + h * 128;
    qs[lane] = bf2f(qrow[lane]) * 0.125f; qs[64 + lane] = bf2f(qrow[64 + lane]) * 0.125f;
    bd[lane] = A->in[1][t5_bucket(lane) * 8 + h]; bd[64 + lane] = A->in[1][t5_bucket(64 + lane) * 8 + h];
    LDS_WAIT(); asm volatile("" ::: "memory");
    float m1 = -1e30f, m2 = -1e30f, l1 = 0.f, l2 = 0.f, o1a = 0.f, o1b = 0.f, o2a = 0.f, o2b = 0.f;
#pragma unroll 1
    for (int j0 = 0; j0 <= t; j0 += 64) {
        const int j = j0 + lane; const bool valid = j <= t;
        const bf16* krow = QKV + (size_t)(b * T + j) * NIN_O + 1024 + h * 128;
        float s1 = 0.f, s2 = 0.f;
#pragma unroll 2
        for (int c8 = 0; c8 < 8; ++c8) { const v4u kv = *(const GAS v4u*)(krow + 8 * c8); const f32x4 qa = *(const LAS f32x4*)(qs + 8 * c8), qb = *(const LAS f32x4*)(qs + 8 * c8 + 4);
            s1 += qa.x * bflo(kv.x) + qa.y * bfhi(kv.x) + qa.z * bflo(kv.y) + qa.w * bfhi(kv.y) + qb.x * bflo(kv.z) + qb.y * bfhi(kv.z) + qb.z * bflo(kv.w) + qb.w * bfhi(kv.w); }
#pragma unroll 2
        for (int c8 = 0; c8 < 8; ++c8) { const v4u kv = *(const GAS v4u*)(krow + 64 + 8 * c8); const f32x4 qa = *(const LAS f32x4*)(qs + 64 + 8 * c8), qb = *(const LAS f32x4*)(qs + 64 + 8 * c8 + 4);
            s2 += qa.x * bflo(kv.x) + qa.y * bfhi(kv.x) + qa.z * bflo(kv.y) + qa.w * bfhi(kv.y) + qb.x * bflo(kv.z) + qb.y * bfhi(kv.z) + qb.z * bflo(kv.w) + qb.w * bfhi(kv.w); }
        const int dist = valid ? (t - j) : 0; const float bias = bd[dist < 127 ? dist : 127];
        s1 = valid ? s1 + bias : -1e30f; s2 = valid ? s2 + bias : -1e30f;
        const float mn1 = fmaxf(m1, wave_max(s1)), mn2 = fmaxf(m2, wave_max(s2));
        const float c1 = fexp(m1 - mn1), c2 = fexp(m2 - mn2);
        const float p1 = valid ? fexp(s1 - mn1) : 0.f, p2 = valid ? fexp(s2 - mn2) : 0.f;
        l1 = l1 * c1 + wave_sum(p1); l2 = l2 * c2 + wave_sum(p2); m1 = mn1; m2 = mn2;
        o1a *= c1; o1b *= c1; o2a *= c2; o2b *= c2;
        const bf16* vbase = QKV + (size_t)(b * T + j0) * NIN_O + 2048 + h * 128 + 2 * lane;
#pragma unroll 4
        for (int jj = 0; jj < 64; ++jj) {
            const float pj1 = __builtin_bit_cast(float, __builtin_amdgcn_readlane(__builtin_bit_cast(int, p1), jj)), pj2 = __builtin_bit_cast(float, __builtin_amdgcn_readlane(__builtin_bit_cast(int, p2), jj));
            const unsigned vv = *(const GAS unsigned*)(vbase + (size_t)jj * NIN_O); const float v0 = bflo(vv), v1 = bfhi(vv);
            o1a += pj1 * v0; o1b += pj1 * v1; o2a += pj2 * v0; o2b += pj2 * v1;
        }
    }
    const float il1 = frcp(l1), il2 = frcp(l2); float oa = o1a * il1 - lam * (o2a * il2), ob = o1b * il1 - lam * (o2b * il2);
    const float ms = wave_sum(oa * oa + ob * ob) * (1.f / 128.f); const float rs = frsq(ms + 1e-5f);
    const float sc = 1.0f - lam_init; const float* sl = A->in[32] + i * 128;
    oa = oa * rs * sl[2 * lane] * sc; ob = ob * rs * sl[2 * lane + 1] * sc;
    *(GAS unsigned*)(O + (size_t)(b * T + t) * D + h * 128 + 2 * lane) = pk2(oa, ob);
}
typedef short a_bf16x8 __attribute__((ext_vector_type(8)));
typedef float f32x16 __attribute__((ext_vector_type(16)));
typedef short a_s16x4 __attribute__((ext_vector_type(4)));
constexpr int AT_SK = 144, AT_SV = 320, AT_K1 = 0, AT_K2 = 64 * AT_SK, AT_V = 2 * 64 * AT_SK, AT_ST = AT_V + 64 * AT_SV, AT_BIAS = 2 * AT_ST, AT_COMB = 0;
static_assert(AT_BIAS + 132 * 4 <= RING_BYTES && 4 * 64 * 64 * 4 <= AT_BIAS, "attention LDS map");
__device__ __forceinline__ int crow16(int r, int hi) { return (r & 3) + 8 * (r >> 2) + 4 * hi; }
__device__ __forceinline__ unsigned cvtpk(float lo, float hi) { unsigned r; asm("v_cvt_pk_bf16_f32 %0, %1, %2" : "=v"(r) : "v"(lo), "v"(hi)); return r; }

__device__ __forceinline__ void attn_unit_mfma(ArgP A, int L, int b, int h, int qb, float lam, float lam_init, LAS unsigned char* lds, int tid) {
    const int lane = tid & 63, wave = __builtin_amdgcn_readfirstlane(tid >> 6), r32 = lane & 31, hi = lane >> 5;
    const int smap = wave >> 2, qs = wave & 3;
    const int i = L >> 1;
    const bf16* QKV = (const bf16*)(A->ws + WS_P); bf16* O = (bf16*)(A->ws + WS_XN);
    const int q0 = qb * 128, qw0 = q0 + 32 * qs, nt = (q0 + 128) / 64;
    const size_t rowb = (size_t)b * T;
    if (tid < 129) { const float far = A->in[1][31 * 8 + h]; ((LAS float*)(lds + AT_BIAS))[tid] = tid < 128 ? (A->in[1][t5_bucket(tid) * 8 + h] - far) * 1.4426950408889634f : 0.f; }
    a_bf16x8 qf[4];
    { const bf16* qrow = QKV + (rowb + qw0 + r32) * NIN_O + h * 128 + smap * 64 + 8 * hi;
#pragma unroll
      for (int ks = 0; ks < 4; ++ks) qf[ks] = *(const GAS a_bf16x8*)(qrow + 16 * ks); }
    const int kr = tid >> 3, kc = tid & 7, vr0 = tid >> 4, vc = tid & 15;
    const bf16* kg = QKV + (rowb + kr) * NIN_O + 1024 + h * 128 + 8 * kc;
    const bf16* vg = QKV + (rowb + vr0) * NIN_O + 2048 + h * 128 + 8 * vc;
    const int kw = kr * AT_SK + kc * 16, vw = vr0 * AT_SV + vc * 16;
    v4u sk1, sk2, sv0, sv1;
#define AT_LOAD(kt) do { const size_t go_ = (size_t)(kt) * 64 * NIN_O; sk1 = *(const GAS v4u*)(kg + go_); sk2 = *(const GAS v4u*)(kg + go_ + 64); sv0 = *(const GAS v4u*)(vg + go_); sv1 = *(const GAS v4u*)(vg + go_ + (size_t)32 * NIN_O); } while (0)
#define AT_STORE(st) do { LAS unsigned char* sb_ = lds + (st) * AT_ST; *(LAS v4u*)(sb_ + AT_K1 + kw) = sk1; *(LAS v4u*)(sb_ + AT_K2 + kw) = sk2; *(LAS v4u*)(sb_ + AT_V + vw) = sv0; *(LAS v4u*)(sb_ + AT_V + vw + 32 * AT_SV) = sv1; } while (0)
    AT_LOAD(0); AT_STORE(0);
    __syncthreads();
    f32x16 o[4];
#pragma unroll
    for (int d = 0; d < 4; ++d)
#pragma unroll
        for (int r = 0; r < 16; ++r) o[d][r] = 0.f;
    float m = -1e30f, l = 0.f;
    const int kfo = (smap ? AT_K2 : AT_K1) + r32 * AT_SK + 16 * hi;
    const int vfo = AT_V + (4 * hi + ((lane & 15) >> 2)) * AT_SV + (16 * ((lane >> 4) & 1) + 4 * (lane & 3)) * 2;
    const LAS float* bdl = (const LAS float*)(lds + AT_BIAS);
    const int qme = qw0 + r32;
#pragma unroll 1
    for (int kt = 0; kt < nt; ++kt) {
        if (kt + 1 < nt) AT_LOAD(kt + 1);
        const int key0 = 64 * kt;
        if (key0 <= qw0 + 31) {
            const LAS unsigned char* sb = lds + (kt & 1) * AT_ST;
            f32x16 p[2];
#pragma unroll
            for (int blk = 0; blk < 2; ++blk) {
#pragma unroll
                for (int r = 0; r < 16; ++r) p[blk][r] = 0.f;
#pragma unroll
                for (int ks = 0; ks < 4; ++ks) { const a_bf16x8 kf = *(const LAS a_bf16x8*)(sb + kfo + blk * 32 * AT_SK + ks * 32); p[blk] = __builtin_amdgcn_mfma_f32_32x32x16_bf16(kf, qf[ks], p[blk], 0, 0, 0); }
            }
            if (key0 + 63 + 128 > qw0) {
#pragma unroll
                for (int blk = 0; blk < 2; ++blk)
#pragma unroll
                    for (int r = 0; r < 16; ++r) { const int dist = qme - (key0 + 32 * blk + crow16(r, hi)); const float bv = bdl[dist < 0 ? 128 : (dist < 128 ? dist : 128)]; p[blk][r] = dist < 0 ? -1e30f : p[blk][r] + bv; }
            }
            float mx = p[0][0];
#pragma unroll
            for (int r = 1; r < 16; ++r) mx = fmaxf(mx, p[0][r]);
#pragma unroll
            for (int r = 0; r < 16; ++r) mx = fmaxf(mx, p[1][r]);
            mx = fmaxf(mx, __shfl_xor(mx, 32));
            if (__any(mx > m + 8.0f)) {
                const float mn = fmaxf(m, mx), al = __builtin_amdgcn_exp2f(m - mn); m = mn; l *= al;
#pragma unroll
                for (int d = 0; d < 4; ++d)
#pragma unroll
                    for (int r = 0; r < 16; ++r) o[d][r] *= al;
            }
            float ls = 0.f;
#pragma unroll
            for (int blk = 0; blk < 2; ++blk)
#pragma unroll
                for (int r = 0; r < 16; ++r) { const float e = __builtin_amdgcn_exp2f(p[blk][r] - m); p[blk][r] = e; ls += e; }
            l += ls;
            a_bf16x8 pf[4];
#pragma unroll
            for (int kk = 0; kk < 4; ++kk) { const int blk = kk >> 1, s8 = 8 * (kk & 1); v4u w; w.x = cvtpk(p[blk][s8], p[blk][s8 + 1]); w.y = cvtpk(p[blk][s8 + 2], p[blk][s8 + 3]); w.z = cvtpk(p[blk][s8 + 4], p[blk][s8 + 5]); w.w = cvtpk(p[blk][s8 + 6], p[blk][s8 + 7]); pf[kk] = __builtin_bit_cast(a_bf16x8, w); }
#pragma unroll
            for (int kk = 0; kk < 4; ++kk)
#pragma unroll
                for (int d = 0; d < 4; ++d) {
                    const LAS unsigned char* vp = sb + vfo + kk * 16 * AT_SV + d * 64;
                    const a_s16x4 lo4 = __builtin_bit_cast(a_s16x4, __builtin_amdgcn_ds_read_tr16_b64_v4i16((LAS a_s16x4*)vp));
                    const a_s16x4 hi4 = __builtin_bit_cast(a_s16x4, __builtin_amdgcn_ds_read_tr16_b64_v4i16((LAS a_s16x4*)(vp + 8 * AT_SV)));
                    const a_bf16x8 vf = (a_bf16x8){lo4[0], lo4[1], lo4[2], lo4[3], hi4[0], hi4[1], hi4[2], hi4[3]};
                    o[d] = __builtin_amdgcn_mfma_f32_32x32x16_bf16(vf, pf[kk], o[d], 0, 0, 0);
                }
        }
        if (kt + 1 < nt) AT_STORE((kt + 1) & 1);
        __syncthreads();
    }
#undef AT_LOAD
#undef AT_STORE
    l += __shfl_xor(l, 32);
    LAS float* comb = (LAS float*)(lds + AT_COMB) + qs * 4096;
    if (smap == 1) { const float sc = lam * frcp(l);
#pragma unroll
        for (int d = 0; d < 4; ++d)
#pragma unroll
            for (int r = 0; r < 16; ++r) comb[(d * 16 + r) * 64 + lane] = o[d][r] * sc; }
    __syncthreads();
    if (smap == 0) {
        const float il = frcp(l); float ss = 0.f;
#pragma unroll
        for (int d = 0; d < 4; ++d)
#pragma unroll
            for (int r = 0; r < 16; ++r) { const float v = o[d][r] * il - comb[(d * 16 + r) * 64 + lane]; o[d][r] = v; ss += v * v; }
        ss += __shfl_xor(ss, 32);
        const float rs = frsq(ss * (1.f / 128.f) + 1e-5f) * (1.0f - lam_init);
        const float* sl = A->in[32] + i * 128;
        bf16* orow = O + (rowb + qw0 + r32) * D + h * 128;
#pragma unroll
        for (int d = 0; d < 4; ++d)
#pragma unroll
            for (int g4 = 0; g4 < 4; ++g4) { const int dc = 32 * d + 8 * g4 + 4 * hi; const f32x4 s4 = *(const GAS f32x4*)(sl + dc);
                v2u w; w.x = cvtpk(o[d][4 * g4] * rs * s4.x, o[d][4 * g4 + 1] * rs * s4.y); w.y = cvtpk(o[d][4 * g4 + 2] * rs * s4.z, o[d][4 * g4 + 3] * rs * s4.w);
                *(GAS v2u*)(orow + dc) = w; }
    }
    __syncthreads();
}

__device__ __forceinline__ void attn_phase_mfma(ArgP A, int L, LAS unsigned char* lds, int tid, int G, int bid) {
    const int lane = tid & 63, i = L >> 1;
    const float lam_init = 0.8f - 0.6f * fexp(-0.3f * (float)L);
    const float lam = fexp(wave_sum(A->in[28][i * 64 + lane] * A->in[29][i * 64 + lane])) - fexp(wave_sum(A->in[30][i * 64 + lane] * A->in[31][i * 64 + lane])) + lam_init;
    if (G == 256) {
        const int v = (bid & 7) * 32 + (bid >> 3), bh = v >> 2, j = v & 3;
#pragma unroll 1
        for (int u = 0; u < 8; ++u) { const int qb = 8 * (u >> 1) + ((u & 1) ? 7 - j : j); attn_unit_mfma(A, L, bh >> 3, bh & 7, qb, lam, lam_init, lds, tid); }
    } else {
#pragma unroll 1
        for (int u = bid; u < 64 * 32; u += G) attn_unit_mfma(A, L, (u >> 5) >> 3, (u >> 5) & 7, 31 - (u & 31), lam, lam_init, lds, tid);
    }
}
constexpr int N_STEPS = 33;
#ifndef MK_ONE_LAUNCH
#define MK_ONE_LAUNCH 1
#endif
__global__ void __launch_bounds__(NTHREADS, 2) hybrid_fwd(Args args) {
    extern __shared__ __attribute__((aligned(16))) unsigned char lds_raw[];
    LAS unsigned char* lds = (LAS unsigned char*)lds_raw;
    ArgP A0 = (ArgP)__builtin_amdgcn_kernarg_segment_ptr();
    { const int tid = threadIdx.x; for (int u = tid; u < (LDS_BYTES - LDSCTL_OFF) / 4; u += NTHREADS) ((LAS unsigned*)(lds + LDSCTL_OFF))[u] = 0u; }
    __syncthreads();
    const int lo = A0->lo, hi = A0->hi;
    if (hi - lo > 1) (void)xcd_barrier_post((unsigned*)(A0->ws + WS_CTL) + CW_BAR, (volatile LAS unsigned*)(lds + MISC_OFF) + 8);
#ifndef PHM
#define PHM 0xff
#endif
#define RUN(s) (lo <= (s) && (s) < hi)
#define EN(b) ((PHM >> (b)) & 1)
#define GRID_BARRIER() do { ArgP Ab_ = FRESH_ARGS(); XcdBarrier b_; b_.bar = (unsigned*)(Ab_->ws + WS_CTL) + CW_BAR; b_.x = xb_xcc_id(); b_.st = (volatile LAS unsigned*)(lds + MISC_OFF) + 8; xcd_barrier(b_); } while (0)
#define SEAM(s) do { if (RUN(s) && RUN((s) + 1)) GRID_BARRIER(); } while (0)
#define PHASE_VARS() ArgP A = FRESH_ARGS(); int L = Lq; FRESH_S(L); int tid = threadIdx.x; FRESH_V(tid); const int lane = tid & 63, wave = __builtin_amdgcn_readfirstlane(tid >> 6); int G = gridDim.x, bid = blockIdx.x; FRESH_S(G); FRESH_S(bid); (void)lane; (void)wave; (void)G; (void)A; (void)bid; \
    bf16* XN = (bf16*)(A->ws + WS_XN); bf16* PB = (bf16*)(A->ws + WS_P); (void)XN; (void)PB

    for (int Lq = 0; Lq < 4; ++Lq) {
        const int s0 = 8 * Lq; const bool even = !(Lq & 1);
        if (EN(0) && RUN(s0 + 0)) { PHASE_VARS(); const float* xin = (L == 0) ? A->in[0] : A->out; phase_convert_norm(A, L, xin, lds, wave, lane, G, bid); }
        SEAM(s0 + 0);
        if (EN(1) && RUN(s0 + 1)) {
            PHASE_VARS(); bf16* Win = (bf16*)(A->ws + WS_WIN);
            if (even) {
                pg8::Gemm g{XN, Win, M, NIN_E, D}; pg8::StaticOrderC<M, NIN_E> S; S.init(G, bid);
                pg8::EpiStoreBf16 E{PB, NIN_E, 0, 1.0f};
                pg8::gemm_phase<pg8::EpiStoreBf16, pg8::StaticOrderC<M, NIN_E>, PG8_ALIGN, PG8_SP2>(lds, g, S, E);
            } else {
                pg8::Gemm g{XN, Win, M, NIN_O, D}; pg8::StaticOrderC<M, NIN_O> S; S.init(G, bid);
                pg8::EpiStoreBf16 E{PB, NIN_O, 4, 0.125f * 1.4426950408889634f};
                pg8::gemm_phase<pg8::EpiStoreBf16, pg8::StaticOrderC<M, NIN_O>, PG8_ALIGN, PG8_SP2>(lds, g, S, E);
            }
        }
        SEAM(s0 + 1);
        if (even) {
            if (EN(2) && RUN(s0 + 2)) { PHASE_VARS(); phase_prep(A, L, lds, G, tid, bid); }
            SEAM(s0 + 2);
            if (EN(3) && RUN(s0 + 3)) {
                PHASE_VARS();
                const int task = bid;
                if (task < 64) { if (wave == 0) rwkv_scan_seq(A, L, task >> 3, task & 7, (LAS float*)lds, lane); }
                else if (task < 96) { if (wave < 2) gla_scan_half(A, (task - 64) >> 2, (task - 64) & 3, wave, (LAS float*)lds + wave * 192, lane); }
                __syncthreads();
                if (task >= 64 && task < 96) gla_norm_rows(A, L, (task - 64) >> 2, (task - 64) & 3, wave, lane);
            }
        } else {
            if (EN(4) && RUN(s0 + 3)) { PHASE_VARS(); attn_phase_mfma(A, L, lds, tid, G, bid); }
        }
        if (RUN(s0 + 3) && RUN(s0 + 4)) GRID_BARRIER();
        if (EN(5) && RUN(s0 + 4)) {
            PHASE_VARS(); bf16* Wout = (bf16*)(A->ws + WS_WOUT); const float* xin = (L == 0) ? A->in[0] : A->out;
            pg8::Gemm g{XN, Wout, M, D, D}; pg8::StaticOrderC<M, D> S; S.init(G, bid);
            pg8::EpiResF32 E{xin, A->out, D};
            pg8::gemm_phase<pg8::EpiResF32, pg8::StaticOrderC<M, D>, PG8_ALIGN, PG8_SP2>(lds, g, S, E);
        }
        SEAM(s0 + 4);
        if (RUN(s0 + 5)) {
            PHASE_VARS();
            const int gw = bid * NWAVES + wave, NGW = G * NWAVES; const float* gain = A->in[3] + (size_t)L * D;
            for (int m = gw; m < M; m += NGW) rms_row_bf16(A->out + (size_t)m * D, gain, XN + (size_t)m * D, lane);
        }
        SEAM(s0 + 5);
        if (EN(6) && RUN(s0 + 6)) {
            PHASE_VARS(); bf16* Wgu = (bf16*)(A->ws + WS_WGU);
            pg8::Gemm g{XN, Wgu, M, NGU, D}; pg8::StaticOrderC<M, NGU> S; S.init(G, bid);
            pg8::EpiSwiglu E{PB, FF};
            pg8::gemm_phase<pg8::EpiSwiglu, pg8::StaticOrderC<M, NGU>, PG8_ALIGN, PG8_SP2>(lds, g, S, E);
        }
        SEAM(s0 + 6);
        if (EN(7) && RUN(s0 + 7)) {
            PHASE_VARS(); bf16* Wdn = (bf16*)(A->ws + WS_WDN);
            pg8::Gemm g{PB, Wdn, M, D, FF}; pg8::StaticOrderC<M, D> S; S.init(G, bid);
            pg8::EpiResF32 E{A->out, A->out, D};
            pg8::gemm_phase<pg8::EpiResF32, pg8::StaticOrderC<M, D>, PG8_ALIGN, PG8_SP2>(lds, g, S, E);
        }
        SEAM(s0 + 7);
    }
    if (RUN(32)) {
        int Lq = 0; PHASE_VARS();
        const int gw = bid * NWAVES + wave, NGW = G * NWAVES;
        for (int m = gw; m < M; m += NGW) rms_row_f32(A->out + (size_t)m * D, A->in[4], A->out + (size_t)m * D, lane);
    }
#undef RUN
#undef SEAM
}

extern "C" void kernel_launch(void* const* d_in, const int* in_sizes, int n_in, void* d_out, int out_size, void* d_ws, size_t ws_size, hipStream_t stream) {
    static int grid = 0;
    if (grid == 0) {
        if (n_in != 36 || in_sizes[0] != M * D || out_size != M * D || ws_size < WS_END) { fprintf(stderr, "kernel_launch: unexpected shapes (n_in %d, in0 %d, out %d, ws %zu); nothing launched\n", n_in, n_in > 0 ? in_sizes[0] : -1, out_size, ws_size); grid = -1; return; }
        int dev = 0, cus = 0, per_cu = 0;
        if (hipGetDevice(&dev) != hipSuccess || hipDeviceGetAttribute(&cus, hipDeviceAttributeMultiprocessorCount, dev) != hipSuccess) { grid = -1; return; }
        if (hipFuncSetAttribute((const void*)hybrid_fwd, hipFuncAttributeMaxDynamicSharedMemorySize, LDS_BYTES) != hipSuccess) { fprintf(stderr, "kernel_launch: hipFuncSetAttribute failed\n"); grid = -1; return; }
        if (hipOccupancyMaxActiveBlocksPerMultiprocessor(&per_cu, (const void*)hybrid_fwd, NTHREADS, LDS_BYTES) != hipSuccess || per_cu < 1) fprintf(stderr, "kernel_launch: occupancy query reports %d\n", per_cu);
        (void)hipGetLastError();
        grid = cus;
    }
    if (grid < 0) return;
    if (hipMemsetAsync((char*)d_ws + WS_CTL, 0, CTL_ZERO_BYTES, stream) != hipSuccess) return;
    Args a{};
    for (int i = 0; i < 36; ++i) a.in[i] = (const float*)d_in[i];
    a.out = (float*)d_out; a.ws = (unsigned char*)d_ws;
#if MK_ONE_LAUNCH
    a.lo = 0; a.hi = N_STEPS;
    hipLaunchKernelGGL(hybrid_fwd, dim3(grid), dim3(NTHREADS), LDS_BYTES, stream, a);
#else
    for (int s = 0; s < N_STEPS; ++s) {
        if (s < 32 && (s & 7) == 2 && ((s >> 3) & 1)) continue;
        a.lo = s; a.hi = s + 1;
        hipLaunchKernelGGL(hybrid_fwd, dim3(grid), dim3(NTHREADS), LDS_BYTES, stream, a);
    }
#endif
}
```

```cpp
#include <hip/hip_runtime.h>
#include <cstdio>
#include <cstdint>
__device__ __forceinline__ float silu_f(float x) { return x * __builtin_amdgcn_rcpf(1.0f + __builtin_amdgcn_exp2f(-1.4426950408889634f * x)); }
namespace pg8 {
#define PG8_LAS __attribute__((address_space(3)))
typedef unsigned short bf16_t;
typedef short bf16x8 __attribute__((ext_vector_type(8)));
typedef float f32x4 __attribute__((ext_vector_type(4)));
typedef unsigned u32x4 __attribute__((ext_vector_type(4)));
constexpr int BM = 256, BK = 64, HALF = 128, HTB = HALF * BK * 2  , STAGE_BYTES = 8 * HTB, NXCD = 8, WGM = 8;

__host__ __device__ __forceinline__ int lds_byte(int r, int c) { const int st = (r >> 4) * 2 + (c >> 5), rr = r & 15, cc = c & 31, ob = rr * 64 + cc * 2; return st * 1024 + (ob ^ (((ob >> 9) & 1) << 5)); }
__host__ __device__ __forceinline__ void stage_rc(int b, int& R, int& C) { const int st = b / 1024, sb = b % 1024, swz = sb ^ (((sb >> 9) & 1) << 5); R = (st >> 1) * 16 + swz / 64; C = (st & 1) * 32 + (swz % 64) / 2; }
__host__ __device__ __forceinline__ int perm32(int rho) { const int n = rho >> 4, i = rho & 15; return 8 * (i >> 2) + 4 * n + (i & 3); }

struct Unit { int pm, pn; };
struct Gemm { const bf16_t* A; const bf16_t* Bt; int M, N, K; };

struct StaticOrder {
    int nM, nN, nwg, G, c;
    __host__ __device__ void init(int M, int N, int G_, int c_) { nM = M / BM; nN = N / BM; nwg = nM * nN; G = G_; c = c_; }
    __host__ __device__ bool next(int i, Unit& u) const {
        const long L = (long)i * G + c; if (L >= nwg) return false;
        int wgid = (int)L; { const int q = nwg / NXCD, r = nwg % NXCD, xcd = wgid % NXCD, off = wgid / NXCD; wgid = (xcd < r ? xcd * (q + 1) : r * (q + 1) + (xcd - r) * q) + off; }
        const int nig = WGM * nN, gid = wgid / nig, fm = gid * WGM, gsz = (nM - fm) < WGM ? (nM - fm) : WGM;
        u.pm = fm + ((wgid % nig) % gsz); u.pn = (wgid % nig) / gsz; return true;
    }
    __device__ __forceinline__ void a_ready(const Unit&) const {}
    __device__ __forceinline__ void done(const Unit&) const {}
};

__device__ __forceinline__ unsigned cvt_pk_bf16(float lo, float hi) { unsigned r; asm volatile("v_cvt_pk_bf16_f32 %0, %1, %2" : "=v"(r) : "v"(lo), "v"(hi)); return r; }
typedef float f32x2 __attribute__((ext_vector_type(2)));
struct EpiStoreBf16 {
    static constexpr bool PERM = true, AFTER_DRAIN = false;
    bf16_t* O; int ldc; int qtiles; float qscale;
    __device__ __forceinline__ void operator()(const f32x4 (&acc)[2][2][4][2], const Unit& u, int wr, int wc, int fr, int fq) const {
        const int row0 = u.pm * BM + wr * 64 + fr, col0 = u.pn * BM + wc * 32 + 8 * fq;
        const float sc = u.pn < qtiles ? qscale : 1.0f;
#pragma unroll
        for (int ai = 0; ai < 2; ++ai)
#pragma unroll
            for (int m = 0; m < 4; ++m) { bf16_t* rowp = O + (size_t)(row0 + ai * HALF + m * 16) * ldc + col0;
#pragma unroll
                for (int bj = 0; bj < 2; ++bj) { const f32x4 v0 = acc[ai][bj][m][0] * sc, v1 = acc[ai][bj][m][1] * sc;
                    u32x4 w; w.x = cvt_pk_bf16(v0[0], v0[1]); w.y = cvt_pk_bf16(v0[2], v0[3]); w.z = cvt_pk_bf16(v1[0], v1[1]); w.w = cvt_pk_bf16(v1[2], v1[3]);
                    *(u32x4*)(rowp + bj * HALF) = w; } }
    }
};
struct EpiResF32 {
    static constexpr bool PERM = false, AFTER_DRAIN = false;
    const float* base; float* out; int ldc;
    __device__ __forceinline__ void operator()(const f32x4 (&acc)[2][2][4][2], const Unit& u, int wr, int wc, int fr, int fq) const {
        const int row0 = u.pm * BM + wr * 64 + fr, col0 = u.pn * BM + wc * 32 + 4 * fq;
#pragma unroll
        for (int ai = 0; ai < 2; ++ai)
#pragma unroll
            for (int m = 0; m < 4; ++m) { const size_t off = (size_t)(row0 + ai * HALF + m * 16) * ldc + col0;
#pragma unroll
                for (int bj = 0; bj < 2; ++bj)
#pragma unroll
                    for (int n = 0; n < 2; ++n) { const f32x4 b = *(const f32x4*)(base + off + bj * HALF + n * 16); *(f32x4*)(out + off + bj * HALF + n * 16) = b + acc[ai][bj][m][n]; }
                asm volatile("" ::: "memory"); }
    }
};
struct EpiSwiglu {
    static constexpr bool PERM = true, AFTER_DRAIN = false;
    bf16_t* H; int ldc;
    __device__ __forceinline__ void operator()(const f32x4 (&acc)[2][2][4][2], const Unit& u, int wr, int wc, int fr, int fq) const {
        const int row0 = u.pm * BM + wr * 64 + fr, colh = u.pn * HALF + wc * 32 + 8 * fq;
#pragma unroll
        for (int ai = 0; ai < 2; ++ai)
#pragma unroll
            for (int m = 0; m < 4; ++m) { bf16_t* rowp = H + (size_t)(row0 + ai * HALF + m * 16) * ldc + colh;
                const f32x4 g0 = acc[ai][0][m][0], g1 = acc[ai][0][m][1], u0 = acc[ai][1][m][0], u1 = acc[ai][1][m][1];
                float h[8];
#pragma unroll
                for (int e = 0; e < 4; ++e) { h[e] = silu_f(g0[e]) * u0[e]; h[4 + e] = silu_f(g1[e]) * u1[e]; }
                u32x4 w; w.x = cvt_pk_bf16(h[0], h[1]); w.y = cvt_pk_bf16(h[2], h[3]); w.z = cvt_pk_bf16(h[4], h[5]); w.w = cvt_pk_bf16(h[6], h[7]);
                *(u32x4*)rowp = w; }
    }
};
template <int M_, int N_> struct StaticOrderC {
    static constexpr int nM = M_ / BM, nN = N_ / BM, nwg = nM * nN;
    int G, c;
    __device__ __forceinline__ void init(int G_, int c_) { G = G_; c = c_; }
    __device__ __forceinline__ bool next(int i, Unit& u) const {
        const int L = i * G + c; if (L >= nwg) return false;
        int wgid = L; { constexpr int q = nwg / NXCD, r = nwg % NXCD; const int xcd = wgid % NXCD, off = wgid / NXCD; wgid = (xcd < r ? xcd * (q + 1) : r * (q + 1) + (xcd - r) * q) + off; }
        constexpr int nig = WGM * nN; const int gid = wgid / nig, fm = gid * WGM, gsz = (nM - fm) < WGM ? (nM - fm) : WGM;
        u.pm = fm + ((wgid % nig) % gsz); u.pn = (wgid % nig) / gsz; return true;
    }
    __device__ __forceinline__ void a_ready(const Unit&) const {}
    __device__ __forceinline__ void done(const Unit&) const {}
};
template <class Epi, class Sched, bool ALIGN_EPI = false, bool SP2 = false>
__device__ __forceinline__ void gemm_phase(PG8_LAS unsigned char* lds, const Gemm g, const Sched& S, const Epi& E) {
    int tid_ = threadIdx.x; asm volatile("" : "+v"(tid_));
    float zz_ = 0.f; asm volatile("" : "+v"(zz_));
    const int tid = tid_, wid = __builtin_amdgcn_readfirstlane(tid >> 6), lane = tid & 63, wr = wid >> 2, wc = wid & 3, fr = lane & 15, fq = lane >> 4;
    const int K = g.K, nt = K / BK;
    unsigned voffA[2], voffB[2];
#pragma unroll
    for (int i = 0; i < 2; ++i) { int R, C; stage_rc(tid * 16 + i * 8192, R, C); const int Rb = Epi::PERM ? ((R & ~31) + perm32(R & 31)) : R;
        voffA[i] = (unsigned)(R * K + C) * 2u; voffB[i] = (unsigned)(Rb * K + C) * 2u; }
    const size_t kstep = (size_t)(BK * 2);
    const size_t hstep = (size_t)HALF * K * 2;
    const size_t tstep = 2 * hstep;
    const unsigned ldsw = (unsigned)wid * 1024u;
    const int aoff = lds_byte(wr * 64 + fr, fq * 8), boff = lds_byte(wc * 32 + fr, fq * 8);
#define PG8_SA(b, h) (((b) * 2 + (h)) * HTB)
#define PG8_SB(b, h) ((4 + (b) * 2 + (h)) * HTB)
#define PG8_STAGE(bufoff, gbase, voff) do { _Pragma("unroll") for (int _i = 0; _i < 2; ++_i) \
        __builtin_amdgcn_global_load_lds((const unsigned*)((const char*)(gbase) + (voff)[_i]), (PG8_LAS unsigned*)(lds + (bufoff) + ldsw + _i * 8192), 16, 0, 0); } while (0)
#define PG8_LDA(dst, b, h) do { _Pragma("unroll") for (int m = 0; m < 4; ++m) _Pragma("unroll") for (int k = 0; k < 2; ++k) dst[m][k] = *(const PG8_LAS bf16x8*)(lds + PG8_SA(b, h) + aoff + m * 2048 + k * 1024); } while (0)
#define PG8_LDB(dst, b, h) do { _Pragma("unroll") for (int n = 0; n < 2; ++n) _Pragma("unroll") for (int k = 0; k < 2; ++k) dst[n][k] = *(const PG8_LAS bf16x8*)(lds + PG8_SB(b, h) + boff + n * 2048 + k * 1024); } while (0)
#define PG8_MMA(ai, bj, At, Bt) do { __builtin_amdgcn_s_setprio(1); _Pragma("unroll") for (int m = 0; m < 4; ++m) _Pragma("unroll") for (int n = 0; n < 2; ++n) _Pragma("unroll") for (int k = 0; k < 2; ++k) \
        acc[ai][bj][m][n] = __builtin_amdgcn_mfma_f32_16x16x32_bf16(Bt[n][k], At[m][k], acc[ai][bj][m][n], 0, 0, 0); __builtin_amdgcn_s_setprio(0); } while (0)
#define PG8_WAIT_V(n) asm volatile("s_waitcnt vmcnt(" #n ")" ::: "memory")
#define PG8_WAIT_L(n) asm volatile("s_waitcnt lgkmcnt(" #n ")" ::: "memory")
#define PG8_BAR __builtin_amdgcn_s_barrier()
#define PG8_SCHED __builtin_amdgcn_sched_barrier(0)
    Unit cur, nxt; int ui = 0;
    if (!S.next(0, cur)) return;
    f32x4 acc[2][2][4][2];
#pragma unroll
    for (int a = 0; a < 2; ++a)
#pragma unroll
        for (int b = 0; b < 2; ++b)
#pragma unroll
            for (int m = 0; m < 4; ++m)
#pragma unroll
                for (int n = 0; n < 2; ++n) acc[a][b][m][n] = (f32x4){zz_, zz_, zz_, zz_};
    bf16x8 At[4][2], B0[2][2], B1[2][2];
    const char* cA = (const char*)g.A + (size_t)cur.pm * tstep; const char* cB = (const char*)g.Bt + (size_t)cur.pn * tstep;
    S.a_ready(cur);
    if constexpr (SP2) {
        PG8_STAGE(PG8_SB(0, 0), cB, voffB); PG8_STAGE(PG8_SB(0, 1), cB + hstep, voffB); PG8_STAGE(PG8_SA(0, 0), cA, voffA); PG8_STAGE(PG8_SA(0, 1), cA + hstep, voffA);
        if (wr == 1) PG8_BAR;
        PG8_WAIT_V(2); PG8_BAR;
        PG8_STAGE(PG8_SB(1, 0), cB + kstep, voffB); PG8_STAGE(PG8_SA(1, 0), cA + kstep, voffA); PG8_STAGE(PG8_SB(1, 1), cB + hstep + kstep, voffB);
        PG8_WAIT_V(6); PG8_BAR;
    } else {
        PG8_STAGE(PG8_SB(0, 0), cB, voffB); PG8_STAGE(PG8_SA(0, 0), cA, voffA); PG8_STAGE(PG8_SB(0, 1), cB + hstep, voffB); PG8_STAGE(PG8_SA(0, 1), cA + hstep, voffA);
        if (wr == 1) PG8_BAR;
        PG8_WAIT_V(4); PG8_BAR;
        PG8_STAGE(PG8_SB(1, 0), cB + kstep, voffB); PG8_STAGE(PG8_SA(1, 0), cA + kstep, voffA); PG8_STAGE(PG8_SB(1, 1), cB + hstep + kstep, voffB);
        PG8_WAIT_V(6); PG8_BAR;
    }
    for (;;) {
        const bool has_next = S.next(ui + 1, nxt);
        const char* nA = has_next ? (const char*)g.A + (size_t)nxt.pm * tstep : cA; const char* nB = has_next ? (const char*)g.Bt + (size_t)nxt.pn * tstep : cB;
        for (int t = 0; t < nt; t += 2) {
            const bool last = (t == nt - 2);
            const char* a1 = cA + (size_t)(t + 1) * kstep;
            const char* a2 = last ? nA : cA + (size_t)(t + 2) * kstep; const char* b2 = last ? nB : cB + (size_t)(t + 2) * kstep;
            const char* a3 = a2 + kstep; const char* b3 = b2 + kstep;
            if (last && has_next) S.a_ready(nxt);
            if constexpr (SP2) {
            PG8_LDB(B0, 0, 0); PG8_LDB(B1, 0, 1); PG8_SCHED; PG8_LDA(At, 0, 0); PG8_STAGE(PG8_SA(1, 1), a1 + hstep, voffA);
            PG8_WAIT_V(8); PG8_WAIT_L(0); PG8_BAR; PG8_MMA(0, 0, At, B0); PG8_MMA(0, 1, At, B1); PG8_BAR; PG8_SCHED;
            PG8_LDA(At, 0, 1); PG8_STAGE(PG8_SB(0, 0), b2, voffB); PG8_STAGE(PG8_SB(0, 1), b2 + hstep, voffB); PG8_STAGE(PG8_SA(0, 0), a2, voffA);
            PG8_WAIT_V(8); PG8_WAIT_L(0); PG8_BAR; PG8_MMA(1, 0, At, B0); PG8_MMA(1, 1, At, B1); PG8_BAR; PG8_SCHED;
            PG8_LDB(B0, 1, 0); PG8_LDB(B1, 1, 1); PG8_SCHED; PG8_LDA(At, 1, 0); PG8_STAGE(PG8_SA(0, 1), a2 + hstep, voffA);
            PG8_WAIT_V(8); PG8_WAIT_L(0); PG8_BAR; PG8_MMA(0, 0, At, B0); PG8_MMA(0, 1, At, B1); PG8_BAR; PG8_SCHED;
            PG8_LDA(At, 1, 1); PG8_STAGE(PG8_SB(1, 0), b3, voffB); PG8_STAGE(PG8_SB(1, 1), b3 + hstep, voffB); PG8_STAGE(PG8_SA(1, 0), a3, voffA);
            PG8_WAIT_V(8); PG8_WAIT_L(0); PG8_BAR; PG8_MMA(1, 0, At, B0); PG8_MMA(1, 1, At, B1); PG8_BAR; PG8_SCHED;
            } else {
            PG8_LDB(B0, 0, 0); PG8_SCHED; PG8_LDA(At, 0, 0); PG8_STAGE(PG8_SA(1, 1), a1 + hstep, voffA);
            PG8_WAIT_L(8); PG8_BAR; PG8_WAIT_L(0); PG8_MMA(0, 0, At, B0); PG8_BAR; PG8_SCHED;
            PG8_LDB(B1, 0, 1); PG8_STAGE(PG8_SB(0, 0), b2, voffB);
            PG8_BAR; PG8_WAIT_L(0); PG8_MMA(0, 1, At, B1); PG8_BAR;
            PG8_LDA(At, 0, 1); PG8_STAGE(PG8_SA(0, 0), a2, voffA);
            PG8_BAR; PG8_WAIT_L(0); PG8_MMA(1, 0, At, B0); PG8_BAR; PG8_SCHED;
            PG8_STAGE(PG8_SB(0, 1), b2 + hstep, voffB);
            PG8_WAIT_V(6); PG8_BAR; PG8_MMA(1, 1, At, B1); PG8_BAR;
            PG8_LDB(B0, 1, 0); PG8_SCHED; PG8_LDA(At, 1, 0); PG8_STAGE(PG8_SA(0, 1), a2 + hstep, voffA);
            PG8_WAIT_L(8); PG8_BAR; PG8_WAIT_L(0); PG8_MMA(0, 0, At, B0); PG8_BAR; PG8_SCHED;
            PG8_LDB(B1, 1, 1); PG8_STAGE(PG8_SB(1, 0), b3, voffB);
            PG8_BAR; PG8_WAIT_L(0); PG8_MMA(0, 1, At, B1); PG8_BAR;
            PG8_LDA(At, 1, 1); PG8_STAGE(PG8_SA(1, 0), a3, voffA);
            PG8_BAR; PG8_WAIT_L(0); PG8_MMA(1, 0, At, B0); PG8_BAR; PG8_SCHED;
            PG8_STAGE(PG8_SB(1, 1), b3 + hstep, voffB);
            PG8_WAIT_V(6); PG8_BAR; PG8_MMA(1, 1, At, B1); PG8_BAR;
            }
        }
        if constexpr (ALIGN_EPI) { if (wr == 0) PG8_BAR; }
        if constexpr (!Epi::AFTER_DRAIN) { E(acc, cur, wr, wc, fr, fq); S.done(cur); }
        if (!has_next) break;
#pragma unroll
        for (int a = 0; a < 2; ++a)
#pragma unroll
            for (int b = 0; b < 2; ++b)
#pragma unroll
                for (int m = 0; m < 4; ++m)
#pragma unroll
                    for (int n = 0; n < 2; ++n) acc[a][b][m][n] = (f32x4){zz_, zz_, zz_, zz_};
        cur = nxt; cA = nA; cB = nB; ++ui;
        if constexpr (ALIGN_EPI) { if (wr == 1) PG8_BAR; }
    }
    PG8_WAIT_V(0);
    if constexpr (!ALIGN_EPI) { if (wr == 0) PG8_BAR; }
    PG8_BAR;
    if constexpr (Epi::AFTER_DRAIN) { E.fused(acc, cur, wr, wc, fr, fq, lds, wid, lane); S.done(cur); }
#undef PG8_SA
#undef PG8_SB
#undef PG8_STAGE
#undef PG8_LDA
#undef PG8_LDB
#undef PG8_MMA
#undef PG8_WAIT_V
#undef PG8_WAIT_L
#undef PG8_BAR
#undef PG8_SCHED
}
}
#ifndef PG8_SP2
#define PG8_SP2 true
#endif
#ifndef PG8_ALIGN
#define PG8_ALIGN true
#endif
constexpr int NWAVES = 8, NTHREADS = NWAVES * 64;
constexpr int BATCH = 8, T = 4096, D = 1024, M = BATCH * T;
constexpr int NIN_E = 3840, NIN_O = 3072, FF = 2816, NGU = 2 * FF;
constexpr int PC_R = 0, PC_K = 512, PC_V = 1024, PC_GQ = 1536, PC_GK = 1792, PC_GV = 2048, PC_GG = 2560;
constexpr int PC_W1A = 3072, PC_W1B = 3136, PC_A1A = 3200, PC_A1B = 3264, PC_G1A = 3328, PC_G1B = 3488, PC_WA1 = 3648, PC_PAD = 3664;
constexpr int NLORA = 304;
constexpr size_t MiB = 1u << 20;
constexpr size_t WS_CTL = 0, CTL_ZERO_BYTES = 1 * MiB;
constexpr size_t WS_WIN = 2 * MiB, WS_WOUT = 10 * MiB, WS_WGU = 12 * MiB, WS_WDN = 23 * MiB;
constexpr size_t WS_W2T = 29 * MiB, WS_A2T = WS_W2T + 65536, WS_G2T = WS_A2T + 65536, WS_WA2T = WS_G2T + 196608;
constexpr size_t WS_XN = 32 * MiB;
constexpr size_t WS_P = 96 * MiB;
constexpr size_t WS_WLOG = 336 * MiB;
constexpr size_t WS_ASIG = 400 * MiB;
constexpr size_t WS_LA = 464 * MiB;
constexpr size_t WS_END = 496 * MiB;
constexpr int CW_BAR = 4096;
constexpr int RING_BYTES = 135168, LDSCTL_OFF = RING_BYTES, MISC_OFF = LDSCTL_OFF + 320, LDS_BYTES = 147456;

#define GAS __attribute__((address_space(1)))
#define LAS __attribute__((address_space(3)))
typedef unsigned short bf16;
typedef unsigned v4u __attribute__((ext_vector_type(4)));
typedef unsigned v2u __attribute__((ext_vector_type(2)));
typedef float f32x4 __attribute__((ext_vector_type(4)));
#define LDS_WAIT() asm volatile("s_waitcnt lgkmcnt(0)" ::: "memory")
#define VM_WAIT() asm volatile("s_waitcnt vmcnt(0)" ::: "memory")
__device__ __forceinline__ unsigned f2bf(float f) { unsigned u = __builtin_bit_cast(unsigned, f); return (u + 0x7fffu + ((u >> 16) & 1u)) >> 16; }
__device__ __forceinline__ unsigned pk2(float lo, float hi) { return f2bf(lo) | (f2bf(hi) << 16); }
__device__ __forceinline__ float bf2f(bf16 u) { return __builtin_bit_cast(float, (unsigned)u << 16); }
__device__ __forceinline__ float bflo(unsigned w) { return __builtin_bit_cast(float, w << 16); }
__device__ __forceinline__ float bfhi(unsigned w) { return __builtin_bit_cast(float, w & 0xffff0000u); }
__device__ __forceinline__ float wave_sum(float v) {
#pragma unroll
    for (int o = 1; o < 64; o <<= 1) v += __shfl_xor(v, o);
    return v;
}
__device__ __forceinline__ float wave_max(float v) {
#pragma unroll
    for (int o = 1; o < 64; o <<= 1) v = fmaxf(v, __shfl_xor(v, o));
    return v;
}
__device__ __forceinline__ float fexp(float x) { return __builtin_amdgcn_exp2f(x * 1.4426950408889634f); }
__device__ __forceinline__ float flog(float x) { return __builtin_amdgcn_logf(x) * 0.6931471805599453f; }
__device__ __forceinline__ float frcp(float x) { return __builtin_amdgcn_rcpf(x); }
__device__ __forceinline__ float frsq(float x) { return __builtin_amdgcn_rsqf(x); }
__device__ __forceinline__ float fsqrt(float x) { return __builtin_amdgcn_sqrtf(x); }
__device__ __forceinline__ float sigmoid_f(float x) { return frcp(1.0f + fexp(-x)); }
__device__ __forceinline__ float softplus_f(float x) { return fmaxf(x, 0.f) + flog(1.0f + fexp(-fabsf(x))); }
__device__ __forceinline__ float tanh_f(float x) { return 1.0f - 2.0f * frcp(1.0f + fexp(2.0f * x)); }
#define XB_TMO      128
#define XB_XCNT(j)  (256  + 64 * (j))
#define XB_XSUB(j)  (1280 + 64 * (j))
#define XB_XGEN(j)  (2304 + 64 * (j))
#define XB_TOP      3328
#define XB_TOPGEN   3392
#define XCD_BAR_WORDS 3456
#define XB_SPIN_CAP (1u << 23)

__device__ __forceinline__ unsigned xb_ld(unsigned* p)              { return __hip_atomic_load(p, __ATOMIC_RELAXED, __HIP_MEMORY_SCOPE_AGENT); }
__device__ __forceinline__ unsigned xb_add(unsigned* p, unsigned v) { return __hip_atomic_fetch_add(p, v, __ATOMIC_RELAXED, __HIP_MEMORY_SCOPE_AGENT); }
__device__ __forceinline__ unsigned xb_xcc_id() { return (unsigned)__builtin_amdgcn_s_getreg((3 << 11) | 20) & 0xFu; }
#define XB_SPIN(cond, bar) do { unsigned _sp = 0; while (cond) { __builtin_amdgcn_s_sleep(1); \
    if ((++_sp & 255u) == 0u) { if (xb_ld(&(bar)[XB_TMO])) break; if (_sp > XB_SPIN_CAP) { atomicAdd(&(bar)[XB_TMO], 1u); break; } } } } while (0)

struct XcdBarrier {
    unsigned* bar; unsigned x;
    volatile LAS unsigned* st;
};

__device__ __forceinline__ XcdBarrier xcd_barrier_post(unsigned* bar, volatile LAS unsigned* st) {
    XcdBarrier b; b.bar = bar; b.x = xb_xcc_id(); b.st = st;
    if (threadIdx.x == 0) (void)xb_add(&bar[XB_XCNT(b.x)], 1u);
    return b;
}
__device__ __forceinline__ void xcd_barrier_complete(unsigned* bar, unsigned x, unsigned& nloc, unsigned& nx) {
    const unsigned G = gridDim.x * gridDim.y * gridDim.z;
    unsigned sum, cnt, mine, sp = 0u;
    for (;;) {
        sum = 0u; cnt = 0u; mine = 0u;
#pragma unroll
        for (unsigned j = 0; j < 16; ++j) { const unsigned c = xb_ld(&bar[XB_XCNT(j)]); sum += c; cnt += (c > 0u) ? 1u : 0u; mine = (j == x) ? c : mine; }
        if (sum == G) break;
        __builtin_amdgcn_s_sleep(1);
        if ((++sp & 255u) == 0u) { if (xb_ld(&bar[XB_TMO])) break; if (sp > XB_SPIN_CAP) { atomicAdd(&bar[XB_TMO], 1u); break; } }
    }
    nloc = mine > 0u ? mine : 1u; nx = cnt > 0u ? cnt : 1u;
}

__device__ __forceinline__ void xcd_barrier(const XcdBarrier& b) {
    asm volatile("s_waitcnt vmcnt(0)" ::: "memory");
    __syncthreads();
    if (threadIdx.x == 0) {
        unsigned blo_ = __builtin_amdgcn_readfirstlane((unsigned)(unsigned long long)b.bar), bhi_ = __builtin_amdgcn_readfirstlane((unsigned)((unsigned long long)b.bar >> 32)), bx = __builtin_amdgcn_readfirstlane(b.x); asm volatile("" : "+s"(blo_), "+s"(bhi_), "+s"(bx)); unsigned* bar = (unsigned*)(((unsigned long long)bhi_ << 32) | blo_);
        __builtin_amdgcn_s_waitcnt(0);
        unsigned nloc = b.st[0], nx = b.st[1];
        if (nloc == 0u) { xcd_barrier_complete(bar, bx, nloc, nx); b.st[0] = nloc; b.st[1] = nx; }
        const unsigned old = xb_add(&bar[XB_XSUB(bx)], 1u);
        const unsigned gen = old / nloc;
        if (old + 1u == (gen + 1u) * nloc) {
            __builtin_amdgcn_fence(__ATOMIC_RELEASE, "agent");
            asm volatile("s_waitcnt vmcnt(0)" ::: "memory");
            const unsigned og = xb_add(&bar[XB_TOP], 1u);
            const unsigned tg = og / nx;
            if (og + 1u == (tg + 1u) * nx) xb_add(&bar[XB_TOPGEN], 1u);
            else XB_SPIN(xb_ld(&bar[XB_TOPGEN]) == tg, bar);
            __builtin_amdgcn_fence(__ATOMIC_ACQUIRE, "agent");
            xb_add(&bar[XB_XGEN(bx)], 1u);
            asm volatile("s_waitcnt vmcnt(0)" ::: "memory");
        } else {
            XB_SPIN(xb_ld(&bar[XB_XGEN(bx)]) == gen, bar);
            __builtin_amdgcn_fence(__ATOMIC_ACQUIRE, "agent");
            asm volatile("s_waitcnt vmcnt(0)" ::: "memory");
        }
    }
    __syncthreads();
}
__device__ __forceinline__ void tr_item(const float* __restrict__ W, int Kreal, int N, bf16* WT, int ldd, int dst_row0, LAS float* scr, int k0, int n0, int lane,
                                        const float* __restrict__ mu, float sc0, float sc1) {
    const int nn = n0 + (lane & 31); const bool nv = nn < N;
#pragma unroll 8
    for (int i = 0; i < 32; ++i) { const int kk = 2 * i + (lane >> 5); float v = (nv && k0 + kk < Kreal) ? W[(size_t)(k0 + kk) * N + nn] : 0.f; if (mu) v *= sc0 + sc1 * mu[k0 + kk]; scr[kk * 33 + (lane & 31)] = v; }
    LDS_WAIT(); asm volatile("" ::: "memory");
    const int c = lane & 7;
#pragma unroll
    for (int j = 0; j < 4; ++j) { const int n = (lane >> 3) + 8 * j; const LAS float* s = scr + (8 * c) * 33 + n;
        v4u o; o.x = pk2(s[0 * 33], s[1 * 33]); o.y = pk2(s[2 * 33], s[3 * 33]); o.z = pk2(s[4 * 33], s[5 * 33]); o.w = pk2(s[6 * 33], s[7 * 33]);
        if (n0 + n < N) *(GAS v4u*)(WT + (size_t)(dst_row0 + n) * ldd + k0 + 8 * c) = o; }
    LDS_WAIT(); asm volatile("" ::: "memory");
}
__device__ __forceinline__ void rms_row_bf16(const float* xrow, const float* g, bf16* orow, int lane) {
    const GAS f32x4* xr = (const GAS f32x4*)xrow + lane; const GAS f32x4* gr = (const GAS f32x4*)g + lane;
    f32x4 v[4]; float s = 0.f;
#pragma unroll
    for (int j = 0; j < 4; ++j) { v[j] = xr[64 * j]; s += (v[j].x * v[j].x + v[j].y * v[j].y) + (v[j].z * v[j].z + v[j].w * v[j].w); }
    const float rs = frsq(wave_sum(s) * (1.f / D) + 1e-6f);
    GAS v2u* o8 = (GAS v2u*)orow + lane;
#pragma unroll
    for (int j = 0; j < 4; ++j) { const f32x4 gv = gr[64 * j]; v2u o; o.x = pk2(v[j].x * rs * gv.x, v[j].y * rs * gv.y); o.y = pk2(v[j].z * rs * gv.z, v[j].w * rs * gv.w); o8[64 * j] = o; }
}
__device__ __forceinline__ void rms_row_f32(const float* xrow, const float* g, float* orow, int lane) {
    const GAS f32x4* xr = (const GAS f32x4*)xrow + lane; const GAS f32x4* gr = (const GAS f32x4*)g + lane;
    f32x4 v[4]; float s = 0.f;
#pragma unroll
    for (int j = 0; j < 4; ++j) { v[j] = xr[64 * j]; s += (v[j].x * v[j].x + v[j].y * v[j].y) + (v[j].z * v[j].z + v[j].w * v[j].w); }
    const float rs = frsq(wave_sum(s) * (1.f / D) + 1e-6f);
    GAS f32x4* o = (GAS f32x4*)orow + lane;
#pragma unroll
    for (int j = 0; j < 4; ++j) { const f32x4 gv = gr[64 * j]; o[64 * j] = v[j] * rs * gv; }
}

struct Args { const float* in[36]; float* out; unsigned char* ws; int lo, hi; };
typedef const __attribute__((address_space(4))) Args* ArgP;
#define FRESH_ARGS() ({ ArgP p_ = (ArgP)__builtin_amdgcn_kernarg_segment_ptr(); asm volatile("" : "+s"(p_)); p_; })
#define FRESH_V(x) asm volatile("" : "+v"(x))
#define FRESH_S(x) asm volatile("" : "+s"(x))

__device__ __forceinline__ void phase_convert_norm(ArgP A, int L, const float* xin, LAS unsigned char* lds, int wave, int lane, int G, int bid) {
    const int i = L >> 1; const bool even = !(L & 1);
    bf16* Win = (bf16*)(A->ws + WS_WIN); bf16* Wout = (bf16*)(A->ws + WS_WOUT); bf16* Wgu = (bf16*)(A->ws + WS_WGU); bf16* Wdn = (bf16*)(A->ws + WS_WDN);
    LAS float* scr = (LAS float*)(lds + wave * 16384);
    const int gw = bid * NWAVES + wave, NGW = G * NWAVES;
    const float* w_in = even ? A->in[5] + (size_t)i * D * 3072 : A->in[26] + (size_t)i * D * 3072;
    const float* w_out = even ? A->in[6] + (size_t)i * D * D : A->in[27] + (size_t)i * D * D;
    const float* mu_w = A->in[8] + (size_t)i * 3 * D, *mu_a = mu_w + D, *mu_g = mu_w + 2 * D;
    const float* w1 = A->in[10] + (size_t)i * D * 64, *a1 = A->in[13] + (size_t)i * D * 64, *g1 = A->in[15] + (size_t)i * D * 160, *wa1 = A->in[22] + (size_t)i * D * 16;
    const float* wg = A->in[33] + (size_t)L * D * FF, *wu = A->in[34] + (size_t)L * D * FF, *wd = A->in[35] + (size_t)L * FF * D;
    const int I_IN = 16 * 96, I_L64 = 16 * 2, I_L160 = 16 * 5, I_L16 = 16 * 1, I_OUT = 16 * 32, I_GU = 16 * 88, I_DN = 44 * 32;
    const int n_lora = even ? (4 * I_L64 + 2 * I_L160 + I_L16 + 16 + 16 + 48) : 0;
    const float* w2s = A->in[11] + (size_t)i * 64 * 512, *a2s = A->in[14] + (size_t)i * 64 * 512, *g2s = A->in[16] + (size_t)i * 160 * 512;
    bf16* W2T = (bf16*)(A->ws + WS_W2T); bf16* A2T = (bf16*)(A->ws + WS_A2T); bf16* G2T = (bf16*)(A->ws + WS_G2T);
    const int NITEMS = I_IN + n_lora + I_OUT + 2 * I_GU + I_DN;
#define TR_JOB(items, nblk, Wp, Kd, Nd, DST, LDD, ROW0, MU, S0, S1) if (r < (items)) { const int kb = r / (nblk), nb = r % (nblk), n0 = 32 * nb; tr_item(Wp, Kd, Nd, DST, LDD, ROW0, scr, 64 * kb, n0, lane, MU, S0, S1); continue; } r -= (items);
    for (int it = gw; it < NITEMS; it += NGW) {
        int r = it;
        TR_JOB(I_IN, 96, w_in, D, 3072, Win, D, n0, nullptr, 1.f, 0.f)
        if (even) {
            TR_JOB(I_L64, 2, w1, D, 64, Win, D, PC_W1A + n0, mu_w, 1.f, -1.f)
            TR_JOB(I_L64, 2, w1, D, 64, Win, D, PC_W1B + n0, mu_w, 0.f, 1.f)
            TR_JOB(I_L64, 2, a1, D, 64, Win, D, PC_A1A + n0, mu_a, 1.f, -1.f)
            TR_JOB(I_L64, 2, a1, D, 64, Win, D, PC_A1B + n0, mu_a, 0.f, 1.f)
            TR_JOB(I_L160, 5, g1, D, 160, Win, D, PC_G1A + n0, mu_g, 1.f, -1.f)
            TR_JOB(I_L160, 5, g1, D, 160, Win, D, PC_G1B + n0, mu_g, 0.f, 1.f)
            TR_JOB(I_L16, 1, wa1, D, 16, Win, D, PC_WA1 + n0, nullptr, 1.f, 0.f)
            TR_JOB(16, 16, w2s, 64, 512, W2T, 64, n0, nullptr, 1.f, 0.f)
            TR_JOB(16, 16, a2s, 64, 512, A2T, 64, n0, nullptr, 1.f, 0.f)
            TR_JOB(48, 16, g2s, 160, 512, G2T, 192, n0, nullptr, 1.f, 0.f)
        }
        TR_JOB(I_OUT, 32, w_out, D, D, Wout, D, n0, nullptr, 1.f, 0.f)
        TR_JOB(I_GU, 88, wg, D, FF, Wgu, D, 256 * (n0 >> 7) + (n0 & 127), nullptr, 1.f, 0.f)
        TR_JOB(I_GU, 88, wu, D, FF, Wgu, D, 256 * (n0 >> 7) + (n0 & 127) + 128, nullptr, 1.f, 0.f)
        TR_JOB(I_DN, 32, wd, FF, D, Wdn, FF, n0, nullptr, 1.f, 0.f)
    }
#undef TR_JOB
    if (even) {
        const int gt = bid * NTHREADS + wave * 64 + lane, NT = G * NTHREADS;
        for (int e = gt; e < (NIN_E - PC_PAD) * D / 8; e += NT) ((GAS v4u*)(Win + (size_t)PC_PAD * D))[e] = (v4u){0u, 0u, 0u, 0u};
    }
    bf16* XN = (bf16*)(A->ws + WS_XN); const float* gain = A->in[2] + (size_t)L * D;
    for (int m = gw; m < M; m += NGW) rms_row_bf16(xin + (size_t)m * D, gain, XN + (size_t)m * D, lane);
}

__device__ __forceinline__ void phase_prep(ArgP A, int L, LAS unsigned char* lds, int G, int tid, int bid) {
    const int i = L >> 1;
    const bf16* P = (const bf16*)(A->ws + WS_P); float* LA = (float*)(A->ws + WS_LA);
    const float* wa2 = A->in[23] + (size_t)i * 16 * 256, *ba = A->in[24] + i * 256;
    LAS float* sl = (LAS float*)lds;
    for (int item = bid; item < M / 32; item += G) {
        const int row0 = item * 32;
        { const int tok = tid >> 4, j = tid & 15; sl[j * 32 + tok] = bf2f(P[(size_t)(row0 + tok) * NIN_E + PC_WA1 + j]); }
        __syncthreads();
        const int c = tid;
        if (c < 256) {
            float acc[32];
#pragma unroll
            for (int t = 0; t < 32; ++t) acc[t] = 0.f;
            for (int j = 0; j < 16; ++j) { const float w = wa2[j * 256 + c];
#pragma unroll
                for (int t4 = 0; t4 < 8; ++t4) { const f32x4 x = *(const LAS f32x4*)(sl + j * 32 + 4 * t4); acc[4 * t4] += x.x * w; acc[4 * t4 + 1] += x.y * w; acc[4 * t4 + 2] += x.z * w; acc[4 * t4 + 3] += x.w * w; } }
            const float b0 = ba[c]; float* op = LA + (size_t)row0 * 256 + c;
#pragma unroll
            for (int t = 0; t < 32; ++t) { *op = -softplus_f(-(b0 + acc[t])) * (1.0f / 16.0f); op += 256; FRESH_V(op); }
        }
        __syncthreads();
    }
}

__device__ __noinline__ void rwkv_scan_seq(ArgP A, int L, int b, int h, LAS float* sc, int lane) {
    const int i = L >> 1, c = h * 64 + lane;
    const bf16* P = (const bf16*)(A->ws + WS_P); const float* WLOG = (const float*)(A->ws + WS_WLOG); const float* ASIG = (const float*)(A->ws + WS_ASIG); bf16* OAB = (bf16*)(A->ws + WS_XN);
    const float* mu = A->in[7] + (size_t)i * 1536;
    const float mur = mu[c], muk = mu[512 + c], muv = mu[1024 + c];
    const float kkc = A->in[17][i * 512 + c], kac = A->in[18][i * 512 + c], rkc = A->in[19][i * 512 + c], lnw = A->in[20][i * 512 + c], lnb = A->in[21][i * 512 + c];
    float S[64];
#pragma unroll
    for (int k = 0; k < 64; ++k) S[k] = 0.f;
    float pr_prev = 0.f, pk_prev = 0.f, pv_prev = 0.f;
    const size_t row0 = (size_t)b * T;
    float npr = bf2f(P[row0 * NIN_E + PC_R + c]), npk = bf2f(P[row0 * NIN_E + PC_K + c]), npv = bf2f(P[row0 * NIN_E + PC_V + c]);
    float nwl = WLOG[row0 * 512 + c], nas = ASIG[row0 * 512 + c], ng = bf2f(OAB[row0 * D + c]);
#pragma unroll 1
    for (int t = 0; t < T; ++t) {
        const float pr = npr, pk = npk, pv = npv, wl = nwl, as = nas, g = ng;
        if (t + 1 < T) { const size_t rw = row0 + t + 1; npr = bf2f(P[rw * NIN_E + PC_R + c]); npk = bf2f(P[rw * NIN_E + PC_K + c]); npv = bf2f(P[rw * NIN_E + PC_V + c]);
            nwl = WLOG[rw * 512 + c]; nas = ASIG[rw * 512 + c]; ng = bf2f(OAB[rw * D + c]); }
        const float r = pr + (pr_prev - pr) * mur, k = pk + (pk_prev - pk) * muk, v = pv + (pv_prev - pv) * muv;
        pr_prev = pr; pk_prev = pk; pv_prev = pv;
        float kk = k * kkc; const float n2 = wave_sum(kk * kk); kk = kk * frcp(fmaxf(fsqrt(n2), 1e-12f));
        const float kmod = k * (1.f + (as - 1.f) * kac);
        sc[lane] = -kk; sc[64 + lane] = fexp(wl); sc[128 + lane] = kk * as; sc[192 + lane] = kmod; sc[256 + lane] = r;
        LDS_WAIT(); asm volatile("" ::: "memory");
        float sa = 0.f;
#pragma unroll
        for (int k4 = 0; k4 < 16; ++k4) { const f32x4 a4 = *(const LAS f32x4*)(sc + 4 * k4); sa += S[4 * k4] * a4.x; sa += S[4 * k4 + 1] * a4.y; sa += S[4 * k4 + 2] * a4.z; sa += S[4 * k4 + 3] * a4.w; }
        float y = 0.f;
#pragma unroll
        for (int k4 = 0; k4 < 16; ++k4) {
            const f32x4 w4 = *(const LAS f32x4*)(sc + 64 + 4 * k4), b4 = *(const LAS f32x4*)(sc + 128 + 4 * k4), kq = *(const LAS f32x4*)(sc + 192 + 4 * k4), r4 = *(const LAS f32x4*)(sc + 256 + 4 * k4);
            S[4 * k4] = S[4 * k4] * w4.x + sa * b4.x + v * kq.x; y += S[4 * k4] * r4.x;
            S[4 * k4 + 1] = S[4 * k4 + 1] * w4.y + sa * b4.y + v * kq.y; y += S[4 * k4 + 1] * r4.y;
            S[4 * k4 + 2] = S[4 * k4 + 2] * w4.z + sa * b4.z + v * kq.z; y += S[4 * k4 + 2] * r4.z;
            S[4 * k4 + 3] = S[4 * k4 + 3] * w4.w + sa * b4.w + v * kq.w; y += S[4 * k4 + 3] * r4.w;
        }
        asm volatile("" ::: "memory");
        const float bonus = wave_sum(r * kmod * rkc);
        const float mean = wave_sum(y) * (1.f / 64.f); const float d = y - mean; const float var = wave_sum(d * d) * (1.f / 64.f);
        float o = d * frsq(var + 64e-5f) * lnw + lnb;
        o = (o + bonus * v) * g;
        OAB[(row0 + t) * D + c] = (bf16)f2bf(o);
    }
}
__device__ __noinline__ void gla_scan_half(ArgP A, int b, int h, int half, LAS float* sc, int lane) {
    const bf16* P = (const bf16*)(A->ws + WS_P); const float* LA = (const float*)(A->ws + WS_LA); bf16* OAB = (bf16*)(A->ws + WS_XN);
    float S0[64];
#pragma unroll
    for (int k = 0; k < 64; ++k) S0[k] = 0.f;
    const size_t row0 = (size_t)b * T;
#pragma unroll 1
    for (int t = 0; t < T; ++t) {
        const size_t rw = row0 + t; const bf16* pr = P + rw * NIN_E;
        const float q = bf2f(pr[PC_GQ + h * 64 + lane]) * 0.125f, kx = bf2f(pr[PC_GK + h * 64 + lane]), la = LA[rw * 256 + h * 64 + lane];
        const float v0 = bf2f(pr[PC_GV + h * 128 + half * 64 + lane]);
        sc[lane] = fexp(la); sc[64 + lane] = kx; sc[128 + lane] = q;
        LDS_WAIT(); asm volatile("" ::: "memory");
        float o0 = 0.f;
#pragma unroll
        for (int k4 = 0; k4 < 16; ++k4) {
            const f32x4 a4 = *(const LAS f32x4*)(sc + 4 * k4), k4v = *(const LAS f32x4*)(sc + 64 + 4 * k4), q4 = *(const LAS f32x4*)(sc + 128 + 4 * k4);
            S0[4 * k4] = S0[4 * k4] * a4.x + k4v.x * v0; o0 += q4.x * S0[4 * k4];
            S0[4 * k4 + 1] = S0[4 * k4 + 1] * a4.y + k4v.y * v0; o0 += q4.y * S0[4 * k4 + 1];
            S0[4 * k4 + 2] = S0[4 * k4 + 2] * a4.z + k4v.z * v0; o0 += q4.z * S0[4 * k4 + 2];
            S0[4 * k4 + 3] = S0[4 * k4 + 3] * a4.w + k4v.w * v0; o0 += q4.w * S0[4 * k4 + 3];
        }
        asm volatile("" ::: "memory");
        OAB[rw * D + 512 + h * 128 + half * 64 + lane] = (bf16)f2bf(o0);
    }
}
__device__ __noinline__ void gla_norm_rows(ArgP A, int L, int b, int h, int wave, int lane) {
    const int i = L >> 1;
    const bf16* P = (const bf16*)(A->ws + WS_P); bf16* OAB = (bf16*)(A->ws + WS_XN);
    const float gn0 = A->in[25][i * 512 + h * 128 + 2 * lane], gn1 = A->in[25][i * 512 + h * 128 + 2 * lane + 1];
    for (int t = wave; t < T; t += NWAVES) {
        const size_t rw = (size_t)b * T + t;
        GAS unsigned* op = (GAS unsigned*)(OAB + rw * D + 512 + h * 128 + 2 * lane);
        const unsigned ov = *op, gv = *(const GAS unsigned*)(P + rw * NIN_E + PC_GG + h * 128 + 2 * lane);
        const float o0 = bflo(ov), o1 = bfhi(ov);
        const float rs = frsq(wave_sum(o0 * o0 + o1 * o1) * (1.f / 128.f) + 1e-5f);
        *op = pk2(o0 * rs * gn0 * silu_f(bflo(gv)), o1 * rs * gn1 * silu_f(bfhi(gv)));
    }
}

__device__ __forceinline__ int t5_bucket(int d) {
    if (d < 16) return d;
    const float r = (float)d / 16.0f; int l = 16 + (int)(flog(r) / 2.0794415416798357f * 16.0f);
    return l < 31 ? l : 31;
}
__device__ __noinline__ void attn_row_simple(ArgP A, int L, int b, int h, int t, float lam, float lam_init, LAS float* qs  , LAS float* bd  , int lane) {
    const int i = L >> 1;
    const bf16* QKV = (const bf16*)(A->ws + WS_P); bf16* O = (bf16*)(A->ws + WS_XN);
    const bf16* qrow = QKV + (size_t)(b * T + t) * NIN_O + h * 128;
    qs[lane] = bf2f(qrow[lane]) * 0.125f; qs[64 + lane] = bf2f(qrow[64 + lane]) * 0.125f;
    bd[lane] = A->in[1][t5_bucket(lane) * 8 + h]; bd[64 + lane] = A->in[1][t5_bucket(64 + lane) * 8 + h];
    LDS_WAIT(); asm volatile("" ::: "memory");
    float m1 = -1e30f, m2 = -1e30f, l1 = 0.f, l2 = 0.f, o1a = 0.f, o1b = 0.f, o2a = 0.f, o2b = 0.f;
#pragma unroll 1
    for (int j0 = 0; j0 <= t; j0 += 64) {
        const int j = j0 + lane; const bool valid = j <= t;
        const bf16* krow = QKV + (size_t)(b * T + j) * NIN_O + 1024 + h * 128;
        float s1 = 0.f, s2 = 0.f;
#pragma unroll 2
        for (int c8 = 0; c8 < 8; ++c8) { const v4u kv = *(const GAS v4u*)(krow + 8 * c8); const f32x4 qa = *(const LAS f32x4*)(qs + 8 * c8), qb = *(const LAS f32x4*)(qs + 8 * c8 + 4);
            s1 += qa.x * bflo(kv.x) + qa.y * bfhi(kv.x) + qa.z * bflo(kv.y) + qa.w * bfhi(kv.y) + qb.x * bflo(kv.z) + qb.y * bfhi(kv.z) + qb.z * bflo(kv.w) + qb.w * bfhi(kv.w); }
#pragma unroll 2
        for (int c8 = 0; c8 < 8; ++c8) { const v4u kv = *(const GAS v4u*)(krow + 64 + 8 * c8); const f32x4 qa = *(const LAS f32x4*)(qs + 64 + 8 * c8), qb = *(const LAS f32x4*)(qs + 64 + 8 * c8 + 4);
            s2 += qa.x * bflo(kv.x) + qa.y * bfhi(kv.x) + qa.z * bflo(kv.y) + qa.w * bfhi(kv.y) + qb.x * bflo(kv.z) + qb.y * bfhi(kv.z) + qb.z * bflo(kv.w) + qb.w * bfhi(kv.w); }
        const int dist = valid ? (t - j) : 0; const float bias = bd[dist < 127 ? dist : 127];
        s1 = valid ? s1 + bias : -1e30f; s2 = valid ? s2 + bias : -1e30f;
        const float mn1 = fmaxf(m1, wave_max(s1)), mn2 = fmaxf(m2, wave_max(s2));
        const float c1 = fexp(m1 - mn1), c2 = fexp(m2 - mn2);
        const float p1 = valid ? fexp(s1 - mn1) : 0.f, p2 = valid ? fexp(s2 - mn2) : 0.f;
        l1 = l1 * c1 + wave_sum(p1); l2 = l2 * c2 + wave_sum(p2); m1 = mn1; m2 = mn2;
        o1a *= c1; o1b *= c1; o2a *= c2; o2b *= c2;
        const bf16* vbase = QKV + (size_t)(b * T + j0) * NIN_O + 2048 + h * 128 + 2 * lane;
#pragma unroll 4
        for (int jj = 0; jj < 64; ++jj) {
            const float pj1 = __builtin_bit_cast(float, __builtin_amdgcn_readlane(__builtin_bit_cast(int, p1), jj)), pj2 = __builtin_bit_cast(float, __builtin_amdgcn_readlane(__builtin_bit_cast(int, p2), jj));
            const unsigned vv = *(const GAS unsigned*)(vbase + (size_t)jj * NIN_O); const float v0 = bflo(vv), v1 = bfhi(vv);
            o1a += pj1 * v0; o1b += pj1 * v1; o2a += pj2 * v0; o2b += pj2 * v1;
        }
    }
    const float il1 = frcp(l1), il2 = frcp(l2); float oa = o1a * il1 - lam * (o2a * il2), ob = o1b * il1 - lam * (o2b * il2);
    const float ms = wave_sum(oa * oa + ob * ob) * (1.f / 128.f); const float rs = frsq(ms + 1e-5f);
    const float sc = 1.0f - lam_init; const float* sl = A->in[32] + i * 128;
    oa = oa * rs * sl[2 * lane] * sc; ob = ob * rs * sl[2 * lane + 1] * sc;
    *(GAS unsigned*)(O + (size_t)(b * T + t) * D + h * 128 + 2 * lane) = pk2(oa, ob);
}
typedef short a_bf16x8 __attribute__((ext_vector_type(8)));
typedef float f32x16 __attribute__((ext_vector_type(16)));
typedef short a_s16x4 __attribute__((ext_vector_type(4)));
constexpr int AT_SK = 144, AT_SV = 320, AT_K1 = 0, AT_K2 = 64 * AT_SK, AT_V = 2 * 64 * AT_SK, AT_ST = AT_V + 64 * AT_SV, AT_BIAS = 2 * AT_ST, AT_COMB = 0;
static_assert(AT_BIAS + 132 * 4 <= RING_BYTES && 4 * 64 * 64 * 4 <= AT_BIAS, "attention LDS map");
__device__ __forceinline__ int crow16(int r, int hi) { return (r & 3) + 8 * (r >> 2) + 4 * hi; }
typedef float f32x2_t __attribute__((ext_vector_type(2))); typedef __bf16 bf16x2_t __attribute__((ext_vector_type(2)));
__device__ __forceinline__ unsigned cvtpk(float lo, float hi) { const f32x2_t v = {lo, hi}; const bf16x2_t b = __builtin_convertvector(v, bf16x2_t); return __builtin_bit_cast(unsigned, b); }

__device__ __forceinline__ void attn_unit_mfma(ArgP A, int L, int b, int h, int qb, float lam, float lam_init, LAS unsigned char* lds, int tid) {
    const int lane = tid & 63, wave = __builtin_amdgcn_readfirstlane(tid >> 6), r32 = lane & 31, hi = lane >> 5;
    const int smap = wave >> 2, qs = wave & 3;
    const int i = L >> 1;
    const bf16* QKV = (const bf16*)(A->ws + WS_P); bf16* O = (bf16*)(A->ws + WS_XN);
    const int q0 = qb * 128, qw0 = q0 + 32 * qs, nt = (q0 + 128) / 64;
    const size_t rowb = (size_t)b * T;
    if (tid < 129) { const float far = A->in[1][31 * 8 + h]; ((LAS float*)(lds + AT_BIAS))[tid] = tid < 128 ? (A->in[1][t5_bucket(tid) * 8 + h] - far) * 1.4426950408889634f : 0.f; }
    a_bf16x8 qf[4];
    { const bf16* qrow = QKV + (rowb + qw0 + r32) * NIN_O + h * 128 + smap * 64 + 8 * hi;
#pragma unroll
      for (int ks = 0; ks < 4; ++ks) qf[ks] = *(const GAS a_bf16x8*)(qrow + 16 * ks); }
    const int kr = tid >> 3, kc = tid & 7, vr0 = tid >> 4, vc = tid & 15;
    const bf16* kg = QKV + (rowb + kr) * NIN_O + 1024 + h * 128 + 8 * kc;
    const bf16* vg = QKV + (rowb + vr0) * NIN_O + 2048 + h * 128 + 8 * vc;
    const int kw = kr * AT_SK + kc * 16, vw = vr0 * AT_SV + vc * 16;
    v4u sk1, sk2, sv0, sv1;
#define AT_LOAD(kt) do { const size_t go_ = (size_t)(kt) * 64 * NIN_O; sk1 = *(const GAS v4u*)(kg + go_); sk2 = *(const GAS v4u*)(kg + go_ + 64); sv0 = *(const GAS v4u*)(vg + go_); sv1 = *(const GAS v4u*)(vg + go_ + (size_t)32 * NIN_O); } while (0)
#define AT_STORE(st) do { LAS unsigned char* sb_ = lds + (st) * AT_ST; *(LAS v4u*)(sb_ + AT_K1 + kw) = sk1; *(LAS v4u*)(sb_ + AT_K2 + kw) = sk2; *(LAS v4u*)(sb_ + AT_V + vw) = sv0; *(LAS v4u*)(sb_ + AT_V + vw + 32 * AT_SV) = sv1; } while (0)
    AT_LOAD(0); AT_STORE(0);
    __syncthreads();
    f32x16 o[4];
#pragma unroll
    for (int d = 0; d < 4; ++d)
#pragma unroll
        for (int r = 0; r < 16; ++r) o[d][r] = 0.f;
    float m = -1e30f, l = 0.f;
    const int kfo = (smap ? AT_K2 : AT_K1) + r32 * AT_SK + 16 * hi;
    const int vfo = AT_V + (4 * hi + ((lane & 15) >> 2)) * AT_SV + (16 * ((lane >> 4) & 1) + 4 * (lane & 3)) * 2;
    const LAS float* bdl = (const LAS float*)(lds + AT_BIAS);
    const int qme = qw0 + r32;
#pragma unroll 1
    for (int kt = 0; kt < nt; ++kt) {
        if (kt + 1 < nt) AT_LOAD(kt + 1);
        const int key0 = 64 * kt;
        if (key0 <= qw0 + 31) {
            const LAS unsigned char* sb = lds + (kt & 1) * AT_ST;
            f32x16 p[2];
#pragma unroll
            for (int blk = 0; blk < 2; ++blk) {
#pragma unroll
                for (int r = 0; r < 16; ++r) p[blk][r] = 0.f;
#pragma unroll
                for (int ks = 0; ks < 4; ++ks) { const a_bf16x8 kf = *(const LAS a_bf16x8*)(sb + kfo + blk * 32 * AT_SK + ks * 32); p[blk] = __builtin_amdgcn_mfma_f32_32x32x16_bf16(kf, qf[ks], p[blk], 0, 0, 0); }
            }
            if (key0 + 63 + 128 > qw0) {
#pragma unroll
                for (int blk = 0; blk < 2; ++blk)
#pragma unroll
                    for (int r = 0; r < 16; ++r) { const int dist = qme - (key0 + 32 * blk + crow16(r, hi)); const float bv = bdl[dist < 0 ? 128 : (dist < 128 ? dist : 128)]; p[blk][r] = dist < 0 ? -1e30f : p[blk][r] + bv; }
            }
            float mx = p[0][0];
#pragma unroll
            for (int r = 1; r < 16; ++r) mx = fmaxf(mx, p[0][r]);
#pragma unroll
            for (int r = 0; r < 16; ++r) mx = fmaxf(mx, p[1][r]);
            mx = fmaxf(mx, __shfl_xor(mx, 32));
            if (__any(mx > m + 8.0f)) {
                const float mn = fmaxf(m, mx), al = __builtin_amdgcn_exp2f(m - mn); m = mn; l *= al;
#pragma unroll
                for (int d = 0; d < 4; ++d)
#pragma unroll
                    for (int r = 0; r < 16; ++r) o[d][r] *= al;
            }
            float ls = 0.f;
#pragma unroll
            for (int blk = 0; blk < 2; ++blk)
#pragma unroll
                for (int r = 0; r < 16; ++r) { const float e = __builtin_amdgcn_exp2f(p[blk][r] - m); p[blk][r] = e; ls += e; }
            l += ls;
            a_bf16x8 pf[4];
#pragma unroll
            for (int kk = 0; kk < 4; ++kk) { const int blk = kk >> 1, s8 = 8 * (kk & 1); v4u w; w.x = cvtpk(p[blk][s8], p[blk][s8 + 1]); w.y = cvtpk(p[blk][s8 + 2], p[blk][s8 + 3]); w.z = cvtpk(p[blk][s8 + 4], p[blk][s8 + 5]); w.w = cvtpk(p[blk][s8 + 6], p[blk][s8 + 7]); pf[kk] = __builtin_bit_cast(a_bf16x8, w); }
#pragma unroll
            for (int kk = 0; kk < 4; ++kk)
#pragma unroll
                for (int d = 0; d < 4; ++d) {
                    const LAS unsigned char* vp = sb + vfo + kk * 16 * AT_SV + d * 64;
                    const a_s16x4 lo4 = __builtin_bit_cast(a_s16x4, __builtin_amdgcn_ds_read_tr16_b64_v4i16((LAS a_s16x4*)vp));
                    const a_s16x4 hi4 = __builtin_bit_cast(a_s16x4, __builtin_amdgcn_ds_read_tr16_b64_v4i16((LAS a_s16x4*)(vp + 8 * AT_SV)));
                    const a_bf16x8 vf = (a_bf16x8){lo4[0], lo4[1], lo4[2], lo4[3], hi4[0], hi4[1], hi4[2], hi4[3]};
                    o[d] = __builtin_amdgcn_mfma_f32_32x32x16_bf16(vf, pf[kk], o[d], 0, 0, 0);
                }
        }
        if (kt + 1 < nt) AT_STORE((kt + 1) & 1);
        __syncthreads();
    }
#undef AT_LOAD
#undef AT_STORE
    l += __shfl_xor(l, 32);
    LAS float* comb = (LAS float*)(lds + AT_COMB) + qs * 4096;
    if (smap == 1) { const float sc = lam * frcp(l);
#pragma unroll
        for (int d = 0; d < 4; ++d)
#pragma unroll
            for (int r = 0; r < 16; ++r) comb[(d * 16 + r) * 64 + lane] = o[d][r] * sc; }
    __syncthreads();
    if (smap == 0) {
        const float il = frcp(l); float ss = 0.f;
#pragma unroll
        for (int d = 0; d < 4; ++d)
#pragma unroll
            for (int r = 0; r < 16; ++r) { const float v = o[d][r] * il - comb[(d * 16 + r) * 64 + lane]; o[d][r] = v; ss += v * v; }
        ss += __shfl_xor(ss, 32);
        const float rs = frsq(ss * (1.f / 128.f) + 1e-5f) * (1.0f - lam_init);
        const float* sl = A->in[32] + i * 128;
        bf16* orow = O + (rowb + qw0 + r32) * D + h * 128;
#pragma unroll
        for (int d = 0; d < 4; ++d)
#pragma unroll
            for (int g4 = 0; g4 < 4; ++g4) { const int dc = 32 * d + 8 * g4 + 4 * hi; const f32x4 s4 = *(const GAS f32x4*)(sl + dc);
                v2u w; w.x = cvtpk(o[d][4 * g4] * rs * s4.x, o[d][4 * g4 + 1] * rs * s4.y); w.y = cvtpk(o[d][4 * g4 + 2] * rs * s4.z, o[d][4 * g4 + 3] * rs * s4.w);
                *(GAS v2u*)(orow + dc) = w; }
    }
    __syncthreads();
}

__device__ __forceinline__ void attn_phase_mfma(ArgP A, int L, LAS unsigned char* lds, int tid, int G, int bid) {
    const int lane = tid & 63, i = L >> 1;
    const float lam_init = 0.8f - 0.6f * fexp(-0.3f * (float)L);
    const float lam = fexp(wave_sum(A->in[28][i * 64 + lane] * A->in[29][i * 64 + lane])) - fexp(wave_sum(A->in[30][i * 64 + lane] * A->in[31][i * 64 + lane])) + lam_init;
    if (G == 256) {
        const int v = (bid & 7) * 32 + (bid >> 3), bh = v >> 2, j = v & 3;
#pragma unroll 1
        for (int u = 0; u < 8; ++u) { const int qb = 8 * (u >> 1) + ((u & 1) ? 7 - j : j); attn_unit_mfma(A, L, bh >> 3, bh & 7, qb, lam, lam_init, lds, tid); }
    } else {
#pragma unroll 1
        for (int u = bid; u < 64 * 32; u += G) attn_unit_mfma(A, L, (u >> 5) >> 3, (u >> 5) & 7, 31 - (u & 31), lam, lam_init, lds, tid);
    }
}
typedef short bf16x8_t __attribute__((ext_vector_type(8)));
constexpr int MS = 72, MB = 64 * MS * 2;
constexpr int RW_XW = 8 * MB, RW_XA = RW_XW + 16384;
constexpr int RW_TOT = 14 * MB, RW_GAM = RW_TOT + 2048, RW_END = RW_GAM + 256;
static_assert(RW_XA + 16384 <= 12 * MB && RW_END <= RING_BYTES, "RWKV LDS map");
constexpr size_t WS_RWI = 336 * MiB;
constexpr size_t WS_BON = 30 * MiB;
#define RBUF(k) ((LAS bf16*)(lds + (k) * MB))
__device__ __forceinline__ f32x4 mfma16(bf16x8_t a, bf16x8_t b, f32x4 c) { return __builtin_amdgcn_mfma_f32_16x16x32_bf16(a, b, c, 0, 0, 0); }
__device__ __forceinline__ bf16x8_t ldfrag(const LAS bf16* Mx, int row0, int k0, int lane) { return *(const LAS bf16x8_t*)(Mx + (row0 + (lane & 15)) * MS + k0 + 8 * (lane >> 4)); }
__device__ __forceinline__ f32x4 mm64(f32x4 acc, const LAS bf16* Am, int ra, const LAS bf16* BTm, int cb, int lane) {
    acc = mfma16(ldfrag(Am, 16 * ra, 0, lane), ldfrag(BTm, 16 * cb, 0, lane), acc);
    return mfma16(ldfrag(Am, 16 * ra, 32, lane), ldfrag(BTm, 16 * cb, 32, lane), acc);
}
__device__ __forceinline__ v2u pack4(f32x4 a) { v2u w; w.x = cvtpk(a[0], a[1]); w.y = cvtpk(a[2], a[3]); return w; }
__device__ __forceinline__ void tstore(LAS bf16* Dm, int rt, int ct, f32x4 acc, int lane) { *(LAS v2u*)(Dm + (16 * ct + (lane & 15)) * MS + 16 * rt + 4 * (lane >> 4)) = pack4(acc); }
__device__ __forceinline__ void tstore_g(bf16* Dg, int rt, int ct, f32x4 acc, int lane) { *(GAS v2u*)(Dg + (16 * ct + (lane & 15)) * 64 + 16 * rt + 4 * (lane >> 4)) = pack4(acc); }
__device__ __forceinline__ f32x4 ld4bf(const LAS bf16* p) { const v2u w = *(const LAS v2u*)p; return (f32x4){bflo(w.x), bfhi(w.x), bflo(w.y), bfhi(w.y)}; }
__device__ __forceinline__ f32x4 ld4bf_g(const bf16* p) { const v2u w = *(const GAS v2u*)p; return (f32x4){bflo(w.x), bfhi(w.x), bflo(w.y), bfhi(w.y)}; }
__device__ __forceinline__ void unpack8(v4u w, float (&f)[8]) { f[0] = bflo(w.x); f[1] = bfhi(w.x); f[2] = bflo(w.y); f[3] = bfhi(w.y); f[4] = bflo(w.z); f[5] = bfhi(w.z); f[6] = bflo(w.w); f[7] = bfhi(w.w); }
__device__ __forceinline__ bf16x8_t pack8(const float (&f)[8]) { v4u w; w.x = cvtpk(f[0], f[1]); w.y = cvtpk(f[2], f[3]); w.z = cvtpk(f[4], f[5]); w.w = cvtpk(f[6], f[7]); return __builtin_bit_cast(bf16x8_t, w); }

__device__ __forceinline__ void rwkv_chunk_item(ArgP A, int L, int b, int n, int h, LAS unsigned char* lds, int tid) {
    const int lane = tid & 63, wave = __builtin_amdgcn_readfirstlane(tid >> 6), i = L >> 1;
    const int l15 = lane & 15, lg = lane >> 4;
    const bf16* P = (const bf16*)(A->ws + WS_P); bf16* XNb = (bf16*)(A->ws + WS_XN);
    const size_t rowb = (size_t)b * T + 64 * n;
    bf16* item = (bf16*)(A->ws + WS_RWI) + ((size_t)((b * 64 + n) * 8 + h)) * 16384;
    {
        const int rt = wave >> 1, ct0 = 2 * (wave & 1);
        const int tt = 16 * rt + l15; const bf16* prow = P + (rowb + tt) * NIN_E; const bool has_prev = (64 * n + tt) > 0;
        const bf16* W2T = (const bf16*)(A->ws + WS_W2T); const bf16* A2T = (const bf16*)(A->ws + WS_A2T); const bf16* G2T = (const bf16*)(A->ws + WS_G2T);
        f32x4 xw[2], xa[2];
#pragma unroll
        for (int c = 0; c < 2; ++c) { xw[c] = (f32x4){0.f, 0.f, 0.f, 0.f}; xa[c] = (f32x4){0.f, 0.f, 0.f, 0.f}; }
#pragma unroll
        for (int k0 = 0; k0 < 64; k0 += 32) {
            const int kc = k0 + 8 * lg; float x[8], y[8], v[8];
            unpack8(*(const GAS v4u*)(prow + PC_W1A + kc), x); if (has_prev) unpack8(*(const GAS v4u*)(prow - NIN_E + PC_W1B + kc), y); else {
#pragma unroll
                for (int e = 0; e < 8; ++e) y[e] = 0.f; }
#pragma unroll
            for (int e = 0; e < 8; ++e) v[e] = tanh_f(x[e] + y[e]);
            const bf16x8_t fw = pack8(v);
            unpack8(*(const GAS v4u*)(prow + PC_A1A + kc), x); if (has_prev) unpack8(*(const GAS v4u*)(prow - NIN_E + PC_A1B + kc), y);
#pragma unroll
            for (int e = 0; e < 8; ++e) v[e] = x[e] + y[e];
            const bf16x8_t fa = pack8(v);
#pragma unroll
            for (int c = 0; c < 2; ++c) { const size_t wo = (size_t)(64 * h + 16 * (ct0 + c) + l15) * 64 + kc;
                xw[c] = mfma16(fw, *(const GAS bf16x8_t*)(W2T + wo), xw[c]); xa[c] = mfma16(fa, *(const GAS bf16x8_t*)(A2T + wo), xa[c]); }
        }
        LAS float* XW = (LAS float*)(lds + RW_XW); LAS float* XA = (LAS float*)(lds + RW_XA);
#pragma unroll
        for (int c = 0; c < 2; ++c)
#pragma unroll
            for (int r = 0; r < 4; ++r) { const int o = (16 * rt + 4 * lg + r) * 64 + 16 * (ct0 + c) + l15; XW[o] = xw[c][r]; XA[o] = xa[c][r]; }
        const int tct = wave >> 1, jt0 = 2 * (wave & 1);
        f32x4 gg[2] = {(f32x4){0.f, 0.f, 0.f, 0.f}, (f32x4){0.f, 0.f, 0.f, 0.f}};
#pragma unroll
        for (int k0 = 0; k0 < 192; k0 += 32) {
            const int kc = k0 + 8 * lg; float x[8], y[8], v[8];
            if (kc < 160) { unpack8(*(const GAS v4u*)(prow + PC_G1A + kc), x); if (has_prev) unpack8(*(const GAS v4u*)(prow - NIN_E + PC_G1B + kc), y); else {
#pragma unroll
                    for (int e = 0; e < 8; ++e) y[e] = 0.f; }
#pragma unroll
                for (int e = 0; e < 8; ++e) v[e] = sigmoid_f(x[e] + y[e]); }
            else {
#pragma unroll
                for (int e = 0; e < 8; ++e) v[e] = 0.f; }
            const bf16x8_t fg = pack8(v);
#pragma unroll
            for (int c = 0; c < 2; ++c) gg[c] = mfma16(*(const GAS bf16x8_t*)(G2T + (size_t)(64 * h + 16 * (jt0 + c) + l15) * 192 + kc), fg, gg[c]);
        }
        (void)tct;
#pragma unroll
        for (int c = 0; c < 2; ++c) *(GAS v2u*)(XNb + (rowb + tt) * D + 64 * h + 16 * (jt0 + c) + 4 * lg) = pack4(gg[c]);
    }
    __syncthreads();
    {
        const int c = 64 * h + lane;
        const float* mu = A->in[7] + (size_t)i * 1536;
        const float mur = mu[c], muk = mu[512 + c], muv = mu[1024 + c];
        const float kkc = A->in[17][i * 512 + c], kac = A->in[18][i * 512 + c], rkc = A->in[19][i * 512 + c], w0c = A->in[9][i * 512 + c], a0c = A->in[12][i * 512 + c];
        const LAS float* XW = (const LAS float*)(lds + RW_XW); const LAS float* XA = (const LAS float*)(lds + RW_XA);
        float* BON = (float*)(A->ws + WS_BON);
        const int tt0 = 8 * wave; const size_t row0 = rowb + tt0;
        float pr_p = 0.f, pk_p = 0.f, pv_p = 0.f;
        if (64 * n + tt0 > 0) { const bf16* pp = P + (row0 - 1) * NIN_E; pr_p = bf2f(pp[PC_R + c]); pk_p = bf2f(pp[PC_K + c]); pv_p = bf2f(pp[PC_V + c]); }
        float rr[8], av[8], bv[8], km[8], vv[8], wl[8], lc[8];
        float run = 0.f;
#pragma unroll
        for (int u = 0; u < 8; ++u) {
            const bf16* pr = P + (row0 + u) * NIN_E; const float pR = bf2f(pr[PC_R + c]), pK = bf2f(pr[PC_K + c]), pV = bf2f(pr[PC_V + c]);
            const float r = pR + (pr_p - pR) * mur, k = pK + (pk_p - pK) * muk, v = pV + (pv_p - pV) * muv; pr_p = pR; pk_p = pK; pv_p = pV;
            const float xw = w0c + XW[(tt0 + u) * 64 + lane], xa = a0c + XA[(tt0 + u) * 64 + lane];
            const float wlog = -fexp(-softplus_f(-xw) - 0.5f), as = sigmoid_f(xa);
            float kk = k * kkc; const float n2 = wave_sum(kk * kk); kk = kk * frcp(fmaxf(fsqrt(n2), 1e-12f));
            const float kmod = k * (1.f + (as - 1.f) * kac);
            const float bon = wave_sum(r * kmod * rkc);
            if (lane == 0) BON[(row0 + u) * 8 + h] = bon;
            run += wlog; rr[u] = r; av[u] = -kk; bv[u] = kk * as; km[u] = kmod; vv[u] = v; wl[u] = wlog; lc[u] = run;
        }
        LAS float* TOT = (LAS float*)(lds + RW_TOT);
        TOT[wave * 64 + lane] = run;
        __syncthreads();
        float off = 0.f, tot = 0.f;
#pragma unroll
        for (int w2 = 0; w2 < 8; ++w2) { const float tv = TOT[w2 * 64 + lane]; tot += tv; if (w2 < wave) off += tv; }
        if (wave == 0) ((LAS float*)(lds + RW_GAM))[lane] = fexp(tot);
        float fR[8], fA[8], fB[8], fK[8];
#pragma unroll
        for (int u = 0; u < 8; ++u) { const float cum = off + lc[u], e1 = fexp(cum), ei = fexp(-cum); fR[u] = rr[u] * e1; fA[u] = av[u] * fexp(cum - wl[u]); fB[u] = bv[u] * ei; fK[u] = km[u] * ei; }
        LAS bf16* At = RBUF(0); LAS bf16* Bt = RBUF(1); LAS bf16* Kt = RBUF(2); LAS bf16* Rt = RBUF(3);
#pragma unroll
        for (int u = 0; u < 8; ++u) { const int o = (tt0 + u) * MS + lane; At[o] = (bf16)f2bf(fA[u]); Bt[o] = (bf16)f2bf(fB[u]); Kt[o] = (bf16)f2bf(fK[u]); Rt[o] = (bf16)f2bf(fR[u]); }
        *(LAS bf16x8_t*)(RBUF(4) + lane * MS + tt0) = pack8(fA); *(LAS bf16x8_t*)(RBUF(5) + lane * MS + tt0) = pack8(fB);
        *(LAS bf16x8_t*)(RBUF(6) + lane * MS + tt0) = pack8(fK); *(LAS bf16x8_t*)(RBUF(7) + lane * MS + tt0) = pack8(vv);
    }
    __syncthreads();
    const int rt = wave >> 1, ct0 = 2 * (wave & 1);
    {
        const LAS bf16* At = RBUF(0); const LAS bf16* Bt = RBUF(1); const LAS bf16* Kt = RBUF(2); const LAS bf16* Rt = RBUF(3);
#pragma unroll
        for (int c = 0; c < 2; ++c) { const int ct = ct0 + c; const f32x4 z = (f32x4){0.f, 0.f, 0.f, 0.f};
            f32x4 aL = mm64(z, Bt, rt, At, ct, lane);
            f32x4 aLT = mm64(z, At, rt, Bt, ct, lane);
            f32x4 aAK = mm64(z, Kt, rt, At, ct, lane);
            f32x4 aRB = mm64(z, Bt, rt, Rt, ct, lane);
            f32x4 aRK = mm64(z, Kt, rt, Rt, ct, lane);
            const int col = 16 * ct + l15;
#pragma unroll
            for (int r = 0; r < 4; ++r) { const int row = 16 * rt + 4 * lg + r;
                if (!(row < col)) { aL[r] = 0.f; aAK[r] = 0.f; }
                if (!(col < row)) aLT[r] = 0.f;
                if (!(row <= col)) { aRB[r] = 0.f; aRK[r] = 0.f; } }
            tstore(RBUF(8), rt, ct, aL, lane); tstore(RBUF(9), rt, ct, aLT, lane); tstore(RBUF(10), rt, ct, aAK, lane); tstore(RBUF(11), rt, ct, aRB, lane); tstore(RBUF(12), rt, ct, aRK, lane);
        }
    }
    __syncthreads();
    {
        for (int e = tid; e < 64 * 16; e += NTHREADS) { const int row = e >> 4, c4 = (e & 15) * 4; v2u w = *(const LAS v2u*)(RBUF(8) + row * MS + c4);
            if ((row >> 2) == (c4 >> 2)) { const unsigned one = 0x3f80u; const int p = row & 3; if (p == 0) w.x = (w.x & 0xffff0000u) | one; else if (p == 1) w.x = (w.x & 0xffffu) | (one << 16); else if (p == 2) w.y = (w.y & 0xffff0000u) | one; else w.y = (w.y & 0xffffu) | (one << 16); }
            *(LAS v2u*)(RBUF(0) + row * MS + c4) = w; }
    }
#define RW_SQUARE(Min, MTin, Mout, MTout) do { _Pragma("unroll") for (int c = 0; c < 2; ++c) { const int ct = ct0 + c; const f32x4 z = (f32x4){0.f, 0.f, 0.f, 0.f}; \
        tstore(RBUF(Mout), rt, ct, mm64(z, RBUF(MTin), rt, RBUF(Min), ct, lane), lane);        \
        tstore(RBUF(MTout), rt, ct, mm64(z, RBUF(Min), rt, RBUF(MTin), ct, lane), lane); } } while (0)
#define RW_YSTEP(Yin, MTin, Yout) do { _Pragma("unroll") for (int c = 0; c < 2; ++c) { const int ct = ct0 + c; \
        const f32x4 y0 = ld4bf(RBUF(Yin) + (16 * ct + l15) * MS + 16 * rt + 4 * lg);            \
        tstore(RBUF(Yout), rt, ct, mm64(y0, RBUF(MTin), rt, RBUF(Yin), ct, lane), lane); } } while (0)
    RW_SQUARE(8, 9, 2, 13);
    __syncthreads();
    RW_YSTEP(0, 13, 1); RW_SQUARE(2, 13, 8, 9);
    __syncthreads();
    RW_YSTEP(1, 9, 0); RW_SQUARE(8, 9, 2, 13);
    __syncthreads();
    RW_YSTEP(0, 13, 1); RW_SQUARE(2, 13, 8, 9);
    __syncthreads();
    RW_YSTEP(1, 9, 0); RW_SQUARE(8, 9, 2, 13);
    __syncthreads();
    RW_YSTEP(0, 13, 1);
    __syncthreads();
#undef RW_SQUARE
#undef RW_YSTEP
    {
#pragma unroll
        for (int c = 0; c < 2; ++c) { const int ct = ct0 + c; const f32x4 z = (f32x4){0.f, 0.f, 0.f, 0.f};
            tstore(RBUF(8), rt, ct, mm64(z, RBUF(1), rt, RBUF(4), ct, lane), lane);
            tstore(RBUF(9), rt, ct, mm64(z, RBUF(10), rt, RBUF(7), ct, lane), lane); }
    }
    __syncthreads();
    {
        const LAS float* GAM = (const LAS float*)(lds + RW_GAM);
#pragma unroll
        for (int c = 0; c < 2; ++c) { const int ct = ct0 + c; const f32x4 z = (f32x4){0.f, 0.f, 0.f, 0.f};
            tstore(RBUF(0), rt, ct, mm64(z, RBUF(1), rt, RBUF(9), ct, lane), lane);
            const f32x4 r0 = ld4bf(RBUF(3) + (16 * ct + l15) * MS + 16 * rt + 4 * lg);
            tstore_g(item, rt, ct, mm64(r0, RBUF(8), rt, RBUF(11), ct, lane), lane);
            f32x4 pp = mm64(z, RBUF(8), rt, RBUF(5), ct, lane);
            const float gm = GAM[16 * ct + l15];
#pragma unroll
            for (int r = 0; r < 4; ++r) pp[r] = gm * (pp[r] + ((16 * rt + 4 * lg + r) == (16 * ct + l15) ? 1.f : 0.f));
            tstore_g(item + 8192, rt, ct, pp, lane); }
    }
    __syncthreads();
    {
        const LAS float* GAM = (const LAS float*)(lds + RW_GAM);
#pragma unroll
        for (int c = 0; c < 2; ++c) { const int ct = ct0 + c; const f32x4 z = (f32x4){0.f, 0.f, 0.f, 0.f};
            f32x4 y0 = mm64(z, RBUF(0), rt, RBUF(11), ct, lane); y0 = mm64(y0, RBUF(7), rt, RBUF(12), ct, lane);
            tstore_g(item + 4096, rt, ct, y0, lane);
            f32x4 q = mm64(z, RBUF(5), rt, RBUF(0), ct, lane); q = mm64(q, RBUF(6), rt, RBUF(7), ct, lane);
            const f32x4 g4 = *(const LAS f32x4*)(GAM + 16 * rt + 4 * lg);
            q = q * g4;
            tstore_g(item + 12288, rt, ct, q, lane); }
    }
    __syncthreads();
}

__device__ __forceinline__ void rwkv_state_scan(ArgP A, int b, int h, int lane) {
    const int r32 = lane & 31, hi = lane >> 5;
    f32x16 St[2][2];
#pragma unroll
    for (int kb = 0; kb < 2; ++kb)
#pragma unroll
        for (int vb = 0; vb < 2; ++vb)
#pragma unroll
            for (int r = 0; r < 16; ++r) St[kb][vb][r] = 0.f;
#pragma unroll 1
    for (int n = 0; n < 64; ++n) {
        bf16* item = (bf16*)(A->ws + WS_RWI) + ((size_t)((b * 64 + n) * 8 + h)) * 16384;
        bf16* PM = item + 8192; const bf16* QT = item + 12288;
        a_bf16x8 pf[2][4];
#pragma unroll
        for (int kb = 0; kb < 2; ++kb)
#pragma unroll
            for (int ks = 0; ks < 4; ++ks) { const bf16* pp = PM + (32 * kb + r32) * 64 + 16 * ks + 4 * hi; const v2u lo = *(const GAS v2u*)pp, h2 = *(const GAS v2u*)(pp + 8);
                pf[kb][ks] = __builtin_bit_cast(a_bf16x8, (v4u){lo.x, lo.y, h2.x, h2.y}); }
        f32x16 Nw[2][2];
#pragma unroll
        for (int kb = 0; kb < 2; ++kb)
#pragma unroll
            for (int vb = 0; vb < 2; ++vb)
#pragma unroll
                for (int g = 0; g < 4; ++g) { const f32x4 q4 = ld4bf_g(QT + (32 * vb + r32) * 64 + 32 * kb + 8 * g + 4 * hi); Nw[kb][vb][4 * g] = q4.x; Nw[kb][vb][4 * g + 1] = q4.y; Nw[kb][vb][4 * g + 2] = q4.z; Nw[kb][vb][4 * g + 3] = q4.w; }
        asm volatile("s_waitcnt vmcnt(0)" ::: "memory");
#pragma unroll
        for (int kb = 0; kb < 2; ++kb)
#pragma unroll
            for (int vb = 0; vb < 2; ++vb)
#pragma unroll
                for (int g = 0; g < 4; ++g) { v2u w; w.x = cvtpk(St[kb][vb][4 * g], St[kb][vb][4 * g + 1]); w.y = cvtpk(St[kb][vb][4 * g + 2], St[kb][vb][4 * g + 3]);
                    *(GAS v2u*)(PM + (32 * vb + r32) * 64 + 32 * kb + 8 * g + 4 * hi) = w; }
        a_bf16x8 sf[4][2];
#pragma unroll
        for (int ks = 0; ks < 4; ++ks)
#pragma unroll
            for (int vb = 0; vb < 2; ++vb) { const int kb = ks >> 1, s8 = 8 * (ks & 1); v4u w; w.x = cvtpk(St[kb][vb][s8], St[kb][vb][s8 + 1]); w.y = cvtpk(St[kb][vb][s8 + 2], St[kb][vb][s8 + 3]);
                w.z = cvtpk(St[kb][vb][s8 + 4], St[kb][vb][s8 + 5]); w.w = cvtpk(St[kb][vb][s8 + 6], St[kb][vb][s8 + 7]); sf[ks][vb] = __builtin_bit_cast(a_bf16x8, w); }
#pragma unroll
        for (int kb = 0; kb < 2; ++kb)
#pragma unroll
            for (int vb = 0; vb < 2; ++vb) {
#pragma unroll
                for (int ks = 0; ks < 4; ++ks) Nw[kb][vb] = __builtin_amdgcn_mfma_f32_32x32x16_bf16(pf[kb][ks], sf[ks][vb], Nw[kb][vb], 0, 0, 0);
                St[kb][vb] = Nw[kb][vb]; }
    }
}

__device__ __forceinline__ void rwkv_out_item(ArgP A, int L, int b, int n, int h, int ct, int lane) {
    const int i = L >> 1, l15 = lane & 15, lg = lane >> 4;
    const bf16* P = (const bf16*)(A->ws + WS_P); bf16* XNb = (bf16*)(A->ws + WS_XN); const float* BON = (const float*)(A->ws + WS_BON);
    const bf16* item = (const bf16*)(A->ws + WS_RWI) + ((size_t)((b * 64 + n) * 8 + h)) * 16384;
    const bf16* RH = item; const bf16* Y0 = item + 4096; const bf16* ST = item + 8192;
    const size_t row = (size_t)b * T + 64 * n + 16 * ct + l15; const int tseq = 64 * n + 16 * ct + l15;
    const bf16x8_t rf0 = *(const GAS bf16x8_t*)(RH + (16 * ct + l15) * 64 + 8 * lg), rf1 = *(const GAS bf16x8_t*)(RH + (16 * ct + l15) * 64 + 32 + 8 * lg);
    f32x4 acc[4]; float s1 = 0.f;
#pragma unroll
    for (int it = 0; it < 4; ++it) {
        f32x4 a = ld4bf_g(Y0 + (16 * ct + l15) * 64 + 16 * it + 4 * lg);
        a = mfma16(*(const GAS bf16x8_t*)(ST + (16 * it + l15) * 64 + 8 * lg), rf0, a);
        a = mfma16(*(const GAS bf16x8_t*)(ST + (16 * it + l15) * 64 + 32 + 8 * lg), rf1, a);
        acc[it] = a; s1 += (a[0] + a[1]) + (a[2] + a[3]);
    }
    s1 += __shfl_xor(s1, 16); s1 += __shfl_xor(s1, 32);
    const float mean = s1 * (1.f / 64.f); float s2 = 0.f;
#pragma unroll
    for (int it = 0; it < 4; ++it) { acc[it] = acc[it] - mean; s2 += (acc[it][0] * acc[it][0] + acc[it][1] * acc[it][1]) + (acc[it][2] * acc[it][2] + acc[it][3] * acc[it][3]); }
    s2 += __shfl_xor(s2, 16); s2 += __shfl_xor(s2, 32);
    const float rs = frsq(s2 * (1.f / 64.f) + 64e-5f);
    const float bon = BON[row * 8 + h];
    const float* lnw = A->in[20] + i * 512 + 64 * h; const float* lnb = A->in[21] + i * 512 + 64 * h; const float* mu = A->in[7] + (size_t)i * 1536 + 1024 + 64 * h;
    const bf16* pr = P + row * NIN_E + PC_V + 64 * h;
#pragma unroll
    for (int it = 0; it < 4; ++it) { const int i0 = 16 * it + 4 * lg;
        const f32x4 w4 = *(const GAS f32x4*)(lnw + i0), b4 = *(const GAS f32x4*)(lnb + i0), m4 = *(const GAS f32x4*)(mu + i0);
        const f32x4 pv = ld4bf_g(pr + i0); const f32x4 pvp = tseq > 0 ? ld4bf_g(pr - NIN_E + i0) : (f32x4){0.f, 0.f, 0.f, 0.f};
        const f32x4 v4 = pv + (pvp - pv) * m4;
        bf16* gp = XNb + row * D + 64 * h + i0; const f32x4 g4 = ld4bf_g(gp);
        const f32x4 o = ((acc[it] * rs) * w4 + b4 + v4 * bon) * g4;
        *(GAS v2u*)gp = pack4(o); }
}
constexpr int N_STEPS = 37;
#ifndef MK_ONE_LAUNCH
#define MK_ONE_LAUNCH 1
#endif
__global__ void __launch_bounds__(NTHREADS, 2) hybrid_fwd(Args args) {
    extern __shared__ __attribute__((aligned(16))) unsigned char lds_raw[];
    LAS unsigned char* lds = (LAS unsigned char*)lds_raw;
    ArgP A0 = (ArgP)__builtin_amdgcn_kernarg_segment_ptr();
    { const int tid = threadIdx.x; for (int u = tid; u < (LDS_BYTES - LDSCTL_OFF) / 4; u += NTHREADS) ((LAS unsigned*)(lds + LDSCTL_OFF))[u] = 0u; }
    __syncthreads();
    const int lo = A0->lo, hi = A0->hi;
    if (hi - lo > 1) (void)xcd_barrier_post((unsigned*)(A0->ws + WS_CTL) + CW_BAR, (volatile LAS unsigned*)(lds + MISC_OFF) + 8);
#ifndef PHM
#define PHM 0xff
#endif
#define RUN(s) (lo <= (s) && (s) < hi)
#define EN(b) ((PHM >> (b)) & 1)
#define GRID_BARRIER() do { ArgP Ab_ = FRESH_ARGS(); XcdBarrier b_; b_.bar = (unsigned*)(Ab_->ws + WS_CTL) + CW_BAR; b_.x = xb_xcc_id(); b_.st = (volatile LAS unsigned*)(lds + MISC_OFF) + 8; xcd_barrier(b_); } while (0)
#define SEAM(s) do { if (RUN(s) && RUN((s) + 1)) GRID_BARRIER(); } while (0)
#define PHASE_VARS() ArgP A = FRESH_ARGS(); int L = Lq; FRESH_S(L); int tid = threadIdx.x; FRESH_V(tid); const int lane = tid & 63, wave = __builtin_amdgcn_readfirstlane(tid >> 6); int G = gridDim.x, bid = blockIdx.x; FRESH_S(G); FRESH_S(bid); (void)lane; (void)wave; (void)G; (void)A; (void)bid; \
    bf16* XN = (bf16*)(A->ws + WS_XN); bf16* PB = (bf16*)(A->ws + WS_P); (void)XN; (void)PB

    for (int Lq = 0; Lq < 4; ++Lq) {
        const int s0 = 9 * Lq; const bool even = !(Lq & 1);
        if (EN(0) && RUN(s0 + 0)) { PHASE_VARS(); const float* xin = (L == 0) ? A->in[0] : A->out; phase_convert_norm(A, L, xin, lds, wave, lane, G, bid); }
        SEAM(s0 + 0);
        if (EN(1) && RUN(s0 + 1)) {
            PHASE_VARS(); bf16* Win = (bf16*)(A->ws + WS_WIN);
            if (even) {
                pg8::Gemm g{XN, Win, M, NIN_E, D}; pg8::StaticOrderC<M, NIN_E> S; S.init(G, bid);
                pg8::EpiStoreBf16 E{PB, NIN_E, 0, 1.0f};
                pg8::gemm_phase<pg8::EpiStoreBf16, pg8::StaticOrderC<M, NIN_E>, PG8_ALIGN, PG8_SP2>(lds, g, S, E);
            } else {
                pg8::Gemm g{XN, Win, M, NIN_O, D}; pg8::StaticOrderC<M, NIN_O> S; S.init(G, bid);
                pg8::EpiStoreBf16 E{PB, NIN_O, 4, 0.125f * 1.4426950408889634f};
                pg8::gemm_phase<pg8::EpiStoreBf16, pg8::StaticOrderC<M, NIN_O>, PG8_ALIGN, PG8_SP2>(lds, g, S, E);
            }
        }
        SEAM(s0 + 1);
        if (even) {
            if (EN(2) && RUN(s0 + 2)) { PHASE_VARS(); phase_prep(A, L, lds, G, tid, bid);
#pragma unroll 1
                for (int it = bid; it < BATCH * 64 * 8; it += G) rwkv_chunk_item(A, L, it >> 9, (it >> 3) & 63, it & 7, lds, tid); }
            SEAM(s0 + 2);
            if (EN(3) && RUN(s0 + 3)) {
                PHASE_VARS();
                const int task = bid;
                if (task < 64) { if (wave == 0) rwkv_state_scan(A, task >> 3, task & 7, lane); }
                else if (task < 96) { if (wave < 2) gla_scan_half(A, (task - 64) >> 2, (task - 64) & 3, wave, (LAS float*)lds + wave * 192, lane); }
                __syncthreads();
                if (task >= 64 && task < 96) gla_norm_rows(A, L, (task - 64) >> 2, (task - 64) & 3, wave, lane);
            }
            SEAM(s0 + 3);
            if (EN(3) && RUN(s0 + 4)) {
                PHASE_VARS();
#pragma unroll 1
                for (int wt = bid * NWAVES + wave; wt < BATCH * 64 * 8 * 4; wt += G * NWAVES) { const int it = wt >> 2; rwkv_out_item(A, L, it >> 9, (it >> 3) & 63, it & 7, wt & 3, lane); }
            }
        } else {
            if (EN(4) && RUN(s0 + 3)) { PHASE_VARS(); attn_phase_mfma(A, L, lds, tid, G, bid); }
        }
        if (even ? (RUN(s0 + 4) && RUN(s0 + 5)) : (RUN(s0 + 3) && RUN(s0 + 5))) GRID_BARRIER();
        if (EN(5) && RUN(s0 + 5)) {
            PHASE_VARS(); bf16* Wout = (bf16*)(A->ws + WS_WOUT); const float* xin = (L == 0) ? A->in[0] : A->out;
            pg8::Gemm g{XN, Wout, M, D, D}; pg8::StaticOrderC<M, D> S; S.init(G, bid);
            pg8::EpiResF32 E{xin, A->out, D};
            pg8::gemm_phase<pg8::EpiResF32, pg8::StaticOrderC<M, D>, PG8_ALIGN, PG8_SP2>(lds, g, S, E);
        }
        SEAM(s0 + 5);
        if (RUN(s0 + 6)) {
            PHASE_VARS();
            const int gw = bid * NWAVES + wave, NGW = G * NWAVES; const float* gain = A->in[3] + (size_t)L * D;
            for (int m = gw; m < M; m += NGW) rms_row_bf16(A->out + (size_t)m * D, gain, XN + (size_t)m * D, lane);
        }
        SEAM(s0 + 6);
        if (EN(6) && RUN(s0 + 7)) {
            PHASE_VARS(); bf16* Wgu = (bf16*)(A->ws + WS_WGU);
            pg8::Gemm g{XN, Wgu, M, NGU, D}; pg8::StaticOrderC<M, NGU> S; S.init(G, bid);
            pg8::EpiSwiglu E{PB, FF};
            pg8::gemm_phase<pg8::EpiSwiglu, pg8::StaticOrderC<M, NGU>, PG8_ALIGN, PG8_SP2>(lds, g, S, E);
        }
        SEAM(s0 + 7);
        if (EN(7) && RUN(s0 + 8)) {
            PHASE_VARS(); bf16* Wdn = (bf16*)(A->ws + WS_WDN);
            pg8::Gemm g{PB, Wdn, M, D, FF}; pg8::StaticOrderC<M, D> S; S.init(G, bid);
            pg8::EpiResF32 E{A->out, A->out, D};
            pg8::gemm_phase<pg8::EpiResF32, pg8::StaticOrderC<M, D>, PG8_ALIGN, PG8_SP2>(lds, g, S, E);
        }
        SEAM(s0 + 8);
    }
    if (RUN(36)) {
        int Lq = 0; PHASE_VARS();
        const int gw = bid * NWAVES + wave, NGW = G * NWAVES;
        for (int m = gw; m < M; m += NGW) rms_row_f32(A->out + (size_t)m * D, A->in[4], A->out + (size_t)m * D, lane);
    }
#undef RUN
#undef SEAM
}

extern "C" void kernel_launch(void* const* d_in, const int* in_sizes, int n_in, void* d_out, int out_size, void* d_ws, size_t ws_size, hipStream_t stream) {
    static int grid = 0;
    if (grid == 0) {
        if (n_in != 36 || in_sizes[0] != M * D || out_size != M * D || ws_size < WS_END) { fprintf(stderr, "kernel_launch: unexpected shapes (n_in %d, in0 %d, out %d, ws %zu); nothing launched\n", n_in, n_in > 0 ? in_sizes[0] : -1, out_size, ws_size); grid = -1; return; }
        int dev = 0, cus = 0, per_cu = 0;
        if (hipGetDevice(&dev) != hipSuccess || hipDeviceGetAttribute(&cus, hipDeviceAttributeMultiprocessorCount, dev) != hipSuccess) { grid = -1; return; }
        if (hipFuncSetAttribute((const void*)hybrid_fwd, hipFuncAttributeMaxDynamicSharedMemorySize, LDS_BYTES) != hipSuccess) { fprintf(stderr, "kernel_launch: hipFuncSetAttribute failed\n"); grid = -1; return; }
        if (hipOccupancyMaxActiveBlocksPerMultiprocessor(&per_cu, (const void*)hybrid_fwd, NTHREADS, LDS_BYTES) != hipSuccess || per_cu < 1) fprintf(stderr, "kernel_launch: occupancy query reports %d\n", per_cu);
        (void)hipGetLastError();
        grid = cus;
    }
    if (grid < 0) return;
    if (hipMemsetAsync((char*)d_ws + WS_CTL, 0, CTL_ZERO_BYTES, stream) != hipSuccess) return;
    Args a{};
    for (int i = 0; i < 36; ++i) a.in[i] = (const float*)d_in[i];
    a.out = (float*)d_out; a.ws = (unsigned char*)d_ws;
#if MK_ONE_LAUNCH
    a.lo = 0; a.hi = N_STEPS;
    hipLaunchKernelGGL(hybrid_fwd, dim3(grid), dim3(NTHREADS), LDS_BYTES, stream, a);
#else
    for (int s = 0; s < N_STEPS; ++s) {
        if (s < 36 && ((s % 9) == 2 || (s % 9) == 4) && ((s / 9) & 1)) continue;
        a.lo = s; a.hi = s + 1;
        hipLaunchKernelGGL(hybrid_fwd, dim3(grid), dim3(NTHREADS), LDS_BYTES, stream, a);
    }
#endif
}
```

```cpp
#include <hip/hip_runtime.h>
#include <cstdio>
#include <cstdint>
__device__ __forceinline__ float silu_f(float x) { return x * __builtin_amdgcn_rcpf(1.0f + __builtin_amdgcn_exp2f(-1.4426950408889634f * x)); }
namespace pg8 {
#define PG8_LAS __attribute__((address_space(3)))
typedef unsigned short bf16_t;
typedef short bf16x8 __attribute__((ext_vector_type(8)));
typedef float f32x4 __attribute__((ext_vector_type(4)));
typedef unsigned u32x4 __attribute__((ext_vector_type(4)));
constexpr int BM = 256, BK = 64, HALF = 128, HTB = HALF * BK * 2  , STAGE_BYTES = 8 * HTB, NXCD = 8, WGM = 8;

__host__ __device__ __forceinline__ int lds_byte(int r, int c) { const int st = (r >> 4) * 2 + (c >> 5), rr = r & 15, cc = c & 31, ob = rr * 64 + cc * 2; return st * 1024 + (ob ^ (((ob >> 9) & 1) << 5)); }
__host__ __device__ __forceinline__ void stage_rc(int b, int& R, int& C) { const int st = b / 1024, sb = b % 1024, swz = sb ^ (((sb >> 9) & 1) << 5); R = (st >> 1) * 16 + swz / 64; C = (st & 1) * 32 + (swz % 64) / 2; }
__host__ __device__ __forceinline__ int perm32(int rho) { const int n = rho >> 4, i = rho & 15; return 8 * (i >> 2) + 4 * n + (i & 3); }

struct Unit { int pm, pn; };
struct Gemm { const bf16_t* A; const bf16_t* Bt; int M, N, K; };

struct StaticOrder {
    int nM, nN, nwg, G, c;
    __host__ __device__ void init(int M, int N, int G_, int c_) { nM = M / BM; nN = N / BM; nwg = nM * nN; G = G_; c = c_; }
    __host__ __device__ bool next(int i, Unit& u) const {
        const long L = (long)i * G + c; if (L >= nwg) return false;
        int wgid = (int)L; { const int q = nwg / NXCD, r = nwg % NXCD, xcd = wgid % NXCD, off = wgid / NXCD; wgid = (xcd < r ? xcd * (q + 1) : r * (q + 1) + (xcd - r) * q) + off; }
        const int nig = WGM * nN, gid = wgid / nig, fm = gid * WGM, gsz = (nM - fm) < WGM ? (nM - fm) : WGM;
        u.pm = fm + ((wgid % nig) % gsz); u.pn = (wgid % nig) / gsz; return true;
    }
    __device__ __forceinline__ void a_ready(const Unit&) const {}
    __device__ __forceinline__ void done(const Unit&) const {}
};

__device__ __forceinline__ unsigned cvt_pk_bf16(float lo, float hi) { unsigned r; asm volatile("v_cvt_pk_bf16_f32 %0, %1, %2" : "=v"(r) : "v"(lo), "v"(hi)); return r; }
typedef float f32x2 __attribute__((ext_vector_type(2)));
struct EpiStoreBf16 {
    static constexpr bool PERM = true, AFTER_DRAIN = false;
    bf16_t* O; int ldc; int qtiles; float qscale;
    __device__ __forceinline__ void operator()(const f32x4 (&acc)[2][2][4][2], const Unit& u, int wr, int wc, int fr, int fq) const {
        const int row0 = u.pm * BM + wr * 64 + fr, col0 = u.pn * BM + wc * 32 + 8 * fq;
        const float sc = u.pn < qtiles ? qscale : 1.0f;
#pragma unroll
        for (int ai = 0; ai < 2; ++ai)
#pragma unroll
            for (int m = 0; m < 4; ++m) { bf16_t* rowp = O + (size_t)(row0 + ai * HALF + m * 16) * ldc + col0;
#pragma unroll
                for (int bj = 0; bj < 2; ++bj) { const f32x4 v0 = acc[ai][bj][m][0] * sc, v1 = acc[ai][bj][m][1] * sc;
                    u32x4 w; w.x = cvt_pk_bf16(v0[0], v0[1]); w.y = cvt_pk_bf16(v0[2], v0[3]); w.z = cvt_pk_bf16(v1[0], v1[1]); w.w = cvt_pk_bf16(v1[2], v1[3]);
                    *(u32x4*)(rowp + bj * HALF) = w; } }
    }
};
struct EpiResF32 {
    static constexpr bool PERM = false, AFTER_DRAIN = false;
    const float* base; float* out; int ldc;
    __device__ __forceinline__ void operator()(const f32x4 (&acc)[2][2][4][2], const Unit& u, int wr, int wc, int fr, int fq) const {
        const int row0 = u.pm * BM + wr * 64 + fr, col0 = u.pn * BM + wc * 32 + 4 * fq;
#pragma unroll
        for (int ai = 0; ai < 2; ++ai)
#pragma unroll
            for (int m = 0; m < 4; ++m) { const size_t off = (size_t)(row0 + ai * HALF + m * 16) * ldc + col0;
#pragma unroll
                for (int bj = 0; bj < 2; ++bj)
#pragma unroll
                    for (int n = 0; n < 2; ++n) { const f32x4 b = *(const f32x4*)(base + off + bj * HALF + n * 16); *(f32x4*)(out + off + bj * HALF + n * 16) = b + acc[ai][bj][m][n]; }
                asm volatile("" ::: "memory"); }
    }
};
struct EpiSwiglu {
    static constexpr bool PERM = true, AFTER_DRAIN = false;
    bf16_t* H; int ldc;
    __device__ __forceinline__ void operator()(const f32x4 (&acc)[2][2][4][2], const Unit& u, int wr, int wc, int fr, int fq) const {
        const int row0 = u.pm * BM + wr * 64 + fr, colh = u.pn * HALF + wc * 32 + 8 * fq;
#pragma unroll
        for (int ai = 0; ai < 2; ++ai)
#pragma unroll
            for (int m = 0; m < 4; ++m) { bf16_t* rowp = H + (size_t)(row0 + ai * HALF + m * 16) * ldc + colh;
                const f32x4 g0 = acc[ai][0][m][0], g1 = acc[ai][0][m][1], u0 = acc[ai][1][m][0], u1 = acc[ai][1][m][1];
                float h[8];
#pragma unroll
                for (int e = 0; e < 4; ++e) { h[e] = silu_f(g0[e]) * u0[e]; h[4 + e] = silu_f(g1[e]) * u1[e]; }
                u32x4 w; w.x = cvt_pk_bf16(h[0], h[1]); w.y = cvt_pk_bf16(h[2], h[3]); w.z = cvt_pk_bf16(h[4], h[5]); w.w = cvt_pk_bf16(h[6], h[7]);
                *(u32x4*)rowp = w; }
    }
};
template <int M_, int N_> struct StaticOrderC {
    static constexpr int nM = M_ / BM, nN = N_ / BM, nwg = nM * nN;
    int G, c;
    __device__ __forceinline__ void init(int G_, int c_) { G = G_; c = c_; }
    __device__ __forceinline__ bool next(int i, Unit& u) const {
        const int L = i * G + c; if (L >= nwg) return false;
        int wgid = L; { constexpr int q = nwg / NXCD, r = nwg % NXCD; const int xcd = wgid % NXCD, off = wgid / NXCD; wgid = (xcd < r ? xcd * (q + 1) : r * (q + 1) + (xcd - r) * q) + off; }
        constexpr int nig = WGM * nN; const int gid = wgid / nig, fm = gid * WGM, gsz = (nM - fm) < WGM ? (nM - fm) : WGM;
        u.pm = fm + ((wgid % nig) % gsz); u.pn = (wgid % nig) / gsz; return true;
    }
    __device__ __forceinline__ void a_ready(const Unit&) const {}
    __device__ __forceinline__ void done(const Unit&) const {}
};
template <class Epi, class Sched, bool ALIGN_EPI = false, bool SP2 = false>
__device__ __forceinline__ void gemm_phase(PG8_LAS unsigned char* lds, const Gemm g, const Sched& S, const Epi& E) {
    int tid_ = threadIdx.x; asm volatile("" : "+v"(tid_));
    float zz_ = 0.f; asm volatile("" : "+v"(zz_));
    const int tid = tid_, wid = __builtin_amdgcn_readfirstlane(tid >> 6), lane = tid & 63, wr = wid >> 2, wc = wid & 3, fr = lane & 15, fq = lane >> 4;
    const int K = g.K, nt = K / BK;
    unsigned voffA[2], voffB[2];
#pragma unroll
    for (int i = 0; i < 2; ++i) { int R, C; stage_rc(tid * 16 + i * 8192, R, C); const int Rb = Epi::PERM ? ((R & ~31) + perm32(R & 31)) : R;
        voffA[i] = (unsigned)(R * K + C) * 2u; voffB[i] = (unsigned)(Rb * K + C) * 2u; }
    const size_t kstep = (size_t)(BK * 2);
    const size_t hstep = (size_t)HALF * K * 2;
    const size_t tstep = 2 * hstep;
    const unsigned ldsw = (unsigned)wid * 1024u;
    const int aoff = lds_byte(wr * 64 + fr, fq * 8), boff = lds_byte(wc * 32 + fr, fq * 8);
#define PG8_SA(b, h) (((b) * 2 + (h)) * HTB)
#define PG8_SB(b, h) ((4 + (b) * 2 + (h)) * HTB)
#define PG8_STAGE(bufoff, gbase, voff) do { _Pragma("unroll") for (int _i = 0; _i < 2; ++_i) \
        __builtin_amdgcn_global_load_lds((const unsigned*)((const char*)(gbase) + (voff)[_i]), (PG8_LAS unsigned*)(lds + (bufoff) + ldsw + _i * 8192), 16, 0, 0); } while (0)
#define PG8_LDA(dst, b, h) do { _Pragma("unroll") for (int m = 0; m < 4; ++m) _Pragma("unroll") for (int k = 0; k < 2; ++k) dst[m][k] = *(const PG8_LAS bf16x8*)(lds + PG8_SA(b, h) + aoff + m * 2048 + k * 1024); } while (0)
#define PG8_LDB(dst, b, h) do { _Pragma("unroll") for (int n = 0; n < 2; ++n) _Pragma("unroll") for (int k = 0; k < 2; ++k) dst[n][k] = *(const PG8_LAS bf16x8*)(lds + PG8_SB(b, h) + boff + n * 2048 + k * 1024); } while (0)
#define PG8_MMA(ai, bj, At, Bt) do { __builtin_amdgcn_s_setprio(1); _Pragma("unroll") for (int m = 0; m < 4; ++m) _Pragma("unroll") for (int n = 0; n < 2; ++n) _Pragma("unroll") for (int k = 0; k < 2; ++k) \
        acc[ai][bj][m][n] = __builtin_amdgcn_mfma_f32_16x16x32_bf16(Bt[n][k], At[m][k], acc[ai][bj][m][n], 0, 0, 0); __builtin_amdgcn_s_setprio(0); } while (0)
#define PG8_WAIT_V(n) asm volatile("s_waitcnt vmcnt(" #n ")" ::: "memory")
#define PG8_WAIT_L(n) asm volatile("s_waitcnt lgkmcnt(" #n ")" ::: "memory")
#define PG8_BAR __builtin_amdgcn_s_barrier()
#define PG8_SCHED __builtin_amdgcn_sched_barrier(0)
    Unit cur, nxt; int ui = 0;
    if (!S.next(0, cur)) return;
    f32x4 acc[2][2][4][2];
#pragma unroll
    for (int a = 0; a < 2; ++a)
#pragma unroll
        for (int b = 0; b < 2; ++b)
#pragma unroll
            for (int m = 0; m < 4; ++m)
#pragma unroll
                for (int n = 0; n < 2; ++n) acc[a][b][m][n] = (f32x4){zz_, zz_, zz_, zz_};
    bf16x8 At[4][2], B0[2][2], B1[2][2];
    const char* cA = (const char*)g.A + (size_t)cur.pm * tstep; const char* cB = (const char*)g.Bt + (size_t)cur.pn * tstep;
    S.a_ready(cur);
    if constexpr (SP2) {
        PG8_STAGE(PG8_SB(0, 0), cB, voffB); PG8_STAGE(PG8_SB(0, 1), cB + hstep, voffB); PG8_STAGE(PG8_SA(0, 0), cA, voffA); PG8_STAGE(PG8_SA(0, 1), cA + hstep, voffA);
        if (wr == 1) PG8_BAR;
        PG8_WAIT_V(2); PG8_BAR;
        PG8_STAGE(PG8_SB(1, 0), cB + kstep, voffB); PG8_STAGE(PG8_SA(1, 0), cA + kstep, voffA); PG8_STAGE(PG8_SB(1, 1), cB + hstep + kstep, voffB);
        PG8_WAIT_V(6); PG8_BAR;
    } else {
        PG8_STAGE(PG8_SB(0, 0), cB, voffB); PG8_STAGE(PG8_SA(0, 0), cA, voffA); PG8_STAGE(PG8_SB(0, 1), cB + hstep, voffB); PG8_STAGE(PG8_SA(0, 1), cA + hstep, voffA);
        if (wr == 1) PG8_BAR;
        PG8_WAIT_V(4); PG8_BAR;
        PG8_STAGE(PG8_SB(1, 0), cB + kstep, voffB); PG8_STAGE(PG8_SA(1, 0), cA + kstep, voffA); PG8_STAGE(PG8_SB(1, 1), cB + hstep + kstep, voffB);
        PG8_WAIT_V(6); PG8_BAR;
    }
    for (;;) {
        const bool has_next = S.next(ui + 1, nxt);
        const char* nA = has_next ? (const char*)g.A + (size_t)nxt.pm * tstep : cA; const char* nB = has_next ? (const char*)g.Bt + (size_t)nxt.pn * tstep : cB;
        for (int t = 0; t < nt; t += 2) {
            const bool last = (t == nt - 2);
            const char* a1 = cA + (size_t)(t + 1) * kstep;
            const char* a2 = last ? nA : cA + (size_t)(t + 2) * kstep; const char* b2 = last ? nB : cB + (size_t)(t + 2) * kstep;
            const char* a3 = a2 + kstep; const char* b3 = b2 + kstep;
            if (last && has_next) S.a_ready(nxt);
            if constexpr (SP2) {
            PG8_LDB(B0, 0, 0); PG8_LDB(B1, 0, 1); PG8_SCHED; PG8_LDA(At, 0, 0); PG8_STAGE(PG8_SA(1, 1), a1 + hstep, voffA);
            PG8_WAIT_V(8); PG8_WAIT_L(0); PG8_BAR; PG8_MMA(0, 0, At, B0); PG8_MMA(0, 1, At, B1); PG8_BAR; PG8_SCHED;
            PG8_LDA(At, 0, 1); PG8_STAGE(PG8_SB(0, 0), b2, voffB); PG8_STAGE(PG8_SB(0, 1), b2 + hstep, voffB); PG8_STAGE(PG8_SA(0, 0), a2, voffA);
            PG8_WAIT_V(8); PG8_WAIT_L(0); PG8_BAR; PG8_MMA(1, 0, At, B0); PG8_MMA(1, 1, At, B1); PG8_BAR; PG8_SCHED;
            PG8_LDB(B0, 1, 0); PG8_LDB(B1, 1, 1); PG8_SCHED; PG8_LDA(At, 1, 0); PG8_STAGE(PG8_SA(0, 1), a2 + hstep, voffA);
            PG8_WAIT_V(8); PG8_WAIT_L(0); PG8_BAR; PG8_MMA(0, 0, At, B0); PG8_MMA(0, 1, At, B1); PG8_BAR; PG8_SCHED;
            PG8_LDA(At, 1, 1); PG8_STAGE(PG8_SB(1, 0), b3, voffB); PG8_STAGE(PG8_SB(1, 1), b3 + hstep, voffB); PG8_STAGE(PG8_SA(1, 0), a3, voffA);
            PG8_WAIT_V(8); PG8_WAIT_L(0); PG8_BAR; PG8_MMA(1, 0, At, B0); PG8_MMA(1, 1, At, B1); PG8_BAR; PG8_SCHED;
            } else {
            PG8_LDB(B0, 0, 0); PG8_SCHED; PG8_LDA(At, 0, 0); PG8_STAGE(PG8_SA(1, 1), a1 + hstep, voffA);
            PG8_WAIT_L(8); PG8_BAR; PG8_WAIT_L(0); PG8_MMA(0, 0, At, B0); PG8_BAR; PG8_SCHED;
            PG8_LDB(B1, 0, 1); PG8_STAGE(PG8_SB(0, 0), b2, voffB);
            PG8_BAR; PG8_WAIT_L(0); PG8_MMA(0, 1, At, B1); PG8_BAR;
            PG8_LDA(At, 0, 1); PG8_STAGE(PG8_SA(0, 0), a2, voffA);
            PG8_BAR; PG8_WAIT_L(0); PG8_MMA(1, 0, At, B0); PG8_BAR; PG8_SCHED;
            PG8_STAGE(PG8_SB(0, 1), b2 + hstep, voffB);
            PG8_WAIT_V(6); PG8_BAR; PG8_MMA(1, 1, At, B1); PG8_BAR;
            PG8_LDB(B0, 1, 0); PG8_SCHED; PG8_LDA(At, 1, 0); PG8_STAGE(PG8_SA(0, 1), a2 + hstep, voffA);
            PG8_WAIT_L(8); PG8_BAR; PG8_WAIT_L(0); PG8_MMA(0, 0, At, B0); PG8_BAR; PG8_SCHED;
            PG8_LDB(B1, 1, 1); PG8_STAGE(PG8_SB(1, 0), b3, voffB);
            PG8_BAR; PG8_WAIT_L(0); PG8_MMA(0, 1, At, B1); PG8_BAR;
            PG8_LDA(At, 1, 1); PG8_STAGE(PG8_SA(1, 0), a3, voffA);
            PG8_BAR; PG8_WAIT_L(0); PG8_MMA(1, 0, At, B0); PG8_BAR; PG8_SCHED;
            PG8_STAGE(PG8_SB(1, 1), b3 + hstep, voffB);
            PG8_WAIT_V(6); PG8_BAR; PG8_MMA(1, 1, At, B1); PG8_BAR;
            }
        }
        if constexpr (ALIGN_EPI) { if (wr == 0) PG8_BAR; }
        if constexpr (!Epi::AFTER_DRAIN) { E(acc, cur, wr, wc, fr, fq); S.done(cur); }
        if (!has_next) break;
#pragma unroll
        for (int a = 0; a < 2; ++a)
#pragma unroll
            for (int b = 0; b < 2; ++b)
#pragma unroll
                for (int m = 0; m < 4; ++m)
#pragma unroll
                    for (int n = 0; n < 2; ++n) acc[a][b][m][n] = (f32x4){zz_, zz_, zz_, zz_};
        cur = nxt; cA = nA; cB = nB; ++ui;
        if constexpr (ALIGN_EPI) { if (wr == 1) PG8_BAR; }
    }
    PG8_WAIT_V(0);
    if constexpr (!ALIGN_EPI) { if (wr == 0) PG8_BAR; }
    PG8_BAR;
    if constexpr (Epi::AFTER_DRAIN) { E.fused(acc, cur, wr, wc, fr, fq, lds, wid, lane); S.done(cur); }
#undef PG8_SA
#undef PG8_SB
#undef PG8_STAGE
#undef PG8_LDA
#undef PG8_LDB
#undef PG8_MMA
#undef PG8_WAIT_V
#undef PG8_WAIT_L
#undef PG8_BAR
#undef PG8_SCHED
}
}
#ifndef PG8_SP2
#define PG8_SP2 true
#endif
#ifndef PG8_ALIGN
#define PG8_ALIGN true
#endif
constexpr int NWAVES = 8, NTHREADS = NWAVES * 64;
constexpr int BATCH = 8, T = 4096, D = 1024, M = BATCH * T;
constexpr int NIN_E = 3840, NIN_O = 3072, FF = 2816, NGU = 2 * FF;
constexpr int PC_R = 0, PC_K = 512, PC_V = 1024, PC_GQ = 1536, PC_GK = 1792, PC_GV = 2048, PC_GG = 2560;
constexpr int PC_W1A = 3072, PC_W1B = 3136, PC_A1A = 3200, PC_A1B = 3264, PC_G1A = 3328, PC_G1B = 3488, PC_WA1 = 3648, PC_PAD = 3664;
constexpr int NLORA = 304;
constexpr size_t MiB = 1u << 20;
constexpr size_t WS_CTL = 0, CTL_ZERO_BYTES = 1 * MiB;
constexpr size_t WS_WIN = 2 * MiB, WS_WOUT = 10 * MiB, WS_WGU = 12 * MiB, WS_WDN = 23 * MiB;
constexpr size_t WS_W2T = 29 * MiB, WS_A2T = WS_W2T + 65536, WS_G2T = WS_A2T + 65536, WS_WA2T = WS_G2T + 196608;
constexpr size_t WS_XN = 32 * MiB;
constexpr size_t WS_P = 96 * MiB;
constexpr size_t WS_WLOG = 336 * MiB;
constexpr size_t WS_ASIG = 400 * MiB;
constexpr size_t WS_LA = 464 * MiB;
constexpr size_t WS_END = 496 * MiB;
constexpr int CW_BAR = 4096;
constexpr int RING_BYTES = 135168, LDSCTL_OFF = RING_BYTES, MISC_OFF = LDSCTL_OFF + 320, LDS_BYTES = 147456;

#define GAS __attribute__((address_space(1)))
#define LAS __attribute__((address_space(3)))
typedef unsigned short bf16;
typedef unsigned v4u __attribute__((ext_vector_type(4)));
typedef unsigned v2u __attribute__((ext_vector_type(2)));
typedef float f32x4 __attribute__((ext_vector_type(4)));
#define LDS_WAIT() asm volatile("s_waitcnt lgkmcnt(0)" ::: "memory")
#define VM_WAIT() asm volatile("s_waitcnt vmcnt(0)" ::: "memory")
__device__ __forceinline__ unsigned f2bf(float f) { unsigned u = __builtin_bit_cast(unsigned, f); return (u + 0x7fffu + ((u >> 16) & 1u)) >> 16; }
__device__ __forceinline__ unsigned pk2(float lo, float hi) { return f2bf(lo) | (f2bf(hi) << 16); }
__device__ __forceinline__ float bf2f(bf16 u) { return __builtin_bit_cast(float, (unsigned)u << 16); }
__device__ __forceinline__ float bflo(unsigned w) { return __builtin_bit_cast(float, w << 16); }
__device__ __forceinline__ float bfhi(unsigned w) { return __builtin_bit_cast(float, w & 0xffff0000u); }
__device__ __forceinline__ float wave_sum(float v) {
#pragma unroll
    for (int o = 1; o < 64; o <<= 1) v += __shfl_xor(v, o);
    return v;
}
__device__ __forceinline__ float wave_max(float v) {
#pragma unroll
    for (int o = 1; o < 64; o <<= 1) v = fmaxf(v, __shfl_xor(v, o));
    return v;
}
__device__ __forceinline__ float fexp(float x) { return __builtin_amdgcn_exp2f(x * 1.4426950408889634f); }
__device__ __forceinline__ float flog(float x) { return __builtin_amdgcn_logf(x) * 0.6931471805599453f; }
__device__ __forceinline__ float frcp(float x) { return __builtin_amdgcn_rcpf(x); }
__device__ __forceinline__ float frsq(float x) { return __builtin_amdgcn_rsqf(x); }
__device__ __forceinline__ float fsqrt(float x) { return __builtin_amdgcn_sqrtf(x); }
__device__ __forceinline__ float sigmoid_f(float x) { return frcp(1.0f + fexp(-x)); }
__device__ __forceinline__ float softplus_f(float x) { return fmaxf(x, 0.f) + flog(1.0f + fexp(-fabsf(x))); }
__device__ __forceinline__ float tanh_f(float x) { return 1.0f - 2.0f * frcp(1.0f + fexp(2.0f * x)); }
#define XB_TMO      128
#define XB_XCNT(j)  (256  + 64 * (j))
#define XB_XSUB(j)  (1280 + 64 * (j))
#define XB_XGEN(j)  (2304 + 64 * (j))
#define XB_TOP      3328
#define XB_TOPGEN   3392
#define XCD_BAR_WORDS 3456
#define XB_SPIN_CAP (1u << 23)

__device__ __forceinline__ unsigned xb_ld(unsigned* p)              { return __hip_atomic_load(p, __ATOMIC_RELAXED, __HIP_MEMORY_SCOPE_AGENT); }
__device__ __forceinline__ unsigned xb_add(unsigned* p, unsigned v) { return __hip_atomic_fetch_add(p, v, __ATOMIC_RELAXED, __HIP_MEMORY_SCOPE_AGENT); }
__device__ __forceinline__ unsigned xb_xcc_id() { return (unsigned)__builtin_amdgcn_s_getreg((3 << 11) | 20) & 0xFu; }
#define XB_SPIN(cond, bar) do { unsigned _sp = 0; while (cond) { __builtin_amdgcn_s_sleep(1); \
    if ((++_sp & 255u) == 0u) { if (xb_ld(&(bar)[XB_TMO])) break; if (_sp > XB_SPIN_CAP) { atomicAdd(&(bar)[XB_TMO], 1u); break; } } } } while (0)

struct XcdBarrier {
    unsigned* bar; unsigned x;
    volatile LAS unsigned* st;
};

__device__ __forceinline__ XcdBarrier xcd_barrier_post(unsigned* bar, volatile LAS unsigned* st) {
    XcdBarrier b; b.bar = bar; b.x = xb_xcc_id(); b.st = st;
    if (threadIdx.x == 0) (void)xb_add(&bar[XB_XCNT(b.x)], 1u);
    return b;
}
__device__ __forceinline__ void xcd_barrier_complete(unsigned* bar, unsigned x, unsigned& nloc, unsigned& nx) {
    const unsigned G = gridDim.x * gridDim.y * gridDim.z;
    unsigned sum, cnt, mine, sp = 0u;
    for (;;) {
        sum = 0u; cnt = 0u; mine = 0u;
#pragma unroll
        for (unsigned j = 0; j < 16; ++j) { const unsigned c = xb_ld(&bar[XB_XCNT(j)]); sum += c; cnt += (c > 0u) ? 1u : 0u; mine = (j == x) ? c : mine; }
        if (sum == G) break;
        __builtin_amdgcn_s_sleep(1);
        if ((++sp & 255u) == 0u) { if (xb_ld(&bar[XB_TMO])) break; if (sp > XB_SPIN_CAP) { atomicAdd(&bar[XB_TMO], 1u); break; } }
    }
    nloc = mine > 0u ? mine : 1u; nx = cnt > 0u ? cnt : 1u;
}

__device__ __forceinline__ void xcd_barrier(const XcdBarrier& b) {
    asm volatile("s_waitcnt vmcnt(0)" ::: "memory");
    __syncthreads();
    if (threadIdx.x == 0) {
        unsigned blo_ = __builtin_amdgcn_readfirstlane((unsigned)(unsigned long long)b.bar), bhi_ = __builtin_amdgcn_readfirstlane((unsigned)((unsigned long long)b.bar >> 32)), bx = __builtin_amdgcn_readfirstlane(b.x); asm volatile("" : "+s"(blo_), "+s"(bhi_), "+s"(bx)); unsigned* bar = (unsigned*)(((unsigned long long)bhi_ << 32) | blo_);
        __builtin_amdgcn_s_waitcnt(0);
        unsigned nloc = b.st[0], nx = b.st[1];
        if (nloc == 0u) { xcd_barrier_complete(bar, bx, nloc, nx); b.st[0] = nloc; b.st[1] = nx; }
        const unsigned old = xb_add(&bar[XB_XSUB(bx)], 1u);
        const unsigned gen = old / nloc;
        if (old + 1u == (gen + 1u) * nloc) {
            __builtin_amdgcn_fence(__ATOMIC_RELEASE, "agent");
            asm volatile("s_waitcnt vmcnt(0)" ::: "memory");
            const unsigned og = xb_add(&bar[XB_TOP], 1u);
            const unsigned tg = og / nx;
            if (og + 1u == (tg + 1u) * nx) xb_add(&bar[XB_TOPGEN], 1u);
            else XB_SPIN(xb_ld(&bar[XB_TOPGEN]) == tg, bar);
            __builtin_amdgcn_fence(__ATOMIC_ACQUIRE, "agent");
            xb_add(&bar[XB_XGEN(bx)], 1u);
            asm volatile("s_waitcnt vmcnt(0)" ::: "memory");
        } else {
            XB_SPIN(xb_ld(&bar[XB_XGEN(bx)]) == gen, bar);
            __builtin_amdgcn_fence(__ATOMIC_ACQUIRE, "agent");
            asm volatile("s_waitcnt vmcnt(0)" ::: "memory");
        }
    }
    __syncthreads();
}
__device__ __forceinline__ void tr_item(const float* __restrict__ W, int Kreal, int N, bf16* WT, int ldd, int dst_row0, LAS float* scr, int k0, int n0, int lane,
                                        const float* __restrict__ mu, float sc0, float sc1) {
    const int nn = n0 + (lane & 31); const bool nv = nn < N;
#pragma unroll 8
    for (int i = 0; i < 32; ++i) { const int kk = 2 * i + (lane >> 5); float v = (nv && k0 + kk < Kreal) ? W[(size_t)(k0 + kk) * N + nn] : 0.f; if (mu) v *= sc0 + sc1 * mu[k0 + kk]; scr[kk * 33 + (lane & 31)] = v; }
    LDS_WAIT(); asm volatile("" ::: "memory");
    const int c = lane & 7;
#pragma unroll
    for (int j = 0; j < 4; ++j) { const int n = (lane >> 3) + 8 * j; const LAS float* s = scr + (8 * c) * 33 + n;
        v4u o; o.x = pk2(s[0 * 33], s[1 * 33]); o.y = pk2(s[2 * 33], s[3 * 33]); o.z = pk2(s[4 * 33], s[5 * 33]); o.w = pk2(s[6 * 33], s[7 * 33]);
        if (n0 + n < N) *(GAS v4u*)(WT + (size_t)(dst_row0 + n) * ldd + k0 + 8 * c) = o; }
    LDS_WAIT(); asm volatile("" ::: "memory");
}
__device__ __forceinline__ void rms_row_bf16(const float* xrow, const float* g, bf16* orow, int lane) {
    const GAS f32x4* xr = (const GAS f32x4*)xrow + lane; const GAS f32x4* gr = (const GAS f32x4*)g + lane;
    f32x4 v[4]; float s = 0.f;
#pragma unroll
    for (int j = 0; j < 4; ++j) { v[j] = xr[64 * j]; s += (v[j].x * v[j].x + v[j].y * v[j].y) + (v[j].z * v[j].z + v[j].w * v[j].w); }
    const float rs = frsq(wave_sum(s) * (1.f / D) + 1e-6f);
    GAS v2u* o8 = (GAS v2u*)orow + lane;
#pragma unroll
    for (int j = 0; j < 4; ++j) { const f32x4 gv = gr[64 * j]; v2u o; o.x = pk2(v[j].x * rs * gv.x, v[j].y * rs * gv.y); o.y = pk2(v[j].z * rs * gv.z, v[j].w * rs * gv.w); o8[64 * j] = o; }
}
__device__ __forceinline__ void rms_row_f32(const float* xrow, const float* g, float* orow, int lane) {
    const GAS f32x4* xr = (const GAS f32x4*)xrow + lane; const GAS f32x4* gr = (const GAS f32x4*)g + lane;
    f32x4 v[4]; float s = 0.f;
#pragma unroll
    for (int j = 0; j < 4; ++j) { v[j] = xr[64 * j]; s += (v[j].x * v[j].x + v[j].y * v[j].y) + (v[j].z * v[j].z + v[j].w * v[j].w); }
    const float rs = frsq(wave_sum(s) * (1.f / D) + 1e-6f);
    GAS f32x4* o = (GAS f32x4*)orow + lane;
#pragma unroll
    for (int j = 0; j < 4; ++j) { const f32x4 gv = gr[64 * j]; o[64 * j] = v[j] * rs * gv; }
}

struct Args { const float* in[36]; float* out; unsigned char* ws; int lo, hi; };
typedef const __attribute__((address_space(4))) Args* ArgP;
#define FRESH_ARGS() ({ ArgP p_ = (ArgP)__builtin_amdgcn_kernarg_segment_ptr(); asm volatile("" : "+s"(p_)); p_; })
#define FRESH_V(x) asm volatile("" : "+v"(x))
#define FRESH_S(x) asm volatile("" : "+s"(x))

__device__ __forceinline__ void phase_convert_norm(ArgP A, int L, const float* xin, LAS unsigned char* lds, int wave, int lane, int G, int bid) {
    const int i = L >> 1; const bool even = !(L & 1);
    bf16* Win = (bf16*)(A->ws + WS_WIN); bf16* Wout = (bf16*)(A->ws + WS_WOUT); bf16* Wgu = (bf16*)(A->ws + WS_WGU); bf16* Wdn = (bf16*)(A->ws + WS_WDN);
    LAS float* scr = (LAS float*)(lds + wave * 16384);
    const int gw = bid * NWAVES + wave, NGW = G * NWAVES;
    const float* w_in = even ? A->in[5] + (size_t)i * D * 3072 : A->in[26] + (size_t)i * D * 3072;
    const float* w_out = even ? A->in[6] + (size_t)i * D * D : A->in[27] + (size_t)i * D * D;
    const float* mu_w = A->in[8] + (size_t)i * 3 * D, *mu_a = mu_w + D, *mu_g = mu_w + 2 * D;
    const float* w1 = A->in[10] + (size_t)i * D * 64, *a1 = A->in[13] + (size_t)i * D * 64, *g1 = A->in[15] + (size_t)i * D * 160, *wa1 = A->in[22] + (size_t)i * D * 16;
    const float* wg = A->in[33] + (size_t)L * D * FF, *wu = A->in[34] + (size_t)L * D * FF, *wd = A->in[35] + (size_t)L * FF * D;
    const int I_IN = 16 * 96, I_L64 = 16 * 2, I_L160 = 16 * 5, I_L16 = 16 * 1, I_OUT = 16 * 32, I_GU = 16 * 88, I_DN = 44 * 32;
    const int n_lora = even ? (4 * I_L64 + 2 * I_L160 + I_L16 + 16 + 16 + 48) : 0;
    const float* w2s = A->in[11] + (size_t)i * 64 * 512, *a2s = A->in[14] + (size_t)i * 64 * 512, *g2s = A->in[16] + (size_t)i * 160 * 512;
    bf16* W2T = (bf16*)(A->ws + WS_W2T); bf16* A2T = (bf16*)(A->ws + WS_A2T); bf16* G2T = (bf16*)(A->ws + WS_G2T);
    const int NITEMS = I_IN + n_lora + I_OUT + 2 * I_GU + I_DN;
#define TR_JOB(items, nblk, Wp, Kd, Nd, DST, LDD, ROW0, MU, S0, S1) if (r < (items)) { const int kb = r / (nblk), nb = r % (nblk), n0 = 32 * nb; tr_item(Wp, Kd, Nd, DST, LDD, ROW0, scr, 64 * kb, n0, lane, MU, S0, S1); continue; } r -= (items);
    for (int it = gw; it < NITEMS; it += NGW) {
        int r = it;
        TR_JOB(I_IN, 96, w_in, D, 3072, Win, D, n0, nullptr, 1.f, 0.f)
        if (even) {
            TR_JOB(I_L64, 2, w1, D, 64, Win, D, PC_W1A + n0, mu_w, 1.f, -1.f)
            TR_JOB(I_L64, 2, w1, D, 64, Win, D, PC_W1B + n0, mu_w, 0.f, 1.f)
            TR_JOB(I_L64, 2, a1, D, 64, Win, D, PC_A1A + n0, mu_a, 1.f, -1.f)
            TR_JOB(I_L64, 2, a1, D, 64, Win, D, PC_A1B + n0, mu_a, 0.f, 1.f)
            TR_JOB(I_L160, 5, g1, D, 160, Win, D, PC_G1A + n0, mu_g, 1.f, -1.f)
            TR_JOB(I_L160, 5, g1, D, 160, Win, D, PC_G1B + n0, mu_g, 0.f, 1.f)
            TR_JOB(I_L16, 1, wa1, D, 16, Win, D, PC_WA1 + n0, nullptr, 1.f, 0.f)
            TR_JOB(16, 16, w2s, 64, 512, W2T, 64, n0, nullptr, 1.f, 0.f)
            TR_JOB(16, 16, a2s, 64, 512, A2T, 64, n0, nullptr, 1.f, 0.f)
            TR_JOB(48, 16, g2s, 160, 512, G2T, 192, n0, nullptr, 1.f, 0.f)
        }
        TR_JOB(I_OUT, 32, w_out, D, D, Wout, D, n0, nullptr, 1.f, 0.f)
        TR_JOB(I_GU, 88, wg, D, FF, Wgu, D, 256 * (n0 >> 7) + (n0 & 127), nullptr, 1.f, 0.f)
        TR_JOB(I_GU, 88, wu, D, FF, Wgu, D, 256 * (n0 >> 7) + (n0 & 127) + 128, nullptr, 1.f, 0.f)
        TR_JOB(I_DN, 32, wd, FF, D, Wdn, FF, n0, nullptr, 1.f, 0.f)
    }
#undef TR_JOB
    if (even) {
        const int gt = bid * NTHREADS + wave * 64 + lane, NT = G * NTHREADS;
        for (int e = gt; e < (NIN_E - PC_PAD) * D / 8; e += NT) ((GAS v4u*)(Win + (size_t)PC_PAD * D))[e] = (v4u){0u, 0u, 0u, 0u};
        { bf16* WA2T = (bf16*)(A->ws + WS_WA2T); const float* wa2 = A->in[23] + (size_t)i * 16 * 256;
          for (int e = gt; e < 256 * 32; e += NT) { const int nn = e >> 5, k = e & 31; WA2T[e] = k < 16 ? (bf16)f2bf(wa2[k * 256 + nn]) : (bf16)0; } }
    }
    bf16* XN = (bf16*)(A->ws + WS_XN); const float* gain = A->in[2] + (size_t)L * D;
    for (int m = gw; m < M; m += NGW) rms_row_bf16(xin + (size_t)m * D, gain, XN + (size_t)m * D, lane);
}

__device__ __forceinline__ void phase_prep(ArgP A, int L, LAS unsigned char* lds, int G, int tid, int bid) {
    const int i = L >> 1;
    const bf16* P = (const bf16*)(A->ws + WS_P); float* LA = (float*)(A->ws + WS_LA);
    const float* wa2 = A->in[23] + (size_t)i * 16 * 256, *ba = A->in[24] + i * 256;
    LAS float* sl = (LAS float*)lds;
    for (int item = bid; item < M / 32; item += G) {
        const int row0 = item * 32;
        { const int tok = tid >> 4, j = tid & 15; sl[j * 32 + tok] = bf2f(P[(size_t)(row0 + tok) * NIN_E + PC_WA1 + j]); }
        __syncthreads();
        const int c = tid;
        if (c < 256) {
            float acc[32];
#pragma unroll
            for (int t = 0; t < 32; ++t) acc[t] = 0.f;
            for (int j = 0; j < 16; ++j) { const float w = wa2[j * 256 + c];
#pragma unroll
                for (int t4 = 0; t4 < 8; ++t4) { const f32x4 x = *(const LAS f32x4*)(sl + j * 32 + 4 * t4); acc[4 * t4] += x.x * w; acc[4 * t4 + 1] += x.y * w; acc[4 * t4 + 2] += x.z * w; acc[4 * t4 + 3] += x.w * w; } }
            const float b0 = ba[c]; float* op = LA + (size_t)row0 * 256 + c;
#pragma unroll
            for (int t = 0; t < 32; ++t) { *op = -softplus_f(-(b0 + acc[t])) * (1.0f / 16.0f); op += 256; FRESH_V(op); }
        }
        __syncthreads();
    }
}

__device__ __noinline__ void rwkv_scan_seq(ArgP A, int L, int b, int h, LAS float* sc, int lane) {
    const int i = L >> 1, c = h * 64 + lane;
    const bf16* P = (const bf16*)(A->ws + WS_P); const float* WLOG = (const float*)(A->ws + WS_WLOG); const float* ASIG = (const float*)(A->ws + WS_ASIG); bf16* OAB = (bf16*)(A->ws + WS_XN);
    const float* mu = A->in[7] + (size_t)i * 1536;
    const float mur = mu[c], muk = mu[512 + c], muv = mu[1024 + c];
    const float kkc = A->in[17][i * 512 + c], kac = A->in[18][i * 512 + c], rkc = A->in[19][i * 512 + c], lnw = A->in[20][i * 512 + c], lnb = A->in[21][i * 512 + c];
    float S[64];
#pragma unroll
    for (int k = 0; k < 64; ++k) S[k] = 0.f;
    float pr_prev = 0.f, pk_prev = 0.f, pv_prev = 0.f;
    const size_t row0 = (size_t)b * T;
    float npr = bf2f(P[row0 * NIN_E + PC_R + c]), npk = bf2f(P[row0 * NIN_E + PC_K + c]), npv = bf2f(P[row0 * NIN_E + PC_V + c]);
    float nwl = WLOG[row0 * 512 + c], nas = ASIG[row0 * 512 + c], ng = bf2f(OAB[row0 * D + c]);
#pragma unroll 1
    for (int t = 0; t < T; ++t) {
        const float pr = npr, pk = npk, pv = npv, wl = nwl, as = nas, g = ng;
        if (t + 1 < T) { const size_t rw = row0 + t + 1; npr = bf2f(P[rw * NIN_E + PC_R + c]); npk = bf2f(P[rw * NIN_E + PC_K + c]); npv = bf2f(P[rw * NIN_E + PC_V + c]);
            nwl = WLOG[rw * 512 + c]; nas = ASIG[rw * 512 + c]; ng = bf2f(OAB[rw * D + c]); }
        const float r = pr + (pr_prev - pr) * mur, k = pk + (pk_prev - pk) * muk, v = pv + (pv_prev - pv) * muv;
        pr_prev = pr; pk_prev = pk; pv_prev = pv;
        float kk = k * kkc; const float n2 = wave_sum(kk * kk); kk = kk * frcp(fmaxf(fsqrt(n2), 1e-12f));
        const float kmod = k * (1.f + (as - 1.f) * kac);
        sc[lane] = -kk; sc[64 + lane] = fexp(wl); sc[128 + lane] = kk * as; sc[192 + lane] = kmod; sc[256 + lane] = r;
        LDS_WAIT(); asm volatile("" ::: "memory");
        float sa = 0.f;
#pragma unroll
        for (int k4 = 0; k4 < 16; ++k4) { const f32x4 a4 = *(const LAS f32x4*)(sc + 4 * k4); sa += S[4 * k4] * a4.x; sa += S[4 * k4 + 1] * a4.y; sa += S[4 * k4 + 2] * a4.z; sa += S[4 * k4 + 3] * a4.w; }
        float y = 0.f;
#pragma unroll
        for (int k4 = 0; k4 < 16; ++k4) {
            const f32x4 w4 = *(const LAS f32x4*)(sc + 64 + 4 * k4), b4 = *(const LAS f32x4*)(sc + 128 + 4 * k4), kq = *(const LAS f32x4*)(sc + 192 + 4 * k4), r4 = *(const LAS f32x4*)(sc + 256 + 4 * k4);
            S[4 * k4] = S[4 * k4] * w4.x + sa * b4.x + v * kq.x; y += S[4 * k4] * r4.x;
            S[4 * k4 + 1] = S[4 * k4 + 1] * w4.y + sa * b4.y + v * kq.y; y += S[4 * k4 + 1] * r4.y;
            S[4 * k4 + 2] = S[4 * k4 + 2] * w4.z + sa * b4.z + v * kq.z; y += S[4 * k4 + 2] * r4.z;
            S[4 * k4 + 3] = S[4 * k4 + 3] * w4.w + sa * b4.w + v * kq.w; y += S[4 * k4 + 3] * r4.w;
        }
        asm volatile("" ::: "memory");
        const float bonus = wave_sum(r * kmod * rkc);
        const float mean = wave_sum(y) * (1.f / 64.f); const float d = y - mean; const float var = wave_sum(d * d) * (1.f / 64.f);
        float o = d * frsq(var + 64e-5f) * lnw + lnb;
        o = (o + bonus * v) * g;
        OAB[(row0 + t) * D + c] = (bf16)f2bf(o);
    }
}
__device__ __noinline__ void gla_scan_half(ArgP A, int b, int h, int half, LAS float* sc, int lane) {
    const bf16* P = (const bf16*)(A->ws + WS_P); const float* LA = (const float*)(A->ws + WS_LA); bf16* OAB = (bf16*)(A->ws + WS_XN);
    float S0[64];
#pragma unroll
    for (int k = 0; k < 64; ++k) S0[k] = 0.f;
    const size_t row0 = (size_t)b * T;
#pragma unroll 1
    for (int t = 0; t < T; ++t) {
        const size_t rw = row0 + t; const bf16* pr = P + rw * NIN_E;
        const float q = bf2f(pr[PC_GQ + h * 64 + lane]) * 0.125f, kx = bf2f(pr[PC_GK + h * 64 + lane]), la = LA[rw * 256 + h * 64 + lane];
        const float v0 = bf2f(pr[PC_GV + h * 128 + half * 64 + lane]);
        sc[lane] = fexp(la); sc[64 + lane] = kx; sc[128 + lane] = q;
        LDS_WAIT(); asm volatile("" ::: "memory");
        float o0 = 0.f;
#pragma unroll
        for (int k4 = 0; k4 < 16; ++k4) {
            const f32x4 a4 = *(const LAS f32x4*)(sc + 4 * k4), k4v = *(const LAS f32x4*)(sc + 64 + 4 * k4), q4 = *(const LAS f32x4*)(sc + 128 + 4 * k4);
            S0[4 * k4] = S0[4 * k4] * a4.x + k4v.x * v0; o0 += q4.x * S0[4 * k4];
            S0[4 * k4 + 1] = S0[4 * k4 + 1] * a4.y + k4v.y * v0; o0 += q4.y * S0[4 * k4 + 1];
            S0[4 * k4 + 2] = S0[4 * k4 + 2] * a4.z + k4v.z * v0; o0 += q4.z * S0[4 * k4 + 2];
            S0[4 * k4 + 3] = S0[4 * k4 + 3] * a4.w + k4v.w * v0; o0 += q4.w * S0[4 * k4 + 3];
        }
        asm volatile("" ::: "memory");
        OAB[rw * D + 512 + h * 128 + half * 64 + lane] = (bf16)f2bf(o0);
    }
}
__device__ __noinline__ void gla_norm_rows(ArgP A, int L, int b, int h, int wave, int lane) {
    const int i = L >> 1;
    const bf16* P = (const bf16*)(A->ws + WS_P); bf16* OAB = (bf16*)(A->ws + WS_XN);
    const float gn0 = A->in[25][i * 512 + h * 128 + 2 * lane], gn1 = A->in[25][i * 512 + h * 128 + 2 * lane + 1];
    for (int t = wave; t < T; t += NWAVES) {
        const size_t rw = (size_t)b * T + t;
        GAS unsigned* op = (GAS unsigned*)(OAB + rw * D + 512 + h * 128 + 2 * lane);
        const unsigned ov = *op, gv = *(const GAS unsigned*)(P + rw * NIN_E + PC_GG + h * 128 + 2 * lane);
        const float o0 = bflo(ov), o1 = bfhi(ov);
        const float rs = frsq(wave_sum(o0 * o0 + o1 * o1) * (1.f / 128.f) + 1e-5f);
        *op = pk2(o0 * rs * gn0 * silu_f(bflo(gv)), o1 * rs * gn1 * silu_f(bfhi(gv)));
    }
}

__device__ __forceinline__ int t5_bucket(int d) {
    if (d < 16) return d;
    const float r = (float)d / 16.0f; int l = 16 + (int)(flog(r) / 2.0794415416798357f * 16.0f);
    return l < 31 ? l : 31;
}
__device__ __noinline__ void attn_row_simple(ArgP A, int L, int b, int h, int t, float lam, float lam_init, LAS float* qs  , LAS float* bd  , int lane) {
    const int i = L >> 1;
    const bf16* QKV = (const bf16*)(A->ws + WS_P); bf16* O = (bf16*)(A->ws + WS_XN);
    const bf16* qrow = QKV + (size_t)(b * T + t) * NIN_O + h * 128;
    qs[lane] = bf2f(qrow[lane]) * 0.125f; qs[64 + lane] = bf2f(qrow[64 + lane]) * 0.125f;
    bd[lane] = A->in[1][t5_bucket(lane) * 8 + h]; bd[64 + lane] = A->in[1][t5_bucket(64 + lane) * 8 + h];
    LDS_WAIT(); asm volatile("" ::: "memory");
    float m1 = -1e30f, m2 = -1e30f, l1 = 0.f, l2 = 0.f, o1a = 0.f, o1b = 0.f, o2a = 0.f, o2b = 0.f;
#pragma unroll 1
    for (int j0 = 0; j0 <= t; j0 += 64) {
        const int j = j0 + lane; const bool valid = j <= t;
        const bf16* krow = QKV + (size_t)(b * T + j) * NIN_O + 1024 + h * 128;
        float s1 = 0.f, s2 = 0.f;
#pragma unroll 2
        for (int c8 = 0; c8 < 8; ++c8) { const v4u kv = *(const GAS v4u*)(krow + 8 * c8); const f32x4 qa = *(const LAS f32x4*)(qs + 8 * c8), qb = *(const LAS f32x4*)(qs + 8 * c8 + 4);
            s1 += qa.x * bflo(kv.x) + qa.y * bfhi(kv.x) + qa.z * bflo(kv.y) + qa.w * bfhi(kv.y) + qb.x * bflo(kv.z) + qb.y * bfhi(kv.z) + qb.z * bflo(kv.w) + qb.w * bfhi(kv.w); }
#pragma unroll 2
        for (int c8 = 0; c8 < 8; ++c8) { const v4u kv = *(const GAS v4u*)(krow + 64 + 8 * c8); const f32x4 qa = *(const LAS f32x4*)(qs + 64 + 8 * c8), qb = *(const LAS f32x4*)(qs + 64 + 8 * c8 + 4);
            s2 += qa.x * bflo(kv.x) + qa.y * bfhi(kv.x) + qa.z * bflo(kv.y) + qa.w * bfhi(kv.y) + qb.x * bflo(kv.z) + qb.y * bfhi(kv.z) + qb.z * bflo(kv.w) + qb.w * bfhi(kv.w); }
        const int dist = valid ? (t - j) : 0; const float bias = bd[dist < 127 ? dist : 127];
        s1 = valid ? s1 + bias : -1e30f; s2 = valid ? s2 + bias : -1e30f;
        const float mn1 = fmaxf(m1, wave_max(s1)), mn2 = fmaxf(m2, wave_max(s2));
        const float c1 = fexp(m1 - mn1), c2 = fexp(m2 - mn2);
        const float p1 = valid ? fexp(s1 - mn1) : 0.f, p2 = valid ? fexp(s2 - mn2) : 0.f;
        l1 = l1 * c1 + wave_sum(p1); l2 = l2 * c2 + wave_sum(p2); m1 = mn1; m2 = mn2;
        o1a *= c1; o1b *= c1; o2a *= c2; o2b *= c2;
        const bf16* vbase = QKV + (size_t)(b * T + j0) * NIN_O + 2048 + h * 128 + 2 * lane;
#pragma unroll 4
        for (int jj = 0; jj < 64; ++jj) {
            const float pj1 = __builtin_bit_cast(float, __builtin_amdgcn_readlane(__builtin_bit_cast(int, p1), jj)), pj2 = __builtin_bit_cast(float, __builtin_amdgcn_readlane(__builtin_bit_cast(int, p2), jj));
            const unsigned vv = *(const GAS unsigned*)(vbase + (size_t)jj * NIN_O); const float v0 = bflo(vv), v1 = bfhi(vv);
            o1a += pj1 * v0; o1b += pj1 * v1; o2a += pj2 * v0; o2b += pj2 * v1;
        }
    }
    const float il1 = frcp(l1), il2 = frcp(l2); float oa = o1a * il1 - lam * (o2a * il2), ob = o1b * il1 - lam * (o2b * il2);
    const float ms = wave_sum(oa * oa + ob * ob) * (1.f / 128.f); const float rs = frsq(ms + 1e-5f);
    const float sc = 1.0f - lam_init; const float* sl = A->in[32] + i * 128;
    oa = oa * rs * sl[2 * lane] * sc; ob = ob * rs * sl[2 * lane + 1] * sc;
    *(GAS unsigned*)(O + (size_t)(b * T + t) * D + h * 128 + 2 * lane) = pk2(oa, ob);
}
typedef short a_bf16x8 __attribute__((ext_vector_type(8)));
typedef float f32x16 __attribute__((ext_vector_type(16)));
typedef short a_s16x4 __attribute__((ext_vector_type(4)));
constexpr int AT_SK = 144, AT_SV = 320, AT_K1 = 0, AT_K2 = 64 * AT_SK, AT_V = 2 * 64 * AT_SK, AT_ST = AT_V + 64 * AT_SV, AT_BIAS = 2 * AT_ST, AT_COMB = 0;
static_assert(AT_BIAS + 132 * 4 <= RING_BYTES && 4 * 64 * 64 * 4 <= AT_BIAS, "attention LDS map");
__device__ __forceinline__ int crow16(int r, int hi) { return (r & 3) + 8 * (r >> 2) + 4 * hi; }
typedef float f32x2_t __attribute__((ext_vector_type(2))); typedef __bf16 bf16x2_t __attribute__((ext_vector_type(2)));
__device__ __forceinline__ unsigned cvtpk(float lo, float hi) { const f32x2_t v = {lo, hi}; const bf16x2_t b = __builtin_convertvector(v, bf16x2_t); return __builtin_bit_cast(unsigned, b); }

__device__ __forceinline__ void attn_unit_mfma(ArgP A, int L, int b, int h, int qb, float lam, float lam_init, LAS unsigned char* lds, int tid) {
    const int lane = tid & 63, wave = __builtin_amdgcn_readfirstlane(tid >> 6), r32 = lane & 31, hi = lane >> 5;
    const int smap = wave >> 2, qs = wave & 3;
    const int i = L >> 1;
    const bf16* QKV = (const bf16*)(A->ws + WS_P); bf16* O = (bf16*)(A->ws + WS_XN);
    const int q0 = qb * 128, qw0 = q0 + 32 * qs, nt = (q0 + 128) / 64;
    const size_t rowb = (size_t)b * T;
    if (tid < 129) { const float far = A->in[1][31 * 8 + h]; ((LAS float*)(lds + AT_BIAS))[tid] = tid < 128 ? (A->in[1][t5_bucket(tid) * 8 + h] - far) * 1.4426950408889634f : 0.f; }
    a_bf16x8 qf[4];
    { const bf16* qrow = QKV + (rowb + qw0 + r32) * NIN_O + h * 128 + smap * 64 + 8 * hi;
#pragma unroll
      for (int ks = 0; ks < 4; ++ks) qf[ks] = *(const GAS a_bf16x8*)(qrow + 16 * ks); }
    const int kr = tid >> 3, kc = tid & 7, vr0 = tid >> 4, vc = tid & 15;
    const bf16* kg = QKV + (rowb + kr) * NIN_O + 1024 + h * 128 + 8 * kc;
    const bf16* vg = QKV + (rowb + vr0) * NIN_O + 2048 + h * 128 + 8 * vc;
    const int kw = kr * AT_SK + kc * 16, vw = vr0 * AT_SV + vc * 16;
    v4u sk1, sk2, sv0, sv1;
#define AT_LOAD(kt) do { const size_t go_ = (size_t)(kt) * 64 * NIN_O; sk1 = *(const GAS v4u*)(kg + go_); sk2 = *(const GAS v4u*)(kg + go_ + 64); sv0 = *(const GAS v4u*)(vg + go_); sv1 = *(const GAS v4u*)(vg + go_ + (size_t)32 * NIN_O); } while (0)
#define AT_STORE(st) do { LAS unsigned char* sb_ = lds + (st) * AT_ST; *(LAS v4u*)(sb_ + AT_K1 + kw) = sk1; *(LAS v4u*)(sb_ + AT_K2 + kw) = sk2; *(LAS v4u*)(sb_ + AT_V + vw) = sv0; *(LAS v4u*)(sb_ + AT_V + vw + 32 * AT_SV) = sv1; } while (0)
    AT_LOAD(0); AT_STORE(0);
    __syncthreads();
    f32x16 o[4];
#pragma unroll
    for (int d = 0; d < 4; ++d)
#pragma unroll
        for (int r = 0; r < 16; ++r) o[d][r] = 0.f;
    float m = -1e30f, l = 0.f;
    const int kfo = (smap ? AT_K2 : AT_K1) + r32 * AT_SK + 16 * hi;
    const int vfo = AT_V + (4 * hi + ((lane & 15) >> 2)) * AT_SV + (16 * ((lane >> 4) & 1) + 4 * (lane & 3)) * 2;
    const LAS float* bdl = (const LAS float*)(lds + AT_BIAS);
    const int qme = qw0 + r32;
#pragma unroll 1
    for (int kt = 0; kt < nt; ++kt) {
        if (kt + 1 < nt) AT_LOAD(kt + 1);
        const int key0 = 64 * kt;
        if (key0 <= qw0 + 31) {
            const LAS unsigned char* sb = lds + (kt & 1) * AT_ST;
            f32x16 p[2];
#pragma unroll
            for (int blk = 0; blk < 2; ++blk) {
#pragma unroll
                for (int r = 0; r < 16; ++r) p[blk][r] = 0.f;
#pragma unroll
                for (int ks = 0; ks < 4; ++ks) { const a_bf16x8 kf = *(const LAS a_bf16x8*)(sb + kfo + blk * 32 * AT_SK + ks * 32); p[blk] = __builtin_amdgcn_mfma_f32_32x32x16_bf16(kf, qf[ks], p[blk], 0, 0, 0); }
            }
            if (key0 + 63 + 128 > qw0) {
#pragma unroll
                for (int blk = 0; blk < 2; ++blk)
#pragma unroll
                    for (int r = 0; r < 16; ++r) { const int dist = qme - (key0 + 32 * blk + crow16(r, hi)); const float bv = bdl[dist < 0 ? 128 : (dist < 128 ? dist : 128)]; p[blk][r] = dist < 0 ? -1e30f : p[blk][r] + bv; }
            }
            float mx = p[0][0];
#pragma unroll
            for (int r = 1; r < 16; ++r) mx = fmaxf(mx, p[0][r]);
#pragma unroll
            for (int r = 0; r < 16; ++r) mx = fmaxf(mx, p[1][r]);
            mx = fmaxf(mx, __shfl_xor(mx, 32));
            if (__any(mx > m + 8.0f)) {
                const float mn = fmaxf(m, mx), al = __builtin_amdgcn_exp2f(m - mn); m = mn; l *= al;
#pragma unroll
                for (int d = 0; d < 4; ++d)
#pragma unroll
                    for (int r = 0; r < 16; ++r) o[d][r] *= al;
            }
            float ls = 0.f;
#pragma unroll
            for (int blk = 0; blk < 2; ++blk)
#pragma unroll
                for (int r = 0; r < 16; ++r) { const float e = __builtin_amdgcn_exp2f(p[blk][r] - m); p[blk][r] = e; ls += e; }
            l += ls;
            a_bf16x8 pf[4];
#pragma unroll
            for (int kk = 0; kk < 4; ++kk) { const int blk = kk >> 1, s8 = 8 * (kk & 1); v4u w; w.x = cvtpk(p[blk][s8], p[blk][s8 + 1]); w.y = cvtpk(p[blk][s8 + 2], p[blk][s8 + 3]); w.z = cvtpk(p[blk][s8 + 4], p[blk][s8 + 5]); w.w = cvtpk(p[blk][s8 + 6], p[blk][s8 + 7]); pf[kk] = __builtin_bit_cast(a_bf16x8, w); }
#pragma unroll
            for (int kk = 0; kk < 4; ++kk)
#pragma unroll
                for (int d = 0; d < 4; ++d) {
                    const LAS unsigned char* vp = sb + vfo + kk * 16 * AT_SV + d * 64;
                    const a_s16x4 lo4 = __builtin_bit_cast(a_s16x4, __builtin_amdgcn_ds_read_tr16_b64_v4i16((LAS a_s16x4*)vp));
                    const a_s16x4 hi4 = __builtin_bit_cast(a_s16x4, __builtin_amdgcn_ds_read_tr16_b64_v4i16((LAS a_s16x4*)(vp + 8 * AT_SV)));
                    const a_bf16x8 vf = (a_bf16x8){lo4[0], lo4[1], lo4[2], lo4[3], hi4[0], hi4[1], hi4[2], hi4[3]};
                    o[d] = __builtin_amdgcn_mfma_f32_32x32x16_bf16(vf, pf[kk], o[d], 0, 0, 0);
                }
        }
        if (kt + 1 < nt) AT_STORE((kt + 1) & 1);
        __syncthreads();
    }
#undef AT_LOAD
#undef AT_STORE
    l += __shfl_xor(l, 32);
    LAS float* comb = (LAS float*)(lds + AT_COMB) + qs * 4096;
    if (smap == 1) { const float sc = lam * frcp(l);
#pragma unroll
        for (int d = 0; d < 4; ++d)
#pragma unroll
            for (int r = 0; r < 16; ++r) comb[(d * 16 + r) * 64 + lane] = o[d][r] * sc; }
    __syncthreads();
    if (smap == 0) {
        const float il = frcp(l); float ss = 0.f;
#pragma unroll
        for (int d = 0; d < 4; ++d)
#pragma unroll
            for (int r = 0; r < 16; ++r) { const float v = o[d][r] * il - comb[(d * 16 + r) * 64 + lane]; o[d][r] = v; ss += v * v; }
        ss += __shfl_xor(ss, 32);
        const float rs = frsq(ss * (1.f / 128.f) + 1e-5f) * (1.0f - lam_init);
        const float* sl = A->in[32] + i * 128;
        bf16* orow = O + (rowb + qw0 + r32) * D + h * 128;
#pragma unroll
        for (int d = 0; d < 4; ++d)
#pragma unroll
            for (int g4 = 0; g4 < 4; ++g4) { const int dc = 32 * d + 8 * g4 + 4 * hi; const f32x4 s4 = *(const GAS f32x4*)(sl + dc);
                v2u w; w.x = cvtpk(o[d][4 * g4] * rs * s4.x, o[d][4 * g4 + 1] * rs * s4.y); w.y = cvtpk(o[d][4 * g4 + 2] * rs * s4.z, o[d][4 * g4 + 3] * rs * s4.w);
                *(GAS v2u*)(orow + dc) = w; }
    }
    __syncthreads();
}

__device__ __forceinline__ void attn_phase_mfma(ArgP A, int L, LAS unsigned char* lds, int tid, int G, int bid) {
    const int lane = tid & 63, i = L >> 1;
    const float lam_init = 0.8f - 0.6f * fexp(-0.3f * (float)L);
    const float lam = fexp(wave_sum(A->in[28][i * 64 + lane] * A->in[29][i * 64 + lane])) - fexp(wave_sum(A->in[30][i * 64 + lane] * A->in[31][i * 64 + lane])) + lam_init;
    if (G == 256) {
        const int v = (bid & 7) * 32 + (bid >> 3), bh = v >> 2, j = v & 3;
#pragma unroll 1
        for (int u = 0; u < 8; ++u) { const int qb = 8 * (u >> 1) + ((u & 1) ? 7 - j : j); attn_unit_mfma(A, L, bh >> 3, bh & 7, qb, lam, lam_init, lds, tid); }
    } else {
#pragma unroll 1
        for (int u = bid; u < 64 * 32; u += G) attn_unit_mfma(A, L, (u >> 5) >> 3, (u >> 5) & 7, 31 - (u & 31), lam, lam_init, lds, tid);
    }
}
typedef short bf16x8_t __attribute__((ext_vector_type(8)));
constexpr int MS = 72, MB = 64 * MS * 2;
constexpr int RW_XW = 8 * MB, RW_XA = RW_XW + 16384;
constexpr int RW_TOT = 14 * MB, RW_GAM = RW_TOT + 2048, RW_END = RW_GAM + 256;
static_assert(RW_XA + 16384 <= 12 * MB && RW_END <= RING_BYTES, "RWKV LDS map");
constexpr size_t WS_RWI = 336 * MiB;
constexpr size_t WS_BON = 30 * MiB;
#define RBUF(k) ((LAS bf16*)(lds + (k) * MB))
__device__ __forceinline__ f32x4 mfma16(bf16x8_t a, bf16x8_t b, f32x4 c) { return __builtin_amdgcn_mfma_f32_16x16x32_bf16(a, b, c, 0, 0, 0); }
__device__ __forceinline__ bf16x8_t ldfrag(const LAS bf16* Mx, int row0, int k0, int lane) { return *(const LAS bf16x8_t*)(Mx + (row0 + (lane & 15)) * MS + k0 + 8 * (lane >> 4)); }
__device__ __forceinline__ f32x4 mm64(f32x4 acc, const LAS bf16* Am, int ra, const LAS bf16* BTm, int cb, int lane) {
    acc = mfma16(ldfrag(Am, 16 * ra, 0, lane), ldfrag(BTm, 16 * cb, 0, lane), acc);
    return mfma16(ldfrag(Am, 16 * ra, 32, lane), ldfrag(BTm, 16 * cb, 32, lane), acc);
}
__device__ __forceinline__ v2u pack4(f32x4 a) { v2u w; w.x = cvtpk(a[0], a[1]); w.y = cvtpk(a[2], a[3]); return w; }
__device__ __forceinline__ void tstore(LAS bf16* Dm, int rt, int ct, f32x4 acc, int lane) { *(LAS v2u*)(Dm + (16 * ct + (lane & 15)) * MS + 16 * rt + 4 * (lane >> 4)) = pack4(acc); }
__device__ __forceinline__ void tstore_g(bf16* Dg, int rt, int ct, f32x4 acc, int lane) { *(GAS v2u*)(Dg + (16 * ct + (lane & 15)) * 64 + 16 * rt + 4 * (lane >> 4)) = pack4(acc); }
__device__ __forceinline__ f32x4 ld4bf(const LAS bf16* p) { const v2u w = *(const LAS v2u*)p; return (f32x4){bflo(w.x), bfhi(w.x), bflo(w.y), bfhi(w.y)}; }
__device__ __forceinline__ f32x4 ld4bf_g(const bf16* p) { const v2u w = *(const GAS v2u*)p; return (f32x4){bflo(w.x), bfhi(w.x), bflo(w.y), bfhi(w.y)}; }
__device__ __forceinline__ void unpack8(v4u w, float (&f)[8]) { f[0] = bflo(w.x); f[1] = bfhi(w.x); f[2] = bflo(w.y); f[3] = bfhi(w.y); f[4] = bflo(w.z); f[5] = bfhi(w.z); f[6] = bflo(w.w); f[7] = bfhi(w.w); }
__device__ __forceinline__ bf16x8_t pack8(const float (&f)[8]) { v4u w; w.x = cvtpk(f[0], f[1]); w.y = cvtpk(f[2], f[3]); w.z = cvtpk(f[4], f[5]); w.w = cvtpk(f[6], f[7]); return __builtin_bit_cast(bf16x8_t, w); }

__device__ __forceinline__ void rwkv_chunk_item(ArgP A, int L, int b, int n, int h, LAS unsigned char* lds, int tid) {
    const int lane = tid & 63, wave = __builtin_amdgcn_readfirstlane(tid >> 6), i = L >> 1;
    const int l15 = lane & 15, lg = lane >> 4;
    const bf16* P = (const bf16*)(A->ws + WS_P); bf16* XNb = (bf16*)(A->ws + WS_XN);
    const size_t rowb = (size_t)b * T + 64 * n;
    bf16* item = (bf16*)(A->ws + WS_RWI) + ((size_t)((b * 64 + n) * 8 + h)) * 16384;
    {
        const int rt = wave >> 1, ct0 = 2 * (wave & 1);
        const int tt = 16 * rt + l15; const bf16* prow = P + (rowb + tt) * NIN_E; const bool has_prev = (64 * n + tt) > 0;
        const bf16* W2T = (const bf16*)(A->ws + WS_W2T); const bf16* A2T = (const bf16*)(A->ws + WS_A2T); const bf16* G2T = (const bf16*)(A->ws + WS_G2T);
        f32x4 xw[2], xa[2];
#pragma unroll
        for (int c = 0; c < 2; ++c) { xw[c] = (f32x4){0.f, 0.f, 0.f, 0.f}; xa[c] = (f32x4){0.f, 0.f, 0.f, 0.f}; }
#pragma unroll
        for (int k0 = 0; k0 < 64; k0 += 32) {
            const int kc = k0 + 8 * lg; float x[8], y[8], v[8];
            unpack8(*(const GAS v4u*)(prow + PC_W1A + kc), x); if (has_prev) unpack8(*(const GAS v4u*)(prow - NIN_E + PC_W1B + kc), y); else {
#pragma unroll
                for (int e = 0; e < 8; ++e) y[e] = 0.f; }
#pragma unroll
            for (int e = 0; e < 8; ++e) v[e] = tanh_f(x[e] + y[e]);
            const bf16x8_t fw = pack8(v);
            unpack8(*(const GAS v4u*)(prow + PC_A1A + kc), x); if (has_prev) unpack8(*(const GAS v4u*)(prow - NIN_E + PC_A1B + kc), y);
#pragma unroll
            for (int e = 0; e < 8; ++e) v[e] = x[e] + y[e];
            const bf16x8_t fa = pack8(v);
#pragma unroll
            for (int c = 0; c < 2; ++c) { const size_t wo = (size_t)(64 * h + 16 * (ct0 + c) + l15) * 64 + kc;
                xw[c] = mfma16(fw, *(const GAS bf16x8_t*)(W2T + wo), xw[c]); xa[c] = mfma16(fa, *(const GAS bf16x8_t*)(A2T + wo), xa[c]); }
        }
        LAS float* XW = (LAS float*)(lds + RW_XW); LAS float* XA = (LAS float*)(lds + RW_XA);
#pragma unroll
        for (int c = 0; c < 2; ++c)
#pragma unroll
            for (int r = 0; r < 4; ++r) { const int o = (16 * rt + 4 * lg + r) * 64 + 16 * (ct0 + c) + l15; XW[o] = xw[c][r]; XA[o] = xa[c][r]; }
        const int tct = wave >> 1, jt0 = 2 * (wave & 1);
        f32x4 gg[2] = {(f32x4){0.f, 0.f, 0.f, 0.f}, (f32x4){0.f, 0.f, 0.f, 0.f}};
#pragma unroll
        for (int k0 = 0; k0 < 192; k0 += 32) {
            const int kc = k0 + 8 * lg; float x[8], y[8], v[8];
            if (kc < 160) { unpack8(*(const GAS v4u*)(prow + PC_G1A + kc), x); if (has_prev) unpack8(*(const GAS v4u*)(prow - NIN_E + PC_G1B + kc), y); else {
#pragma unroll
                    for (int e = 0; e < 8; ++e) y[e] = 0.f; }
#pragma unroll
                for (int e = 0; e < 8; ++e) v[e] = sigmoid_f(x[e] + y[e]); }
            else {
#pragma unroll
                for (int e = 0; e < 8; ++e) v[e] = 0.f; }
            const bf16x8_t fg = pack8(v);
#pragma unroll
            for (int c = 0; c < 2; ++c) gg[c] = mfma16(*(const GAS bf16x8_t*)(G2T + (size_t)(64 * h + 16 * (jt0 + c) + l15) * 192 + kc), fg, gg[c]);
        }
        (void)tct;
#pragma unroll
        for (int c = 0; c < 2; ++c) *(GAS v2u*)(XNb + (rowb + tt) * D + 64 * h + 16 * (jt0 + c) + 4 * lg) = pack4(gg[c]);
    }
    __syncthreads();
    {
        const int c = 64 * h + lane;
        const float* mu = A->in[7] + (size_t)i * 1536;
        const float mur = mu[c], muk = mu[512 + c], muv = mu[1024 + c];
        const float kkc = A->in[17][i * 512 + c], kac = A->in[18][i * 512 + c], rkc = A->in[19][i * 512 + c], w0c = A->in[9][i * 512 + c], a0c = A->in[12][i * 512 + c];
        const LAS float* XW = (const LAS float*)(lds + RW_XW); const LAS float* XA = (const LAS float*)(lds + RW_XA);
        float* BON = (float*)(A->ws + WS_BON);
        const int tt0 = 8 * wave; const size_t row0 = rowb + tt0;
        float pr_p = 0.f, pk_p = 0.f, pv_p = 0.f;
        if (64 * n + tt0 > 0) { const bf16* pp = P + (row0 - 1) * NIN_E; pr_p = bf2f(pp[PC_R + c]); pk_p = bf2f(pp[PC_K + c]); pv_p = bf2f(pp[PC_V + c]); }
        float rr[8], av[8], bv[8], km[8], vv[8], wl[8], lc[8];
        float run = 0.f;
#pragma unroll
        for (int u = 0; u < 8; ++u) {
            const bf16* pr = P + (row0 + u) * NIN_E; const float pR = bf2f(pr[PC_R + c]), pK = bf2f(pr[PC_K + c]), pV = bf2f(pr[PC_V + c]);
            const float r = pR + (pr_p - pR) * mur, k = pK + (pk_p - pK) * muk, v = pV + (pv_p - pV) * muv; pr_p = pR; pk_p = pK; pv_p = pV;
            const float xw = w0c + XW[(tt0 + u) * 64 + lane], xa = a0c + XA[(tt0 + u) * 64 + lane];
            const float wlog = -fexp(-softplus_f(-xw) - 0.5f), as = sigmoid_f(xa);
            float kk = k * kkc; const float n2 = wave_sum(kk * kk); kk = kk * frcp(fmaxf(fsqrt(n2), 1e-12f));
            const float kmod = k * (1.f + (as - 1.f) * kac);
            const float bon = wave_sum(r * kmod * rkc);
            if (lane == 0) BON[(row0 + u) * 8 + h] = bon;
            run += wlog; rr[u] = r; av[u] = -kk; bv[u] = kk * as; km[u] = kmod; vv[u] = v; wl[u] = wlog; lc[u] = run;
        }
        LAS float* TOT = (LAS float*)(lds + RW_TOT);
        TOT[wave * 64 + lane] = run;
        __syncthreads();
        float off = 0.f, tot = 0.f;
#pragma unroll
        for (int w2 = 0; w2 < 8; ++w2) { const float tv = TOT[w2 * 64 + lane]; tot += tv; if (w2 < wave) off += tv; }
        if (wave == 0) ((LAS float*)(lds + RW_GAM))[lane] = fexp(tot);
        float fR[8], fA[8], fB[8], fK[8];
#pragma unroll
        for (int u = 0; u < 8; ++u) { const float cum = off + lc[u], e1 = fexp(cum), ei = fexp(-cum); fR[u] = rr[u] * e1; fA[u] = av[u] * fexp(cum - wl[u]); fB[u] = bv[u] * ei; fK[u] = km[u] * ei; }
        LAS bf16* At = RBUF(0); LAS bf16* Bt = RBUF(1); LAS bf16* Kt = RBUF(2); LAS bf16* Rt = RBUF(3);
#pragma unroll
        for (int u = 0; u < 8; ++u) { const int o = (tt0 + u) * MS + lane; At[o] = (bf16)f2bf(fA[u]); Bt[o] = (bf16)f2bf(fB[u]); Kt[o] = (bf16)f2bf(fK[u]); Rt[o] = (bf16)f2bf(fR[u]); }
        *(LAS bf16x8_t*)(RBUF(4) + lane * MS + tt0) = pack8(fA); *(LAS bf16x8_t*)(RBUF(5) + lane * MS + tt0) = pack8(fB);
        *(LAS bf16x8_t*)(RBUF(6) + lane * MS + tt0) = pack8(fK); *(LAS bf16x8_t*)(RBUF(7) + lane * MS + tt0) = pack8(vv);
    }
    __syncthreads();
    const int rt = wave >> 1, ct0 = 2 * (wave & 1);
    {
        const LAS bf16* At = RBUF(0); const LAS bf16* Bt = RBUF(1); const LAS bf16* Kt = RBUF(2); const LAS bf16* Rt = RBUF(3);
#pragma unroll
        for (int c = 0; c < 2; ++c) { const int ct = ct0 + c; const f32x4 z = (f32x4){0.f, 0.f, 0.f, 0.f};
            f32x4 aL = mm64(z, Bt, rt, At, ct, lane);
            f32x4 aLT = mm64(z, At, rt, Bt, ct, lane);
            f32x4 aAK = mm64(z, Kt, rt, At, ct, lane);
            f32x4 aRB = mm64(z, Bt, rt, Rt, ct, lane);
            f32x4 aRK = mm64(z, Kt, rt, Rt, ct, lane);
            const int col = 16 * ct + l15;
#pragma unroll
            for (int r = 0; r < 4; ++r) { const int row = 16 * rt + 4 * lg + r;
                if (!(row < col)) { aL[r] = 0.f; aAK[r] = 0.f; }
                if (!(col < row)) aLT[r] = 0.f;
                if (!(row <= col)) { aRB[r] = 0.f; aRK[r] = 0.f; } }
            tstore(RBUF(8), rt, ct, aL, lane); tstore(RBUF(9), rt, ct, aLT, lane); tstore(RBUF(10), rt, ct, aAK, lane); tstore(RBUF(11), rt, ct, aRB, lane); tstore(RBUF(12), rt, ct, aRK, lane);
        }
    }
    __syncthreads();
    {
        for (int e = tid; e < 64 * 16; e += NTHREADS) { const int row = e >> 4, c4 = (e & 15) * 4; v2u w = *(const LAS v2u*)(RBUF(8) + row * MS + c4);
            if ((row >> 2) == (c4 >> 2)) { const unsigned one = 0x3f80u; const int p = row & 3; if (p == 0) w.x = (w.x & 0xffff0000u) | one; else if (p == 1) w.x = (w.x & 0xffffu) | (one << 16); else if (p == 2) w.y = (w.y & 0xffff0000u) | one; else w.y = (w.y & 0xffffu) | (one << 16); }
            *(LAS v2u*)(RBUF(0) + row * MS + c4) = w; }
    }
#define RW_SQUARE(Min, MTin, Mout, MTout) do { _Pragma("unroll") for (int c = 0; c < 2; ++c) { const int ct = ct0 + c; const f32x4 z = (f32x4){0.f, 0.f, 0.f, 0.f}; \
        tstore(RBUF(Mout), rt, ct, mm64(z, RBUF(MTin), rt, RBUF(Min), ct, lane), lane);        \
        tstore(RBUF(MTout), rt, ct, mm64(z, RBUF(Min), rt, RBUF(MTin), ct, lane), lane); } } while (0)
#define RW_YSTEP(Yin, MTin, Yout) do { _Pragma("unroll") for (int c = 0; c < 2; ++c) { const int ct = ct0 + c; \
        const f32x4 y0 = ld4bf(RBUF(Yin) + (16 * ct + l15) * MS + 16 * rt + 4 * lg);            \
        tstore(RBUF(Yout), rt, ct, mm64(y0, RBUF(MTin), rt, RBUF(Yin), ct, lane), lane); } } while (0)
    RW_SQUARE(8, 9, 2, 13);
    __syncthreads();
    RW_YSTEP(0, 13, 1); RW_SQUARE(2, 13, 8, 9);
    __syncthreads();
    RW_YSTEP(1, 9, 0); RW_SQUARE(8, 9, 2, 13);
    __syncthreads();
    RW_YSTEP(0, 13, 1); RW_SQUARE(2, 13, 8, 9);
    __syncthreads();
    RW_YSTEP(1, 9, 0); RW_SQUARE(8, 9, 2, 13);
    __syncthreads();
    RW_YSTEP(0, 13, 1);
    __syncthreads();
#undef RW_SQUARE
#undef RW_YSTEP
    {
#pragma unroll
        for (int c = 0; c < 2; ++c) { const int ct = ct0 + c; const f32x4 z = (f32x4){0.f, 0.f, 0.f, 0.f};
            tstore(RBUF(8), rt, ct, mm64(z, RBUF(1), rt, RBUF(4), ct, lane), lane);
            tstore(RBUF(9), rt, ct, mm64(z, RBUF(10), rt, RBUF(7), ct, lane), lane); }
    }
    __syncthreads();
    {
        const LAS float* GAM = (const LAS float*)(lds + RW_GAM);
#pragma unroll
        for (int c = 0; c < 2; ++c) { const int ct = ct0 + c; const f32x4 z = (f32x4){0.f, 0.f, 0.f, 0.f};
            tstore(RBUF(0), rt, ct, mm64(z, RBUF(1), rt, RBUF(9), ct, lane), lane);
            const f32x4 r0 = ld4bf(RBUF(3) + (16 * ct + l15) * MS + 16 * rt + 4 * lg);
            tstore_g(item, rt, ct, mm64(r0, RBUF(8), rt, RBUF(11), ct, lane), lane);
            f32x4 pp = mm64(z, RBUF(8), rt, RBUF(5), ct, lane);
            const float gm = GAM[16 * ct + l15];
#pragma unroll
            for (int r = 0; r < 4; ++r) pp[r] = gm * (pp[r] + ((16 * rt + 4 * lg + r) == (16 * ct + l15) ? 1.f : 0.f));
            tstore_g(item + 8192, rt, ct, pp, lane); }
    }
    __syncthreads();
    {
        const LAS float* GAM = (const LAS float*)(lds + RW_GAM);
#pragma unroll
        for (int c = 0; c < 2; ++c) { const int ct = ct0 + c; const f32x4 z = (f32x4){0.f, 0.f, 0.f, 0.f};
            f32x4 y0 = mm64(z, RBUF(0), rt, RBUF(11), ct, lane); y0 = mm64(y0, RBUF(7), rt, RBUF(12), ct, lane);
            tstore_g(item + 4096, rt, ct, y0, lane);
            f32x4 q = mm64(z, RBUF(5), rt, RBUF(0), ct, lane); q = mm64(q, RBUF(6), rt, RBUF(7), ct, lane);
            const f32x4 g4 = *(const LAS f32x4*)(GAM + 16 * rt + 4 * lg);
            q = q * g4;
            tstore_g(item + 12288, rt, ct, q, lane); }
    }
    __syncthreads();
}

__device__ __forceinline__ void rwkv_state_scan(ArgP A, int b, int h, int lane) {
    const int r32 = lane & 31, hi = lane >> 5;
    f32x16 St[2][2];
#pragma unroll
    for (int kb = 0; kb < 2; ++kb)
#pragma unroll
        for (int vb = 0; vb < 2; ++vb)
#pragma unroll
            for (int r = 0; r < 16; ++r) St[kb][vb][r] = 0.f;
#pragma unroll 1
    for (int n = 0; n < 64; ++n) {
        bf16* item = (bf16*)(A->ws + WS_RWI) + ((size_t)((b * 64 + n) * 8 + h)) * 16384;
        bf16* PM = item + 8192; const bf16* QT = item + 12288;
        a_bf16x8 pf[2][4];
#pragma unroll
        for (int kb = 0; kb < 2; ++kb)
#pragma unroll
            for (int ks = 0; ks < 4; ++ks) { const bf16* pp = PM + (32 * kb + r32) * 64 + 16 * ks + 4 * hi; const v2u lo = *(const GAS v2u*)pp, h2 = *(const GAS v2u*)(pp + 8);
                pf[kb][ks] = __builtin_bit_cast(a_bf16x8, (v4u){lo.x, lo.y, h2.x, h2.y}); }
        f32x16 Nw[2][2];
#pragma unroll
        for (int kb = 0; kb < 2; ++kb)
#pragma unroll
            for (int vb = 0; vb < 2; ++vb)
#pragma unroll
                for (int g = 0; g < 4; ++g) { const f32x4 q4 = ld4bf_g(QT + (32 * vb + r32) * 64 + 32 * kb + 8 * g + 4 * hi); Nw[kb][vb][4 * g] = q4.x; Nw[kb][vb][4 * g + 1] = q4.y; Nw[kb][vb][4 * g + 2] = q4.z; Nw[kb][vb][4 * g + 3] = q4.w; }
        asm volatile("s_waitcnt vmcnt(0)" ::: "memory");
#pragma unroll
        for (int kb = 0; kb < 2; ++kb)
#pragma unroll
            for (int vb = 0; vb < 2; ++vb)
#pragma unroll
                for (int g = 0; g < 4; ++g) { v2u w; w.x = cvtpk(St[kb][vb][4 * g], St[kb][vb][4 * g + 1]); w.y = cvtpk(St[kb][vb][4 * g + 2], St[kb][vb][4 * g + 3]);
                    *(GAS v2u*)(PM + (32 * vb + r32) * 64 + 32 * kb + 8 * g + 4 * hi) = w; }
        a_bf16x8 sf[4][2];
#pragma unroll
        for (int ks = 0; ks < 4; ++ks)
#pragma unroll
            for (int vb = 0; vb < 2; ++vb) { const int kb = ks >> 1, s8 = 8 * (ks & 1); v4u w; w.x = cvtpk(St[kb][vb][s8], St[kb][vb][s8 + 1]); w.y = cvtpk(St[kb][vb][s8 + 2], St[kb][vb][s8 + 3]);
                w.z = cvtpk(St[kb][vb][s8 + 4], St[kb][vb][s8 + 5]); w.w = cvtpk(St[kb][vb][s8 + 6], St[kb][vb][s8 + 7]); sf[ks][vb] = __builtin_bit_cast(a_bf16x8, w); }
#pragma unroll
        for (int kb = 0; kb < 2; ++kb)
#pragma unroll
            for (int vb = 0; vb < 2; ++vb) {
#pragma unroll
                for (int ks = 0; ks < 4; ++ks) Nw[kb][vb] = __builtin_amdgcn_mfma_f32_32x32x16_bf16(pf[kb][ks], sf[ks][vb], Nw[kb][vb], 0, 0, 0);
                St[kb][vb] = Nw[kb][vb]; }
    }
}

__device__ __forceinline__ void rwkv_out_item(ArgP A, int L, int b, int n, int h, int ct, int lane) {
    const int i = L >> 1, l15 = lane & 15, lg = lane >> 4;
    const bf16* P = (const bf16*)(A->ws + WS_P); bf16* XNb = (bf16*)(A->ws + WS_XN); const float* BON = (const float*)(A->ws + WS_BON);
    const bf16* item = (const bf16*)(A->ws + WS_RWI) + ((size_t)((b * 64 + n) * 8 + h)) * 16384;
    const bf16* RH = item; const bf16* Y0 = item + 4096; const bf16* ST = item + 8192;
    const size_t row = (size_t)b * T + 64 * n + 16 * ct + l15; const int tseq = 64 * n + 16 * ct + l15;
    const bf16x8_t rf0 = *(const GAS bf16x8_t*)(RH + (16 * ct + l15) * 64 + 8 * lg), rf1 = *(const GAS bf16x8_t*)(RH + (16 * ct + l15) * 64 + 32 + 8 * lg);
    f32x4 acc[4]; float s1 = 0.f;
#pragma unroll
    for (int it = 0; it < 4; ++it) {
        f32x4 a = ld4bf_g(Y0 + (16 * ct + l15) * 64 + 16 * it + 4 * lg);
        a = mfma16(*(const GAS bf16x8_t*)(ST + (16 * it + l15) * 64 + 8 * lg), rf0, a);
        a = mfma16(*(const GAS bf16x8_t*)(ST + (16 * it + l15) * 64 + 32 + 8 * lg), rf1, a);
        acc[it] = a; s1 += (a[0] + a[1]) + (a[2] + a[3]);
    }
    s1 += __shfl_xor(s1, 16); s1 += __shfl_xor(s1, 32);
    const float mean = s1 * (1.f / 64.f); float s2 = 0.f;
#pragma unroll
    for (int it = 0; it < 4; ++it) { acc[it] = acc[it] - mean; s2 += (acc[it][0] * acc[it][0] + acc[it][1] * acc[it][1]) + (acc[it][2] * acc[it][2] + acc[it][3] * acc[it][3]); }
    s2 += __shfl_xor(s2, 16); s2 += __shfl_xor(s2, 32);
    const float rs = frsq(s2 * (1.f / 64.f) + 64e-5f);
    const float bon = BON[row * 8 + h];
    const float* lnw = A->in[20] + i * 512 + 64 * h; const float* lnb = A->in[21] + i * 512 + 64 * h; const float* mu = A->in[7] + (size_t)i * 1536 + 1024 + 64 * h;
    const bf16* pr = P + row * NIN_E + PC_V + 64 * h;
#pragma unroll
    for (int it = 0; it < 4; ++it) { const int i0 = 16 * it + 4 * lg;
        const f32x4 w4 = *(const GAS f32x4*)(lnw + i0), b4 = *(const GAS f32x4*)(lnb + i0), m4 = *(const GAS f32x4*)(mu + i0);
        const f32x4 pv = ld4bf_g(pr + i0); const f32x4 pvp = tseq > 0 ? ld4bf_g(pr - NIN_E + i0) : (f32x4){0.f, 0.f, 0.f, 0.f};
        const f32x4 v4 = pv + (pvp - pv) * m4;
        bf16* gp = XNb + row * D + 64 * h + i0; const f32x4 g4 = ld4bf_g(gp);
        const f32x4 o = ((acc[it] * rs) * w4 + b4 + v4 * bon) * g4;
        *(GAS v2u*)gp = pack4(o); }
}
constexpr size_t WS_GKV = 464 * MiB;
constexpr size_t WS_GDEC = 31 * MiB;
constexpr int GL_LA = 0, GL_KR = 16384, GL_VT = GL_KR + MB, GL_TOT = GL_VT + 2 * MB, GL1_END = GL_TOT + 2048;
constexpr int G3_LA = 0, G3_QD = 16384, G3_KD = G3_QD + MB, G3_VT = G3_KD + MB, G3_SC = G3_VT + 2 * MB, G3_TOT = G3_SC + MB, G3_GRP = G3_TOT + 1024;
static_assert(2 * G3_GRP <= RING_BYTES && GL1_END <= RING_BYTES, "GLA LDS map");

template <int NCT> __device__ __forceinline__ void gla_lora_tiles(ArgP A, size_t rowb, int h4, int rt, int ct0, LAS float* LAs, int lane) {
    const int l15 = lane & 15, lg = lane >> 4;
    const bf16* P = (const bf16*)(A->ws + WS_P); const bf16* WA2T = (const bf16*)(A->ws + WS_WA2T);
    v4u av = (v4u){0u, 0u, 0u, 0u};
    if (lg < 2) av = *(const GAS v4u*)(P + (rowb + 16 * rt + l15) * NIN_E + PC_WA1 + 8 * lg);
    const bf16x8_t af = __builtin_bit_cast(bf16x8_t, av);
#pragma unroll
    for (int c = 0; c < NCT; ++c) { const int ct = ct0 + c;
        const f32x4 x = mfma16(af, *(const GAS bf16x8_t*)(WA2T + (size_t)(64 * h4 + 16 * ct + l15) * 32 + 8 * lg), (f32x4){0.f, 0.f, 0.f, 0.f});
#pragma unroll
        for (int r = 0; r < 4; ++r) LAs[(16 * rt + 4 * lg + r) * 64 + 16 * ct + l15] = x[r]; }
}

__device__ __forceinline__ void gla_kv_item(ArgP A, int L, int b, int n, int h4, LAS unsigned char* lds, int tid) {
    const int lane = tid & 63, wave = __builtin_amdgcn_readfirstlane(tid >> 6), i = L >> 1, l15 = lane & 15, lg = lane >> 4;
    const bf16* P = (const bf16*)(A->ws + WS_P);
    const size_t rowb = (size_t)b * T + 64 * n; const int itemi = (b * 64 + n) * 4 + h4;
    LAS float* LAs = (LAS float*)(lds + GL_LA); LAS bf16* KrT = (LAS bf16*)(lds + GL_KR); LAS bf16* VTm = (LAS bf16*)(lds + GL_VT); LAS float* TOT = (LAS float*)(lds + GL_TOT);
    gla_lora_tiles<2>(A, rowb, h4, wave >> 1, 2 * (wave & 1), LAs, lane);
    __syncthreads();
    {
        const int c = 64 * h4 + lane, tt0 = 8 * wave; const float bac = A->in[24][i * 256 + c];
        float lc[8], kx[8], v0[8], v1[8]; float run = 0.f;
#pragma unroll
        for (int u = 0; u < 8; ++u) { const bf16* pr = P + (rowb + tt0 + u) * NIN_E; const float x = bac + LAs[(tt0 + u) * 64 + lane];
            run += -softplus_f(-x) * (1.0f / 16.0f); lc[u] = run; kx[u] = bf2f(pr[PC_GK + c]); v0[u] = bf2f(pr[PC_GV + 128 * h4 + lane]); v1[u] = bf2f(pr[PC_GV + 128 * h4 + 64 + lane]); }
        TOT[wave * 64 + lane] = run;
        __syncthreads();
        float off = 0.f, tot = 0.f;
#pragma unroll
        for (int w2 = 0; w2 < 8; ++w2) { const float tv = TOT[w2 * 64 + lane]; tot += tv; if (w2 < wave) off += tv; }
        if (wave == 0) ((float*)(A->ws + WS_GDEC))[itemi * 64 + lane] = fexp(tot);
#pragma unroll
        for (int u = 0; u < 8; ++u) kx[u] *= fexp(tot - (off + lc[u]));
        *(LAS bf16x8_t*)(KrT + lane * MS + tt0) = pack8(kx); *(LAS bf16x8_t*)(VTm + lane * MS + tt0) = pack8(v0); *(LAS bf16x8_t*)(VTm + (64 + lane) * MS + tt0) = pack8(v1);
    }
    __syncthreads();
    {
        bf16* KVg = (bf16*)(A->ws + WS_GKV) + (size_t)itemi * 8192; const int rt = wave >> 1;
#pragma unroll
        for (int c = 0; c < 4; ++c) { const int et = 4 * (wave & 1) + c;
            const f32x4 acc = mm64((f32x4){0.f, 0.f, 0.f, 0.f}, KrT, rt, VTm, et, lane);
            *(GAS v2u*)(KVg + (16 * et + l15) * 64 + 16 * rt + 4 * lg) = pack4(acc); }
    }
    __syncthreads();
}

__device__ __forceinline__ void gla_state_scan(ArgP A, int gt) {
    const int bh = gt >> 11, grp = gt & 2047;
    const int b = bh >> 2, h4 = bh & 3;
    bf16* base = (bf16*)(A->ws + WS_GKV) + (size_t)((b * 64) * 4 + h4) * 8192 + (size_t)grp * 4;
    const float* dec = (const float*)(A->ws + WS_GDEC) + (size_t)((b * 64) * 4 + h4) * 64 + (grp & 15) * 4;
    f32x4 S = (f32x4){0.f, 0.f, 0.f, 0.f};
#pragma unroll 1
    for (int n0 = 0; n0 < 64; n0 += 8) {
        v2u kv[8]; f32x4 dc[8];
#pragma unroll
        for (int u = 0; u < 8; ++u) { kv[u] = *(const GAS v2u*)(base + (size_t)(n0 + u) * 4 * 8192); dc[u] = *(const GAS f32x4*)(dec + (size_t)(n0 + u) * 4 * 64); }
#pragma unroll
        for (int u = 0; u < 8; ++u) { *(GAS v2u*)(base + (size_t)(n0 + u) * 4 * 8192) = pack4(S);
            S = S * dc[u] + (f32x4){bflo(kv[u].x), bfhi(kv[u].x), bflo(kv[u].y), bfhi(kv[u].y)}; }
    }
}

__device__ __forceinline__ void gla_out_group(ArgP A, int L, int item2, LAS unsigned char* lds, int tid) {
    const int lane = tid & 63, wave = __builtin_amdgcn_readfirstlane(tid >> 6), i = L >> 1, l15 = lane & 15, lg = lane >> 4;
    const int gi = wave >> 2, wq = wave & 3;
    const int itemi = 2 * item2 + gi, h4 = itemi & 3, n = (itemi >> 2) & 63, b = itemi >> 8;
    const bf16* P = (const bf16*)(A->ws + WS_P); bf16* XNb = (bf16*)(A->ws + WS_XN);
    const size_t rowb = (size_t)b * T + 64 * n;
    LAS unsigned char* gb = lds + gi * G3_GRP;
    LAS float* LAs = (LAS float*)(gb + G3_LA); LAS bf16* Qd = (LAS bf16*)(gb + G3_QD); LAS bf16* Kd = (LAS bf16*)(gb + G3_KD); LAS bf16* VTm = (LAS bf16*)(gb + G3_VT); LAS bf16* SC = (LAS bf16*)(gb + G3_SC);
    LAS float* TOT = (LAS float*)(gb + G3_TOT);
    gla_lora_tiles<4>(A, rowb, h4, wq, 0, LAs, lane);
    __syncthreads();
    {
        const int c = 64 * h4 + lane, tt0 = 16 * wq; const float bac = A->in[24][i * 256 + c];
        float lc[16], qx[16], kx[16]; float run = 0.f;
#pragma unroll
        for (int u = 0; u < 16; ++u) { const bf16* pr = P + (rowb + tt0 + u) * NIN_E; const float x = bac + LAs[(tt0 + u) * 64 + lane];
            run += -softplus_f(-x) * (1.0f / 16.0f); lc[u] = run; qx[u] = bf2f(pr[PC_GQ + c]) * 0.125f; kx[u] = bf2f(pr[PC_GK + c]); }
        TOT[wq * 64 + lane] = run;
        __syncthreads();
        float off = 0.f;
#pragma unroll
        for (int w2 = 0; w2 < 4; ++w2) { const float tv = TOT[w2 * 64 + lane]; if (w2 < wq) off += tv; }
#pragma unroll
        for (int u = 0; u < 16; ++u) { const float cum = off + lc[u]; Qd[(tt0 + u) * MS + lane] = (bf16)f2bf(qx[u] * fexp(cum)); Kd[(tt0 + u) * MS + lane] = (bf16)f2bf(kx[u] * fexp(-cum)); }
#pragma unroll
        for (int hf = 0; hf < 2; ++hf) { float v0[8], v1[8];
#pragma unroll
            for (int u = 0; u < 8; ++u) { const bf16* pr = P + (rowb + tt0 + 8 * hf + u) * NIN_E + PC_GV + 128 * h4; v0[u] = bf2f(pr[lane]); v1[u] = bf2f(pr[64 + lane]); }
            *(LAS bf16x8_t*)(VTm + lane * MS + tt0 + 8 * hf) = pack8(v0); *(LAS bf16x8_t*)(VTm + (64 + lane) * MS + tt0 + 8 * hf) = pack8(v1); }
    }
    __syncthreads();
    const int ct = wq; const int col = 16 * ct + l15;
#pragma unroll
    for (int rt = 0; rt < 4; ++rt) { f32x4 acc = (f32x4){0.f, 0.f, 0.f, 0.f};
        if (rt <= ct) { acc = mm64(acc, Kd, rt, Qd, ct, lane);
#pragma unroll
            for (int r = 0; r < 4; ++r) if (!((16 * rt + 4 * lg + r) <= col)) acc[r] = 0.f; }
        tstore(SC, rt, ct, acc, lane); }
    LDS_WAIT(); asm volatile("" ::: "memory");
    const bf16* Sg = (const bf16*)(A->ws + WS_GKV) + (size_t)itemi * 8192;
    f32x4 o[8]; float ss = 0.f;
#pragma unroll
    for (int et = 0; et < 8; ++et) { f32x4 acc = mm64((f32x4){0.f, 0.f, 0.f, 0.f}, VTm, et, SC, ct, lane);
        acc = mfma16(*(const GAS bf16x8_t*)(Sg + (16 * et + l15) * 64 + 8 * lg), ldfrag(Qd, 16 * ct, 0, lane), acc);
        acc = mfma16(*(const GAS bf16x8_t*)(Sg + (16 * et + l15) * 64 + 32 + 8 * lg), ldfrag(Qd, 16 * ct, 32, lane), acc);
        o[et] = acc; ss += (acc[0] * acc[0] + acc[1] * acc[1]) + (acc[2] * acc[2] + acc[3] * acc[3]); }
    ss += __shfl_xor(ss, 16); ss += __shfl_xor(ss, 32);
    const float rs = frsq(ss * (1.f / 128.f) + 1e-5f);
    const size_t row = rowb + col; const float* gn = A->in[25] + i * 512 + 128 * h4;
#pragma unroll
    for (int et = 0; et < 8; ++et) { const int e0 = 16 * et + 4 * lg; const f32x4 g4 = *(const GAS f32x4*)(gn + e0); const f32x4 gg = ld4bf_g(P + row * NIN_E + PC_GG + 128 * h4 + e0);
        f32x4 v = o[et] * rs * g4; v[0] *= silu_f(gg[0]); v[1] *= silu_f(gg[1]); v[2] *= silu_f(gg[2]); v[3] *= silu_f(gg[3]);
        *(GAS v2u*)(XNb + row * D + 512 + 128 * h4 + e0) = pack4(v); }
    __syncthreads();
}
constexpr int N_STEPS = 37;
#ifndef MK_ONE_LAUNCH
#define MK_ONE_LAUNCH 1
#endif
__global__ void __launch_bounds__(NTHREADS, 2) hybrid_fwd(Args args) {
    extern __shared__ __attribute__((aligned(16))) unsigned char lds_raw[];
    LAS unsigned char* lds = (LAS unsigned char*)lds_raw;
    ArgP A0 = (ArgP)__builtin_amdgcn_kernarg_segment_ptr();
    { const int tid = threadIdx.x; for (int u = tid; u < (LDS_BYTES - LDSCTL_OFF) / 4; u += NTHREADS) ((LAS unsigned*)(lds + LDSCTL_OFF))[u] = 0u; }
    __syncthreads();
    const int lo = A0->lo, hi = A0->hi;
    if (hi - lo > 1) (void)xcd_barrier_post((unsigned*)(A0->ws + WS_CTL) + CW_BAR, (volatile LAS unsigned*)(lds + MISC_OFF) + 8);
#ifndef PHM
#define PHM 0xff
#endif
#define RUN(s) (lo <= (s) && (s) < hi)
#define EN(b) ((PHM >> (b)) & 1)
#define GRID_BARRIER() do { ArgP Ab_ = FRESH_ARGS(); XcdBarrier b_; b_.bar = (unsigned*)(Ab_->ws + WS_CTL) + CW_BAR; b_.x = xb_xcc_id(); b_.st = (volatile LAS unsigned*)(lds + MISC_OFF) + 8; xcd_barrier(b_); } while (0)
#define SEAM(s) do { if (RUN(s) && RUN((s) + 1)) GRID_BARRIER(); } while (0)
#define PHASE_VARS() ArgP A = FRESH_ARGS(); int L = Lq; FRESH_S(L); int tid = threadIdx.x; FRESH_V(tid); const int lane = tid & 63, wave = __builtin_amdgcn_readfirstlane(tid >> 6); int G = gridDim.x, bid = blockIdx.x; FRESH_S(G); FRESH_S(bid); (void)lane; (void)wave; (void)G; (void)A; (void)bid; \
    bf16* XN = (bf16*)(A->ws + WS_XN); bf16* PB = (bf16*)(A->ws + WS_P); (void)XN; (void)PB

    for (int Lq = 0; Lq < 4; ++Lq) {
        const int s0 = 9 * Lq; const bool even = !(Lq & 1);
        if (EN(0) && RUN(s0 + 0)) { PHASE_VARS(); const float* xin = (L == 0) ? A->in[0] : A->out; phase_convert_norm(A, L, xin, lds, wave, lane, G, bid); }
        SEAM(s0 + 0);
        if (EN(1) && RUN(s0 + 1)) {
            PHASE_VARS(); bf16* Win = (bf16*)(A->ws + WS_WIN);
            if (even) {
                pg8::Gemm g{XN, Win, M, NIN_E, D}; pg8::StaticOrderC<M, NIN_E> S; S.init(G, bid);
                pg8::EpiStoreBf16 E{PB, NIN_E, 0, 1.0f};
                pg8::gemm_phase<pg8::EpiStoreBf16, pg8::StaticOrderC<M, NIN_E>, PG8_ALIGN, PG8_SP2>(lds, g, S, E);
            } else {
                pg8::Gemm g{XN, Win, M, NIN_O, D}; pg8::StaticOrderC<M, NIN_O> S; S.init(G, bid);
                pg8::EpiStoreBf16 E{PB, NIN_O, 4, 0.125f * 1.4426950408889634f};
                pg8::gemm_phase<pg8::EpiStoreBf16, pg8::StaticOrderC<M, NIN_O>, PG8_ALIGN, PG8_SP2>(lds, g, S, E);
            }
        }
        SEAM(s0 + 1);
        if (even) {
            if (EN(2) && RUN(s0 + 2)) { PHASE_VARS();
#pragma unroll 1
                for (int it = bid; it < BATCH * 64 * 8; it += G) rwkv_chunk_item(A, L, it >> 9, (it >> 3) & 63, it & 7, lds, tid);
#pragma unroll 1
                for (int it = bid; it < BATCH * 64 * 4; it += G) gla_kv_item(A, L, it >> 8, (it >> 2) & 63, it & 3, lds, tid); }
            SEAM(s0 + 2);
            if (EN(3) && RUN(s0 + 3)) {
                PHASE_VARS();
                if (bid < 64) { if (wave == 0) rwkv_state_scan(A, bid >> 3, bid & 7, lane); }
                else { for (int gt = (bid - 64) * NTHREADS + tid; gt < 32 * 2048; gt += (G - 64) * NTHREADS) gla_state_scan(A, gt); }
            }
            SEAM(s0 + 3);
            if (EN(3) && RUN(s0 + 4)) {
                PHASE_VARS();
#pragma unroll 1
                for (int i2 = bid; i2 < BATCH * 64 * 4 / 2; i2 += G) gla_out_group(A, L, i2, lds, tid);
#pragma unroll 1
                for (int wt = bid * NWAVES + wave; wt < BATCH * 64 * 8 * 4; wt += G * NWAVES) { const int it = wt >> 2; rwkv_out_item(A, L, it >> 9, (it >> 3) & 63, it & 7, wt & 3, lane); }
            }
        } else {
            if (EN(4) && RUN(s0 + 3)) { PHASE_VARS(); attn_phase_mfma(A, L, lds, tid, G, bid); }
        }
        if (even ? (RUN(s0 + 4) && RUN(s0 + 5)) : (RUN(s0 + 3) && RUN(s0 + 5))) GRID_BARRIER();
        if (EN(5) && RUN(s0 + 5)) {
            PHASE_VARS(); bf16* Wout = (bf16*)(A->ws + WS_WOUT); const float* xin = (L == 0) ? A->in[0] : A->out;
            pg8::Gemm g{XN, Wout, M, D, D}; pg8::StaticOrderC<M, D> S; S.init(G, bid);
            pg8::EpiResF32 E{xin, A->out, D};
            pg8::gemm_phase<pg8::EpiResF32, pg8::StaticOrderC<M, D>, PG8_ALIGN, PG8_SP2>(lds, g, S, E);
        }
        SEAM(s0 + 5);
        if (RUN(s0 + 6)) {
            PHASE_VARS();
            const int gw = bid * NWAVES + wave, NGW = G * NWAVES; const float* gain = A->in[3] + (size_t)L * D;
            for (int m = gw; m < M; m += NGW) rms_row_bf16(A->out + (size_t)m * D, gain, XN + (size_t)m * D, lane);
        }
        SEAM(s0 + 6);
        if (EN(6) && RUN(s0 + 7)) {
            PHASE_VARS(); bf16* Wgu = (bf16*)(A->ws + WS_WGU);
            pg8::Gemm g{XN, Wgu, M, NGU, D}; pg8::StaticOrderC<M, NGU> S; S.init(G, bid);
            pg8::EpiSwiglu E{PB, FF};
            pg8::gemm_phase<pg8::EpiSwiglu, pg8::StaticOrderC<M, NGU>, PG8_ALIGN, PG8_SP2>(lds, g, S, E);
        }
        SEAM(s0 + 7);
        if (EN(7) && RUN(s0 + 8)) {
            PHASE_VARS(); bf16* Wdn = (bf16*)(A->ws + WS_WDN);
            pg8::Gemm g{PB, Wdn, M, D, FF}; pg8::StaticOrderC<M, D> S; S.init(G, bid);
            pg8::EpiResF32 E{A->out, A->out, D};
            pg8::gemm_phase<pg8::EpiResF32, pg8::StaticOrderC<M, D>, PG8_ALIGN, PG8_SP2>(lds, g, S, E);
        }
        SEAM(s0 + 8);
    }
    if (RUN(36)) {
        int Lq = 0; PHASE_VARS();
        const int gw = bid * NWAVES + wave, NGW = G * NWAVES;
        for (int m = gw; m < M; m += NGW) rms_row_f32(A->out + (size_t)m * D, A->in[4], A->out + (size_t)m * D, lane);
    }
#undef RUN
#undef SEAM
}

extern "C" void kernel_launch(void* const* d_in, const int* in_sizes, int n_in, void* d_out, int out_size, void* d_ws, size_t ws_size, hipStream_t stream) {
    static int grid = 0;
    if (grid == 0) {
        if (n_in != 36 || in_sizes[0] != M * D || out_size != M * D || ws_size < WS_END) { fprintf(stderr, "kernel_launch: unexpected shapes (n_in %d, in0 %d, out %d, ws %zu); nothing launched\n", n_in, n_in > 0 ? in_sizes[0] : -1, out_size, ws_size); grid = -1; return; }
        int dev = 0, cus = 0, per_cu = 0;
        if (hipGetDevice(&dev) != hipSuccess || hipDeviceGetAttribute(&cus, hipDeviceAttributeMultiprocessorCount, dev) != hipSuccess) { grid = -1; return; }
        if (hipFuncSetAttribute((const void*)hybrid_fwd, hipFuncAttributeMaxDynamicSharedMemorySize, LDS_BYTES) != hipSuccess) { fprintf(stderr, "kernel_launch: hipFuncSetAttribute failed\n"); grid = -1; return; }
        if (hipOccupancyMaxActiveBlocksPerMultiprocessor(&per_cu, (const void*)hybrid_fwd, NTHREADS, LDS_BYTES) != hipSuccess || per_cu < 1) fprintf(stderr, "kernel_launch: occupancy query reports %d\n", per_cu);
        (void)hipGetLastError();
        grid = cus;
    }
    if (grid < 0) return;
    if (hipMemsetAsync((char*)d_ws + WS_CTL, 0, CTL_ZERO_BYTES, stream) != hipSuccess) return;
    Args a{};
    for (int i = 0; i < 36; ++i) a.in[i] = (const float*)d_in[i];
    a.out = (float*)d_out; a.ws = (unsigned char*)d_ws;
#if MK_ONE_LAUNCH
    a.lo = 0; a.hi = N_STEPS;
    hipLaunchKernelGGL(hybrid_fwd, dim3(grid), dim3(NTHREADS), LDS_BYTES, stream, a);
#else
    for (int s = 0; s < N_STEPS; ++s) {
        if (s < 36 && ((s % 9) == 2 || (s % 9) == 4) && ((s / 9) & 1)) continue;
        a.lo = s; a.hi = s + 1;
        hipLaunchKernelGGL(hybrid_fwd, dim3(grid), dim3(NTHREADS), LDS_BYTES, stream, a);
    }
#endif
}
```

```cpp
#include <hip/hip_runtime.h>
#include <cstdio>
#include <cstdint>
__device__ __forceinline__ float silu_f(float x) { return x * __builtin_amdgcn_rcpf(1.0f + __builtin_amdgcn_exp2f(-1.4426950408889634f * x)); }
namespace pg8 {
#define PG8_LAS __attribute__((address_space(3)))
typedef unsigned short bf16_t;
typedef short bf16x8 __attribute__((ext_vector_type(8)));
typedef float f32x4 __attribute__((ext_vector_type(4)));
typedef unsigned u32x4 __attribute__((ext_vector_type(4)));
constexpr int BM = 256, BK = 64, HALF = 128, HTB = HALF * BK * 2  , STAGE_BYTES = 8 * HTB, NXCD = 8, WGM = 8;

__host__ __device__ __forceinline__ int lds_byte(int r, int c) { const int st = (r >> 4) * 2 + (c >> 5), rr = r & 15, cc = c & 31, ob = rr * 64 + cc * 2; return st * 1024 + (ob ^ (((ob >> 9) & 1) << 5)); }
__host__ __device__ __forceinline__ void stage_rc(int b, int& R, int& C) { const int st = b / 1024, sb = b % 1024, swz = sb ^ (((sb >> 9) & 1) << 5); R = (st >> 1) * 16 + swz / 64; C = (st & 1) * 32 + (swz % 64) / 2; }
__host__ __device__ __forceinline__ int perm32(int rho) { const int n = rho >> 4, i = rho & 15; return 8 * (i >> 2) + 4 * n + (i & 3); }

struct Unit { int pm, pn; };
struct Gemm { const bf16_t* A; const bf16_t* Bt; int M, N, K; };

struct StaticOrder {
    int nM, nN, nwg, G, c;
    __host__ __device__ void init(int M, int N, int G_, int c_) { nM = M / BM; nN = N / BM; nwg = nM * nN; G = G_; c = c_; }
    __host__ __device__ bool next(int i, Unit& u) const {
        const long L = (long)i * G + c; if (L >= nwg) return false;
        int wgid = (int)L; { const int q = nwg / NXCD, r = nwg % NXCD, xcd = wgid % NXCD, off = wgid / NXCD; wgid = (xcd < r ? xcd * (q + 1) : r * (q + 1) + (xcd - r) * q) + off; }
        const int nig = WGM * nN, gid = wgid / nig, fm = gid * WGM, gsz = (nM - fm) < WGM ? (nM - fm) : WGM;
        u.pm = fm + ((wgid % nig) % gsz); u.pn = (wgid % nig) / gsz; return true;
    }
    __device__ __forceinline__ void a_ready(const Unit&) const {}
    __device__ __forceinline__ void done(const Unit&) const {}
};

__device__ __forceinline__ unsigned cvt_pk_bf16(float lo, float hi) { unsigned r; asm volatile("v_cvt_pk_bf16_f32 %0, %1, %2" : "=v"(r) : "v"(lo), "v"(hi)); return r; }
typedef float f32x2 __attribute__((ext_vector_type(2)));
struct EpiStoreBf16 {
    static constexpr bool PERM = true, AFTER_DRAIN = false;
    bf16_t* O; int ldc; int qtiles; float qscale;
    __device__ __forceinline__ void operator()(const f32x4 (&acc)[2][2][4][2], const Unit& u, int wr, int wc, int fr, int fq) const {
        const int row0 = u.pm * BM + wr * 64 + fr, col0 = u.pn * BM + wc * 32 + 8 * fq;
        const float sc = u.pn < qtiles ? qscale : 1.0f;
#pragma unroll
        for (int ai = 0; ai < 2; ++ai)
#pragma unroll
            for (int m = 0; m < 4; ++m) { bf16_t* rowp = O + (size_t)(row0 + ai * HALF + m * 16) * ldc + col0;
#pragma unroll
                for (int bj = 0; bj < 2; ++bj) { const f32x4 v0 = acc[ai][bj][m][0] * sc, v1 = acc[ai][bj][m][1] * sc;
                    u32x4 w; w.x = cvt_pk_bf16(v0[0], v0[1]); w.y = cvt_pk_bf16(v0[2], v0[3]); w.z = cvt_pk_bf16(v1[0], v1[1]); w.w = cvt_pk_bf16(v1[2], v1[3]);
                    *(u32x4*)(rowp + bj * HALF) = w; } }
    }
};
struct EpiResF32 {
    static constexpr bool PERM = false, AFTER_DRAIN = false;
    const float* base; float* out; int ldc;
    __device__ __forceinline__ void operator()(const f32x4 (&acc)[2][2][4][2], const Unit& u, int wr, int wc, int fr, int fq) const {
        const int row0 = u.pm * BM + wr * 64 + fr, col0 = u.pn * BM + wc * 32 + 4 * fq;
#pragma unroll
        for (int ai = 0; ai < 2; ++ai)
#pragma unroll
            for (int m = 0; m < 4; ++m) { const size_t off = (size_t)(row0 + ai * HALF + m * 16) * ldc + col0;
#pragma unroll
                for (int bj = 0; bj < 2; ++bj)
#pragma unroll
                    for (int n = 0; n < 2; ++n) { const f32x4 b = *(const f32x4*)(base + off + bj * HALF + n * 16); *(f32x4*)(out + off + bj * HALF + n * 16) = b + acc[ai][bj][m][n]; }
                if (m & 1) asm volatile("" ::: "memory"); }
    }
};
struct EpiSwiglu {
    static constexpr bool PERM = true, AFTER_DRAIN = false;
    bf16_t* H; int ldc;
    __device__ __forceinline__ void operator()(const f32x4 (&acc)[2][2][4][2], const Unit& u, int wr, int wc, int fr, int fq) const {
        const int row0 = u.pm * BM + wr * 64 + fr, colh = u.pn * HALF + wc * 32 + 8 * fq;
#pragma unroll
        for (int ai = 0; ai < 2; ++ai)
#pragma unroll
            for (int m = 0; m < 4; ++m) { bf16_t* rowp = H + (size_t)(row0 + ai * HALF + m * 16) * ldc + colh;
                const f32x4 g0 = acc[ai][0][m][0], g1 = acc[ai][0][m][1], u0 = acc[ai][1][m][0], u1 = acc[ai][1][m][1];
                float h[8];
#pragma unroll
                for (int e = 0; e < 4; ++e) { h[e] = silu_f(g0[e]) * u0[e]; h[4 + e] = silu_f(g1[e]) * u1[e]; }
                u32x4 w; w.x = cvt_pk_bf16(h[0], h[1]); w.y = cvt_pk_bf16(h[2], h[3]); w.z = cvt_pk_bf16(h[4], h[5]); w.w = cvt_pk_bf16(h[6], h[7]);
                *(u32x4*)rowp = w; }
    }
};
template <int M_, int N_> struct StaticOrderC {
    static constexpr int nM = M_ / BM, nN = N_ / BM, nwg = nM * nN;
    int G, c;
    __device__ __forceinline__ void init(int G_, int c_) { G = G_; c = c_; }
    __device__ __forceinline__ bool next(int i, Unit& u) const {
        const int L = i * G + c; if (L >= nwg) return false;
        int wgid = L; { constexpr int q = nwg / NXCD, r = nwg % NXCD; const int xcd = wgid % NXCD, off = wgid / NXCD; wgid = (xcd < r ? xcd * (q + 1) : r * (q + 1) + (xcd - r) * q) + off; }
        constexpr int nig = WGM * nN; const int gid = wgid / nig, fm = gid * WGM, gsz = (nM - fm) < WGM ? (nM - fm) : WGM;
        u.pm = fm + ((wgid % nig) % gsz); u.pn = (wgid % nig) / gsz; return true;
    }
    __device__ __forceinline__ void a_ready(const Unit&) const {}
    __device__ __forceinline__ void done(const Unit&) const {}
};
template <class Epi, class Sched, bool ALIGN_EPI = false, bool SP2 = false>
__device__ __forceinline__ void gemm_phase(PG8_LAS unsigned char* lds, const Gemm g, const Sched& S, const Epi& E) {
    int tid_ = threadIdx.x; asm volatile("" : "+v"(tid_));
    float zz_ = 0.f; asm volatile("" : "+v"(zz_));
    const int tid = tid_, wid = __builtin_amdgcn_readfirstlane(tid >> 6), lane = tid & 63, wr = wid >> 2, wc = wid & 3, fr = lane & 15, fq = lane >> 4;
    const int K = g.K, nt = K / BK;
    unsigned voffA[2], voffB[2];
#pragma unroll
    for (int i = 0; i < 2; ++i) { int R, C; stage_rc(tid * 16 + i * 8192, R, C); const int Rb = Epi::PERM ? ((R & ~31) + perm32(R & 31)) : R;
        voffA[i] = (unsigned)(R * K + C) * 2u; voffB[i] = (unsigned)(Rb * K + C) * 2u; }
    const size_t kstep = (size_t)(BK * 2);
    const size_t hstep = (size_t)HALF * K * 2;
    const size_t tstep = 2 * hstep;
    const unsigned ldsw = (unsigned)wid * 1024u;
    const int aoff = lds_byte(wr * 64 + fr, fq * 8), boff = lds_byte(wc * 32 + fr, fq * 8);
#define PG8_SA(b, h) (((b) * 2 + (h)) * HTB)
#define PG8_SB(b, h) ((4 + (b) * 2 + (h)) * HTB)
#define PG8_STAGE(bufoff, gbase, voff) do { _Pragma("unroll") for (int _i = 0; _i < 2; ++_i) \
        __builtin_amdgcn_global_load_lds((const unsigned*)((const char*)(gbase) + (voff)[_i]), (PG8_LAS unsigned*)(lds + (bufoff) + ldsw + _i * 8192), 16, 0, 0); } while (0)
#define PG8_LDA(dst, b, h) do { _Pragma("unroll") for (int m = 0; m < 4; ++m) _Pragma("unroll") for (int k = 0; k < 2; ++k) dst[m][k] = *(const PG8_LAS bf16x8*)(lds + PG8_SA(b, h) + aoff + m * 2048 + k * 1024); } while (0)
#define PG8_LDB(dst, b, h) do { _Pragma("unroll") for (int n = 0; n < 2; ++n) _Pragma("unroll") for (int k = 0; k < 2; ++k) dst[n][k] = *(const PG8_LAS bf16x8*)(lds + PG8_SB(b, h) + boff + n * 2048 + k * 1024); } while (0)
#define PG8_MMA(ai, bj, At, Bt) do { __builtin_amdgcn_s_setprio(1); _Pragma("unroll") for (int m = 0; m < 4; ++m) _Pragma("unroll") for (int n = 0; n < 2; ++n) _Pragma("unroll") for (int k = 0; k < 2; ++k) \
        acc[ai][bj][m][n] = __builtin_amdgcn_mfma_f32_16x16x32_bf16(Bt[n][k], At[m][k], acc[ai][bj][m][n], 0, 0, 0); __builtin_amdgcn_s_setprio(0); } while (0)
#define PG8_WAIT_V(n) asm volatile("s_waitcnt vmcnt(" #n ")" ::: "memory")
#define PG8_WAIT_L(n) asm volatile("s_waitcnt lgkmcnt(" #n ")" ::: "memory")
#define PG8_BAR __builtin_amdgcn_s_barrier()
#define PG8_SCHED __builtin_amdgcn_sched_barrier(0)
    Unit cur, nxt; int ui = 0;
    if (!S.next(0, cur)) return;
    f32x4 acc[2][2][4][2];
#pragma unroll
    for (int a = 0; a < 2; ++a)
#pragma unroll
        for (int b = 0; b < 2; ++b)
#pragma unroll
            for (int m = 0; m < 4; ++m)
#pragma unroll
                for (int n = 0; n < 2; ++n) acc[a][b][m][n] = (f32x4){zz_, zz_, zz_, zz_};
    bf16x8 At[4][2], B0[2][2], B1[2][2];
    const char* cA = (const char*)g.A + (size_t)cur.pm * tstep; const char* cB = (const char*)g.Bt + (size_t)cur.pn * tstep;
    S.a_ready(cur);
    if constexpr (SP2) {
        PG8_STAGE(PG8_SB(0, 0), cB, voffB); PG8_STAGE(PG8_SB(0, 1), cB + hstep, voffB); PG8_STAGE(PG8_SA(0, 0), cA, voffA); PG8_STAGE(PG8_SA(0, 1), cA + hstep, voffA);
        if (wr == 1) PG8_BAR;
        PG8_WAIT_V(2); PG8_BAR;
        PG8_STAGE(PG8_SB(1, 0), cB + kstep, voffB); PG8_STAGE(PG8_SA(1, 0), cA + kstep, voffA); PG8_STAGE(PG8_SB(1, 1), cB + hstep + kstep, voffB);
        PG8_WAIT_V(6); PG8_BAR;
    } else {
        PG8_STAGE(PG8_SB(0, 0), cB, voffB); PG8_STAGE(PG8_SA(0, 0), cA, voffA); PG8_STAGE(PG8_SB(0, 1), cB + hstep, voffB); PG8_STAGE(PG8_SA(0, 1), cA + hstep, voffA);
        if (wr == 1) PG8_BAR;
        PG8_WAIT_V(4); PG8_BAR;
        PG8_STAGE(PG8_SB(1, 0), cB + kstep, voffB); PG8_STAGE(PG8_SA(1, 0), cA + kstep, voffA); PG8_STAGE(PG8_SB(1, 1), cB + hstep + kstep, voffB);
        PG8_WAIT_V(6); PG8_BAR;
    }
    for (;;) {
        const bool has_next = S.next(ui + 1, nxt);
        const char* nA = has_next ? (const char*)g.A + (size_t)nxt.pm * tstep : cA; const char* nB = has_next ? (const char*)g.Bt + (size_t)nxt.pn * tstep : cB;
        for (int t = 0; t < nt; t += 2) {
            const bool last = (t == nt - 2);
            const char* a1 = cA + (size_t)(t + 1) * kstep;
            const char* a2 = last ? nA : cA + (size_t)(t + 2) * kstep; const char* b2 = last ? nB : cB + (size_t)(t + 2) * kstep;
            const char* a3 = a2 + kstep; const char* b3 = b2 + kstep;
            if (last && has_next) S.a_ready(nxt);
            if constexpr (SP2) {
            PG8_LDB(B0, 0, 0); PG8_LDB(B1, 0, 1); PG8_SCHED; PG8_LDA(At, 0, 0); PG8_STAGE(PG8_SA(1, 1), a1 + hstep, voffA);
            PG8_WAIT_V(8); PG8_WAIT_L(0); PG8_BAR; PG8_MMA(0, 0, At, B0); PG8_MMA(0, 1, At, B1); PG8_BAR; PG8_SCHED;
            PG8_LDA(At, 0, 1); PG8_STAGE(PG8_SB(0, 0), b2, voffB); PG8_STAGE(PG8_SB(0, 1), b2 + hstep, voffB); PG8_STAGE(PG8_SA(0, 0), a2, voffA);
            PG8_WAIT_V(8); PG8_WAIT_L(0); PG8_BAR; PG8_MMA(1, 0, At, B0); PG8_MMA(1, 1, At, B1); PG8_BAR; PG8_SCHED;
            PG8_LDB(B0, 1, 0); PG8_LDB(B1, 1, 1); PG8_SCHED; PG8_LDA(At, 1, 0); PG8_STAGE(PG8_SA(0, 1), a2 + hstep, voffA);
            PG8_WAIT_V(8); PG8_WAIT_L(0); PG8_BAR; PG8_MMA(0, 0, At, B0); PG8_MMA(0, 1, At, B1); PG8_BAR; PG8_SCHED;
            PG8_LDA(At, 1, 1); PG8_STAGE(PG8_SB(1, 0), b3, voffB); PG8_STAGE(PG8_SB(1, 1), b3 + hstep, voffB); PG8_STAGE(PG8_SA(1, 0), a3, voffA);
            PG8_WAIT_V(8); PG8_WAIT_L(0); PG8_BAR; PG8_MMA(1, 0, At, B0); PG8_MMA(1, 1, At, B1); PG8_BAR; PG8_SCHED;
            } else {
            PG8_LDB(B0, 0, 0); PG8_SCHED; PG8_LDA(At, 0, 0); PG8_STAGE(PG8_SA(1, 1), a1 + hstep, voffA);
            PG8_WAIT_L(8); PG8_BAR; PG8_WAIT_L(0); PG8_MMA(0, 0, At, B0); PG8_BAR; PG8_SCHED;
            PG8_LDB(B1, 0, 1); PG8_STAGE(PG8_SB(0, 0), b2, voffB);
            PG8_BAR; PG8_WAIT_L(0); PG8_MMA(0, 1, At, B1); PG8_BAR;
            PG8_LDA(At, 0, 1); PG8_STAGE(PG8_SA(0, 0), a2, voffA);
            PG8_BAR; PG8_WAIT_L(0); PG8_MMA(1, 0, At, B0); PG8_BAR; PG8_SCHED;
            PG8_STAGE(PG8_SB(0, 1), b2 + hstep, voffB);
            PG8_WAIT_V(6); PG8_BAR; PG8_MMA(1, 1, At, B1); PG8_BAR;
            PG8_LDB(B0, 1, 0); PG8_SCHED; PG8_LDA(At, 1, 0); PG8_STAGE(PG8_SA(0, 1), a2 + hstep, voffA);
            PG8_WAIT_L(8); PG8_BAR; PG8_WAIT_L(0); PG8_MMA(0, 0, At, B0); PG8_BAR; PG8_SCHED;
            PG8_LDB(B1, 1, 1); PG8_STAGE(PG8_SB(1, 0), b3, voffB);
            PG8_BAR; PG8_WAIT_L(0); PG8_MMA(0, 1, At, B1); PG8_BAR;
            PG8_LDA(At, 1, 1); PG8_STAGE(PG8_SA(1, 0), a3, voffA);
            PG8_BAR; PG8_WAIT_L(0); PG8_MMA(1, 0, At, B0); PG8_BAR; PG8_SCHED;
            PG8_STAGE(PG8_SB(1, 1), b3 + hstep, voffB);
            PG8_WAIT_V(6); PG8_BAR; PG8_MMA(1, 1, At, B1); PG8_BAR;
            }
        }
        if constexpr (ALIGN_EPI) { if (wr == 0) PG8_BAR; }
        if constexpr (!Epi::AFTER_DRAIN) { E(acc, cur, wr, wc, fr, fq); S.done(cur); }
        if (!has_next) break;
#pragma unroll
        for (int a = 0; a < 2; ++a)
#pragma unroll
            for (int b = 0; b < 2; ++b)
#pragma unroll
                for (int m = 0; m < 4; ++m)
#pragma unroll
                    for (int n = 0; n < 2; ++n) acc[a][b][m][n] = (f32x4){zz_, zz_, zz_, zz_};
        cur = nxt; cA = nA; cB = nB; ++ui;
        if constexpr (ALIGN_EPI) { if (wr == 1) PG8_BAR; }
    }
    PG8_WAIT_V(0);
    if constexpr (!ALIGN_EPI) { if (wr == 0) PG8_BAR; }
    PG8_BAR;
    if constexpr (Epi::AFTER_DRAIN) { E.fused(acc, cur, wr, wc, fr, fq, lds, wid, lane); S.done(cur); }
#undef PG8_SA
#undef PG8_SB
#undef PG8_STAGE
#undef PG8_LDA
#undef PG8_LDB
#undef PG8_MMA
#undef PG8_WAIT_V
#undef PG8_WAIT_L
#undef PG8_BAR
#undef PG8_SCHED
}
}
#ifndef PG8_SP2
#define PG8_SP2 true
#endif
#ifndef PG8_ALIGN
#define PG8_ALIGN true
#endif
constexpr int NWAVES = 8, NTHREADS = NWAVES * 64;
constexpr int BATCH = 8, T = 4096, D = 1024, M = BATCH * T;
constexpr int NIN_E = 3840, NIN_O = 3072, FF = 2816, NGU = 2 * FF;
constexpr int PC_R = 0, PC_K = 512, PC_V = 1024, PC_GQ = 1536, PC_GK = 1792, PC_GV = 2048, PC_GG = 2560;
constexpr int PC_W1A = 3072, PC_W1B = 3136, PC_A1A = 3200, PC_A1B = 3264, PC_G1A = 3328, PC_G1B = 3488, PC_WA1 = 3648, PC_PAD = 3664;
constexpr int NLORA = 304;
constexpr size_t MiB = 1u << 20;
constexpr size_t WS_CTL = 0, CTL_ZERO_BYTES = 1 * MiB;
constexpr size_t WS_WIN = 2 * MiB, WS_WOUT = 10 * MiB, WS_WGU = 12 * MiB, WS_WDN = 23 * MiB;
constexpr size_t WS_W2T = 29 * MiB, WS_A2T = WS_W2T + 65536, WS_G2T = WS_A2T + 65536, WS_WA2T = WS_G2T + 196608;
constexpr size_t WS_XN = 32 * MiB;
constexpr size_t WS_P = 96 * MiB;
constexpr size_t WS_WLOG = 336 * MiB;
constexpr size_t WS_ASIG = 400 * MiB;
constexpr size_t WS_LA = 464 * MiB;
constexpr size_t WS_END = 496 * MiB;
constexpr int CW_BAR = 4096;
constexpr int RING_BYTES = 135168, LDSCTL_OFF = RING_BYTES, MISC_OFF = LDSCTL_OFF + 320, LDS_BYTES = 147456;

#define GAS __attribute__((address_space(1)))
#define LAS __attribute__((address_space(3)))
typedef unsigned short bf16;
typedef unsigned v4u __attribute__((ext_vector_type(4)));
typedef unsigned v2u __attribute__((ext_vector_type(2)));
typedef float f32x4 __attribute__((ext_vector_type(4)));
#define LDS_WAIT() asm volatile("s_waitcnt lgkmcnt(0)" ::: "memory")
#define VM_WAIT() asm volatile("s_waitcnt vmcnt(0)" ::: "memory")
__device__ __forceinline__ unsigned f2bf(float f) { unsigned u = __builtin_bit_cast(unsigned, f); return (u + 0x7fffu + ((u >> 16) & 1u)) >> 16; }
__device__ __forceinline__ unsigned pk2(float lo, float hi) { return f2bf(lo) | (f2bf(hi) << 16); }
__device__ __forceinline__ float bf2f(bf16 u) { return __builtin_bit_cast(float, (unsigned)u << 16); }
__device__ __forceinline__ float bflo(unsigned w) { return __builtin_bit_cast(float, w << 16); }
__device__ __forceinline__ float bfhi(unsigned w) { return __builtin_bit_cast(float, w & 0xffff0000u); }
__device__ __forceinline__ float wave_sum(float v) {
#pragma unroll
    for (int o = 1; o < 64; o <<= 1) v += __shfl_xor(v, o);
    return v;
}
__device__ __forceinline__ float wave_max(float v) {
#pragma unroll
    for (int o = 1; o < 64; o <<= 1) v = fmaxf(v, __shfl_xor(v, o));
    return v;
}
__device__ __forceinline__ float fexp(float x) { return __builtin_amdgcn_exp2f(x * 1.4426950408889634f); }
__device__ __forceinline__ float flog(float x) { return __builtin_amdgcn_logf(x) * 0.6931471805599453f; }
__device__ __forceinline__ float frcp(float x) { return __builtin_amdgcn_rcpf(x); }
__device__ __forceinline__ float frsq(float x) { return __builtin_amdgcn_rsqf(x); }
__device__ __forceinline__ float fsqrt(float x) { return __builtin_amdgcn_sqrtf(x); }
__device__ __forceinline__ float sigmoid_f(float x) { return frcp(1.0f + fexp(-x)); }
__device__ __forceinline__ float softplus_f(float x) { return fmaxf(x, 0.f) + flog(1.0f + fexp(-fabsf(x))); }
__device__ __forceinline__ float tanh_f(float x) { return 1.0f - 2.0f * frcp(1.0f + fexp(2.0f * x)); }
#define XB_TMO      128
#define XB_XCNT(j)  (256  + 64 * (j))
#define XB_XSUB(j)  (1280 + 64 * (j))
#define XB_XGEN(j)  (2304 + 64 * (j))
#define XB_TOP      3328
#define XB_TOPGEN   3392
#define XCD_BAR_WORDS 3456
#define XB_SPIN_CAP (1u << 23)

__device__ __forceinline__ unsigned xb_ld(unsigned* p)              { return __hip_atomic_load(p, __ATOMIC_RELAXED, __HIP_MEMORY_SCOPE_AGENT); }
__device__ __forceinline__ unsigned xb_add(unsigned* p, unsigned v) { return __hip_atomic_fetch_add(p, v, __ATOMIC_RELAXED, __HIP_MEMORY_SCOPE_AGENT); }
__device__ __forceinline__ unsigned xb_xcc_id() { return (unsigned)__builtin_amdgcn_s_getreg((3 << 11) | 20) & 0xFu; }
#define XB_SPIN(cond, bar) do { unsigned _sp = 0; while (cond) { __builtin_amdgcn_s_sleep(1); \
    if ((++_sp & 255u) == 0u) { if (xb_ld(&(bar)[XB_TMO])) break; if (_sp > XB_SPIN_CAP) { atomicAdd(&(bar)[XB_TMO], 1u); break; } } } } while (0)

struct XcdBarrier {
    unsigned* bar; unsigned x;
    volatile LAS unsigned* st;
};

__device__ __forceinline__ XcdBarrier xcd_barrier_post(unsigned* bar, volatile LAS unsigned* st) {
    XcdBarrier b; b.bar = bar; b.x = xb_xcc_id(); b.st = st;
    if (threadIdx.x == 0) (void)xb_add(&bar[XB_XCNT(b.x)], 1u);
    return b;
}
__device__ __forceinline__ void xcd_barrier_complete(unsigned* bar, unsigned x, unsigned& nloc, unsigned& nx) {
    const unsigned G = gridDim.x * gridDim.y * gridDim.z;
    unsigned sum, cnt, mine, sp = 0u;
    for (;;) {
        sum = 0u; cnt = 0u; mine = 0u;
#pragma unroll
        for (unsigned j = 0; j < 16; ++j) { const unsigned c = xb_ld(&bar[XB_XCNT(j)]); sum += c; cnt += (c > 0u) ? 1u : 0u; mine = (j == x) ? c : mine; }
        if (sum == G) break;
        __builtin_amdgcn_s_sleep(1);
        if ((++sp & 255u) == 0u) { if (xb_ld(&bar[XB_TMO])) break; if (sp > XB_SPIN_CAP) { atomicAdd(&bar[XB_TMO], 1u); break; } }
    }
    nloc = mine > 0u ? mine : 1u; nx = cnt > 0u ? cnt : 1u;
}

__device__ __forceinline__ void xcd_barrier(const XcdBarrier& b) {
    asm volatile("s_waitcnt vmcnt(0)" ::: "memory");
    __syncthreads();
    if (threadIdx.x == 0) {
        unsigned blo_ = __builtin_amdgcn_readfirstlane((unsigned)(unsigned long long)b.bar), bhi_ = __builtin_amdgcn_readfirstlane((unsigned)((unsigned long long)b.bar >> 32)), bx = __builtin_amdgcn_readfirstlane(b.x); asm volatile("" : "+s"(blo_), "+s"(bhi_), "+s"(bx)); unsigned* bar = (unsigned*)(((unsigned long long)bhi_ << 32) | blo_);
        __builtin_amdgcn_s_waitcnt(0);
        unsigned nloc = b.st[0], nx = b.st[1];
        if (nloc == 0u) { xcd_barrier_complete(bar, bx, nloc, nx); b.st[0] = nloc; b.st[1] = nx; }
        const unsigned old = xb_add(&bar[XB_XSUB(bx)], 1u);
        const unsigned gen = old / nloc;
        if (old + 1u == (gen + 1u) * nloc) {
            __builtin_amdgcn_fence(__ATOMIC_RELEASE, "agent");
            asm volatile("s_waitcnt vmcnt(0)" ::: "memory");
            const unsigned og = xb_add(&bar[XB_TOP], 1u);
            const unsigned tg = og / nx;
            if (og + 1u == (tg + 1u) * nx) xb_add(&bar[XB_TOPGEN], 1u);
            else XB_SPIN(xb_ld(&bar[XB_TOPGEN]) == tg, bar);
            __builtin_amdgcn_fence(__ATOMIC_ACQUIRE, "agent");
            xb_add(&bar[XB_XGEN(bx)], 1u);
            asm volatile("s_waitcnt vmcnt(0)" ::: "memory");
        } else {
            XB_SPIN(xb_ld(&bar[XB_XGEN(bx)]) == gen, bar);
            __builtin_amdgcn_fence(__ATOMIC_ACQUIRE, "agent");
            asm volatile("s_waitcnt vmcnt(0)" ::: "memory");
        }
    }
    __syncthreads();
}
__device__ __forceinline__ void tr_item(const float* __restrict__ W, int Kreal, int N, bf16* WT, int ldd, int dst_row0, LAS float* scr, int k0, int n0, int lane,
                                        const float* __restrict__ mu, float sc0, float sc1) {
    const int nn = n0 + (lane & 31); const bool nv = nn < N;
#pragma unroll 8
    for (int i = 0; i < 32; ++i) { const int kk = 2 * i + (lane >> 5); float v = (nv && k0 + kk < Kreal) ? W[(size_t)(k0 + kk) * N + nn] : 0.f; if (mu) v *= sc0 + sc1 * mu[k0 + kk]; scr[kk * 33 + (lane & 31)] = v; }
    LDS_WAIT(); asm volatile("" ::: "memory");
    const int c = lane & 7;
#pragma unroll
    for (int j = 0; j < 4; ++j) { const int n = (lane >> 3) + 8 * j; const LAS float* s = scr + (8 * c) * 33 + n;
        v4u o; o.x = pk2(s[0 * 33], s[1 * 33]); o.y = pk2(s[2 * 33], s[3 * 33]); o.z = pk2(s[4 * 33], s[5 * 33]); o.w = pk2(s[6 * 33], s[7 * 33]);
        if (n0 + n < N) *(GAS v4u*)(WT + (size_t)(dst_row0 + n) * ldd + k0 + 8 * c) = o; }
    LDS_WAIT(); asm volatile("" ::: "memory");
}
__device__ __forceinline__ void rms_row_bf16(const float* xrow, const float* g, bf16* orow, int lane) {
    const GAS f32x4* xr = (const GAS f32x4*)xrow + lane; const GAS f32x4* gr = (const GAS f32x4*)g + lane;
    f32x4 v[4]; float s = 0.f;
#pragma unroll
    for (int j = 0; j < 4; ++j) { v[j] = xr[64 * j]; s += (v[j].x * v[j].x + v[j].y * v[j].y) + (v[j].z * v[j].z + v[j].w * v[j].w); }
    const float rs = frsq(wave_sum(s) * (1.f / D) + 1e-6f);
    GAS v2u* o8 = (GAS v2u*)orow + lane;
#pragma unroll
    for (int j = 0; j < 4; ++j) { const f32x4 gv = gr[64 * j]; v2u o; o.x = pk2(v[j].x * rs * gv.x, v[j].y * rs * gv.y); o.y = pk2(v[j].z * rs * gv.z, v[j].w * rs * gv.w); o8[64 * j] = o; }
}
__device__ __forceinline__ void rms_row_f32(const float* xrow, const float* g, float* orow, int lane) {
    const GAS f32x4* xr = (const GAS f32x4*)xrow + lane; const GAS f32x4* gr = (const GAS f32x4*)g + lane;
    f32x4 v[4]; float s = 0.f;
#pragma unroll
    for (int j = 0; j < 4; ++j) { v[j] = xr[64 * j]; s += (v[j].x * v[j].x + v[j].y * v[j].y) + (v[j].z * v[j].z + v[j].w * v[j].w); }
    const float rs = frsq(wave_sum(s) * (1.f / D) + 1e-6f);
    GAS f32x4* o = (GAS f32x4*)orow + lane;
#pragma unroll
    for (int j = 0; j < 4; ++j) { const f32x4 gv = gr[64 * j]; o[64 * j] = v[j] * rs * gv; }
}

struct Args { const float* in[36]; float* out; unsigned char* ws; int lo, hi; };
typedef const __attribute__((address_space(4))) Args* ArgP;
#define FRESH_ARGS() ({ ArgP p_ = (ArgP)__builtin_amdgcn_kernarg_segment_ptr(); asm volatile("" : "+s"(p_)); p_; })
#define FRESH_V(x) asm volatile("" : "+v"(x))
#define FRESH_S(x) asm volatile("" : "+s"(x))

__device__ __forceinline__ void phase_convert_norm(ArgP A, int L, const float* xin, LAS unsigned char* lds, int wave, int lane, int G, int bid) {
    const int i = L >> 1; const bool even = !(L & 1);
    bf16* Win = (bf16*)(A->ws + WS_WIN); bf16* Wout = (bf16*)(A->ws + WS_WOUT); bf16* Wgu = (bf16*)(A->ws + WS_WGU); bf16* Wdn = (bf16*)(A->ws + WS_WDN);
    LAS float* scr = (LAS float*)(lds + wave * 16384);
    const int gw = bid * NWAVES + wave, NGW = G * NWAVES;
    const float* w_in = even ? A->in[5] + (size_t)i * D * 3072 : A->in[26] + (size_t)i * D * 3072;
    const float* w_out = even ? A->in[6] + (size_t)i * D * D : A->in[27] + (size_t)i * D * D;
    const float* mu_w = A->in[8] + (size_t)i * 3 * D, *mu_a = mu_w + D, *mu_g = mu_w + 2 * D;
    const float* w1 = A->in[10] + (size_t)i * D * 64, *a1 = A->in[13] + (size_t)i * D * 64, *g1 = A->in[15] + (size_t)i * D * 160, *wa1 = A->in[22] + (size_t)i * D * 16;
    const float* wg = A->in[33] + (size_t)L * D * FF, *wu = A->in[34] + (size_t)L * D * FF, *wd = A->in[35] + (size_t)L * FF * D;
    const int I_IN = 16 * 96, I_L64 = 16 * 2, I_L160 = 16 * 5, I_L16 = 16 * 1, I_OUT = 16 * 32, I_GU = 16 * 88, I_DN = 44 * 32;
    const int n_lora = even ? (4 * I_L64 + 2 * I_L160 + I_L16 + 16 + 16 + 48) : 0;
    const float* w2s = A->in[11] + (size_t)i * 64 * 512, *a2s = A->in[14] + (size_t)i * 64 * 512, *g2s = A->in[16] + (size_t)i * 160 * 512;
    bf16* W2T = (bf16*)(A->ws + WS_W2T); bf16* A2T = (bf16*)(A->ws + WS_A2T); bf16* G2T = (bf16*)(A->ws + WS_G2T);
    const int NITEMS = I_IN + n_lora + I_OUT + 2 * I_GU + I_DN;
#define TR_JOB(items, nblk, Wp, Kd, Nd, DST, LDD, ROW0, MU, S0, S1) if (r < (items)) { const int kb = r / (nblk), nb = r % (nblk), n0 = 32 * nb; tr_item(Wp, Kd, Nd, DST, LDD, ROW0, scr, 64 * kb, n0, lane, MU, S0, S1); continue; } r -= (items);
    for (int it = gw; it < NITEMS; it += NGW) {
        int r = it;
        TR_JOB(I_IN, 96, w_in, D, 3072, Win, D, n0, nullptr, 1.f, 0.f)
        if (even) {
            TR_JOB(I_L64, 2, w1, D, 64, Win, D, PC_W1A + n0, mu_w, 1.f, -1.f)
            TR_JOB(I_L64, 2, w1, D, 64, Win, D, PC_W1B + n0, mu_w, 0.f, 1.f)
            TR_JOB(I_L64, 2, a1, D, 64, Win, D, PC_A1A + n0, mu_a, 1.f, -1.f)
            TR_JOB(I_L64, 2, a1, D, 64, Win, D, PC_A1B + n0, mu_a, 0.f, 1.f)
            TR_JOB(I_L160, 5, g1, D, 160, Win, D, PC_G1A + n0, mu_g, 1.f, -1.f)
            TR_JOB(I_L160, 5, g1, D, 160, Win, D, PC_G1B + n0, mu_g, 0.f, 1.f)
            TR_JOB(I_L16, 1, wa1, D, 16, Win, D, PC_WA1 + n0, nullptr, 1.f, 0.f)
            TR_JOB(16, 16, w2s, 64, 512, W2T, 64, n0, nullptr, 1.f, 0.f)
            TR_JOB(16, 16, a2s, 64, 512, A2T, 64, n0, nullptr, 1.f, 0.f)
            TR_JOB(48, 16, g2s, 160, 512, G2T, 192, n0, nullptr, 1.f, 0.f)
        }
        TR_JOB(I_OUT, 32, w_out, D, D, Wout, D, n0, nullptr, 1.f, 0.f)
        TR_JOB(I_GU, 88, wg, D, FF, Wgu, D, 256 * (n0 >> 7) + (n0 & 127), nullptr, 1.f, 0.f)
        TR_JOB(I_GU, 88, wu, D, FF, Wgu, D, 256 * (n0 >> 7) + (n0 & 127) + 128, nullptr, 1.f, 0.f)
        TR_JOB(I_DN, 32, wd, FF, D, Wdn, FF, n0, nullptr, 1.f, 0.f)
    }
#undef TR_JOB
    if (even) {
        const int gt = bid * NTHREADS + wave * 64 + lane, NT = G * NTHREADS;
        for (int e = gt; e < (NIN_E - PC_PAD) * D / 8; e += NT) ((GAS v4u*)(Win + (size_t)PC_PAD * D))[e] = (v4u){0u, 0u, 0u, 0u};
        { bf16* WA2T = (bf16*)(A->ws + WS_WA2T); const float* wa2 = A->in[23] + (size_t)i * 16 * 256;
          for (int e = gt; e < 256 * 32; e += NT) { const int nn = e >> 5, k = e & 31; WA2T[e] = k < 16 ? (bf16)f2bf(wa2[k * 256 + nn]) : (bf16)0; } }
    }
    bf16* XN = (bf16*)(A->ws + WS_XN); const float* gain = A->in[2] + (size_t)L * D;
    for (int m = gw; m < M; m += NGW) rms_row_bf16(xin + (size_t)m * D, gain, XN + (size_t)m * D, lane);
}

__device__ __forceinline__ void phase_prep(ArgP A, int L, LAS unsigned char* lds, int G, int tid, int bid) {
    const int i = L >> 1;
    const bf16* P = (const bf16*)(A->ws + WS_P); float* LA = (float*)(A->ws + WS_LA);
    const float* wa2 = A->in[23] + (size_t)i * 16 * 256, *ba = A->in[24] + i * 256;
    LAS float* sl = (LAS float*)lds;
    for (int item = bid; item < M / 32; item += G) {
        const int row0 = item * 32;
        { const int tok = tid >> 4, j = tid & 15; sl[j * 32 + tok] = bf2f(P[(size_t)(row0 + tok) * NIN_E + PC_WA1 + j]); }
        __syncthreads();
        const int c = tid;
        if (c < 256) {
            float acc[32];
#pragma unroll
            for (int t = 0; t < 32; ++t) acc[t] = 0.f;
            for (int j = 0; j < 16; ++j) { const float w = wa2[j * 256 + c];
#pragma unroll
                for (int t4 = 0; t4 < 8; ++t4) { const f32x4 x = *(const LAS f32x4*)(sl + j * 32 + 4 * t4); acc[4 * t4] += x.x * w; acc[4 * t4 + 1] += x.y * w; acc[4 * t4 + 2] += x.z * w; acc[4 * t4 + 3] += x.w * w; } }
            const float b0 = ba[c]; float* op = LA + (size_t)row0 * 256 + c;
#pragma unroll
            for (int t = 0; t < 32; ++t) { *op = -softplus_f(-(b0 + acc[t])) * (1.0f / 16.0f); op += 256; FRESH_V(op); }
        }
        __syncthreads();
    }
}

__device__ __noinline__ void rwkv_scan_seq(ArgP A, int L, int b, int h, LAS float* sc, int lane) {
    const int i = L >> 1, c = h * 64 + lane;
    const bf16* P = (const bf16*)(A->ws + WS_P); const float* WLOG = (const float*)(A->ws + WS_WLOG); const float* ASIG = (const float*)(A->ws + WS_ASIG); bf16* OAB = (bf16*)(A->ws + WS_XN);
    const float* mu = A->in[7] + (size_t)i * 1536;
    const float mur = mu[c], muk = mu[512 + c], muv = mu[1024 + c];
    const float kkc = A->in[17][i * 512 + c], kac = A->in[18][i * 512 + c], rkc = A->in[19][i * 512 + c], lnw = A->in[20][i * 512 + c], lnb = A->in[21][i * 512 + c];
    float S[64];
#pragma unroll
    for (int k = 0; k < 64; ++k) S[k] = 0.f;
    float pr_prev = 0.f, pk_prev = 0.f, pv_prev = 0.f;
    const size_t row0 = (size_t)b * T;
    float npr = bf2f(P[row0 * NIN_E + PC_R + c]), npk = bf2f(P[row0 * NIN_E + PC_K + c]), npv = bf2f(P[row0 * NIN_E + PC_V + c]);
    float nwl = WLOG[row0 * 512 + c], nas = ASIG[row0 * 512 + c], ng = bf2f(OAB[row0 * D + c]);
#pragma unroll 1
    for (int t = 0; t < T; ++t) {
        const float pr = npr, pk = npk, pv = npv, wl = nwl, as = nas, g = ng;
        if (t + 1 < T) { const size_t rw = row0 + t + 1; npr = bf2f(P[rw * NIN_E + PC_R + c]); npk = bf2f(P[rw * NIN_E + PC_K + c]); npv = bf2f(P[rw * NIN_E + PC_V + c]);
            nwl = WLOG[rw * 512 + c]; nas = ASIG[rw * 512 + c]; ng = bf2f(OAB[rw * D + c]); }
        const float r = pr + (pr_prev - pr) * mur, k = pk + (pk_prev - pk) * muk, v = pv + (pv_prev - pv) * muv;
        pr_prev = pr; pk_prev = pk; pv_prev = pv;
        float kk = k * kkc; const float n2 = wave_sum(kk * kk); kk = kk * frcp(fmaxf(fsqrt(n2), 1e-12f));
        const float kmod = k * (1.f + (as - 1.f) * kac);
        sc[lane] = -kk; sc[64 + lane] = fexp(wl); sc[128 + lane] = kk * as; sc[192 + lane] = kmod; sc[256 + lane] = r;
        LDS_WAIT(); asm volatile("" ::: "memory");
        float sa = 0.f;
#pragma unroll
        for (int k4 = 0; k4 < 16; ++k4) { const f32x4 a4 = *(const LAS f32x4*)(sc + 4 * k4); sa += S[4 * k4] * a4.x; sa += S[4 * k4 + 1] * a4.y; sa += S[4 * k4 + 2] * a4.z; sa += S[4 * k4 + 3] * a4.w; }
        float y = 0.f;
#pragma unroll
        for (int k4 = 0; k4 < 16; ++k4) {
            const f32x4 w4 = *(const LAS f32x4*)(sc + 64 + 4 * k4), b4 = *(const LAS f32x4*)(sc + 128 + 4 * k4), kq = *(const LAS f32x4*)(sc + 192 + 4 * k4), r4 = *(const LAS f32x4*)(sc + 256 + 4 * k4);
            S[4 * k4] = S[4 * k4] * w4.x + sa * b4.x + v * kq.x; y += S[4 * k4] * r4.x;
            S[4 * k4 + 1] = S[4 * k4 + 1] * w4.y + sa * b4.y + v * kq.y; y += S[4 * k4 + 1] * r4.y;
            S[4 * k4 + 2] = S[4 * k4 + 2] * w4.z + sa * b4.z + v * kq.z; y += S[4 * k4 + 2] * r4.z;
            S[4 * k4 + 3] = S[4 * k4 + 3] * w4.w + sa * b4.w + v * kq.w; y += S[4 * k4 + 3] * r4.w;
        }
        asm volatile("" ::: "memory");
        const float bonus = wave_sum(r * kmod * rkc);
        const float mean = wave_sum(y) * (1.f / 64.f); const float d = y - mean; const float var = wave_sum(d * d) * (1.f / 64.f);
        float o = d * frsq(var + 64e-5f) * lnw + lnb;
        o = (o + bonus * v) * g;
        OAB[(row0 + t) * D + c] = (bf16)f2bf(o);
    }
}
__device__ __noinline__ void gla_scan_half(ArgP A, int b, int h, int half, LAS float* sc, int lane) {
    const bf16* P = (const bf16*)(A->ws + WS_P); const float* LA = (const float*)(A->ws + WS_LA); bf16* OAB = (bf16*)(A->ws + WS_XN);
    float S0[64];
#pragma unroll
    for (int k = 0; k < 64; ++k) S0[k] = 0.f;
    const size_t row0 = (size_t)b * T;
#pragma unroll 1
    for (int t = 0; t < T; ++t) {
        const size_t rw = row0 + t; const bf16* pr = P + rw * NIN_E;
        const float q = bf2f(pr[PC_GQ + h * 64 + lane]) * 0.125f, kx = bf2f(pr[PC_GK + h * 64 + lane]), la = LA[rw * 256 + h * 64 + lane];
        const float v0 = bf2f(pr[PC_GV + h * 128 + half * 64 + lane]);
        sc[lane] = fexp(la); sc[64 + lane] = kx; sc[128 + lane] = q;
        LDS_WAIT(); asm volatile("" ::: "memory");
        float o0 = 0.f;
#pragma unroll
        for (int k4 = 0; k4 < 16; ++k4) {
            const f32x4 a4 = *(const LAS f32x4*)(sc + 4 * k4), k4v = *(const LAS f32x4*)(sc + 64 + 4 * k4), q4 = *(const LAS f32x4*)(sc + 128 + 4 * k4);
            S0[4 * k4] = S0[4 * k4] * a4.x + k4v.x * v0; o0 += q4.x * S0[4 * k4];
            S0[4 * k4 + 1] = S0[4 * k4 + 1] * a4.y + k4v.y * v0; o0 += q4.y * S0[4 * k4 + 1];
            S0[4 * k4 + 2] = S0[4 * k4 + 2] * a4.z + k4v.z * v0; o0 += q4.z * S0[4 * k4 + 2];
            S0[4 * k4 + 3] = S0[4 * k4 + 3] * a4.w + k4v.w * v0; o0 += q4.w * S0[4 * k4 + 3];
        }
        asm volatile("" ::: "memory");
        OAB[rw * D + 512 + h * 128 + half * 64 + lane] = (bf16)f2bf(o0);
    }
}
__device__ __noinline__ void gla_norm_rows(ArgP A, int L, int b, int h, int wave, int lane) {
    const int i = L >> 1;
    const bf16* P = (const bf16*)(A->ws + WS_P); bf16* OAB = (bf16*)(A->ws + WS_XN);
    const float gn0 = A->in[25][i * 512 + h * 128 + 2 * lane], gn1 = A->in[25][i * 512 + h * 128 + 2 * lane + 1];
    for (int t = wave; t < T; t += NWAVES) {
        const size_t rw = (size_t)b * T + t;
        GAS unsigned* op = (GAS unsigned*)(OAB + rw * D + 512 + h * 128 + 2 * lane);
        const unsigned ov = *op, gv = *(const GAS unsigned*)(P + rw * NIN_E + PC_GG + h * 128 + 2 * lane);
        const float o0 = bflo(ov), o1 = bfhi(ov);
        const float rs = frsq(wave_sum(o0 * o0 + o1 * o1) * (1.f / 128.f) + 1e-5f);
        *op = pk2(o0 * rs * gn0 * silu_f(bflo(gv)), o1 * rs * gn1 * silu_f(bfhi(gv)));
    }
}

__device__ __forceinline__ int t5_bucket(int d) {
    if (d < 16) return d;
    const float r = (float)d / 16.0f; int l = 16 + (int)(flog(r) / 2.0794415416798357f * 16.0f);
    return l < 31 ? l : 31;
}
__device__ __noinline__ void attn_row_simple(ArgP A, int L, int b, int h, int t, float lam, float lam_init, LAS float* qs  , LAS float* bd  , int lane) {
    const int i = L >> 1;
    const bf16* QKV = (const bf16*)(A->ws + WS_P); bf16* O = (bf16*)(A->ws + WS_XN);
    const bf16* qrow = QKV + (size_t)(b * T + t) * NIN_O + h * 128;
    qs[lane] = bf2f(qrow[lane]) * 0.125f; qs[64 + lane] = bf2f(qrow[64 + lane]) * 0.125f;
    bd[lane] = A->in[1][t5_bucket(lane) * 8 + h]; bd[64 + lane] = A->in[1][t5_bucket(64 + lane) * 8 + h];
    LDS_WAIT(); asm volatile("" ::: "memory");
    float m1 = -1e30f, m2 = -1e30f, l1 = 0.f, l2 = 0.f, o1a = 0.f, o1b = 0.f, o2a = 0.f, o2b = 0.f;
#pragma unroll 1
    for (int j0 = 0; j0 <= t; j0 += 64) {
        const int j = j0 + lane; const bool valid = j <= t;
        const bf16* krow = QKV + (size_t)(b * T + j) * NIN_O + 1024 + h * 128;
        float s1 = 0.f, s2 = 0.f;
#pragma unroll 2
        for (int c8 = 0; c8 < 8; ++c8) { const v4u kv = *(const GAS v4u*)(krow + 8 * c8); const f32x4 qa = *(const LAS f32x4*)(qs + 8 * c8), qb = *(const LAS f32x4*)(qs + 8 * c8 + 4);
            s1 += qa.x * bflo(kv.x) + qa.y * bfhi(kv.x) + qa.z * bflo(kv.y) + qa.w * bfhi(kv.y) + qb.x * bflo(kv.z) + qb.y * bfhi(kv.z) + qb.z * bflo(kv.w) + qb.w * bfhi(kv.w); }
#pragma unroll 2
        for (int c8 = 0; c8 < 8; ++c8) { const v4u kv = *(const GAS v4u*)(krow + 64 + 8 * c8); const f32x4 qa = *(const LAS f32x4*)(qs + 64 + 8 * c8), qb = *(const LAS f32x4*)(qs + 64 + 8 * c8 + 4);
            s2 += qa.x * bflo(kv.x) + qa.y * bfhi(kv.x) + qa.z * bflo(kv.y) + qa.w * bfhi(kv.y) + qb.x * bflo(kv.z) + qb.y * bfhi(kv.z) + qb.z * bflo(kv.w) + qb.w * bfhi(kv.w); }
        const int dist = valid ? (t - j) : 0; const float bias = bd[dist < 127 ? dist : 127];
        s1 = valid ? s1 + bias : -1e30f; s2 = valid ? s2 + bias : -1e30f;
        const float mn1 = fmaxf(m1, wave_max(s1)), mn2 = fmaxf(m2, wave_max(s2));
        const float c1 = fexp(m1 - mn1), c2 = fexp(m2 - mn2);
        const float p1 = valid ? fexp(s1 - mn1) : 0.f, p2 = valid ? fexp(s2 - mn2) : 0.f;
        l1 = l1 * c1 + wave_sum(p1); l2 = l2 * c2 + wave_sum(p2); m1 = mn1; m2 = mn2;
        o1a *= c1; o1b *= c1; o2a *= c2; o2b *= c2;
        const bf16* vbase = QKV + (size_t)(b * T + j0) * NIN_O + 2048 + h * 128 + 2 * lane;
#pragma unroll 4
        for (int jj = 0; jj < 64; ++jj) {
            const float pj1 = __builtin_bit_cast(float, __builtin_amdgcn_readlane(__builtin_bit_cast(int, p1), jj)), pj2 = __builtin_bit_cast(float, __builtin_amdgcn_readlane(__builtin_bit_cast(int, p2), jj));
            const unsigned vv = *(const GAS unsigned*)(vbase + (size_t)jj * NIN_O); const float v0 = bflo(vv), v1 = bfhi(vv);
            o1a += pj1 * v0; o1b += pj1 * v1; o2a += pj2 * v0; o2b += pj2 * v1;
        }
    }
    const float il1 = frcp(l1), il2 = frcp(l2); float oa = o1a * il1 - lam * (o2a * il2), ob = o1b * il1 - lam * (o2b * il2);
    const float ms = wave_sum(oa * oa + ob * ob) * (1.f / 128.f); const float rs = frsq(ms + 1e-5f);
    const float sc = 1.0f - lam_init; const float* sl = A->in[32] + i * 128;
    oa = oa * rs * sl[2 * lane] * sc; ob = ob * rs * sl[2 * lane + 1] * sc;
    *(GAS unsigned*)(O + (size_t)(b * T + t) * D + h * 128 + 2 * lane) = pk2(oa, ob);
}
typedef short a_bf16x8 __attribute__((ext_vector_type(8)));
typedef float f32x16 __attribute__((ext_vector_type(16)));
typedef short a_s16x4 __attribute__((ext_vector_type(4)));
constexpr int AT_SK = 144, AT_SV = 320, AT_K1 = 0, AT_K2 = 64 * AT_SK, AT_V = 2 * 64 * AT_SK, AT_ST = AT_V + 64 * AT_SV, AT_BIAS = 2 * AT_ST, AT_COMB = 0;
static_assert(AT_BIAS + 132 * 4 <= RING_BYTES && 4 * 64 * 64 * 4 <= AT_BIAS, "attention LDS map");
__device__ __forceinline__ int crow16(int r, int hi) { return (r & 3) + 8 * (r >> 2) + 4 * hi; }
typedef float f32x2_t __attribute__((ext_vector_type(2))); typedef __bf16 bf16x2_t __attribute__((ext_vector_type(2)));
__device__ __forceinline__ unsigned cvtpk(float lo, float hi) { const f32x2_t v = {lo, hi}; const bf16x2_t b = __builtin_convertvector(v, bf16x2_t); return __builtin_bit_cast(unsigned, b); }

__device__ __forceinline__ void attn_unit_mfma(ArgP A, int L, int b, int h, int qb, float lam, float lam_init, LAS unsigned char* lds, int tid) {
    const int lane = tid & 63, wave = __builtin_amdgcn_readfirstlane(tid >> 6), r32 = lane & 31, hi = lane >> 5;
    const int smap = wave >> 2, qs = wave & 3;
    const int i = L >> 1;
    const bf16* QKV = (const bf16*)(A->ws + WS_P); bf16* O = (bf16*)(A->ws + WS_XN);
    const int q0 = qb * 128, qw0 = q0 + 32 * qs, nt = (q0 + 128) / 64;
    const size_t rowb = (size_t)b * T;
    if (tid < 129) { const float far = A->in[1][31 * 8 + h]; ((LAS float*)(lds + AT_BIAS))[tid] = tid < 128 ? (A->in[1][t5_bucket(tid) * 8 + h] - far) * 1.4426950408889634f : 0.f; }
    a_bf16x8 qf[4];
    { const bf16* qrow = QKV + (rowb + qw0 + r32) * NIN_O + h * 128 + smap * 64 + 8 * hi;
#pragma unroll
      for (int ks = 0; ks < 4; ++ks) qf[ks] = *(const GAS a_bf16x8*)(qrow + 16 * ks); }
    const int kr = tid >> 3, kc = tid & 7, vr0 = tid >> 4, vc = tid & 15;
    const bf16* kg = QKV + (rowb + kr) * NIN_O + 1024 + h * 128 + 8 * kc;
    const bf16* vg = QKV + (rowb + vr0) * NIN_O + 2048 + h * 128 + 8 * vc;
    const int kw = kr * AT_SK + kc * 16, vw = vr0 * AT_SV + vc * 16;
    v4u sA[4];
#define AT_LOAD(S, kt) do { const size_t go_ = (size_t)(kt) * 64 * NIN_O; S[0] = *(const GAS v4u*)(kg + go_); S[1] = *(const GAS v4u*)(kg + go_ + 64); S[2] = *(const GAS v4u*)(vg + go_); S[3] = *(const GAS v4u*)(vg + go_ + (size_t)32 * NIN_O); } while (0)
#define AT_STORE(S, st) do { LAS unsigned char* sb_ = lds + (st) * AT_ST; *(LAS v4u*)(sb_ + AT_K1 + kw) = S[0]; *(LAS v4u*)(sb_ + AT_K2 + kw) = S[1]; *(LAS v4u*)(sb_ + AT_V + vw) = S[2]; *(LAS v4u*)(sb_ + AT_V + vw + 32 * AT_SV) = S[3]; } while (0)
    AT_LOAD(sA, 0); AT_STORE(sA, 0);
    __syncthreads();
    f32x16 o[4];
#pragma unroll
    for (int d = 0; d < 4; ++d)
#pragma unroll
        for (int r = 0; r < 16; ++r) o[d][r] = 0.f;
    float m = -1e30f, l = 0.f;
    const int kfo = (smap ? AT_K2 : AT_K1) + r32 * AT_SK + 16 * hi;
    const int vfo = AT_V + (4 * hi + ((lane & 15) >> 2)) * AT_SV + (16 * ((lane >> 4) & 1) + 4 * (lane & 3)) * 2;
    const LAS float* bdl = (const LAS float*)(lds + AT_BIAS);
    const int qme = qw0 + r32;
#pragma unroll 1
    for (int kt = 0; kt < nt; ++kt) {
        if (kt + 1 < nt) AT_LOAD(sA, kt + 1);
        const int key0 = 64 * kt;
        if (key0 <= qw0 + 31) {
            const LAS unsigned char* sb = lds + (kt & 1) * AT_ST;
            f32x16 p[2]; a_bf16x8 kf[8];
#pragma unroll
            for (int f = 0; f < 8; ++f) kf[f] = *(const LAS a_bf16x8*)(sb + kfo + (f >> 2) * 32 * AT_SK + (f & 3) * 32);
            __builtin_amdgcn_sched_barrier(0);
#pragma unroll
            for (int blk = 0; blk < 2; ++blk) {
#pragma unroll
                for (int r = 0; r < 16; ++r) p[blk][r] = 0.f;
#pragma unroll
                for (int ks = 0; ks < 4; ++ks) p[blk] = __builtin_amdgcn_mfma_f32_32x32x16_bf16(kf[blk * 4 + ks], qf[ks], p[blk], 0, 0, 0);
            }
            if (key0 + 63 + 128 > qw0) {
#pragma unroll
                for (int blk = 0; blk < 2; ++blk) { float bvv[16];
#pragma unroll
                    for (int r = 0; r < 16; ++r) { const unsigned ud = (unsigned)(qme - (key0 + 32 * blk + crow16(r, hi))); bvv[r] = bdl[ud < 128u ? ud : 128u]; }
                    asm volatile("" : "+v"(bvv[0]), "+v"(bvv[1]), "+v"(bvv[2]), "+v"(bvv[3]), "+v"(bvv[4]), "+v"(bvv[5]), "+v"(bvv[6]), "+v"(bvv[7]), "+v"(bvv[8]), "+v"(bvv[9]), "+v"(bvv[10]), "+v"(bvv[11]), "+v"(bvv[12]), "+v"(bvv[13]), "+v"(bvv[14]), "+v"(bvv[15]));
#pragma unroll
                    for (int r = 0; r < 16; ++r) { const int dist = qme - (key0 + 32 * blk + crow16(r, hi)); p[blk][r] = dist < 0 ? -1e30f : p[blk][r] + bvv[r]; } }
            }
            float mx = p[0][0];
#pragma unroll
            for (int r = 1; r < 16; ++r) mx = fmaxf(mx, p[0][r]);
#pragma unroll
            for (int r = 0; r < 16; ++r) mx = fmaxf(mx, p[1][r]);
            mx = fmaxf(mx, __shfl_xor(mx, 32));
            if (__any(mx > m + 8.0f)) {
                const float mn = fmaxf(m, mx), al = __builtin_amdgcn_exp2f(m - mn); m = mn; l *= al;
#pragma unroll
                for (int d = 0; d < 4; ++d)
#pragma unroll
                    for (int r = 0; r < 16; ++r) o[d][r] *= al;
            }
            float ls = 0.f; a_bf16x8 pf[4]; a_s16x4 vA[8], vB[8];
#define AT_VREAD(VF, kk) do { _Pragma("unroll") for (int d = 0; d < 4; ++d) { const LAS unsigned char* vp_ = sb + vfo + (kk) * 16 * AT_SV + d * 64; \
                VF[2 * d] = __builtin_bit_cast(a_s16x4, __builtin_amdgcn_ds_read_tr16_b64_v4i16((LAS a_s16x4*)vp_)); VF[2 * d + 1] = __builtin_bit_cast(a_s16x4, __builtin_amdgcn_ds_read_tr16_b64_v4i16((LAS a_s16x4*)(vp_ + 8 * AT_SV))); } } while (0)
#define AT_EXPPK(kk) do { const int blk_ = (kk) >> 1, s8_ = 8 * ((kk) & 1); float e_[8]; _Pragma("unroll") for (int j = 0; j < 8; ++j) { e_[j] = __builtin_amdgcn_exp2f(p[blk_][s8_ + j] - m); ls += e_[j]; } \
                v4u w_; w_.x = cvtpk(e_[0], e_[1]); w_.y = cvtpk(e_[2], e_[3]); w_.z = cvtpk(e_[4], e_[5]); w_.w = cvtpk(e_[6], e_[7]); pf[kk] = __builtin_bit_cast(a_bf16x8, w_); } while (0)
#define AT_PV(VF, kk) do { _Pragma("unroll") for (int d = 0; d < 4; ++d) { const a_bf16x8 vf_ = (a_bf16x8){VF[2 * d][0], VF[2 * d][1], VF[2 * d][2], VF[2 * d][3], VF[2 * d + 1][0], VF[2 * d + 1][1], VF[2 * d + 1][2], VF[2 * d + 1][3]}; \
                o[d] = __builtin_amdgcn_mfma_f32_32x32x16_bf16(vf_, pf[kk], o[d], 0, 0, 0); } } while (0)
            AT_VREAD(vA, 0); AT_EXPPK(0);
            __builtin_amdgcn_sched_barrier(0);
            AT_VREAD(vB, 1); AT_PV(vA, 0); AT_EXPPK(1);
            __builtin_amdgcn_sched_barrier(0);
            AT_VREAD(vA, 2); AT_PV(vB, 1); AT_EXPPK(2);
            __builtin_amdgcn_sched_barrier(0);
            AT_VREAD(vB, 3); AT_PV(vA, 2); AT_EXPPK(3);
            __builtin_amdgcn_sched_barrier(0);
            AT_PV(vB, 3);
            l += ls;
#undef AT_VREAD
#undef AT_EXPPK
#undef AT_PV
        }
        if (kt + 1 < nt) AT_STORE(sA, (kt + 1) & 1);
        __syncthreads();
    }
#undef AT_LOAD
#undef AT_STORE
    l += __shfl_xor(l, 32);
    LAS float* comb = (LAS float*)(lds + AT_COMB) + qs * 4096;
    if (smap == 1) { const float sc = lam * frcp(l);
#pragma unroll
        for (int d = 0; d < 4; ++d)
#pragma unroll
            for (int r = 0; r < 16; ++r) comb[(d * 16 + r) * 64 + lane] = o[d][r] * sc; }
    __syncthreads();
    if (smap == 0) {
        const float il = frcp(l); float ss = 0.f;
#pragma unroll
        for (int d = 0; d < 4; ++d)
#pragma unroll
            for (int r = 0; r < 16; ++r) { const float v = o[d][r] * il - comb[(d * 16 + r) * 64 + lane]; o[d][r] = v; ss += v * v; }
        ss += __shfl_xor(ss, 32);
        const float rs = frsq(ss * (1.f / 128.f) + 1e-5f) * (1.0f - lam_init);
        const float* sl = A->in[32] + i * 128;
        bf16* orow = O + (rowb + qw0 + r32) * D + h * 128;
#pragma unroll
        for (int d = 0; d < 4; ++d)
#pragma unroll
            for (int g4 = 0; g4 < 4; ++g4) { const int dc = 32 * d + 8 * g4 + 4 * hi; const f32x4 s4 = *(const GAS f32x4*)(sl + dc);
                v2u w; w.x = cvtpk(o[d][4 * g4] * rs * s4.x, o[d][4 * g4 + 1] * rs * s4.y); w.y = cvtpk(o[d][4 * g4 + 2] * rs * s4.z, o[d][4 * g4 + 3] * rs * s4.w);
                *(GAS v2u*)(orow + dc) = w; }
    }
    __syncthreads();
}

__device__ __forceinline__ void attn_phase_mfma(ArgP A, int L, LAS unsigned char* lds, int tid, int G, int bid) {
    const int lane = tid & 63, i = L >> 1;
    const float lam_init = 0.8f - 0.6f * fexp(-0.3f * (float)L);
    const float lam = fexp(wave_sum(A->in[28][i * 64 + lane] * A->in[29][i * 64 + lane])) - fexp(wave_sum(A->in[30][i * 64 + lane] * A->in[31][i * 64 + lane])) + lam_init;
    if (G == 256) {
        const int v = (bid & 7) * 32 + (bid >> 3), bh = v >> 2, j = v & 3;
#pragma unroll 1
        for (int u = 0; u < 8; ++u) { const int qb = 8 * (u >> 1) + ((u & 1) ? 7 - j : j); attn_unit_mfma(A, L, bh >> 3, bh & 7, qb, lam, lam_init, lds, tid); }
    } else {
#pragma unroll 1
        for (int u = bid; u < 64 * 32; u += G) attn_unit_mfma(A, L, (u >> 5) >> 3, (u >> 5) & 7, 31 - (u & 31), lam, lam_init, lds, tid);
    }
}
typedef short bf16x8_t __attribute__((ext_vector_type(8)));
constexpr int MS = 72, MB = 64 * MS * 2;
constexpr int RW_XW = 8 * MB, RW_XA = RW_XW + 16384;
constexpr int RW_TOT = 14 * MB, RW_GAM = RW_TOT + 2048, RW_END = RW_GAM + 256;
static_assert(RW_XA + 16384 <= 12 * MB && RW_END <= RING_BYTES, "RWKV LDS map");
constexpr size_t WS_RWI = 336 * MiB;
constexpr size_t WS_BON = 30 * MiB;
#define RBUF(k) ((LAS bf16*)(lds + (k) * MB))
__device__ __forceinline__ f32x4 mfma16(bf16x8_t a, bf16x8_t b, f32x4 c) { return __builtin_amdgcn_mfma_f32_16x16x32_bf16(a, b, c, 0, 0, 0); }
__device__ __forceinline__ bf16x8_t ldfrag(const LAS bf16* Mx, int row0, int k0, int lane) { return *(const LAS bf16x8_t*)(Mx + (row0 + (lane & 15)) * MS + k0 + 8 * (lane >> 4)); }
__device__ __forceinline__ f32x4 mm64(f32x4 acc, const LAS bf16* Am, int ra, const LAS bf16* BTm, int cb, int lane) {
    acc = mfma16(ldfrag(Am, 16 * ra, 0, lane), ldfrag(BTm, 16 * cb, 0, lane), acc);
    return mfma16(ldfrag(Am, 16 * ra, 32, lane), ldfrag(BTm, 16 * cb, 32, lane), acc);
}
__device__ __forceinline__ v2u pack4(f32x4 a) { v2u w; w.x = cvtpk(a[0], a[1]); w.y = cvtpk(a[2], a[3]); return w; }
__device__ __forceinline__ void tstore(LAS bf16* Dm, int rt, int ct, f32x4 acc, int lane) { *(LAS v2u*)(Dm + (16 * ct + (lane & 15)) * MS + 16 * rt + 4 * (lane >> 4)) = pack4(acc); }
__device__ __forceinline__ void tstore_g(bf16* Dg, int rt, int ct, f32x4 acc, int lane) { *(GAS v2u*)(Dg + (16 * ct + (lane & 15)) * 64 + 16 * rt + 4 * (lane >> 4)) = pack4(acc); }
__device__ __forceinline__ f32x4 ld4bf(const LAS bf16* p) { const v2u w = *(const LAS v2u*)p; return (f32x4){bflo(w.x), bfhi(w.x), bflo(w.y), bfhi(w.y)}; }
__device__ __forceinline__ f32x4 ld4bf_g(const bf16* p) { const v2u w = *(const GAS v2u*)p; return (f32x4){bflo(w.x), bfhi(w.x), bflo(w.y), bfhi(w.y)}; }
__device__ __forceinline__ void unpack8(v4u w, float (&f)[8]) { f[0] = bflo(w.x); f[1] = bfhi(w.x); f[2] = bflo(w.y); f[3] = bfhi(w.y); f[4] = bflo(w.z); f[5] = bfhi(w.z); f[6] = bflo(w.w); f[7] = bfhi(w.w); }
__device__ __forceinline__ bf16x8_t pack8(const float (&f)[8]) { v4u w; w.x = cvtpk(f[0], f[1]); w.y = cvtpk(f[2], f[3]); w.z = cvtpk(f[4], f[5]); w.w = cvtpk(f[6], f[7]); return __builtin_bit_cast(bf16x8_t, w); }

__device__ __forceinline__ void rwkv_chunk_item(ArgP A, int L, int b, int n, int h, LAS unsigned char* lds, int tid) {
    const int lane = tid & 63, wave = __builtin_amdgcn_readfirstlane(tid >> 6), i = L >> 1;
    const int l15 = lane & 15, lg = lane >> 4;
    const bf16* P = (const bf16*)(A->ws + WS_P); bf16* XNb = (bf16*)(A->ws + WS_XN);
    const size_t rowb = (size_t)b * T + 64 * n;
    bf16* item = (bf16*)(A->ws + WS_RWI) + ((size_t)((b * 64 + n) * 8 + h)) * 16384;
    {
        const int rt = wave >> 1, ct0 = 2 * (wave & 1);
        const int tt = 16 * rt + l15; const bf16* prow = P + (rowb + tt) * NIN_E; const bool has_prev = (64 * n + tt) > 0;
        const bf16* W2T = (const bf16*)(A->ws + WS_W2T); const bf16* A2T = (const bf16*)(A->ws + WS_A2T); const bf16* G2T = (const bf16*)(A->ws + WS_G2T);
        f32x4 xw[2], xa[2];
#pragma unroll
        for (int c = 0; c < 2; ++c) { xw[c] = (f32x4){0.f, 0.f, 0.f, 0.f}; xa[c] = (f32x4){0.f, 0.f, 0.f, 0.f}; }
#pragma unroll
        for (int k0 = 0; k0 < 64; k0 += 32) {
            const int kc = k0 + 8 * lg; float x[8], y[8], v[8];
            unpack8(*(const GAS v4u*)(prow + PC_W1A + kc), x); if (has_prev) unpack8(*(const GAS v4u*)(prow - NIN_E + PC_W1B + kc), y); else {
#pragma unroll
                for (int e = 0; e < 8; ++e) y[e] = 0.f; }
#pragma unroll
            for (int e = 0; e < 8; ++e) v[e] = tanh_f(x[e] + y[e]);
            const bf16x8_t fw = pack8(v);
            unpack8(*(const GAS v4u*)(prow + PC_A1A + kc), x); if (has_prev) unpack8(*(const GAS v4u*)(prow - NIN_E + PC_A1B + kc), y);
#pragma unroll
            for (int e = 0; e < 8; ++e) v[e] = x[e] + y[e];
            const bf16x8_t fa = pack8(v);
#pragma unroll
            for (int c = 0; c < 2; ++c) { const size_t wo = (size_t)(64 * h + 16 * (ct0 + c) + l15) * 64 + kc;
                xw[c] = mfma16(fw, *(const GAS bf16x8_t*)(W2T + wo), xw[c]); xa[c] = mfma16(fa, *(const GAS bf16x8_t*)(A2T + wo), xa[c]); }
        }
        LAS float* XW = (LAS float*)(lds + RW_XW); LAS float* XA = (LAS float*)(lds + RW_XA);
#pragma unroll
        for (int c = 0; c < 2; ++c)
#pragma unroll
            for (int r = 0; r < 4; ++r) { const int o = (16 * rt + 4 * lg + r) * 64 + 16 * (ct0 + c) + l15; XW[o] = xw[c][r]; XA[o] = xa[c][r]; }
        const int tct = wave >> 1, jt0 = 2 * (wave & 1);
        f32x4 gg[2] = {(f32x4){0.f, 0.f, 0.f, 0.f}, (f32x4){0.f, 0.f, 0.f, 0.f}};
#pragma unroll
        for (int k0 = 0; k0 < 192; k0 += 32) {
            const int kc = k0 + 8 * lg; float x[8], y[8], v[8];
            if (kc < 160) { unpack8(*(const GAS v4u*)(prow + PC_G1A + kc), x); if (has_prev) unpack8(*(const GAS v4u*)(prow - NIN_E + PC_G1B + kc), y); else {
#pragma unroll
                    for (int e = 0; e < 8; ++e) y[e] = 0.f; }
#pragma unroll
                for (int e = 0; e < 8; ++e) v[e] = sigmoid_f(x[e] + y[e]); }
            else {
#pragma unroll
                for (int e = 0; e < 8; ++e) v[e] = 0.f; }
            const bf16x8_t fg = pack8(v);
#pragma unroll
            for (int c = 0; c < 2; ++c) gg[c] = mfma16(*(const GAS bf16x8_t*)(G2T + (size_t)(64 * h + 16 * (jt0 + c) + l15) * 192 + kc), fg, gg[c]);
        }
        (void)tct;
#pragma unroll
        for (int c = 0; c < 2; ++c) *(GAS v2u*)(XNb + (rowb + tt) * D + 64 * h + 16 * (jt0 + c) + 4 * lg) = pack4(gg[c]);
    }
    __syncthreads();
    {
        const int c = 64 * h + lane;
        const float* mu = A->in[7] + (size_t)i * 1536;
        const float mur = mu[c], muk = mu[512 + c], muv = mu[1024 + c];
        const float kkc = A->in[17][i * 512 + c], kac = A->in[18][i * 512 + c], rkc = A->in[19][i * 512 + c], w0c = A->in[9][i * 512 + c], a0c = A->in[12][i * 512 + c];
        const LAS float* XW = (const LAS float*)(lds + RW_XW); const LAS float* XA = (const LAS float*)(lds + RW_XA);
        float* BON = (float*)(A->ws + WS_BON);
        const int tt0 = 8 * wave; const size_t row0 = rowb + tt0;
        float pr_p = 0.f, pk_p = 0.f, pv_p = 0.f;
        if (64 * n + tt0 > 0) { const bf16* pp = P + (row0 - 1) * NIN_E; pr_p = bf2f(pp[PC_R + c]); pk_p = bf2f(pp[PC_K + c]); pv_p = bf2f(pp[PC_V + c]); }
        float rr[8], av[8], bv[8], km[8], vv[8], wl[8], lc[8];
        float run = 0.f;
#pragma unroll
        for (int u = 0; u < 8; ++u) {
            const bf16* pr = P + (row0 + u) * NIN_E; const float pR = bf2f(pr[PC_R + c]), pK = bf2f(pr[PC_K + c]), pV = bf2f(pr[PC_V + c]);
            const float r = pR + (pr_p - pR) * mur, k = pK + (pk_p - pK) * muk, v = pV + (pv_p - pV) * muv; pr_p = pR; pk_p = pK; pv_p = pV;
            const float xw = w0c + XW[(tt0 + u) * 64 + lane], xa = a0c + XA[(tt0 + u) * 64 + lane];
            const float wlog = -fexp(-softplus_f(-xw) - 0.5f), as = sigmoid_f(xa);
            float kk = k * kkc; const float n2 = wave_sum(kk * kk); kk = kk * frcp(fmaxf(fsqrt(n2), 1e-12f));
            const float kmod = k * (1.f + (as - 1.f) * kac);
            const float bon = wave_sum(r * kmod * rkc);
            if (lane == 0) BON[(row0 + u) * 8 + h] = bon;
            run += wlog; rr[u] = r; av[u] = -kk; bv[u] = kk * as; km[u] = kmod; vv[u] = v; wl[u] = wlog; lc[u] = run;
        }
        LAS float* TOT = (LAS float*)(lds + RW_TOT);
        TOT[wave * 64 + lane] = run;
        __syncthreads();
        float off = 0.f, tot = 0.f;
#pragma unroll
        for (int w2 = 0; w2 < 8; ++w2) { const float tv = TOT[w2 * 64 + lane]; tot += tv; if (w2 < wave) off += tv; }
        if (wave == 0) ((LAS float*)(lds + RW_GAM))[lane] = fexp(tot);
        float fR[8], fA[8], fB[8], fK[8];
#pragma unroll
        for (int u = 0; u < 8; ++u) { const float cum = off + lc[u], e1 = fexp(cum), ei = fexp(-cum); fR[u] = rr[u] * e1; fA[u] = av[u] * fexp(cum - wl[u]); fB[u] = bv[u] * ei; fK[u] = km[u] * ei; }
        LAS bf16* At = RBUF(0); LAS bf16* Bt = RBUF(1); LAS bf16* Kt = RBUF(2); LAS bf16* Rt = RBUF(3);
#pragma unroll
        for (int u = 0; u < 8; ++u) { const int o = (tt0 + u) * MS + lane; At[o] = (bf16)f2bf(fA[u]); Bt[o] = (bf16)f2bf(fB[u]); Kt[o] = (bf16)f2bf(fK[u]); Rt[o] = (bf16)f2bf(fR[u]); }
        *(LAS bf16x8_t*)(RBUF(4) + lane * MS + tt0) = pack8(fA); *(LAS bf16x8_t*)(RBUF(5) + lane * MS + tt0) = pack8(fB);
        *(LAS bf16x8_t*)(RBUF(6) + lane * MS + tt0) = pack8(fK); *(LAS bf16x8_t*)(RBUF(7) + lane * MS + tt0) = pack8(vv);
    }
    __syncthreads();
    const int rt = wave >> 1, ct0 = 2 * (wave & 1);
    {
        const LAS bf16* At = RBUF(0); const LAS bf16* Bt = RBUF(1); const LAS bf16* Kt = RBUF(2); const LAS bf16* Rt = RBUF(3);
#pragma unroll
        for (int c = 0; c < 2; ++c) { const int ct = ct0 + c; const f32x4 z = (f32x4){0.f, 0.f, 0.f, 0.f};
            f32x4 aL = mm64(z, Bt, rt, At, ct, lane);
            f32x4 aLT = mm64(z, At, rt, Bt, ct, lane);
            f32x4 aAK = mm64(z, Kt, rt, At, ct, lane);
            f32x4 aRB = mm64(z, Bt, rt, Rt, ct, lane);
            f32x4 aRK = mm64(z, Kt, rt, Rt, ct, lane);
            const int col = 16 * ct + l15;
#pragma unroll
            for (int r = 0; r < 4; ++r) { const int row = 16 * rt + 4 * lg + r;
                if (!(row < col)) { aL[r] = 0.f; aAK[r] = 0.f; }
                if (!(col < row)) aLT[r] = 0.f;
                if (!(row <= col)) { aRB[r] = 0.f; aRK[r] = 0.f; } }
            tstore(RBUF(8), rt, ct, aL, lane); tstore(RBUF(9), rt, ct, aLT, lane); tstore(RBUF(10), rt, ct, aAK, lane); tstore(RBUF(11), rt, ct, aRB, lane); tstore(RBUF(12), rt, ct, aRK, lane);
        }
    }
    __syncthreads();
    {
        for (int e = tid; e < 64 * 16; e += NTHREADS) { const int row = e >> 4, c4 = (e & 15) * 4; v2u w = *(const LAS v2u*)(RBUF(8) + row * MS + c4);
            if ((row >> 2) == (c4 >> 2)) { const unsigned one = 0x3f80u; const int p = row & 3; if (p == 0) w.x = (w.x & 0xffff0000u) | one; else if (p == 1) w.x = (w.x & 0xffffu) | (one << 16); else if (p == 2) w.y = (w.y & 0xffff0000u) | one; else w.y = (w.y & 0xffffu) | (one << 16); }
            *(LAS v2u*)(RBUF(0) + row * MS + c4) = w; }
    }
#define RW_SQUARE(Min, MTin, Mout, MTout) do { _Pragma("unroll") for (int c = 0; c < 2; ++c) { const int ct = ct0 + c; const f32x4 z = (f32x4){0.f, 0.f, 0.f, 0.f}; \
        tstore(RBUF(Mout), rt, ct, mm64(z, RBUF(MTin), rt, RBUF(Min), ct, lane), lane);        \
        tstore(RBUF(MTout), rt, ct, mm64(z, RBUF(Min), rt, RBUF(MTin), ct, lane), lane); } } while (0)
#define RW_YSTEP(Yin, MTin, Yout) do { _Pragma("unroll") for (int c = 0; c < 2; ++c) { const int ct = ct0 + c; \
        const f32x4 y0 = ld4bf(RBUF(Yin) + (16 * ct + l15) * MS + 16 * rt + 4 * lg);            \
        tstore(RBUF(Yout), rt, ct, mm64(y0, RBUF(MTin), rt, RBUF(Yin), ct, lane), lane); } } while (0)
    RW_SQUARE(8, 9, 2, 13);
    __syncthreads();
    RW_YSTEP(0, 13, 1); RW_SQUARE(2, 13, 8, 9);
    __syncthreads();
    RW_YSTEP(1, 9, 0); RW_SQUARE(8, 9, 2, 13);
    __syncthreads();
    RW_YSTEP(0, 13, 1); RW_SQUARE(2, 13, 8, 9);
    __syncthreads();
    RW_YSTEP(1, 9, 0); RW_SQUARE(8, 9, 2, 13);
    __syncthreads();
    RW_YSTEP(0, 13, 1);
    __syncthreads();
#undef RW_SQUARE
#undef RW_YSTEP
    {
#pragma unroll
        for (int c = 0; c < 2; ++c) { const int ct = ct0 + c; const f32x4 z = (f32x4){0.f, 0.f, 0.f, 0.f};
            tstore(RBUF(8), rt, ct, mm64(z, RBUF(1), rt, RBUF(4), ct, lane), lane);
            tstore(RBUF(9), rt, ct, mm64(z, RBUF(10), rt, RBUF(7), ct, lane), lane); }
    }
    __syncthreads();
    {
        const LAS float* GAM = (const LAS float*)(lds + RW_GAM);
#pragma unroll
        for (int c = 0; c < 2; ++c) { const int ct = ct0 + c; const f32x4 z = (f32x4){0.f, 0.f, 0.f, 0.f};
            tstore(RBUF(0), rt, ct, mm64(z, RBUF(1), rt, RBUF(9), ct, lane), lane);
            const f32x4 r0 = ld4bf(RBUF(3) + (16 * ct + l15) * MS + 16 * rt + 4 * lg);
            tstore_g(item, rt, ct, mm64(r0, RBUF(8), rt, RBUF(11), ct, lane), lane);
            f32x4 pp = mm64(z, RBUF(8), rt, RBUF(5), ct, lane);
            const float gm = GAM[16 * ct + l15];
#pragma unroll
            for (int r = 0; r < 4; ++r) pp[r] = gm * (pp[r] + ((16 * rt + 4 * lg + r) == (16 * ct + l15) ? 1.f : 0.f));
            { const int jp = 16 * ct + l15, j0 = 16 * rt + 4 * lg;
              *(GAS v2u*)(item + 8192 + ((((jp >> 5) * 4 + (j0 >> 4)) * 64 + (jp & 31) + 32 * ((j0 >> 2) & 1)) * 8 + 4 * ((j0 >> 3) & 1))) = pack4(pp); } }
    }
    __syncthreads();
    {
        const LAS float* GAM = (const LAS float*)(lds + RW_GAM);
#pragma unroll
        for (int c = 0; c < 2; ++c) { const int ct = ct0 + c; const f32x4 z = (f32x4){0.f, 0.f, 0.f, 0.f};
            f32x4 y0 = mm64(z, RBUF(0), rt, RBUF(11), ct, lane); y0 = mm64(y0, RBUF(7), rt, RBUF(12), ct, lane);
            tstore_g(item + 4096, rt, ct, y0, lane);
            f32x4 q = mm64(z, RBUF(5), rt, RBUF(0), ct, lane); q = mm64(q, RBUF(6), rt, RBUF(7), ct, lane);
            const f32x4 g4 = *(const LAS f32x4*)(GAM + 16 * rt + 4 * lg);
            q = q * g4;
            { const int iv = 16 * ct + l15, j0 = 16 * rt + 4 * lg;
              *(GAS v2u*)(item + 12288 + (((((j0 >> 5) * 2 + (iv >> 5)) * 4 + ((j0 >> 3) & 3)) * 64 + (iv & 31) + 32 * ((j0 >> 2) & 1)) * 4)) = pack4(q); } }
    }
    __syncthreads();
}

__device__ __forceinline__ void rwkv_state_scan(ArgP A, int b, int h, int lane, bool do_store = true) {
    const int r32 = lane & 31, hi = lane >> 5;
    f32x16 St[2][2];
#pragma unroll
    for (int kb = 0; kb < 2; ++kb)
#pragma unroll
        for (int vb = 0; vb < 2; ++vb)
#pragma unroll
            for (int r = 0; r < 16; ++r) St[kb][vb][r] = 0.f;
    bf16* item0 = (bf16*)(A->ws + WS_RWI) + ((size_t)((b * 64) * 8 + h)) * 16384;
    v4u pfn[8]; v2u qn[16];
#define RW2_LOAD(nn) do { const bf16* it_ = item0 + (size_t)(nn) * 8 * 16384; \
        _Pragma("unroll") for (int f = 0; f < 8; ++f) pfn[f] = *(const GAS v4u*)(it_ + 8192 + (f * 64 + lane) * 8); \
        _Pragma("unroll") for (int f = 0; f < 16; ++f) qn[f] = *(const GAS v2u*)(it_ + 12288 + (f * 64 + lane) * 4); } while (0)
    RW2_LOAD(0);
#pragma unroll 1
    for (int n = 0; n < 64; ++n) {
        bf16* PM = item0 + (size_t)n * 8 * 16384 + 8192;
        a_bf16x8 pf[2][4]; f32x16 Nw[2][2];
#pragma unroll
        for (int f = 0; f < 8; ++f) pf[f >> 2][f & 3] = __builtin_bit_cast(a_bf16x8, pfn[f]);
#pragma unroll
        for (int kb = 0; kb < 2; ++kb)
#pragma unroll
            for (int vb = 0; vb < 2; ++vb)
#pragma unroll
                for (int g = 0; g < 4; ++g) { const v2u w = qn[(kb * 2 + vb) * 4 + g]; Nw[kb][vb][4 * g] = bflo(w.x); Nw[kb][vb][4 * g + 1] = bfhi(w.x); Nw[kb][vb][4 * g + 2] = bflo(w.y); Nw[kb][vb][4 * g + 3] = bfhi(w.y); }
#pragma unroll
        for (int kb = 0; kb < 2; ++kb)
#pragma unroll
            for (int vb = 0; vb < 2; ++vb)
#pragma unroll
                for (int g = 0; g < 4; ++g) { v2u w; w.x = cvtpk(St[kb][vb][4 * g], St[kb][vb][4 * g + 1]); w.y = cvtpk(St[kb][vb][4 * g + 2], St[kb][vb][4 * g + 3]);
                    if (do_store) *(GAS v2u*)(PM + ((((2 * vb + (r32 >> 4)) * 2 + kb) * 64 + g * 16 + (r32 & 15)) * 8 + 4 * hi)) = w; }
        if (n + 1 < 64) RW2_LOAD(n + 1);
        a_bf16x8 sf[4][2];
#pragma unroll
        for (int ks = 0; ks < 4; ++ks)
#pragma unroll
            for (int vb = 0; vb < 2; ++vb) { const int kb = ks >> 1, s8 = 8 * (ks & 1); v4u w; w.x = cvtpk(St[kb][vb][s8], St[kb][vb][s8 + 1]); w.y = cvtpk(St[kb][vb][s8 + 2], St[kb][vb][s8 + 3]);
                w.z = cvtpk(St[kb][vb][s8 + 4], St[kb][vb][s8 + 5]); w.w = cvtpk(St[kb][vb][s8 + 6], St[kb][vb][s8 + 7]); sf[ks][vb] = __builtin_bit_cast(a_bf16x8, w); }
#pragma unroll
        for (int kb = 0; kb < 2; ++kb)
#pragma unroll
            for (int vb = 0; vb < 2; ++vb) {
#pragma unroll
                for (int ks = 0; ks < 4; ++ks) Nw[kb][vb] = __builtin_amdgcn_mfma_f32_32x32x16_bf16(pf[kb][ks], sf[ks][vb], Nw[kb][vb], 0, 0, 0);
            }
#pragma unroll
        for (int kb = 0; kb < 2; ++kb)
#pragma unroll
            for (int vb = 0; vb < 2; ++vb) St[kb][vb] = Nw[kb][vb];
    }
#undef RW2_LOAD
}

__device__ __forceinline__ void rwkv_out_item(ArgP A, int L, int b, int n, int h, int ct, int lane, bool do_store = true) {
    const int i = L >> 1, l15 = lane & 15, lg = lane >> 4;
    const bf16* P = (const bf16*)(A->ws + WS_P); bf16* XNb = (bf16*)(A->ws + WS_XN); const float* BON = (const float*)(A->ws + WS_BON);
    const bf16* item = (const bf16*)(A->ws + WS_RWI) + ((size_t)((b * 64 + n) * 8 + h)) * 16384;
    const bf16* RH = item; const bf16* Y0 = item + 4096; const bf16* ST = item + 8192;
    const size_t row = (size_t)b * T + 64 * n + 16 * ct + l15; const int tseq = 64 * n + 16 * ct + l15;
    const bf16x8_t rf0 = *(const GAS bf16x8_t*)(RH + (16 * ct + l15) * 64 + 8 * lg), rf1 = *(const GAS bf16x8_t*)(RH + (16 * ct + l15) * 64 + 32 + 8 * lg);
    f32x4 acc[4]; float s1 = 0.f;
#pragma unroll
    for (int it = 0; it < 4; ++it) {
        f32x4 a = ld4bf_g(Y0 + (16 * ct + l15) * 64 + 16 * it + 4 * lg);
        a = mfma16(*(const GAS bf16x8_t*)(ST + ((it * 2 + 0) * 64 + lane) * 8), rf0, a);
        a = mfma16(*(const GAS bf16x8_t*)(ST + ((it * 2 + 1) * 64 + lane) * 8), rf1, a);
        acc[it] = a; s1 += (a[0] + a[1]) + (a[2] + a[3]);
    }
    s1 += __shfl_xor(s1, 16); s1 += __shfl_xor(s1, 32);
    const float mean = s1 * (1.f / 64.f); float s2 = 0.f;
#pragma unroll
    for (int it = 0; it < 4; ++it) { acc[it] = acc[it] - mean; s2 += (acc[it][0] * acc[it][0] + acc[it][1] * acc[it][1]) + (acc[it][2] * acc[it][2] + acc[it][3] * acc[it][3]); }
    s2 += __shfl_xor(s2, 16); s2 += __shfl_xor(s2, 32);
    const float rs = frsq(s2 * (1.f / 64.f) + 64e-5f);
    const float bon = BON[row * 8 + h];
    const float* lnw = A->in[20] + i * 512 + 64 * h; const float* lnb = A->in[21] + i * 512 + 64 * h; const float* mu = A->in[7] + (size_t)i * 1536 + 1024 + 64 * h;
    const bf16* pr = P + row * NIN_E + PC_V + 64 * h;
#pragma unroll
    for (int it = 0; it < 4; ++it) { const int i0 = 16 * it + 4 * lg;
        const f32x4 w4 = *(const GAS f32x4*)(lnw + i0), b4 = *(const GAS f32x4*)(lnb + i0), m4 = *(const GAS f32x4*)(mu + i0);
        const f32x4 pv = ld4bf_g(pr + i0); const f32x4 pvp = tseq > 0 ? ld4bf_g(pr - NIN_E + i0) : (f32x4){0.f, 0.f, 0.f, 0.f};
        const f32x4 v4 = pv + (pvp - pv) * m4;
        bf16* gp = XNb + row * D + 64 * h + i0; const f32x4 g4 = ld4bf_g(gp);
        const f32x4 o = ((acc[it] * rs) * w4 + b4 + v4 * bon) * g4;
        if (do_store) *(GAS v2u*)gp = pack4(o); }
}
constexpr size_t WS_GKV = 464 * MiB;
constexpr size_t WS_GDEC = 31 * MiB;
constexpr int GL_LA = 0, GL_KR = 16384, GL_VT = GL_KR + MB, GL_TOT = GL_VT + 2 * MB, GL1_END = GL_TOT + 2048;
constexpr int G3_LA = 0, G3_QD = 16384, G3_KD = G3_QD + MB, G3_VT = G3_KD + MB, G3_SC = G3_VT + 2 * MB, G3_TOT = G3_SC + MB, G3_GRP = G3_TOT + 1024;
static_assert(2 * G3_GRP <= RING_BYTES && GL1_END <= RING_BYTES, "GLA LDS map");

template <int NCT> __device__ __forceinline__ void gla_lora_tiles(ArgP A, size_t rowb, int h4, int rt, int ct0, LAS float* LAs, int lane) {
    const int l15 = lane & 15, lg = lane >> 4;
    const bf16* P = (const bf16*)(A->ws + WS_P); const bf16* WA2T = (const bf16*)(A->ws + WS_WA2T);
    v4u av = (v4u){0u, 0u, 0u, 0u};
    if (lg < 2) av = *(const GAS v4u*)(P + (rowb + 16 * rt + l15) * NIN_E + PC_WA1 + 8 * lg);
    const bf16x8_t af = __builtin_bit_cast(bf16x8_t, av);
#pragma unroll
    for (int c = 0; c < NCT; ++c) { const int ct = ct0 + c;
        const f32x4 x = mfma16(af, *(const GAS bf16x8_t*)(WA2T + (size_t)(64 * h4 + 16 * ct + l15) * 32 + 8 * lg), (f32x4){0.f, 0.f, 0.f, 0.f});
#pragma unroll
        for (int r = 0; r < 4; ++r) LAs[(16 * rt + 4 * lg + r) * 64 + 16 * ct + l15] = x[r]; }
}

__device__ __forceinline__ void gla_kv_item(ArgP A, int L, int b, int n, int h4, LAS unsigned char* lds, int tid) {
    const int lane = tid & 63, wave = __builtin_amdgcn_readfirstlane(tid >> 6), i = L >> 1, l15 = lane & 15, lg = lane >> 4;
    const bf16* P = (const bf16*)(A->ws + WS_P);
    const size_t rowb = (size_t)b * T + 64 * n; const int itemi = (b * 64 + n) * 4 + h4;
    LAS float* LAs = (LAS float*)(lds + GL_LA); LAS bf16* KrT = (LAS bf16*)(lds + GL_KR); LAS bf16* VTm = (LAS bf16*)(lds + GL_VT); LAS float* TOT = (LAS float*)(lds + GL_TOT);
    gla_lora_tiles<2>(A, rowb, h4, wave >> 1, 2 * (wave & 1), LAs, lane);
    __syncthreads();
    {
        const int c = 64 * h4 + lane, tt0 = 8 * wave; const float bac = A->in[24][i * 256 + c];
        float lc[8], kx[8], v0[8], v1[8]; float run = 0.f;
#pragma unroll
        for (int u = 0; u < 8; ++u) { const bf16* pr = P + (rowb + tt0 + u) * NIN_E; const float x = bac + LAs[(tt0 + u) * 64 + lane];
            run += -softplus_f(-x) * (1.0f / 16.0f); lc[u] = run; kx[u] = bf2f(pr[PC_GK + c]); v0[u] = bf2f(pr[PC_GV + 128 * h4 + lane]); v1[u] = bf2f(pr[PC_GV + 128 * h4 + 64 + lane]); }
        TOT[wave * 64 + lane] = run;
        __syncthreads();
        float off = 0.f, tot = 0.f;
#pragma unroll
        for (int w2 = 0; w2 < 8; ++w2) { const float tv = TOT[w2 * 64 + lane]; tot += tv; if (w2 < wave) off += tv; }
        if (wave == 0) ((float*)(A->ws + WS_GDEC))[itemi * 64 + lane] = fexp(tot);
#pragma unroll
        for (int u = 0; u < 8; ++u) kx[u] *= fexp(tot - (off + lc[u]));
        *(LAS bf16x8_t*)(KrT + lane * MS + tt0) = pack8(kx); *(LAS bf16x8_t*)(VTm + lane * MS + tt0) = pack8(v0); *(LAS bf16x8_t*)(VTm + (64 + lane) * MS + tt0) = pack8(v1);
    }
    __syncthreads();
    {
        bf16* KVg = (bf16*)(A->ws + WS_GKV) + (size_t)itemi * 8192; const int rt = wave >> 1;
#pragma unroll
        for (int c = 0; c < 4; ++c) { const int et = 4 * (wave & 1) + c;
            const f32x4 acc = mm64((f32x4){0.f, 0.f, 0.f, 0.f}, KrT, rt, VTm, et, lane);
            *(GAS v2u*)(KVg + (16 * et + l15) * 64 + 16 * rt + 4 * lg) = pack4(acc); }
    }
    __syncthreads();
}

__device__ __forceinline__ void gla_state_scan(ArgP A, int gt, bool do_store = true) {
    const int bh = gt >> 11, grp = gt & 2047;
    const int b = bh >> 2, h4 = bh & 3;
    bf16* base = (bf16*)(A->ws + WS_GKV) + (size_t)((b * 64) * 4 + h4) * 8192 + (size_t)grp * 4;
    const float* dec = (const float*)(A->ws + WS_GDEC) + (size_t)((b * 64) * 4 + h4) * 64 + (grp & 15) * 4;
    f32x4 S = (f32x4){0.f, 0.f, 0.f, 0.f};
#pragma unroll 1
    for (int n0 = 0; n0 < 64; n0 += 8) {
        v2u kv[8]; f32x4 dc[8];
#pragma unroll
        for (int u = 0; u < 8; ++u) { kv[u] = *(const GAS v2u*)(base + (size_t)(n0 + u) * 4 * 8192); dc[u] = *(const GAS f32x4*)(dec + (size_t)(n0 + u) * 4 * 64); }
#pragma unroll
        for (int u = 0; u < 8; ++u) { if (do_store) *(GAS v2u*)(base + (size_t)(n0 + u) * 4 * 8192) = pack4(S);
            S = S * dc[u] + (f32x4){bflo(kv[u].x), bfhi(kv[u].x), bflo(kv[u].y), bfhi(kv[u].y)}; }
    }
}

__device__ __forceinline__ void gla_out_group(ArgP A, int L, int item2, LAS unsigned char* lds, int tid) {
    const int lane = tid & 63, wave = __builtin_amdgcn_readfirstlane(tid >> 6), i = L >> 1, l15 = lane & 15, lg = lane >> 4;
    const int gi = wave >> 2, wq = wave & 3;
    const int itemi = 2 * item2 + gi, h4 = itemi & 3, n = (itemi >> 2) & 63, b = itemi >> 8;
    const bf16* P = (const bf16*)(A->ws + WS_P); bf16* XNb = (bf16*)(A->ws + WS_XN);
    const size_t rowb = (size_t)b * T + 64 * n;
    LAS unsigned char* gb = lds + gi * G3_GRP;
    LAS float* LAs = (LAS float*)(gb + G3_LA); LAS bf16* Qd = (LAS bf16*)(gb + G3_QD); LAS bf16* Kd = (LAS bf16*)(gb + G3_KD); LAS bf16* VTm = (LAS bf16*)(gb + G3_VT); LAS bf16* SC = (LAS bf16*)(gb + G3_SC);
    LAS float* TOT = (LAS float*)(gb + G3_TOT);
    gla_lora_tiles<4>(A, rowb, h4, wq, 0, LAs, lane);
    __syncthreads();
    {
        const int c = 64 * h4 + lane, tt0 = 16 * wq; const float bac = A->in[24][i * 256 + c];
        float lc[16], qx[16], kx[16]; float run = 0.f;
#pragma unroll
        for (int u = 0; u < 16; ++u) { const bf16* pr = P + (rowb + tt0 + u) * NIN_E; const float x = bac + LAs[(tt0 + u) * 64 + lane];
            run += -softplus_f(-x) * (1.0f / 16.0f); lc[u] = run; qx[u] = bf2f(pr[PC_GQ + c]) * 0.125f; kx[u] = bf2f(pr[PC_GK + c]); }
        TOT[wq * 64 + lane] = run;
        __syncthreads();
        float off = 0.f;
#pragma unroll
        for (int w2 = 0; w2 < 4; ++w2) { const float tv = TOT[w2 * 64 + lane]; if (w2 < wq) off += tv; }
#pragma unroll
        for (int u = 0; u < 16; ++u) { const float cum = off + lc[u]; Qd[(tt0 + u) * MS + lane] = (bf16)f2bf(qx[u] * fexp(cum)); Kd[(tt0 + u) * MS + lane] = (bf16)f2bf(kx[u] * fexp(-cum)); }
#pragma unroll
        for (int hf = 0; hf < 2; ++hf) { float v0[8], v1[8];
#pragma unroll
            for (int u = 0; u < 8; ++u) { const bf16* pr = P + (rowb + tt0 + 8 * hf + u) * NIN_E + PC_GV + 128 * h4; v0[u] = bf2f(pr[lane]); v1[u] = bf2f(pr[64 + lane]); }
            *(LAS bf16x8_t*)(VTm + lane * MS + tt0 + 8 * hf) = pack8(v0); *(LAS bf16x8_t*)(VTm + (64 + lane) * MS + tt0 + 8 * hf) = pack8(v1); }
    }
    __syncthreads();
    const int ct = wq; const int col = 16 * ct + l15;
#pragma unroll
    for (int rt = 0; rt < 4; ++rt) { f32x4 acc = (f32x4){0.f, 0.f, 0.f, 0.f};
        if (rt <= ct) { acc = mm64(acc, Kd, rt, Qd, ct, lane);
#pragma unroll
            for (int r = 0; r < 4; ++r) if (!((16 * rt + 4 * lg + r) <= col)) acc[r] = 0.f; }
        tstore(SC, rt, ct, acc, lane); }
    LDS_WAIT(); asm volatile("" ::: "memory");
    const bf16* Sg = (const bf16*)(A->ws + WS_GKV) + (size_t)itemi * 8192;
    f32x4 o[8]; float ss = 0.f;
#pragma unroll
    for (int et = 0; et < 8; ++et) { f32x4 acc = mm64((f32x4){0.f, 0.f, 0.f, 0.f}, VTm, et, SC, ct, lane);
        acc = mfma16(*(const GAS bf16x8_t*)(Sg + (16 * et + l15) * 64 + 8 * lg), ldfrag(Qd, 16 * ct, 0, lane), acc);
        acc = mfma16(*(const GAS bf16x8_t*)(Sg + (16 * et + l15) * 64 + 32 + 8 * lg), ldfrag(Qd, 16 * ct, 32, lane), acc);
        o[et] = acc; ss += (acc[0] * acc[0] + acc[1] * acc[1]) + (acc[2] * acc[2] + acc[3] * acc[3]); }
    ss += __shfl_xor(ss, 16); ss += __shfl_xor(ss, 32);
    const float rs = frsq(ss * (1.f / 128.f) + 1e-5f);
    const size_t row = rowb + col; const float* gn = A->in[25] + i * 512 + 128 * h4;
#pragma unroll
    for (int et = 0; et < 8; ++et) { const int e0 = 16 * et + 4 * lg; const f32x4 g4 = *(const GAS f32x4*)(gn + e0); const f32x4 gg = ld4bf_g(P + row * NIN_E + PC_GG + 128 * h4 + e0);
        f32x4 v = o[et] * rs * g4; v[0] *= silu_f(gg[0]); v[1] *= silu_f(gg[1]); v[2] *= silu_f(gg[2]); v[3] *= silu_f(gg[3]);
        *(GAS v2u*)(XNb + row * D + 512 + 128 * h4 + e0) = pack4(v); }
    __syncthreads();
}
constexpr int N_STEPS = 37;
#ifndef MK_ONE_LAUNCH
#define MK_ONE_LAUNCH 1
#endif
__global__ void __launch_bounds__(NTHREADS, 2) hybrid_fwd(Args args) {
    extern __shared__ __attribute__((aligned(16))) unsigned char lds_raw[];
    LAS unsigned char* lds = (LAS unsigned char*)lds_raw;
    ArgP A0 = (ArgP)__builtin_amdgcn_kernarg_segment_ptr();
    { const int tid = threadIdx.x; for (int u = tid; u < (LDS_BYTES - LDSCTL_OFF) / 4; u += NTHREADS) ((LAS unsigned*)(lds + LDSCTL_OFF))[u] = 0u; }
    __syncthreads();
    const int lo = A0->lo, hi = A0->hi;
    if (hi - lo > 1) (void)xcd_barrier_post((unsigned*)(A0->ws + WS_CTL) + CW_BAR, (volatile LAS unsigned*)(lds + MISC_OFF) + 8);
#ifndef PHM
#define PHM 0xff
#endif
#define RUN(s) (lo <= (s) && (s) < hi)
#define EN(b) ((PHM >> (b)) & 1)
#ifndef PROBE_REP
#define PROBE_REP 0
#endif
#define REP(b) _Pragma("unroll 1") for (int rep_ = 0; rep_ < (((PROBE_REP >> (b)) & 1) ? 2 : 1); ++rep_)
#define GRID_BARRIER() do { ArgP Ab_ = FRESH_ARGS(); XcdBarrier b_; b_.bar = (unsigned*)(Ab_->ws + WS_CTL) + CW_BAR; b_.x = xb_xcc_id(); b_.st = (volatile LAS unsigned*)(lds + MISC_OFF) + 8; xcd_barrier(b_); } while (0)
#define SEAM(s) do { if (RUN(s) && RUN((s) + 1)) GRID_BARRIER(); } while (0)
#define PHASE_VARS() ArgP A = FRESH_ARGS(); int L = Lq; FRESH_S(L); int tid = threadIdx.x; FRESH_V(tid); const int lane = tid & 63, wave = __builtin_amdgcn_readfirstlane(tid >> 6); int G = gridDim.x, bid = blockIdx.x; FRESH_S(G); FRESH_S(bid); (void)lane; (void)wave; (void)G; (void)A; (void)bid; \
    bf16* XN = (bf16*)(A->ws + WS_XN); bf16* PB = (bf16*)(A->ws + WS_P); (void)XN; (void)PB

    for (int Lq = 0; Lq < 4; ++Lq) {
        const int s0 = 9 * Lq; const bool even = !(Lq & 1);
        if (EN(0) && RUN(s0 + 0)) REP(0) { PHASE_VARS(); const float* xin = (L == 0) ? A->in[0] : A->out; phase_convert_norm(A, L, xin, lds, wave, lane, G, bid); }
        SEAM(s0 + 0);
        if (EN(1) && RUN(s0 + 1)) REP(1) {
            PHASE_VARS(); bf16* Win = (bf16*)(A->ws + WS_WIN);
            if (even) {
                pg8::Gemm g{XN, Win, M, NIN_E, D}; pg8::StaticOrderC<M, NIN_E> S; S.init(G, bid);
                pg8::EpiStoreBf16 E{PB, NIN_E, 0, 1.0f};
                pg8::gemm_phase<pg8::EpiStoreBf16, pg8::StaticOrderC<M, NIN_E>, PG8_ALIGN, PG8_SP2>(lds, g, S, E);
            } else {
                pg8::Gemm g{XN, Win, M, NIN_O, D}; pg8::StaticOrderC<M, NIN_O> S; S.init(G, bid);
                pg8::EpiStoreBf16 E{PB, NIN_O, 4, 0.125f * 1.4426950408889634f};
                pg8::gemm_phase<pg8::EpiStoreBf16, pg8::StaticOrderC<M, NIN_O>, PG8_ALIGN, PG8_SP2>(lds, g, S, E);
            }
        }
        SEAM(s0 + 1);
        if (even) {
            if (EN(2) && RUN(s0 + 2)) REP(2) { PHASE_VARS();
#pragma unroll 1
                for (int it = bid; it < BATCH * 64 * 8; it += G) rwkv_chunk_item(A, L, it >> 9, (it >> 3) & 63, it & 7, lds, tid);
                REP(8) {
#pragma unroll 1
                for (int it = bid; it < BATCH * 64 * 4; it += G) gla_kv_item(A, L, it >> 8, (it >> 2) & 63, it & 3, lds, tid); } }
            SEAM(s0 + 2);
            if (EN(3) && RUN(s0 + 3)) {
                PHASE_VARS();
                if (bid < 64) { REP(10) { if (wave == 0) rwkv_state_scan(A, bid >> 3, bid & 7, lane, !((PROBE_REP >> 10) & 1) || rep_ == 1); } }
                else { REP(11) { for (int gt = (bid - 64) * NTHREADS + tid; gt < 32 * 2048; gt += (G - 64) * NTHREADS) gla_state_scan(A, gt, !((PROBE_REP >> 11) & 1) || rep_ == 1); } }
            }
            SEAM(s0 + 3);
            if (EN(3) && RUN(s0 + 4)) {
                PHASE_VARS();
                REP(9) {
#pragma unroll 1
                for (int i2 = bid; i2 < BATCH * 64 * 4 / 2; i2 += G) gla_out_group(A, L, i2, lds, tid); }
                REP(12) { for (int wt = bid * NWAVES + wave; wt < BATCH * 64 * 8 * 4; wt += G * NWAVES) { const int it = wt >> 2; rwkv_out_item(A, L, it >> 9, (it >> 3) & 63, it & 7, wt & 3, lane, !((PROBE_REP >> 12) & 1) || rep_ == 1); } }
            }
        } else {
            if (EN(4) && RUN(s0 + 3)) REP(4) { PHASE_VARS(); attn_phase_mfma(A, L, lds, tid, G, bid); }
        }
        if (even ? (RUN(s0 + 4) && RUN(s0 + 5)) : (RUN(s0 + 3) && RUN(s0 + 5))) GRID_BARRIER();
        if (EN(5) && RUN(s0 + 5)) {
            PHASE_VARS(); bf16* Wout = (bf16*)(A->ws + WS_WOUT); const float* xin = (L == 0) ? A->in[0] : A->out;
            pg8::Gemm g{XN, Wout, M, D, D}; pg8::StaticOrderC<M, D> S; S.init(G, bid);
            pg8::EpiResF32 E{xin, A->out, D};
            pg8::gemm_phase<pg8::EpiResF32, pg8::StaticOrderC<M, D>, PG8_ALIGN, PG8_SP2>(lds, g, S, E);
        }
        SEAM(s0 + 5);
        if (RUN(s0 + 6)) {
            PHASE_VARS();
            const int gw = bid * NWAVES + wave, NGW = G * NWAVES; const float* gain = A->in[3] + (size_t)L * D;
            for (int m = gw; m < M; m += NGW) rms_row_bf16(A->out + (size_t)m * D, gain, XN + (size_t)m * D, lane);
        }
        SEAM(s0 + 6);
        if (EN(6) && RUN(s0 + 7)) REP(6) {
            PHASE_VARS(); bf16* Wgu = (bf16*)(A->ws + WS_WGU);
            pg8::Gemm g{XN, Wgu, M, NGU, D}; pg8::StaticOrderC<M, NGU> S; S.init(G, bid);
            pg8::EpiSwiglu E{PB, FF};
            pg8::gemm_phase<pg8::EpiSwiglu, pg8::StaticOrderC<M, NGU>, PG8_ALIGN, PG8_SP2>(lds, g, S, E);
        }
        SEAM(s0 + 7);
        if (EN(7) && RUN(s0 + 8)) {
            PHASE_VARS(); bf16* Wdn = (bf16*)(A->ws + WS_WDN);
            pg8::Gemm g{PB, Wdn, M, D, FF}; pg8::StaticOrderC<M, D> S; S.init(G, bid);
            pg8::EpiResF32 E{A->out, A->out, D};
            pg8::gemm_phase<pg8::EpiResF32, pg8::StaticOrderC<M, D>, PG8_ALIGN, PG8_SP2>(lds, g, S, E);
        }
        SEAM(s0 + 8);
    }
    if (RUN(36)) {
        int Lq = 0; PHASE_VARS();
        const int gw = bid * NWAVES + wave, NGW = G * NWAVES;
        for (int m = gw; m < M; m += NGW) rms_row_f32(A->out + (size_t)m * D, A->in[4], A->out + (size_t)m * D, lane);
    }
#undef RUN
#undef SEAM
}

extern "C" void kernel_launch(void* const* d_in, const int* in_sizes, int n_in, void* d_out, int out_size, void* d_ws, size_t ws_size, hipStream_t stream) {
    static int grid = 0;
    if (grid == 0) {
        if (n_in != 36 || in_sizes[0] != M * D || out_size != M * D || ws_size < WS_END) { fprintf(stderr, "kernel_launch: unexpected shapes (n_in %d, in0 %d, out %d, ws %zu); nothing launched\n", n_in, n_in > 0 ? in_sizes[0] : -1, out_size, ws_size); grid = -1; return; }
        int dev = 0, cus = 0, per_cu = 0;
        if (hipGetDevice(&dev) != hipSuccess || hipDeviceGetAttribute(&cus, hipDeviceAttributeMultiprocessorCount, dev) != hipSuccess) { grid = -1; return; }
        if (hipFuncSetAttribute((const void*)hybrid_fwd, hipFuncAttributeMaxDynamicSharedMemorySize, LDS_BYTES) != hipSuccess) { fprintf(stderr, "kernel_launch: hipFuncSetAttribute failed\n"); grid = -1; return; }
        if (hipOccupancyMaxActiveBlocksPerMultiprocessor(&per_cu, (const void*)hybrid_fwd, NTHREADS, LDS_BYTES) != hipSuccess || per_cu < 1) fprintf(stderr, "kernel_launch: occupancy query reports %d\n", per_cu);
        (void)hipGetLastError();
        grid = cus;
    }
    if (grid < 0) return;
    if (hipMemsetAsync((char*)d_ws + WS_CTL, 0, CTL_ZERO_BYTES, stream) != hipSuccess) return;
    Args a{};
    for (int i = 0; i < 36; ++i) a.in[i] = (const float*)d_in[i];
    a.out = (float*)d_out; a.ws = (unsigned char*)d_ws;
#if MK_ONE_LAUNCH
    a.lo = 0; a.hi = N_STEPS;
    hipLaunchKernelGGL(hybrid_fwd, dim3(grid), dim3(NTHREADS), LDS_BYTES, stream, a);
#else
    for (int s = 0; s < N_STEPS; ++s) {
        if (s < 36 && ((s % 9) == 2 || (s % 9) == 4) && ((s / 9) & 1)) continue;
        a.lo = s; a.hi = s + 1;
        hipLaunchKernelGGL(hybrid_fwd, dim3(grid), dim3(NTHREADS), LDS_BYTES, stream, a);
    }
#endif
}
```

```cpp
#include <hip/hip_runtime.h>
#include <cstdio>
#include <cstdint>
__device__ __forceinline__ float silu_f(float x) { return x * __builtin_amdgcn_rcpf(1.0f + __builtin_amdgcn_exp2f(-1.4426950408889634f * x)); }
namespace pg8 {
#define PG8_LAS __attribute__((address_space(3)))
typedef unsigned short bf16_t;
typedef short bf16x8 __attribute__((ext_vector_type(8)));
typedef float f32x4 __attribute__((ext_vector_type(4)));
typedef unsigned u32x4 __attribute__((ext_vector_type(4)));
constexpr int BM = 256, BK = 64, HALF = 128, HTB = HALF * BK * 2  , STAGE_BYTES = 8 * HTB, NXCD = 8, WGM = 8;

__host__ __device__ __forceinline__ int lds_byte(int r, int c) { const int st = (r >> 4) * 2 + (c >> 5), rr = r & 15, cc = c & 31, ob = rr * 64 + cc * 2; return st * 1024 + (ob ^ (((ob >> 9) & 1) << 5)); }
__host__ __device__ __forceinline__ void stage_rc(int b, int& R, int& C) { const int st = b / 1024, sb = b % 1024, swz = sb ^ (((sb >> 9) & 1) << 5); R = (st >> 1) * 16 + swz / 64; C = (st & 1) * 32 + (swz % 64) / 2; }
__host__ __device__ __forceinline__ int perm32(int rho) { const int n = rho >> 4, i = rho & 15; return 8 * (i >> 2) + 4 * n + (i & 3); }

struct Unit { int pm, pn, idx; };
struct Gemm { const bf16_t* A; const bf16_t* Bt; int M, N, K; };

struct StaticOrder {
    int nM, nN, nwg, G, c;
    __host__ __device__ void init(int M, int N, int G_, int c_) { nM = M / BM; nN = N / BM; nwg = nM * nN; G = G_; c = c_; }
    __host__ __device__ bool next(int i, Unit& u) const {
        const long L = (long)i * G + c; if (L >= nwg) return false;
        int wgid = (int)L; { const int q = nwg / NXCD, r = nwg % NXCD, xcd = wgid % NXCD, off = wgid / NXCD; wgid = (xcd < r ? xcd * (q + 1) : r * (q + 1) + (xcd - r) * q) + off; }
        const int nig = WGM * nN, gid = wgid / nig, fm = gid * WGM, gsz = (nM - fm) < WGM ? (nM - fm) : WGM;
        u.pm = fm + ((wgid % nig) % gsz); u.pn = (wgid % nig) / gsz; return true;
    }
    __device__ __forceinline__ void a_ready(const Unit&) const {}
    __device__ __forceinline__ void done(const Unit&) const {}
};

__device__ __forceinline__ unsigned cvt_pk_bf16(float lo, float hi) { unsigned r; asm volatile("v_cvt_pk_bf16_f32 %0, %1, %2" : "=v"(r) : "v"(lo), "v"(hi)); return r; }
typedef float f32x2 __attribute__((ext_vector_type(2)));
__device__ __forceinline__ float row_ssq(const float* ssq, int row) { const f32x4* p = (const f32x4*)(ssq + (size_t)row * 16); const f32x4 a = p[0], b = p[1], c = p[2], d = p[3];
    return (((a[0] + a[1]) + (a[2] + a[3])) + ((b[0] + b[1]) + (b[2] + b[3]))) + (((c[0] + c[1]) + (c[2] + c[3])) + ((d[0] + d[1]) + (d[2] + d[3]))); }
struct EpiStoreBf16 {
    static constexpr bool PERM = true, AFTER_DRAIN = false;
    bf16_t* O; int ldc; int qtiles; float qscale; const PG8_LAS float* rstab;
    __device__ __forceinline__ void operator()(const f32x4 (&acc)[2][2][4][2], const Unit& u, int wr, int wc, int fr, int fq) const {
        const int row0 = u.pm * BM + wr * 64 + fr, col0 = u.pn * BM + wc * 32 + 8 * fq;
        const float sc = u.pn < qtiles ? qscale : 1.0f;
        const PG8_LAS float* rt_ = rstab + u.idx * BM + wr * 64 + fr;
#pragma unroll
        for (int ai = 0; ai < 2; ++ai)
#pragma unroll
            for (int m = 0; m < 4; ++m) { const int row = row0 + ai * HALF + m * 16; bf16_t* rowp = O + (size_t)row * ldc + col0;
                const float rs = sc * rt_[ai * HALF + m * 16];
#pragma unroll
                for (int bj = 0; bj < 2; ++bj) { const f32x4 v0 = acc[ai][bj][m][0] * rs, v1 = acc[ai][bj][m][1] * rs;
                    u32x4 w; w.x = cvt_pk_bf16(v0[0], v0[1]); w.y = cvt_pk_bf16(v0[2], v0[3]); w.z = cvt_pk_bf16(v1[0], v1[1]); w.w = cvt_pk_bf16(v1[2], v1[3]);
                    *(u32x4*)(rowp + bj * HALF) = w; } }
    }
};
template <bool LAST> struct EpiResBf16 {
    static constexpr bool PERM = false, AFTER_DRAIN = false;
    bf16_t* xr; int ldc; float* ssq; float* xf;
    __device__ __forceinline__ void operator()(const f32x4 (&acc)[2][2][4][2], const Unit& u, int wr, int wc, int fr, int fq) const {
        typedef unsigned u32x2 __attribute__((ext_vector_type(2)));
        const int row0 = u.pm * BM + wr * 64 + fr, col0 = u.pn * BM + wc * 32 + 4 * fq;
#pragma unroll
        for (int ai = 0; ai < 2; ++ai)
#pragma unroll
            for (int m = 0; m < 4; ++m) { const int row = row0 + ai * HALF + m * 16; const size_t off = (size_t)row * ldc + col0; float s = 0.f;
#pragma unroll
                for (int bj = 0; bj < 2; ++bj)
#pragma unroll
                    for (int n = 0; n < 2; ++n) { const u32x2 bw = *(const u32x2*)(xr + off + bj * HALF + n * 16);
                        const f32x4 b = (f32x4){__builtin_bit_cast(float, bw.x << 16), __builtin_bit_cast(float, bw.x & 0xffff0000u), __builtin_bit_cast(float, bw.y << 16), __builtin_bit_cast(float, bw.y & 0xffff0000u)};
                        const f32x4 v = b + acc[ai][bj][m][n];
                        s += (v[0] * v[0] + v[1] * v[1]) + (v[2] * v[2] + v[3] * v[3]);
                        if (LAST) *(f32x4*)(xf + off + bj * HALF + n * 16) = v;
                        else { u32x2 w; w.x = cvt_pk_bf16(v[0], v[1]); w.y = cvt_pk_bf16(v[2], v[3]); *(u32x2*)(xr + off + bj * HALF + n * 16) = w; } }
                s += __shfl_xor(s, 16); s += __shfl_xor(s, 32);
                if (fq == 0) ssq[(size_t)row * 16 + u.pn * 4 + wc] = s;
                if (m & 1) asm volatile("" ::: "memory"); }
    }
};
struct EpiSwiglu {
    static constexpr bool PERM = true, AFTER_DRAIN = false;
    bf16_t* H; int ldc; const PG8_LAS float* rstab;
    __device__ __forceinline__ void operator()(const f32x4 (&acc)[2][2][4][2], const Unit& u, int wr, int wc, int fr, int fq) const {
        const int row0 = u.pm * BM + wr * 64 + fr, colh = u.pn * HALF + wc * 32 + 8 * fq;
        const PG8_LAS float* rt_ = rstab + u.idx * BM + wr * 64 + fr;
#pragma unroll
        for (int ai = 0; ai < 2; ++ai)
#pragma unroll
            for (int m = 0; m < 4; ++m) { const int row = row0 + ai * HALF + m * 16; bf16_t* rowp = H + (size_t)row * ldc + colh;
                const float rs = rt_[ai * HALF + m * 16];
                const f32x4 g0 = acc[ai][0][m][0] * rs, g1 = acc[ai][0][m][1] * rs, u0 = acc[ai][1][m][0] * rs, u1 = acc[ai][1][m][1] * rs;
                float h[8];
#pragma unroll
                for (int e = 0; e < 4; ++e) { h[e] = silu_f(g0[e]) * u0[e]; h[4 + e] = silu_f(g1[e]) * u1[e]; }
                u32x4 w; w.x = cvt_pk_bf16(h[0], h[1]); w.y = cvt_pk_bf16(h[2], h[3]); w.z = cvt_pk_bf16(h[4], h[5]); w.w = cvt_pk_bf16(h[6], h[7]);
                *(u32x4*)rowp = w; }
    }
};
template <int M_, int N_> struct StaticOrderC {
    static constexpr int nM = M_ / BM, nN = N_ / BM, nwg = nM * nN;
    int G, c;
    __device__ __forceinline__ void init(int G_, int c_) { G = G_; c = c_; }
    __device__ __forceinline__ bool next(int i, Unit& u) const {
        const int L = i * G + c; if (L >= nwg) return false;
        int wgid = L; { constexpr int q = nwg / NXCD, r = nwg % NXCD; const int xcd = wgid % NXCD, off = wgid / NXCD; wgid = (xcd < r ? xcd * (q + 1) : r * (q + 1) + (xcd - r) * q) + off; }
        constexpr int nig = WGM * nN; const int gid = wgid / nig, fm = gid * WGM, gsz = (nM - fm) < WGM ? (nM - fm) : WGM;
        u.pm = fm + ((wgid % nig) % gsz); u.pn = (wgid % nig) / gsz; u.idx = i; return true;
    }
    __device__ __forceinline__ void a_ready(const Unit&) const {}
    __device__ __forceinline__ void done(const Unit&) const {}
};
template <class Sched> __device__ __forceinline__ void fill_row_scales(const Sched& S, const float* ssq, PG8_LAS float* tab, int tid) {
    Unit u; const int r = tid >> 1, hf = tid & 1;
    for (int i = 0; S.next(i, u); ++i) { const f32x4* p = (const f32x4*)(ssq + (size_t)(u.pm * BM + r) * 16 + hf * 8); const f32x4 a = p[0], b = p[1];
        float sum = ((a[0] + a[1]) + (a[2] + a[3])) + ((b[0] + b[1]) + (b[2] + b[3])); sum += __shfl_xor(sum, 1);
        if (hf == 0) tab[i * BM + r] = __builtin_amdgcn_rsqf(sum * (1.0f / 1024.0f) + 1e-6f); }
    __syncthreads();
}
template <class Epi, class Sched, bool ALIGN_EPI = false, bool SP2 = false>
__device__ __forceinline__ void gemm_phase(PG8_LAS unsigned char* lds, const Gemm g, const Sched& S, const Epi& E) {
    int tid_ = threadIdx.x; asm volatile("" : "+v"(tid_));
    float zz_ = 0.f; asm volatile("" : "+v"(zz_));
    const int tid = tid_, wid = __builtin_amdgcn_readfirstlane(tid >> 6), lane = tid & 63, wr = wid >> 2, wc = wid & 3, fr = lane & 15, fq = lane >> 4;
    const int K = g.K, nt = K / BK;
    unsigned voffA[2], voffB[2];
#pragma unroll
    for (int i = 0; i < 2; ++i) { int R, C; stage_rc(tid * 16 + i * 8192, R, C); const int Rb = Epi::PERM ? ((R & ~31) + perm32(R & 31)) : R;
        voffA[i] = (unsigned)(R * K + C) * 2u; voffB[i] = (unsigned)(Rb * K + C) * 2u; }
    const size_t kstep = (size_t)(BK * 2);
    const size_t hstep = (size_t)HALF * K * 2;
    const size_t tstep = 2 * hstep;
    const unsigned ldsw = (unsigned)wid * 1024u;
    const int aoff = lds_byte(wr * 64 + fr, fq * 8), boff = lds_byte(wc * 32 + fr, fq * 8);
#define PG8_SA(b, h) (((b) * 2 + (h)) * HTB)
#define PG8_SB(b, h) ((4 + (b) * 2 + (h)) * HTB)
#define PG8_STAGE(bufoff, gbase, voff) do { _Pragma("unroll") for (int _i = 0; _i < 2; ++_i) \
        __builtin_amdgcn_global_load_lds((const unsigned*)((const char*)(gbase) + (voff)[_i]), (PG8_LAS unsigned*)(lds + (bufoff) + ldsw + _i * 8192), 16, 0, 0); } while (0)
#define PG8_LDA(dst, b, h) do { _Pragma("unroll") for (int m = 0; m < 4; ++m) _Pragma("unroll") for (int k = 0; k < 2; ++k) dst[m][k] = *(const PG8_LAS bf16x8*)(lds + PG8_SA(b, h) + aoff + m * 2048 + k * 1024); } while (0)
#define PG8_LDB(dst, b, h) do { _Pragma("unroll") for (int n = 0; n < 2; ++n) _Pragma("unroll") for (int k = 0; k < 2; ++k) dst[n][k] = *(const PG8_LAS bf16x8*)(lds + PG8_SB(b, h) + boff + n * 2048 + k * 1024); } while (0)
#define PG8_MMA(ai, bj, At, Bt) do { __builtin_amdgcn_s_setprio(1); _Pragma("unroll") for (int m = 0; m < 4; ++m) _Pragma("unroll") for (int n = 0; n < 2; ++n) _Pragma("unroll") for (int k = 0; k < 2; ++k) \
        acc[ai][bj][m][n] = __builtin_amdgcn_mfma_f32_16x16x32_bf16(Bt[n][k], At[m][k], acc[ai][bj][m][n], 0, 0, 0); __builtin_amdgcn_s_setprio(0); } while (0)
#define PG8_WAIT_V(n) asm volatile("s_waitcnt vmcnt(" #n ")" ::: "memory")
#define PG8_WAIT_L(n) asm volatile("s_waitcnt lgkmcnt(" #n ")" ::: "memory")
#define PG8_BAR __builtin_amdgcn_s_barrier()
#define PG8_SCHED __builtin_amdgcn_sched_barrier(0)
    Unit cur, nxt; int ui = 0;
    if (!S.next(0, cur)) return;
    f32x4 acc[2][2][4][2];
#pragma unroll
    for (int a = 0; a < 2; ++a)
#pragma unroll
        for (int b = 0; b < 2; ++b)
#pragma unroll
            for (int m = 0; m < 4; ++m)
#pragma unroll
                for (int n = 0; n < 2; ++n) acc[a][b][m][n] = (f32x4){zz_, zz_, zz_, zz_};
    bf16x8 At[4][2], B0[2][2], B1[2][2];
    const char* cA = (const char*)g.A + (size_t)cur.pm * tstep; const char* cB = (const char*)g.Bt + (size_t)cur.pn * tstep;
    S.a_ready(cur);
    if constexpr (SP2) {
        PG8_STAGE(PG8_SB(0, 0), cB, voffB); PG8_STAGE(PG8_SB(0, 1), cB + hstep, voffB); PG8_STAGE(PG8_SA(0, 0), cA, voffA); PG8_STAGE(PG8_SA(0, 1), cA + hstep, voffA);
        if (wr == 1) PG8_BAR;
        PG8_WAIT_V(2); PG8_BAR;
        PG8_STAGE(PG8_SB(1, 0), cB + kstep, voffB); PG8_STAGE(PG8_SA(1, 0), cA + kstep, voffA); PG8_STAGE(PG8_SB(1, 1), cB + hstep + kstep, voffB);
        PG8_WAIT_V(6); PG8_BAR;
    } else {
        PG8_STAGE(PG8_SB(0, 0), cB, voffB); PG8_STAGE(PG8_SA(0, 0), cA, voffA); PG8_STAGE(PG8_SB(0, 1), cB + hstep, voffB); PG8_STAGE(PG8_SA(0, 1), cA + hstep, voffA);
        if (wr == 1) PG8_BAR;
        PG8_WAIT_V(4); PG8_BAR;
        PG8_STAGE(PG8_SB(1, 0), cB + kstep, voffB); PG8_STAGE(PG8_SA(1, 0), cA + kstep, voffA); PG8_STAGE(PG8_SB(1, 1), cB + hstep + kstep, voffB);
        PG8_WAIT_V(6); PG8_BAR;
    }
    for (;;) {
        const bool has_next = S.next(ui + 1, nxt);
        const char* nA = has_next ? (const char*)g.A + (size_t)nxt.pm * tstep : cA; const char* nB = has_next ? (const char*)g.Bt + (size_t)nxt.pn * tstep : cB;
        for (int t = 0; t < nt; t += 2) {
            const bool last = (t == nt - 2);
            const char* a1 = cA + (size_t)(t + 1) * kstep;
            const char* a2 = last ? nA : cA + (size_t)(t + 2) * kstep; const char* b2 = last ? nB : cB + (size_t)(t + 2) * kstep;
            const char* a3 = a2 + kstep; const char* b3 = b2 + kstep;
            if (last && has_next) S.a_ready(nxt);
            if constexpr (SP2) {
            PG8_LDB(B0, 0, 0); PG8_LDB(B1, 0, 1); PG8_SCHED; PG8_LDA(At, 0, 0); PG8_STAGE(PG8_SA(1, 1), a1 + hstep, voffA);
            PG8_WAIT_V(8); PG8_WAIT_L(0); PG8_BAR; PG8_MMA(0, 0, At, B0); PG8_MMA(0, 1, At, B1); PG8_BAR; PG8_SCHED;
            PG8_LDA(At, 0, 1); PG8_STAGE(PG8_SB(0, 0), b2, voffB); PG8_STAGE(PG8_SB(0, 1), b2 + hstep, voffB); PG8_STAGE(PG8_SA(0, 0), a2, voffA);
            PG8_WAIT_V(8); PG8_WAIT_L(0); PG8_BAR; PG8_MMA(1, 0, At, B0); PG8_MMA(1, 1, At, B1); PG8_BAR; PG8_SCHED;
            PG8_LDB(B0, 1, 0); PG8_LDB(B1, 1, 1); PG8_SCHED; PG8_LDA(At, 1, 0); PG8_STAGE(PG8_SA(0, 1), a2 + hstep, voffA);
            PG8_WAIT_V(8); PG8_WAIT_L(0); PG8_BAR; PG8_MMA(0, 0, At, B0); PG8_MMA(0, 1, At, B1); PG8_BAR; PG8_SCHED;
            PG8_LDA(At, 1, 1); PG8_STAGE(PG8_SB(1, 0), b3, voffB); PG8_STAGE(PG8_SB(1, 1), b3 + hstep, voffB); PG8_STAGE(PG8_SA(1, 0), a3, voffA);
            PG8_WAIT_V(8); PG8_WAIT_L(0); PG8_BAR; PG8_MMA(1, 0, At, B0); PG8_MMA(1, 1, At, B1); PG8_BAR; PG8_SCHED;
            } else {
            PG8_LDB(B0, 0, 0); PG8_SCHED; PG8_LDA(At, 0, 0); PG8_STAGE(PG8_SA(1, 1), a1 + hstep, voffA);
            PG8_WAIT_L(8); PG8_BAR; PG8_WAIT_L(0); PG8_MMA(0, 0, At, B0); PG8_BAR; PG8_SCHED;
            PG8_LDB(B1, 0, 1); PG8_STAGE(PG8_SB(0, 0), b2, voffB);
            PG8_BAR; PG8_WAIT_L(0); PG8_MMA(0, 1, At, B1); PG8_BAR;
            PG8_LDA(At, 0, 1); PG8_STAGE(PG8_SA(0, 0), a2, voffA);
            PG8_BAR; PG8_WAIT_L(0); PG8_MMA(1, 0, At, B0); PG8_BAR; PG8_SCHED;
            PG8_STAGE(PG8_SB(0, 1), b2 + hstep, voffB);
            PG8_WAIT_V(6); PG8_BAR; PG8_MMA(1, 1, At, B1); PG8_BAR;
            PG8_LDB(B0, 1, 0); PG8_SCHED; PG8_LDA(At, 1, 0); PG8_STAGE(PG8_SA(0, 1), a2 + hstep, voffA);
            PG8_WAIT_L(8); PG8_BAR; PG8_WAIT_L(0); PG8_MMA(0, 0, At, B0); PG8_BAR; PG8_SCHED;
            PG8_LDB(B1, 1, 1); PG8_STAGE(PG8_SB(1, 0), b3, voffB);
            PG8_BAR; PG8_WAIT_L(0); PG8_MMA(0, 1, At, B1); PG8_BAR;
            PG8_LDA(At, 1, 1); PG8_STAGE(PG8_SA(1, 0), a3, voffA);
            PG8_BAR; PG8_WAIT_L(0); PG8_MMA(1, 0, At, B0); PG8_BAR; PG8_SCHED;
            PG8_STAGE(PG8_SB(1, 1), b3 + hstep, voffB);
            PG8_WAIT_V(6); PG8_BAR; PG8_MMA(1, 1, At, B1); PG8_BAR;
            }
        }
        if constexpr (ALIGN_EPI) { if (wr == 0) PG8_BAR; }
        if constexpr (!Epi::AFTER_DRAIN) { E(acc, cur, wr, wc, fr, fq); S.done(cur); }
        if (!has_next) break;
#pragma unroll
        for (int a = 0; a < 2; ++a)
#pragma unroll
            for (int b = 0; b < 2; ++b)
#pragma unroll
                for (int m = 0; m < 4; ++m)
#pragma unroll
                    for (int n = 0; n < 2; ++n) acc[a][b][m][n] = (f32x4){zz_, zz_, zz_, zz_};
        cur = nxt; cA = nA; cB = nB; ++ui;
        if constexpr (ALIGN_EPI) { if (wr == 1) PG8_BAR; }
    }
    PG8_WAIT_V(0);
    if constexpr (!ALIGN_EPI) { if (wr == 0) PG8_BAR; }
    PG8_BAR;
    if constexpr (Epi::AFTER_DRAIN) { E.fused(acc, cur, wr, wc, fr, fq, lds, wid, lane); S.done(cur); }
#undef PG8_SA
#undef PG8_SB
#undef PG8_STAGE
#undef PG8_LDA
#undef PG8_LDB
#undef PG8_MMA
#undef PG8_WAIT_V
#undef PG8_WAIT_L
#undef PG8_BAR
#undef PG8_SCHED
}
}
#ifndef PG8_SP2
#define PG8_SP2 true
#endif
#ifndef PG8_ALIGN
#define PG8_ALIGN true
#endif
constexpr int NWAVES = 8, NTHREADS = NWAVES * 64;
constexpr int BATCH = 8, T = 4096, D = 1024, M = BATCH * T;
constexpr int NIN_E = 3840, NIN_O = 3072, FF = 2816, NGU = 2 * FF;
constexpr int PC_R = 0, PC_K = 512, PC_V = 1024, PC_GQ = 1536, PC_GK = 1792, PC_GV = 2048, PC_GG = 2560;
constexpr int PC_W1A = 3072, PC_W1B = 3136, PC_A1A = 3200, PC_A1B = 3264, PC_G1A = 3328, PC_G1B = 3488, PC_WA1 = 3648, PC_PAD = 3664;
constexpr int NLORA = 304;
constexpr size_t MiB = 1u << 20;
constexpr size_t WS_CTL = 0, CTL_ZERO_BYTES = 1 * MiB;
constexpr size_t WS_WIN = 2 * MiB, WS_WOUT = 10 * MiB, WS_WGU = 12 * MiB, WS_WDN = 23 * MiB;
constexpr size_t WS_W2T = 29 * MiB, WS_A2T = WS_W2T + 65536, WS_G2T = WS_A2T + 65536, WS_WA2T = WS_G2T + 196608;
constexpr size_t WS_SSQ = 496 * MiB;
constexpr size_t WS_XFIN = 336 * MiB;
constexpr size_t WS_XN = 32 * MiB;
constexpr size_t WS_P = 96 * MiB;
constexpr size_t WS_WLOG = 336 * MiB;
constexpr size_t WS_ASIG = 400 * MiB;
constexpr size_t WS_LA = 464 * MiB;
constexpr size_t WS_END = 500 * MiB;
constexpr int CW_BAR = 4096;
constexpr int RING_BYTES = 135168, LDSCTL_OFF = RING_BYTES, MISC_OFF = LDSCTL_OFF + 320, LDS_BYTES = 163840, RSTAB_OFF = MISC_OFF + 128;

#define GAS __attribute__((address_space(1)))
#define LAS __attribute__((address_space(3)))
typedef unsigned short bf16;
typedef unsigned v4u __attribute__((ext_vector_type(4)));
typedef unsigned v2u __attribute__((ext_vector_type(2)));
typedef float f32x4 __attribute__((ext_vector_type(4)));
#define LDS_WAIT() asm volatile("s_waitcnt lgkmcnt(0)" ::: "memory")
#define VM_WAIT() asm volatile("s_waitcnt vmcnt(0)" ::: "memory")
__device__ __forceinline__ unsigned f2bf(float f) { unsigned u = __builtin_bit_cast(unsigned, f); return (u + 0x7fffu + ((u >> 16) & 1u)) >> 16; }
__device__ __forceinline__ unsigned pk2(float lo, float hi) { return f2bf(lo) | (f2bf(hi) << 16); }
__device__ __forceinline__ float bf2f(bf16 u) { return __builtin_bit_cast(float, (unsigned)u << 16); }
__device__ __forceinline__ float bflo(unsigned w) { return __builtin_bit_cast(float, w << 16); }
__device__ __forceinline__ float bfhi(unsigned w) { return __builtin_bit_cast(float, w & 0xffff0000u); }
__device__ __forceinline__ float wave_sum(float v) {
#pragma unroll
    for (int o = 1; o < 64; o <<= 1) v += __shfl_xor(v, o);
    return v;
}
__device__ __forceinline__ float wave_max(float v) {
#pragma unroll
    for (int o = 1; o < 64; o <<= 1) v = fmaxf(v, __shfl_xor(v, o));
    return v;
}
__device__ __forceinline__ float fexp(float x) { return __builtin_amdgcn_exp2f(x * 1.4426950408889634f); }
__device__ __forceinline__ float flog(float x) { return __builtin_amdgcn_logf(x) * 0.6931471805599453f; }
__device__ __forceinline__ float frcp(float x) { return __builtin_amdgcn_rcpf(x); }
__device__ __forceinline__ float frsq(float x) { return __builtin_amdgcn_rsqf(x); }
__device__ __forceinline__ float fsqrt(float x) { return __builtin_amdgcn_sqrtf(x); }
__device__ __forceinline__ float sigmoid_f(float x) { return frcp(1.0f + fexp(-x)); }
__device__ __forceinline__ float softplus_f(float x) { return fmaxf(x, 0.f) + flog(1.0f + fexp(-fabsf(x))); }
__device__ __forceinline__ float tanh_f(float x) { return 1.0f - 2.0f * frcp(1.0f + fexp(2.0f * x)); }
#define XB_TMO      128
#define XB_XCNT(j)  (256  + 64 * (j))
#define XB_XSUB(j)  (1280 + 64 * (j))
#define XB_XGEN(j)  (2304 + 64 * (j))
#define XB_TOP      3328
#define XB_TOPGEN   3392
#define XCD_BAR_WORDS 3456
#define XB_SPIN_CAP (1u << 23)

__device__ __forceinline__ unsigned xb_ld(unsigned* p)              { return __hip_atomic_load(p, __ATOMIC_RELAXED, __HIP_MEMORY_SCOPE_AGENT); }
__device__ __forceinline__ unsigned xb_add(unsigned* p, unsigned v) { return __hip_atomic_fetch_add(p, v, __ATOMIC_RELAXED, __HIP_MEMORY_SCOPE_AGENT); }
__device__ __forceinline__ unsigned xb_xcc_id() { return (unsigned)__builtin_amdgcn_s_getreg((3 << 11) | 20) & 0xFu; }
#define XB_SPIN(cond, bar) do { unsigned _sp = 0; while (cond) { __builtin_amdgcn_s_sleep(1); \
    if ((++_sp & 255u) == 0u) { if (xb_ld(&(bar)[XB_TMO])) break; if (_sp > XB_SPIN_CAP) { atomicAdd(&(bar)[XB_TMO], 1u); break; } } } } while (0)

struct XcdBarrier {
    unsigned* bar; unsigned x;
    volatile LAS unsigned* st;
};

__device__ __forceinline__ XcdBarrier xcd_barrier_post(unsigned* bar, volatile LAS unsigned* st) {
    XcdBarrier b; b.bar = bar; b.x = xb_xcc_id(); b.st = st;
    if (threadIdx.x == 0) (void)xb_add(&bar[XB_XCNT(b.x)], 1u);
    return b;
}
__device__ __forceinline__ void xcd_barrier_complete(unsigned* bar, unsigned x, unsigned& nloc, unsigned& nx) {
    const unsigned G = gridDim.x * gridDim.y * gridDim.z;
    unsigned sum, cnt, mine, sp = 0u;
    for (;;) {
        sum = 0u; cnt = 0u; mine = 0u;
#pragma unroll
        for (unsigned j = 0; j < 16; ++j) { const unsigned c = xb_ld(&bar[XB_XCNT(j)]); sum += c; cnt += (c > 0u) ? 1u : 0u; mine = (j == x) ? c : mine; }
        if (sum == G) break;
        __builtin_amdgcn_s_sleep(1);
        if ((++sp & 255u) == 0u) { if (xb_ld(&bar[XB_TMO])) break; if (sp > XB_SPIN_CAP) { atomicAdd(&bar[XB_TMO], 1u); break; } }
    }
    nloc = mine > 0u ? mine : 1u; nx = cnt > 0u ? cnt : 1u;
}

__device__ __forceinline__ void xcd_barrier(const XcdBarrier& b) {
    asm volatile("s_waitcnt vmcnt(0)" ::: "memory");
    __syncthreads();
    if (threadIdx.x == 0) {
        unsigned blo_ = __builtin_amdgcn_readfirstlane((unsigned)(unsigned long long)b.bar), bhi_ = __builtin_amdgcn_readfirstlane((unsigned)((unsigned long long)b.bar >> 32)), bx = __builtin_amdgcn_readfirstlane(b.x); asm volatile("" : "+s"(blo_), "+s"(bhi_), "+s"(bx)); unsigned* bar = (unsigned*)(((unsigned long long)bhi_ << 32) | blo_);
        __builtin_amdgcn_s_waitcnt(0);
        unsigned nloc = b.st[0], nx = b.st[1];
        if (nloc == 0u) { xcd_barrier_complete(bar, bx, nloc, nx); b.st[0] = nloc; b.st[1] = nx; }
        const unsigned old = xb_add(&bar[XB_XSUB(bx)], 1u);
        const unsigned gen = old / nloc;
        if (old + 1u == (gen + 1u) * nloc) {
            __builtin_amdgcn_fence(__ATOMIC_RELEASE, "agent");
            asm volatile("s_waitcnt vmcnt(0)" ::: "memory");
            const unsigned og = xb_add(&bar[XB_TOP], 1u);
            const unsigned tg = og / nx;
            if (og + 1u == (tg + 1u) * nx) xb_add(&bar[XB_TOPGEN], 1u);
            else XB_SPIN(xb_ld(&bar[XB_TOPGEN]) == tg, bar);
            __builtin_amdgcn_fence(__ATOMIC_ACQUIRE, "agent");
            xb_add(&bar[XB_XGEN(bx)], 1u);
            asm volatile("s_waitcnt vmcnt(0)" ::: "memory");
        } else {
            XB_SPIN(xb_ld(&bar[XB_XGEN(bx)]) == gen, bar);
            __builtin_amdgcn_fence(__ATOMIC_ACQUIRE, "agent");
            asm volatile("s_waitcnt vmcnt(0)" ::: "memory");
        }
    }
    __syncthreads();
}
__device__ __forceinline__ void tr_item(const float* __restrict__ W, int Kreal, int N, bf16* WT, int ldd, int dst_row0, LAS float* scr, int k0, int n0, int lane,
                                        const float* __restrict__ mu, float sc0, float sc1, const float* __restrict__ gk = nullptr) {
    const int nn = n0 + (lane & 31); const bool nv = nn < N;
#pragma unroll 8
    for (int i = 0; i < 32; ++i) { const int kk = 2 * i + (lane >> 5); float v = (nv && k0 + kk < Kreal) ? W[(size_t)(k0 + kk) * N + nn] : 0.f; if (mu) v *= sc0 + sc1 * mu[k0 + kk]; if (gk) v *= gk[k0 + kk]; scr[kk * 33 + (lane & 31)] = v; }
    LDS_WAIT(); asm volatile("" ::: "memory");
    const int c = lane & 7;
#pragma unroll
    for (int j = 0; j < 4; ++j) { const int n = (lane >> 3) + 8 * j; const LAS float* s = scr + (8 * c) * 33 + n;
        v4u o; o.x = pk2(s[0 * 33], s[1 * 33]); o.y = pk2(s[2 * 33], s[3 * 33]); o.z = pk2(s[4 * 33], s[5 * 33]); o.w = pk2(s[6 * 33], s[7 * 33]);
        if (n0 + n < N) *(GAS v4u*)(WT + (size_t)(dst_row0 + n) * ldd + k0 + 8 * c) = o; }
    LDS_WAIT(); asm volatile("" ::: "memory");
}
__device__ __forceinline__ void rms_row_bf16(const float* xrow, const float* g, bf16* orow, int lane) {
    const GAS f32x4* xr = (const GAS f32x4*)xrow + lane; const GAS f32x4* gr = (const GAS f32x4*)g + lane;
    f32x4 v[4]; float s = 0.f;
#pragma unroll
    for (int j = 0; j < 4; ++j) { v[j] = xr[64 * j]; s += (v[j].x * v[j].x + v[j].y * v[j].y) + (v[j].z * v[j].z + v[j].w * v[j].w); }
    const float rs = frsq(wave_sum(s) * (1.f / D) + 1e-6f);
    GAS v2u* o8 = (GAS v2u*)orow + lane;
#pragma unroll
    for (int j = 0; j < 4; ++j) { const f32x4 gv = gr[64 * j]; v2u o; o.x = pk2(v[j].x * rs * gv.x, v[j].y * rs * gv.y); o.y = pk2(v[j].z * rs * gv.z, v[j].w * rs * gv.w); o8[64 * j] = o; }
}
__device__ __forceinline__ void rms_row_f32(const float* xrow, const float* g, float* orow, int lane) {
    const GAS f32x4* xr = (const GAS f32x4*)xrow + lane; const GAS f32x4* gr = (const GAS f32x4*)g + lane;
    f32x4 v[4]; float s = 0.f;
#pragma unroll
    for (int j = 0; j < 4; ++j) { v[j] = xr[64 * j]; s += (v[j].x * v[j].x + v[j].y * v[j].y) + (v[j].z * v[j].z + v[j].w * v[j].w); }
    const float rs = frsq(wave_sum(s) * (1.f / D) + 1e-6f);
    GAS f32x4* o = (GAS f32x4*)orow + lane;
#pragma unroll
    for (int j = 0; j < 4; ++j) { const f32x4 gv = gr[64 * j]; o[64 * j] = v[j] * rs * gv; }
}

struct Args { const float* in[36]; float* out; unsigned char* ws; int lo, hi; };
typedef const __attribute__((address_space(4))) Args* ArgP;
#define FRESH_ARGS() ({ ArgP p_ = (ArgP)__builtin_amdgcn_kernarg_segment_ptr(); asm volatile("" : "+s"(p_)); p_; })
#define FRESH_V(x) asm volatile("" : "+v"(x))
#define FRESH_S(x) asm volatile("" : "+s"(x))

#define TR_JOB(items, nblk, Wp, Kd, Nd, DST, LDD, ROW0, MU, S0, S1, GK) if (r < (items)) { const int kb = r / (nblk), nb = r % (nblk), n0 = 32 * nb; tr_item(Wp, Kd, Nd, DST, LDD, ROW0, scr, 64 * kb, n0, lane, MU, S0, S1, GK); continue; } r -= (items);
__device__ __forceinline__ void convert_mixer_weights(ArgP A, int L, LAS unsigned char* lds, int wave, int lane, int gw, int NGW) {
    const int i = L >> 1; const bool even = !(L & 1);
    bf16* Win = (bf16*)(A->ws + WS_WIN); bf16* Wout = (bf16*)(A->ws + WS_WOUT);
    LAS float* scr = (LAS float*)(lds + wave * 16384);
    const float* gmix = A->in[2] + (size_t)L * D;
    const float* w_in = even ? A->in[5] + (size_t)i * D * 3072 : A->in[26] + (size_t)i * D * 3072;
    const float* w_out = even ? A->in[6] + (size_t)i * D * D : A->in[27] + (size_t)i * D * D;
    const float* mu_w = A->in[8] + (size_t)i * 3 * D, *mu_a = mu_w + D, *mu_g = mu_w + 2 * D;
    const float* w1 = A->in[10] + (size_t)i * D * 64, *a1 = A->in[13] + (size_t)i * D * 64, *g1 = A->in[15] + (size_t)i * D * 160, *wa1 = A->in[22] + (size_t)i * D * 16;
    const float* w2s = A->in[11] + (size_t)i * 64 * 512, *a2s = A->in[14] + (size_t)i * 64 * 512, *g2s = A->in[16] + (size_t)i * 160 * 512;
    bf16* W2T = (bf16*)(A->ws + WS_W2T); bf16* A2T = (bf16*)(A->ws + WS_A2T); bf16* G2T = (bf16*)(A->ws + WS_G2T);
    const int I_IN = 16 * 96, I_L64 = 16 * 2, I_L160 = 16 * 5, I_L16 = 16 * 1, I_OUT = 16 * 32;
    const int n_lora = even ? (4 * I_L64 + 2 * I_L160 + I_L16 + 16 + 16 + 48) : 0;
    const int NITEMS = I_IN + n_lora + I_OUT;
    for (int it = gw; it < NITEMS; it += NGW) {
        int r = it;
        TR_JOB(I_IN, 96, w_in, D, 3072, Win, D, n0, nullptr, 1.f, 0.f, gmix)
        if (even) {
            TR_JOB(I_L64, 2, w1, D, 64, Win, D, PC_W1A + n0, mu_w, 1.f, -1.f, gmix)
            TR_JOB(I_L64, 2, w1, D, 64, Win, D, PC_W1B + n0, mu_w, 0.f, 1.f, gmix)
            TR_JOB(I_L64, 2, a1, D, 64, Win, D, PC_A1A + n0, mu_a, 1.f, -1.f, gmix)
            TR_JOB(I_L64, 2, a1, D, 64, Win, D, PC_A1B + n0, mu_a, 0.f, 1.f, gmix)
            TR_JOB(I_L160, 5, g1, D, 160, Win, D, PC_G1A + n0, mu_g, 1.f, -1.f, gmix)
            TR_JOB(I_L160, 5, g1, D, 160, Win, D, PC_G1B + n0, mu_g, 0.f, 1.f, gmix)
            TR_JOB(I_L16, 1, wa1, D, 16, Win, D, PC_WA1 + n0, nullptr, 1.f, 0.f, gmix)
            TR_JOB(16, 16, w2s, 64, 512, W2T, 64, n0, nullptr, 1.f, 0.f, nullptr)
            TR_JOB(16, 16, a2s, 64, 512, A2T, 64, n0, nullptr, 1.f, 0.f, nullptr)
            TR_JOB(48, 16, g2s, 160, 512, G2T, 192, n0, nullptr, 1.f, 0.f, nullptr)
        }
        TR_JOB(I_OUT, 32, w_out, D, D, Wout, D, n0, nullptr, 1.f, 0.f, nullptr)
    }
    if (even) {
        const int gt = gw * 64 + lane, NT = NGW * 64;
        for (int e = gt; e < (NIN_E - PC_PAD) * D / 8; e += NT) ((GAS v4u*)(Win + (size_t)PC_PAD * D))[e] = (v4u){0u, 0u, 0u, 0u};
        bf16* WA2T = (bf16*)(A->ws + WS_WA2T); const float* wa2 = A->in[23] + (size_t)i * 16 * 256;
        for (int e = gt; e < 256 * 32; e += NT) { const int nn = e >> 5, k = e & 31; WA2T[e] = k < 16 ? (bf16)f2bf(wa2[k * 256 + nn]) : (bf16)0; }
    }
}
__device__ __forceinline__ void convert_ffn_weights(ArgP A, int L, LAS unsigned char* lds, int wave, int lane, int gw, int NGW) {
    bf16* Wgu = (bf16*)(A->ws + WS_WGU); bf16* Wdn = (bf16*)(A->ws + WS_WDN);
    LAS float* scr = (LAS float*)(lds + wave * 16384);
    const float* gffn = A->in[3] + (size_t)L * D;
    const float* wg = A->in[33] + (size_t)L * D * FF, *wu = A->in[34] + (size_t)L * D * FF, *wd = A->in[35] + (size_t)L * FF * D;
    const int I_GU = 16 * 88, I_DN = 44 * 32;
    for (int it = gw; it < 2 * I_GU + I_DN; it += NGW) {
        int r = it;
        TR_JOB(I_GU, 88, wg, D, FF, Wgu, D, 256 * (n0 >> 7) + (n0 & 127), nullptr, 1.f, 0.f, gffn)
        TR_JOB(I_GU, 88, wu, D, FF, Wgu, D, 256 * (n0 >> 7) + (n0 & 127) + 128, nullptr, 1.f, 0.f, gffn)
        TR_JOB(I_DN, 32, wd, FF, D, Wdn, FF, n0, nullptr, 1.f, 0.f, nullptr)
    }
}
#undef TR_JOB
__device__ __forceinline__ void x_to_bf16_ssq(const float* xrow, bf16* orow, float* ssq_row, int lane) {
    const GAS f32x4* xr = (const GAS f32x4*)xrow + lane; f32x4 v[4]; float s = 0.f;
#pragma unroll
    for (int j = 0; j < 4; ++j) { v[j] = xr[64 * j]; s += (v[j].x * v[j].x + v[j].y * v[j].y) + (v[j].z * v[j].z + v[j].w * v[j].w); }
    s = wave_sum(s); if (lane < 16) ssq_row[lane] = lane == 0 ? s : 0.f;
    GAS v2u* o8 = (GAS v2u*)orow + lane;
#pragma unroll
    for (int j = 0; j < 4; ++j) { v2u o; o.x = pk2(v[j].x, v[j].y); o.y = pk2(v[j].z, v[j].w); o8[64 * j] = o; }
}

__device__ __forceinline__ void phase_prep(ArgP A, int L, LAS unsigned char* lds, int G, int tid, int bid) {
    const int i = L >> 1;
    const bf16* P = (const bf16*)(A->ws + WS_P); float* LA = (float*)(A->ws + WS_LA);
    const float* wa2 = A->in[23] + (size_t)i * 16 * 256, *ba = A->in[24] + i * 256;
    LAS float* sl = (LAS float*)lds;
    for (int item = bid; item < M / 32; item += G) {
        const int row0 = item * 32;
        { const int tok = tid >> 4, j = tid & 15; sl[j * 32 + tok] = bf2f(P[(size_t)(row0 + tok) * NIN_E + PC_WA1 + j]); }
        __syncthreads();
        const int c = tid;
        if (c < 256) {
            float acc[32];
#pragma unroll
            for (int t = 0; t < 32; ++t) acc[t] = 0.f;
            for (int j = 0; j < 16; ++j) { const float w = wa2[j * 256 + c];
#pragma unroll
                for (int t4 = 0; t4 < 8; ++t4) { const f32x4 x = *(const LAS f32x4*)(sl + j * 32 + 4 * t4); acc[4 * t4] += x.x * w; acc[4 * t4 + 1] += x.y * w; acc[4 * t4 + 2] += x.z * w; acc[4 * t4 + 3] += x.w * w; } }
            const float b0 = ba[c]; float* op = LA + (size_t)row0 * 256 + c;
#pragma unroll
            for (int t = 0; t < 32; ++t) { *op = -softplus_f(-(b0 + acc[t])) * (1.0f / 16.0f); op += 256; FRESH_V(op); }
        }
        __syncthreads();
    }
}

__device__ __noinline__ void rwkv_scan_seq(ArgP A, int L, int b, int h, LAS float* sc, int lane) {
    const int i = L >> 1, c = h * 64 + lane;
    const bf16* P = (const bf16*)(A->ws + WS_P); const float* WLOG = (const float*)(A->ws + WS_WLOG); const float* ASIG = (const float*)(A->ws + WS_ASIG); bf16* OAB = (bf16*)(A->ws + WS_XN);
    const float* mu = A->in[7] + (size_t)i * 1536;
    const float mur = mu[c], muk = mu[512 + c], muv = mu[1024 + c];
    const float kkc = A->in[17][i * 512 + c], kac = A->in[18][i * 512 + c], rkc = A->in[19][i * 512 + c], lnw = A->in[20][i * 512 + c], lnb = A->in[21][i * 512 + c];
    float S[64];
#pragma unroll
    for (int k = 0; k < 64; ++k) S[k] = 0.f;
    float pr_prev = 0.f, pk_prev = 0.f, pv_prev = 0.f;
    const size_t row0 = (size_t)b * T;
    float npr = bf2f(P[row0 * NIN_E + PC_R + c]), npk = bf2f(P[row0 * NIN_E + PC_K + c]), npv = bf2f(P[row0 * NIN_E + PC_V + c]);
    float nwl = WLOG[row0 * 512 + c], nas = ASIG[row0 * 512 + c], ng = bf2f(OAB[row0 * D + c]);
#pragma unroll 1
    for (int t = 0; t < T; ++t) {
        const float pr = npr, pk = npk, pv = npv, wl = nwl, as = nas, g = ng;
        if (t + 1 < T) { const size_t rw = row0 + t + 1; npr = bf2f(P[rw * NIN_E + PC_R + c]); npk = bf2f(P[rw * NIN_E + PC_K + c]); npv = bf2f(P[rw * NIN_E + PC_V + c]);
            nwl = WLOG[rw * 512 + c]; nas = ASIG[rw * 512 + c]; ng = bf2f(OAB[rw * D + c]); }
        const float r = pr + (pr_prev - pr) * mur, k = pk + (pk_prev - pk) * muk, v = pv + (pv_prev - pv) * muv;
        pr_prev = pr; pk_prev = pk; pv_prev = pv;
        float kk = k * kkc; const float n2 = wave_sum(kk * kk); kk = kk * frcp(fmaxf(fsqrt(n2), 1e-12f));
        const float kmod = k * (1.f + (as - 1.f) * kac);
        sc[lane] = -kk; sc[64 + lane] = fexp(wl); sc[128 + lane] = kk * as; sc[192 + lane] = kmod; sc[256 + lane] = r;
        LDS_WAIT(); asm volatile("" ::: "memory");
        float sa = 0.f;
#pragma unroll
        for (int k4 = 0; k4 < 16; ++k4) { const f32x4 a4 = *(const LAS f32x4*)(sc + 4 * k4); sa += S[4 * k4] * a4.x; sa += S[4 * k4 + 1] * a4.y; sa += S[4 * k4 + 2] * a4.z; sa += S[4 * k4 + 3] * a4.w; }
        float y = 0.f;
#pragma unroll
        for (int k4 = 0; k4 < 16; ++k4) {
            const f32x4 w4 = *(const LAS f32x4*)(sc + 64 + 4 * k4), b4 = *(const LAS f32x4*)(sc + 128 + 4 * k4), kq = *(const LAS f32x4*)(sc + 192 + 4 * k4), r4 = *(const LAS f32x4*)(sc + 256 + 4 * k4);
            S[4 * k4] = S[4 * k4] * w4.x + sa * b4.x + v * kq.x; y += S[4 * k4] * r4.x;
            S[4 * k4 + 1] = S[4 * k4 + 1] * w4.y + sa * b4.y + v * kq.y; y += S[4 * k4 + 1] * r4.y;
            S[4 * k4 + 2] = S[4 * k4 + 2] * w4.z + sa * b4.z + v * kq.z; y += S[4 * k4 + 2] * r4.z;
            S[4 * k4 + 3] = S[4 * k4 + 3] * w4.w + sa * b4.w + v * kq.w; y += S[4 * k4 + 3] * r4.w;
        }
        asm volatile("" ::: "memory");
        const float bonus = wave_sum(r * kmod * rkc);
        const float mean = wave_sum(y) * (1.f / 64.f); const float d = y - mean; const float var = wave_sum(d * d) * (1.f / 64.f);
        float o = d * frsq(var + 64e-5f) * lnw + lnb;
        o = (o + bonus * v) * g;
        OAB[(row0 + t) * D + c] = (bf16)f2bf(o);
    }
}
__device__ __noinline__ void gla_scan_half(ArgP A, int b, int h, int half, LAS float* sc, int lane) {
    const bf16* P = (const bf16*)(A->ws + WS_P); const float* LA = (const float*)(A->ws + WS_LA); bf16* OAB = (bf16*)(A->ws + WS_XN);
    float S0[64];
#pragma unroll
    for (int k = 0; k < 64; ++k) S0[k] = 0.f;
    const size_t row0 = (size_t)b * T;
#pragma unroll 1
    for (int t = 0; t < T; ++t) {
        const size_t rw = row0 + t; const bf16* pr = P + rw * NIN_E;
        const float q = bf2f(pr[PC_GQ + h * 64 + lane]) * 0.125f, kx = bf2f(pr[PC_GK + h * 64 + lane]), la = LA[rw * 256 + h * 64 + lane];
        const float v0 = bf2f(pr[PC_GV + h * 128 + half * 64 + lane]);
        sc[lane] = fexp(la); sc[64 + lane] = kx; sc[128 + lane] = q;
        LDS_WAIT(); asm volatile("" ::: "memory");
        float o0 = 0.f;
#pragma unroll
        for (int k4 = 0; k4 < 16; ++k4) {
            const f32x4 a4 = *(const LAS f32x4*)(sc + 4 * k4), k4v = *(const LAS f32x4*)(sc + 64 + 4 * k4), q4 = *(const LAS f32x4*)(sc + 128 + 4 * k4);
            S0[4 * k4] = S0[4 * k4] * a4.x + k4v.x * v0; o0 += q4.x * S0[4 * k4];
            S0[4 * k4 + 1] = S0[4 * k4 + 1] * a4.y + k4v.y * v0; o0 += q4.y * S0[4 * k4 + 1];
            S0[4 * k4 + 2] = S0[4 * k4 + 2] * a4.z + k4v.z * v0; o0 += q4.z * S0[4 * k4 + 2];
            S0[4 * k4 + 3] = S0[4 * k4 + 3] * a4.w + k4v.w * v0; o0 += q4.w * S0[4 * k4 + 3];
        }
        asm volatile("" ::: "memory");
        OAB[rw * D + 512 + h * 128 + half * 64 + lane] = (bf16)f2bf(o0);
    }
}
__device__ __noinline__ void gla_norm_rows(ArgP A, int L, int b, int h, int wave, int lane) {
    const int i = L >> 1;
    const bf16* P = (const bf16*)(A->ws + WS_P); bf16* OAB = (bf16*)(A->ws + WS_XN);
    const float gn0 = A->in[25][i * 512 + h * 128 + 2 * lane], gn1 = A->in[25][i * 512 + h * 128 + 2 * lane + 1];
    for (int t = wave; t < T; t += NWAVES) {
        const size_t rw = (size_t)b * T + t;
        GAS unsigned* op = (GAS unsigned*)(OAB + rw * D + 512 + h * 128 + 2 * lane);
        const unsigned ov = *op, gv = *(const GAS unsigned*)(P + rw * NIN_E + PC_GG + h * 128 + 2 * lane);
        const float o0 = bflo(ov), o1 = bfhi(ov);
        const float rs = frsq(wave_sum(o0 * o0 + o1 * o1) * (1.f / 128.f) + 1e-5f);
        *op = pk2(o0 * rs * gn0 * silu_f(bflo(gv)), o1 * rs * gn1 * silu_f(bfhi(gv)));
    }
}

__device__ __forceinline__ int t5_bucket(int d) {
    if (d < 16) return d;
    const float r = (float)d / 16.0f; int l = 16 + (int)(flog(r) / 2.0794415416798357f * 16.0f);
    return l < 31 ? l : 31;
}
__device__ __noinline__ void attn_row_simple(ArgP A, int L, int b, int h, int t, float lam, float lam_init, LAS float* qs  , LAS float* bd  , int lane) {
    const int i = L >> 1;
    const bf16* QKV = (const bf16*)(A->ws + WS_P); bf16* O = (bf16*)(A->ws + WS_XN);
    const bf16* qrow = QKV + (size_t)(b * T + t) * NIN_O + h * 128;
    qs[lane] = bf2f(qrow[lane]) * 0.125f; qs[64 + lane] = bf2f(qrow[64 + lane]) * 0.125f;
    bd[lane] = A->in[1][t5_bucket(lane) * 8 + h]; bd[64 + lane] = A->in[1][t5_bucket(64 + lane) * 8 + h];
    LDS_WAIT(); asm volatile("" ::: "memory");
    float m1 = -1e30f, m2 = -1e30f, l1 = 0.f, l2 = 0.f, o1a = 0.f, o1b = 0.f, o2a = 0.f, o2b = 0.f;
#pragma unroll 1
    for (int j0 = 0; j0 <= t; j0 += 64) {
        const int j = j0 + lane; const bool valid = j <= t;
        const bf16* krow = QKV + (size_t)(b * T + j) * NIN_O + 1024 + h * 128;
        float s1 = 0.f, s2 = 0.f;
#pragma unroll 2
        for (int c8 = 0; c8 < 8; ++c8) { const v4u kv = *(const GAS v4u*)(krow + 8 * c8); const f32x4 qa = *(const LAS f32x4*)(qs + 8 * c8), qb = *(const LAS f32x4*)(qs + 8 * c8 + 4);
            s1 += qa.x * bflo(kv.x) + qa.y * bfhi(kv.x) + qa.z * bflo(kv.y) + qa.w * bfhi(kv.y) + qb.x * bflo(kv.z) + qb.y * bfhi(kv.z) + qb.z * bflo(kv.w) + qb.w * bfhi(kv.w); }
#pragma unroll 2
        for (int c8 = 0; c8 < 8; ++c8) { const v4u kv = *(const GAS v4u*)(krow + 64 + 8 * c8); const f32x4 qa = *(const LAS f32x4*)(qs + 64 + 8 * c8), qb = *(const LAS f32x4*)(qs + 64 + 8 * c8 + 4);
            s2 += qa.x * bflo(kv.x) + qa.y * bfhi(kv.x) + qa.z * bflo(kv.y) + qa.w * bfhi(kv.y) + qb.x * bflo(kv.z) + qb.y * bfhi(kv.z) + qb.z * bflo(kv.w) + qb.w * bfhi(kv.w); }
        const int dist = valid ? (t - j) : 0; const float bias = bd[dist < 127 ? dist : 127];
        s1 = valid ? s1 + bias : -1e30f; s2 = valid ? s2 + bias : -1e30f;
        const float mn1 = fmaxf(m1, wave_max(s1)), mn2 = fmaxf(m2, wave_max(s2));
        const float c1 = fexp(m1 - mn1), c2 = fexp(m2 - mn2);
        const float p1 = valid ? fexp(s1 - mn1) : 0.f, p2 = valid ? fexp(s2 - mn2) : 0.f;
        l1 = l1 * c1 + wave_sum(p1); l2 = l2 * c2 + wave_sum(p2); m1 = mn1; m2 = mn2;
        o1a *= c1; o1b *= c1; o2a *= c2; o2b *= c2;
        const bf16* vbase = QKV + (size_t)(b * T + j0) * NIN_O + 2048 + h * 128 + 2 * lane;
#pragma unroll 4
        for (int jj = 0; jj < 64; ++jj) {
            const float pj1 = __builtin_bit_cast(float, __builtin_amdgcn_readlane(__builtin_bit_cast(int, p1), jj)), pj2 = __builtin_bit_cast(float, __builtin_amdgcn_readlane(__builtin_bit_cast(int, p2), jj));
            const unsigned vv = *(const GAS unsigned*)(vbase + (size_t)jj * NIN_O); const float v0 = bflo(vv), v1 = bfhi(vv);
            o1a += pj1 * v0; o1b += pj1 * v1; o2a += pj2 * v0; o2b += pj2 * v1;
        }
    }
    const float il1 = frcp(l1), il2 = frcp(l2); float oa = o1a * il1 - lam * (o2a * il2), ob = o1b * il1 - lam * (o2b * il2);
    const float ms = wave_sum(oa * oa + ob * ob) * (1.f / 128.f); const float rs = frsq(ms + 1e-5f);
    const float sc = 1.0f - lam_init; const float* sl = A->in[32] + i * 128;
    oa = oa * rs * sl[2 * lane] * sc; ob = ob * rs * sl[2 * lane + 1] * sc;
    *(GAS unsigned*)(O + (size_t)(b * T + t) * D + h * 128 + 2 * lane) = pk2(oa, ob);
}
typedef short a_bf16x8 __attribute__((ext_vector_type(8)));
typedef float f32x16 __attribute__((ext_vector_type(16)));
typedef short a_s16x4 __attribute__((ext_vector_type(4)));
constexpr int AT_SK = 144, AT_SV = 320, AT_K1 = 0, AT_K2 = 64 * AT_SK, AT_V = 2 * 64 * AT_SK, AT_ST = AT_V + 64 * AT_SV, AT_BIAS = 2 * AT_ST, AT_COMB = 0;
static_assert(AT_BIAS + 132 * 4 <= RING_BYTES && 4 * 64 * 64 * 4 <= AT_BIAS, "attention LDS map");
__device__ __forceinline__ int crow16(int r, int hi) { return (r & 3) + 8 * (r >> 2) + 4 * hi; }
typedef float f32x2_t __attribute__((ext_vector_type(2))); typedef __bf16 bf16x2_t __attribute__((ext_vector_type(2)));
__device__ __forceinline__ unsigned cvtpk(float lo, float hi) { const f32x2_t v = {lo, hi}; const bf16x2_t b = __builtin_convertvector(v, bf16x2_t); return __builtin_bit_cast(unsigned, b); }

__device__ __forceinline__ void attn_unit_mfma(ArgP A, int L, int b, int h, int qb, float lam, float lam_init, LAS unsigned char* lds, int tid) {
    const int lane = tid & 63, wave = __builtin_amdgcn_readfirstlane(tid >> 6), r32 = lane & 31, hi = lane >> 5;
    const int smap = wave >> 2, qs = wave & 3;
    const int i = L >> 1;
    const bf16* QKV = (const bf16*)(A->ws + WS_P); bf16* O = (bf16*)(A->ws + WS_XN);
    const int q0 = qb * 128, qw0 = q0 + 32 * qs, nt = (q0 + 128) / 64;
    const size_t rowb = (size_t)b * T;
    if (tid < 129) { const float far = A->in[1][31 * 8 + h]; ((LAS float*)(lds + AT_BIAS))[tid] = tid < 128 ? (A->in[1][t5_bucket(tid) * 8 + h] - far) * 1.4426950408889634f : 0.f; }
    a_bf16x8 qf[4];
    { const bf16* qrow = QKV + (rowb + qw0 + r32) * NIN_O + h * 128 + smap * 64 + 8 * hi;
#pragma unroll
      for (int ks = 0; ks < 4; ++ks) qf[ks] = *(const GAS a_bf16x8*)(qrow + 16 * ks); }
    const int kr = tid >> 3, kc = tid & 7, vr0 = tid >> 4, vc = tid & 15;
    const bf16* kg = QKV + (rowb + kr) * NIN_O + 1024 + h * 128 + 8 * kc;
    const bf16* vg = QKV + (rowb + vr0) * NIN_O + 2048 + h * 128 + 8 * vc;
    const int kw = kr * AT_SK + kc * 16, vw = vr0 * AT_SV + vc * 16;
    v4u sA[4];
#define AT_LOAD(S, kt) do { const size_t go_ = (size_t)(kt) * 64 * NIN_O; S[0] = *(const GAS v4u*)(kg + go_); S[1] = *(const GAS v4u*)(kg + go_ + 64); S[2] = *(const GAS v4u*)(vg + go_); S[3] = *(const GAS v4u*)(vg + go_ + (size_t)32 * NIN_O); } while (0)
#define AT_STORE(S, st) do { LAS unsigned char* sb_ = lds + (st) * AT_ST; *(LAS v4u*)(sb_ + AT_K1 + kw) = S[0]; *(LAS v4u*)(sb_ + AT_K2 + kw) = S[1]; *(LAS v4u*)(sb_ + AT_V + vw) = S[2]; *(LAS v4u*)(sb_ + AT_V + vw + 32 * AT_SV) = S[3]; } while (0)
    AT_LOAD(sA, 0); AT_STORE(sA, 0);
    __syncthreads();
    f32x16 o[4];
#pragma unroll
    for (int d = 0; d < 4; ++d)
#pragma unroll
        for (int r = 0; r < 16; ++r) o[d][r] = 0.f;
    float m = -1e30f, l = 0.f;
    const int kfo = (smap ? AT_K2 : AT_K1) + r32 * AT_SK + 16 * hi;
    const int vfo = AT_V + (4 * hi + ((lane & 15) >> 2)) * AT_SV + (16 * ((lane >> 4) & 1) + 4 * (lane & 3)) * 2;
    const LAS float* bdl = (const LAS float*)(lds + AT_BIAS);
    const int qme = qw0 + r32;
#pragma unroll 1
    for (int kt = 0; kt < nt; ++kt) {
        if (kt + 1 < nt) AT_LOAD(sA, kt + 1);
        const int key0 = 64 * kt;
        if (key0 <= qw0 + 31) {
            const LAS unsigned char* sb = lds + (kt & 1) * AT_ST;
            f32x16 p[2]; a_bf16x8 kf[8];
#pragma unroll
            for (int f = 0; f < 8; ++f) kf[f] = *(const LAS a_bf16x8*)(sb + kfo + (f >> 2) * 32 * AT_SK + (f & 3) * 32);
            __builtin_amdgcn_sched_barrier(0);
#pragma unroll
            for (int blk = 0; blk < 2; ++blk) {
#pragma unroll
                for (int r = 0; r < 16; ++r) p[blk][r] = 0.f;
#pragma unroll
                for (int ks = 0; ks < 4; ++ks) p[blk] = __builtin_amdgcn_mfma_f32_32x32x16_bf16(kf[blk * 4 + ks], qf[ks], p[blk], 0, 0, 0);
            }
            if (key0 + 63 + 128 > qw0) {
#pragma unroll
                for (int blk = 0; blk < 2; ++blk) { float bvv[16];
#pragma unroll
                    for (int r = 0; r < 16; ++r) { const unsigned ud = (unsigned)(qme - (key0 + 32 * blk + crow16(r, hi))); bvv[r] = bdl[ud < 128u ? ud : 128u]; }
                    asm volatile("" : "+v"(bvv[0]), "+v"(bvv[1]), "+v"(bvv[2]), "+v"(bvv[3]), "+v"(bvv[4]), "+v"(bvv[5]), "+v"(bvv[6]), "+v"(bvv[7]), "+v"(bvv[8]), "+v"(bvv[9]), "+v"(bvv[10]), "+v"(bvv[11]), "+v"(bvv[12]), "+v"(bvv[13]), "+v"(bvv[14]), "+v"(bvv[15]));
#pragma unroll
                    for (int r = 0; r < 16; ++r) { const int dist = qme - (key0 + 32 * blk + crow16(r, hi)); p[blk][r] = dist < 0 ? -1e30f : p[blk][r] + bvv[r]; } }
            }
            float mx = p[0][0];
#pragma unroll
            for (int r = 1; r < 16; ++r) mx = fmaxf(mx, p[0][r]);
#pragma unroll
            for (int r = 0; r < 16; ++r) mx = fmaxf(mx, p[1][r]);
            mx = fmaxf(mx, __shfl_xor(mx, 32));
            if (__any(mx > m + 8.0f)) {
                const float mn = fmaxf(m, mx), al = __builtin_amdgcn_exp2f(m - mn); m = mn; l *= al;
#pragma unroll
                for (int d = 0; d < 4; ++d)
#pragma unroll
                    for (int r = 0; r < 16; ++r) o[d][r] *= al;
            }
            float ls = 0.f; a_bf16x8 pf[4]; a_s16x4 vA[8], vB[8];
#define AT_VREAD(VF, kk) do { _Pragma("unroll") for (int d = 0; d < 4; ++d) { const LAS unsigned char* vp_ = sb + vfo + (kk) * 16 * AT_SV + d * 64; \
                VF[2 * d] = __builtin_bit_cast(a_s16x4, __builtin_amdgcn_ds_read_tr16_b64_v4i16((LAS a_s16x4*)vp_)); VF[2 * d + 1] = __builtin_bit_cast(a_s16x4, __builtin_amdgcn_ds_read_tr16_b64_v4i16((LAS a_s16x4*)(vp_ + 8 * AT_SV))); } } while (0)
#define AT_EXPPK(kk) do { const int blk_ = (kk) >> 1, s8_ = 8 * ((kk) & 1); float e_[8]; _Pragma("unroll") for (int j = 0; j < 8; ++j) { e_[j] = __builtin_amdgcn_exp2f(p[blk_][s8_ + j] - m); ls += e_[j]; } \
                v4u w_; w_.x = cvtpk(e_[0], e_[1]); w_.y = cvtpk(e_[2], e_[3]); w_.z = cvtpk(e_[4], e_[5]); w_.w = cvtpk(e_[6], e_[7]); pf[kk] = __builtin_bit_cast(a_bf16x8, w_); } while (0)
#define AT_PV(VF, kk) do { _Pragma("unroll") for (int d = 0; d < 4; ++d) { const a_bf16x8 vf_ = (a_bf16x8){VF[2 * d][0], VF[2 * d][1], VF[2 * d][2], VF[2 * d][3], VF[2 * d + 1][0], VF[2 * d + 1][1], VF[2 * d + 1][2], VF[2 * d + 1][3]}; \
                o[d] = __builtin_amdgcn_mfma_f32_32x32x16_bf16(vf_, pf[kk], o[d], 0, 0, 0); } } while (0)
            AT_VREAD(vA, 0); AT_EXPPK(0);
            __builtin_amdgcn_sched_barrier(0);
            AT_VREAD(vB, 1); AT_PV(vA, 0); AT_EXPPK(1);
            __builtin_amdgcn_sched_barrier(0);
            AT_VREAD(vA, 2); AT_PV(vB, 1); AT_EXPPK(2);
            __builtin_amdgcn_sched_barrier(0);
            AT_VREAD(vB, 3); AT_PV(vA, 2); AT_EXPPK(3);
            __builtin_amdgcn_sched_barrier(0);
            AT_PV(vB, 3);
            l += ls;
#undef AT_VREAD
#undef AT_EXPPK
#undef AT_PV
        }
        if (kt + 1 < nt) AT_STORE(sA, (kt + 1) & 1);
        __syncthreads();
    }
#undef AT_LOAD
#undef AT_STORE
    l += __shfl_xor(l, 32);
    LAS float* comb = (LAS float*)(lds + AT_COMB) + qs * 4096;
    if (smap == 1) { const float sc = lam * frcp(l);
#pragma unroll
        for (int d = 0; d < 4; ++d)
#pragma unroll
            for (int r = 0; r < 16; ++r) comb[(d * 16 + r) * 64 + lane] = o[d][r] * sc; }
    __syncthreads();
    if (smap == 0) {
        const float il = frcp(l); float ss = 0.f;
#pragma unroll
        for (int d = 0; d < 4; ++d)
#pragma unroll
            for (int r = 0; r < 16; ++r) { const float v = o[d][r] * il - comb[(d * 16 + r) * 64 + lane]; o[d][r] = v; ss += v * v; }
        ss += __shfl_xor(ss, 32);
        const float rs = frsq(ss * (1.f / 128.f) + 1e-5f) * (1.0f - lam_init);
        const float* sl = A->in[32] + i * 128;
        bf16* orow = O + (rowb + qw0 + r32) * D + h * 128;
#pragma unroll
        for (int d = 0; d < 4; ++d)
#pragma unroll
            for (int g4 = 0; g4 < 4; ++g4) { const int dc = 32 * d + 8 * g4 + 4 * hi; const f32x4 s4 = *(const GAS f32x4*)(sl + dc);
                v2u w; w.x = cvtpk(o[d][4 * g4] * rs * s4.x, o[d][4 * g4 + 1] * rs * s4.y); w.y = cvtpk(o[d][4 * g4 + 2] * rs * s4.z, o[d][4 * g4 + 3] * rs * s4.w);
                *(GAS v2u*)(orow + dc) = w; }
    }
    __syncthreads();
}

__device__ __forceinline__ void attn_phase_mfma(ArgP A, int L, LAS unsigned char* lds, int tid, int G, int bid) {
    const int lane = tid & 63, i = L >> 1;
    const float lam_init = 0.8f - 0.6f * fexp(-0.3f * (float)L);
    const float lam = fexp(wave_sum(A->in[28][i * 64 + lane] * A->in[29][i * 64 + lane])) - fexp(wave_sum(A->in[30][i * 64 + lane] * A->in[31][i * 64 + lane])) + lam_init;
    if (G == 256) {
        const int v = (bid & 7) * 32 + (bid >> 3), bh = v >> 2, j = v & 3;
#pragma unroll 1
        for (int u = 0; u < 8; ++u) { const int qb = 8 * (u >> 1) + ((u & 1) ? 7 - j : j); attn_unit_mfma(A, L, bh >> 3, bh & 7, qb, lam, lam_init, lds, tid); }
    } else {
#pragma unroll 1
        for (int u = bid; u < 64 * 32; u += G) attn_unit_mfma(A, L, (u >> 5) >> 3, (u >> 5) & 7, 31 - (u & 31), lam, lam_init, lds, tid);
    }
}
typedef short bf16x8_t __attribute__((ext_vector_type(8)));
constexpr int MS = 72, MB = 64 * MS * 2;
constexpr int RW_XW = 8 * MB, RW_XA = RW_XW + 16384;
constexpr int RW_TOT = 14 * MB, RW_GAM = RW_TOT + 2048, RW_END = RW_GAM + 256;
static_assert(RW_XA + 16384 <= 12 * MB && RW_END <= RING_BYTES, "RWKV LDS map");
constexpr size_t WS_RWI = 336 * MiB;
constexpr size_t WS_BON = 30 * MiB;
#define RBUF(k) ((LAS bf16*)(lds + (k) * MB))
__device__ __forceinline__ f32x4 mfma16(bf16x8_t a, bf16x8_t b, f32x4 c) { return __builtin_amdgcn_mfma_f32_16x16x32_bf16(a, b, c, 0, 0, 0); }
__device__ __forceinline__ bf16x8_t ldfrag(const LAS bf16* Mx, int row0, int k0, int lane) { return *(const LAS bf16x8_t*)(Mx + (row0 + (lane & 15)) * MS + k0 + 8 * (lane >> 4)); }
__device__ __forceinline__ f32x4 mm64(f32x4 acc, const LAS bf16* Am, int ra, const LAS bf16* BTm, int cb, int lane) {
    acc = mfma16(ldfrag(Am, 16 * ra, 0, lane), ldfrag(BTm, 16 * cb, 0, lane), acc);
    return mfma16(ldfrag(Am, 16 * ra, 32, lane), ldfrag(BTm, 16 * cb, 32, lane), acc);
}
__device__ __forceinline__ v2u pack4(f32x4 a) { v2u w; w.x = cvtpk(a[0], a[1]); w.y = cvtpk(a[2], a[3]); return w; }
__device__ __forceinline__ void tstore(LAS bf16* Dm, int rt, int ct, f32x4 acc, int lane) { *(LAS v2u*)(Dm + (16 * ct + (lane & 15)) * MS + 16 * rt + 4 * (lane >> 4)) = pack4(acc); }
__device__ __forceinline__ void tstore_g(bf16* Dg, int rt, int ct, f32x4 acc, int lane) { *(GAS v2u*)(Dg + (16 * ct + (lane & 15)) * 64 + 16 * rt + 4 * (lane >> 4)) = pack4(acc); }
__device__ __forceinline__ f32x4 ld4bf(const LAS bf16* p) { const v2u w = *(const LAS v2u*)p; return (f32x4){bflo(w.x), bfhi(w.x), bflo(w.y), bfhi(w.y)}; }
__device__ __forceinline__ f32x4 ld4bf_g(const bf16* p) { const v2u w = *(const GAS v2u*)p; return (f32x4){bflo(w.x), bfhi(w.x), bflo(w.y), bfhi(w.y)}; }
__device__ __forceinline__ void unpack8(v4u w, float (&f)[8]) { f[0] = bflo(w.x); f[1] = bfhi(w.x); f[2] = bflo(w.y); f[3] = bfhi(w.y); f[4] = bflo(w.z); f[5] = bfhi(w.z); f[6] = bflo(w.w); f[7] = bfhi(w.w); }
__device__ __forceinline__ bf16x8_t pack8(const float (&f)[8]) { v4u w; w.x = cvtpk(f[0], f[1]); w.y = cvtpk(f[2], f[3]); w.z = cvtpk(f[4], f[5]); w.w = cvtpk(f[6], f[7]); return __builtin_bit_cast(bf16x8_t, w); }

__device__ __forceinline__ void rwkv_chunk_item(ArgP A, int L, int b, int n, int h, LAS unsigned char* lds, int tid) {
    const int lane = tid & 63, wave = __builtin_amdgcn_readfirstlane(tid >> 6), i = L >> 1;
    const int l15 = lane & 15, lg = lane >> 4;
    const bf16* P = (const bf16*)(A->ws + WS_P); bf16* XNb = (bf16*)(A->ws + WS_XN);
    const size_t rowb = (size_t)b * T + 64 * n;
    bf16* item = (bf16*)(A->ws + WS_RWI) + ((size_t)((b * 64 + n) * 8 + h)) * 16384;
    {
        const int rt = wave >> 1, ct0 = 2 * (wave & 1);
        const int tt = 16 * rt + l15; const bf16* prow = P + (rowb + tt) * NIN_E; const bool has_prev = (64 * n + tt) > 0;
        const bf16* W2T = (const bf16*)(A->ws + WS_W2T); const bf16* A2T = (const bf16*)(A->ws + WS_A2T); const bf16* G2T = (const bf16*)(A->ws + WS_G2T);
        f32x4 xw[2], xa[2];
#pragma unroll
        for (int c = 0; c < 2; ++c) { xw[c] = (f32x4){0.f, 0.f, 0.f, 0.f}; xa[c] = (f32x4){0.f, 0.f, 0.f, 0.f}; }
#pragma unroll
        for (int k0 = 0; k0 < 64; k0 += 32) {
            const int kc = k0 + 8 * lg; float x[8], y[8], v[8];
            unpack8(*(const GAS v4u*)(prow + PC_W1A + kc), x); if (has_prev) unpack8(*(const GAS v4u*)(prow - NIN_E + PC_W1B + kc), y); else {
#pragma unroll
                for (int e = 0; e < 8; ++e) y[e] = 0.f; }
#pragma unroll
            for (int e = 0; e < 8; ++e) v[e] = tanh_f(x[e] + y[e]);
            const bf16x8_t fw = pack8(v);
            unpack8(*(const GAS v4u*)(prow + PC_A1A + kc), x); if (has_prev) unpack8(*(const GAS v4u*)(prow - NIN_E + PC_A1B + kc), y);
#pragma unroll
            for (int e = 0; e < 8; ++e) v[e] = x[e] + y[e];
            const bf16x8_t fa = pack8(v);
#pragma unroll
            for (int c = 0; c < 2; ++c) { const size_t wo = (size_t)(64 * h + 16 * (ct0 + c) + l15) * 64 + kc;
                xw[c] = mfma16(fw, *(const GAS bf16x8_t*)(W2T + wo), xw[c]); xa[c] = mfma16(fa, *(const GAS bf16x8_t*)(A2T + wo), xa[c]); }
        }
        LAS float* XW = (LAS float*)(lds + RW_XW); LAS float* XA = (LAS float*)(lds + RW_XA);
#pragma unroll
        for (int c = 0; c < 2; ++c)
#pragma unroll
            for (int r = 0; r < 4; ++r) { const int o = (16 * rt + 4 * lg + r) * 64 + 16 * (ct0 + c) + l15; XW[o] = xw[c][r]; XA[o] = xa[c][r]; }
        const int tct = wave >> 1, jt0 = 2 * (wave & 1);
        f32x4 gg[2] = {(f32x4){0.f, 0.f, 0.f, 0.f}, (f32x4){0.f, 0.f, 0.f, 0.f}};
#pragma unroll
        for (int k0 = 0; k0 < 192; k0 += 32) {
            const int kc = k0 + 8 * lg; float x[8], y[8], v[8];
            if (kc < 160) { unpack8(*(const GAS v4u*)(prow + PC_G1A + kc), x); if (has_prev) unpack8(*(const GAS v4u*)(prow - NIN_E + PC_G1B + kc), y); else {
#pragma unroll
                    for (int e = 0; e < 8; ++e) y[e] = 0.f; }
#pragma unroll
                for (int e = 0; e < 8; ++e) v[e] = sigmoid_f(x[e] + y[e]); }
            else {
#pragma unroll
                for (int e = 0; e < 8; ++e) v[e] = 0.f; }
            const bf16x8_t fg = pack8(v);
#pragma unroll
            for (int c = 0; c < 2; ++c) gg[c] = mfma16(*(const GAS bf16x8_t*)(G2T + (size_t)(64 * h + 16 * (jt0 + c) + l15) * 192 + kc), fg, gg[c]);
        }
        (void)tct;
#pragma unroll
        for (int c = 0; c < 2; ++c) *(GAS v2u*)(XNb + (rowb + tt) * D + 64 * h + 16 * (jt0 + c) + 4 * lg) = pack4(gg[c]);
    }
    __syncthreads();
    {
        const int c = 64 * h + lane;
        const float* mu = A->in[7] + (size_t)i * 1536;
        const float mur = mu[c], muk = mu[512 + c], muv = mu[1024 + c];
        const float kkc = A->in[17][i * 512 + c], kac = A->in[18][i * 512 + c], rkc = A->in[19][i * 512 + c], w0c = A->in[9][i * 512 + c], a0c = A->in[12][i * 512 + c];
        const LAS float* XW = (const LAS float*)(lds + RW_XW); const LAS float* XA = (const LAS float*)(lds + RW_XA);
        float* BON = (float*)(A->ws + WS_BON);
        const int tt0 = 8 * wave; const size_t row0 = rowb + tt0;
        float pr_p = 0.f, pk_p = 0.f, pv_p = 0.f;
        if (64 * n + tt0 > 0) { const bf16* pp = P + (row0 - 1) * NIN_E; pr_p = bf2f(pp[PC_R + c]); pk_p = bf2f(pp[PC_K + c]); pv_p = bf2f(pp[PC_V + c]); }
        float rr[8], av[8], bv[8], km[8], vv[8], wl[8], lc[8];
        float run = 0.f;
#pragma unroll
        for (int u = 0; u < 8; ++u) {
            const bf16* pr = P + (row0 + u) * NIN_E; const float pR = bf2f(pr[PC_R + c]), pK = bf2f(pr[PC_K + c]), pV = bf2f(pr[PC_V + c]);
            const float r = pR + (pr_p - pR) * mur, k = pK + (pk_p - pK) * muk, v = pV + (pv_p - pV) * muv; pr_p = pR; pk_p = pK; pv_p = pV;
            const float xw = w0c + XW[(tt0 + u) * 64 + lane], xa = a0c + XA[(tt0 + u) * 64 + lane];
            const float wlog = -fexp(-softplus_f(-xw) - 0.5f), as = sigmoid_f(xa);
            float kk = k * kkc; const float n2 = wave_sum(kk * kk); kk = kk * frcp(fmaxf(fsqrt(n2), 1e-12f));
            const float kmod = k * (1.f + (as - 1.f) * kac);
            const float bon = wave_sum(r * kmod * rkc);
            if (lane == 0) BON[(row0 + u) * 8 + h] = bon;
            run += wlog; rr[u] = r; av[u] = -kk; bv[u] = kk * as; km[u] = kmod; vv[u] = v; wl[u] = wlog; lc[u] = run;
        }
        LAS float* TOT = (LAS float*)(lds + RW_TOT);
        TOT[wave * 64 + lane] = run;
        __syncthreads();
        float off = 0.f, tot = 0.f;
#pragma unroll
        for (int w2 = 0; w2 < 8; ++w2) { const float tv = TOT[w2 * 64 + lane]; tot += tv; if (w2 < wave) off += tv; }
        if (wave == 0) ((LAS float*)(lds + RW_GAM))[lane] = fexp(tot);
        float fR[8], fA[8], fB[8], fK[8];
#pragma unroll
        for (int u = 0; u < 8; ++u) { const float cum = off + lc[u], e1 = fexp(cum), ei = fexp(-cum); fR[u] = rr[u] * e1; fA[u] = av[u] * fexp(cum - wl[u]); fB[u] = bv[u] * ei; fK[u] = km[u] * ei; }
        LAS bf16* At = RBUF(0); LAS bf16* Bt = RBUF(1); LAS bf16* Kt = RBUF(2); LAS bf16* Rt = RBUF(3);
#pragma unroll
        for (int u = 0; u < 8; ++u) { const int o = (tt0 + u) * MS + lane; At[o] = (bf16)f2bf(fA[u]); Bt[o] = (bf16)f2bf(fB[u]); Kt[o] = (bf16)f2bf(fK[u]); Rt[o] = (bf16)f2bf(fR[u]); }
        *(LAS bf16x8_t*)(RBUF(4) + lane * MS + tt0) = pack8(fA); *(LAS bf16x8_t*)(RBUF(5) + lane * MS + tt0) = pack8(fB);
        *(LAS bf16x8_t*)(RBUF(6) + lane * MS + tt0) = pack8(fK); *(LAS bf16x8_t*)(RBUF(7) + lane * MS + tt0) = pack8(vv);
    }
    __syncthreads();
    const int rt = wave >> 1, ct0 = 2 * (wave & 1);
    {
        const LAS bf16* At = RBUF(0); const LAS bf16* Bt = RBUF(1); const LAS bf16* Kt = RBUF(2); const LAS bf16* Rt = RBUF(3);
#pragma unroll
        for (int c = 0; c < 2; ++c) { const int ct = ct0 + c; const f32x4 z = (f32x4){0.f, 0.f, 0.f, 0.f};
            f32x4 aL = mm64(z, Bt, rt, At, ct, lane);
            f32x4 aLT = mm64(z, At, rt, Bt, ct, lane);
            f32x4 aAK = mm64(z, Kt, rt, At, ct, lane);
            f32x4 aRB = mm64(z, Bt, rt, Rt, ct, lane);
            f32x4 aRK = mm64(z, Kt, rt, Rt, ct, lane);
            const int col = 16 * ct + l15;
#pragma unroll
            for (int r = 0; r < 4; ++r) { const int row = 16 * rt + 4 * lg + r;
                if (!(row < col)) { aL[r] = 0.f; aAK[r] = 0.f; }
                if (!(col < row)) aLT[r] = 0.f;
                if (!(row <= col)) { aRB[r] = 0.f; aRK[r] = 0.f; } }
            tstore(RBUF(8), rt, ct, aL, lane); tstore(RBUF(9), rt, ct, aLT, lane); tstore(RBUF(10), rt, ct, aAK, lane); tstore(RBUF(11), rt, ct, aRB, lane); tstore(RBUF(12), rt, ct, aRK, lane);
        }
    }
    __syncthreads();
    {
        for (int e = tid; e < 64 * 16; e += NTHREADS) { const int row = e >> 4, c4 = (e & 15) * 4; v2u w = *(const LAS v2u*)(RBUF(8) + row * MS + c4);
            if ((row >> 2) == (c4 >> 2)) { const unsigned one = 0x3f80u; const int p = row & 3; if (p == 0) w.x = (w.x & 0xffff0000u) | one; else if (p == 1) w.x = (w.x & 0xffffu) | (one << 16); else if (p == 2) w.y = (w.y & 0xffff0000u) | one; else w.y = (w.y & 0xffffu) | (one << 16); }
            *(LAS v2u*)(RBUF(0) + row * MS + c4) = w; }
    }
#define RW_SQUARE(Min, MTin, Mout, MTout) do { _Pragma("unroll") for (int c = 0; c < 2; ++c) { const int ct = ct0 + c; const f32x4 z = (f32x4){0.f, 0.f, 0.f, 0.f}; \
        tstore(RBUF(Mout), rt, ct, mm64(z, RBUF(MTin), rt, RBUF(Min), ct, lane), lane);        \
        tstore(RBUF(MTout), rt, ct, mm64(z, RBUF(Min), rt, RBUF(MTin), ct, lane), lane); } } while (0)
#define RW_YSTEP(Yin, MTin, Yout) do { _Pragma("unroll") for (int c = 0; c < 2; ++c) { const int ct = ct0 + c; \
        const f32x4 y0 = ld4bf(RBUF(Yin) + (16 * ct + l15) * MS + 16 * rt + 4 * lg);            \
        tstore(RBUF(Yout), rt, ct, mm64(y0, RBUF(MTin), rt, RBUF(Yin), ct, lane), lane); } } while (0)
    RW_SQUARE(8, 9, 2, 13);
    __syncthreads();
    RW_YSTEP(0, 13, 1); RW_SQUARE(2, 13, 8, 9);
    __syncthreads();
    RW_YSTEP(1, 9, 0); RW_SQUARE(8, 9, 2, 13);
    __syncthreads();
    RW_YSTEP(0, 13, 1); RW_SQUARE(2, 13, 8, 9);
    __syncthreads();
    RW_YSTEP(1, 9, 0); RW_SQUARE(8, 9, 2, 13);
    __syncthreads();
    RW_YSTEP(0, 13, 1);
    __syncthreads();
#undef RW_SQUARE
#undef RW_YSTEP
    {
#pragma unroll
        for (int c = 0; c < 2; ++c) { const int ct = ct0 + c; const f32x4 z = (f32x4){0.f, 0.f, 0.f, 0.f};
            tstore(RBUF(8), rt, ct, mm64(z, RBUF(1), rt, RBUF(4), ct, lane), lane);
            tstore(RBUF(9), rt, ct, mm64(z, RBUF(10), rt, RBUF(7), ct, lane), lane); }
    }
    __syncthreads();
    {
        const LAS float* GAM = (const LAS float*)(lds + RW_GAM);
#pragma unroll
        for (int c = 0; c < 2; ++c) { const int ct = ct0 + c; const f32x4 z = (f32x4){0.f, 0.f, 0.f, 0.f};
            tstore(RBUF(0), rt, ct, mm64(z, RBUF(1), rt, RBUF(9), ct, lane), lane);
            const f32x4 r0 = ld4bf(RBUF(3) + (16 * ct + l15) * MS + 16 * rt + 4 * lg);
            tstore_g(item, rt, ct, mm64(r0, RBUF(8), rt, RBUF(11), ct, lane), lane);
            f32x4 pp = mm64(z, RBUF(8), rt, RBUF(5), ct, lane);
            const float gm = GAM[16 * ct + l15];
#pragma unroll
            for (int r = 0; r < 4; ++r) pp[r] = gm * (pp[r] + ((16 * rt + 4 * lg + r) == (16 * ct + l15) ? 1.f : 0.f));
            { const int jp = 16 * ct + l15, j0 = 16 * rt + 4 * lg;
              *(GAS v2u*)(item + 8192 + ((((jp >> 5) * 4 + (j0 >> 4)) * 64 + (jp & 31) + 32 * ((j0 >> 2) & 1)) * 8 + 4 * ((j0 >> 3) & 1))) = pack4(pp); } }
    }
    __syncthreads();
    {
        const LAS float* GAM = (const LAS float*)(lds + RW_GAM);
#pragma unroll
        for (int c = 0; c < 2; ++c) { const int ct = ct0 + c; const f32x4 z = (f32x4){0.f, 0.f, 0.f, 0.f};
            f32x4 y0 = mm64(z, RBUF(0), rt, RBUF(11), ct, lane); y0 = mm64(y0, RBUF(7), rt, RBUF(12), ct, lane);
            tstore_g(item + 4096, rt, ct, y0, lane);
            f32x4 q = mm64(z, RBUF(5), rt, RBUF(0), ct, lane); q = mm64(q, RBUF(6), rt, RBUF(7), ct, lane);
            const f32x4 g4 = *(const LAS f32x4*)(GAM + 16 * rt + 4 * lg);
            q = q * g4;
            { const int iv = 16 * ct + l15, j0 = 16 * rt + 4 * lg;
              *(GAS v2u*)(item + 12288 + (((((j0 >> 5) * 2 + (iv >> 5)) * 4 + ((j0 >> 3) & 3)) * 64 + (iv & 31) + 32 * ((j0 >> 2) & 1)) * 4)) = pack4(q); } }
    }
    __syncthreads();
}

__device__ __forceinline__ void rwkv_state_scan(ArgP A, int b, int h, int lane, bool do_store = true) {
    const int r32 = lane & 31, hi = lane >> 5;
    f32x16 St[2][2];
#pragma unroll
    for (int kb = 0; kb < 2; ++kb)
#pragma unroll
        for (int vb = 0; vb < 2; ++vb)
#pragma unroll
            for (int r = 0; r < 16; ++r) St[kb][vb][r] = 0.f;
    bf16* item0 = (bf16*)(A->ws + WS_RWI) + ((size_t)((b * 64) * 8 + h)) * 16384;
    v4u pfn[8]; v2u qn[16];
#define RW2_LOAD(nn) do { const bf16* it_ = item0 + (size_t)(nn) * 8 * 16384; \
        _Pragma("unroll") for (int f = 0; f < 8; ++f) pfn[f] = *(const GAS v4u*)(it_ + 8192 + (f * 64 + lane) * 8); \
        _Pragma("unroll") for (int f = 0; f < 16; ++f) qn[f] = *(const GAS v2u*)(it_ + 12288 + (f * 64 + lane) * 4); } while (0)
    RW2_LOAD(0);
#pragma unroll 1
    for (int n = 0; n < 64; ++n) {
        bf16* PM = item0 + (size_t)n * 8 * 16384 + 8192;
        a_bf16x8 pf[2][4]; f32x16 Nw[2][2];
#pragma unroll
        for (int f = 0; f < 8; ++f) pf[f >> 2][f & 3] = __builtin_bit_cast(a_bf16x8, pfn[f]);
#pragma unroll
        for (int kb = 0; kb < 2; ++kb)
#pragma unroll
            for (int vb = 0; vb < 2; ++vb)
#pragma unroll
                for (int g = 0; g < 4; ++g) { const v2u w = qn[(kb * 2 + vb) * 4 + g]; Nw[kb][vb][4 * g] = bflo(w.x); Nw[kb][vb][4 * g + 1] = bfhi(w.x); Nw[kb][vb][4 * g + 2] = bflo(w.y); Nw[kb][vb][4 * g + 3] = bfhi(w.y); }
#pragma unroll
        for (int kb = 0; kb < 2; ++kb)
#pragma unroll
            for (int vb = 0; vb < 2; ++vb)
#pragma unroll
                for (int g = 0; g < 4; ++g) { v2u w; w.x = cvtpk(St[kb][vb][4 * g], St[kb][vb][4 * g + 1]); w.y = cvtpk(St[kb][vb][4 * g + 2], St[kb][vb][4 * g + 3]);
                    if (do_store) *(GAS v2u*)(PM + ((((2 * vb + (r32 >> 4)) * 2 + kb) * 64 + g * 16 + (r32 & 15)) * 8 + 4 * hi)) = w; }
        if (n + 1 < 64) RW2_LOAD(n + 1);
        a_bf16x8 sf[4][2];
#pragma unroll
        for (int ks = 0; ks < 4; ++ks)
#pragma unroll
            for (int vb = 0; vb < 2; ++vb) { const int kb = ks >> 1, s8 = 8 * (ks & 1); v4u w; w.x = cvtpk(St[kb][vb][s8], St[kb][vb][s8 + 1]); w.y = cvtpk(St[kb][vb][s8 + 2], St[kb][vb][s8 + 3]);
                w.z = cvtpk(St[kb][vb][s8 + 4], St[kb][vb][s8 + 5]); w.w = cvtpk(St[kb][vb][s8 + 6], St[kb][vb][s8 + 7]); sf[ks][vb] = __builtin_bit_cast(a_bf16x8, w); }
#pragma unroll
        for (int kb = 0; kb < 2; ++kb)
#pragma unroll
            for (int vb = 0; vb < 2; ++vb) {
#pragma unroll
                for (int ks = 0; ks < 4; ++ks) Nw[kb][vb] = __builtin_amdgcn_mfma_f32_32x32x16_bf16(pf[kb][ks], sf[ks][vb], Nw[kb][vb], 0, 0, 0);
            }
#pragma unroll
        for (int kb = 0; kb < 2; ++kb)
#pragma unroll
            for (int vb = 0; vb < 2; ++vb) St[kb][vb] = Nw[kb][vb];
    }
#undef RW2_LOAD
}

__device__ __forceinline__ void rwkv_out_item(ArgP A, int L, int b, int n, int h, int ct, int lane, bool do_store = true) {
    const int i = L >> 1, l15 = lane & 15, lg = lane >> 4;
    const bf16* P = (const bf16*)(A->ws + WS_P); bf16* XNb = (bf16*)(A->ws + WS_XN); const float* BON = (const float*)(A->ws + WS_BON);
    const bf16* item = (const bf16*)(A->ws + WS_RWI) + ((size_t)((b * 64 + n) * 8 + h)) * 16384;
    const bf16* RH = item; const bf16* Y0 = item + 4096; const bf16* ST = item + 8192;
    const size_t row = (size_t)b * T + 64 * n + 16 * ct + l15; const int tseq = 64 * n + 16 * ct + l15;
    const bf16x8_t rf0 = *(const GAS bf16x8_t*)(RH + (16 * ct + l15) * 64 + 8 * lg), rf1 = *(const GAS bf16x8_t*)(RH + (16 * ct + l15) * 64 + 32 + 8 * lg);
    f32x4 acc[4]; float s1 = 0.f;
#pragma unroll
    for (int it = 0; it < 4; ++it) {
        f32x4 a = ld4bf_g(Y0 + (16 * ct + l15) * 64 + 16 * it + 4 * lg);
        a = mfma16(*(const GAS bf16x8_t*)(ST + ((it * 2 + 0) * 64 + lane) * 8), rf0, a);
        a = mfma16(*(const GAS bf16x8_t*)(ST + ((it * 2 + 1) * 64 + lane) * 8), rf1, a);
        acc[it] = a; s1 += (a[0] + a[1]) + (a[2] + a[3]);
    }
    s1 += __shfl_xor(s1, 16); s1 += __shfl_xor(s1, 32);
    const float mean = s1 * (1.f / 64.f); float s2 = 0.f;
#pragma unroll
    for (int it = 0; it < 4; ++it) { acc[it] = acc[it] - mean; s2 += (acc[it][0] * acc[it][0] + acc[it][1] * acc[it][1]) + (acc[it][2] * acc[it][2] + acc[it][3] * acc[it][3]); }
    s2 += __shfl_xor(s2, 16); s2 += __shfl_xor(s2, 32);
    const float rs = frsq(s2 * (1.f / 64.f) + 64e-5f);
    const float bon = BON[row * 8 + h];
    const float* lnw = A->in[20] + i * 512 + 64 * h; const float* lnb = A->in[21] + i * 512 + 64 * h; const float* mu = A->in[7] + (size_t)i * 1536 + 1024 + 64 * h;
    const bf16* pr = P + row * NIN_E + PC_V + 64 * h;
#pragma unroll
    for (int it = 0; it < 4; ++it) { const int i0 = 16 * it + 4 * lg;
        const f32x4 w4 = *(const GAS f32x4*)(lnw + i0), b4 = *(const GAS f32x4*)(lnb + i0), m4 = *(const GAS f32x4*)(mu + i0);
        const f32x4 pv = ld4bf_g(pr + i0); const f32x4 pvp = tseq > 0 ? ld4bf_g(pr - NIN_E + i0) : (f32x4){0.f, 0.f, 0.f, 0.f};
        const f32x4 v4 = pv + (pvp - pv) * m4;
        bf16* gp = XNb + row * D + 64 * h + i0; const f32x4 g4 = ld4bf_g(gp);
        const f32x4 o = ((acc[it] * rs) * w4 + b4 + v4 * bon) * g4;
        if (do_store) *(GAS v2u*)gp = pack4(o); }
}
constexpr size_t WS_GKV = 464 * MiB;
constexpr size_t WS_GDEC = 29 * MiB + 512 * 1024;
constexpr int GL_LA = 0, GL_KR = 16384, GL_VT = GL_KR + MB, GL_TOT = GL_VT + 2 * MB, GL1_END = GL_TOT + 2048;
constexpr int G3_LA = 0, G3_QD = 16384, G3_KD = G3_QD + MB, G3_VT = G3_KD + MB, G3_SC = G3_VT + 2 * MB, G3_TOT = G3_SC + MB, G3_GRP = G3_TOT + 1024;
static_assert(2 * G3_GRP <= RING_BYTES && GL1_END <= RING_BYTES, "GLA LDS map");

template <int NCT> __device__ __forceinline__ void gla_lora_tiles(ArgP A, size_t rowb, int h4, int rt, int ct0, LAS float* LAs, int lane) {
    const int l15 = lane & 15, lg = lane >> 4;
    const bf16* P = (const bf16*)(A->ws + WS_P); const bf16* WA2T = (const bf16*)(A->ws + WS_WA2T);
    v4u av = (v4u){0u, 0u, 0u, 0u};
    if (lg < 2) av = *(const GAS v4u*)(P + (rowb + 16 * rt + l15) * NIN_E + PC_WA1 + 8 * lg);
    const bf16x8_t af = __builtin_bit_cast(bf16x8_t, av);
#pragma unroll
    for (int c = 0; c < NCT; ++c) { const int ct = ct0 + c;
        const f32x4 x = mfma16(af, *(const GAS bf16x8_t*)(WA2T + (size_t)(64 * h4 + 16 * ct + l15) * 32 + 8 * lg), (f32x4){0.f, 0.f, 0.f, 0.f});
#pragma unroll
        for (int r = 0; r < 4; ++r) LAs[(16 * rt + 4 * lg + r) * 64 + 16 * ct + l15] = x[r]; }
}

__device__ __forceinline__ void gla_kv_item(ArgP A, int L, int b, int n, int h4, LAS unsigned char* lds, int tid) {
    const int lane = tid & 63, wave = __builtin_amdgcn_readfirstlane(tid >> 6), i = L >> 1, l15 = lane & 15, lg = lane >> 4;
    const bf16* P = (const bf16*)(A->ws + WS_P);
    const size_t rowb = (size_t)b * T + 64 * n; const int itemi = (b * 64 + n) * 4 + h4;
    LAS float* LAs = (LAS float*)(lds + GL_LA); LAS bf16* KrT = (LAS bf16*)(lds + GL_KR); LAS bf16* VTm = (LAS bf16*)(lds + GL_VT); LAS float* TOT = (LAS float*)(lds + GL_TOT);
    gla_lora_tiles<2>(A, rowb, h4, wave >> 1, 2 * (wave & 1), LAs, lane);
    __syncthreads();
    {
        const int c = 64 * h4 + lane, tt0 = 8 * wave; const float bac = A->in[24][i * 256 + c];
        float lc[8], kx[8], v0[8], v1[8]; float run = 0.f;
#pragma unroll
        for (int u = 0; u < 8; ++u) { const bf16* pr = P + (rowb + tt0 + u) * NIN_E; const float x = bac + LAs[(tt0 + u) * 64 + lane];
            run += -softplus_f(-x) * (1.0f / 16.0f); lc[u] = run; kx[u] = bf2f(pr[PC_GK + c]); v0[u] = bf2f(pr[PC_GV + 128 * h4 + lane]); v1[u] = bf2f(pr[PC_GV + 128 * h4 + 64 + lane]); }
        TOT[wave * 64 + lane] = run;
        __syncthreads();
        float off = 0.f, tot = 0.f;
#pragma unroll
        for (int w2 = 0; w2 < 8; ++w2) { const float tv = TOT[w2 * 64 + lane]; tot += tv; if (w2 < wave) off += tv; }
        if (wave == 0) ((float*)(A->ws + WS_GDEC))[itemi * 64 + lane] = fexp(tot);
#pragma unroll
        for (int u = 0; u < 8; ++u) kx[u] *= fexp(tot - (off + lc[u]));
        *(LAS bf16x8_t*)(KrT + lane * MS + tt0) = pack8(kx); *(LAS bf16x8_t*)(VTm + lane * MS + tt0) = pack8(v0); *(LAS bf16x8_t*)(VTm + (64 + lane) * MS + tt0) = pack8(v1);
    }
    __syncthreads();
    {
        bf16* KVg = (bf16*)(A->ws + WS_GKV) + (size_t)itemi * 8192; const int rt = wave >> 1;
#pragma unroll
        for (int c = 0; c < 4; ++c) { const int et = 4 * (wave & 1) + c;
            const f32x4 acc = mm64((f32x4){0.f, 0.f, 0.f, 0.f}, KrT, rt, VTm, et, lane);
            *(GAS v2u*)(KVg + (16 * et + l15) * 64 + 16 * rt + 4 * lg) = pack4(acc); }
    }
    __syncthreads();
}

__device__ __forceinline__ void gla_state_scan(ArgP A, int gt, bool do_store = true) {
    const int bh = gt >> 11, grp = gt & 2047;
    const int b = bh >> 2, h4 = bh & 3;
    bf16* base = (bf16*)(A->ws + WS_GKV) + (size_t)((b * 64) * 4 + h4) * 8192 + (size_t)grp * 4;
    const float* dec = (const float*)(A->ws + WS_GDEC) + (size_t)((b * 64) * 4 + h4) * 64 + (grp & 15) * 4;
    f32x4 S = (f32x4){0.f, 0.f, 0.f, 0.f};
#pragma unroll 1
    for (int n0 = 0; n0 < 64; n0 += 8) {
        v2u kv[8]; f32x4 dc[8];
#pragma unroll
        for (int u = 0; u < 8; ++u) { kv[u] = *(const GAS v2u*)(base + (size_t)(n0 + u) * 4 * 8192); dc[u] = *(const GAS f32x4*)(dec + (size_t)(n0 + u) * 4 * 64); }
#pragma unroll
        for (int u = 0; u < 8; ++u) { if (do_store) *(GAS v2u*)(base + (size_t)(n0 + u) * 4 * 8192) = pack4(S);
            S = S * dc[u] + (f32x4){bflo(kv[u].x), bfhi(kv[u].x), bflo(kv[u].y), bfhi(kv[u].y)}; }
    }
}

__device__ __forceinline__ void gla_out_group(ArgP A, int L, int item2, LAS unsigned char* lds, int tid) {
    const int lane = tid & 63, wave = __builtin_amdgcn_readfirstlane(tid >> 6), i = L >> 1, l15 = lane & 15, lg = lane >> 4;
    const int gi = wave >> 2, wq = wave & 3;
    const int itemi = 2 * item2 + gi, h4 = itemi & 3, n = (itemi >> 2) & 63, b = itemi >> 8;
    const bf16* P = (const bf16*)(A->ws + WS_P); bf16* XNb = (bf16*)(A->ws + WS_XN);
    const size_t rowb = (size_t)b * T + 64 * n;
    LAS unsigned char* gb = lds + gi * G3_GRP;
    LAS float* LAs = (LAS float*)(gb + G3_LA); LAS bf16* Qd = (LAS bf16*)(gb + G3_QD); LAS bf16* Kd = (LAS bf16*)(gb + G3_KD); LAS bf16* VTm = (LAS bf16*)(gb + G3_VT); LAS bf16* SC = (LAS bf16*)(gb + G3_SC);
    LAS float* TOT = (LAS float*)(gb + G3_TOT);
    gla_lora_tiles<4>(A, rowb, h4, wq, 0, LAs, lane);
    __syncthreads();
    {
        const int c = 64 * h4 + lane, tt0 = 16 * wq; const float bac = A->in[24][i * 256 + c];
        float lc[16], qx[16], kx[16]; float run = 0.f;
#pragma unroll
        for (int u = 0; u < 16; ++u) { const bf16* pr = P + (rowb + tt0 + u) * NIN_E; const float x = bac + LAs[(tt0 + u) * 64 + lane];
            run += -softplus_f(-x) * (1.0f / 16.0f); lc[u] = run; qx[u] = bf2f(pr[PC_GQ + c]) * 0.125f; kx[u] = bf2f(pr[PC_GK + c]); }
        TOT[wq * 64 + lane] = run;
        __syncthreads();
        float off = 0.f;
#pragma unroll
        for (int w2 = 0; w2 < 4; ++w2) { const float tv = TOT[w2 * 64 + lane]; if (w2 < wq) off += tv; }
#pragma unroll
        for (int u = 0; u < 16; ++u) { const float cum = off + lc[u]; Qd[(tt0 + u) * MS + lane] = (bf16)f2bf(qx[u] * fexp(cum)); Kd[(tt0 + u) * MS + lane] = (bf16)f2bf(kx[u] * fexp(-cum)); }
#pragma unroll
        for (int hf = 0; hf < 2; ++hf) { float v0[8], v1[8];
#pragma unroll
            for (int u = 0; u < 8; ++u) { const bf16* pr = P + (rowb + tt0 + 8 * hf + u) * NIN_E + PC_GV + 128 * h4; v0[u] = bf2f(pr[lane]); v1[u] = bf2f(pr[64 + lane]); }
            *(LAS bf16x8_t*)(VTm + lane * MS + tt0 + 8 * hf) = pack8(v0); *(LAS bf16x8_t*)(VTm + (64 + lane) * MS + tt0 + 8 * hf) = pack8(v1); }
    }
    __syncthreads();
    const int ct = wq; const int col = 16 * ct + l15;
#pragma unroll
    for (int rt = 0; rt < 4; ++rt) { f32x4 acc = (f32x4){0.f, 0.f, 0.f, 0.f};
        if (rt <= ct) { acc = mm64(acc, Kd, rt, Qd, ct, lane);
#pragma unroll
            for (int r = 0; r < 4; ++r) if (!((16 * rt + 4 * lg + r) <= col)) acc[r] = 0.f; }
        tstore(SC, rt, ct, acc, lane); }
    LDS_WAIT(); asm volatile("" ::: "memory");
    const bf16* Sg = (const bf16*)(A->ws + WS_GKV) + (size_t)itemi * 8192;
    f32x4 o[8]; float ss = 0.f;
#pragma unroll
    for (int et = 0; et < 8; ++et) { f32x4 acc = mm64((f32x4){0.f, 0.f, 0.f, 0.f}, VTm, et, SC, ct, lane);
        acc = mfma16(*(const GAS bf16x8_t*)(Sg + (16 * et + l15) * 64 + 8 * lg), ldfrag(Qd, 16 * ct, 0, lane), acc);
        acc = mfma16(*(const GAS bf16x8_t*)(Sg + (16 * et + l15) * 64 + 32 + 8 * lg), ldfrag(Qd, 16 * ct, 32, lane), acc);
        o[et] = acc; ss += (acc[0] * acc[0] + acc[1] * acc[1]) + (acc[2] * acc[2] + acc[3] * acc[3]); }
    ss += __shfl_xor(ss, 16); ss += __shfl_xor(ss, 32);
    const float rs = frsq(ss * (1.f / 128.f) + 1e-5f);
    const size_t row = rowb + col; const float* gn = A->in[25] + i * 512 + 128 * h4;
#pragma unroll
    for (int et = 0; et < 8; ++et) { const int e0 = 16 * et + 4 * lg; const f32x4 g4 = *(const GAS f32x4*)(gn + e0); const f32x4 gg = ld4bf_g(P + row * NIN_E + PC_GG + 128 * h4 + e0);
        f32x4 v = o[et] * rs * g4; v[0] *= silu_f(gg[0]); v[1] *= silu_f(gg[1]); v[2] *= silu_f(gg[2]); v[3] *= silu_f(gg[3]);
        *(GAS v2u*)(XNb + row * D + 512 + 128 * h4 + e0) = pack4(v); }
    __syncthreads();
}
constexpr int N_STEPS = 37;
#ifndef MK_ONE_LAUNCH
#define MK_ONE_LAUNCH 1
#endif
__global__ void __launch_bounds__(NTHREADS, 2) hybrid_fwd(Args args) {
    extern __shared__ __attribute__((aligned(16))) unsigned char lds_raw[];
    LAS unsigned char* lds = (LAS unsigned char*)lds_raw;
    ArgP A0 = (ArgP)__builtin_amdgcn_kernarg_segment_ptr();
    { const int tid = threadIdx.x; for (int u = tid; u < (LDS_BYTES - LDSCTL_OFF) / 4; u += NTHREADS) ((LAS unsigned*)(lds + LDSCTL_OFF))[u] = 0u; }
    __syncthreads();
    const int lo = A0->lo, hi = A0->hi;
    if (hi - lo > 1) (void)xcd_barrier_post((unsigned*)(A0->ws + WS_CTL) + CW_BAR, (volatile LAS unsigned*)(lds + MISC_OFF) + 8);
#ifndef PHM
#define PHM 0xff
#endif
#define RUN(s) (lo <= (s) && (s) < hi)
#define EN(b) ((PHM >> (b)) & 1)
#ifndef PROBE_REP
#define PROBE_REP 0
#endif
#define REP(b) _Pragma("unroll 1") for (int rep_ = 0; rep_ < (((PROBE_REP >> (b)) & 1) ? 2 : 1); ++rep_)
#define GRID_BARRIER() do { ArgP Ab_ = FRESH_ARGS(); XcdBarrier b_; b_.bar = (unsigned*)(Ab_->ws + WS_CTL) + CW_BAR; b_.x = xb_xcc_id(); b_.st = (volatile LAS unsigned*)(lds + MISC_OFF) + 8; xcd_barrier(b_); } while (0)
#define SEAM(s) do { if (RUN(s) && RUN((s) + 1)) GRID_BARRIER(); } while (0)
#define PHASE_VARS() ArgP A = FRESH_ARGS(); int L = Lq; FRESH_S(L); int tid = threadIdx.x; FRESH_V(tid); const int lane = tid & 63, wave = __builtin_amdgcn_readfirstlane(tid >> 6); int G = gridDim.x, bid = blockIdx.x; FRESH_S(G); FRESH_S(bid); (void)lane; (void)wave; (void)G; (void)A; (void)bid; \
    bf16* XN = (bf16*)(A->ws + WS_XN); bf16* PB = (bf16*)(A->ws + WS_P); (void)XN; (void)PB

#define BAR2(a, b) do { if (RUN(a) && RUN(b)) GRID_BARRIER(); } while (0)
    if (EN(0) && RUN(0)) REP(0) { int Lq = 0; PHASE_VARS(); const int gw = bid * NWAVES + wave, NGW = G * NWAVES;
        convert_mixer_weights(A, 0, lds, wave, lane, gw, NGW);
        float* ssq0 = (float*)(A->ws + WS_SSQ);
        for (int m = gw; m < M; m += NGW) x_to_bf16_ssq(A->in[0] + (size_t)m * D, (bf16*)A->out + (size_t)m * D, ssq0 + (size_t)m * 16, lane); }
    BAR2(0, 1);
    for (int Lq = 0; Lq < 4; ++Lq) {
        const int s0 = 9 * Lq; const bool even = !(Lq & 1);
        if (EN(1) && RUN(s0 + 1)) REP(1) {
            PHASE_VARS(); bf16* Win = (bf16*)(A->ws + WS_WIN); const float* ssq = (const float*)(A->ws + WS_SSQ);
            if (even) {
                pg8::Gemm g{(bf16*)A->out, Win, M, NIN_E, D}; pg8::StaticOrderC<M, NIN_E> S; S.init(G, bid);
                pg8::fill_row_scales(S, ssq, (LAS float*)(lds + RSTAB_OFF), tid);
                pg8::EpiStoreBf16 E{PB, NIN_E, 0, 1.0f, (const LAS float*)(lds + RSTAB_OFF)};
                pg8::gemm_phase<pg8::EpiStoreBf16, pg8::StaticOrderC<M, NIN_E>, PG8_ALIGN, PG8_SP2>(lds, g, S, E);
            } else {
                pg8::Gemm g{(bf16*)A->out, Win, M, NIN_O, D}; pg8::StaticOrderC<M, NIN_O> S; S.init(G, bid);
                pg8::fill_row_scales(S, ssq, (LAS float*)(lds + RSTAB_OFF), tid);
                pg8::EpiStoreBf16 E{PB, NIN_O, 4, 0.125f * 1.4426950408889634f, (const LAS float*)(lds + RSTAB_OFF)};
                pg8::gemm_phase<pg8::EpiStoreBf16, pg8::StaticOrderC<M, NIN_O>, PG8_ALIGN, PG8_SP2>(lds, g, S, E);
            }
        }
        if (even) {
            BAR2(s0 + 1, s0 + 2);
            if (EN(2) && RUN(s0 + 2)) REP(2) { PHASE_VARS();
#pragma unroll 1
                for (int it = bid; it < BATCH * 64 * 8; it += G) rwkv_chunk_item(A, L, it >> 9, (it >> 3) & 63, it & 7, lds, tid);
                REP(8) {
#pragma unroll 1
                for (int it = bid; it < BATCH * 64 * 4; it += G) gla_kv_item(A, L, it >> 8, (it >> 2) & 63, it & 3, lds, tid); } }
            BAR2(s0 + 2, s0 + 3);
            if (EN(3) && RUN(s0 + 3)) {
                PHASE_VARS();
                if (bid < 64) { if (wave == 0) rwkv_state_scan(A, bid >> 3, bid & 7, lane); }
                else { for (int gt = (bid - 64) * NTHREADS + tid; gt < 32 * 2048; gt += (G - 64) * NTHREADS) gla_state_scan(A, gt);
                       convert_ffn_weights(A, L, lds, wave, lane, (bid - 64) * NWAVES + wave, (G - 64) * NWAVES); }
            }
            BAR2(s0 + 3, s0 + 4);
            if (EN(3) && RUN(s0 + 4)) {
                PHASE_VARS();
                REP(9) {
#pragma unroll 1
                for (int i2 = bid; i2 < BATCH * 64 * 4 / 2; i2 += G) gla_out_group(A, L, i2, lds, tid); }
#pragma unroll 1
                for (int wt = bid * NWAVES + wave; wt < BATCH * 64 * 8 * 4; wt += G * NWAVES) { const int it = wt >> 2; rwkv_out_item(A, L, it >> 9, (it >> 3) & 63, it & 7, wt & 3, lane); }
            }
            BAR2(s0 + 4, s0 + 5);
        } else {
            BAR2(s0 + 1, s0 + 3);
            if (EN(4) && RUN(s0 + 3)) REP(4) { PHASE_VARS(); attn_phase_mfma(A, L, lds, tid, G, bid); convert_ffn_weights(A, L, lds, wave, lane, bid * NWAVES + wave, G * NWAVES); }
            BAR2(s0 + 3, s0 + 5);
        }
        if (EN(5) && RUN(s0 + 5)) {
            PHASE_VARS(); bf16* Wout = (bf16*)(A->ws + WS_WOUT);
            pg8::Gemm g{XN, Wout, M, D, D}; pg8::StaticOrderC<M, D> S; S.init(G, bid);
            pg8::EpiResBf16<false> E{(bf16*)A->out, D, (float*)(A->ws + WS_SSQ) + (size_t)M * 16, nullptr};
            pg8::gemm_phase<pg8::EpiResBf16<false>, pg8::StaticOrderC<M, D>, PG8_ALIGN, PG8_SP2>(lds, g, S, E);
        }
        BAR2(s0 + 5, s0 + 7);
        if (EN(6) && RUN(s0 + 7)) REP(6) {
            PHASE_VARS(); bf16* Wgu = (bf16*)(A->ws + WS_WGU);
            pg8::Gemm g{(bf16*)A->out, Wgu, M, NGU, D}; pg8::StaticOrderC<M, NGU> S; S.init(G, bid);
            pg8::fill_row_scales(S, (const float*)(A->ws + WS_SSQ) + (size_t)M * 16, (LAS float*)(lds + RSTAB_OFF), tid);
            pg8::EpiSwiglu E{PB, FF, (const LAS float*)(lds + RSTAB_OFF)};
            pg8::gemm_phase<pg8::EpiSwiglu, pg8::StaticOrderC<M, NGU>, PG8_ALIGN, PG8_SP2>(lds, g, S, E);
        }
        BAR2(s0 + 7, s0 + 8);
        if (EN(7) && RUN(s0 + 8)) {
            PHASE_VARS(); bf16* Wdn = (bf16*)(A->ws + WS_WDN);
            pg8::Gemm g{PB, Wdn, M, D, FF}; pg8::StaticOrderC<M, D> S; S.init(G, bid);
            if (L < 3) { pg8::EpiResBf16<false> E{(bf16*)A->out, D, (float*)(A->ws + WS_SSQ), nullptr};
                pg8::gemm_phase<pg8::EpiResBf16<false>, pg8::StaticOrderC<M, D>, PG8_ALIGN, PG8_SP2>(lds, g, S, E);
                convert_mixer_weights(A, L + 1, lds, wave, lane, bid * NWAVES + wave, G * NWAVES); }
            else { pg8::EpiResBf16<true> E{(bf16*)A->out, D, (float*)(A->ws + WS_SSQ), (float*)(A->ws + WS_XFIN)};
                pg8::gemm_phase<pg8::EpiResBf16<true>, pg8::StaticOrderC<M, D>, PG8_ALIGN, PG8_SP2>(lds, g, S, E); }
        }
        BAR2(s0 + 8, Lq < 3 ? s0 + 10 : 36);
    }
    if (RUN(36)) {
        int Lq = 0; PHASE_VARS();
        const int gw = bid * NWAVES + wave, NGW = G * NWAVES;
        for (int m = gw; m < M; m += NGW) rms_row_f32((const float*)(A->ws + WS_XFIN) + (size_t)m * D, A->in[4], A->out + (size_t)m * D, lane);
    }
#undef RUN
#undef SEAM
}

extern "C" void kernel_launch(void* const* d_in, const int* in_sizes, int n_in, void* d_out, int out_size, void* d_ws, size_t ws_size, hipStream_t stream) {
    static int grid = 0;
    if (grid == 0) {
        if (n_in != 36 || in_sizes[0] != M * D || out_size != M * D || ws_size < WS_END) { fprintf(stderr, "kernel_launch: unexpected shapes (n_in %d, in0 %d, out %d, ws %zu); nothing launched\n", n_in, n_in > 0 ? in_sizes[0] : -1, out_size, ws_size); grid = -1; return; }
        int dev = 0, cus = 0, per_cu = 0;
        if (hipGetDevice(&dev) != hipSuccess || hipDeviceGetAttribute(&cus, hipDeviceAttributeMultiprocessorCount, dev) != hipSuccess) { grid = -1; return; }
        if (hipFuncSetAttribute((const void*)hybrid_fwd, hipFuncAttributeMaxDynamicSharedMemorySize, LDS_BYTES) != hipSuccess) { fprintf(stderr, "kernel_launch: hipFuncSetAttribute failed\n"); grid = -1; return; }
        if (hipOccupancyMaxActiveBlocksPerMultiprocessor(&per_cu, (const void*)hybrid_fwd, NTHREADS, LDS_BYTES) != hipSuccess || per_cu < 1) fprintf(stderr, "kernel_launch: occupancy query reports %d\n", per_cu);
        (void)hipGetLastError();
        grid = cus;
    }
    if (grid < 0) return;
    if (hipMemsetAsync((char*)d_ws + WS_CTL, 0, CTL_ZERO_BYTES, stream) != hipSuccess) return;
    Args a{};
    for (int i = 0; i < 36; ++i) a.in[i] = (const float*)d_in[i];
    a.out = (float*)d_out; a.ws = (unsigned char*)d_ws;
#if MK_ONE_LAUNCH
    a.lo = 0; a.hi = N_STEPS;
    hipLaunchKernelGGL(hybrid_fwd, dim3(grid), dim3(NTHREADS), LDS_BYTES, stream, a);
#else
    for (int s = 0; s < N_STEPS; ++s) {
        if (s < 36 && ((s % 9) == 2 || (s % 9) == 4) && ((s / 9) & 1)) continue;
        a.lo = s; a.hi = s + 1;
        hipLaunchKernelGGL(hybrid_fwd, dim3(grid), dim3(NTHREADS), LDS_BYTES, stream, a);
    }
#endif
}
```

```cpp
#include <hip/hip_runtime.h>
#include <cstdio>
#include <cstdint>
__device__ __forceinline__ float silu_f(float x) { return x * __builtin_amdgcn_rcpf(1.0f + __builtin_amdgcn_exp2f(-1.4426950408889634f * x)); }
namespace pg8 {
#define PG8_LAS __attribute__((address_space(3)))
typedef unsigned short bf16_t;
typedef short bf16x8 __attribute__((ext_vector_type(8)));
typedef float f32x4 __attribute__((ext_vector_type(4)));
typedef unsigned u32x4 __attribute__((ext_vector_type(4)));
constexpr int BM = 256, BK = 64, HALF = 128, HTB = HALF * BK * 2  , STAGE_BYTES = 8 * HTB, NXCD = 8, WGM = 4;

__host__ __device__ __forceinline__ int lds_byte(int r, int c) { const int st = (r >> 4) * 2 + (c >> 5), rr = r & 15, cc = c & 31, ob = rr * 64 + cc * 2; return st * 1024 + (ob ^ (((ob >> 9) & 1) << 5)); }
__host__ __device__ __forceinline__ void stage_rc(int b, int& R, int& C) { const int st = b / 1024, sb = b % 1024, swz = sb ^ (((sb >> 9) & 1) << 5); R = (st >> 1) * 16 + swz / 64; C = (st & 1) * 32 + (swz % 64) / 2; }
__host__ __device__ __forceinline__ int perm32(int rho) { const int n = rho >> 4, i = rho & 15; return 8 * (i >> 2) + 4 * n + (i & 3); }

struct Unit { int pm, pn, idx; };
struct Gemm { const bf16_t* A; const bf16_t* Bt; int M, N, K; };

struct StaticOrder {
    int nM, nN, nwg, G, c;
    __host__ __device__ void init(int M, int N, int G_, int c_) { nM = M / BM; nN = N / BM; nwg = nM * nN; G = G_; c = c_; }
    __host__ __device__ bool next(int i, Unit& u) const {
        const long L = (long)i * G + c; if (L >= nwg) return false;
        int wgid = (int)L; { const int q = nwg / NXCD, r = nwg % NXCD, xcd = wgid % NXCD, off = wgid / NXCD; wgid = (xcd < r ? xcd * (q + 1) : r * (q + 1) + (xcd - r) * q) + off; }
        const int nig = WGM * nN, gid = wgid / nig, fm = gid * WGM, gsz = (nM - fm) < WGM ? (nM - fm) : WGM;
        u.pm = fm + ((wgid % nig) % gsz); u.pn = (wgid % nig) / gsz; return true;
    }
    __device__ __forceinline__ void a_ready(const Unit&) const {}
    __device__ __forceinline__ void done(const Unit&) const {}
};

__device__ __forceinline__ unsigned cvt_pk_bf16(float lo, float hi) { unsigned r; asm volatile("v_cvt_pk_bf16_f32 %0, %1, %2" : "=v"(r) : "v"(lo), "v"(hi)); return r; }
typedef float f32x2 __attribute__((ext_vector_type(2)));
__device__ __forceinline__ float row_ssq(const float* ssq, int row) { const f32x4* p = (const f32x4*)(ssq + (size_t)row * 16); const f32x4 a = p[0], b = p[1], c = p[2], d = p[3];
    return (((a[0] + a[1]) + (a[2] + a[3])) + ((b[0] + b[1]) + (b[2] + b[3]))) + (((c[0] + c[1]) + (c[2] + c[3])) + ((d[0] + d[1]) + (d[2] + d[3]))); }
struct EpiStoreBf16 {
    static constexpr bool PERM = true, AFTER_DRAIN = false;
    bf16_t* O; int ldc; int qtiles; float qscale; const PG8_LAS float* rstab;
    __device__ __forceinline__ void operator()(const f32x4 (&acc)[2][2][4][2], const Unit& u, int wr, int wc, int fr, int fq) const {
        const int row0 = u.pm * BM + wr * 64 + fr, col0 = u.pn * BM + wc * 32 + 8 * fq;
        const float sc = u.pn < qtiles ? qscale : 1.0f;
        const PG8_LAS float* rt_ = rstab + u.idx * BM + wr * 64 + fr;
#pragma unroll
        for (int ai = 0; ai < 2; ++ai)
#pragma unroll
            for (int m = 0; m < 4; ++m) { const int row = row0 + ai * HALF + m * 16; bf16_t* rowp = O + (size_t)row * ldc + col0;
                const float rs = sc * rt_[ai * HALF + m * 16];
#pragma unroll
                for (int bj = 0; bj < 2; ++bj) { const f32x4 v0 = acc[ai][bj][m][0] * rs, v1 = acc[ai][bj][m][1] * rs;
                    u32x4 w; w.x = cvt_pk_bf16(v0[0], v0[1]); w.y = cvt_pk_bf16(v0[2], v0[3]); w.z = cvt_pk_bf16(v1[0], v1[1]); w.w = cvt_pk_bf16(v1[2], v1[3]);
                    *(u32x4*)(rowp + bj * HALF) = w; } }
    }
};
template <bool LAST, bool NOSTORE = false> struct EpiResBf16 {
    static constexpr bool PERM = false, AFTER_DRAIN = false;
    bf16_t* xr; int ldc; float* ssq; bf16_t* xf;
    __device__ __forceinline__ void operator()(const f32x4 (&acc)[2][2][4][2], const Unit& u, int wr, int wc, int fr, int fq) const {
        typedef unsigned u32x2 __attribute__((ext_vector_type(2)));
        const int row0 = u.pm * BM + wr * 64 + fr, col0 = u.pn * BM + wc * 32 + 4 * fq;
#pragma unroll
        for (int ai = 0; ai < 2; ++ai)
#pragma unroll
            for (int m = 0; m < 4; ++m) { const int row = row0 + ai * HALF + m * 16; const size_t off = (size_t)row * ldc + col0; float s = 0.f;
#pragma unroll
                for (int bj = 0; bj < 2; ++bj)
#pragma unroll
                    for (int n = 0; n < 2; ++n) { const u32x2 bw = *(const u32x2*)(xr + off + bj * HALF + n * 16);
                        const f32x4 b = (f32x4){__builtin_bit_cast(float, bw.x << 16), __builtin_bit_cast(float, bw.x & 0xffff0000u), __builtin_bit_cast(float, bw.y << 16), __builtin_bit_cast(float, bw.y & 0xffff0000u)};
                        const f32x4 v = b + acc[ai][bj][m][n];
                        s += (v[0] * v[0] + v[1] * v[1]) + (v[2] * v[2] + v[3] * v[3]);
                        u32x2 w; w.x = cvt_pk_bf16(v[0], v[1]); w.y = cvt_pk_bf16(v[2], v[3]); if (!NOSTORE) *(u32x2*)((LAST ? xf : xr) + off + bj * HALF + n * 16) = w; else asm volatile("" :: "v"(w.x), "v"(w.y)); }
                s += __shfl_xor(s, 16); s += __shfl_xor(s, 32);
                if (fq == 0 && !NOSTORE) ssq[(size_t)row * 16 + u.pn * 4 + wc] = s;
                if (m & 1) asm volatile("" ::: "memory"); }
    }
};
template <bool NOSTORE = false> struct EpiSwigluT {
    static constexpr bool PERM = true, AFTER_DRAIN = false;
    bf16_t* H; int ldc; const PG8_LAS float* rstab;
    __device__ __forceinline__ void operator()(const f32x4 (&acc)[2][2][4][2], const Unit& u, int wr, int wc, int fr, int fq) const {
        const int row0 = u.pm * BM + wr * 64 + fr, colh = u.pn * HALF + wc * 32 + 8 * fq;
        const PG8_LAS float* rt_ = rstab + u.idx * BM + wr * 64 + fr;
#pragma unroll
        for (int ai = 0; ai < 2; ++ai)
#pragma unroll
            for (int m = 0; m < 4; ++m) { const int row = row0 + ai * HALF + m * 16; bf16_t* rowp = H + (size_t)row * ldc + colh;
                const float rs = rt_[ai * HALF + m * 16];
                const f32x4 g0 = acc[ai][0][m][0] * rs, g1 = acc[ai][0][m][1] * rs, u0 = acc[ai][1][m][0] * rs, u1 = acc[ai][1][m][1] * rs;
                float h[8];
#pragma unroll
                for (int e = 0; e < 4; ++e) { h[e] = silu_f(g0[e]) * u0[e]; h[4 + e] = silu_f(g1[e]) * u1[e]; }
                u32x4 w; w.x = cvt_pk_bf16(h[0], h[1]); w.y = cvt_pk_bf16(h[2], h[3]); w.z = cvt_pk_bf16(h[4], h[5]); w.w = cvt_pk_bf16(h[6], h[7]);
                if (!NOSTORE) *(u32x4*)rowp = w; else asm volatile("" :: "v"(w.x), "v"(w.y), "v"(w.z), "v"(w.w)); }
    }
};
typedef EpiSwigluT<false> EpiSwiglu;
template <int M_, int N_> struct StaticOrderC {
    static constexpr int nM = M_ / BM, nN = N_ / BM, nwg = nM * nN;
    int G, c;
    __device__ __forceinline__ void init(int G_, int c_) { G = G_; c = c_; }
    __device__ __forceinline__ bool next(int i, Unit& u) const {
        const int L = i * G + c; if (L >= nwg) return false;
        int wgid = L; { constexpr int q = nwg / NXCD, r = nwg % NXCD; const int xcd = wgid % NXCD, off = wgid / NXCD; wgid = (xcd < r ? xcd * (q + 1) : r * (q + 1) + (xcd - r) * q) + off; }
        constexpr int nig = WGM * nN; const int gid = wgid / nig, fm = gid * WGM, gsz = (nM - fm) < WGM ? (nM - fm) : WGM;
        u.pm = fm + ((wgid % nig) % gsz); u.pn = (wgid % nig) / gsz; u.idx = i; return true;
    }
    __device__ __forceinline__ void a_ready(const Unit&) const {}
    __device__ __forceinline__ void done(const Unit&) const {}
};
template <class Sched> __device__ __forceinline__ void fill_row_scales(const Sched& S, const float* ssq, PG8_LAS float* tab, int tid) {
    Unit u; const int r = tid >> 1, hf = tid & 1;
    for (int i = 0; S.next(i, u); ++i) { const f32x4* p = (const f32x4*)(ssq + (size_t)(u.pm * BM + r) * 16 + hf * 8); const f32x4 a = p[0], b = p[1];
        float sum = ((a[0] + a[1]) + (a[2] + a[3])) + ((b[0] + b[1]) + (b[2] + b[3])); sum += __shfl_xor(sum, 1);
        if (hf == 0) tab[i * BM + r] = __builtin_amdgcn_rsqf(sum * (1.0f / 1024.0f) + 1e-6f); }
    __syncthreads();
}
template <class Epi, class Sched, bool ALIGN_EPI = false, bool SP2 = false>
__device__ __forceinline__ void gemm_phase(PG8_LAS unsigned char* lds, const Gemm g, const Sched& S, const Epi& E) {
    int tid_ = threadIdx.x; asm volatile("" : "+v"(tid_));
    float zz_ = 0.f; asm volatile("" : "+v"(zz_));
    const int tid = tid_, wid = __builtin_amdgcn_readfirstlane(tid >> 6), lane = tid & 63, wr = wid >> 2, wc = wid & 3, fr = lane & 15, fq = lane >> 4;
    const int K = g.K, nt = K / BK;
    unsigned voffA[2], voffB[2];
#pragma unroll
    for (int i = 0; i < 2; ++i) { int R, C; stage_rc(tid * 16 + i * 8192, R, C); const int Rb = Epi::PERM ? ((R & ~31) + perm32(R & 31)) : R;
        voffA[i] = (unsigned)(R * K + C) * 2u; voffB[i] = (unsigned)(Rb * K + C) * 2u; }
    const size_t kstep = (size_t)(BK * 2);
    const size_t hstep = (size_t)HALF * K * 2;
    const size_t tstep = 2 * hstep;
    const unsigned ldsw = (unsigned)wid * 1024u;
    const int aoff = lds_byte(wr * 64 + fr, fq * 8), boff = lds_byte(wc * 32 + fr, fq * 8);
#define PG8_SA(b, h) (((b) * 2 + (h)) * HTB)
#define PG8_SB(b, h) ((4 + (b) * 2 + (h)) * HTB)
#define PG8_STAGE(bufoff, gbase, voff) do { _Pragma("unroll") for (int _i = 0; _i < 2; ++_i) \
        __builtin_amdgcn_global_load_lds((const unsigned*)((const char*)(gbase) + (voff)[_i]), (PG8_LAS unsigned*)(lds + (bufoff) + ldsw + _i * 8192), 16, 0, 0); } while (0)
#define PG8_LDA(dst, b, h) do { _Pragma("unroll") for (int m = 0; m < 4; ++m) _Pragma("unroll") for (int k = 0; k < 2; ++k) dst[m][k] = *(const PG8_LAS bf16x8*)(lds + PG8_SA(b, h) + aoff + m * 2048 + k * 1024); } while (0)
#define PG8_LDB(dst, b, h) do { _Pragma("unroll") for (int n = 0; n < 2; ++n) _Pragma("unroll") for (int k = 0; k < 2; ++k) dst[n][k] = *(const PG8_LAS bf16x8*)(lds + PG8_SB(b, h) + boff + n * 2048 + k * 1024); } while (0)
#define PG8_MMA(ai, bj, At, Bt) do { __builtin_amdgcn_s_setprio(1); _Pragma("unroll") for (int m = 0; m < 4; ++m) _Pragma("unroll") for (int n = 0; n < 2; ++n) _Pragma("unroll") for (int k = 0; k < 2; ++k) \
        acc[ai][bj][m][n] = __builtin_amdgcn_mfma_f32_16x16x32_bf16(Bt[n][k], At[m][k], acc[ai][bj][m][n], 0, 0, 0); __builtin_amdgcn_s_setprio(0); } while (0)
#define PG8_WAIT_V(n) asm volatile("s_waitcnt vmcnt(" #n ")" ::: "memory")
#define PG8_WAIT_L(n) asm volatile("s_waitcnt lgkmcnt(" #n ")" ::: "memory")
#define PG8_BAR __builtin_amdgcn_s_barrier()
#define PG8_SCHED __builtin_amdgcn_sched_barrier(0)
    Unit cur, nxt; int ui = 0;
    if (!S.next(0, cur)) return;
    f32x4 acc[2][2][4][2];
#pragma unroll
    for (int a = 0; a < 2; ++a)
#pragma unroll
        for (int b = 0; b < 2; ++b)
#pragma unroll
            for (int m = 0; m < 4; ++m)
#pragma unroll
                for (int n = 0; n < 2; ++n) acc[a][b][m][n] = (f32x4){zz_, zz_, zz_, zz_};
    bf16x8 At[4][2], B0[2][2], B1[2][2];
    const char* cA = (const char*)g.A + (size_t)cur.pm * tstep; const char* cB = (const char*)g.Bt + (size_t)cur.pn * tstep;
    S.a_ready(cur);
    if constexpr (SP2) {
        PG8_STAGE(PG8_SB(0, 0), cB, voffB); PG8_STAGE(PG8_SB(0, 1), cB + hstep, voffB); PG8_STAGE(PG8_SA(0, 0), cA, voffA); PG8_STAGE(PG8_SA(0, 1), cA + hstep, voffA);
        if (wr == 1) PG8_BAR;
        PG8_WAIT_V(2); PG8_BAR;
        PG8_STAGE(PG8_SB(1, 0), cB + kstep, voffB); PG8_STAGE(PG8_SA(1, 0), cA + kstep, voffA); PG8_STAGE(PG8_SB(1, 1), cB + hstep + kstep, voffB);
        PG8_WAIT_V(6); PG8_BAR;
    } else {
        PG8_STAGE(PG8_SB(0, 0), cB, voffB); PG8_STAGE(PG8_SA(0, 0), cA, voffA); PG8_STAGE(PG8_SB(0, 1), cB + hstep, voffB); PG8_STAGE(PG8_SA(0, 1), cA + hstep, voffA);
        if (wr == 1) PG8_BAR;
        PG8_WAIT_V(4); PG8_BAR;
        PG8_STAGE(PG8_SB(1, 0), cB + kstep, voffB); PG8_STAGE(PG8_SA(1, 0), cA + kstep, voffA); PG8_STAGE(PG8_SB(1, 1), cB + hstep + kstep, voffB);
        PG8_WAIT_V(6); PG8_BAR;
    }
    for (;;) {
        const bool has_next = S.next(ui + 1, nxt);
        const char* nA = has_next ? (const char*)g.A + (size_t)nxt.pm * tstep : cA; const char* nB = has_next ? (const char*)g.Bt + (size_t)nxt.pn * tstep : cB;
        for (int t = 0; t < nt; t += 2) {
            const bool last = (t == nt - 2);
            const char* a1 = cA + (size_t)(t + 1) * kstep;
            const char* a2 = last ? nA : cA + (size_t)(t + 2) * kstep; const char* b2 = last ? nB : cB + (size_t)(t + 2) * kstep;
            const char* a3 = a2 + kstep; const char* b3 = b2 + kstep;
            if (last && has_next) S.a_ready(nxt);
            if constexpr (SP2) {
            PG8_LDB(B0, 0, 0); PG8_LDB(B1, 0, 1); PG8_SCHED; PG8_LDA(At, 0, 0); PG8_STAGE(PG8_SA(1, 1), a1 + hstep, voffA);
            PG8_WAIT_V(8); PG8_WAIT_L(0); PG8_BAR; PG8_MMA(0, 0, At, B0); PG8_MMA(0, 1, At, B1); PG8_BAR; PG8_SCHED;
            PG8_LDA(At, 0, 1); PG8_STAGE(PG8_SB(0, 0), b2, voffB); PG8_STAGE(PG8_SB(0, 1), b2 + hstep, voffB); PG8_STAGE(PG8_SA(0, 0), a2, voffA);
            PG8_WAIT_V(8); PG8_WAIT_L(0); PG8_BAR; PG8_MMA(1, 0, At, B0); PG8_MMA(1, 1, At, B1); PG8_BAR; PG8_SCHED;
            PG8_LDB(B0, 1, 0); PG8_LDB(B1, 1, 1); PG8_SCHED; PG8_LDA(At, 1, 0); PG8_STAGE(PG8_SA(0, 1), a2 + hstep, voffA);
            PG8_WAIT_V(8); PG8_WAIT_L(0); PG8_BAR; PG8_MMA(0, 0, At, B0); PG8_MMA(0, 1, At, B1); PG8_BAR; PG8_SCHED;
            PG8_LDA(At, 1, 1); PG8_STAGE(PG8_SB(1, 0), b3, voffB); PG8_STAGE(PG8_SB(1, 1), b3 + hstep, voffB); PG8_STAGE(PG8_SA(1, 0), a3, voffA);
            PG8_WAIT_V(8); PG8_WAIT_L(0); PG8_BAR; PG8_MMA(1, 0, At, B0); PG8_MMA(1, 1, At, B1); PG8_BAR; PG8_SCHED;
            } else {
            PG8_LDB(B0, 0, 0); PG8_SCHED; PG8_LDA(At, 0, 0); PG8_STAGE(PG8_SA(1, 1), a1 + hstep, voffA);
            PG8_WAIT_L(8); PG8_BAR; PG8_WAIT_L(0); PG8_MMA(0, 0, At, B0); PG8_BAR; PG8_SCHED;
            PG8_LDB(B1, 0, 1); PG8_STAGE(PG8_SB(0, 0), b2, voffB);
            PG8_BAR; PG8_WAIT_L(0); PG8_MMA(0, 1, At, B1); PG8_BAR;
            PG8_LDA(At, 0, 1); PG8_STAGE(PG8_SA(0, 0), a2, voffA);
            PG8_BAR; PG8_WAIT_L(0); PG8_MMA(1, 0, At, B0); PG8_BAR; PG8_SCHED;
            PG8_STAGE(PG8_SB(0, 1), b2 + hstep, voffB);
            PG8_WAIT_V(6); PG8_BAR; PG8_MMA(1, 1, At, B1); PG8_BAR;
            PG8_LDB(B0, 1, 0); PG8_SCHED; PG8_LDA(At, 1, 0); PG8_STAGE(PG8_SA(0, 1), a2 + hstep, voffA);
            PG8_WAIT_L(8); PG8_BAR; PG8_WAIT_L(0); PG8_MMA(0, 0, At, B0); PG8_BAR; PG8_SCHED;
            PG8_LDB(B1, 1, 1); PG8_STAGE(PG8_SB(1, 0), b3, voffB);
            PG8_BAR; PG8_WAIT_L(0); PG8_MMA(0, 1, At, B1); PG8_BAR;
            PG8_LDA(At, 1, 1); PG8_STAGE(PG8_SA(1, 0), a3, voffA);
            PG8_BAR; PG8_WAIT_L(0); PG8_MMA(1, 0, At, B0); PG8_BAR; PG8_SCHED;
            PG8_STAGE(PG8_SB(1, 1), b3 + hstep, voffB);
            PG8_WAIT_V(6); PG8_BAR; PG8_MMA(1, 1, At, B1); PG8_BAR;
            }
        }
        if constexpr (ALIGN_EPI) { if (wr == 0) PG8_BAR; }
        if constexpr (!Epi::AFTER_DRAIN) { E(acc, cur, wr, wc, fr, fq); S.done(cur); }
        if (!has_next) break;
#pragma unroll
        for (int a = 0; a < 2; ++a)
#pragma unroll
            for (int b = 0; b < 2; ++b)
#pragma unroll
                for (int m = 0; m < 4; ++m)
#pragma unroll
                    for (int n = 0; n < 2; ++n) acc[a][b][m][n] = (f32x4){zz_, zz_, zz_, zz_};
        cur = nxt; cA = nA; cB = nB; ++ui;
        if constexpr (ALIGN_EPI) { if (wr == 1) PG8_BAR; }
    }
    PG8_WAIT_V(0);
    if constexpr (!ALIGN_EPI) { if (wr == 0) PG8_BAR; }
    PG8_BAR;
    if constexpr (Epi::AFTER_DRAIN) { E.fused(acc, cur, wr, wc, fr, fq, lds, wid, lane); S.done(cur); }
#undef PG8_SA
#undef PG8_SB
#undef PG8_STAGE
#undef PG8_LDA
#undef PG8_LDB
#undef PG8_MMA
#undef PG8_WAIT_V
#undef PG8_WAIT_L
#undef PG8_BAR
#undef PG8_SCHED
}
}
#ifndef PG8_SP2
#define PG8_SP2 true
#endif
#ifndef PG8_ALIGN
#define PG8_ALIGN true
#endif
constexpr int NWAVES = 8, NTHREADS = NWAVES * 64;
constexpr int BATCH = 8, T = 4096, D = 1024, M = BATCH * T;
constexpr int NIN_E = 3840, NIN_O = 3072, FF = 2816, NGU = 2 * FF;
constexpr int PC_R = 0, PC_K = 512, PC_V = 1024, PC_GQ = 1536, PC_GK = 1792, PC_GV = 2048, PC_GG = 2560;
constexpr int PC_W1A = 3072, PC_W1B = 3136, PC_A1A = 3200, PC_A1B = 3264, PC_G1A = 3328, PC_G1B = 3488, PC_WA1 = 3648, PC_PAD = 3664;
constexpr int NLORA = 304;
constexpr size_t MiB = 1u << 20;
constexpr size_t WS_CTL = 0, CTL_ZERO_BYTES = 1 * MiB;
constexpr size_t WS_WIN = 2 * MiB, WS_WOUT = 10 * MiB, WS_WGU = 12 * MiB, WS_WDN = 23 * MiB;
constexpr size_t WS_W2T = 29 * MiB, WS_A2T = WS_W2T + 65536, WS_G2T = WS_A2T + 65536, WS_WA2T = WS_G2T + 196608;
constexpr size_t WS_SSQ = 496 * MiB;
constexpr size_t WS_XFIN = 336 * MiB;
constexpr size_t WS_XN = 32 * MiB;
constexpr size_t WS_P = 96 * MiB;
constexpr size_t WS_END = 500 * MiB;
constexpr int CW_BAR = 4096;
constexpr int RING_BYTES = 135168, LDS_BYTES = 163840, LDSCTL_OFF = LDS_BYTES - 1024, MISC_OFF = LDSCTL_OFF + 320, RSTAB_OFF = RING_BYTES + 448;

#define GAS __attribute__((address_space(1)))
#define LAS __attribute__((address_space(3)))
typedef unsigned short bf16;
typedef unsigned v4u __attribute__((ext_vector_type(4)));
typedef unsigned v2u __attribute__((ext_vector_type(2)));
typedef float f32x4 __attribute__((ext_vector_type(4)));
#define LDS_WAIT() asm volatile("s_waitcnt lgkmcnt(0)" ::: "memory")
#define VM_WAIT() asm volatile("s_waitcnt vmcnt(0)" ::: "memory")
#define LDS_BARRIER() do { asm volatile("s_waitcnt lgkmcnt(0)\n\ts_barrier" ::: "memory"); } while (0)
__device__ __forceinline__ unsigned f2bf(float f) { unsigned u = __builtin_bit_cast(unsigned, f); return (u + 0x7fffu + ((u >> 16) & 1u)) >> 16; }
__device__ __forceinline__ unsigned pk2(float lo, float hi) { return f2bf(lo) | (f2bf(hi) << 16); }
__device__ __forceinline__ float bf2f(bf16 u) { return __builtin_bit_cast(float, (unsigned)u << 16); }
__device__ __forceinline__ float bflo(unsigned w) { return __builtin_bit_cast(float, w << 16); }
__device__ __forceinline__ float bfhi(unsigned w) { return __builtin_bit_cast(float, w & 0xffff0000u); }
__device__ __forceinline__ float wave_sum(float v) {
#define WS_DPP(x, ctrl, rmask) __builtin_bit_cast(float, __builtin_amdgcn_update_dpp(0, __builtin_bit_cast(int, x), ctrl, rmask, 0xf, true))
    v += WS_DPP(v, 0x111, 0xf);
    v += WS_DPP(v, 0x112, 0xf);
    v += WS_DPP(v, 0x114, 0xf);
    v += WS_DPP(v, 0x118, 0xf);
    v += WS_DPP(v, 0x142, 0xa);
    v += WS_DPP(v, 0x143, 0xc);
#undef WS_DPP
    return __builtin_bit_cast(float, __builtin_amdgcn_readlane(__builtin_bit_cast(int, v), 63));
}
__device__ __forceinline__ float wave_max(float v) {
#pragma unroll
    for (int o = 1; o < 64; o <<= 1) v = fmaxf(v, __shfl_xor(v, o));
    return v;
}
__device__ __forceinline__ float fexp(float x) { return __builtin_amdgcn_exp2f(x * 1.4426950408889634f); }
__device__ __forceinline__ float flog(float x) { return __builtin_amdgcn_logf(x) * 0.6931471805599453f; }
__device__ __forceinline__ float frcp(float x) { return __builtin_amdgcn_rcpf(x); }
__device__ __forceinline__ float frsq(float x) { return __builtin_amdgcn_rsqf(x); }
__device__ __forceinline__ float fsqrt(float x) { return __builtin_amdgcn_sqrtf(x); }
__device__ __forceinline__ float sigmoid_f(float x) { return frcp(1.0f + fexp(-x)); }
__device__ __forceinline__ float softplus_f(float x) { return fmaxf(x, 0.f) + flog(1.0f + fexp(-fabsf(x))); }
__device__ __forceinline__ float tanh_f(float x) { return 1.0f - 2.0f * frcp(1.0f + fexp(2.0f * x)); }
#define XB_TMO      128
#define XB_XCNT(j)  (256  + 64 * (j))
#define XB_XSUB(j)  (1280 + 64 * (j))
#define XB_XGEN(j)  (2304 + 64 * (j))
#define XB_TOP      3328
#define XB_TOPGEN   3392
#define XCD_BAR_WORDS 3456
#define XB_SPIN_CAP (1u << 23)

__device__ __forceinline__ unsigned xb_ld(unsigned* p)              { return __hip_atomic_load(p, __ATOMIC_RELAXED, __HIP_MEMORY_SCOPE_AGENT); }
__device__ __forceinline__ unsigned xb_add(unsigned* p, unsigned v) { return __hip_atomic_fetch_add(p, v, __ATOMIC_RELAXED, __HIP_MEMORY_SCOPE_AGENT); }
__device__ __forceinline__ unsigned xb_xcc_id() { return (unsigned)__builtin_amdgcn_s_getreg((3 << 11) | 20) & 0xFu; }
#define XB_SPIN(cond, bar) do { unsigned _sp = 0; while (cond) { __builtin_amdgcn_s_sleep(1); \
    if ((++_sp & 255u) == 0u) { if (xb_ld(&(bar)[XB_TMO])) break; if (_sp > XB_SPIN_CAP) { atomicAdd(&(bar)[XB_TMO], 1u); break; } } } } while (0)

struct XcdBarrier {
    unsigned* bar; unsigned x;
    volatile LAS unsigned* st;
};

__device__ __forceinline__ XcdBarrier xcd_barrier_post(unsigned* bar, volatile LAS unsigned* st) {
    XcdBarrier b; b.bar = bar; b.x = xb_xcc_id(); b.st = st;
    if (threadIdx.x == 0) (void)xb_add(&bar[XB_XCNT(b.x)], 1u);
    return b;
}
__device__ __forceinline__ void xcd_barrier_complete(unsigned* bar, unsigned x, unsigned& nloc, unsigned& nx) {
    const unsigned G = gridDim.x * gridDim.y * gridDim.z;
    unsigned sum, cnt, mine, sp = 0u;
    for (;;) {
        sum = 0u; cnt = 0u; mine = 0u;
#pragma unroll
        for (unsigned j = 0; j < 16; ++j) { const unsigned c = xb_ld(&bar[XB_XCNT(j)]); sum += c; cnt += (c > 0u) ? 1u : 0u; mine = (j == x) ? c : mine; }
        if (sum == G) break;
        __builtin_amdgcn_s_sleep(1);
        if ((++sp & 255u) == 0u) { if (xb_ld(&bar[XB_TMO])) break; if (sp > XB_SPIN_CAP) { atomicAdd(&bar[XB_TMO], 1u); break; } }
    }
    nloc = mine > 0u ? mine : 1u; nx = cnt > 0u ? cnt : 1u;
}

__device__ __forceinline__ void xcd_barrier(const XcdBarrier& b) {
    asm volatile("s_waitcnt vmcnt(0)" ::: "memory");
    __syncthreads();
    if (threadIdx.x == 0) {
        unsigned blo_ = __builtin_amdgcn_readfirstlane((unsigned)(unsigned long long)b.bar), bhi_ = __builtin_amdgcn_readfirstlane((unsigned)((unsigned long long)b.bar >> 32)), bx = __builtin_amdgcn_readfirstlane(b.x); asm volatile("" : "+s"(blo_), "+s"(bhi_), "+s"(bx)); unsigned* bar = (unsigned*)(((unsigned long long)bhi_ << 32) | blo_);
        __builtin_amdgcn_s_waitcnt(0);
        unsigned nloc = b.st[0], nx = b.st[1];
        if (nloc == 0u) { xcd_barrier_complete(bar, bx, nloc, nx); b.st[0] = nloc; b.st[1] = nx; }
        const unsigned old = xb_add(&bar[XB_XSUB(bx)], 1u);
        const unsigned gen = old / nloc;
        if (old + 1u == (gen + 1u) * nloc) {
            __builtin_amdgcn_fence(__ATOMIC_RELEASE, "agent");
            asm volatile("s_waitcnt vmcnt(0)" ::: "memory");
            const unsigned og = xb_add(&bar[XB_TOP], 1u);
            const unsigned tg = og / nx;
            if (og + 1u == (tg + 1u) * nx) xb_add(&bar[XB_TOPGEN], 1u);
            else XB_SPIN(xb_ld(&bar[XB_TOPGEN]) == tg, bar);
            __builtin_amdgcn_fence(__ATOMIC_ACQUIRE, "agent");
            xb_add(&bar[XB_XGEN(bx)], 1u);
            asm volatile("s_waitcnt vmcnt(0)" ::: "memory");
        } else {
            XB_SPIN(xb_ld(&bar[XB_XGEN(bx)]) == gen, bar);
            __builtin_amdgcn_fence(__ATOMIC_ACQUIRE, "agent");
            asm volatile("s_waitcnt vmcnt(0)" ::: "memory");
        }
    }
    __syncthreads();
}
__device__ __forceinline__ void tr_item(const float* __restrict__ W, int Kreal, int N, bf16* WT, int ldd, int dst_row0, LAS float* scr, int k0, int n0, int lane,
                                        const float* __restrict__ mu, float sc0, float sc1, const float* __restrict__ gk = nullptr) {
    const int rr = lane >> 3, c4 = lane & 7, nn = n0 + 4 * c4; const bool nv = nn < N;
#pragma unroll
    for (int i = 0; i < 8; ++i) { const int kk = 8 * i + rr; f32x4 v = (nv && k0 + kk < Kreal) ? *(const GAS f32x4*)(W + (size_t)(k0 + kk) * N + nn) : (f32x4){0.f, 0.f, 0.f, 0.f};
        float sc = 1.0f; if (mu) sc = sc0 + sc1 * mu[k0 + kk]; if (gk) sc *= gk[k0 + kk]; v = v * sc;
        LAS float* d = scr + kk * 33 + 4 * c4; d[0] = v.x; d[1] = v.y; d[2] = v.z; d[3] = v.w; }
    LDS_WAIT(); asm volatile("" ::: "memory");
    const int c = lane & 7;
#pragma unroll
    for (int j = 0; j < 4; ++j) { const int n = (lane >> 3) + 8 * j; const LAS float* s = scr + (8 * c) * 33 + n;
        v4u o; o.x = pk2(s[0 * 33], s[1 * 33]); o.y = pk2(s[2 * 33], s[3 * 33]); o.z = pk2(s[4 * 33], s[5 * 33]); o.w = pk2(s[6 * 33], s[7 * 33]);
        if (n0 + n < N) *(GAS v4u*)(WT + (size_t)(dst_row0 + n) * ldd + k0 + 8 * c) = o; }
    LDS_WAIT(); asm volatile("" ::: "memory");
}
__device__ __forceinline__ void rms_row_bf16_to_f32(const bf16* xrow, const float* g, float* orow, int lane, float oscale = 1.0f) {
    const GAS v4u* xr = (const GAS v4u*)xrow + 2 * lane; const v4u a = xr[0], b = xr[1]; float v[16]; float s = 0.f;
    v[0] = bflo(a.x); v[1] = bfhi(a.x); v[2] = bflo(a.y); v[3] = bfhi(a.y); v[4] = bflo(a.z); v[5] = bfhi(a.z); v[6] = bflo(a.w); v[7] = bfhi(a.w);
    v[8] = bflo(b.x); v[9] = bfhi(b.x); v[10] = bflo(b.y); v[11] = bfhi(b.y); v[12] = bflo(b.z); v[13] = bfhi(b.z); v[14] = bflo(b.w); v[15] = bfhi(b.w);
#pragma unroll
    for (int e = 0; e < 16; ++e) s += v[e] * v[e];
    const float rs = frsq(wave_sum(s) * (1.f / D) + 1e-6f) * oscale;
    const GAS f32x4* gr = (const GAS f32x4*)g + 4 * lane; GAS f32x4* o = (GAS f32x4*)orow + 4 * lane;
#pragma unroll
    for (int q = 0; q < 4; ++q) { const f32x4 gv = gr[q]; o[q] = (f32x4){v[4 * q] * rs * gv.x, v[4 * q + 1] * rs * gv.y, v[4 * q + 2] * rs * gv.z, v[4 * q + 3] * rs * gv.w}; }
}
struct Args { const float* in[36]; float* out; unsigned char* ws; int lo, hi; };
typedef const __attribute__((address_space(4))) Args* ArgP;
#define FRESH_ARGS() ({ ArgP p_ = (ArgP)__builtin_amdgcn_kernarg_segment_ptr(); asm volatile("" : "+s"(p_)); p_; })
#define FRESH_V(x) asm volatile("" : "+v"(x))
#define FRESH_S(x) asm volatile("" : "+s"(x))

#define TR_JOB(items, nblk, Wp, Kd, Nd, DST, LDD, ROW0, MU, S0, S1, GK) if (r < (items)) { const int kb = r / (nblk), nb = r % (nblk), n0 = 32 * nb; tr_item(Wp, Kd, Nd, DST, LDD, ROW0, scr, 64 * kb, n0, lane, MU, S0, S1, GK); continue; } r -= (items);
__device__ __forceinline__ void convert_mixer_weights(ArgP A, int L, LAS unsigned char* lds, int wave, int lane, int gw, int NGW) {
    const int i = L >> 1; const bool even = !(L & 1);
    bf16* Win = (bf16*)(A->ws + WS_WIN); bf16* Wout = (bf16*)(A->ws + WS_WOUT);
    LAS float* scr = (LAS float*)(lds + wave * 16384);
    const float* gmix = A->in[2] + (size_t)L * D;
    const float* w_in = even ? A->in[5] + (size_t)i * D * 3072 : A->in[26] + (size_t)i * D * 3072;
    const float* w_out = even ? A->in[6] + (size_t)i * D * D : A->in[27] + (size_t)i * D * D;
    const float* mu_w = A->in[8] + (size_t)i * 3 * D, *mu_a = mu_w + D, *mu_g = mu_w + 2 * D;
    const float* w1 = A->in[10] + (size_t)i * D * 64, *a1 = A->in[13] + (size_t)i * D * 64, *g1 = A->in[15] + (size_t)i * D * 160, *wa1 = A->in[22] + (size_t)i * D * 16;
    const float* w2s = A->in[11] + (size_t)i * 64 * 512, *a2s = A->in[14] + (size_t)i * 64 * 512, *g2s = A->in[16] + (size_t)i * 160 * 512;
    bf16* W2T = (bf16*)(A->ws + WS_W2T); bf16* A2T = (bf16*)(A->ws + WS_A2T); bf16* G2T = (bf16*)(A->ws + WS_G2T);
    const int I_IN = 16 * 96, I_L64 = 16 * 2, I_L160 = 16 * 5, I_L16 = 16 * 1, I_OUT = 16 * 32;
    const int n_lora = even ? (4 * I_L64 + 2 * I_L160 + I_L16 + 16 + 16 + 48) : 0;
    const int NITEMS = I_IN + n_lora + I_OUT;
    for (int it = gw; it < NITEMS; it += NGW) {
        int r = it;
        TR_JOB(I_IN, 96, w_in, D, 3072, Win, D, n0, nullptr, 1.f, 0.f, gmix)
        if (even) {
            TR_JOB(I_L64, 2, w1, D, 64, Win, D, PC_W1A + n0, mu_w, 1.f, -1.f, gmix)
            TR_JOB(I_L64, 2, w1, D, 64, Win, D, PC_W1B + n0, mu_w, 0.f, 1.f, gmix)
            TR_JOB(I_L64, 2, a1, D, 64, Win, D, PC_A1A + n0, mu_a, 1.f, -1.f, gmix)
            TR_JOB(I_L64, 2, a1, D, 64, Win, D, PC_A1B + n0, mu_a, 0.f, 1.f, gmix)
            TR_JOB(I_L160, 5, g1, D, 160, Win, D, PC_G1A + n0, mu_g, 1.f, -1.f, gmix)
            TR_JOB(I_L160, 5, g1, D, 160, Win, D, PC_G1B + n0, mu_g, 0.f, 1.f, gmix)
            TR_JOB(I_L16, 1, wa1, D, 16, Win, D, PC_WA1 + n0, nullptr, 1.f, 0.f, gmix)
            TR_JOB(16, 16, w2s, 64, 512, W2T, 64, n0, nullptr, 1.f, 0.f, nullptr)
            TR_JOB(16, 16, a2s, 64, 512, A2T, 64, n0, nullptr, 1.f, 0.f, nullptr)
            TR_JOB(48, 16, g2s, 160, 512, G2T, 192, n0, nullptr, 1.f, 0.f, nullptr)
        }
        TR_JOB(I_OUT, 32, w_out, D, D, Wout, D, n0, nullptr, 1.f, 0.f, nullptr)
    }
    if (even) {
        const int gt = gw * 64 + lane, NT = NGW * 64;
        for (int e = gt; e < (NIN_E - PC_PAD) * D / 8; e += NT) ((GAS v4u*)(Win + (size_t)PC_PAD * D))[e] = (v4u){0u, 0u, 0u, 0u};
        bf16* WA2T = (bf16*)(A->ws + WS_WA2T); const float* wa2 = A->in[23] + (size_t)i * 16 * 256;
        for (int e = gt; e < 256 * 32; e += NT) { const int nn = e >> 5, k = e & 31; WA2T[e] = k < 16 ? (bf16)f2bf(wa2[k * 256 + nn]) : (bf16)0; }
    }
}
__device__ __forceinline__ void convert_ffn_weights(ArgP A, int L, LAS unsigned char* lds, int wave, int lane, int gw, int NGW) {
    bf16* Wgu = (bf16*)(A->ws + WS_WGU); bf16* Wdn = (bf16*)(A->ws + WS_WDN);
    LAS float* scr = (LAS float*)(lds + wave * 16384);
    const float* gffn = A->in[3] + (size_t)L * D;
    const float* wg = A->in[33] + (size_t)L * D * FF, *wu = A->in[34] + (size_t)L * D * FF, *wd = A->in[35] + (size_t)L * FF * D;
    const int I_GU = 16 * 88, I_DN = 44 * 32;
    for (int it = gw; it < 2 * I_GU + I_DN; it += NGW) {
        int r = it;
        TR_JOB(I_GU, 88, wg, D, FF, Wgu, D, 256 * (n0 >> 7) + (n0 & 127), nullptr, 1.f, 0.f, gffn)
        TR_JOB(I_GU, 88, wu, D, FF, Wgu, D, 256 * (n0 >> 7) + (n0 & 127) + 128, nullptr, 1.f, 0.f, gffn)
        TR_JOB(I_DN, 32, wd, FF, D, Wdn, FF, n0, nullptr, 1.f, 0.f, nullptr)
    }
}
#undef TR_JOB
__device__ __forceinline__ void x_to_bf16_ssq(const float* xrow, bf16* orow, float* ssq_row, int lane) {
    const GAS f32x4* xr = (const GAS f32x4*)xrow + lane; f32x4 v[4]; float s = 0.f;
#pragma unroll
    for (int j = 0; j < 4; ++j) { v[j] = xr[64 * j]; s += (v[j].x * v[j].x + v[j].y * v[j].y) + (v[j].z * v[j].z + v[j].w * v[j].w); }
    s = wave_sum(s); if (lane < 16) ssq_row[lane] = lane == 0 ? s : 0.f;
    GAS v2u* o8 = (GAS v2u*)orow + lane;
#pragma unroll
    for (int j = 0; j < 4; ++j) { v2u o; o.x = pk2(v[j].x, v[j].y); o.y = pk2(v[j].z, v[j].w); o8[64 * j] = o; }
}

__device__ __forceinline__ int t5_bucket(int d) {
    if (d < 16) return d;
    const float r = (float)d / 16.0f; int l = 16 + (int)(flog(r) / 2.0794415416798357f * 16.0f);
    return l < 31 ? l : 31;
}
typedef short a_bf16x8 __attribute__((ext_vector_type(8)));
typedef float f32x16 __attribute__((ext_vector_type(16)));
typedef short a_s16x4 __attribute__((ext_vector_type(4)));
constexpr int AT_K1 = 0, AT_K2 = 8192, AT_V = 16384, AT_ST = 32768, AT_NST = 4, AT_BIAS = AT_NST * AT_ST, AT_COMB = 0;
static_assert(AT_BIAS + 132 * 4 <= LDSCTL_OFF && 4 * 64 * 64 * 4 <= AT_BIAS, "attention LDS map");
__device__ __forceinline__ int crow16(int r, int hi) { return (r & 3) + 8 * (r >> 2) + 4 * hi; }
typedef float f32x2_t __attribute__((ext_vector_type(2))); typedef __bf16 bf16x2_t __attribute__((ext_vector_type(2)));
__device__ __forceinline__ unsigned cvtpk(float lo, float hi) { const f32x2_t v = {lo, hi}; const bf16x2_t b = __builtin_convertvector(v, bf16x2_t); return __builtin_bit_cast(unsigned, b); }

template <bool HALFSYNC = false> __device__ __forceinline__ void attn_unit_mfma(ArgP A, int L, int b, int h, int qb, float lam, float lam_init, LAS unsigned char* lds, int tid) {
    const int lane = tid & 63, wave = __builtin_amdgcn_readfirstlane(tid >> 6), r32 = lane & 31, hi = lane >> 5;
    const int smap = wave >> 2, qs = wave & 3;
    const int i = L >> 1;
    const bf16* QKV = (const bf16*)(A->ws + WS_P); bf16* O = (bf16*)(A->ws + WS_XN);
    const int q0 = qb * 128, qw0 = q0 + 32 * qs, nt = (q0 + 128) / 64;
    const size_t rowb = (size_t)b * T;
    if (tid < 129) { const float far = A->in[1][31 * 8 + h]; ((LAS float*)(lds + AT_BIAS))[tid] = tid < 128 ? (A->in[1][t5_bucket(tid) * 8 + h] - far) * 1.4426950408889634f : 0.f; }
    a_bf16x8 qf[4];
    { const bf16* qrow = QKV + (rowb + qw0 + r32) * NIN_O + h * 128 + smap * 64 + 8 * hi;
#pragma unroll
      for (int ks = 0; ks < 4; ++ks) qf[ks] = *(const GAS a_bf16x8*)(qrow + 16 * ks); }
    const int kr = 8 * wave + (lane >> 3), kcs = (lane & 7) ^ ((kr >> 1) & 7);
    const bf16* kg = QKV + (rowb + kr) * NIN_O + 1024 + h * 128 + 8 * kcs;
    const int vr0 = 8 * wave + (lane >> 4), vr1 = vr0 + 4;
    const bf16* vg0 = QKV + (rowb + vr0) * NIN_O + 2048 + h * 128 + 8 * ((lane & 15) ^ (((vr0 & 3) << 2) | ((vr0 >> 2) & 3)));
    const bf16* vg1 = QKV + (rowb + vr1) * NIN_O + 2048 + h * 128 + 8 * ((lane & 15) ^ (((vr1 & 3) << 2) | ((vr1 >> 2) & 3)));
#define AT_DMA(kt, stoff) do { const size_t go_ = (size_t)(kt) * 64 * NIN_O; LAS unsigned char* sb_ = lds + (stoff) + wave * 1024; \
        __builtin_amdgcn_global_load_lds((const unsigned*)(kg + go_), (LAS unsigned*)(sb_ + AT_K1), 16, 0, 0); __builtin_amdgcn_global_load_lds((const unsigned*)(kg + go_ + 64), (LAS unsigned*)(sb_ + AT_K2), 16, 0, 0); \
        __builtin_amdgcn_global_load_lds((const unsigned*)(vg0 + go_), (LAS unsigned*)(sb_ + AT_V + wave * 1024), 16, 0, 0); __builtin_amdgcn_global_load_lds((const unsigned*)(vg1 + go_), (LAS unsigned*)(sb_ + AT_V + wave * 1024 + 1024), 16, 0, 0); } while (0)
    AT_DMA(0, 0); AT_DMA(1, AT_ST);
    __syncthreads();
    f32x16 o[4];
#pragma unroll
    for (int d = 0; d < 4; ++d)
#pragma unroll
        for (int r = 0; r < 16; ++r) o[d][r] = 0.f;
    float m = -1e30f, l = 0.f;
    const int kfo = (smap ? AT_K2 : AT_K1) + r32 * 128, khg = hi ^ ((r32 >> 1) & 7);
    int vfo[2][4];
    { const int q = (lane & 15) >> 2, pp = lane & 3, blk = (lane >> 4) & 1;
#pragma unroll
      for (int t = 0; t < 2; ++t)
#pragma unroll
          for (int d = 0; d < 4; ++d) vfo[t][d] = AT_V + 256 * (4 * hi + q + 8 * t) + 16 * (((d ^ q) << 2) | ((2 * blk + (pp >> 1)) ^ ((hi + 2 * t) & 3))) + 8 * (pp & 1); }
    const LAS float* bdl = (const LAS float*)(lds + AT_BIAS);
    const int qme = qw0 + r32;
#define AT_VREAD(VF, kk, dh) do { _Pragma("unroll") for (int d2 = 0; d2 < 2; ++d2) { const int d = 2 * (dh) + d2; \
                VF[2 * d2] = __builtin_bit_cast(a_s16x4, __builtin_amdgcn_ds_read_tr16_b64_v4i16((LAS a_s16x4*)(sbv + vfo[0][d] + (kk) * 4096))); VF[2 * d2 + 1] = __builtin_bit_cast(a_s16x4, __builtin_amdgcn_ds_read_tr16_b64_v4i16((LAS a_s16x4*)(sbv + vfo[1][d] + (kk) * 4096))); } } while (0)
#define AT_PV(VF, PF, kk, dh) do { _Pragma("unroll") for (int d2 = 0; d2 < 2; ++d2) { const int d = 2 * (dh) + d2; const a_bf16x8 vf_ = (a_bf16x8){VF[2 * d2][0], VF[2 * d2][1], VF[2 * d2][2], VF[2 * d2][3], VF[2 * d2 + 1][0], VF[2 * d2 + 1][1], VF[2 * d2 + 1][2], VF[2 * d2 + 1][3]}; \
                o[d] = __builtin_amdgcn_mfma_f32_32x32x16_bf16(vf_, PF[kk], o[d], 0, 0, 0); } } while (0)
    int pbase = 0;
#define AT_QK(P, stoff_) do { const LAS unsigned char* sbk_ = lds + (stoff_); a_bf16x8 kf_[8]; \
        _Pragma("unroll") for (int f = 0; f < 8; ++f) kf_[f] = *(const LAS a_bf16x8*)(sbk_ + kfo + (f >> 2) * 4096 + ((khg ^ (2 * (f & 3))) * 16)); \
        __builtin_amdgcn_sched_barrier(0); __builtin_amdgcn_s_setprio(1); \
        _Pragma("unroll") for (int blk = 0; blk < 2; ++blk) { _Pragma("unroll") for (int r = 0; r < 16; ++r) P[blk][r] = 0.f; \
            _Pragma("unroll") for (int ks = 0; ks < 4; ++ks) P[blk] = __builtin_amdgcn_mfma_f32_32x32x16_bf16(kf_[blk * 4 + ks], qf[ks], P[blk], 0, 0, 0); } \
        __builtin_amdgcn_s_setprio(0); } while (0)
#define AT_EXPPK(P, PF, kk) do { const int blk_ = (kk) >> 1, s8_ = 8 * ((kk) & 1); float e_[8]; _Pragma("unroll") for (int j = 0; j < 8; ++j) { e_[j] = __builtin_amdgcn_exp2f(P[blk_][s8_ + j] - m); ls += e_[j]; } \
        v4u w_; w_.x = cvtpk(e_[0], e_[1]); w_.y = cvtpk(e_[2], e_[3]); w_.z = cvtpk(e_[4], e_[5]); w_.w = cvtpk(e_[6], e_[7]); PF[kk] = __builtin_bit_cast(a_bf16x8, w_); } while (0)
#define AT_SOFTPV(P, kt_, stoff_) do { const int key0 = 64 * (kt_); const LAS unsigned char* sbv = lds + (stoff_); \
        if (key0 + 63 + 128 > qw0) { \
            _Pragma("unroll") for (int blk = 0; blk < 2; ++blk) { float bvv[16]; \
                _Pragma("unroll") for (int r = 0; r < 16; ++r) { const unsigned ud = (unsigned)(qme - (key0 + 32 * blk + crow16(r, hi))); bvv[r] = bdl[ud < 128u ? ud : 128u]; } \
                asm volatile("" : "+v"(bvv[0]), "+v"(bvv[1]), "+v"(bvv[2]), "+v"(bvv[3]), "+v"(bvv[4]), "+v"(bvv[5]), "+v"(bvv[6]), "+v"(bvv[7]), "+v"(bvv[8]), "+v"(bvv[9]), "+v"(bvv[10]), "+v"(bvv[11]), "+v"(bvv[12]), "+v"(bvv[13]), "+v"(bvv[14]), "+v"(bvv[15])); \
                _Pragma("unroll") for (int r = 0; r < 16; ++r) { const int dist = qme - (key0 + 32 * blk + crow16(r, hi)); P[blk][r] = dist < 0 ? -1e30f : P[blk][r] + bvv[r]; } } } \
        float mx = P[0][0]; \
        _Pragma("unroll") for (int r = 1; r < 16; ++r) mx = fmaxf(mx, P[0][r]); \
        _Pragma("unroll") for (int r = 0; r < 16; ++r) mx = fmaxf(mx, P[1][r]); \
        { const auto sw_ = __builtin_amdgcn_permlane32_swap(__builtin_bit_cast(unsigned, mx), __builtin_bit_cast(unsigned, mx), false, false); mx = fmaxf(__builtin_bit_cast(float, sw_[0]), __builtin_bit_cast(float, sw_[1])); } \
        if (__any(mx > m + 8.0f)) { const float mn = fmaxf(m, mx), al = __builtin_amdgcn_exp2f(m - mn); m = mn; l *= al; \
            _Pragma("unroll") for (int d = 0; d < 4; ++d) _Pragma("unroll") for (int r = 0; r < 16; ++r) o[d][r] *= al; } \
        float ls = 0.f; a_bf16x8 pf[4]; a_s16x4 vA[4], vB[4]; \
        AT_VREAD(vA, 0, 0); AT_EXPPK(P, pf, 0); __builtin_amdgcn_sched_barrier(0); \
        AT_VREAD(vB, 0, 1); AT_PV(vA, pf, 0, 0); __builtin_amdgcn_sched_barrier(0); \
        AT_VREAD(vA, 1, 0); AT_PV(vB, pf, 0, 1); AT_EXPPK(P, pf, 1); __builtin_amdgcn_sched_barrier(0); \
        AT_VREAD(vB, 1, 1); AT_PV(vA, pf, 1, 0); __builtin_amdgcn_sched_barrier(0); \
        AT_VREAD(vA, 2, 0); AT_PV(vB, pf, 1, 1); AT_EXPPK(P, pf, 2); __builtin_amdgcn_sched_barrier(0); \
        AT_VREAD(vB, 2, 1); AT_PV(vA, pf, 2, 0); __builtin_amdgcn_sched_barrier(0); \
        AT_VREAD(vA, 3, 0); AT_PV(vB, pf, 2, 1); AT_EXPPK(P, pf, 3); __builtin_amdgcn_sched_barrier(0); \
        AT_VREAD(vB, 3, 1); AT_PV(vA, pf, 3, 0); __builtin_amdgcn_sched_barrier(0); \
        AT_PV(vB, pf, 3, 1); l += ls; } while (0)
#pragma unroll 1
    for (int kt0 = 0; kt0 < nt; kt0 += 2) {
        const int nbase = pbase ? 0 : 2 * AT_ST;
        if (kt0 + 2 < nt) { AT_DMA(kt0 + 2, nbase); AT_DMA(kt0 + 3, nbase + AT_ST); }
        const bool visA = 64 * kt0 <= qw0 + 31, visB = 64 * (kt0 + 1) <= qw0 + 31;
        f32x16 pA[2], pB[2];
        if (visA) AT_QK(pA, pbase);
        if (visB) AT_QK(pB, pbase + AT_ST);
        if (visA) AT_SOFTPV(pA, kt0, pbase);
        if (visB) AT_SOFTPV(pB, kt0 + 1, pbase + AT_ST);
        __syncthreads();
        pbase = nbase;
    }
#undef AT_QK
#undef AT_EXPPK
#undef AT_SOFTPV
#undef AT_VREAD
#undef AT_PV
#undef AT_DMA
    l += __shfl_xor(l, 32);
    LAS float* comb = (LAS float*)(lds + AT_COMB) + qs * 4096;
    if (smap == 1) { const float sc = lam * frcp(l);
#pragma unroll
        for (int d = 0; d < 4; ++d)
#pragma unroll
            for (int r = 0; r < 16; ++r) comb[(d * 16 + r) * 64 + lane] = o[d][r] * sc; }
    __syncthreads();
    if (smap == 0) {
        const float il = frcp(l); float ss = 0.f;
#pragma unroll
        for (int d = 0; d < 4; ++d)
#pragma unroll
            for (int r = 0; r < 16; ++r) { const float v = o[d][r] * il - comb[(d * 16 + r) * 64 + lane]; o[d][r] = v; ss += v * v; }
        ss += __shfl_xor(ss, 32);
        const float rs = frsq(ss * (1.f / 128.f) + 1e-5f) * (1.0f - lam_init);
        const float* sl = A->in[32] + i * 128;
        bf16* orow = O + (rowb + qw0 + r32) * D + h * 128;
#pragma unroll
        for (int d = 0; d < 4; ++d)
#pragma unroll
            for (int g4 = 0; g4 < 4; ++g4) { const int dc = 32 * d + 8 * g4 + 4 * hi; const f32x4 s4 = *(const GAS f32x4*)(sl + dc);
                v2u w; w.x = cvtpk(o[d][4 * g4] * rs * s4.x, o[d][4 * g4 + 1] * rs * s4.y); w.y = cvtpk(o[d][4 * g4 + 2] * rs * s4.z, o[d][4 * g4 + 3] * rs * s4.w);
                *(GAS v2u*)(orow + dc) = w; }
    }
    __syncthreads();
}

template <bool HALFSYNC = false> __device__ __forceinline__ void attn_phase_mfma(ArgP A, int L, LAS unsigned char* lds, int tid, int G, int bid) {
    const int lane = tid & 63, i = L >> 1;
    const float lam_init = 0.8f - 0.6f * fexp(-0.3f * (float)L);
    const float lam = fexp(wave_sum(A->in[28][i * 64 + lane] * A->in[29][i * 64 + lane])) - fexp(wave_sum(A->in[30][i * 64 + lane] * A->in[31][i * 64 + lane])) + lam_init;
    if (G == 256) {
        const int v = (bid & 7) * 32 + (bid >> 3), bh = v >> 2, j = v & 3;
#pragma unroll 1
        for (int u = 0; u < 8; ++u) { const int qb = 8 * (u >> 1) + ((u & 1) ? 7 - j : j); attn_unit_mfma<HALFSYNC>(A, L, bh >> 3, bh & 7, qb, lam, lam_init, lds, tid); }
    } else {
#pragma unroll 1
        for (int u = bid; u < 64 * 32; u += G) attn_unit_mfma<HALFSYNC>(A, L, (u >> 5) >> 3, (u >> 5) & 7, 31 - (u & 31), lam, lam_init, lds, tid);
    }
}
typedef short bf16x8_t __attribute__((ext_vector_type(8)));
constexpr int MS = 72, MB = 64 * MS * 2;
constexpr int RW_XW = 8 * MB, RW_XA = RW_XW + 16384;
constexpr int RW_TOT = 14 * MB, RW_GAM = RW_TOT + 2048, RW_END = RW_GAM + 256;
static_assert(RW_XA + 16384 <= 12 * MB && RW_END <= RING_BYTES, "RWKV LDS map");
constexpr size_t WS_RWI = 336 * MiB;
constexpr size_t WS_BON = 30 * MiB;
#define RBUF(k) ((LAS bf16*)(lds + (k) * MB))
__device__ __forceinline__ f32x4 mfma16(bf16x8_t a, bf16x8_t b, f32x4 c) { return __builtin_amdgcn_mfma_f32_16x16x32_bf16(a, b, c, 0, 0, 0); }
__device__ __forceinline__ bf16x8_t ldfrag(const LAS bf16* Mx, int row0, int k0, int lane) { return *(const LAS bf16x8_t*)(Mx + (row0 + (lane & 15)) * MS + k0 + 8 * (lane >> 4)); }
__device__ __forceinline__ f32x4 mm64(f32x4 acc, const LAS bf16* Am, int ra, const LAS bf16* BTm, int cb, int lane) {
    acc = mfma16(ldfrag(Am, 16 * ra, 0, lane), ldfrag(BTm, 16 * cb, 0, lane), acc);
    return mfma16(ldfrag(Am, 16 * ra, 32, lane), ldfrag(BTm, 16 * cb, 32, lane), acc);
}
__device__ __forceinline__ v2u pack4(f32x4 a) { v2u w; w.x = cvtpk(a[0], a[1]); w.y = cvtpk(a[2], a[3]); return w; }
__device__ __forceinline__ void tstore(LAS bf16* Dm, int rt, int ct, f32x4 acc, int lane) { *(LAS v2u*)(Dm + (16 * ct + (lane & 15)) * MS + 16 * rt + 4 * (lane >> 4)) = pack4(acc); }
__device__ __forceinline__ void tstore_g(bf16* Dg, int rt, int ct, f32x4 acc, int lane) { *(GAS v2u*)(Dg + (16 * ct + (lane & 15)) * 64 + 16 * rt + 4 * (lane >> 4)) = pack4(acc); }
__device__ __forceinline__ f32x4 ld4bf(const LAS bf16* p) { const v2u w = *(const LAS v2u*)p; return (f32x4){bflo(w.x), bfhi(w.x), bflo(w.y), bfhi(w.y)}; }
__device__ __forceinline__ f32x4 ld4bf_g(const bf16* p) { const v2u w = *(const GAS v2u*)p; return (f32x4){bflo(w.x), bfhi(w.x), bflo(w.y), bfhi(w.y)}; }
__device__ __forceinline__ void unpack8(v4u w, float (&f)[8]) { f[0] = bflo(w.x); f[1] = bfhi(w.x); f[2] = bflo(w.y); f[3] = bfhi(w.y); f[4] = bflo(w.z); f[5] = bfhi(w.z); f[6] = bflo(w.w); f[7] = bfhi(w.w); }
__device__ __forceinline__ bf16x8_t pack8(const float (&f)[8]) { v4u w; w.x = cvtpk(f[0], f[1]); w.y = cvtpk(f[2], f[3]); w.z = cvtpk(f[4], f[5]); w.w = cvtpk(f[6], f[7]); return __builtin_bit_cast(bf16x8_t, w); }

__device__ __forceinline__ void rwkv_chunk_phase(ArgP A, int L, LAS unsigned char* lds, int tid, int G, int bid) {
    const int lane = tid & 63, wave = __builtin_amdgcn_readfirstlane(tid >> 6), i = L >> 1;
    const int l15 = lane & 15, lg = lane >> 4;
    const bf16* P = (const bf16*)(A->ws + WS_P); bf16* XNb = (bf16*)(A->ws + WS_XN);
    const int rt = wave >> 1, ct0 = 2 * (wave & 1);
    constexpr int NIT = BATCH * 64 * 8;
    v4u pw[2][2], pa[2][2]; unsigned short pe[9][3];
#define R1_PREFETCH(itx) do { const int b_ = (itx) >> 9, n_ = ((itx) >> 3) & 63, h_ = (itx) & 7; const size_t rowb_ = (size_t)b_ * T + 64 * n_; \
        { const int tt_ = 16 * rt + l15; const bf16* prow_ = P + (rowb_ + tt_) * NIN_E; const bool hp_ = (64 * n_ + tt_) > 0; const v4u z4_ = (v4u){0u, 0u, 0u, 0u}; \
          _Pragma("unroll") for (int q = 0; q < 2; ++q) { const int kc_ = 32 * q + 8 * lg; pw[q][0] = *(const GAS v4u*)(prow_ + PC_W1A + kc_); pw[q][1] = hp_ ? *(const GAS v4u*)(prow_ - NIN_E + PC_W1B + kc_) : z4_; \
              pa[q][0] = *(const GAS v4u*)(prow_ + PC_A1A + kc_); pa[q][1] = hp_ ? *(const GAS v4u*)(prow_ - NIN_E + PC_A1B + kc_) : z4_; } \
          } \
        { const int c_ = 64 * h_ + lane; const size_t row0_ = rowb_ + 8 * wave; const bool hp_ = (64 * n_ + 8 * wave) > 0; \
          _Pragma("unroll") for (int u = 0; u < 9; ++u) { const bf16* pp_ = P + (row0_ + u - 1) * NIN_E; const bool ok_ = u > 0 || hp_; \
              pe[u][0] = ok_ ? pp_[PC_R + c_] : (unsigned short)0; pe[u][1] = ok_ ? pp_[PC_K + c_] : (unsigned short)0; pe[u][2] = ok_ ? pp_[PC_V + c_] : (unsigned short)0; } } } while (0)
    if (bid < NIT) R1_PREFETCH(bid);
#pragma unroll 1
    for (int it = bid; it < NIT; it += G) {
    const int b = it >> 9, n = (it >> 3) & 63, h = it & 7;
    const size_t rowb = (size_t)b * T + 64 * n;
    bf16* item = (bf16*)(A->ws + WS_RWI) + ((size_t)((b * 64 + n) * 8 + h)) * 16384;
    asm volatile("; MARK_R1_E1");
    {
        const bf16* W2T = (const bf16*)(A->ws + WS_W2T); const bf16* A2T = (const bf16*)(A->ws + WS_A2T);
        f32x4 xw[2], xa[2];
#pragma unroll
        for (int c = 0; c < 2; ++c) { xw[c] = (f32x4){0.f, 0.f, 0.f, 0.f}; xa[c] = (f32x4){0.f, 0.f, 0.f, 0.f}; }
#pragma unroll
        for (int q = 0; q < 2; ++q) {
            const int kc = 32 * q + 8 * lg; float x[8], y[8], v[8];
            unpack8(pw[q][0], x); unpack8(pw[q][1], y);
#pragma unroll
            for (int e = 0; e < 8; ++e) v[e] = tanh_f(x[e] + y[e]);
            const bf16x8_t fw = pack8(v);
            unpack8(pa[q][0], x); unpack8(pa[q][1], y);
#pragma unroll
            for (int e = 0; e < 8; ++e) v[e] = x[e] + y[e];
            const bf16x8_t fa = pack8(v);
#pragma unroll
            for (int c = 0; c < 2; ++c) { const size_t wo = (size_t)(64 * h + 16 * (ct0 + c) + l15) * 64 + kc;
                xw[c] = mfma16(fw, *(const GAS bf16x8_t*)(W2T + wo), xw[c]); xa[c] = mfma16(fa, *(const GAS bf16x8_t*)(A2T + wo), xa[c]); }
        }
        LAS float* XW = (LAS float*)(lds + RW_XW); LAS float* XA = (LAS float*)(lds + RW_XA);
#pragma unroll
        for (int c = 0; c < 2; ++c)
#pragma unroll
            for (int r = 0; r < 4; ++r) { const int o = (16 * rt + 4 * lg + r) * 64 + 16 * (ct0 + c) + l15; XW[o] = xw[c][r]; XA[o] = xa[c][r]; }
    }
    LDS_BARRIER();
    asm volatile("; MARK_R1_E2");
    {
        const int c = 64 * h + lane;
        const float* mu = A->in[7] + (size_t)i * 1536;
        const float mur = mu[c], muk = mu[512 + c], muv = mu[1024 + c];
        const float kkc = A->in[17][i * 512 + c], kac = A->in[18][i * 512 + c], rkc = A->in[19][i * 512 + c], w0c = A->in[9][i * 512 + c], a0c = A->in[12][i * 512 + c];
        const LAS float* XW = (const LAS float*)(lds + RW_XW); const LAS float* XA = (const LAS float*)(lds + RW_XA);
        float* BON = (float*)(A->ws + WS_BON);
        const int tt0 = 8 * wave; const size_t row0 = rowb + tt0;
        float pr_p = bf2f(pe[0][0]), pk_p = bf2f(pe[0][1]), pv_p = bf2f(pe[0][2]);
        float rr[8], av[8], bv[8], km[8], vv[8], lc[8];
        float run = 0.f;
#pragma unroll
        for (int u = 0; u < 8; ++u) {
            const float pR = bf2f(pe[u + 1][0]), pK = bf2f(pe[u + 1][1]), pV = bf2f(pe[u + 1][2]);
            const float r = pR + (pr_p - pR) * mur, k = pK + (pk_p - pK) * muk, v = pV + (pv_p - pV) * muv; pr_p = pR; pk_p = pK; pv_p = pV;
            const float xw = w0c + XW[(tt0 + u) * 64 + lane], xa = a0c + XA[(tt0 + u) * 64 + lane];
            const float wlog = -0.6065306597126334f * sigmoid_f(xw), as = sigmoid_f(xa);
            float kk = k * kkc; const float n2 = wave_sum(kk * kk); kk = kk * frsq(fmaxf(n2, 1e-24f));
            const float kmod = k * (1.f + (as - 1.f) * kac);
            const float bon = wave_sum(r * kmod * rkc);
            if (lane == 0) BON[(row0 + u) * 8 + h] = bon;
            run += wlog; rr[u] = r; av[u] = -kk; bv[u] = kk * as; km[u] = kmod; vv[u] = v; lc[u] = run;
        }
        LAS float* TOT = (LAS float*)(lds + RW_TOT);
        TOT[wave * 64 + lane] = run;
        LDS_BARRIER();
        float off = 0.f, tot = 0.f;
#pragma unroll
        for (int w2 = 0; w2 < 8; ++w2) { const float tv = TOT[w2 * 64 + lane]; tot += tv; if (w2 < wave) off += tv; }
        if (wave == 0) ((LAS float*)(lds + RW_GAM))[lane] = fexp(tot);
        float fR[8], fA[8], fB[8], fK[8];
        float eprev = fexp(off);
#pragma unroll
        for (int u = 0; u < 8; ++u) { const float cum = off + lc[u], e1 = fexp(cum), ei = frcp(e1); fR[u] = rr[u] * e1; fA[u] = av[u] * eprev; fB[u] = bv[u] * ei; fK[u] = km[u] * ei; eprev = e1; }
        LAS bf16* At = RBUF(0); LAS bf16* Bt = RBUF(1); LAS bf16* Kt = RBUF(2); LAS bf16* Rt = RBUF(3);
#pragma unroll
        for (int u = 0; u < 8; ++u) { const int o = (tt0 + u) * MS + lane; At[o] = (bf16)f2bf(fA[u]); Bt[o] = (bf16)f2bf(fB[u]); Kt[o] = (bf16)f2bf(fK[u]); Rt[o] = (bf16)f2bf(fR[u]); }
        *(LAS bf16x8_t*)(RBUF(4) + lane * MS + tt0) = pack8(fA); *(LAS bf16x8_t*)(RBUF(5) + lane * MS + tt0) = pack8(fB);
        *(LAS bf16x8_t*)(RBUF(6) + lane * MS + tt0) = pack8(fK); *(LAS bf16x8_t*)(RBUF(7) + lane * MS + tt0) = pack8(vv);
    }
    asm volatile("" ::: "memory");
    if (it + G < NIT) R1_PREFETCH(it + G);
    LDS_BARRIER();
    asm volatile("; MARK_R1_G");
    {
        const LAS bf16* At = RBUF(0); const LAS bf16* Bt = RBUF(1); const LAS bf16* Kt = RBUF(2); const LAS bf16* Rt = RBUF(3);
#pragma unroll
        for (int c = 0; c < 2; ++c) { const int ct = ct0 + c; const f32x4 z = (f32x4){0.f, 0.f, 0.f, 0.f};
            f32x4 aL = mm64(z, Bt, rt, At, ct, lane);
            f32x4 aLT = mm64(z, At, rt, Bt, ct, lane);
            f32x4 aAK = mm64(z, Kt, rt, At, ct, lane);
            f32x4 aRB = mm64(z, Bt, rt, Rt, ct, lane);
            f32x4 aRK = mm64(z, Kt, rt, Rt, ct, lane);
            const int col = 16 * ct + l15;
#pragma unroll
            for (int r = 0; r < 4; ++r) { const int row = 16 * rt + 4 * lg + r;
                if (!(row < col)) { aL[r] = 0.f; aAK[r] = 0.f; }
                if (!(col < row)) aLT[r] = 0.f;
                if (!(row <= col)) { aRB[r] = 0.f; aRK[r] = 0.f; } }
            tstore(RBUF(8), rt, ct, aL, lane); tstore(RBUF(9), rt, ct, aLT, lane); tstore(RBUF(10), rt, ct, aAK, lane); tstore(RBUF(11), rt, ct, aRB, lane); tstore(RBUF(12), rt, ct, aRK, lane);
        }
    }
    LDS_BARRIER();
    asm volatile("; MARK_R1_N");
    {
    {
        for (int e = tid; e < 64 * 16; e += NTHREADS) { const int row = e >> 4, c4 = (e & 15) * 4; v2u w = *(const LAS v2u*)(RBUF(8) + row * MS + c4);
            if ((row >> 2) == (c4 >> 2)) { const unsigned one = 0x3f80u; const int p = row & 3; if (p == 0) w.x = (w.x & 0xffff0000u) | one; else if (p == 1) w.x = (w.x & 0xffffu) | (one << 16); else if (p == 2) w.y = (w.y & 0xffff0000u) | one; else w.y = (w.y & 0xffffu) | (one << 16); }
            *(LAS v2u*)(RBUF(0) + row * MS + c4) = w; }
    }
#define RW_SQUARE(Min, MTin, Mout, MTout) do { _Pragma("unroll") for (int c = 0; c < 2; ++c) { const int ct = ct0 + c; const f32x4 z = (f32x4){0.f, 0.f, 0.f, 0.f}; \
        tstore(RBUF(Mout), rt, ct, mm64(z, RBUF(MTin), rt, RBUF(Min), ct, lane), lane);        \
        tstore(RBUF(MTout), rt, ct, mm64(z, RBUF(Min), rt, RBUF(MTin), ct, lane), lane); } } while (0)
#define RW_YSTEP(Yin, MTin, Yout) do { _Pragma("unroll") for (int c = 0; c < 2; ++c) { const int ct = ct0 + c; \
        const f32x4 y0 = ld4bf(RBUF(Yin) + (16 * ct + l15) * MS + 16 * rt + 4 * lg);            \
        tstore(RBUF(Yout), rt, ct, mm64(y0, RBUF(MTin), rt, RBUF(Yin), ct, lane), lane); } } while (0)
    RW_SQUARE(8, 9, 2, 13);
    LDS_BARRIER();
    RW_YSTEP(0, 13, 1); RW_SQUARE(2, 13, 8, 9);
    LDS_BARRIER();
    RW_YSTEP(1, 9, 0); RW_SQUARE(8, 9, 2, 13);
    LDS_BARRIER();
    RW_YSTEP(0, 13, 1); RW_SQUARE(2, 13, 8, 9);
    LDS_BARRIER();
    RW_YSTEP(1, 9, 0); RW_SQUARE(8, 9, 2, 13);
    LDS_BARRIER();
    RW_YSTEP(0, 13, 1);
    {
#pragma unroll
        for (int c = 0; c < 2; ++c) { const int ct = ct0 + c; tstore(RBUF(9), rt, ct, mm64((f32x4){0.f, 0.f, 0.f, 0.f}, RBUF(10), rt, RBUF(7), ct, lane), lane); }
    }
    LDS_BARRIER();
    }
#undef RW_SQUARE
#undef RW_YSTEP
    asm volatile("; MARK_R1_F1");
    {
    {
#pragma unroll
        for (int c = 0; c < 2; ++c) { const int ct = ct0 + c; const f32x4 z = (f32x4){0.f, 0.f, 0.f, 0.f};
            tstore(RBUF(8), rt, ct, mm64(z, RBUF(1), rt, RBUF(4), ct, lane), lane);
            tstore(RBUF(0), rt, ct, mm64(z, RBUF(1), rt, RBUF(9), ct, lane), lane); }
    }
    LDS_BARRIER();
    {
        const LAS float* GAM = (const LAS float*)(lds + RW_GAM);
#pragma unroll
        for (int c = 0; c < 2; ++c) { const int ct = ct0 + c; const f32x4 z = (f32x4){0.f, 0.f, 0.f, 0.f};
            const f32x4 r0 = ld4bf(RBUF(3) + (16 * ct + l15) * MS + 16 * rt + 4 * lg);
            tstore_g(item, rt, ct, mm64(r0, RBUF(8), rt, RBUF(11), ct, lane), lane);
            f32x4 pp = mm64(z, RBUF(8), rt, RBUF(5), ct, lane);
            const float gm = GAM[16 * ct + l15];
#pragma unroll
            for (int r = 0; r < 4; ++r) pp[r] = gm * (pp[r] + ((16 * rt + 4 * lg + r) == (16 * ct + l15) ? 1.f : 0.f));
            { const int jp = 16 * ct + l15, j0 = 16 * rt + 4 * lg;
              *(GAS v2u*)(item + 8192 + ((((jp >> 5) * 4 + (j0 >> 4)) * 64 + (jp & 31) + 32 * ((j0 >> 2) & 1)) * 8 + 4 * ((j0 >> 3) & 1))) = pack4(pp); }
            f32x4 y0 = mm64(z, RBUF(0), rt, RBUF(11), ct, lane); y0 = mm64(y0, RBUF(7), rt, RBUF(12), ct, lane);
            tstore_g(item + 4096, rt, ct, y0, lane);
            f32x4 q = mm64(z, RBUF(5), rt, RBUF(0), ct, lane); q = mm64(q, RBUF(6), rt, RBUF(7), ct, lane);
            const f32x4 g4 = *(const LAS f32x4*)(GAM + 16 * rt + 4 * lg);
            q = q * g4;
            { const int iv = 16 * ct + l15, j0 = 16 * rt + 4 * lg;
              *(GAS v2u*)(item + 12288 + (((((j0 >> 5) * 2 + (iv >> 5)) * 4 + ((j0 >> 3) & 3)) * 64 + (iv & 31) + 32 * ((j0 >> 2) & 1)) * 4)) = pack4(q); } }
    }
    LDS_BARRIER();
    }
    }
#undef R1_PREFETCH
}

__device__ __forceinline__ void rwkv_state_scan(ArgP A, int b, int h, int lane, bool do_store = true) {
    const int r32 = lane & 31, hi = lane >> 5;
    f32x16 St[2][2];
#pragma unroll
    for (int kb = 0; kb < 2; ++kb)
#pragma unroll
        for (int vb = 0; vb < 2; ++vb)
#pragma unroll
            for (int r = 0; r < 16; ++r) St[kb][vb][r] = 0.f;
    bf16* item0 = (bf16*)(A->ws + WS_RWI) + ((size_t)((b * 64) * 8 + h)) * 16384;
    v4u pfn[8]; v2u qn[16];
#define RW2_LOAD(nn) do { const bf16* it_ = item0 + (size_t)(nn) * 8 * 16384; \
        _Pragma("unroll") for (int f = 0; f < 8; ++f) pfn[f] = *(const GAS v4u*)(it_ + 8192 + (f * 64 + lane) * 8); \
        _Pragma("unroll") for (int f = 0; f < 16; ++f) qn[f] = *(const GAS v2u*)(it_ + 12288 + (f * 64 + lane) * 4); } while (0)
    RW2_LOAD(0);
#pragma unroll 1
    for (int n = 0; n < 64; ++n) {
        bf16* PM = item0 + (size_t)n * 8 * 16384 + 8192;
        a_bf16x8 pf[2][4]; f32x16 Nw[2][2];
#pragma unroll
        for (int f = 0; f < 8; ++f) pf[f >> 2][f & 3] = __builtin_bit_cast(a_bf16x8, pfn[f]);
#pragma unroll
        for (int kb = 0; kb < 2; ++kb)
#pragma unroll
            for (int vb = 0; vb < 2; ++vb)
#pragma unroll
                for (int g = 0; g < 4; ++g) { const v2u w = qn[(kb * 2 + vb) * 4 + g]; Nw[kb][vb][4 * g] = bflo(w.x); Nw[kb][vb][4 * g + 1] = bfhi(w.x); Nw[kb][vb][4 * g + 2] = bflo(w.y); Nw[kb][vb][4 * g + 3] = bfhi(w.y); }
#pragma unroll
        for (int kb = 0; kb < 2; ++kb)
#pragma unroll
            for (int vb = 0; vb < 2; ++vb)
#pragma unroll
                for (int g = 0; g < 4; ++g) { v2u w; w.x = cvtpk(St[kb][vb][4 * g], St[kb][vb][4 * g + 1]); w.y = cvtpk(St[kb][vb][4 * g + 2], St[kb][vb][4 * g + 3]);
                    if (do_store) *(GAS v2u*)(PM + ((((2 * vb + (r32 >> 4)) * 2 + kb) * 64 + g * 16 + (r32 & 15)) * 8 + 4 * hi)) = w; }
        if (n + 1 < 64) RW2_LOAD(n + 1);
        a_bf16x8 sf[4][2];
#pragma unroll
        for (int ks = 0; ks < 4; ++ks)
#pragma unroll
            for (int vb = 0; vb < 2; ++vb) { const int kb = ks >> 1, s8 = 8 * (ks & 1); v4u w; w.x = cvtpk(St[kb][vb][s8], St[kb][vb][s8 + 1]); w.y = cvtpk(St[kb][vb][s8 + 2], St[kb][vb][s8 + 3]);
                w.z = cvtpk(St[kb][vb][s8 + 4], St[kb][vb][s8 + 5]); w.w = cvtpk(St[kb][vb][s8 + 6], St[kb][vb][s8 + 7]); sf[ks][vb] = __builtin_bit_cast(a_bf16x8, w); }
#pragma unroll
        for (int kb = 0; kb < 2; ++kb)
#pragma unroll
            for (int vb = 0; vb < 2; ++vb) {
#pragma unroll
                for (int ks = 0; ks < 4; ++ks) Nw[kb][vb] = __builtin_amdgcn_mfma_f32_32x32x16_bf16(pf[kb][ks], sf[ks][vb], Nw[kb][vb], 0, 0, 0);
            }
#pragma unroll
        for (int kb = 0; kb < 2; ++kb)
#pragma unroll
            for (int vb = 0; vb < 2; ++vb) St[kb][vb] = Nw[kb][vb];
    }
#undef RW2_LOAD
}

__device__ __forceinline__ void rwkv_out_item(ArgP A, int L, int b, int n, int h, int ct, int lane, bool do_store = true) {
    const int i = L >> 1, l15 = lane & 15, lg = lane >> 4;
    const bf16* P = (const bf16*)(A->ws + WS_P); bf16* XNb = (bf16*)(A->ws + WS_XN); const float* BON = (const float*)(A->ws + WS_BON);
    const bf16* item = (const bf16*)(A->ws + WS_RWI) + ((size_t)((b * 64 + n) * 8 + h)) * 16384;
    const bf16* RH = item; const bf16* Y0 = item + 4096; const bf16* ST = item + 8192;
    const size_t row = (size_t)b * T + 64 * n + 16 * ct + l15; const int tseq = 64 * n + 16 * ct + l15;
    const bf16x8_t rf0 = *(const GAS bf16x8_t*)(RH + (16 * ct + l15) * 64 + 8 * lg), rf1 = *(const GAS bf16x8_t*)(RH + (16 * ct + l15) * 64 + 32 + 8 * lg);
    f32x4 acc[4]; float s1 = 0.f;
#pragma unroll
    for (int it = 0; it < 4; ++it) {
        f32x4 a = ld4bf_g(Y0 + (16 * ct + l15) * 64 + 16 * it + 4 * lg);
        a = mfma16(*(const GAS bf16x8_t*)(ST + ((it * 2 + 0) * 64 + lane) * 8), rf0, a);
        a = mfma16(*(const GAS bf16x8_t*)(ST + ((it * 2 + 1) * 64 + lane) * 8), rf1, a);
        acc[it] = a; s1 += (a[0] + a[1]) + (a[2] + a[3]);
    }
    s1 += __shfl_xor(s1, 16); s1 += __shfl_xor(s1, 32);
    const float mean = s1 * (1.f / 64.f); float s2 = 0.f;
#pragma unroll
    for (int it = 0; it < 4; ++it) { acc[it] = acc[it] - mean; s2 += (acc[it][0] * acc[it][0] + acc[it][1] * acc[it][1]) + (acc[it][2] * acc[it][2] + acc[it][3] * acc[it][3]); }
    s2 += __shfl_xor(s2, 16); s2 += __shfl_xor(s2, 32);
    const float rs = frsq(s2 * (1.f / 64.f) + 64e-5f);
    const float bon = BON[row * 8 + h];
    const float* lnw = A->in[20] + i * 512 + 64 * h; const float* lnb = A->in[21] + i * 512 + 64 * h; const float* mu = A->in[7] + (size_t)i * 1536 + 1024 + 64 * h;
    const bf16* pr = P + row * NIN_E + PC_V + 64 * h;
    f32x4 gq[4] = {(f32x4){0.f, 0.f, 0.f, 0.f}, (f32x4){0.f, 0.f, 0.f, 0.f}, (f32x4){0.f, 0.f, 0.f, 0.f}, (f32x4){0.f, 0.f, 0.f, 0.f}};
    { const bf16* G2T = (const bf16*)(A->ws + WS_G2T) + (size_t)(64 * h + l15) * 192 + 8 * lg; const bf16* prow = P + row * NIN_E;
#pragma unroll
      for (int q = 0; q < 5; ++q) { float x[8], y[8], v[8]; unpack8(*(const GAS v4u*)(prow + PC_G1A + 32 * q + 8 * lg), x);
          if (tseq > 0) unpack8(*(const GAS v4u*)(prow - NIN_E + PC_G1B + 32 * q + 8 * lg), y); else {
#pragma unroll
              for (int e = 0; e < 8; ++e) y[e] = 0.f; }
#pragma unroll
          for (int e = 0; e < 8; ++e) v[e] = sigmoid_f(x[e] + y[e]);
          const bf16x8_t fg = pack8(v);
#pragma unroll
          for (int it = 0; it < 4; ++it) gq[it] = mfma16(*(const GAS bf16x8_t*)(G2T + (size_t)(16 * it) * 192 + 32 * q), fg, gq[it]); } }
#pragma unroll
    for (int it = 0; it < 4; ++it) { const int i0 = 16 * it + 4 * lg;
        const f32x4 w4 = *(const GAS f32x4*)(lnw + i0), b4 = *(const GAS f32x4*)(lnb + i0), m4 = *(const GAS f32x4*)(mu + i0);
        const f32x4 pv = ld4bf_g(pr + i0); const f32x4 pvp = tseq > 0 ? ld4bf_g(pr - NIN_E + i0) : (f32x4){0.f, 0.f, 0.f, 0.f};
        const f32x4 v4 = pv + (pvp - pv) * m4;
        bf16* gp = XNb + row * D + 64 * h + i0; const f32x4 g4 = gq[it];
        const f32x4 o = ((acc[it] * rs) * w4 + b4 + v4 * bon) * g4;
        if (do_store) *(GAS v2u*)gp = pack4(o); }
}
constexpr size_t WS_GKV = 464 * MiB;
constexpr size_t WS_GDEC = 29 * MiB + 512 * 1024;
constexpr int GL_LA = 0, GL_KR = 16384, GL_VT = GL_KR + MB, GL_TOT = GL_VT + 2 * MB, GL1_END = GL_TOT + 2048;
static_assert(GL1_END <= RING_BYTES, "GLA LDS map");

template <int NCT> __device__ __forceinline__ void gla_lora_tiles(ArgP A, size_t rowb, int h4, int rt, int ct0, LAS float* LAs, int lane) {
    const int l15 = lane & 15, lg = lane >> 4;
    const bf16* P = (const bf16*)(A->ws + WS_P); const bf16* WA2T = (const bf16*)(A->ws + WS_WA2T);
    v4u av = (v4u){0u, 0u, 0u, 0u};
    if (lg < 2) av = *(const GAS v4u*)(P + (rowb + 16 * rt + l15) * NIN_E + PC_WA1 + 8 * lg);
    const bf16x8_t af = __builtin_bit_cast(bf16x8_t, av);
#pragma unroll
    for (int c = 0; c < NCT; ++c) { const int ct = ct0 + c;
        const f32x4 x = mfma16(af, *(const GAS bf16x8_t*)(WA2T + (size_t)(64 * h4 + 16 * ct + l15) * 32 + 8 * lg), (f32x4){0.f, 0.f, 0.f, 0.f});
#pragma unroll
        for (int r = 0; r < 4; ++r) LAs[(16 * rt + 4 * lg + r) * 64 + 16 * ct + l15] = x[r]; }
}

__device__ __forceinline__ void gla_kv_item(ArgP A, int L, int b, int n, int h4, LAS unsigned char* lds, int tid) {
    const int lane = tid & 63, wave = __builtin_amdgcn_readfirstlane(tid >> 6), i = L >> 1, l15 = lane & 15, lg = lane >> 4;
    const bf16* P = (const bf16*)(A->ws + WS_P);
    const size_t rowb = (size_t)b * T + 64 * n; const int itemi = (b * 64 + n) * 4 + h4;
    LAS float* LAs = (LAS float*)(lds + GL_LA); LAS bf16* KrT = (LAS bf16*)(lds + GL_KR); LAS bf16* VTm = (LAS bf16*)(lds + GL_VT); LAS float* TOT = (LAS float*)(lds + GL_TOT);
    gla_lora_tiles<2>(A, rowb, h4, wave >> 1, 2 * (wave & 1), LAs, lane);
    __syncthreads();
    {
        const int c = 64 * h4 + lane, tt0 = 8 * wave; const float bac = A->in[24][i * 256 + c];
        float lc[8], kx[8], qx[8], v0[8], v1[8]; float run = 0.f;
#pragma unroll
        for (int u = 0; u < 8; ++u) { const bf16* pr = P + (rowb + tt0 + u) * NIN_E; const float x = bac + LAs[(tt0 + u) * 64 + lane];
            run += -softplus_f(-x) * (1.0f / 16.0f); lc[u] = run; kx[u] = bf2f(pr[PC_GK + c]); qx[u] = bf2f(pr[PC_GQ + c]); v0[u] = bf2f(pr[PC_GV + 128 * h4 + lane]); v1[u] = bf2f(pr[PC_GV + 128 * h4 + 64 + lane]); }
        TOT[wave * 64 + lane] = run;
        __syncthreads();
        float off = 0.f, tot = 0.f;
#pragma unroll
        for (int w2 = 0; w2 < 8; ++w2) { const float tv = TOT[w2 * 64 + lane]; tot += tv; if (w2 < wave) off += tv; }
        if (wave == 0) ((float*)(A->ws + WS_GDEC))[itemi * 64 + lane] = fexp(tot);
        { bf16* Pw = (bf16*)(A->ws + WS_P); const float etot = fexp(tot);
#pragma unroll
          for (int u = 0; u < 8; ++u) { const float cum = off + lc[u], e1 = fexp(cum), kt = kx[u] * frcp(e1); bf16* pw = Pw + (rowb + tt0 + u) * NIN_E;
              pw[PC_GQ + c] = (bf16)f2bf(qx[u] * 0.125f * e1); pw[PC_GK + c] = (bf16)f2bf(kt); kx[u] = kt * etot; } }
        *(LAS bf16x8_t*)(KrT + lane * MS + tt0) = pack8(kx); *(LAS bf16x8_t*)(VTm + lane * MS + tt0) = pack8(v0); *(LAS bf16x8_t*)(VTm + (64 + lane) * MS + tt0) = pack8(v1);
    }
    __syncthreads();
    {
        bf16* KVg = (bf16*)(A->ws + WS_GKV) + (size_t)itemi * 8192; const int rt = wave >> 1;
#pragma unroll
        for (int c = 0; c < 4; ++c) { const int et = 4 * (wave & 1) + c;
            const f32x4 acc = mm64((f32x4){0.f, 0.f, 0.f, 0.f}, KrT, rt, VTm, et, lane);
            *(GAS v2u*)(KVg + (16 * et + l15) * 64 + 16 * rt + 4 * lg) = pack4(acc); }
    }
    __syncthreads();
}

__device__ __forceinline__ void gla_state_scan(ArgP A, int gt, bool do_store = true) {
    const int bh = gt >> 11, grp = gt & 2047;
    const int b = bh >> 2, h4 = bh & 3;
    bf16* base = (bf16*)(A->ws + WS_GKV) + (size_t)((b * 64) * 4 + h4) * 8192 + (size_t)grp * 4;
    const float* dec = (const float*)(A->ws + WS_GDEC) + (size_t)((b * 64) * 4 + h4) * 64 + (grp & 15) * 4;
    f32x4 S = (f32x4){0.f, 0.f, 0.f, 0.f};
#pragma unroll 1
    for (int n0 = 0; n0 < 64; n0 += 8) {
        v2u kv[8]; f32x4 dc[8];
#pragma unroll
        for (int u = 0; u < 8; ++u) { kv[u] = *(const GAS v2u*)(base + (size_t)(n0 + u) * 4 * 8192); dc[u] = *(const GAS f32x4*)(dec + (size_t)(n0 + u) * 4 * 64); }
#pragma unroll
        for (int u = 0; u < 8; ++u) { if (do_store) *(GAS v2u*)(base + (size_t)(n0 + u) * 4 * 8192) = pack4(S);
            S = S * dc[u] + (f32x4){bflo(kv[u].x), bfhi(kv[u].x), bflo(kv[u].y), bfhi(kv[u].y)}; }
    }
}

constexpr int G3B_SV = 272, G3B_VT = 0, G3B_SC = 64 * G3B_SV, G3B_GRP = G3B_SC + MB;
static_assert(2 * G3B_GRP <= RING_BYTES, "GLA phase-3 LDS map");
__device__ __forceinline__ void gla_out_group(ArgP A, int L, int item2, LAS unsigned char* lds, int tid) {
    const int lane = tid & 63, wave = __builtin_amdgcn_readfirstlane(tid >> 6), i = L >> 1, l15 = lane & 15, lg = lane >> 4;
    const int gi = wave >> 2, wq = wave & 3;
    const int itemi = 2 * item2 + gi, h4 = itemi & 3, n = (itemi >> 2) & 63, b = itemi >> 8;
    const bf16* P = (const bf16*)(A->ws + WS_P); bf16* XNb = (bf16*)(A->ws + WS_XN);
    const size_t rowb = (size_t)b * T + 64 * n;
    LAS unsigned char* gb = lds + gi * G3B_GRP; LAS bf16* SC = (LAS bf16*)(gb + G3B_SC);
    { const int t4 = tid & 255;
#pragma unroll
      for (int q = 0; q < 4; ++q) { const int id = t4 + 256 * q, row = id >> 4, ch = id & 15;
          *(LAS v4u*)(gb + G3B_VT + row * G3B_SV + ch * 16) = *(const GAS v4u*)(P + (rowb + row) * NIN_E + PC_GV + 128 * h4 + 8 * ch); } }
    const int ct = wq; const int col = 16 * ct + l15;
    const bf16* qrow = P + (rowb + col) * NIN_E + PC_GQ + 64 * h4 + 8 * lg;
    const bf16x8_t qf0 = *(const GAS bf16x8_t*)qrow, qf1 = *(const GAS bf16x8_t*)(qrow + 32);
#pragma unroll
    for (int rt = 0; rt < 4; ++rt) { f32x4 acc = (f32x4){0.f, 0.f, 0.f, 0.f};
        if (rt <= ct) { const bf16* krow = P + (rowb + 16 * rt + l15) * NIN_E + PC_GK + 64 * h4 + 8 * lg;
            acc = mfma16(*(const GAS bf16x8_t*)krow, qf0, acc); acc = mfma16(*(const GAS bf16x8_t*)(krow + 32), qf1, acc);
#pragma unroll
            for (int r = 0; r < 4; ++r) if (!((16 * rt + 4 * lg + r) <= col)) acc[r] = 0.f; }
        tstore(SC, rt, ct, acc, lane); }
    __syncthreads();
    const bf16* Sg = (const bf16*)(A->ws + WS_GKV) + (size_t)itemi * 8192;
    const int vto = G3B_VT + (8 * lg + (l15 >> 2)) * G3B_SV + 4 * (lane & 3) * 2;
    f32x4 o[8]; float ss = 0.f;
#pragma unroll
    for (int et = 0; et < 8; ++et) { f32x4 acc = (f32x4){0.f, 0.f, 0.f, 0.f};
#pragma unroll
        for (int ks = 0; ks < 2; ++ks) { const LAS unsigned char* vp = gb + vto + ks * 32 * G3B_SV + et * 32;
            const a_s16x4 lo4 = __builtin_bit_cast(a_s16x4, __builtin_amdgcn_ds_read_tr16_b64_v4i16((LAS a_s16x4*)vp));
            const a_s16x4 hi4 = __builtin_bit_cast(a_s16x4, __builtin_amdgcn_ds_read_tr16_b64_v4i16((LAS a_s16x4*)(vp + 4 * G3B_SV)));
            const bf16x8_t vf = (bf16x8_t){lo4[0], lo4[1], lo4[2], lo4[3], hi4[0], hi4[1], hi4[2], hi4[3]};
            acc = mfma16(vf, ldfrag(SC, 16 * ct, 32 * ks, lane), acc); }
        acc = mfma16(*(const GAS bf16x8_t*)(Sg + (16 * et + l15) * 64 + 8 * lg), qf0, acc);
        acc = mfma16(*(const GAS bf16x8_t*)(Sg + (16 * et + l15) * 64 + 32 + 8 * lg), qf1, acc);
        o[et] = acc; ss += (acc[0] * acc[0] + acc[1] * acc[1]) + (acc[2] * acc[2] + acc[3] * acc[3]); }
    ss += __shfl_xor(ss, 16); ss += __shfl_xor(ss, 32);
    const float rs = frsq(ss * (1.f / 128.f) + 1e-5f);
    const size_t row = rowb + col; const float* gn = A->in[25] + i * 512 + 128 * h4;
#pragma unroll
    for (int et = 0; et < 8; ++et) { const int e0 = 16 * et + 4 * lg; const f32x4 g4 = *(const GAS f32x4*)(gn + e0); const f32x4 gg = ld4bf_g(P + row * NIN_E + PC_GG + 128 * h4 + e0);
        f32x4 v = o[et] * rs * g4; v[0] *= silu_f(gg[0]); v[1] *= silu_f(gg[1]); v[2] *= silu_f(gg[2]); v[3] *= silu_f(gg[3]);
        *(GAS v2u*)(XNb + row * D + 512 + 128 * h4 + e0) = pack4(v); }
    __syncthreads();
}
constexpr int N_STEPS = 37;
#ifndef MK_ONE_LAUNCH
#define MK_ONE_LAUNCH 1
#endif
__global__ void __launch_bounds__(NTHREADS, 2) hybrid_fwd(Args args) {
    extern __shared__ __attribute__((aligned(16))) unsigned char lds_raw[];
    LAS unsigned char* lds = (LAS unsigned char*)lds_raw;
    ArgP A0 = (ArgP)__builtin_amdgcn_kernarg_segment_ptr();
    { const int tid = threadIdx.x; for (int u = tid; u < (LDS_BYTES - LDSCTL_OFF) / 4; u += NTHREADS) ((LAS unsigned*)(lds + LDSCTL_OFF))[u] = 0u; }
    __syncthreads();
    const int lo = A0->lo, hi = A0->hi;
    if (hi - lo > 1) (void)xcd_barrier_post((unsigned*)(A0->ws + WS_CTL) + CW_BAR, (volatile LAS unsigned*)(lds + MISC_OFF) + 8);
#ifndef PHM
#define PHM 0xff
#endif
#define RUN(s) (lo <= (s) && (s) < hi)
#define EN(b) ((PHM >> (b)) & 1)
#ifndef PROBE_REP
#define PROBE_REP 0
#endif
#define REP(b) _Pragma("unroll 1") for (int rep_ = 0; rep_ < (((PROBE_REP >> (b)) & 1) ? 2 : 1); ++rep_)
#ifndef PROBE_TMASK
#define PROBE_TMASK 0u
#endif
    int nbar_ = 0;
    if (PROBE_TMASK) { if (blockIdx.x == 0 && threadIdx.x == 0) ((unsigned long long*)((unsigned*)(A0->ws + WS_CTL) + 32768))[0] = __builtin_amdgcn_s_memrealtime(); }
#define GRID_BARRIER() do { ArgP Ab_ = FRESH_ARGS(); XcdBarrier b_; b_.bar = (unsigned*)(Ab_->ws + WS_CTL) + CW_BAR; b_.x = xb_xcc_id(); b_.st = (volatile LAS unsigned*)(lds + MISC_OFF) + 8; xcd_barrier(b_); if (PROBE_TMASK) { ++nbar_; if (blockIdx.x == 0 && threadIdx.x == 0) ((unsigned long long*)((unsigned*)(Ab_->ws + WS_CTL) + 32768))[nbar_] = __builtin_amdgcn_s_memrealtime(); } } while (0)
#define SEAM(s) do { if (RUN(s) && RUN((s) + 1)) GRID_BARRIER(); } while (0)
#define PHASE_VARS() ArgP A = FRESH_ARGS(); int L = Lq; FRESH_S(L); int tid = threadIdx.x; FRESH_V(tid); const int lane = tid & 63, wave = __builtin_amdgcn_readfirstlane(tid >> 6); int G = gridDim.x, bid = blockIdx.x; FRESH_S(G); FRESH_S(bid); (void)lane; (void)wave; (void)G; (void)A; (void)bid; \
    bf16* XN = (bf16*)(A->ws + WS_XN); bf16* PB = (bf16*)(A->ws + WS_P); (void)XN; (void)PB

#define BAR2(a, b) do { if (RUN(a) && RUN(b)) GRID_BARRIER(); } while (0)
    if (EN(0) && RUN(0)) REP(0) { int Lq = 0; PHASE_VARS(); const int gw = bid * NWAVES + wave, NGW = G * NWAVES;
        convert_mixer_weights(A, 0, lds, wave, lane, gw, NGW);
        float* ssq0 = (float*)(A->ws + WS_SSQ);
        for (int m = gw; m < M; m += NGW) x_to_bf16_ssq(A->in[0] + (size_t)m * D, (bf16*)A->out + (size_t)m * D, ssq0 + (size_t)m * 16, lane); }
    BAR2(0, 1);
    for (int Lq = 0; Lq < 4; ++Lq) {
        const int s0 = 9 * Lq; const bool even = !(Lq & 1);
        if (EN(1) && RUN(s0 + 1)) REP(1) {
            PHASE_VARS(); bf16* Win = (bf16*)(A->ws + WS_WIN); const float* ssq = (const float*)(A->ws + WS_SSQ);
            if (even) {
                pg8::Gemm g{(bf16*)A->out, Win, M, NIN_E, D}; pg8::StaticOrderC<M, NIN_E> S; S.init(G, bid);
                pg8::fill_row_scales(S, ssq, (LAS float*)(lds + RSTAB_OFF), tid);
                pg8::EpiStoreBf16 E{PB, NIN_E, 0, 1.0f, (const LAS float*)(lds + RSTAB_OFF)};
                pg8::gemm_phase<pg8::EpiStoreBf16, pg8::StaticOrderC<M, NIN_E>, PG8_ALIGN, PG8_SP2>(lds, g, S, E);
            } else {
                pg8::Gemm g{(bf16*)A->out, Win, M, NIN_O, D}; pg8::StaticOrderC<M, NIN_O> S; S.init(G, bid);
                pg8::fill_row_scales(S, ssq, (LAS float*)(lds + RSTAB_OFF), tid);
                pg8::EpiStoreBf16 E{PB, NIN_O, 4, 0.125f * 1.4426950408889634f, (const LAS float*)(lds + RSTAB_OFF)};
                pg8::gemm_phase<pg8::EpiStoreBf16, pg8::StaticOrderC<M, NIN_O>, PG8_ALIGN, PG8_SP2>(lds, g, S, E);
            }
        }
        if (even) {
            BAR2(s0 + 1, s0 + 2);
            if (EN(2) && RUN(s0 + 2)) REP(2) { PHASE_VARS();
                rwkv_chunk_phase(A, L, lds, tid, G, bid);
                REP(8) {
#pragma unroll 1
                for (int it = bid; it < BATCH * 64 * 4; it += G) gla_kv_item(A, L, it >> 8, (it >> 2) & 63, it & 3, lds, tid); } }
            BAR2(s0 + 2, s0 + 3);
            if (EN(3) && RUN(s0 + 3)) {
                PHASE_VARS();
                if (bid < 64) { if (wave == 0) rwkv_state_scan(A, bid >> 3, bid & 7, lane); }
                else { for (int gt = (bid - 64) * NTHREADS + tid; gt < 32 * 2048; gt += (G - 64) * NTHREADS) gla_state_scan(A, gt);
                       convert_ffn_weights(A, L, lds, wave, lane, (bid - 64) * NWAVES + wave, (G - 64) * NWAVES); }
            }
            BAR2(s0 + 3, s0 + 4);
            if (EN(3) && RUN(s0 + 4)) {
                PHASE_VARS();
                REP(9) {
#pragma unroll 1
                for (int i2 = bid; i2 < BATCH * 64 * 4 / 2; i2 += G) gla_out_group(A, L, i2, lds, tid); }
#pragma unroll 1
                for (int wt = bid * NWAVES + wave; wt < BATCH * 64 * 8 * 4; wt += G * NWAVES) { const int it = wt >> 2; rwkv_out_item(A, L, it >> 9, (it >> 3) & 63, it & 7, wt & 3, lane); }
            }
            BAR2(s0 + 4, s0 + 5);
        } else {
            BAR2(s0 + 1, s0 + 3);
            if (EN(4) && RUN(s0 + 3) && ((PROBE_REP >> 16) & 1)) { PHASE_VARS(); attn_phase_mfma<true>(A, L, lds, tid, G, bid); }
            if (EN(4) && RUN(s0 + 3)) REP(4) { PHASE_VARS(); attn_phase_mfma(A, L, lds, tid, G, bid); convert_ffn_weights(A, L, lds, wave, lane, bid * NWAVES + wave, G * NWAVES); }
            BAR2(s0 + 3, s0 + 5);
        }
        if (EN(5) && RUN(s0 + 5)) {
            PHASE_VARS(); bf16* Wout = (bf16*)(A->ws + WS_WOUT);
            pg8::Gemm g{XN, Wout, M, D, D}; pg8::StaticOrderC<M, D> S; S.init(G, bid);
            if ((PROBE_REP >> 5) & 1) { pg8::EpiResBf16<false, true> E0{(bf16*)A->out, D, (float*)(A->ws + WS_SSQ) + (size_t)M * 16, nullptr};
                pg8::gemm_phase<pg8::EpiResBf16<false, true>, pg8::StaticOrderC<M, D>, PG8_ALIGN, PG8_SP2>(lds, g, S, E0); }
            pg8::EpiResBf16<false> E{(bf16*)A->out, D, (float*)(A->ws + WS_SSQ) + (size_t)M * 16, nullptr};
            pg8::gemm_phase<pg8::EpiResBf16<false>, pg8::StaticOrderC<M, D>, PG8_ALIGN, PG8_SP2>(lds, g, S, E);
        }
        BAR2(s0 + 5, s0 + 7);
        if (EN(6) && RUN(s0 + 7)) REP(6) {
            PHASE_VARS(); bf16* Wgu = (bf16*)(A->ws + WS_WGU);
            pg8::Gemm g{(bf16*)A->out, Wgu, M, NGU, D}; pg8::StaticOrderC<M, NGU> S; S.init(G, bid);
            pg8::fill_row_scales(S, (const float*)(A->ws + WS_SSQ) + (size_t)M * 16, (LAS float*)(lds + RSTAB_OFF), tid);
            if ((PROBE_REP >> 15) & 1) { pg8::EpiSwigluT<true> E0{PB, FF, (const LAS float*)(lds + RSTAB_OFF)};
                pg8::gemm_phase<pg8::EpiSwigluT<true>, pg8::StaticOrderC<M, NGU>, PG8_ALIGN, PG8_SP2>(lds, g, S, E0); }
            pg8::EpiSwiglu E{PB, FF, (const LAS float*)(lds + RSTAB_OFF)};
            pg8::gemm_phase<pg8::EpiSwiglu, pg8::StaticOrderC<M, NGU>, PG8_ALIGN, PG8_SP2>(lds, g, S, E);
        }
        BAR2(s0 + 7, s0 + 8);
        if (EN(7) && RUN(s0 + 8)) {
            PHASE_VARS(); bf16* Wdn = (bf16*)(A->ws + WS_WDN);
            pg8::Gemm g{PB, Wdn, M, D, FF}; pg8::StaticOrderC<M, D> S; S.init(G, bid);
            if ((PROBE_REP >> 7) & 1) { pg8::EpiResBf16<false, true> E0{(bf16*)A->out, D, (float*)(A->ws + WS_SSQ), nullptr};
                pg8::gemm_phase<pg8::EpiResBf16<false, true>, pg8::StaticOrderC<M, D>, PG8_ALIGN, PG8_SP2>(lds, g, S, E0); }
            if (L < 3) { pg8::EpiResBf16<false> E{(bf16*)A->out, D, (float*)(A->ws + WS_SSQ), nullptr};
                pg8::gemm_phase<pg8::EpiResBf16<false>, pg8::StaticOrderC<M, D>, PG8_ALIGN, PG8_SP2>(lds, g, S, E);
                convert_mixer_weights(A, L + 1, lds, wave, lane, bid * NWAVES + wave, G * NWAVES); }
            else { pg8::EpiResBf16<true> E{(bf16*)A->out, D, (float*)(A->ws + WS_SSQ), XN};
                pg8::gemm_phase<pg8::EpiResBf16<true>, pg8::StaticOrderC<M, D>, PG8_ALIGN, PG8_SP2>(lds, g, S, E); }
        }
        BAR2(s0 + 8, Lq < 3 ? s0 + 10 : 36);
    }
    if (RUN(36)) {
        int Lq = 0; PHASE_VARS();
        const int gw = bid * NWAVES + wave, NGW = G * NWAVES;
        float pscale_ = 1.0f;
        if (PROBE_TMASK) { const unsigned long long* ts = (const unsigned long long*)((const unsigned*)(A->ws + WS_CTL) + 32768); unsigned long long acc_ = 0;
            for (int k = 1; k <= 25; ++k) if ((PROBE_TMASK >> k) & 1u) acc_ += ts[k] - ts[k - 1];
            pscale_ = 1.0f + __builtin_sqrtf((float)acc_ * 0.01f * 1e-4f); }
        for (int m = gw; m < M; m += NGW) rms_row_bf16_to_f32(XN + (size_t)m * D, A->in[4], A->out + (size_t)m * D, lane, pscale_);
    }
#undef RUN
#undef SEAM
}

extern "C" void kernel_launch(void* const* d_in, const int* in_sizes, int n_in, void* d_out, int out_size, void* d_ws, size_t ws_size, hipStream_t stream) {
    static int grid = 0;
    if (grid == 0) {
        if (n_in != 36 || in_sizes[0] != M * D || out_size != M * D || ws_size < WS_END) { fprintf(stderr, "kernel_launch: unexpected shapes (n_in %d, in0 %d, out %d, ws %zu); nothing launched\n", n_in, n_in > 0 ? in_sizes[0] : -1, out_size, ws_size); grid = -1; return; }
        int dev = 0, cus = 0, per_cu = 0;
        if (hipGetDevice(&dev) != hipSuccess || hipDeviceGetAttribute(&cus, hipDeviceAttributeMultiprocessorCount, dev) != hipSuccess) { grid = -1; return; }
        if (hipFuncSetAttribute((const void*)hybrid_fwd, hipFuncAttributeMaxDynamicSharedMemorySize, LDS_BYTES) != hipSuccess) { fprintf(stderr, "kernel_launch: hipFuncSetAttribute failed\n"); grid = -1; return; }
        if (hipOccupancyMaxActiveBlocksPerMultiprocessor(&per_cu, (const void*)hybrid_fwd, NTHREADS, LDS_BYTES) != hipSuccess || per_cu < 1) fprintf(stderr, "kernel_launch: occupancy query reports %d\n", per_cu);
        (void)hipGetLastError();
        if (cus < 128) { fprintf(stderr, "kernel_launch: built for a 256-CU device (phase 3 of the even layers needs more than 64 workgroups); nothing launched\n"); grid = -1; return; }
        grid = cus;
    }
    if (grid < 0) return;
    if (hipMemsetAsync((char*)d_ws + WS_CTL, 0, CTL_ZERO_BYTES, stream) != hipSuccess) return;
    Args a{};
    for (int i = 0; i < 36; ++i) a.in[i] = (const float*)d_in[i];
    a.out = (float*)d_out; a.ws = (unsigned char*)d_ws;
#if MK_ONE_LAUNCH
    a.lo = 0; a.hi = N_STEPS;
    hipLaunchKernelGGL(hybrid_fwd, dim3(grid), dim3(NTHREADS), LDS_BYTES, stream, a);
#else
    for (int s = 0; s < N_STEPS; ++s) {
        if (s < 36 && ((s % 9) == 2 || (s % 9) == 4) && ((s / 9) & 1)) continue;
        a.lo = s; a.hi = s + 1;
        hipLaunchKernelGGL(hybrid_fwd, dim3(grid), dim3(NTHREADS), LDS_BYTES, stream, a);
    }
#endif
}
```

```cpp
#include <hip/hip_runtime.h>
#include <cstdio>
#include <cstdint>
__device__ __forceinline__ float silu_f(float x) { return x * __builtin_amdgcn_rcpf(1.0f + __builtin_amdgcn_exp2f(-1.4426950408889634f * x)); }
namespace pg8 {
#define PG8_LAS __attribute__((address_space(3)))
typedef unsigned short bf16_t;
typedef short bf16x8 __attribute__((ext_vector_type(8)));
typedef float f32x4 __attribute__((ext_vector_type(4)));
typedef unsigned u32x4 __attribute__((ext_vector_type(4)));
constexpr int BM = 256, BK = 64, HALF = 128, HTB = HALF * BK * 2  , STAGE_BYTES = 8 * HTB, NXCD = 8, WGM = 4;

__host__ __device__ __forceinline__ int lds_byte(int r, int c) { const int st = (r >> 4) * 2 + (c >> 5), rr = r & 15, cc = c & 31, ob = rr * 64 + cc * 2; return st * 1024 + (ob ^ (((ob >> 9) & 1) << 5)); }
__host__ __device__ __forceinline__ void stage_rc(int b, int& R, int& C) { const int st = b / 1024, sb = b % 1024, swz = sb ^ (((sb >> 9) & 1) << 5); R = (st >> 1) * 16 + swz / 64; C = (st & 1) * 32 + (swz % 64) / 2; }
__host__ __device__ __forceinline__ int perm32(int rho) { const int n = rho >> 4, i = rho & 15; return 8 * (i >> 2) + 4 * n + (i & 3); }

struct Unit { int pm, pn, idx; };
struct Gemm { const bf16_t* A; const bf16_t* Bt; int M, N, K; };

struct StaticOrder {
    int nM, nN, nwg, G, c;
    __host__ __device__ void init(int M, int N, int G_, int c_) { nM = M / BM; nN = N / BM; nwg = nM * nN; G = G_; c = c_; }
    __host__ __device__ bool next(int i, Unit& u) const {
        const long L = (long)i * G + c; if (L >= nwg) return false;
        int wgid = (int)L; { const int q = nwg / NXCD, r = nwg % NXCD, xcd = wgid % NXCD, off = wgid / NXCD; wgid = (xcd < r ? xcd * (q + 1) : r * (q + 1) + (xcd - r) * q) + off; }
        const int nig = WGM * nN, gid = wgid / nig, fm = gid * WGM, gsz = (nM - fm) < WGM ? (nM - fm) : WGM;
        u.pm = fm + ((wgid % nig) % gsz); u.pn = (wgid % nig) / gsz; return true;
    }
    __device__ __forceinline__ void a_ready(const Unit&) const {}
    __device__ __forceinline__ void done(const Unit&) const {}
};

__device__ __forceinline__ unsigned cvt_pk_bf16(float lo, float hi) { unsigned r; asm volatile("v_cvt_pk_bf16_f32 %0, %1, %2" : "=v"(r) : "v"(lo), "v"(hi)); return r; }
typedef float f32x2 __attribute__((ext_vector_type(2)));
__device__ __forceinline__ float row_ssq(const float* ssq, int row) { const f32x4* p = (const f32x4*)(ssq + (size_t)row * 16); const f32x4 a = p[0], b = p[1], c = p[2], d = p[3];
    return (((a[0] + a[1]) + (a[2] + a[3])) + ((b[0] + b[1]) + (b[2] + b[3]))) + (((c[0] + c[1]) + (c[2] + c[3])) + ((d[0] + d[1]) + (d[2] + d[3]))); }
struct EpiStoreBf16 {
    static constexpr bool PERM = true, AFTER_DRAIN = false;
    bf16_t* O; int ldc; int qtiles; float qscale; const PG8_LAS float* rstab;
    __device__ __forceinline__ void operator()(const f32x4 (&acc)[2][2][4][2], const Unit& u, int wr, int wc, int fr, int fq) const {
        const int row0 = u.pm * BM + wr * 64 + fr, col0 = u.pn * BM + wc * 32 + 8 * fq;
        const float sc = u.pn < qtiles ? qscale : 1.0f;
        const PG8_LAS float* rt_ = rstab + u.idx * BM + wr * 64 + fr;
#pragma unroll
        for (int ai = 0; ai < 2; ++ai)
#pragma unroll
            for (int m = 0; m < 4; ++m) { const int row = row0 + ai * HALF + m * 16; bf16_t* rowp = O + (size_t)row * ldc + col0;
                const float rs = sc * rt_[ai * HALF + m * 16];
#pragma unroll
                for (int bj = 0; bj < 2; ++bj) { const f32x4 v0 = acc[ai][bj][m][0] * rs, v1 = acc[ai][bj][m][1] * rs;
                    u32x4 w; w.x = cvt_pk_bf16(v0[0], v0[1]); w.y = cvt_pk_bf16(v0[2], v0[3]); w.z = cvt_pk_bf16(v1[0], v1[1]); w.w = cvt_pk_bf16(v1[2], v1[3]);
                    *(u32x4*)(rowp + bj * HALF) = w; } }
    }
};
template <bool LAST, bool NOSTORE = false> struct EpiResBf16 {
    static constexpr bool PERM = false, AFTER_DRAIN = false;
    bf16_t* xr; int ldc; float* ssq; bf16_t* xf;
    __device__ __forceinline__ void operator()(const f32x4 (&acc)[2][2][4][2], const Unit& u, int wr, int wc, int fr, int fq) const {
        typedef unsigned u32x2 __attribute__((ext_vector_type(2)));
        const int row0 = u.pm * BM + wr * 64 + fr, col0 = u.pn * BM + wc * 32 + 4 * fq;
#pragma unroll
        for (int ai = 0; ai < 2; ++ai)
#pragma unroll
            for (int m = 0; m < 4; ++m) { const int row = row0 + ai * HALF + m * 16; const size_t off = (size_t)row * ldc + col0; float s = 0.f;
#pragma unroll
                for (int bj = 0; bj < 2; ++bj)
#pragma unroll
                    for (int n = 0; n < 2; ++n) { const u32x2 bw = *(const u32x2*)(xr + off + bj * HALF + n * 16);
                        const f32x4 b = (f32x4){__builtin_bit_cast(float, bw.x << 16), __builtin_bit_cast(float, bw.x & 0xffff0000u), __builtin_bit_cast(float, bw.y << 16), __builtin_bit_cast(float, bw.y & 0xffff0000u)};
                        const f32x4 v = b + acc[ai][bj][m][n];
                        s += (v[0] * v[0] + v[1] * v[1]) + (v[2] * v[2] + v[3] * v[3]);
                        u32x2 w; w.x = cvt_pk_bf16(v[0], v[1]); w.y = cvt_pk_bf16(v[2], v[3]); if (!NOSTORE) *(u32x2*)((LAST ? xf : xr) + off + bj * HALF + n * 16) = w; else asm volatile("" :: "v"(w.x), "v"(w.y)); }
                s += __shfl_xor(s, 16); s += __shfl_xor(s, 32);
                if (fq == 0 && !NOSTORE) ssq[(size_t)row * 16 + u.pn * 4 + wc] = s;
                if (m & 1) asm volatile("" ::: "memory"); }
    }
};
template <bool NOSTORE = false> struct EpiSwigluT {
    static constexpr bool PERM = true, AFTER_DRAIN = false;
    bf16_t* H; int ldc; const PG8_LAS float* rstab;
    __device__ __forceinline__ void operator()(const f32x4 (&acc)[2][2][4][2], const Unit& u, int wr, int wc, int fr, int fq) const {
        const int row0 = u.pm * BM + wr * 64 + fr, colh = u.pn * HALF + wc * 32 + 8 * fq;
        const PG8_LAS float* rt_ = rstab + u.idx * BM + wr * 64 + fr;
#pragma unroll
        for (int ai = 0; ai < 2; ++ai)
#pragma unroll
            for (int m = 0; m < 4; ++m) { const int row = row0 + ai * HALF + m * 16; bf16_t* rowp = H + (size_t)row * ldc + colh;
                const float rs = rt_[ai * HALF + m * 16];
                const f32x4 g0 = acc[ai][0][m][0] * rs, g1 = acc[ai][0][m][1] * rs, u0 = acc[ai][1][m][0] * rs, u1 = acc[ai][1][m][1] * rs;
                float h[8];
#pragma unroll
                for (int e = 0; e < 4; ++e) { h[e] = silu_f(g0[e]) * u0[e]; h[4 + e] = silu_f(g1[e]) * u1[e]; }
                u32x4 w; w.x = cvt_pk_bf16(h[0], h[1]); w.y = cvt_pk_bf16(h[2], h[3]); w.z = cvt_pk_bf16(h[4], h[5]); w.w = cvt_pk_bf16(h[6], h[7]);
                if (!NOSTORE) *(u32x4*)rowp = w; else asm volatile("" :: "v"(w.x), "v"(w.y), "v"(w.z), "v"(w.w)); }
    }
};
typedef EpiSwigluT<false> EpiSwiglu;
struct EpiNull {
    static constexpr bool PERM = true, AFTER_DRAIN = false;
    __device__ __forceinline__ void operator()(const f32x4 (&acc)[2][2][4][2], const Unit& u, int wr, int wc, int fr, int fq) const {
#pragma unroll
        for (int ai = 0; ai < 2; ++ai)
#pragma unroll
            for (int bj = 0; bj < 2; ++bj)
#pragma unroll
                for (int m = 0; m < 4; ++m)
#pragma unroll
                    for (int n = 0; n < 2; ++n) asm volatile("" :: "v"(acc[ai][bj][m][n]));
    }
};
template <int M_, int N_> struct StaticOrderC {
    static constexpr int nM = M_ / BM, nN = N_ / BM, nwg = nM * nN;
    int G, c;
    __device__ __forceinline__ void init(int G_, int c_) { G = G_; c = c_; }
    __device__ __forceinline__ bool next(int i, Unit& u) const {
        const int L = i * G + c; if (L >= nwg) return false;
        int wgid = L; { constexpr int q = nwg / NXCD, r = nwg % NXCD; const int xcd = wgid % NXCD, off = wgid / NXCD; wgid = (xcd < r ? xcd * (q + 1) : r * (q + 1) + (xcd - r) * q) + off; }
        constexpr int nig = WGM * nN; const int gid = wgid / nig, fm = gid * WGM, gsz = (nM - fm) < WGM ? (nM - fm) : WGM;
        u.pm = fm + ((wgid % nig) % gsz); u.pn = (wgid % nig) / gsz; u.idx = i; return true;
    }
    __device__ __forceinline__ void a_ready(const Unit&) const {}
    __device__ __forceinline__ void done(const Unit&) const {}
};
template <class Sched> __device__ __forceinline__ void fill_row_scales(const Sched& S, const float* ssq, PG8_LAS float* tab, int tid) {
    Unit u; const int r = tid >> 1, hf = tid & 1;
    for (int i = 0; S.next(i, u); ++i) { const f32x4* p = (const f32x4*)(ssq + (size_t)(u.pm * BM + r) * 16 + hf * 8); const f32x4 a = p[0], b = p[1];
        float sum = ((a[0] + a[1]) + (a[2] + a[3])) + ((b[0] + b[1]) + (b[2] + b[3])); sum += __shfl_xor(sum, 1);
        if (hf == 0) tab[i * BM + r] = __builtin_amdgcn_rsqf(sum * (1.0f / 1024.0f) + 1e-6f); }
    __syncthreads();
}
template <class Epi, class Sched, bool ALIGN_EPI = false, bool SP2 = false>
__device__ __forceinline__ void gemm_phase(PG8_LAS unsigned char* lds, const Gemm g, const Sched& S, const Epi& E) {
    int tid_ = threadIdx.x; asm volatile("" : "+v"(tid_));
    float zz_ = 0.f; asm volatile("" : "+v"(zz_));
    const int tid = tid_, wid = __builtin_amdgcn_readfirstlane(tid >> 6), lane = tid & 63, wr = wid >> 2, wc = wid & 3, fr = lane & 15, fq = lane >> 4;
    const int K = g.K, nt = K / BK;
    unsigned voffA[2], voffB[2];
#pragma unroll
    for (int i = 0; i < 2; ++i) { int R, C; stage_rc(tid * 16 + i * 8192, R, C); const int Rb = Epi::PERM ? ((R & ~31) + perm32(R & 31)) : R;
        voffA[i] = (unsigned)(R * K + C) * 2u; voffB[i] = (unsigned)(Rb * K + C) * 2u; }
    const size_t kstep = (size_t)(BK * 2);
    const size_t hstep = (size_t)HALF * K * 2;
    const size_t tstep = 2 * hstep;
    const unsigned ldsw = (unsigned)wid * 1024u;
    const int aoff = lds_byte(wr * 64 + fr, fq * 8), boff = lds_byte(wc * 32 + fr, fq * 8);
#define PG8_SA(b, h) (((b) * 2 + (h)) * HTB)
#define PG8_SB(b, h) ((4 + (b) * 2 + (h)) * HTB)
#define PG8_STAGE(bufoff, gbase, voff) do { _Pragma("unroll") for (int _i = 0; _i < 2; ++_i) \
        __builtin_amdgcn_global_load_lds((const unsigned*)((const char*)(gbase) + (voff)[_i]), (PG8_LAS unsigned*)(lds + (bufoff) + ldsw + _i * 8192), 16, 0, 0); } while (0)
#define PG8_LDA(dst, b, h) do { _Pragma("unroll") for (int m = 0; m < 4; ++m) _Pragma("unroll") for (int k = 0; k < 2; ++k) dst[m][k] = *(const PG8_LAS bf16x8*)(lds + PG8_SA(b, h) + aoff + m * 2048 + k * 1024); } while (0)
#define PG8_LDB(dst, b, h) do { _Pragma("unroll") for (int n = 0; n < 2; ++n) _Pragma("unroll") for (int k = 0; k < 2; ++k) dst[n][k] = *(const PG8_LAS bf16x8*)(lds + PG8_SB(b, h) + boff + n * 2048 + k * 1024); } while (0)
#define PG8_MMA(ai, bj, At, Bt) do { __builtin_amdgcn_s_setprio(1); _Pragma("unroll") for (int m = 0; m < 4; ++m) _Pragma("unroll") for (int n = 0; n < 2; ++n) _Pragma("unroll") for (int k = 0; k < 2; ++k) \
        acc[ai][bj][m][n] = __builtin_amdgcn_mfma_f32_16x16x32_bf16(Bt[n][k], At[m][k], acc[ai][bj][m][n], 0, 0, 0); __builtin_amdgcn_s_setprio(0); } while (0)
#define PG8_WAIT_V(n) asm volatile("s_waitcnt vmcnt(" #n ")" ::: "memory")
#define PG8_WAIT_L(n) asm volatile("s_waitcnt lgkmcnt(" #n ")" ::: "memory")
#define PG8_BAR __builtin_amdgcn_s_barrier()
#define PG8_SCHED __builtin_amdgcn_sched_barrier(0)
    Unit cur, nxt; int ui = 0;
    if (!S.next(0, cur)) return;
    f32x4 acc[2][2][4][2];
#pragma unroll
    for (int a = 0; a < 2; ++a)
#pragma unroll
        for (int b = 0; b < 2; ++b)
#pragma unroll
            for (int m = 0; m < 4; ++m)
#pragma unroll
                for (int n = 0; n < 2; ++n) acc[a][b][m][n] = (f32x4){zz_, zz_, zz_, zz_};
    bf16x8 At[4][2], B0[2][2], B1[2][2];
    const char* cA = (const char*)g.A + (size_t)cur.pm * tstep; const char* cB = (const char*)g.Bt + (size_t)cur.pn * tstep;
    S.a_ready(cur);
    if constexpr (SP2) {
        PG8_STAGE(PG8_SB(0, 0), cB, voffB); PG8_STAGE(PG8_SB(0, 1), cB + hstep, voffB); PG8_STAGE(PG8_SA(0, 0), cA, voffA); PG8_STAGE(PG8_SA(0, 1), cA + hstep, voffA);
        if (wr == 1) PG8_BAR;
        PG8_WAIT_V(2); PG8_BAR;
        PG8_STAGE(PG8_SB(1, 0), cB + kstep, voffB); PG8_STAGE(PG8_SA(1, 0), cA + kstep, voffA); PG8_STAGE(PG8_SB(1, 1), cB + hstep + kstep, voffB);
        PG8_WAIT_V(6); PG8_BAR;
    } else {
        PG8_STAGE(PG8_SB(0, 0), cB, voffB); PG8_STAGE(PG8_SA(0, 0), cA, voffA); PG8_STAGE(PG8_SB(0, 1), cB + hstep, voffB); PG8_STAGE(PG8_SA(0, 1), cA + hstep, voffA);
        if (wr == 1) PG8_BAR;
        PG8_WAIT_V(4); PG8_BAR;
        PG8_STAGE(PG8_SB(1, 0), cB + kstep, voffB); PG8_STAGE(PG8_SA(1, 0), cA + kstep, voffA); PG8_STAGE(PG8_SB(1, 1), cB + hstep + kstep, voffB);
        PG8_WAIT_V(6); PG8_BAR;
    }
    for (;;) {
        const bool has_next = S.next(ui + 1, nxt);
        const char* nA = has_next ? (const char*)g.A + (size_t)nxt.pm * tstep : cA; const char* nB = has_next ? (const char*)g.Bt + (size_t)nxt.pn * tstep : cB;
        for (int t = 0; t < nt; t += 2) {
            const bool last = (t == nt - 2);
            const char* a1 = cA + (size_t)(t + 1) * kstep;
            const char* a2 = last ? nA : cA + (size_t)(t + 2) * kstep; const char* b2 = last ? nB : cB + (size_t)(t + 2) * kstep;
            const char* a3 = a2 + kstep; const char* b3 = b2 + kstep;
            if (last && has_next) S.a_ready(nxt);
            if constexpr (SP2) {
            PG8_LDB(B0, 0, 0); PG8_LDB(B1, 0, 1); PG8_SCHED; PG8_LDA(At, 0, 0); PG8_STAGE(PG8_SA(1, 1), a1 + hstep, voffA);
            PG8_WAIT_V(8); PG8_WAIT_L(0); PG8_BAR; PG8_MMA(0, 0, At, B0); PG8_MMA(0, 1, At, B1); PG8_BAR; PG8_SCHED;
            PG8_LDA(At, 0, 1); PG8_STAGE(PG8_SB(0, 0), b2, voffB); PG8_STAGE(PG8_SB(0, 1), b2 + hstep, voffB); PG8_STAGE(PG8_SA(0, 0), a2, voffA);
            PG8_WAIT_V(8); PG8_WAIT_L(0); PG8_BAR; PG8_MMA(1, 0, At, B0); PG8_MMA(1, 1, At, B1); PG8_BAR; PG8_SCHED;
            PG8_LDB(B0, 1, 0); PG8_LDB(B1, 1, 1); PG8_SCHED; PG8_LDA(At, 1, 0); PG8_STAGE(PG8_SA(0, 1), a2 + hstep, voffA);
            PG8_WAIT_V(8); PG8_WAIT_L(0); PG8_BAR; PG8_MMA(0, 0, At, B0); PG8_MMA(0, 1, At, B1); PG8_BAR; PG8_SCHED;
            PG8_LDA(At, 1, 1); PG8_STAGE(PG8_SB(1, 0), b3, voffB); PG8_STAGE(PG8_SB(1, 1), b3 + hstep, voffB); PG8_STAGE(PG8_SA(1, 0), a3, voffA);
            PG8_WAIT_V(8); PG8_WAIT_L(0); PG8_BAR; PG8_MMA(1, 0, At, B0); PG8_MMA(1, 1, At, B1); PG8_BAR; PG8_SCHED;
            } else {
            PG8_LDB(B0, 0, 0); PG8_SCHED; PG8_LDA(At, 0, 0); PG8_STAGE(PG8_SA(1, 1), a1 + hstep, voffA);
            PG8_WAIT_L(8); PG8_BAR; PG8_WAIT_L(0); PG8_MMA(0, 0, At, B0); PG8_BAR; PG8_SCHED;
            PG8_LDB(B1, 0, 1); PG8_STAGE(PG8_SB(0, 0), b2, voffB);
            PG8_BAR; PG8_WAIT_L(0); PG8_MMA(0, 1, At, B1); PG8_BAR;
            PG8_LDA(At, 0, 1); PG8_STAGE(PG8_SA(0, 0), a2, voffA);
            PG8_BAR; PG8_WAIT_L(0); PG8_MMA(1, 0, At, B0); PG8_BAR; PG8_SCHED;
            PG8_STAGE(PG8_SB(0, 1), b2 + hstep, voffB);
            PG8_WAIT_V(6); PG8_BAR; PG8_MMA(1, 1, At, B1); PG8_BAR;
            PG8_LDB(B0, 1, 0); PG8_SCHED; PG8_LDA(At, 1, 0); PG8_STAGE(PG8_SA(0, 1), a2 + hstep, voffA);
            PG8_WAIT_L(8); PG8_BAR; PG8_WAIT_L(0); PG8_MMA(0, 0, At, B0); PG8_BAR; PG8_SCHED;
            PG8_LDB(B1, 1, 1); PG8_STAGE(PG8_SB(1, 0), b3, voffB);
            PG8_BAR; PG8_WAIT_L(0); PG8_MMA(0, 1, At, B1); PG8_BAR;
            PG8_LDA(At, 1, 1); PG8_STAGE(PG8_SA(1, 0), a3, voffA);
            PG8_BAR; PG8_WAIT_L(0); PG8_MMA(1, 0, At, B0); PG8_BAR; PG8_SCHED;
            PG8_STAGE(PG8_SB(1, 1), b3 + hstep, voffB);
            PG8_WAIT_V(6); PG8_BAR; PG8_MMA(1, 1, At, B1); PG8_BAR;
            }
        }
        if constexpr (ALIGN_EPI) { if (wr == 0) PG8_BAR; }
        if constexpr (!Epi::AFTER_DRAIN) { E(acc, cur, wr, wc, fr, fq); S.done(cur); }
        if (!has_next) break;
#pragma unroll
        for (int a = 0; a < 2; ++a)
#pragma unroll
            for (int b = 0; b < 2; ++b)
#pragma unroll
                for (int m = 0; m < 4; ++m)
#pragma unroll
                    for (int n = 0; n < 2; ++n) acc[a][b][m][n] = (f32x4){zz_, zz_, zz_, zz_};
        cur = nxt; cA = nA; cB = nB; ++ui;
        if constexpr (ALIGN_EPI) { if (wr == 1) PG8_BAR; }
    }
    PG8_WAIT_V(0);
    if constexpr (!ALIGN_EPI) { if (wr == 0) PG8_BAR; }
    PG8_BAR;
    if constexpr (Epi::AFTER_DRAIN) { E.fused(acc, cur, wr, wc, fr, fq, lds, wid, lane); S.done(cur); }
#undef PG8_SA
#undef PG8_SB
#undef PG8_STAGE
#undef PG8_LDA
#undef PG8_LDB
#undef PG8_MMA
#undef PG8_WAIT_V
#undef PG8_WAIT_L
#undef PG8_BAR
#undef PG8_SCHED
}
}
#ifndef PG8_SP2
#define PG8_SP2 true
#endif
#ifndef PG8_ALIGN
#define PG8_ALIGN true
#endif
constexpr int NWAVES = 8, NTHREADS = NWAVES * 64;
constexpr int BATCH = 8, T = 4096, D = 1024, M = BATCH * T;
constexpr int NIN_E = 3840, NIN_O = 3072, FF = 2816, NGU = 2 * FF;
constexpr int PC_R = 0, PC_K = 512, PC_V = 1024, PC_GQ = 1536, PC_GK = 1792, PC_GV = 2048, PC_GG = 2560;
constexpr int PC_W1A = 3072, PC_W1B = 3136, PC_A1A = 3200, PC_A1B = 3264, PC_G1A = 3328, PC_G1B = 3488, PC_WA1 = 3648, PC_PAD = 3664;
constexpr int NLORA = 304;
constexpr size_t MiB = 1u << 20;
constexpr size_t WS_CTL = 0, CTL_ZERO_BYTES = 1 * MiB;
constexpr size_t WS_WIN = 2 * MiB, WS_WOUT = 10 * MiB, WS_WGU = 12 * MiB, WS_WDN = 23 * MiB;
constexpr size_t WS_W2T = 29 * MiB, WS_A2T = WS_W2T + 65536, WS_G2T = WS_A2T + 65536, WS_WA2T = WS_G2T + 196608;
constexpr size_t WS_SSQ = 496 * MiB;
constexpr size_t WS_XFIN = 336 * MiB;
constexpr size_t WS_XN = 32 * MiB;
constexpr size_t WS_P = 96 * MiB;
constexpr size_t WS_END = 500 * MiB;
constexpr int CW_BAR = 4096;
constexpr int RING_BYTES = 135168, LDS_BYTES = 163840, LDSCTL_OFF = LDS_BYTES - 1024, MISC_OFF = LDSCTL_OFF + 320, RSTAB_OFF = RING_BYTES + 448;

#define GAS __attribute__((address_space(1)))
#define LAS __attribute__((address_space(3)))
typedef unsigned short bf16;
typedef unsigned v4u __attribute__((ext_vector_type(4)));
typedef unsigned v2u __attribute__((ext_vector_type(2)));
typedef float f32x4 __attribute__((ext_vector_type(4)));
#define LDS_WAIT() asm volatile("s_waitcnt lgkmcnt(0)" ::: "memory")
#define VM_WAIT() asm volatile("s_waitcnt vmcnt(0)" ::: "memory")
#define LDS_BARRIER() do { asm volatile("s_waitcnt lgkmcnt(0)\n\ts_barrier" ::: "memory"); } while (0)
__device__ __forceinline__ unsigned f2bf(float f) { unsigned u = __builtin_bit_cast(unsigned, f); return (u + 0x7fffu + ((u >> 16) & 1u)) >> 16; }
__device__ __forceinline__ unsigned pk2(float lo, float hi) { return f2bf(lo) | (f2bf(hi) << 16); }
__device__ __forceinline__ float bf2f(bf16 u) { return __builtin_bit_cast(float, (unsigned)u << 16); }
__device__ __forceinline__ float bflo(unsigned w) { return __builtin_bit_cast(float, w << 16); }
__device__ __forceinline__ float bfhi(unsigned w) { return __builtin_bit_cast(float, w & 0xffff0000u); }
__device__ __forceinline__ float wave_sum(float v) {
#define WS_DPP(x, ctrl, rmask) __builtin_bit_cast(float, __builtin_amdgcn_update_dpp(0, __builtin_bit_cast(int, x), ctrl, rmask, 0xf, true))
    v += WS_DPP(v, 0x111, 0xf);
    v += WS_DPP(v, 0x112, 0xf);
    v += WS_DPP(v, 0x114, 0xf);
    v += WS_DPP(v, 0x118, 0xf);
    v += WS_DPP(v, 0x142, 0xa);
    v += WS_DPP(v, 0x143, 0xc);
#undef WS_DPP
    return __builtin_bit_cast(float, __builtin_amdgcn_readlane(__builtin_bit_cast(int, v), 63));
}
__device__ __forceinline__ float wave_max(float v) {
#pragma unroll
    for (int o = 1; o < 64; o <<= 1) v = fmaxf(v, __shfl_xor(v, o));
    return v;
}
__device__ __forceinline__ float fexp(float x) { return __builtin_amdgcn_exp2f(x * 1.4426950408889634f); }
__device__ __forceinline__ float flog(float x) { return __builtin_amdgcn_logf(x) * 0.6931471805599453f; }
__device__ __forceinline__ float frcp(float x) { return __builtin_amdgcn_rcpf(x); }
__device__ __forceinline__ float frsq(float x) { return __builtin_amdgcn_rsqf(x); }
__device__ __forceinline__ float fsqrt(float x) { return __builtin_amdgcn_sqrtf(x); }
__device__ __forceinline__ float sigmoid_f(float x) { return frcp(1.0f + fexp(-x)); }
__device__ __forceinline__ float softplus_f(float x) { return fmaxf(x, 0.f) + flog(1.0f + fexp(-fabsf(x))); }
__device__ __forceinline__ float tanh_f(float x) { return 1.0f - 2.0f * frcp(1.0f + fexp(2.0f * x)); }
#define XB_TMO      128
#define XB_XCNT(j)  (256  + 64 * (j))
#define XB_XSUB(j)  (1280 + 64 * (j))
#define XB_XGEN(j)  (2304 + 64 * (j))
#define XB_TOP      3328
#define XB_TOPGEN   3392
#define XCD_BAR_WORDS 3456
#define XB_SPIN_CAP (1u << 23)

__device__ __forceinline__ unsigned xb_ld(unsigned* p)              { return __hip_atomic_load(p, __ATOMIC_RELAXED, __HIP_MEMORY_SCOPE_AGENT); }
__device__ __forceinline__ unsigned xb_add(unsigned* p, unsigned v) { return __hip_atomic_fetch_add(p, v, __ATOMIC_RELAXED, __HIP_MEMORY_SCOPE_AGENT); }
__device__ __forceinline__ unsigned xb_xcc_id() { return (unsigned)__builtin_amdgcn_s_getreg((3 << 11) | 20) & 0xFu; }
#define XB_SPIN(cond, bar) do { unsigned _sp = 0; while (cond) { __builtin_amdgcn_s_sleep(1); \
    if ((++_sp & 255u) == 0u) { if (xb_ld(&(bar)[XB_TMO])) break; if (_sp > XB_SPIN_CAP) { atomicAdd(&(bar)[XB_TMO], 1u); break; } } } } while (0)

struct XcdBarrier {
    unsigned* bar; unsigned x;
    volatile LAS unsigned* st;
};

__device__ __forceinline__ XcdBarrier xcd_barrier_post(unsigned* bar, volatile LAS unsigned* st) {
    XcdBarrier b; b.bar = bar; b.x = xb_xcc_id(); b.st = st;
    if (threadIdx.x == 0) (void)xb_add(&bar[XB_XCNT(b.x)], 1u);
    return b;
}
__device__ __forceinline__ void xcd_barrier_complete(unsigned* bar, unsigned x, unsigned& nloc, unsigned& nx) {
    const unsigned G = gridDim.x * gridDim.y * gridDim.z;
    unsigned sum, cnt, mine, sp = 0u;
    for (;;) {
        sum = 0u; cnt = 0u; mine = 0u;
#pragma unroll
        for (unsigned j = 0; j < 16; ++j) { const unsigned c = xb_ld(&bar[XB_XCNT(j)]); sum += c; cnt += (c > 0u) ? 1u : 0u; mine = (j == x) ? c : mine; }
        if (sum == G) break;
        __builtin_amdgcn_s_sleep(1);
        if ((++sp & 255u) == 0u) { if (xb_ld(&bar[XB_TMO])) break; if (sp > XB_SPIN_CAP) { atomicAdd(&bar[XB_TMO], 1u); break; } }
    }
    nloc = mine > 0u ? mine : 1u; nx = cnt > 0u ? cnt : 1u;
}

__device__ __forceinline__ void xcd_barrier(const XcdBarrier& b) {
    asm volatile("s_waitcnt vmcnt(0)" ::: "memory");
    __syncthreads();
    if (threadIdx.x == 0) {
        unsigned blo_ = __builtin_amdgcn_readfirstlane((unsigned)(unsigned long long)b.bar), bhi_ = __builtin_amdgcn_readfirstlane((unsigned)((unsigned long long)b.bar >> 32)), bx = __builtin_amdgcn_readfirstlane(b.x); asm volatile("" : "+s"(blo_), "+s"(bhi_), "+s"(bx)); unsigned* bar = (unsigned*)(((unsigned long long)bhi_ << 32) | blo_);
        __builtin_amdgcn_s_waitcnt(0);
        unsigned nloc = b.st[0], nx = b.st[1];
        if (nloc == 0u) { xcd_barrier_complete(bar, bx, nloc, nx); b.st[0] = nloc; b.st[1] = nx; }
        const unsigned old = xb_add(&bar[XB_XSUB(bx)], 1u);
        const unsigned gen = old / nloc;
        if (old + 1u == (gen + 1u) * nloc) {
            __builtin_amdgcn_fence(__ATOMIC_RELEASE, "agent");
            asm volatile("s_waitcnt vmcnt(0)" ::: "memory");
            const unsigned og = xb_add(&bar[XB_TOP], 1u);
            const unsigned tg = og / nx;
            if (og + 1u == (tg + 1u) * nx) xb_add(&bar[XB_TOPGEN], 1u);
            else XB_SPIN(xb_ld(&bar[XB_TOPGEN]) == tg, bar);
            __builtin_amdgcn_fence(__ATOMIC_ACQUIRE, "agent");
            xb_add(&bar[XB_XGEN(bx)], 1u);
            asm volatile("s_waitcnt vmcnt(0)" ::: "memory");
        } else {
            XB_SPIN(xb_ld(&bar[XB_XGEN(bx)]) == gen, bar);
            __builtin_amdgcn_fence(__ATOMIC_ACQUIRE, "agent");
            asm volatile("s_waitcnt vmcnt(0)" ::: "memory");
        }
    }
    __syncthreads();
}
__device__ __forceinline__ void tr_item(const float* __restrict__ W, int Kreal, int N, bf16* WT, int ldd, int dst_row0, LAS float* scr, int k0, int n0, int lane,
                                        const float* __restrict__ mu, float sc0, float sc1, const float* __restrict__ gk = nullptr) {
    const int rr = lane >> 3, c4 = lane & 7, nn = n0 + 4 * c4; const bool nv = nn < N;
#pragma unroll
    for (int i = 0; i < 8; ++i) { const int kk = 8 * i + rr; f32x4 v = (nv && k0 + kk < Kreal) ? *(const GAS f32x4*)(W + (size_t)(k0 + kk) * N + nn) : (f32x4){0.f, 0.f, 0.f, 0.f};
        float sc = 1.0f; if (mu) sc = sc0 + sc1 * mu[k0 + kk]; if (gk) sc *= gk[k0 + kk]; v = v * sc;
        LAS float* d = scr + kk * 33 + 4 * c4; d[0] = v.x; d[1] = v.y; d[2] = v.z; d[3] = v.w; }
    LDS_WAIT(); asm volatile("" ::: "memory");
    const int c = lane & 7;
#pragma unroll
    for (int j = 0; j < 4; ++j) { const int n = (lane >> 3) + 8 * j; const LAS float* s = scr + (8 * c) * 33 + n;
        v4u o; o.x = pk2(s[0 * 33], s[1 * 33]); o.y = pk2(s[2 * 33], s[3 * 33]); o.z = pk2(s[4 * 33], s[5 * 33]); o.w = pk2(s[6 * 33], s[7 * 33]);
        if (n0 + n < N) *(GAS v4u*)(WT + (size_t)(dst_row0 + n) * ldd + k0 + 8 * c) = o; }
    LDS_WAIT(); asm volatile("" ::: "memory");
}
__device__ __forceinline__ void rms_row_bf16_to_f32(const bf16* xrow, const float* g, float* orow, int lane, float oscale = 1.0f) {
    const GAS v4u* xr = (const GAS v4u*)xrow + 2 * lane; const v4u a = xr[0], b = xr[1]; float v[16]; float s = 0.f;
    v[0] = bflo(a.x); v[1] = bfhi(a.x); v[2] = bflo(a.y); v[3] = bfhi(a.y); v[4] = bflo(a.z); v[5] = bfhi(a.z); v[6] = bflo(a.w); v[7] = bfhi(a.w);
    v[8] = bflo(b.x); v[9] = bfhi(b.x); v[10] = bflo(b.y); v[11] = bfhi(b.y); v[12] = bflo(b.z); v[13] = bfhi(b.z); v[14] = bflo(b.w); v[15] = bfhi(b.w);
#pragma unroll
    for (int e = 0; e < 16; ++e) s += v[e] * v[e];
    const float rs = frsq(wave_sum(s) * (1.f / D) + 1e-6f) * oscale;
    const GAS f32x4* gr = (const GAS f32x4*)g + 4 * lane; GAS f32x4* o = (GAS f32x4*)orow + 4 * lane;
#pragma unroll
    for (int q = 0; q < 4; ++q) { const f32x4 gv = gr[q]; o[q] = (f32x4){v[4 * q] * rs * gv.x, v[4 * q + 1] * rs * gv.y, v[4 * q + 2] * rs * gv.z, v[4 * q + 3] * rs * gv.w}; }
}
struct Args { const float* in[36]; float* out; unsigned char* ws; int lo, hi; };
typedef const __attribute__((address_space(4))) Args* ArgP;
#define FRESH_ARGS() ({ ArgP p_ = (ArgP)__builtin_amdgcn_kernarg_segment_ptr(); asm volatile("" : "+s"(p_)); p_; })
#define FRESH_V(x) asm volatile("" : "+v"(x))
#define FRESH_S(x) asm volatile("" : "+s"(x))

#define TR_JOB(items, nblk, Wp, Kd, Nd, DST, LDD, ROW0, MU, S0, S1, GK) if (r < (items)) { const int kb = r / (nblk), nb = r % (nblk), n0 = 32 * nb; tr_item(Wp, Kd, Nd, DST, LDD, ROW0, scr, 64 * kb, n0, lane, MU, S0, S1, GK); continue; } r -= (items);
__device__ __forceinline__ void convert_mixer_weights(ArgP A, int L, LAS unsigned char* lds, int wave, int lane, int gw, int NGW) {
    const int i = L >> 1; const bool even = !(L & 1);
    bf16* Win = (bf16*)(A->ws + WS_WIN); bf16* Wout = (bf16*)(A->ws + WS_WOUT);
    LAS float* scr = (LAS float*)(lds + wave * 16384);
    const float* gmix = A->in[2] + (size_t)L * D;
    const float* w_in = even ? A->in[5] + (size_t)i * D * 3072 : A->in[26] + (size_t)i * D * 3072;
    const float* w_out = even ? A->in[6] + (size_t)i * D * D : A->in[27] + (size_t)i * D * D;
    const float* mu_w = A->in[8] + (size_t)i * 3 * D, *mu_a = mu_w + D, *mu_g = mu_w + 2 * D;
    const float* w1 = A->in[10] + (size_t)i * D * 64, *a1 = A->in[13] + (size_t)i * D * 64, *g1 = A->in[15] + (size_t)i * D * 160, *wa1 = A->in[22] + (size_t)i * D * 16;
    const float* w2s = A->in[11] + (size_t)i * 64 * 512, *a2s = A->in[14] + (size_t)i * 64 * 512, *g2s = A->in[16] + (size_t)i * 160 * 512;
    bf16* W2T = (bf16*)(A->ws + WS_W2T); bf16* A2T = (bf16*)(A->ws + WS_A2T); bf16* G2T = (bf16*)(A->ws + WS_G2T);
    const int I_IN = 16 * 96, I_L64 = 16 * 2, I_L160 = 16 * 5, I_L16 = 16 * 1, I_OUT = 16 * 32;
    const int n_lora = even ? (4 * I_L64 + 2 * I_L160 + I_L16 + 16 + 16 + 48) : 0;
    const int NITEMS = I_IN + n_lora + I_OUT;
    for (int it = gw; it < NITEMS; it += NGW) {
        int r = it;
        TR_JOB(I_IN, 96, w_in, D, 3072, Win, D, n0, nullptr, 1.f, 0.f, gmix)
        if (even) {
            TR_JOB(I_L64, 2, w1, D, 64, Win, D, PC_W1A + n0, mu_w, 1.f, -1.f, gmix)
            TR_JOB(I_L64, 2, w1, D, 64, Win, D, PC_W1B + n0, mu_w, 0.f, 1.f, gmix)
            TR_JOB(I_L64, 2, a1, D, 64, Win, D, PC_A1A + n0, mu_a, 1.f, -1.f, gmix)
            TR_JOB(I_L64, 2, a1, D, 64, Win, D, PC_A1B + n0, mu_a, 0.f, 1.f, gmix)
            TR_JOB(I_L160, 5, g1, D, 160, Win, D, PC_G1A + n0, mu_g, 1.f, -1.f, gmix)
            TR_JOB(I_L160, 5, g1, D, 160, Win, D, PC_G1B + n0, mu_g, 0.f, 1.f, gmix)
            TR_JOB(I_L16, 1, wa1, D, 16, Win, D, PC_WA1 + n0, nullptr, 1.f, 0.f, gmix)
            TR_JOB(16, 16, w2s, 64, 512, W2T, 64, n0, nullptr, 1.f, 0.f, nullptr)
            TR_JOB(16, 16, a2s, 64, 512, A2T, 64, n0, nullptr, 1.f, 0.f, nullptr)
            TR_JOB(48, 16, g2s, 160, 512, G2T, 192, n0, nullptr, 1.f, 0.f, nullptr)
        }
        TR_JOB(I_OUT, 32, w_out, D, D, Wout, D, n0, nullptr, 1.f, 0.f, nullptr)
    }
    if (even) {
        const int gt = gw * 64 + lane, NT = NGW * 64;
        for (int e = gt; e < (NIN_E - PC_PAD) * D / 8; e += NT) ((GAS v4u*)(Win + (size_t)PC_PAD * D))[e] = (v4u){0u, 0u, 0u, 0u};
        bf16* WA2T = (bf16*)(A->ws + WS_WA2T); const float* wa2 = A->in[23] + (size_t)i * 16 * 256;
        for (int e = gt; e < 256 * 32; e += NT) { const int nn = e >> 5, k = e & 31; WA2T[e] = k < 16 ? (bf16)f2bf(wa2[k * 256 + nn]) : (bf16)0; }
    }
}
__device__ __forceinline__ void convert_ffn_weights(ArgP A, int L, LAS unsigned char* lds, int wave, int lane, int gw, int NGW) {
    bf16* Wgu = (bf16*)(A->ws + WS_WGU); bf16* Wdn = (bf16*)(A->ws + WS_WDN);
    LAS float* scr = (LAS float*)(lds + wave * 16384);
    const float* gffn = A->in[3] + (size_t)L * D;
    const float* wg = A->in[33] + (size_t)L * D * FF, *wu = A->in[34] + (size_t)L * D * FF, *wd = A->in[35] + (size_t)L * FF * D;
    const int I_GU = 16 * 88, I_DN = 44 * 32;
    for (int it = gw; it < 2 * I_GU + I_DN; it += NGW) {
        int r = it;
        TR_JOB(I_GU, 88, wg, D, FF, Wgu, D, 256 * (n0 >> 7) + (n0 & 127), nullptr, 1.f, 0.f, gffn)
        TR_JOB(I_GU, 88, wu, D, FF, Wgu, D, 256 * (n0 >> 7) + (n0 & 127) + 128, nullptr, 1.f, 0.f, gffn)
        TR_JOB(I_DN, 32, wd, FF, D, Wdn, FF, n0, nullptr, 1.f, 0.f, nullptr)
    }
}
#undef TR_JOB
__device__ __forceinline__ void x_to_bf16_ssq(const float* xrow, bf16* orow, float* ssq_row, int lane) {
    const GAS f32x4* xr = (const GAS f32x4*)xrow + lane; f32x4 v[4]; float s = 0.f;
#pragma unroll
    for (int j = 0; j < 4; ++j) { v[j] = xr[64 * j]; s += (v[j].x * v[j].x + v[j].y * v[j].y) + (v[j].z * v[j].z + v[j].w * v[j].w); }
    s = wave_sum(s); if (lane < 16) ssq_row[lane] = lane == 0 ? s : 0.f;
    GAS v2u* o8 = (GAS v2u*)orow + lane;
#pragma unroll
    for (int j = 0; j < 4; ++j) { v2u o; o.x = pk2(v[j].x, v[j].y); o.y = pk2(v[j].z, v[j].w); o8[64 * j] = o; }
}

__device__ __forceinline__ int t5_bucket(int d) {
    if (d < 16) return d;
    const float r = (float)d / 16.0f; int l = 16 + (int)(flog(r) / 2.0794415416798357f * 16.0f);
    return l < 31 ? l : 31;
}
typedef short a_bf16x8 __attribute__((ext_vector_type(8)));
typedef float f32x16 __attribute__((ext_vector_type(16)));
typedef short a_s16x4 __attribute__((ext_vector_type(4)));
constexpr int AT_K1 = 0, AT_K2 = 8192, AT_V = 16384, AT_ST = 32768, AT_NST = 4, AT_BIAS = AT_NST * AT_ST, AT_COMB = 0;
static_assert(AT_BIAS + 132 * 4 <= LDSCTL_OFF && 4 * 64 * 64 * 4 <= AT_BIAS, "attention LDS map");
__device__ __forceinline__ int crow16(int r, int hi) { return (r & 3) + 8 * (r >> 2) + 4 * hi; }
typedef float f32x2_t __attribute__((ext_vector_type(2))); typedef __bf16 bf16x2_t __attribute__((ext_vector_type(2)));
__device__ __forceinline__ unsigned cvtpk(float lo, float hi) { const f32x2_t v = {lo, hi}; const bf16x2_t b = __builtin_convertvector(v, bf16x2_t); return __builtin_bit_cast(unsigned, b); }

template <bool HALFSYNC = false> __device__ __forceinline__ void attn_unit_mfma(ArgP A, int L, int b, int h, int qb, float lam, float lam_init, LAS unsigned char* lds, int tid) {
    const int lane = tid & 63, wave = __builtin_amdgcn_readfirstlane(tid >> 6), r32 = lane & 31, hi = lane >> 5;
    const int smap = wave >> 2, qs = wave & 3;
    const int i = L >> 1;
    const bf16* QKV = (const bf16*)(A->ws + WS_P); bf16* O = (bf16*)(A->ws + WS_XN);
    const int q0 = qb * 128, qw0 = q0 + 32 * qs, nt = (q0 + 128) / 64;
    const size_t rowb = (size_t)b * T;
    if (tid < 129) { const float far = A->in[1][31 * 8 + h]; ((LAS float*)(lds + AT_BIAS))[tid] = tid < 128 ? (A->in[1][t5_bucket(tid) * 8 + h] - far) * 1.4426950408889634f : 0.f; }
    a_bf16x8 qf[4];
    { const bf16* qrow = QKV + (rowb + qw0 + r32) * NIN_O + h * 128 + smap * 64 + 8 * hi;
#pragma unroll
      for (int ks = 0; ks < 4; ++ks) qf[ks] = *(const GAS a_bf16x8*)(qrow + 16 * ks); }
    const int kr = 8 * wave + (lane >> 3), kcs = (lane & 7) ^ ((kr >> 1) & 7);
    const bf16* kg = QKV + (rowb + kr) * NIN_O + 1024 + h * 128 + 8 * kcs;
    const int vr0 = 8 * wave + (lane >> 4), vr1 = vr0 + 4;
    const bf16* vg0 = QKV + (rowb + vr0) * NIN_O + 2048 + h * 128 + 8 * ((lane & 15) ^ (((vr0 & 3) << 2) | ((vr0 >> 2) & 3)));
    const bf16* vg1 = QKV + (rowb + vr1) * NIN_O + 2048 + h * 128 + 8 * ((lane & 15) ^ (((vr1 & 3) << 2) | ((vr1 >> 2) & 3)));
#define AT_DMA(kt, stoff) do { const size_t go_ = (size_t)(kt) * 64 * NIN_O; LAS unsigned char* sb_ = lds + (stoff) + wave * 1024; \
        __builtin_amdgcn_global_load_lds((const unsigned*)(kg + go_), (LAS unsigned*)(sb_ + AT_K1), 16, 0, 0); __builtin_amdgcn_global_load_lds((const unsigned*)(kg + go_ + 64), (LAS unsigned*)(sb_ + AT_K2), 16, 0, 0); \
        __builtin_amdgcn_global_load_lds((const unsigned*)(vg0 + go_), (LAS unsigned*)(sb_ + AT_V + wave * 1024), 16, 0, 0); __builtin_amdgcn_global_load_lds((const unsigned*)(vg1 + go_), (LAS unsigned*)(sb_ + AT_V + wave * 1024 + 1024), 16, 0, 0); } while (0)
    AT_DMA(0, 0); AT_DMA(1, AT_ST);
    __syncthreads();
    f32x16 o[4];
#pragma unroll
    for (int d = 0; d < 4; ++d)
#pragma unroll
        for (int r = 0; r < 16; ++r) o[d][r] = 0.f;
    float m = -1e30f, l = 0.f;
    const int kfo = (smap ? AT_K2 : AT_K1) + r32 * 128, khg = hi ^ ((r32 >> 1) & 7);
    int vfo[2][4];
    { const int q = (lane & 15) >> 2, pp = lane & 3, blk = (lane >> 4) & 1;
#pragma unroll
      for (int t = 0; t < 2; ++t)
#pragma unroll
          for (int d = 0; d < 4; ++d) vfo[t][d] = AT_V + 256 * (4 * hi + q + 8 * t) + 16 * (((d ^ q) << 2) | ((2 * blk + (pp >> 1)) ^ ((hi + 2 * t) & 3))) + 8 * (pp & 1); }
    const LAS float* bdl = (const LAS float*)(lds + AT_BIAS);
    const int qme = qw0 + r32;
#define AT_VREAD(VF, kk) do { _Pragma("unroll") for (int d = 0; d < 4; ++d) { \
                VF[2 * d] = __builtin_bit_cast(a_s16x4, __builtin_amdgcn_ds_read_tr16_b64_v4i16((LAS a_s16x4*)(sbv + vfo[0][d] + (kk) * 4096))); VF[2 * d + 1] = __builtin_bit_cast(a_s16x4, __builtin_amdgcn_ds_read_tr16_b64_v4i16((LAS a_s16x4*)(sbv + vfo[1][d] + (kk) * 4096))); } } while (0)
#define AT_PV(VF, PF, kk) do { _Pragma("unroll") for (int d = 0; d < 4; ++d) { const a_bf16x8 vf_ = (a_bf16x8){VF[2 * d][0], VF[2 * d][1], VF[2 * d][2], VF[2 * d][3], VF[2 * d + 1][0], VF[2 * d + 1][1], VF[2 * d + 1][2], VF[2 * d + 1][3]}; \
                o[d] = __builtin_amdgcn_mfma_f32_32x32x16_bf16(vf_, PF[kk], o[d], 0, 0, 0); } } while (0)
    int pbase = 0;
#pragma unroll 1
    for (int kt0 = 0; kt0 < nt; kt0 += 2) {
        const int nbase = pbase ? 0 : 2 * AT_ST;
#pragma unroll 1
      for (int sub = 0; sub < 2; ++sub) { const int kt = kt0 + sub; const int stoff = pbase + sub * AT_ST;
        if (kt + 2 < nt) AT_DMA(kt + 2, nbase + sub * AT_ST);
        const int key0 = 64 * kt;
        if (key0 <= qw0 + 31) {
            const LAS unsigned char* sb = lds + stoff; const LAS unsigned char* sbv = sb;
            f32x16 p[2]; a_bf16x8 kf[8];
#pragma unroll
            for (int f = 0; f < 8; ++f) kf[f] = *(const LAS a_bf16x8*)(sb + kfo + (f >> 2) * 4096 + ((khg ^ (2 * (f & 3))) * 16));
            __builtin_amdgcn_sched_barrier(0);
            __builtin_amdgcn_s_setprio(1);
#pragma unroll
            for (int blk = 0; blk < 2; ++blk) {
#pragma unroll
                for (int r = 0; r < 16; ++r) p[blk][r] = 0.f;
#pragma unroll
                for (int ks = 0; ks < 4; ++ks) p[blk] = __builtin_amdgcn_mfma_f32_32x32x16_bf16(kf[blk * 4 + ks], qf[ks], p[blk], 0, 0, 0);
            }
            __builtin_amdgcn_s_setprio(0);
            if (key0 + 63 + 128 > qw0) {
#pragma unroll
                for (int blk = 0; blk < 2; ++blk) { float bvv[16];
#pragma unroll
                    for (int r = 0; r < 16; ++r) { const unsigned ud = (unsigned)(qme - (key0 + 32 * blk + crow16(r, hi))); bvv[r] = bdl[ud < 128u ? ud : 128u]; }
                    asm volatile("" : "+v"(bvv[0]), "+v"(bvv[1]), "+v"(bvv[2]), "+v"(bvv[3]), "+v"(bvv[4]), "+v"(bvv[5]), "+v"(bvv[6]), "+v"(bvv[7]), "+v"(bvv[8]), "+v"(bvv[9]), "+v"(bvv[10]), "+v"(bvv[11]), "+v"(bvv[12]), "+v"(bvv[13]), "+v"(bvv[14]), "+v"(bvv[15]));
#pragma unroll
                    for (int r = 0; r < 16; ++r) { const int dist = qme - (key0 + 32 * blk + crow16(r, hi)); p[blk][r] = dist < 0 ? -1e30f : p[blk][r] + bvv[r]; } }
            }
            float mx = p[0][0];
#pragma unroll
            for (int r = 1; r < 16; ++r) mx = fmaxf(mx, p[0][r]);
#pragma unroll
            for (int r = 0; r < 16; ++r) mx = fmaxf(mx, p[1][r]);
            { const auto sw_ = __builtin_amdgcn_permlane32_swap(__builtin_bit_cast(unsigned, mx), __builtin_bit_cast(unsigned, mx), false, false);
              mx = fmaxf(__builtin_bit_cast(float, sw_[0]), __builtin_bit_cast(float, sw_[1])); }
            if (__any(mx > m + 8.0f)) {
                const float mn = fmaxf(m, mx), al = __builtin_amdgcn_exp2f(m - mn); m = mn; l *= al;
#pragma unroll
                for (int d = 0; d < 4; ++d)
#pragma unroll
                    for (int r = 0; r < 16; ++r) o[d][r] *= al;
            }
            float ls = 0.f;
#define AT_EXPPK(PF, kk) do { const int blk_ = (kk) >> 1, s8_ = 8 * ((kk) & 1); float e_[8]; _Pragma("unroll") for (int j = 0; j < 8; ++j) { e_[j] = __builtin_amdgcn_exp2f(p[blk_][s8_ + j] - m); ls += e_[j]; } \
                v4u w_; w_.x = cvtpk(e_[0], e_[1]); w_.y = cvtpk(e_[2], e_[3]); w_.z = cvtpk(e_[4], e_[5]); w_.w = cvtpk(e_[6], e_[7]); PF[kk] = __builtin_bit_cast(a_bf16x8, w_); } while (0)
            {
                a_bf16x8 pf[4]; a_s16x4 vA[8], vB[8];
                AT_VREAD(vA, 0); AT_EXPPK(pf, 0);
                __builtin_amdgcn_sched_barrier(0);
                AT_VREAD(vB, 1); AT_PV(vA, pf, 0); AT_EXPPK(pf, 1);
                __builtin_amdgcn_sched_barrier(0);
                AT_VREAD(vA, 2); AT_PV(vB, pf, 1); AT_EXPPK(pf, 2);
                __builtin_amdgcn_sched_barrier(0);
                AT_VREAD(vB, 3); AT_PV(vA, pf, 2); AT_EXPPK(pf, 3);
                __builtin_amdgcn_sched_barrier(0);
                AT_PV(vB, pf, 3);
            }
            l += ls;
#undef AT_EXPPK
        }
      }
        __syncthreads();
        pbase = nbase;
    }
#undef AT_VREAD
#undef AT_PV
#undef AT_DMA
    l += __shfl_xor(l, 32);
    LAS float* comb = (LAS float*)(lds + AT_COMB) + qs * 4096;
    if (smap == 1) { const float sc = lam * frcp(l);
#pragma unroll
        for (int d = 0; d < 4; ++d)
#pragma unroll
            for (int r = 0; r < 16; ++r) comb[(d * 16 + r) * 64 + lane] = o[d][r] * sc; }
    __syncthreads();
    if (smap == 0) {
        const float il = frcp(l); float ss = 0.f;
#pragma unroll
        for (int d = 0; d < 4; ++d)
#pragma unroll
            for (int r = 0; r < 16; ++r) { const float v = o[d][r] * il - comb[(d * 16 + r) * 64 + lane]; o[d][r] = v; ss += v * v; }
        ss += __shfl_xor(ss, 32);
        const float rs = frsq(ss * (1.f / 128.f) + 1e-5f) * (1.0f - lam_init);
        const float* sl = A->in[32] + i * 128;
        bf16* orow = O + (rowb + qw0 + r32) * D + h * 128;
#pragma unroll
        for (int d = 0; d < 4; ++d)
#pragma unroll
            for (int g4 = 0; g4 < 4; ++g4) { const int dc = 32 * d + 8 * g4 + 4 * hi; const f32x4 s4 = *(const GAS f32x4*)(sl + dc);
                v2u w; w.x = cvtpk(o[d][4 * g4] * rs * s4.x, o[d][4 * g4 + 1] * rs * s4.y); w.y = cvtpk(o[d][4 * g4 + 2] * rs * s4.z, o[d][4 * g4 + 3] * rs * s4.w);
                *(GAS v2u*)(orow + dc) = w; }
    }
    __syncthreads();
}

template <bool HALFSYNC = false> __device__ __forceinline__ void attn_phase_mfma(ArgP A, int L, LAS unsigned char* lds, int tid, int G, int bid) {
    const int lane = tid & 63, i = L >> 1;
    const float lam_init = 0.8f - 0.6f * fexp(-0.3f * (float)L);
    const float lam = fexp(wave_sum(A->in[28][i * 64 + lane] * A->in[29][i * 64 + lane])) - fexp(wave_sum(A->in[30][i * 64 + lane] * A->in[31][i * 64 + lane])) + lam_init;
    if (G == 256) {
        const int v = (bid & 7) * 32 + (bid >> 3), bh = v >> 2, j = v & 3;
#pragma unroll 1
        for (int u = 0; u < 8; ++u) { const int qb = 8 * (u >> 1) + ((u & 1) ? 7 - j : j); attn_unit_mfma<HALFSYNC>(A, L, bh >> 3, bh & 7, qb, lam, lam_init, lds, tid); }
    } else {
#pragma unroll 1
        for (int u = bid; u < 64 * 32; u += G) attn_unit_mfma<HALFSYNC>(A, L, (u >> 5) >> 3, (u >> 5) & 7, 31 - (u & 31), lam, lam_init, lds, tid);
    }
}
typedef short bf16x8_t __attribute__((ext_vector_type(8)));
constexpr int MS = 72, MB = 64 * MS * 2;
constexpr int RW_XW = 8 * MB, RW_XA = RW_XW + 16384;
constexpr int RW_TOT = 14 * MB, RW_GAM = RW_TOT + 2048, RW_END = RW_GAM + 256;
static_assert(RW_XA + 16384 <= 12 * MB && RW_END <= RING_BYTES, "RWKV LDS map");
constexpr size_t WS_RWI = 336 * MiB;
constexpr size_t WS_BON = 30 * MiB;
#define RBUF(k) ((LAS bf16*)(lds + (k) * MB))
__device__ __forceinline__ f32x4 mfma16(bf16x8_t a, bf16x8_t b, f32x4 c) { return __builtin_amdgcn_mfma_f32_16x16x32_bf16(a, b, c, 0, 0, 0); }
__device__ __forceinline__ bf16x8_t ldfrag(const LAS bf16* Mx, int row0, int k0, int lane) { return *(const LAS bf16x8_t*)(Mx + (row0 + (lane & 15)) * MS + k0 + 8 * (lane >> 4)); }
__device__ __forceinline__ f32x4 mm64(f32x4 acc, const LAS bf16* Am, int ra, const LAS bf16* BTm, int cb, int lane) {
    acc = mfma16(ldfrag(Am, 16 * ra, 0, lane), ldfrag(BTm, 16 * cb, 0, lane), acc);
    return mfma16(ldfrag(Am, 16 * ra, 32, lane), ldfrag(BTm, 16 * cb, 32, lane), acc);
}
__device__ __forceinline__ v2u pack4(f32x4 a) { v2u w; w.x = cvtpk(a[0], a[1]); w.y = cvtpk(a[2], a[3]); return w; }
__device__ __forceinline__ void tstore(LAS bf16* Dm, int rt, int ct, f32x4 acc, int lane) { *(LAS v2u*)(Dm + (16 * ct + (lane & 15)) * MS + 16 * rt + 4 * (lane >> 4)) = pack4(acc); }
__device__ __forceinline__ void tstore_g(bf16* Dg, int rt, int ct, f32x4 acc, int lane) { *(GAS v2u*)(Dg + (16 * ct + (lane & 15)) * 64 + 16 * rt + 4 * (lane >> 4)) = pack4(acc); }
__device__ __forceinline__ f32x4 ld4bf(const LAS bf16* p) { const v2u w = *(const LAS v2u*)p; return (f32x4){bflo(w.x), bfhi(w.x), bflo(w.y), bfhi(w.y)}; }
__device__ __forceinline__ f32x4 ld4bf_g(const bf16* p) { const v2u w = *(const GAS v2u*)p; return (f32x4){bflo(w.x), bfhi(w.x), bflo(w.y), bfhi(w.y)}; }
__device__ __forceinline__ void unpack8(v4u w, float (&f)[8]) { f[0] = bflo(w.x); f[1] = bfhi(w.x); f[2] = bflo(w.y); f[3] = bfhi(w.y); f[4] = bflo(w.z); f[5] = bfhi(w.z); f[6] = bflo(w.w); f[7] = bfhi(w.w); }
__device__ __forceinline__ bf16x8_t pack8(const float (&f)[8]) { v4u w; w.x = cvtpk(f[0], f[1]); w.y = cvtpk(f[2], f[3]); w.z = cvtpk(f[4], f[5]); w.w = cvtpk(f[6], f[7]); return __builtin_bit_cast(bf16x8_t, w); }

__device__ __forceinline__ void rwkv_chunk_phase(ArgP A, int L, LAS unsigned char* lds, int tid, int G, int bid) {
    const int lane = tid & 63, wave = __builtin_amdgcn_readfirstlane(tid >> 6), i = L >> 1;
    const int l15 = lane & 15, lg = lane >> 4;
    const bf16* P = (const bf16*)(A->ws + WS_P); bf16* XNb = (bf16*)(A->ws + WS_XN);
    const int rt = wave >> 1, ct0 = 2 * (wave & 1);
    constexpr int NIT = BATCH * 64 * 8;
    v4u pw[2][2], pa[2][2]; unsigned short pe[9][3];
#define R1_PREFETCH(itx) do { const int b_ = (itx) >> 9, n_ = ((itx) >> 3) & 63, h_ = (itx) & 7; const size_t rowb_ = (size_t)b_ * T + 64 * n_; \
        { const int tt_ = 16 * rt + l15; const bf16* prow_ = P + (rowb_ + tt_) * NIN_E; const bool hp_ = (64 * n_ + tt_) > 0; const v4u z4_ = (v4u){0u, 0u, 0u, 0u}; \
          _Pragma("unroll") for (int q = 0; q < 2; ++q) { const int kc_ = 32 * q + 8 * lg; pw[q][0] = *(const GAS v4u*)(prow_ + PC_W1A + kc_); pw[q][1] = hp_ ? *(const GAS v4u*)(prow_ - NIN_E + PC_W1B + kc_) : z4_; \
              pa[q][0] = *(const GAS v4u*)(prow_ + PC_A1A + kc_); pa[q][1] = hp_ ? *(const GAS v4u*)(prow_ - NIN_E + PC_A1B + kc_) : z4_; } \
          } \
        { const int c_ = 64 * h_ + lane; const size_t row0_ = rowb_ + 8 * wave; const bool hp_ = (64 * n_ + 8 * wave) > 0; \
          _Pragma("unroll") for (int u = 0; u < 9; ++u) { const bf16* pp_ = P + (row0_ + u - 1) * NIN_E; const bool ok_ = u > 0 || hp_; \
              pe[u][0] = ok_ ? pp_[PC_R + c_] : (unsigned short)0; pe[u][1] = ok_ ? pp_[PC_K + c_] : (unsigned short)0; pe[u][2] = ok_ ? pp_[PC_V + c_] : (unsigned short)0; } } } while (0)
    if (bid < NIT) R1_PREFETCH(bid);
#pragma unroll 1
    for (int it = bid; it < NIT; it += G) {
    const int b = it >> 9, n = (it >> 3) & 63, h = it & 7;
    const size_t rowb = (size_t)b * T + 64 * n;
    bf16* item = (bf16*)(A->ws + WS_RWI) + ((size_t)((b * 64 + n) * 8 + h)) * 16384;
    asm volatile("; MARK_R1_E1");
    {
        const bf16* W2T = (const bf16*)(A->ws + WS_W2T); const bf16* A2T = (const bf16*)(A->ws + WS_A2T);
        f32x4 xw[2], xa[2];
#pragma unroll
        for (int c = 0; c < 2; ++c) { xw[c] = (f32x4){0.f, 0.f, 0.f, 0.f}; xa[c] = (f32x4){0.f, 0.f, 0.f, 0.f}; }
#pragma unroll
        for (int q = 0; q < 2; ++q) {
            const int kc = 32 * q + 8 * lg; float x[8], y[8], v[8];
            unpack8(pw[q][0], x); unpack8(pw[q][1], y);
#pragma unroll
            for (int e = 0; e < 8; ++e) v[e] = tanh_f(x[e] + y[e]);
            const bf16x8_t fw = pack8(v);
            unpack8(pa[q][0], x); unpack8(pa[q][1], y);
#pragma unroll
            for (int e = 0; e < 8; ++e) v[e] = x[e] + y[e];
            const bf16x8_t fa = pack8(v);
#pragma unroll
            for (int c = 0; c < 2; ++c) { const size_t wo = (size_t)(64 * h + 16 * (ct0 + c) + l15) * 64 + kc;
                xw[c] = mfma16(fw, *(const GAS bf16x8_t*)(W2T + wo), xw[c]); xa[c] = mfma16(fa, *(const GAS bf16x8_t*)(A2T + wo), xa[c]); }
        }
        LAS float* XW = (LAS float*)(lds + RW_XW); LAS float* XA = (LAS float*)(lds + RW_XA);
#pragma unroll
        for (int c = 0; c < 2; ++c)
#pragma unroll
            for (int r = 0; r < 4; ++r) { const int o = (16 * rt + 4 * lg + r) * 64 + 16 * (ct0 + c) + l15; XW[o] = xw[c][r]; XA[o] = xa[c][r]; }
    }
    LDS_BARRIER();
    asm volatile("; MARK_R1_E2");
    {
        const int c = 64 * h + lane;
        const float* mu = A->in[7] + (size_t)i * 1536;
        const float mur = mu[c], muk = mu[512 + c], muv = mu[1024 + c];
        const float kkc = A->in[17][i * 512 + c], kac = A->in[18][i * 512 + c], rkc = A->in[19][i * 512 + c], w0c = A->in[9][i * 512 + c], a0c = A->in[12][i * 512 + c];
        const LAS float* XW = (const LAS float*)(lds + RW_XW); const LAS float* XA = (const LAS float*)(lds + RW_XA);
        float* BON = (float*)(A->ws + WS_BON);
        const int tt0 = 8 * wave; const size_t row0 = rowb + tt0;
        float pr_p = bf2f(pe[0][0]), pk_p = bf2f(pe[0][1]), pv_p = bf2f(pe[0][2]);
        float rr[8], av[8], bv[8], km[8], vv[8], lc[8];
        float run = 0.f;
#pragma unroll
        for (int u = 0; u < 8; ++u) {
            const float pR = bf2f(pe[u + 1][0]), pK = bf2f(pe[u + 1][1]), pV = bf2f(pe[u + 1][2]);
            const float r = pR + (pr_p - pR) * mur, k = pK + (pk_p - pK) * muk, v = pV + (pv_p - pV) * muv; pr_p = pR; pk_p = pK; pv_p = pV;
            const float xw = w0c + XW[(tt0 + u) * 64 + lane], xa = a0c + XA[(tt0 + u) * 64 + lane];
            const float wlog = -0.6065306597126334f * sigmoid_f(xw), as = sigmoid_f(xa);
            float kk = k * kkc; const float n2 = wave_sum(kk * kk); kk = kk * frsq(fmaxf(n2, 1e-24f));
            const float kmod = k * (1.f + (as - 1.f) * kac);
            const float bon = wave_sum(r * kmod * rkc);
            if (lane == 0) BON[(row0 + u) * 8 + h] = bon;
            run += wlog; rr[u] = r; av[u] = -kk; bv[u] = kk * as; km[u] = kmod; vv[u] = v; lc[u] = run;
        }
        LAS float* TOT = (LAS float*)(lds + RW_TOT);
        TOT[wave * 64 + lane] = run;
        LDS_BARRIER();
        float off = 0.f, tot = 0.f;
#pragma unroll
        for (int w2 = 0; w2 < 8; ++w2) { const float tv = TOT[w2 * 64 + lane]; tot += tv; if (w2 < wave) off += tv; }
        if (wave == 0) ((LAS float*)(lds + RW_GAM))[lane] = fexp(tot);
        float fR[8], fA[8], fB[8], fK[8];
        float eprev = fexp(off);
#pragma unroll
        for (int u = 0; u < 8; ++u) { const float cum = off + lc[u], e1 = fexp(cum), ei = frcp(e1); fR[u] = rr[u] * e1; fA[u] = av[u] * eprev; fB[u] = bv[u] * ei; fK[u] = km[u] * ei; eprev = e1; }
        LAS bf16* At = RBUF(0); LAS bf16* Bt = RBUF(1); LAS bf16* Kt = RBUF(2); LAS bf16* Rt = RBUF(3);
#pragma unroll
        for (int u = 0; u < 8; ++u) { const int o = (tt0 + u) * MS + lane; At[o] = (bf16)f2bf(fA[u]); Bt[o] = (bf16)f2bf(fB[u]); Kt[o] = (bf16)f2bf(fK[u]); Rt[o] = (bf16)f2bf(fR[u]); }
        *(LAS bf16x8_t*)(RBUF(4) + lane * MS + tt0) = pack8(fA); *(LAS bf16x8_t*)(RBUF(5) + lane * MS + tt0) = pack8(fB);
        *(LAS bf16x8_t*)(RBUF(6) + lane * MS + tt0) = pack8(fK); *(LAS bf16x8_t*)(RBUF(7) + lane * MS + tt0) = pack8(vv);
    }
    asm volatile("" ::: "memory");
    if (it + G < NIT) R1_PREFETCH(it + G);
    LDS_BARRIER();
    asm volatile("; MARK_R1_G");
    {
        const LAS bf16* At = RBUF(0); const LAS bf16* Bt = RBUF(1); const LAS bf16* Kt = RBUF(2); const LAS bf16* Rt = RBUF(3);
#pragma unroll
        for (int c = 0; c < 2; ++c) { const int ct = ct0 + c; const f32x4 z = (f32x4){0.f, 0.f, 0.f, 0.f};
            f32x4 aL = mm64(z, Bt, rt, At, ct, lane);
            f32x4 aLT = mm64(z, At, rt, Bt, ct, lane);
            f32x4 aAK = mm64(z, Kt, rt, At, ct, lane);
            f32x4 aRB = mm64(z, Bt, rt, Rt, ct, lane);
            f32x4 aRK = mm64(z, Kt, rt, Rt, ct, lane);
            const int col = 16 * ct + l15;
#pragma unroll
            for (int r = 0; r < 4; ++r) { const int row = 16 * rt + 4 * lg + r;
                if (!(row < col)) { aL[r] = 0.f; aAK[r] = 0.f; }
                if (!(col < row)) aLT[r] = 0.f;
                if (!(row <= col)) { aRB[r] = 0.f; aRK[r] = 0.f; } }
            tstore(RBUF(8), rt, ct, aL, lane); tstore(RBUF(9), rt, ct, aLT, lane); tstore(RBUF(10), rt, ct, aAK, lane); tstore(RBUF(11), rt, ct, aRB, lane); tstore(RBUF(12), rt, ct, aRK, lane);
        }
    }
    LDS_BARRIER();
    asm volatile("; MARK_R1_N");
    {
    {
        for (int e = tid; e < 64 * 16; e += NTHREADS) { const int row = e >> 4, c4 = (e & 15) * 4; v2u w = *(const LAS v2u*)(RBUF(8) + row * MS + c4);
            if ((row >> 2) == (c4 >> 2)) { const unsigned one = 0x3f80u; const int p = row & 3; if (p == 0) w.x = (w.x & 0xffff0000u) | one; else if (p == 1) w.x = (w.x & 0xffffu) | (one << 16); else if (p == 2) w.y = (w.y & 0xffff0000u) | one; else w.y = (w.y & 0xffffu) | (one << 16); }
            *(LAS v2u*)(RBUF(0) + row * MS + c4) = w; }
    }
#define RW_SQUARE(Min, MTin, Mout, MTout) do { _Pragma("unroll") for (int c = 0; c < 2; ++c) { const int ct = ct0 + c; const f32x4 z = (f32x4){0.f, 0.f, 0.f, 0.f}; \
        tstore(RBUF(Mout), rt, ct, mm64(z, RBUF(MTin), rt, RBUF(Min), ct, lane), lane);        \
        tstore(RBUF(MTout), rt, ct, mm64(z, RBUF(Min), rt, RBUF(MTin), ct, lane), lane); } } while (0)
#define RW_YSTEP(Yin, MTin, Yout) do { _Pragma("unroll") for (int c = 0; c < 2; ++c) { const int ct = ct0 + c; \
        const f32x4 y0 = ld4bf(RBUF(Yin) + (16 * ct + l15) * MS + 16 * rt + 4 * lg);            \
        tstore(RBUF(Yout), rt, ct, mm64(y0, RBUF(MTin), rt, RBUF(Yin), ct, lane), lane); } } while (0)
    RW_SQUARE(8, 9, 2, 13);
    LDS_BARRIER();
    RW_YSTEP(0, 13, 1); RW_SQUARE(2, 13, 8, 9);
    LDS_BARRIER();
    RW_YSTEP(1, 9, 0); RW_SQUARE(8, 9, 2, 13);
    LDS_BARRIER();
    RW_YSTEP(0, 13, 1); RW_SQUARE(2, 13, 8, 9);
    LDS_BARRIER();
    RW_YSTEP(1, 9, 0); RW_SQUARE(8, 9, 2, 13);
    LDS_BARRIER();
    RW_YSTEP(0, 13, 1);
    {
#pragma unroll
        for (int c = 0; c < 2; ++c) { const int ct = ct0 + c; tstore(RBUF(9), rt, ct, mm64((f32x4){0.f, 0.f, 0.f, 0.f}, RBUF(10), rt, RBUF(7), ct, lane), lane); }
    }
    LDS_BARRIER();
    }
#undef RW_SQUARE
#undef RW_YSTEP
    asm volatile("; MARK_R1_F1");
    {
    {
#pragma unroll
        for (int c = 0; c < 2; ++c) { const int ct = ct0 + c; const f32x4 z = (f32x4){0.f, 0.f, 0.f, 0.f};
            tstore(RBUF(8), rt, ct, mm64(z, RBUF(1), rt, RBUF(4), ct, lane), lane);
            tstore(RBUF(0), rt, ct, mm64(z, RBUF(1), rt, RBUF(9), ct, lane), lane); }
    }
    LDS_BARRIER();
    {
        const LAS float* GAM = (const LAS float*)(lds + RW_GAM);
#pragma unroll
        for (int c = 0; c < 2; ++c) { const int ct = ct0 + c; const f32x4 z = (f32x4){0.f, 0.f, 0.f, 0.f};
            const f32x4 r0 = ld4bf(RBUF(3) + (16 * ct + l15) * MS + 16 * rt + 4 * lg);
            tstore_g(item, rt, ct, mm64(r0, RBUF(8), rt, RBUF(11), ct, lane), lane);
            f32x4 pp = mm64(z, RBUF(8), rt, RBUF(5), ct, lane);
            const float gm = GAM[16 * ct + l15];
#pragma unroll
            for (int r = 0; r < 4; ++r) pp[r] = gm * (pp[r] + ((16 * rt + 4 * lg + r) == (16 * ct + l15) ? 1.f : 0.f));
            { const int jp = 16 * ct + l15, j0 = 16 * rt + 4 * lg;
              *(GAS v2u*)(item + 8192 + ((((jp >> 5) * 4 + (j0 >> 4)) * 64 + (jp & 31) + 32 * ((j0 >> 2) & 1)) * 8 + 4 * ((j0 >> 3) & 1))) = pack4(pp); }
            f32x4 y0 = mm64(z, RBUF(0), rt, RBUF(11), ct, lane); y0 = mm64(y0, RBUF(7), rt, RBUF(12), ct, lane);
            tstore_g(item + 4096, rt, ct, y0, lane);
            f32x4 q = mm64(z, RBUF(5), rt, RBUF(0), ct, lane); q = mm64(q, RBUF(6), rt, RBUF(7), ct, lane);
            const f32x4 g4 = *(const LAS f32x4*)(GAM + 16 * rt + 4 * lg);
            q = q * g4;
            { const int iv = 16 * ct + l15, j0 = 16 * rt + 4 * lg;
              *(GAS v2u*)(item + 12288 + (((((j0 >> 5) * 2 + (iv >> 5)) * 4 + ((j0 >> 3) & 3)) * 64 + (iv & 31) + 32 * ((j0 >> 2) & 1)) * 4)) = pack4(q); } }
    }
    LDS_BARRIER();
    }
    }
#undef R1_PREFETCH
}

__device__ __forceinline__ void rwkv_state_scan(ArgP A, int b, int h, int lane, bool do_store = true) {
    const int r32 = lane & 31, hi = lane >> 5;
    f32x16 St[2][2];
#pragma unroll
    for (int kb = 0; kb < 2; ++kb)
#pragma unroll
        for (int vb = 0; vb < 2; ++vb)
#pragma unroll
            for (int r = 0; r < 16; ++r) St[kb][vb][r] = 0.f;
    bf16* item0 = (bf16*)(A->ws + WS_RWI) + ((size_t)((b * 64) * 8 + h)) * 16384;
    v4u pfn[8]; v2u qn[16];
#define RW2_LOAD(nn) do { const bf16* it_ = item0 + (size_t)(nn) * 8 * 16384; \
        _Pragma("unroll") for (int f = 0; f < 8; ++f) pfn[f] = *(const GAS v4u*)(it_ + 8192 + (f * 64 + lane) * 8); \
        _Pragma("unroll") for (int f = 0; f < 16; ++f) qn[f] = *(const GAS v2u*)(it_ + 12288 + (f * 64 + lane) * 4); } while (0)
    RW2_LOAD(0);
#pragma unroll 1
    for (int n = 0; n < 64; ++n) {
        bf16* PM = item0 + (size_t)n * 8 * 16384 + 8192;
        a_bf16x8 pf[2][4]; f32x16 Nw[2][2];
#pragma unroll
        for (int f = 0; f < 8; ++f) pf[f >> 2][f & 3] = __builtin_bit_cast(a_bf16x8, pfn[f]);
#pragma unroll
        for (int kb = 0; kb < 2; ++kb)
#pragma unroll
            for (int vb = 0; vb < 2; ++vb)
#pragma unroll
                for (int g = 0; g < 4; ++g) { const v2u w = qn[(kb * 2 + vb) * 4 + g]; Nw[kb][vb][4 * g] = bflo(w.x); Nw[kb][vb][4 * g + 1] = bfhi(w.x); Nw[kb][vb][4 * g + 2] = bflo(w.y); Nw[kb][vb][4 * g + 3] = bfhi(w.y); }
#pragma unroll
        for (int kb = 0; kb < 2; ++kb)
#pragma unroll
            for (int vb = 0; vb < 2; ++vb)
#pragma unroll
                for (int g = 0; g < 4; ++g) { v2u w; w.x = cvtpk(St[kb][vb][4 * g], St[kb][vb][4 * g + 1]); w.y = cvtpk(St[kb][vb][4 * g + 2], St[kb][vb][4 * g + 3]);
                    if (do_store) *(GAS v2u*)(PM + ((((2 * vb + (r32 >> 4)) * 2 + kb) * 64 + g * 16 + (r32 & 15)) * 8 + 4 * hi)) = w; }
        if (n + 1 < 64) RW2_LOAD(n + 1);
        a_bf16x8 sf[4][2];
#pragma unroll
        for (int ks = 0; ks < 4; ++ks)
#pragma unroll
            for (int vb = 0; vb < 2; ++vb) { const int kb = ks >> 1, s8 = 8 * (ks & 1); v4u w; w.x = cvtpk(St[kb][vb][s8], St[kb][vb][s8 + 1]); w.y = cvtpk(St[kb][vb][s8 + 2], St[kb][vb][s8 + 3]);
                w.z = cvtpk(St[kb][vb][s8 + 4], St[kb][vb][s8 + 5]); w.w = cvtpk(St[kb][vb][s8 + 6], St[kb][vb][s8 + 7]); sf[ks][vb] = __builtin_bit_cast(a_bf16x8, w); }
#pragma unroll
        for (int kb = 0; kb < 2; ++kb)
#pragma unroll
            for (int vb = 0; vb < 2; ++vb) {
#pragma unroll
                for (int ks = 0; ks < 4; ++ks) Nw[kb][vb] = __builtin_amdgcn_mfma_f32_32x32x16_bf16(pf[kb][ks], sf[ks][vb], Nw[kb][vb], 0, 0, 0);
            }
#pragma unroll
        for (int kb = 0; kb < 2; ++kb)
#pragma unroll
            for (int vb = 0; vb < 2; ++vb) St[kb][vb] = Nw[kb][vb];
    }
#undef RW2_LOAD
}

__device__ __forceinline__ void rwkv_out_phase(ArgP A, int L, int wt0, int wtstride, int lane) {
    const int i = L >> 1, l15 = lane & 15, lg = lane >> 4;
    const bf16* P = (const bf16*)(A->ws + WS_P); bf16* XNb = (bf16*)(A->ws + WS_XN); const float* BON = (const float*)(A->ws + WS_BON);
    int hcur = -1; v4u g2f[5][4]; f32x4 w4[4], b4[4], m4[4];
#pragma unroll 1
    for (int wt = wt0; wt < BATCH * 64 * 8 * 4; wt += wtstride) {
    const int it_ = wt >> 2, ct = wt & 3, b = it_ >> 9, n = (it_ >> 3) & 63, h = it_ & 7;
    if (h != hcur) { hcur = h;
        const bf16* G2T = (const bf16*)(A->ws + WS_G2T) + (size_t)(64 * h + l15) * 192 + 8 * lg;
#pragma unroll
        for (int q = 0; q < 5; ++q)
#pragma unroll
            for (int it = 0; it < 4; ++it) g2f[q][it] = *(const GAS v4u*)(G2T + (size_t)(16 * it) * 192 + 32 * q);
        const float* lnw = A->in[20] + i * 512 + 64 * h; const float* lnb = A->in[21] + i * 512 + 64 * h; const float* mu = A->in[7] + (size_t)i * 1536 + 1024 + 64 * h;
#pragma unroll
        for (int it = 0; it < 4; ++it) { const int i0 = 16 * it + 4 * lg; w4[it] = *(const GAS f32x4*)(lnw + i0); b4[it] = *(const GAS f32x4*)(lnb + i0); m4[it] = *(const GAS f32x4*)(mu + i0); } }
    const bf16* item = (const bf16*)(A->ws + WS_RWI) + ((size_t)((b * 64 + n) * 8 + h)) * 16384;
    const bf16* RH = item; const bf16* Y0 = item + 4096; const bf16* ST = item + 8192;
    const size_t row = (size_t)b * T + 64 * n + 16 * ct + l15; const int tseq = 64 * n + 16 * ct + l15;
    const bf16x8_t rf0 = *(const GAS bf16x8_t*)(RH + (16 * ct + l15) * 64 + 8 * lg), rf1 = *(const GAS bf16x8_t*)(RH + (16 * ct + l15) * 64 + 32 + 8 * lg);
    const bf16* prow = P + row * NIN_E; v4u gx[5], gy[5];
#pragma unroll
    for (int q = 0; q < 5; ++q) { gx[q] = *(const GAS v4u*)(prow + PC_G1A + 32 * q + 8 * lg); gy[q] = tseq > 0 ? *(const GAS v4u*)(prow - NIN_E + PC_G1B + 32 * q + 8 * lg) : (v4u){0u, 0u, 0u, 0u}; }
    const bf16* pr = prow + PC_V + 64 * h; v2u pvr[4], pvq[4];
#pragma unroll
    for (int it = 0; it < 4; ++it) { const int i0 = 16 * it + 4 * lg; pvr[it] = *(const GAS v2u*)(pr + i0); pvq[it] = tseq > 0 ? *(const GAS v2u*)(pr - NIN_E + i0) : (v2u){0u, 0u}; }
    const float bon = BON[row * 8 + h];
    f32x4 acc[4]; float s1 = 0.f;
#pragma unroll
    for (int it = 0; it < 4; ++it) {
        f32x4 a = ld4bf_g(Y0 + (16 * ct + l15) * 64 + 16 * it + 4 * lg);
        a = mfma16(*(const GAS bf16x8_t*)(ST + ((it * 2 + 0) * 64 + lane) * 8), rf0, a);
        a = mfma16(*(const GAS bf16x8_t*)(ST + ((it * 2 + 1) * 64 + lane) * 8), rf1, a);
        acc[it] = a; s1 += (a[0] + a[1]) + (a[2] + a[3]);
    }
    s1 += __shfl_xor(s1, 16); s1 += __shfl_xor(s1, 32);
    const float mean = s1 * (1.f / 64.f); float s2 = 0.f;
#pragma unroll
    for (int it = 0; it < 4; ++it) { acc[it] = acc[it] - mean; s2 += (acc[it][0] * acc[it][0] + acc[it][1] * acc[it][1]) + (acc[it][2] * acc[it][2] + acc[it][3] * acc[it][3]); }
    s2 += __shfl_xor(s2, 16); s2 += __shfl_xor(s2, 32);
    const float rs = frsq(s2 * (1.f / 64.f) + 64e-5f);
    f32x4 gq[4] = {(f32x4){0.f, 0.f, 0.f, 0.f}, (f32x4){0.f, 0.f, 0.f, 0.f}, (f32x4){0.f, 0.f, 0.f, 0.f}, (f32x4){0.f, 0.f, 0.f, 0.f}};
#pragma unroll
    for (int q = 0; q < 5; ++q) { float x[8], y[8], v[8]; unpack8(gx[q], x); unpack8(gy[q], y);
#pragma unroll
        for (int e = 0; e < 8; ++e) v[e] = sigmoid_f(x[e] + y[e]);
        const bf16x8_t fg = pack8(v);
#pragma unroll
        for (int it = 0; it < 4; ++it) gq[it] = mfma16(__builtin_bit_cast(bf16x8_t, g2f[q][it]), fg, gq[it]); }
#pragma unroll
    for (int it = 0; it < 4; ++it) { const int i0 = 16 * it + 4 * lg;
        const f32x4 pv = (f32x4){bflo(pvr[it].x), bfhi(pvr[it].x), bflo(pvr[it].y), bfhi(pvr[it].y)}, pvp = (f32x4){bflo(pvq[it].x), bfhi(pvq[it].x), bflo(pvq[it].y), bfhi(pvq[it].y)};
        const f32x4 v4 = pv + (pvp - pv) * m4[it];
        const f32x4 o = ((acc[it] * rs) * w4[it] + b4[it] + v4 * bon) * gq[it];
        *(GAS v2u*)(XNb + row * D + 64 * h + i0) = pack4(o); }
    }
}
constexpr size_t WS_GKV = 464 * MiB;
constexpr size_t WS_GDEC = 29 * MiB + 512 * 1024;
constexpr int GL_LA = 0, GL_KR = 16384, GL_VT = GL_KR + MB, GL_TOT = GL_VT + 2 * MB, GL1_END = GL_TOT + 2048;
static_assert(GL1_END <= RING_BYTES, "GLA LDS map");

template <int NCT> __device__ __forceinline__ void gla_lora_tiles(ArgP A, size_t rowb, int h4, int rt, int ct0, LAS float* LAs, int lane) {
    const int l15 = lane & 15, lg = lane >> 4;
    const bf16* P = (const bf16*)(A->ws + WS_P); const bf16* WA2T = (const bf16*)(A->ws + WS_WA2T);
    v4u av = (v4u){0u, 0u, 0u, 0u};
    if (lg < 2) av = *(const GAS v4u*)(P + (rowb + 16 * rt + l15) * NIN_E + PC_WA1 + 8 * lg);
    const bf16x8_t af = __builtin_bit_cast(bf16x8_t, av);
#pragma unroll
    for (int c = 0; c < NCT; ++c) { const int ct = ct0 + c;
        const f32x4 x = mfma16(af, *(const GAS bf16x8_t*)(WA2T + (size_t)(64 * h4 + 16 * ct + l15) * 32 + 8 * lg), (f32x4){0.f, 0.f, 0.f, 0.f});
#pragma unroll
        for (int r = 0; r < 4; ++r) LAs[(16 * rt + 4 * lg + r) * 64 + 16 * ct + l15] = x[r]; }
}

__device__ __forceinline__ void gla_kv_item(ArgP A, int L, int b, int n, int h4, LAS unsigned char* lds, int tid) {
    const int lane = tid & 63, wave = __builtin_amdgcn_readfirstlane(tid >> 6), i = L >> 1, l15 = lane & 15, lg = lane >> 4;
    const bf16* P = (const bf16*)(A->ws + WS_P);
    const size_t rowb = (size_t)b * T + 64 * n; const int itemi = (b * 64 + n) * 4 + h4;
    LAS float* LAs = (LAS float*)(lds + GL_LA); LAS bf16* KrT = (LAS bf16*)(lds + GL_KR); LAS bf16* VTm = (LAS bf16*)(lds + GL_VT); LAS float* TOT = (LAS float*)(lds + GL_TOT);
    gla_lora_tiles<2>(A, rowb, h4, wave >> 1, 2 * (wave & 1), LAs, lane);
    __syncthreads();
    {
        const int c = 64 * h4 + lane, tt0 = 8 * wave; const float bac = A->in[24][i * 256 + c];
        float lc[8], kx[8], qx[8], v0[8], v1[8]; float run = 0.f;
#pragma unroll
        for (int u = 0; u < 8; ++u) { const bf16* pr = P + (rowb + tt0 + u) * NIN_E; const float x = bac + LAs[(tt0 + u) * 64 + lane];
            run += -softplus_f(-x) * (1.0f / 16.0f); lc[u] = run; kx[u] = bf2f(pr[PC_GK + c]); qx[u] = bf2f(pr[PC_GQ + c]); v0[u] = bf2f(pr[PC_GV + 128 * h4 + lane]); v1[u] = bf2f(pr[PC_GV + 128 * h4 + 64 + lane]); }
        TOT[wave * 64 + lane] = run;
        __syncthreads();
        float off = 0.f, tot = 0.f;
#pragma unroll
        for (int w2 = 0; w2 < 8; ++w2) { const float tv = TOT[w2 * 64 + lane]; tot += tv; if (w2 < wave) off += tv; }
        if (wave == 0) ((float*)(A->ws + WS_GDEC))[itemi * 64 + lane] = fexp(tot);
        { bf16* Pw = (bf16*)(A->ws + WS_P); const float etot = fexp(tot);
#pragma unroll
          for (int u = 0; u < 8; ++u) { const float cum = off + lc[u], e1 = fexp(cum), kt = kx[u] * frcp(e1); bf16* pw = Pw + (rowb + tt0 + u) * NIN_E;
              pw[PC_GQ + c] = (bf16)f2bf(qx[u] * 0.125f * e1); pw[PC_GK + c] = (bf16)f2bf(kt); kx[u] = kt * etot; } }
        *(LAS bf16x8_t*)(KrT + lane * MS + tt0) = pack8(kx); *(LAS bf16x8_t*)(VTm + lane * MS + tt0) = pack8(v0); *(LAS bf16x8_t*)(VTm + (64 + lane) * MS + tt0) = pack8(v1);
    }
    __syncthreads();
    {
        bf16* KVg = (bf16*)(A->ws + WS_GKV) + (size_t)itemi * 8192; const int rt = wave >> 1;
#pragma unroll
        for (int c = 0; c < 4; ++c) { const int et = 4 * (wave & 1) + c;
            const f32x4 acc = mm64((f32x4){0.f, 0.f, 0.f, 0.f}, KrT, rt, VTm, et, lane);
            *(GAS v2u*)(KVg + (16 * et + l15) * 64 + 16 * rt + 4 * lg) = pack4(acc); }
    }
    __syncthreads();
}

__device__ __forceinline__ void gla_state_scan(ArgP A, int gt, bool do_store = true) {
    const int bh = gt >> 11, grp = gt & 2047;
    const int b = bh >> 2, h4 = bh & 3;
    bf16* base = (bf16*)(A->ws + WS_GKV) + (size_t)((b * 64) * 4 + h4) * 8192 + (size_t)grp * 4;
    const float* dec = (const float*)(A->ws + WS_GDEC) + (size_t)((b * 64) * 4 + h4) * 64 + (grp & 15) * 4;
    f32x4 S = (f32x4){0.f, 0.f, 0.f, 0.f};
#pragma unroll 1
    for (int n0 = 0; n0 < 64; n0 += 8) {
        v2u kv[8]; f32x4 dc[8];
#pragma unroll
        for (int u = 0; u < 8; ++u) { kv[u] = *(const GAS v2u*)(base + (size_t)(n0 + u) * 4 * 8192); dc[u] = *(const GAS f32x4*)(dec + (size_t)(n0 + u) * 4 * 64); }
#pragma unroll
        for (int u = 0; u < 8; ++u) { if (do_store) *(GAS v2u*)(base + (size_t)(n0 + u) * 4 * 8192) = pack4(S);
            S = S * dc[u] + (f32x4){bflo(kv[u].x), bfhi(kv[u].x), bflo(kv[u].y), bfhi(kv[u].y)}; }
    }
}

constexpr int G3B_SV = 272, G3B_VT = 0, G3B_SC = 64 * G3B_SV, G3B_GRP = G3B_SC + MB;
static_assert(2 * G3B_GRP <= RING_BYTES, "GLA phase-3 LDS map");
__device__ __forceinline__ void gla_out_group(ArgP A, int L, int item2, LAS unsigned char* lds, int tid) {
    const int lane = tid & 63, wave = __builtin_amdgcn_readfirstlane(tid >> 6), i = L >> 1, l15 = lane & 15, lg = lane >> 4;
    const int gi = wave >> 2, wq = wave & 3;
    const int itemi = 2 * item2 + gi, h4 = itemi & 3, n = (itemi >> 2) & 63, b = itemi >> 8;
    const bf16* P = (const bf16*)(A->ws + WS_P); bf16* XNb = (bf16*)(A->ws + WS_XN);
    const size_t rowb = (size_t)b * T + 64 * n;
    LAS unsigned char* gb = lds + gi * G3B_GRP; LAS bf16* SC = (LAS bf16*)(gb + G3B_SC);
    { const int t4 = tid & 255;
#pragma unroll
      for (int q = 0; q < 4; ++q) { const int id = t4 + 256 * q, row = id >> 4, ch = id & 15;
          *(LAS v4u*)(gb + G3B_VT + row * G3B_SV + ch * 16) = *(const GAS v4u*)(P + (rowb + row) * NIN_E + PC_GV + 128 * h4 + 8 * ch); } }
    const int ct = wq; const int col = 16 * ct + l15;
    const bf16* qrow = P + (rowb + col) * NIN_E + PC_GQ + 64 * h4 + 8 * lg;
    const bf16x8_t qf0 = *(const GAS bf16x8_t*)qrow, qf1 = *(const GAS bf16x8_t*)(qrow + 32);
#pragma unroll
    for (int rt = 0; rt < 4; ++rt) { f32x4 acc = (f32x4){0.f, 0.f, 0.f, 0.f};
        if (rt <= ct) { const bf16* krow = P + (rowb + 16 * rt + l15) * NIN_E + PC_GK + 64 * h4 + 8 * lg;
            acc = mfma16(*(const GAS bf16x8_t*)krow, qf0, acc); acc = mfma16(*(const GAS bf16x8_t*)(krow + 32), qf1, acc);
#pragma unroll
            for (int r = 0; r < 4; ++r) if (!((16 * rt + 4 * lg + r) <= col)) acc[r] = 0.f; }
        tstore(SC, rt, ct, acc, lane); }
    __syncthreads();
    const bf16* Sg = (const bf16*)(A->ws + WS_GKV) + (size_t)itemi * 8192;
    const int vto = G3B_VT + (8 * lg + (l15 >> 2)) * G3B_SV + 4 * (lane & 3) * 2;
    f32x4 o[8]; float ss = 0.f;
#pragma unroll
    for (int et = 0; et < 8; ++et) { f32x4 acc = (f32x4){0.f, 0.f, 0.f, 0.f};
#pragma unroll
        for (int ks = 0; ks < 2; ++ks) { const LAS unsigned char* vp = gb + vto + ks * 32 * G3B_SV + et * 32;
            const a_s16x4 lo4 = __builtin_bit_cast(a_s16x4, __builtin_amdgcn_ds_read_tr16_b64_v4i16((LAS a_s16x4*)vp));
            const a_s16x4 hi4 = __builtin_bit_cast(a_s16x4, __builtin_amdgcn_ds_read_tr16_b64_v4i16((LAS a_s16x4*)(vp + 4 * G3B_SV)));
            const bf16x8_t vf = (bf16x8_t){lo4[0], lo4[1], lo4[2], lo4[3], hi4[0], hi4[1], hi4[2], hi4[3]};
            acc = mfma16(vf, ldfrag(SC, 16 * ct, 32 * ks, lane), acc); }
        acc = mfma16(*(const GAS bf16x8_t*)(Sg + (16 * et + l15) * 64 + 8 * lg), qf0, acc);
        acc = mfma16(*(const GAS bf16x8_t*)(Sg + (16 * et + l15) * 64 + 32 + 8 * lg), qf1, acc);
        o[et] = acc; ss += (acc[0] * acc[0] + acc[1] * acc[1]) + (acc[2] * acc[2] + acc[3] * acc[3]); }
    ss += __shfl_xor(ss, 16); ss += __shfl_xor(ss, 32);
    const float rs = frsq(ss * (1.f / 128.f) + 1e-5f);
    const size_t row = rowb + col; const float* gn = A->in[25] + i * 512 + 128 * h4;
#pragma unroll
    for (int et = 0; et < 8; ++et) { const int e0 = 16 * et + 4 * lg; const f32x4 g4 = *(const GAS f32x4*)(gn + e0); const f32x4 gg = ld4bf_g(P + row * NIN_E + PC_GG + 128 * h4 + e0);
        f32x4 v = o[et] * rs * g4; v[0] *= silu_f(gg[0]); v[1] *= silu_f(gg[1]); v[2] *= silu_f(gg[2]); v[3] *= silu_f(gg[3]);
        *(GAS v2u*)(XNb + row * D + 512 + 128 * h4 + e0) = pack4(v); }
    __syncthreads();
}
constexpr int N_STEPS = 37;
#ifndef MK_ONE_LAUNCH
#define MK_ONE_LAUNCH 1
#endif
__global__ void __launch_bounds__(NTHREADS, 2) hybrid_fwd(Args args) {
    extern __shared__ __attribute__((aligned(16))) unsigned char lds_raw[];
    LAS unsigned char* lds = (LAS unsigned char*)lds_raw;
    ArgP A0 = (ArgP)__builtin_amdgcn_kernarg_segment_ptr();
    { const int tid = threadIdx.x; for (int u = tid; u < (LDS_BYTES - LDSCTL_OFF) / 4; u += NTHREADS) ((LAS unsigned*)(lds + LDSCTL_OFF))[u] = 0u; }
    __syncthreads();
    const int lo = A0->lo, hi = A0->hi;
    if (hi - lo > 1) (void)xcd_barrier_post((unsigned*)(A0->ws + WS_CTL) + CW_BAR, (volatile LAS unsigned*)(lds + MISC_OFF) + 8);
#ifndef PHM
#define PHM 0xff
#endif
#define RUN(s) (lo <= (s) && (s) < hi)
#define EN(b) ((PHM >> (b)) & 1)
#ifndef PROBE_REP
#define PROBE_REP 0
#endif
#define REP(b) _Pragma("unroll 1") for (int rep_ = 0; rep_ < (((PROBE_REP >> (b)) & 1) ? 2 : 1); ++rep_)
#ifndef PROBE_TMASK
#define PROBE_TMASK 0u
#endif
    int nbar_ = 0;
    if (PROBE_TMASK) { if (blockIdx.x == 0 && threadIdx.x == 0) ((unsigned long long*)((unsigned*)(A0->ws + WS_CTL) + 32768))[0] = __builtin_amdgcn_s_memrealtime(); }
#define GRID_BARRIER() do { ArgP Ab_ = FRESH_ARGS(); XcdBarrier b_; b_.bar = (unsigned*)(Ab_->ws + WS_CTL) + CW_BAR; b_.x = xb_xcc_id(); b_.st = (volatile LAS unsigned*)(lds + MISC_OFF) + 8; xcd_barrier(b_); if (PROBE_TMASK) { ++nbar_; if (blockIdx.x == 0 && threadIdx.x == 0) ((unsigned long long*)((unsigned*)(Ab_->ws + WS_CTL) + 32768))[nbar_] = __builtin_amdgcn_s_memrealtime(); } } while (0)
#define SEAM(s) do { if (RUN(s) && RUN((s) + 1)) GRID_BARRIER(); } while (0)
#define PHASE_VARS() ArgP A = FRESH_ARGS(); int L = Lq; FRESH_S(L); int tid = threadIdx.x; FRESH_V(tid); const int lane = tid & 63, wave = __builtin_amdgcn_readfirstlane(tid >> 6); int G = gridDim.x, bid = blockIdx.x; FRESH_S(G); FRESH_S(bid); (void)lane; (void)wave; (void)G; (void)A; (void)bid; \
    bf16* XN = (bf16*)(A->ws + WS_XN); bf16* PB = (bf16*)(A->ws + WS_P); (void)XN; (void)PB

#define BAR2(a, b) do { if (RUN(a) && RUN(b)) GRID_BARRIER(); } while (0)
    if (EN(0) && RUN(0)) REP(0) { int Lq = 0; PHASE_VARS(); const int gw = bid * NWAVES + wave, NGW = G * NWAVES;
        convert_mixer_weights(A, 0, lds, wave, lane, gw, NGW);
        float* ssq0 = (float*)(A->ws + WS_SSQ);
        for (int m = gw; m < M; m += NGW) x_to_bf16_ssq(A->in[0] + (size_t)m * D, (bf16*)A->out + (size_t)m * D, ssq0 + (size_t)m * 16, lane); }
    BAR2(0, 1);
    for (int Lq = 0; Lq < 4; ++Lq) {
        const int s0 = 9 * Lq; const bool even = !(Lq & 1);
        if (EN(1) && RUN(s0 + 1)) REP(1) {
            PHASE_VARS(); bf16* Win = (bf16*)(A->ws + WS_WIN); const float* ssq = (const float*)(A->ws + WS_SSQ);
            if (even) {
                pg8::Gemm g{(bf16*)A->out, Win, M, NIN_E, D}; pg8::StaticOrderC<M, NIN_E> S; S.init(G, bid);
                pg8::fill_row_scales(S, ssq, (LAS float*)(lds + RSTAB_OFF), tid);
                pg8::EpiStoreBf16 E{PB, NIN_E, 0, 1.0f, (const LAS float*)(lds + RSTAB_OFF)};
                pg8::gemm_phase<pg8::EpiStoreBf16, pg8::StaticOrderC<M, NIN_E>, PG8_ALIGN, PG8_SP2>(lds, g, S, E);
            } else {
                pg8::Gemm g{(bf16*)A->out, Win, M, NIN_O, D}; pg8::StaticOrderC<M, NIN_O> S; S.init(G, bid);
                pg8::fill_row_scales(S, ssq, (LAS float*)(lds + RSTAB_OFF), tid);
                pg8::EpiStoreBf16 E{PB, NIN_O, 4, 0.125f * 1.4426950408889634f, (const LAS float*)(lds + RSTAB_OFF)};
                pg8::gemm_phase<pg8::EpiStoreBf16, pg8::StaticOrderC<M, NIN_O>, PG8_ALIGN, PG8_SP2>(lds, g, S, E);
            }
        }
        if (even) {
            BAR2(s0 + 1, s0 + 2);
            if (EN(2) && RUN(s0 + 2)) REP(2) { PHASE_VARS();
                rwkv_chunk_phase(A, L, lds, tid, G, bid);
                REP(8) {
#pragma unroll 1
                for (int it = bid; it < BATCH * 64 * 4; it += G) gla_kv_item(A, L, it >> 8, (it >> 2) & 63, it & 3, lds, tid); } }
            BAR2(s0 + 2, s0 + 3);
            if (EN(3) && RUN(s0 + 3)) {
                PHASE_VARS();
                if (bid < 64) { if (wave == 0) rwkv_state_scan(A, bid >> 3, bid & 7, lane); }
                else { for (int gt = (bid - 64) * NTHREADS + tid; gt < 32 * 2048; gt += (G - 64) * NTHREADS) gla_state_scan(A, gt);
                       convert_ffn_weights(A, L, lds, wave, lane, (bid - 64) * NWAVES + wave, (G - 64) * NWAVES); }
            }
            BAR2(s0 + 3, s0 + 4);
            if (EN(3) && RUN(s0 + 4)) {
                PHASE_VARS();
                REP(9) {
#pragma unroll 1
                for (int i2 = bid; i2 < BATCH * 64 * 4 / 2; i2 += G) gla_out_group(A, L, i2, lds, tid); }
                rwkv_out_phase(A, L, bid * NWAVES + wave, G * NWAVES, lane);
            }
            BAR2(s0 + 4, s0 + 5);
        } else {
            BAR2(s0 + 1, s0 + 3);
            if (EN(4) && RUN(s0 + 3) && ((PROBE_REP >> 16) & 1)) { PHASE_VARS(); attn_phase_mfma<true>(A, L, lds, tid, G, bid); }
            if (EN(4) && RUN(s0 + 3)) REP(4) { PHASE_VARS(); attn_phase_mfma(A, L, lds, tid, G, bid); convert_ffn_weights(A, L, lds, wave, lane, bid * NWAVES + wave, G * NWAVES); }
            BAR2(s0 + 3, s0 + 5);
        }
        if (EN(5) && RUN(s0 + 5)) {
            PHASE_VARS(); bf16* Wout = (bf16*)(A->ws + WS_WOUT);
            pg8::Gemm g{XN, Wout, M, D, D}; pg8::StaticOrderC<M, D> S; S.init(G, bid);
            if ((PROBE_REP >> 5) & 1) { pg8::EpiResBf16<false, true> E0{(bf16*)A->out, D, (float*)(A->ws + WS_SSQ) + (size_t)M * 16, nullptr};
                pg8::gemm_phase<pg8::EpiResBf16<false, true>, pg8::StaticOrderC<M, D>, PG8_ALIGN, PG8_SP2>(lds, g, S, E0); }
            pg8::EpiResBf16<false> E{(bf16*)A->out, D, (float*)(A->ws + WS_SSQ) + (size_t)M * 16, nullptr};
            pg8::gemm_phase<pg8::EpiResBf16<false>, pg8::StaticOrderC<M, D>, PG8_ALIGN, PG8_SP2>(lds, g, S, E);
        }
        BAR2(s0 + 5, s0 + 7);
        if (EN(6) && RUN(s0 + 7)) REP(6) {
            PHASE_VARS(); bf16* Wgu = (bf16*)(A->ws + WS_WGU);
            pg8::Gemm g{(bf16*)A->out, Wgu, M, NGU, D}; pg8::StaticOrderC<M, NGU> S; S.init(G, bid);
            pg8::fill_row_scales(S, (const float*)(A->ws + WS_SSQ) + (size_t)M * 16, (LAS float*)(lds + RSTAB_OFF), tid);
            if ((PROBE_REP >> 18) & 1) { pg8::EpiNull En; pg8::gemm_phase<pg8::EpiNull, pg8::StaticOrderC<M, NGU>, PG8_ALIGN, PG8_SP2>(lds, g, S, En); }
            if ((PROBE_REP >> 15) & 1) { pg8::EpiSwigluT<true> E0{PB, FF, (const LAS float*)(lds + RSTAB_OFF)};
                pg8::gemm_phase<pg8::EpiSwigluT<true>, pg8::StaticOrderC<M, NGU>, PG8_ALIGN, PG8_SP2>(lds, g, S, E0); }
            pg8::EpiSwiglu E{PB, FF, (const LAS float*)(lds + RSTAB_OFF)};
            pg8::gemm_phase<pg8::EpiSwiglu, pg8::StaticOrderC<M, NGU>, PG8_ALIGN, PG8_SP2>(lds, g, S, E);
        }
        BAR2(s0 + 7, s0 + 8);
        if (EN(7) && RUN(s0 + 8)) {
            PHASE_VARS(); bf16* Wdn = (bf16*)(A->ws + WS_WDN);
            pg8::Gemm g{PB, Wdn, M, D, FF}; pg8::StaticOrderC<M, D> S; S.init(G, bid);
            if ((PROBE_REP >> 7) & 1) { pg8::EpiResBf16<false, true> E0{(bf16*)A->out, D, (float*)(A->ws + WS_SSQ), nullptr};
                pg8::gemm_phase<pg8::EpiResBf16<false, true>, pg8::StaticOrderC<M, D>, PG8_ALIGN, PG8_SP2>(lds, g, S, E0); }
            if (L < 3) { pg8::EpiResBf16<false> E{(bf16*)A->out, D, (float*)(A->ws + WS_SSQ), nullptr};
                pg8::gemm_phase<pg8::EpiResBf16<false>, pg8::StaticOrderC<M, D>, PG8_ALIGN, PG8_SP2>(lds, g, S, E);
                convert_mixer_weights(A, L + 1, lds, wave, lane, bid * NWAVES + wave, G * NWAVES); }
            else { pg8::EpiResBf16<true> E{(bf16*)A->out, D, (float*)(A->ws + WS_SSQ), XN};
                pg8::gemm_phase<pg8::EpiResBf16<true>, pg8::StaticOrderC<M, D>, PG8_ALIGN, PG8_SP2>(lds, g, S, E); }
        }
        BAR2(s0 + 8, Lq < 3 ? s0 + 10 : 36);
    }
    if (RUN(36)) REP(17) {
        int Lq = 0; PHASE_VARS();
        const int gw = bid * NWAVES + wave, NGW = G * NWAVES;
        float pscale_ = 1.0f;
        if (PROBE_TMASK) { const unsigned long long* ts = (const unsigned long long*)((const unsigned*)(A->ws + WS_CTL) + 32768); unsigned long long acc_ = 0;
            for (int k = 1; k <= 25; ++k) if ((PROBE_TMASK >> k) & 1u) acc_ += ts[k] - ts[k - 1];
            pscale_ = 1.0f + __builtin_sqrtf((float)acc_ * 0.01f * 1e-4f); }
        for (int m = gw; m < M; m += NGW) rms_row_bf16_to_f32(XN + (size_t)m * D, A->in[4], A->out + (size_t)m * D, lane, pscale_);
    }
#undef RUN
#undef SEAM
}

extern "C" void kernel_launch(void* const* d_in, const int* in_sizes, int n_in, void* d_out, int out_size, void* d_ws, size_t ws_size, hipStream_t stream) {
    static int grid = 0;
    if (grid == 0) {
        if (n_in != 36 || in_sizes[0] != M * D || out_size != M * D || ws_size < WS_END) { fprintf(stderr, "kernel_launch: unexpected shapes (n_in %d, in0 %d, out %d, ws %zu); nothing launched\n", n_in, n_in > 0 ? in_sizes[0] : -1, out_size, ws_size); grid = -1; return; }
        int dev = 0, cus = 0, per_cu = 0;
        if (hipGetDevice(&dev) != hipSuccess || hipDeviceGetAttribute(&cus, hipDeviceAttributeMultiprocessorCount, dev) != hipSuccess) { grid = -1; return; }
        if (hipFuncSetAttribute((const void*)hybrid_fwd, hipFuncAttributeMaxDynamicSharedMemorySize, LDS_BYTES) != hipSuccess) { fprintf(stderr, "kernel_launch: hipFuncSetAttribute failed\n"); grid = -1; return; }
        if (hipOccupancyMaxActiveBlocksPerMultiprocessor(&per_cu, (const void*)hybrid_fwd, NTHREADS, LDS_BYTES) != hipSuccess || per_cu < 1) fprintf(stderr, "kernel_launch: occupancy query reports %d\n", per_cu);
        (void)hipGetLastError();
        if (cus < 128) { fprintf(stderr, "kernel_launch: built for a 256-CU device (phase 3 of the even layers needs more than 64 workgroups); nothing launched\n"); grid = -1; return; }
        grid = cus;
    }
    if (grid < 0) return;
    if (hipMemsetAsync((char*)d_ws + WS_CTL, 0, CTL_ZERO_BYTES, stream) != hipSuccess) return;
    Args a{};
    for (int i = 0; i < 36; ++i) a.in[i] = (const float*)d_in[i];
    a.out = (float*)d_out; a.ws = (unsigned char*)d_ws;
#if MK_ONE_LAUNCH
    a.lo = 0; a.hi = N_STEPS;
    hipLaunchKernelGGL(hybrid_fwd, dim3(grid), dim3(NTHREADS), LDS_BYTES, stream, a);
#else
    for (int s = 0; s < N_STEPS; ++s) {
        if (s < 36 && ((s % 9) == 2 || (s % 9) == 4) && ((s / 9) & 1)) continue;
        a.lo = s; a.hi = s + 1;
        hipLaunchKernelGGL(hybrid_fwd, dim3(grid), dim3(NTHREADS), LDS_BYTES, stream, a);
    }
#endif
}
```

```cpp
#include <hip/hip_runtime.h>
#include <cstdio>
#include <cstdint>
__device__ __forceinline__ float silu_f(float x) { return x * __builtin_amdgcn_rcpf(1.0f + __builtin_amdgcn_exp2f(-1.4426950408889634f * x)); }
namespace pg8 {
#define PG8_LAS __attribute__((address_space(3)))
typedef unsigned short bf16_t;
typedef short bf16x8 __attribute__((ext_vector_type(8)));
typedef float f32x4 __attribute__((ext_vector_type(4)));
typedef unsigned u32x4 __attribute__((ext_vector_type(4)));
constexpr int BM = 256, BK = 64, HALF = 128, HTB = HALF * BK * 2  , STAGE_BYTES = 8 * HTB, NXCD = 8, WGM = 4;

__host__ __device__ __forceinline__ int lds_byte(int r, int c) { const int st = (r >> 4) * 2 + (c >> 5), rr = r & 15, cc = c & 31, ob = rr * 64 + cc * 2; return st * 1024 + (ob ^ (((ob >> 9) & 1) << 5)); }
__host__ __device__ __forceinline__ void stage_rc(int b, int& R, int& C) { const int st = b / 1024, sb = b % 1024, swz = sb ^ (((sb >> 9) & 1) << 5); R = (st >> 1) * 16 + swz / 64; C = (st & 1) * 32 + (swz % 64) / 2; }
__host__ __device__ __forceinline__ int perm32(int rho) { const int n = rho >> 4, i = rho & 15; return 8 * (i >> 2) + 4 * n + (i & 3); }

struct Unit { int pm, pn, idx; };
struct Gemm { const bf16_t* A; const bf16_t* Bt; int M, N, K; };

struct StaticOrder {
    int nM, nN, nwg, G, c;
    __host__ __device__ void init(int M, int N, int G_, int c_) { nM = M / BM; nN = N / BM; nwg = nM * nN; G = G_; c = c_; }
    __host__ __device__ bool next(int i, Unit& u) const {
        const long L = (long)i * G + c; if (L >= nwg) return false;
        int wgid = (int)L; { const int q = nwg / NXCD, r = nwg % NXCD, xcd = wgid % NXCD, off = wgid / NXCD; wgid = (xcd < r ? xcd * (q + 1) : r * (q + 1) + (xcd - r) * q) + off; }
        const int nig = WGM * nN, gid = wgid / nig, fm = gid * WGM, gsz = (nM - fm) < WGM ? (nM - fm) : WGM;
        u.pm = fm + ((wgid % nig) % gsz); u.pn = (wgid % nig) / gsz; return true;
    }
    __device__ __forceinline__ void a_ready(const Unit&) const {}
    __device__ __forceinline__ void done(const Unit&) const {}
};

__device__ __forceinline__ unsigned cvt_pk_bf16(float lo, float hi) { unsigned r; asm volatile("v_cvt_pk_bf16_f32 %0, %1, %2" : "=v"(r) : "v"(lo), "v"(hi)); return r; }
typedef float f32x2 __attribute__((ext_vector_type(2)));
__device__ __forceinline__ float row_ssq(const float* ssq, int row) { const f32x4* p = (const f32x4*)(ssq + (size_t)row * 16); const f32x4 a = p[0], b = p[1], c = p[2], d = p[3];
    return (((a[0] + a[1]) + (a[2] + a[3])) + ((b[0] + b[1]) + (b[2] + b[3]))) + (((c[0] + c[1]) + (c[2] + c[3])) + ((d[0] + d[1]) + (d[2] + d[3]))); }
struct EpiStoreBf16 {
    static constexpr bool PERM = true, AFTER_DRAIN = false;
    bf16_t* O; int ldc; int qtiles; float qscale; const PG8_LAS float* rstab;
    __device__ __forceinline__ void operator()(const f32x4 (&acc)[2][2][4][2], const Unit& u, int wr, int wc, int fr, int fq) const {
        const int row0 = u.pm * BM + wr * 64 + fr, col0 = u.pn * BM + wc * 32 + 8 * fq;
        const float sc = u.pn < qtiles ? qscale : 1.0f;
        const PG8_LAS float* rt_ = rstab + u.idx * BM + wr * 64 + fr;
#pragma unroll
        for (int ai = 0; ai < 2; ++ai)
#pragma unroll
            for (int m = 0; m < 4; ++m) { const int row = row0 + ai * HALF + m * 16; bf16_t* rowp = O + (size_t)row * ldc + col0;
                const float rs = sc * rt_[ai * HALF + m * 16];
#pragma unroll
                for (int bj = 0; bj < 2; ++bj) { const f32x4 v0 = acc[ai][bj][m][0] * rs, v1 = acc[ai][bj][m][1] * rs;
                    u32x4 w; w.x = cvt_pk_bf16(v0[0], v0[1]); w.y = cvt_pk_bf16(v0[2], v0[3]); w.z = cvt_pk_bf16(v1[0], v1[1]); w.w = cvt_pk_bf16(v1[2], v1[3]);
                    *(u32x4*)(rowp + bj * HALF) = w; } }
    }
};
template <bool LAST, bool NOSTORE = false> struct EpiResBf16 {
    static constexpr bool PERM = false, AFTER_DRAIN = false;
    bf16_t* xr; int ldc; float* ssq; bf16_t* xf;
    __device__ __forceinline__ void operator()(const f32x4 (&acc)[2][2][4][2], const Unit& u, int wr, int wc, int fr, int fq) const {
        typedef unsigned u32x2 __attribute__((ext_vector_type(2)));
        const int row0 = u.pm * BM + wr * 64 + fr, col0 = u.pn * BM + wc * 32 + 4 * fq;
#pragma unroll
        for (int ai = 0; ai < 2; ++ai)
#pragma unroll
            for (int m = 0; m < 4; ++m) { const int row = row0 + ai * HALF + m * 16; const size_t off = (size_t)row * ldc + col0; float s = 0.f;
#pragma unroll
                for (int bj = 0; bj < 2; ++bj)
#pragma unroll
                    for (int n = 0; n < 2; ++n) { const u32x2 bw = *(const u32x2*)(xr + off + bj * HALF + n * 16);
                        const f32x4 b = (f32x4){__builtin_bit_cast(float, bw.x << 16), __builtin_bit_cast(float, bw.x & 0xffff0000u), __builtin_bit_cast(float, bw.y << 16), __builtin_bit_cast(float, bw.y & 0xffff0000u)};
                        const f32x4 v = b + acc[ai][bj][m][n];
                        s += (v[0] * v[0] + v[1] * v[1]) + (v[2] * v[2] + v[3] * v[3]);
                        u32x2 w; w.x = cvt_pk_bf16(v[0], v[1]); w.y = cvt_pk_bf16(v[2], v[3]); if (!NOSTORE) *(u32x2*)((LAST ? xf : xr) + off + bj * HALF + n * 16) = w; else asm volatile("" :: "v"(w.x), "v"(w.y)); }
                s += __shfl_xor(s, 16); s += __shfl_xor(s, 32);
                if (fq == 0 && !NOSTORE) ssq[(size_t)row * 16 + u.pn * 4 + wc] = s;
                if (m & 1) asm volatile("" ::: "memory"); }
    }
};
template <bool NOSTORE = false> struct EpiSwigluT {
    static constexpr bool PERM = true, AFTER_DRAIN = false;
    bf16_t* H; int ldc; const PG8_LAS float* rstab;
    __device__ __forceinline__ void operator()(const f32x4 (&acc)[2][2][4][2], const Unit& u, int wr, int wc, int fr, int fq) const {
        const int row0 = u.pm * BM + wr * 64 + fr, colh = u.pn * HALF + wc * 32 + 8 * fq;
        const PG8_LAS float* rt_ = rstab + u.idx * BM + wr * 64 + fr;
#pragma unroll
        for (int ai = 0; ai < 2; ++ai)
#pragma unroll
            for (int m = 0; m < 4; ++m) { const int row = row0 + ai * HALF + m * 16; bf16_t* rowp = H + (size_t)row * ldc + colh;
                const float rs = rt_[ai * HALF + m * 16];
                const f32x4 g0 = acc[ai][0][m][0] * rs, g1 = acc[ai][0][m][1] * rs, u0 = acc[ai][1][m][0] * rs, u1 = acc[ai][1][m][1] * rs;
                float h[8];
#pragma unroll
                for (int e = 0; e < 4; ++e) { h[e] = silu_f(g0[e]) * u0[e]; h[4 + e] = silu_f(g1[e]) * u1[e]; }
                u32x4 w; w.x = cvt_pk_bf16(h[0], h[1]); w.y = cvt_pk_bf16(h[2], h[3]); w.z = cvt_pk_bf16(h[4], h[5]); w.w = cvt_pk_bf16(h[6], h[7]);
                if (!NOSTORE) *(u32x4*)rowp = w; else asm volatile("" :: "v"(w.x), "v"(w.y), "v"(w.z), "v"(w.w)); }
    }
};
typedef EpiSwigluT<false> EpiSwiglu;
struct EpiNull {
    static constexpr bool PERM = true, AFTER_DRAIN = false;
    __device__ __forceinline__ void operator()(const f32x4 (&acc)[2][2][4][2], const Unit& u, int wr, int wc, int fr, int fq) const {
#pragma unroll
        for (int ai = 0; ai < 2; ++ai)
#pragma unroll
            for (int bj = 0; bj < 2; ++bj)
#pragma unroll
                for (int m = 0; m < 4; ++m)
#pragma unroll
                    for (int n = 0; n < 2; ++n) asm volatile("" :: "v"(acc[ai][bj][m][n]));
    }
};
template <int M_, int N_> struct StaticOrderC {
    static constexpr int nM = M_ / BM, nN = N_ / BM, nwg = nM * nN;
    int G, c;
    __device__ __forceinline__ void init(int G_, int c_) { G = G_; c = c_; }
    __device__ __forceinline__ bool next(int i, Unit& u) const {
        const int L = i * G + c; if (L >= nwg) return false;
        int wgid = L; { constexpr int q = nwg / NXCD, r = nwg % NXCD; const int xcd = wgid % NXCD, off = wgid / NXCD; wgid = (xcd < r ? xcd * (q + 1) : r * (q + 1) + (xcd - r) * q) + off; }
        constexpr int nig = WGM * nN; const int gid = wgid / nig, fm = gid * WGM, gsz = (nM - fm) < WGM ? (nM - fm) : WGM;
        u.pm = fm + ((wgid % nig) % gsz); u.pn = (wgid % nig) / gsz; u.idx = i; return true;
    }
    __device__ __forceinline__ void a_ready(const Unit&) const {}
    __device__ __forceinline__ void done(const Unit&) const {}
};
template <class Sched> __device__ __forceinline__ void fill_row_scales(const Sched& S, const float* ssq, PG8_LAS float* tab, int tid) {
    Unit u; const int r = tid >> 1, hf = tid & 1;
    for (int i = 0; S.next(i, u); ++i) { const f32x4* p = (const f32x4*)(ssq + (size_t)(u.pm * BM + r) * 16 + hf * 8); const f32x4 a = p[0], b = p[1];
        float sum = ((a[0] + a[1]) + (a[2] + a[3])) + ((b[0] + b[1]) + (b[2] + b[3])); sum += __shfl_xor(sum, 1);
        if (hf == 0) tab[i * BM + r] = __builtin_amdgcn_rsqf(sum * (1.0f / 1024.0f) + 1e-6f); }
    __syncthreads();
}
template <class Epi, class Sched, bool ALIGN_EPI = false, bool SP2 = false>
__device__ __forceinline__ void gemm_phase(PG8_LAS unsigned char* lds, const Gemm g, const Sched& S, const Epi& E) {
    int tid_ = threadIdx.x; asm volatile("" : "+v"(tid_));
    float zz_ = 0.f; asm volatile("" : "+v"(zz_));
    const int tid = tid_, wid = __builtin_amdgcn_readfirstlane(tid >> 6), lane = tid & 63, wr = wid >> 2, wc = wid & 3, fr = lane & 15, fq = lane >> 4;
    const int K = g.K, nt = K / BK;
    unsigned voffA[2], voffB[2];
#pragma unroll
    for (int i = 0; i < 2; ++i) { int R, C; stage_rc(tid * 16 + i * 8192, R, C); const int Rb = Epi::PERM ? ((R & ~31) + perm32(R & 31)) : R;
        voffA[i] = (unsigned)(R * K + C) * 2u; voffB[i] = (unsigned)(Rb * K + C) * 2u; }
    const size_t kstep = (size_t)(BK * 2);
    const size_t hstep = (size_t)HALF * K * 2;
    const size_t tstep = 2 * hstep;
    const unsigned ldsw = (unsigned)wid * 1024u;
    const int aoff = lds_byte(wr * 64 + fr, fq * 8), boff = lds_byte(wc * 32 + fr, fq * 8);
#define PG8_SA(b, h) (((b) * 2 + (h)) * HTB)
#define PG8_SB(b, h) ((4 + (b) * 2 + (h)) * HTB)
#define PG8_STAGE(bufoff, gbase, voff) do { _Pragma("unroll") for (int _i = 0; _i < 2; ++_i) \
        __builtin_amdgcn_global_load_lds((const unsigned*)((const char*)(gbase) + (voff)[_i]), (PG8_LAS unsigned*)(lds + (bufoff) + ldsw + _i * 8192), 16, 0, 0); } while (0)
#define PG8_LDA(dst, b, h) do { _Pragma("unroll") for (int m = 0; m < 4; ++m) _Pragma("unroll") for (int k = 0; k < 2; ++k) dst[m][k] = *(const PG8_LAS bf16x8*)(lds + PG8_SA(b, h) + aoff + m * 2048 + k * 1024); } while (0)
#define PG8_LDB(dst, b, h) do { _Pragma("unroll") for (int n = 0; n < 2; ++n) _Pragma("unroll") for (int k = 0; k < 2; ++k) dst[n][k] = *(const PG8_LAS bf16x8*)(lds + PG8_SB(b, h) + boff + n * 2048 + k * 1024); } while (0)
#define PG8_MMA(ai, bj, At, Bt) do { __builtin_amdgcn_s_setprio(1); _Pragma("unroll") for (int m = 0; m < 4; ++m) _Pragma("unroll") for (int n = 0; n < 2; ++n) _Pragma("unroll") for (int k = 0; k < 2; ++k) \
        acc[ai][bj][m][n] = __builtin_amdgcn_mfma_f32_16x16x32_bf16(Bt[n][k], At[m][k], acc[ai][bj][m][n], 0, 0, 0); __builtin_amdgcn_s_setprio(0); } while (0)
#define PG8_WAIT_V(n) asm volatile("s_waitcnt vmcnt(" #n ")" ::: "memory")
#define PG8_WAIT_L(n) asm volatile("s_waitcnt lgkmcnt(" #n ")" ::: "memory")
#define PG8_BAR __builtin_amdgcn_s_barrier()
#define PG8_SCHED __builtin_amdgcn_sched_barrier(0)
    Unit cur, nxt; int ui = 0;
    if (!S.next(0, cur)) return;
    f32x4 acc[2][2][4][2];
#pragma unroll
    for (int a = 0; a < 2; ++a)
#pragma unroll
        for (int b = 0; b < 2; ++b)
#pragma unroll
            for (int m = 0; m < 4; ++m)
#pragma unroll
                for (int n = 0; n < 2; ++n) acc[a][b][m][n] = (f32x4){zz_, zz_, zz_, zz_};
    bf16x8 At[4][2], B0[2][2], B1[2][2];
    const char* cA = (const char*)g.A + (size_t)cur.pm * tstep; const char* cB = (const char*)g.Bt + (size_t)cur.pn * tstep;
    S.a_ready(cur);
    if constexpr (SP2) {
        PG8_STAGE(PG8_SB(0, 0), cB, voffB); PG8_STAGE(PG8_SB(0, 1), cB + hstep, voffB); PG8_STAGE(PG8_SA(0, 0), cA, voffA); PG8_STAGE(PG8_SA(0, 1), cA + hstep, voffA);
        if (wr == 1) PG8_BAR;
        PG8_WAIT_V(2); PG8_BAR;
        PG8_STAGE(PG8_SB(1, 0), cB + kstep, voffB); PG8_STAGE(PG8_SA(1, 0), cA + kstep, voffA); PG8_STAGE(PG8_SB(1, 1), cB + hstep + kstep, voffB);
        PG8_WAIT_V(6); PG8_BAR;
    } else {
        PG8_STAGE(PG8_SB(0, 0), cB, voffB); PG8_STAGE(PG8_SA(0, 0), cA, voffA); PG8_STAGE(PG8_SB(0, 1), cB + hstep, voffB); PG8_STAGE(PG8_SA(0, 1), cA + hstep, voffA);
        if (wr == 1) PG8_BAR;
        PG8_WAIT_V(4); PG8_BAR;
        PG8_STAGE(PG8_SB(1, 0), cB + kstep, voffB); PG8_STAGE(PG8_SA(1, 0), cA + kstep, voffA); PG8_STAGE(PG8_SB(1, 1), cB + hstep + kstep, voffB);
        PG8_WAIT_V(6); PG8_BAR;
    }
    for (;;) {
        const bool has_next = S.next(ui + 1, nxt);
        const char* nA = has_next ? (const char*)g.A + (size_t)nxt.pm * tstep : cA; const char* nB = has_next ? (const char*)g.Bt + (size_t)nxt.pn * tstep : cB;
        for (int t = 0; t < nt; t += 2) {
            const bool last = (t == nt - 2);
            const char* a1 = cA + (size_t)(t + 1) * kstep;
            const char* a2 = last ? nA : cA + (size_t)(t + 2) * kstep; const char* b2 = last ? nB : cB + (size_t)(t + 2) * kstep;
            const char* a3 = a2 + kstep; const char* b3 = b2 + kstep;
            if (last && has_next) S.a_ready(nxt);
            if constexpr (SP2) {
            PG8_LDB(B0, 0, 0); PG8_LDB(B1, 0, 1); PG8_SCHED; PG8_LDA(At, 0, 0); PG8_STAGE(PG8_SA(1, 1), a1 + hstep, voffA);
            PG8_WAIT_V(8); PG8_WAIT_L(0); PG8_BAR; PG8_MMA(0, 0, At, B0); PG8_MMA(0, 1, At, B1); PG8_BAR; PG8_SCHED;
            PG8_LDA(At, 0, 1); PG8_STAGE(PG8_SB(0, 0), b2, voffB); PG8_STAGE(PG8_SB(0, 1), b2 + hstep, voffB); PG8_STAGE(PG8_SA(0, 0), a2, voffA);
            PG8_WAIT_V(8); PG8_WAIT_L(0); PG8_BAR; PG8_MMA(1, 0, At, B0); PG8_MMA(1, 1, At, B1); PG8_BAR; PG8_SCHED;
            PG8_LDB(B0, 1, 0); PG8_LDB(B1, 1, 1); PG8_SCHED; PG8_LDA(At, 1, 0); PG8_STAGE(PG8_SA(0, 1), a2 + hstep, voffA);
            PG8_WAIT_V(8); PG8_WAIT_L(0); PG8_BAR; PG8_MMA(0, 0, At, B0); PG8_MMA(0, 1, At, B1); PG8_BAR; PG8_SCHED;
            PG8_LDA(At, 1, 1); PG8_STAGE(PG8_SB(1, 0), b3, voffB); PG8_STAGE(PG8_SB(1, 1), b3 + hstep, voffB); PG8_STAGE(PG8_SA(1, 0), a3, voffA);
            PG8_WAIT_V(8); PG8_WAIT_L(0); PG8_BAR; PG8_MMA(1, 0, At, B0); PG8_MMA(1, 1, At, B1); PG8_BAR; PG8_SCHED;
            } else {
            PG8_LDB(B0, 0, 0); PG8_SCHED; PG8_LDA(At, 0, 0); PG8_STAGE(PG8_SA(1, 1), a1 + hstep, voffA);
            PG8_WAIT_L(8); PG8_BAR; PG8_WAIT_L(0); PG8_MMA(0, 0, At, B0); PG8_BAR; PG8_SCHED;
            PG8_LDB(B1, 0, 1); PG8_STAGE(PG8_SB(0, 0), b2, voffB);
            PG8_BAR; PG8_WAIT_L(0); PG8_MMA(0, 1, At, B1); PG8_BAR;
            PG8_LDA(At, 0, 1); PG8_STAGE(PG8_SA(0, 0), a2, voffA);
            PG8_BAR; PG8_WAIT_L(0); PG8_MMA(1, 0, At, B0); PG8_BAR; PG8_SCHED;
            PG8_STAGE(PG8_SB(0, 1), b2 + hstep, voffB);
            PG8_WAIT_V(6); PG8_BAR; PG8_MMA(1, 1, At, B1); PG8_BAR;
            PG8_LDB(B0, 1, 0); PG8_SCHED; PG8_LDA(At, 1, 0); PG8_STAGE(PG8_SA(0, 1), a2 + hstep, voffA);
            PG8_WAIT_L(8); PG8_BAR; PG8_WAIT_L(0); PG8_MMA(0, 0, At, B0); PG8_BAR; PG8_SCHED;
            PG8_LDB(B1, 1, 1); PG8_STAGE(PG8_SB(1, 0), b3, voffB);
            PG8_BAR; PG8_WAIT_L(0); PG8_MMA(0, 1, At, B1); PG8_BAR;
            PG8_LDA(At, 1, 1); PG8_STAGE(PG8_SA(1, 0), a3, voffA);
            PG8_BAR; PG8_WAIT_L(0); PG8_MMA(1, 0, At, B0); PG8_BAR; PG8_SCHED;
            PG8_STAGE(PG8_SB(1, 1), b3 + hstep, voffB);
            PG8_WAIT_V(6); PG8_BAR; PG8_MMA(1, 1, At, B1); PG8_BAR;
            }
        }
        if constexpr (ALIGN_EPI) { if (wr == 0) PG8_BAR; }
        if constexpr (!Epi::AFTER_DRAIN) { E(acc, cur, wr, wc, fr, fq); S.done(cur); }
        if (!has_next) break;
#pragma unroll
        for (int a = 0; a < 2; ++a)
#pragma unroll
            for (int b = 0; b < 2; ++b)
#pragma unroll
                for (int m = 0; m < 4; ++m)
#pragma unroll
                    for (int n = 0; n < 2; ++n) acc[a][b][m][n] = (f32x4){zz_, zz_, zz_, zz_};
        cur = nxt; cA = nA; cB = nB; ++ui;
        if constexpr (ALIGN_EPI) { if (wr == 1) PG8_BAR; }
    }
    PG8_WAIT_V(0);
    if constexpr (!ALIGN_EPI) { if (wr == 0) PG8_BAR; }
    PG8_BAR;
    if constexpr (Epi::AFTER_DRAIN) { E.fused(acc, cur, wr, wc, fr, fq, lds, wid, lane); S.done(cur); }
#undef PG8_SA
#undef PG8_SB
#undef PG8_STAGE
#undef PG8_LDA
#undef PG8_LDB
#undef PG8_MMA
#undef PG8_WAIT_V
#undef PG8_WAIT_L
#undef PG8_BAR
#undef PG8_SCHED
}
}
#ifndef PG8_SP2
#define PG8_SP2 true
#endif
#ifndef PG8_ALIGN
#define PG8_ALIGN true
#endif
constexpr int NWAVES = 8, NTHREADS = NWAVES * 64;
constexpr int BATCH = 8, T = 4096, D = 1024, M = BATCH * T;
constexpr int NIN_E = 3840, NIN_O = 3072, FF = 2816, NGU = 2 * FF;
constexpr int PC_R = 0, PC_K = 512, PC_V = 1024, PC_GQ = 1536, PC_GK = 1792, PC_GV = 2048, PC_GG = 2560;
constexpr int PC_W1A = 3072, PC_W1B = 3136, PC_A1A = 3200, PC_A1B = 3264, PC_G1A = 3328, PC_G1B = 3488, PC_WA1 = 3648, PC_PAD = 3664;
constexpr int NLORA = 304;
constexpr size_t MiB = 1u << 20;
constexpr size_t WS_CTL = 0, CTL_ZERO_BYTES = 1 * MiB;
constexpr size_t WS_WIN = 2 * MiB, WS_WOUT = 10 * MiB, WS_WGU = 12 * MiB, WS_WDN = 23 * MiB;
constexpr size_t WS_W2T = 29 * MiB, WS_A2T = WS_W2T + 65536, WS_G2T = WS_A2T + 65536, WS_WA2T = WS_G2T + 196608;
constexpr size_t WS_SSQ = 496 * MiB;
constexpr size_t WS_XFIN = 336 * MiB;
constexpr size_t WS_XN = 32 * MiB;
constexpr size_t WS_P = 96 * MiB;
constexpr size_t WS_END = 500 * MiB;
constexpr int CW_BAR = 4096;
constexpr int RING_BYTES = 135168, LDS_BYTES = 163840, LDSCTL_OFF = LDS_BYTES - 1024, MISC_OFF = LDSCTL_OFF + 320, RSTAB_OFF = RING_BYTES + 448;

#define GAS __attribute__((address_space(1)))
#define LAS __attribute__((address_space(3)))
typedef unsigned short bf16;
typedef unsigned v4u __attribute__((ext_vector_type(4)));
typedef unsigned v2u __attribute__((ext_vector_type(2)));
typedef float f32x4 __attribute__((ext_vector_type(4)));
#define LDS_WAIT() asm volatile("s_waitcnt lgkmcnt(0)" ::: "memory")
#define VM_WAIT() asm volatile("s_waitcnt vmcnt(0)" ::: "memory")
#define LDS_BARRIER() do { asm volatile("s_waitcnt lgkmcnt(0)\n\ts_barrier" ::: "memory"); } while (0)
__device__ __forceinline__ unsigned f2bf(float f) { unsigned u = __builtin_bit_cast(unsigned, f); return (u + 0x7fffu + ((u >> 16) & 1u)) >> 16; }
__device__ __forceinline__ unsigned pk2(float lo, float hi) { return f2bf(lo) | (f2bf(hi) << 16); }
__device__ __forceinline__ float bf2f(bf16 u) { return __builtin_bit_cast(float, (unsigned)u << 16); }
__device__ __forceinline__ float bflo(unsigned w) { return __builtin_bit_cast(float, w << 16); }
__device__ __forceinline__ float bfhi(unsigned w) { return __builtin_bit_cast(float, w & 0xffff0000u); }
__device__ __forceinline__ float wave_sum(float v) {
#define WS_DPP(x, ctrl, rmask) __builtin_bit_cast(float, __builtin_amdgcn_update_dpp(0, __builtin_bit_cast(int, x), ctrl, rmask, 0xf, true))
    v += WS_DPP(v, 0x111, 0xf);
    v += WS_DPP(v, 0x112, 0xf);
    v += WS_DPP(v, 0x114, 0xf);
    v += WS_DPP(v, 0x118, 0xf);
    v += WS_DPP(v, 0x142, 0xa);
    v += WS_DPP(v, 0x143, 0xc);
#undef WS_DPP
    return __builtin_bit_cast(float, __builtin_amdgcn_readlane(__builtin_bit_cast(int, v), 63));
}
__device__ __forceinline__ float wave_max(float v) {
#pragma unroll
    for (int o = 1; o < 64; o <<= 1) v = fmaxf(v, __shfl_xor(v, o));
    return v;
}
__device__ __forceinline__ float fexp(float x) { return __builtin_amdgcn_exp2f(x * 1.4426950408889634f); }
__device__ __forceinline__ float flog(float x) { return __builtin_amdgcn_logf(x) * 0.6931471805599453f; }
__device__ __forceinline__ float frcp(float x) { return __builtin_amdgcn_rcpf(x); }
__device__ __forceinline__ float frsq(float x) { return __builtin_amdgcn_rsqf(x); }
__device__ __forceinline__ float fsqrt(float x) { return __builtin_amdgcn_sqrtf(x); }
__device__ __forceinline__ float sigmoid_f(float x) { return frcp(1.0f + fexp(-x)); }
__device__ __forceinline__ float softplus_f(float x) { return fmaxf(x, 0.f) + flog(1.0f + fexp(-fabsf(x))); }
__device__ __forceinline__ float tanh_f(float x) { return 1.0f - 2.0f * frcp(1.0f + fexp(2.0f * x)); }
#define XB_TMO      128
#define XB_XCNT(j)  (256  + 64 * (j))
#define XB_XSUB(j)  (1280 + 64 * (j))
#define XB_XGEN(j)  (2304 + 64 * (j))
#define XB_TOP      3328
#define XB_TOPGEN   3392
#define XCD_BAR_WORDS 3456
#define XB_SPIN_CAP (1u << 23)

__device__ __forceinline__ unsigned xb_ld(unsigned* p)              { return __hip_atomic_load(p, __ATOMIC_RELAXED, __HIP_MEMORY_SCOPE_AGENT); }
__device__ __forceinline__ unsigned xb_add(unsigned* p, unsigned v) { return __hip_atomic_fetch_add(p, v, __ATOMIC_RELAXED, __HIP_MEMORY_SCOPE_AGENT); }
__device__ __forceinline__ unsigned xb_xcc_id() { return (unsigned)__builtin_amdgcn_s_getreg((3 << 11) | 20) & 0xFu; }
#define XB_SPIN(cond, bar) do { unsigned _sp = 0; while (cond) { __builtin_amdgcn_s_sleep(1); \
    if ((++_sp & 255u) == 0u) { if (xb_ld(&(bar)[XB_TMO])) break; if (_sp > XB_SPIN_CAP) { atomicAdd(&(bar)[XB_TMO], 1u); break; } } } } while (0)

struct XcdBarrier {
    unsigned* bar; unsigned x;
    volatile LAS unsigned* st;
};

__device__ __forceinline__ XcdBarrier xcd_barrier_post(unsigned* bar, volatile LAS unsigned* st) {
    XcdBarrier b; b.bar = bar; b.x = xb_xcc_id(); b.st = st;
    if (threadIdx.x == 0) (void)xb_add(&bar[XB_XCNT(b.x)], 1u);
    return b;
}
__device__ __forceinline__ void xcd_barrier_complete(unsigned* bar, unsigned x, unsigned& nloc, unsigned& nx) {
    const unsigned G = gridDim.x * gridDim.y * gridDim.z;
    unsigned sum, cnt, mine, sp = 0u;
    for (;;) {
        sum = 0u; cnt = 0u; mine = 0u;
#pragma unroll
        for (unsigned j = 0; j < 16; ++j) { const unsigned c = xb_ld(&bar[XB_XCNT(j)]); sum += c; cnt += (c > 0u) ? 1u : 0u; mine = (j == x) ? c : mine; }
        if (sum == G) break;
        __builtin_amdgcn_s_sleep(1);
        if ((++sp & 255u) == 0u) { if (xb_ld(&bar[XB_TMO])) break; if (sp > XB_SPIN_CAP) { atomicAdd(&bar[XB_TMO], 1u); break; } }
    }
    nloc = mine > 0u ? mine : 1u; nx = cnt > 0u ? cnt : 1u;
}

__device__ __forceinline__ void xcd_barrier(const XcdBarrier& b) {
    asm volatile("s_waitcnt vmcnt(0)" ::: "memory");
    __syncthreads();
    if (threadIdx.x == 0) {
        unsigned blo_ = __builtin_amdgcn_readfirstlane((unsigned)(unsigned long long)b.bar), bhi_ = __builtin_amdgcn_readfirstlane((unsigned)((unsigned long long)b.bar >> 32)), bx = __builtin_amdgcn_readfirstlane(b.x); asm volatile("" : "+s"(blo_), "+s"(bhi_), "+s"(bx)); unsigned* bar = (unsigned*)(((unsigned long long)bhi_ << 32) | blo_);
        __builtin_amdgcn_s_waitcnt(0);
        unsigned nloc = b.st[0], nx = b.st[1];
        if (nloc == 0u) { xcd_barrier_complete(bar, bx, nloc, nx); b.st[0] = nloc; b.st[1] = nx; }
        const unsigned old = xb_add(&bar[XB_XSUB(bx)], 1u);
        const unsigned gen = old / nloc;
        if (old + 1u == (gen + 1u) * nloc) {
            __builtin_amdgcn_fence(__ATOMIC_RELEASE, "agent");
            asm volatile("s_waitcnt vmcnt(0)" ::: "memory");
            const unsigned og = xb_add(&bar[XB_TOP], 1u);
            const unsigned tg = og / nx;
            if (og + 1u == (tg + 1u) * nx) xb_add(&bar[XB_TOPGEN], 1u);
            else XB_SPIN(xb_ld(&bar[XB_TOPGEN]) == tg, bar);
            __builtin_amdgcn_fence(__ATOMIC_ACQUIRE, "agent");
            xb_add(&bar[XB_XGEN(bx)], 1u);
            asm volatile("s_waitcnt vmcnt(0)" ::: "memory");
        } else {
            XB_SPIN(xb_ld(&bar[XB_XGEN(bx)]) == gen, bar);
            __builtin_amdgcn_fence(__ATOMIC_ACQUIRE, "agent");
            asm volatile("s_waitcnt vmcnt(0)" ::: "memory");
        }
    }
    __syncthreads();
}
__device__ __forceinline__ void tr_item(const float* __restrict__ W, int Kreal, int N, bf16* WT, int ldd, int dst_row0, LAS float* scr, int k0, int n0, int lane,
                                        const float* __restrict__ mu, float sc0, float sc1, const float* __restrict__ gk = nullptr) {
    const int rr = lane >> 3, c4 = lane & 7, nn = n0 + 4 * c4; const bool nv = nn < N;
#pragma unroll
    for (int i = 0; i < 8; ++i) { const int kk = 8 * i + rr; f32x4 v = (nv && k0 + kk < Kreal) ? *(const GAS f32x4*)(W + (size_t)(k0 + kk) * N + nn) : (f32x4){0.f, 0.f, 0.f, 0.f};
        float sc = 1.0f; if (mu) sc = sc0 + sc1 * mu[k0 + kk]; if (gk) sc *= gk[k0 + kk]; v = v * sc;
        LAS float* d = scr + kk * 33 + 4 * c4; d[0] = v.x; d[1] = v.y; d[2] = v.z; d[3] = v.w; }
    LDS_WAIT(); asm volatile("" ::: "memory");
    const int c = lane & 7;
#pragma unroll
    for (int j = 0; j < 4; ++j) { const int n = (lane >> 3) + 8 * j; const LAS float* s = scr + (8 * c) * 33 + n;
        v4u o; o.x = pk2(s[0 * 33], s[1 * 33]); o.y = pk2(s[2 * 33], s[3 * 33]); o.z = pk2(s[4 * 33], s[5 * 33]); o.w = pk2(s[6 * 33], s[7 * 33]);
        if (n0 + n < N) *(GAS v4u*)(WT + (size_t)(dst_row0 + n) * ldd + k0 + 8 * c) = o; }
    LDS_WAIT(); asm volatile("" ::: "memory");
}
__device__ __forceinline__ void rms_row_bf16_to_f32(const bf16* xrow, const float* g, float* orow, int lane, float oscale = 1.0f) {
    const GAS v4u* xr = (const GAS v4u*)xrow + 2 * lane; const v4u a = xr[0], b = xr[1]; float v[16]; float s = 0.f;
    v[0] = bflo(a.x); v[1] = bfhi(a.x); v[2] = bflo(a.y); v[3] = bfhi(a.y); v[4] = bflo(a.z); v[5] = bfhi(a.z); v[6] = bflo(a.w); v[7] = bfhi(a.w);
    v[8] = bflo(b.x); v[9] = bfhi(b.x); v[10] = bflo(b.y); v[11] = bfhi(b.y); v[12] = bflo(b.z); v[13] = bfhi(b.z); v[14] = bflo(b.w); v[15] = bfhi(b.w);
#pragma unroll
    for (int e = 0; e < 16; ++e) s += v[e] * v[e];
    const float rs = frsq(wave_sum(s) * (1.f / D) + 1e-6f) * oscale;
    const GAS f32x4* gr = (const GAS f32x4*)g + 4 * lane; GAS f32x4* o = (GAS f32x4*)orow + 4 * lane;
#pragma unroll
    for (int q = 0; q < 4; ++q) { const f32x4 gv = gr[q]; o[q] = (f32x4){v[4 * q] * rs * gv.x, v[4 * q + 1] * rs * gv.y, v[4 * q + 2] * rs * gv.z, v[4 * q + 3] * rs * gv.w}; }
}
struct Args { const float* in[36]; float* out; unsigned char* ws; int lo, hi; };
typedef const __attribute__((address_space(4))) Args* ArgP;
#define FRESH_ARGS() ({ ArgP p_ = (ArgP)__builtin_amdgcn_kernarg_segment_ptr(); asm volatile("" : "+s"(p_)); p_; })
#define FRESH_V(x) asm volatile("" : "+v"(x))
#define FRESH_S(x) asm volatile("" : "+s"(x))

#define TR_JOB(items, nblk, Wp, Kd, Nd, DST, LDD, ROW0, MU, S0, S1, GK) if (r < (items)) { const int kb = r / (nblk), nb = r % (nblk), n0 = 32 * nb; tr_item(Wp, Kd, Nd, DST, LDD, ROW0, scr, 64 * kb, n0, lane, MU, S0, S1, GK); continue; } r -= (items);
__device__ __forceinline__ void convert_mixer_weights(ArgP A, int L, LAS unsigned char* lds, int wave, int lane, int gw, int NGW) {
    const int i = L >> 1; const bool even = !(L & 1);
    bf16* Win = (bf16*)(A->ws + WS_WIN); bf16* Wout = (bf16*)(A->ws + WS_WOUT);
    LAS float* scr = (LAS float*)(lds + wave * 16384);
    const float* gmix = A->in[2] + (size_t)L * D;
    const float* w_in = even ? A->in[5] + (size_t)i * D * 3072 : A->in[26] + (size_t)i * D * 3072;
    const float* w_out = even ? A->in[6] + (size_t)i * D * D : A->in[27] + (size_t)i * D * D;
    const float* mu_w = A->in[8] + (size_t)i * 3 * D, *mu_a = mu_w + D, *mu_g = mu_w + 2 * D;
    const float* w1 = A->in[10] + (size_t)i * D * 64, *a1 = A->in[13] + (size_t)i * D * 64, *g1 = A->in[15] + (size_t)i * D * 160, *wa1 = A->in[22] + (size_t)i * D * 16;
    const float* w2s = A->in[11] + (size_t)i * 64 * 512, *a2s = A->in[14] + (size_t)i * 64 * 512, *g2s = A->in[16] + (size_t)i * 160 * 512;
    bf16* W2T = (bf16*)(A->ws + WS_W2T); bf16* A2T = (bf16*)(A->ws + WS_A2T); bf16* G2T = (bf16*)(A->ws + WS_G2T);
    const int I_IN = 16 * 96, I_L64 = 16 * 2, I_L160 = 16 * 5, I_L16 = 16 * 1, I_OUT = 16 * 32;
    const int n_lora = even ? (4 * I_L64 + 2 * I_L160 + I_L16 + 16 + 16 + 48) : 0;
    const int NITEMS = I_IN + n_lora + I_OUT;
    for (int it = gw; it < NITEMS; it += NGW) {
        int r = it;
        TR_JOB(I_IN, 96, w_in, D, 3072, Win, D, n0, nullptr, 1.f, 0.f, gmix)
        if (even) {
            TR_JOB(I_L64, 2, w1, D, 64, Win, D, PC_W1A + n0, mu_w, 1.f, -1.f, gmix)
            TR_JOB(I_L64, 2, w1, D, 64, Win, D, PC_W1B + n0, mu_w, 0.f, 1.f, gmix)
            TR_JOB(I_L64, 2, a1, D, 64, Win, D, PC_A1A + n0, mu_a, 1.f, -1.f, gmix)
            TR_JOB(I_L64, 2, a1, D, 64, Win, D, PC_A1B + n0, mu_a, 0.f, 1.f, gmix)
            TR_JOB(I_L160, 5, g1, D, 160, Win, D, PC_G1A + n0, mu_g, 1.f, -1.f, gmix)
            TR_JOB(I_L160, 5, g1, D, 160, Win, D, PC_G1B + n0, mu_g, 0.f, 1.f, gmix)
            TR_JOB(I_L16, 1, wa1, D, 16, Win, D, PC_WA1 + n0, nullptr, 1.f, 0.f, gmix)
            TR_JOB(16, 16, w2s, 64, 512, W2T, 64, n0, nullptr, 1.f, 0.f, nullptr)
            TR_JOB(16, 16, a2s, 64, 512, A2T, 64, n0, nullptr, 1.f, 0.f, nullptr)
            TR_JOB(48, 16, g2s, 160, 512, G2T, 192, n0, nullptr, 1.f, 0.f, nullptr)
        }
        TR_JOB(I_OUT, 32, w_out, D, D, Wout, D, n0, nullptr, 1.f, 0.f, nullptr)
    }
    if (even) {
        const int gt = gw * 64 + lane, NT = NGW * 64;
        for (int e = gt; e < (NIN_E - PC_PAD) * D / 8; e += NT) ((GAS v4u*)(Win + (size_t)PC_PAD * D))[e] = (v4u){0u, 0u, 0u, 0u};
        bf16* WA2T = (bf16*)(A->ws + WS_WA2T); const float* wa2 = A->in[23] + (size_t)i * 16 * 256;
        for (int e = gt; e < 256 * 32; e += NT) { const int nn = e >> 5, k = e & 31; WA2T[e] = k < 16 ? (bf16)f2bf(wa2[k * 256 + nn]) : (bf16)0; }
    }
}
__device__ __forceinline__ void convert_ffn_weights(ArgP A, int L, LAS unsigned char* lds, int wave, int lane, int gw, int NGW) {
    bf16* Wgu = (bf16*)(A->ws + WS_WGU); bf16* Wdn = (bf16*)(A->ws + WS_WDN);
    LAS float* scr = (LAS float*)(lds + wave * 16384);
    const float* gffn = A->in[3] + (size_t)L * D;
    const float* wg = A->in[33] + (size_t)L * D * FF, *wu = A->in[34] + (size_t)L * D * FF, *wd = A->in[35] + (size_t)L * FF * D;
    const int I_GU = 16 * 88, I_DN = 44 * 32;
    for (int it = gw; it < 2 * I_GU + I_DN; it += NGW) {
        int r = it;
        TR_JOB(I_GU, 88, wg, D, FF, Wgu, D, 256 * (n0 >> 7) + (n0 & 127), nullptr, 1.f, 0.f, gffn)
        TR_JOB(I_GU, 88, wu, D, FF, Wgu, D, 256 * (n0 >> 7) + (n0 & 127) + 128, nullptr, 1.f, 0.f, gffn)
        TR_JOB(I_DN, 32, wd, FF, D, Wdn, FF, n0, nullptr, 1.f, 0.f, nullptr)
    }
}
#undef TR_JOB
__device__ __forceinline__ void x_to_bf16_ssq(const float* xrow, bf16* orow, float* ssq_row, int lane) {
    const GAS f32x4* xr = (const GAS f32x4*)xrow + lane; f32x4 v[4]; float s = 0.f;
#pragma unroll
    for (int j = 0; j < 4; ++j) { v[j] = xr[64 * j]; s += (v[j].x * v[j].x + v[j].y * v[j].y) + (v[j].z * v[j].z + v[j].w * v[j].w); }
    s = wave_sum(s); if (lane < 16) ssq_row[lane] = lane == 0 ? s : 0.f;
    GAS v2u* o8 = (GAS v2u*)orow + lane;
#pragma unroll
    for (int j = 0; j < 4; ++j) { v2u o; o.x = pk2(v[j].x, v[j].y); o.y = pk2(v[j].z, v[j].w); o8[64 * j] = o; }
}

__device__ __forceinline__ int t5_bucket(int d) {
    if (d < 16) return d;
    const float r = (float)d / 16.0f; int l = 16 + (int)(flog(r) / 2.0794415416798357f * 16.0f);
    return l < 31 ? l : 31;
}
typedef short a_bf16x8 __attribute__((ext_vector_type(8)));
typedef float f32x16 __attribute__((ext_vector_type(16)));
typedef short a_s16x4 __attribute__((ext_vector_type(4)));
constexpr int AT_K1 = 0, AT_K2 = 8192, AT_V = 16384, AT_ST = 32768, AT_NST = 4, AT_BIAS = AT_NST * AT_ST, AT_COMB = 0;
static_assert(AT_BIAS + 132 * 4 <= LDSCTL_OFF && 4 * 64 * 64 * 4 <= AT_BIAS, "attention LDS map");
__device__ __forceinline__ int crow16(int r, int hi) { return (r & 3) + 8 * (r >> 2) + 4 * hi; }
typedef float f32x2_t __attribute__((ext_vector_type(2))); typedef __bf16 bf16x2_t __attribute__((ext_vector_type(2)));
__device__ __forceinline__ unsigned cvtpk(float lo, float hi) { const f32x2_t v = {lo, hi}; const bf16x2_t b = __builtin_convertvector(v, bf16x2_t); return __builtin_bit_cast(unsigned, b); }

template <bool HALFSYNC = false> __device__ __forceinline__ void attn_unit_mfma(ArgP A, int L, int b, int h, int qb, float lam, float lam_init, LAS unsigned char* lds, int tid) {
    const int lane = tid & 63, wave = __builtin_amdgcn_readfirstlane(tid >> 6), r32 = lane & 31, hi = lane >> 5;
    const int smap = wave >> 2, qs = wave & 3;
    const int i = L >> 1;
    const bf16* QKV = (const bf16*)(A->ws + WS_P); bf16* O = (bf16*)(A->ws + WS_XN);
    const int q0 = qb * 128, qw0 = q0 + 32 * qs, nt = (q0 + 128) / 64;
    const size_t rowb = (size_t)b * T;
    if (tid < 129) { const float far = A->in[1][31 * 8 + h]; ((LAS float*)(lds + AT_BIAS))[tid] = tid < 128 ? (A->in[1][t5_bucket(tid) * 8 + h] - far) * 1.4426950408889634f : 0.f; }
    a_bf16x8 qf[4];
    { const bf16* qrow = QKV + (rowb + qw0 + r32) * NIN_O + h * 128 + smap * 64 + 8 * hi;
#pragma unroll
      for (int ks = 0; ks < 4; ++ks) qf[ks] = *(const GAS a_bf16x8*)(qrow + 16 * ks); }
    const int kr = 8 * wave + (lane >> 3), kcs = (lane & 7) ^ ((kr >> 1) & 7);
    const bf16* kg = QKV + (rowb + kr) * NIN_O + 1024 + h * 128 + 8 * kcs;
    const int vr0 = 8 * wave + (lane >> 4), vr1 = vr0 + 4;
    const bf16* vg0 = QKV + (rowb + vr0) * NIN_O + 2048 + h * 128 + 8 * ((lane & 15) ^ (((vr0 & 3) << 2) | ((vr0 >> 2) & 3)));
    const bf16* vg1 = QKV + (rowb + vr1) * NIN_O + 2048 + h * 128 + 8 * ((lane & 15) ^ (((vr1 & 3) << 2) | ((vr1 >> 2) & 3)));
#define AT_DMA(kt, stoff) do { const size_t go_ = (size_t)(kt) * 64 * NIN_O; LAS unsigned char* sb_ = lds + (stoff) + wave * 1024; \
        __builtin_amdgcn_global_load_lds((const unsigned*)(kg + go_), (LAS unsigned*)(sb_ + AT_K1), 16, 0, 0); __builtin_amdgcn_global_load_lds((const unsigned*)(kg + go_ + 64), (LAS unsigned*)(sb_ + AT_K2), 16, 0, 0); \
        __builtin_amdgcn_global_load_lds((const unsigned*)(vg0 + go_), (LAS unsigned*)(sb_ + AT_V + wave * 1024), 16, 0, 0); __builtin_amdgcn_global_load_lds((const unsigned*)(vg1 + go_), (LAS unsigned*)(sb_ + AT_V + wave * 1024 + 1024), 16, 0, 0); } while (0)
    AT_DMA(0, 0); AT_DMA(1, AT_ST);
    __syncthreads();
    f32x16 o[4];
#pragma unroll
    for (int d = 0; d < 4; ++d)
#pragma unroll
        for (int r = 0; r < 16; ++r) o[d][r] = 0.f;
    float m = -1e30f, l = 0.f;
    const int kfo = (smap ? AT_K2 : AT_K1) + r32 * 128, khg = hi ^ ((r32 >> 1) & 7);
    int vfo[2][4];
    { const int q = (lane & 15) >> 2, pp = lane & 3, blk = (lane >> 4) & 1;
#pragma unroll
      for (int t = 0; t < 2; ++t)
#pragma unroll
          for (int d = 0; d < 4; ++d) vfo[t][d] = AT_V + 256 * (4 * hi + q + 8 * t) + 16 * (((d ^ q) << 2) | ((2 * blk + (pp >> 1)) ^ ((hi + 2 * t) & 3))) + 8 * (pp & 1); }
    const LAS float* bdl = (const LAS float*)(lds + AT_BIAS);
    const int qme = qw0 + r32;
#define AT_VREAD(VF, kk) do { _Pragma("unroll") for (int d = 0; d < 4; ++d) { \
                VF[2 * d] = __builtin_bit_cast(a_s16x4, __builtin_amdgcn_ds_read_tr16_b64_v4i16((LAS a_s16x4*)(sbv + vfo[0][d] + (kk) * 4096))); VF[2 * d + 1] = __builtin_bit_cast(a_s16x4, __builtin_amdgcn_ds_read_tr16_b64_v4i16((LAS a_s16x4*)(sbv + vfo[1][d] + (kk) * 4096))); } } while (0)
#define AT_PV(VF, PF, kk) do { _Pragma("unroll") for (int d = 0; d < 4; ++d) { const a_bf16x8 vf_ = (a_bf16x8){VF[2 * d][0], VF[2 * d][1], VF[2 * d][2], VF[2 * d][3], VF[2 * d + 1][0], VF[2 * d + 1][1], VF[2 * d + 1][2], VF[2 * d + 1][3]}; \
                o[d] = __builtin_amdgcn_mfma_f32_32x32x16_bf16(vf_, PF[kk], o[d], 0, 0, 0); } } while (0)
    int pbase = 0;
#pragma unroll 1
    for (int kt0 = 0; kt0 < nt; kt0 += 2) {
        const int nbase = pbase ? 0 : 2 * AT_ST;
#pragma unroll 1
      for (int sub = 0; sub < 2; ++sub) { const int kt = kt0 + sub; const int stoff = pbase + sub * AT_ST;
        if (kt + 2 < nt) AT_DMA(kt + 2, nbase + sub * AT_ST);
        const int key0 = 64 * kt;
        if (key0 <= qw0 + 31) {
            const LAS unsigned char* sb = lds + stoff; const LAS unsigned char* sbv = sb;
            f32x16 p[2]; a_bf16x8 kf[8];
#pragma unroll
            for (int f = 0; f < 8; ++f) kf[f] = *(const LAS a_bf16x8*)(sb + kfo + (f >> 2) * 4096 + ((khg ^ (2 * (f & 3))) * 16));
            __builtin_amdgcn_sched_barrier(0);
            __builtin_amdgcn_s_setprio(1);
#pragma unroll
            for (int blk = 0; blk < 2; ++blk) {
#pragma unroll
                for (int r = 0; r < 16; ++r) p[blk][r] = 0.f;
#pragma unroll
                for (int ks = 0; ks < 4; ++ks) p[blk] = __builtin_amdgcn_mfma_f32_32x32x16_bf16(kf[blk * 4 + ks], qf[ks], p[blk], 0, 0, 0);
            }
            __builtin_amdgcn_s_setprio(0);
            if (key0 + 63 + 128 > qw0) {
#pragma unroll
                for (int blk = 0; blk < 2; ++blk) { float bvv[16];
#pragma unroll
                    for (int r = 0; r < 16; ++r) { const unsigned ud = (unsigned)(qme - (key0 + 32 * blk + crow16(r, hi))); bvv[r] = bdl[ud < 128u ? ud : 128u]; }
                    asm volatile("" : "+v"(bvv[0]), "+v"(bvv[1]), "+v"(bvv[2]), "+v"(bvv[3]), "+v"(bvv[4]), "+v"(bvv[5]), "+v"(bvv[6]), "+v"(bvv[7]), "+v"(bvv[8]), "+v"(bvv[9]), "+v"(bvv[10]), "+v"(bvv[11]), "+v"(bvv[12]), "+v"(bvv[13]), "+v"(bvv[14]), "+v"(bvv[15]));
#pragma unroll
                    for (int r = 0; r < 16; ++r) { const int dist = qme - (key0 + 32 * blk + crow16(r, hi)); p[blk][r] = dist < 0 ? -1e30f : p[blk][r] + bvv[r]; } }
            }
            float mx = p[0][0];
#pragma unroll
            for (int r = 1; r < 16; ++r) mx = fmaxf(mx, p[0][r]);
#pragma unroll
            for (int r = 0; r < 16; ++r) mx = fmaxf(mx, p[1][r]);
            { const auto sw_ = __builtin_amdgcn_permlane32_swap(__builtin_bit_cast(unsigned, mx), __builtin_bit_cast(unsigned, mx), false, false);
              mx = fmaxf(__builtin_bit_cast(float, sw_[0]), __builtin_bit_cast(float, sw_[1])); }
            if (__any(mx > m + 8.0f)) {
                const float mn = fmaxf(m, mx), al = __builtin_amdgcn_exp2f(m - mn); m = mn; l *= al;
#pragma unroll
                for (int d = 0; d < 4; ++d)
#pragma unroll
                    for (int r = 0; r < 16; ++r) o[d][r] *= al;
            }
            float ls = 0.f;
#define AT_EXPPK(PF, kk) do { const int blk_ = (kk) >> 1, s8_ = 8 * ((kk) & 1); float e_[8]; _Pragma("unroll") for (int j = 0; j < 8; ++j) { e_[j] = __builtin_amdgcn_exp2f(p[blk_][s8_ + j] - m); ls += e_[j]; } \
                v4u w_; w_.x = cvtpk(e_[0], e_[1]); w_.y = cvtpk(e_[2], e_[3]); w_.z = cvtpk(e_[4], e_[5]); w_.w = cvtpk(e_[6], e_[7]); PF[kk] = __builtin_bit_cast(a_bf16x8, w_); } while (0)
            {
                a_bf16x8 pf[4]; a_s16x4 vA[8], vB[8];
                AT_VREAD(vA, 0); AT_EXPPK(pf, 0);
                __builtin_amdgcn_sched_barrier(0);
                AT_VREAD(vB, 1); AT_PV(vA, pf, 0); AT_EXPPK(pf, 1);
                __builtin_amdgcn_sched_barrier(0);
                AT_VREAD(vA, 2); AT_PV(vB, pf, 1); AT_EXPPK(pf, 2);
                __builtin_amdgcn_sched_barrier(0);
                AT_VREAD(vB, 3); AT_PV(vA, pf, 2); AT_EXPPK(pf, 3);
                __builtin_amdgcn_sched_barrier(0);
                AT_PV(vB, pf, 3);
            }
            l += ls;
#undef AT_EXPPK
        }
      }
        __syncthreads();
        pbase = nbase;
    }
#undef AT_VREAD
#undef AT_PV
#undef AT_DMA
    l += __shfl_xor(l, 32);
    LAS float* comb = (LAS float*)(lds + AT_COMB) + qs * 4096;
    if (smap == 1) { const float sc = lam * frcp(l);
#pragma unroll
        for (int d = 0; d < 4; ++d)
#pragma unroll
            for (int r = 0; r < 16; ++r) comb[(d * 16 + r) * 64 + lane] = o[d][r] * sc; }
    __syncthreads();
    if (smap == 0) {
        const float il = frcp(l); float ss = 0.f;
#pragma unroll
        for (int d = 0; d < 4; ++d)
#pragma unroll
            for (int r = 0; r < 16; ++r) { const float v = o[d][r] * il - comb[(d * 16 + r) * 64 + lane]; o[d][r] = v; ss += v * v; }
        ss += __shfl_xor(ss, 32);
        const float rs = frsq(ss * (1.f / 128.f) + 1e-5f) * (1.0f - lam_init);
        const float* sl = A->in[32] + i * 128;
        bf16* orow = O + (rowb + qw0 + r32) * D + h * 128;
#pragma unroll
        for (int d = 0; d < 4; ++d)
#pragma unroll
            for (int g4 = 0; g4 < 4; ++g4) { const int dc = 32 * d + 8 * g4 + 4 * hi; const f32x4 s4 = *(const GAS f32x4*)(sl + dc);
                v2u w; w.x = cvtpk(o[d][4 * g4] * rs * s4.x, o[d][4 * g4 + 1] * rs * s4.y); w.y = cvtpk(o[d][4 * g4 + 2] * rs * s4.z, o[d][4 * g4 + 3] * rs * s4.w);
                *(GAS v2u*)(orow + dc) = w; }
    }
    __syncthreads();
}

template <bool HALFSYNC = false> __device__ __forceinline__ void attn_phase_mfma(ArgP A, int L, LAS unsigned char* lds, int tid, int G, int bid) {
    const int lane = tid & 63, i = L >> 1;
    const float lam_init = 0.8f - 0.6f * fexp(-0.3f * (float)L);
    const float lam = fexp(wave_sum(A->in[28][i * 64 + lane] * A->in[29][i * 64 + lane])) - fexp(wave_sum(A->in[30][i * 64 + lane] * A->in[31][i * 64 + lane])) + lam_init;
    if (G == 256) {
        const int v = (bid & 7) * 32 + (bid >> 3), bh = v >> 2, j = v & 3;
#pragma unroll 1
        for (int u = 0; u < 8; ++u) { const int qb = 8 * (u >> 1) + ((u & 1) ? 7 - j : j); attn_unit_mfma<HALFSYNC>(A, L, bh >> 3, bh & 7, qb, lam, lam_init, lds, tid); }
    } else {
#pragma unroll 1
        for (int u = bid; u < 64 * 32; u += G) attn_unit_mfma<HALFSYNC>(A, L, (u >> 5) >> 3, (u >> 5) & 7, 31 - (u & 31), lam, lam_init, lds, tid);
    }
}
typedef short bf16x8_t __attribute__((ext_vector_type(8)));
constexpr int MS = 72, MB = 64 * MS * 2;
constexpr int RW_XW = 8 * MB, RW_XA = RW_XW + 16384;
constexpr int RW_TOT = 14 * MB, RW_GAM = RW_TOT + 2048, RW_END = RW_GAM + 256;
static_assert(RW_XA + 16384 <= 12 * MB && RW_END <= RING_BYTES, "RWKV LDS map");
constexpr size_t WS_RWI = 336 * MiB;
constexpr size_t WS_BON = 30 * MiB;
#define RBUF(k) ((LAS bf16*)(lds + (k) * MB))
__device__ __forceinline__ f32x4 mfma16(bf16x8_t a, bf16x8_t b, f32x4 c) { return __builtin_amdgcn_mfma_f32_16x16x32_bf16(a, b, c, 0, 0, 0); }
__device__ __forceinline__ bf16x8_t ldfrag(const LAS bf16* Mx, int row0, int k0, int lane) { return *(const LAS bf16x8_t*)(Mx + (row0 + (lane & 15)) * MS + k0 + 8 * (lane >> 4)); }
__device__ __forceinline__ f32x4 mm64(f32x4 acc, const LAS bf16* Am, int ra, const LAS bf16* BTm, int cb, int lane) {
    acc = mfma16(ldfrag(Am, 16 * ra, 0, lane), ldfrag(BTm, 16 * cb, 0, lane), acc);
    return mfma16(ldfrag(Am, 16 * ra, 32, lane), ldfrag(BTm, 16 * cb, 32, lane), acc);
}
__device__ __forceinline__ v2u pack4(f32x4 a) { v2u w; w.x = cvtpk(a[0], a[1]); w.y = cvtpk(a[2], a[3]); return w; }
__device__ __forceinline__ void tstore(LAS bf16* Dm, int rt, int ct, f32x4 acc, int lane) { *(LAS v2u*)(Dm + (16 * ct + (lane & 15)) * MS + 16 * rt + 4 * (lane >> 4)) = pack4(acc); }
__device__ __forceinline__ void tstore_g(bf16* Dg, int rt, int ct, f32x4 acc, int lane) { *(GAS v2u*)(Dg + (16 * ct + (lane & 15)) * 64 + 16 * rt + 4 * (lane >> 4)) = pack4(acc); }
__device__ __forceinline__ f32x4 ld4bf(const LAS bf16* p) { const v2u w = *(const LAS v2u*)p; return (f32x4){bflo(w.x), bfhi(w.x), bflo(w.y), bfhi(w.y)}; }
__device__ __forceinline__ f32x4 ld4bf_g(const bf16* p) { const v2u w = *(const GAS v2u*)p; return (f32x4){bflo(w.x), bfhi(w.x), bflo(w.y), bfhi(w.y)}; }
__device__ __forceinline__ void unpack8(v4u w, float (&f)[8]) { f[0] = bflo(w.x); f[1] = bfhi(w.x); f[2] = bflo(w.y); f[3] = bfhi(w.y); f[4] = bflo(w.z); f[5] = bfhi(w.z); f[6] = bflo(w.w); f[7] = bfhi(w.w); }
__device__ __forceinline__ bf16x8_t pack8(const float (&f)[8]) { v4u w; w.x = cvtpk(f[0], f[1]); w.y = cvtpk(f[2], f[3]); w.z = cvtpk(f[4], f[5]); w.w = cvtpk(f[6], f[7]); return __builtin_bit_cast(bf16x8_t, w); }

__device__ __forceinline__ void rwkv_chunk_phase(ArgP A, int L, LAS unsigned char* lds, int tid, int G, int bid) {
    const int lane = tid & 63, wave = __builtin_amdgcn_readfirstlane(tid >> 6), i = L >> 1;
    const int l15 = lane & 15, lg = lane >> 4;
    const bf16* P = (const bf16*)(A->ws + WS_P); bf16* XNb = (bf16*)(A->ws + WS_XN);
    const int rt = wave >> 1, ct0 = 2 * (wave & 1);
    constexpr int NIT = BATCH * 64 * 8;
    v4u pw[2][2], pa[2][2]; unsigned short pe[9][3];
#define R1_PREFETCH(itx) do { const int b_ = (itx) >> 9, n_ = ((itx) >> 3) & 63, h_ = (itx) & 7; const size_t rowb_ = (size_t)b_ * T + 64 * n_; \
        { const int tt_ = 16 * rt + l15; const bf16* prow_ = P + (rowb_ + tt_) * NIN_E; const bool hp_ = (64 * n_ + tt_) > 0; const v4u z4_ = (v4u){0u, 0u, 0u, 0u}; \
          _Pragma("unroll") for (int q = 0; q < 2; ++q) { const int kc_ = 32 * q + 8 * lg; pw[q][0] = *(const GAS v4u*)(prow_ + PC_W1A + kc_); pw[q][1] = hp_ ? *(const GAS v4u*)(prow_ - NIN_E + PC_W1B + kc_) : z4_; \
              pa[q][0] = *(const GAS v4u*)(prow_ + PC_A1A + kc_); pa[q][1] = hp_ ? *(const GAS v4u*)(prow_ - NIN_E + PC_A1B + kc_) : z4_; } \
          } \
        { const int c_ = 64 * h_ + lane; const size_t row0_ = rowb_ + 8 * wave; const bool hp_ = (64 * n_ + 8 * wave) > 0; \
          _Pragma("unroll") for (int u = 0; u < 9; ++u) { const bf16* pp_ = P + (row0_ + u - 1) * NIN_E; const bool ok_ = u > 0 || hp_; \
              pe[u][0] = ok_ ? pp_[PC_R + c_] : (unsigned short)0; pe[u][1] = ok_ ? pp_[PC_K + c_] : (unsigned short)0; pe[u][2] = ok_ ? pp_[PC_V + c_] : (unsigned short)0; } } } while (0)
    if (bid < NIT) R1_PREFETCH(bid);
#pragma unroll 1
    for (int it = bid; it < NIT; it += G) {
    const int b = it >> 9, n = (it >> 3) & 63, h = it & 7;
    const size_t rowb = (size_t)b * T + 64 * n;
    bf16* item = (bf16*)(A->ws + WS_RWI) + ((size_t)((b * 64 + n) * 8 + h)) * 16384;
    asm volatile("; MARK_R1_E1");
    {
        const bf16* W2T = (const bf16*)(A->ws + WS_W2T); const bf16* A2T = (const bf16*)(A->ws + WS_A2T);
        f32x4 xw[2], xa[2];
#pragma unroll
        for (int c = 0; c < 2; ++c) { xw[c] = (f32x4){0.f, 0.f, 0.f, 0.f}; xa[c] = (f32x4){0.f, 0.f, 0.f, 0.f}; }
#pragma unroll
        for (int q = 0; q < 2; ++q) {
            const int kc = 32 * q + 8 * lg; float x[8], y[8], v[8];
            unpack8(pw[q][0], x); unpack8(pw[q][1], y);
#pragma unroll
            for (int e = 0; e < 8; ++e) v[e] = tanh_f(x[e] + y[e]);
            const bf16x8_t fw = pack8(v);
            unpack8(pa[q][0], x); unpack8(pa[q][1], y);
#pragma unroll
            for (int e = 0; e < 8; ++e) v[e] = x[e] + y[e];
            const bf16x8_t fa = pack8(v);
#pragma unroll
            for (int c = 0; c < 2; ++c) { const size_t wo = (size_t)(64 * h + 16 * (ct0 + c) + l15) * 64 + kc;
                xw[c] = mfma16(fw, *(const GAS bf16x8_t*)(W2T + wo), xw[c]); xa[c] = mfma16(fa, *(const GAS bf16x8_t*)(A2T + wo), xa[c]); }
        }
        LAS float* XW = (LAS float*)(lds + RW_XW); LAS float* XA = (LAS float*)(lds + RW_XA);
#pragma unroll
        for (int c = 0; c < 2; ++c)
#pragma unroll
            for (int r = 0; r < 4; ++r) { const int o = (16 * rt + 4 * lg + r) * 64 + 16 * (ct0 + c) + l15; XW[o] = xw[c][r]; XA[o] = xa[c][r]; }
    }
    LDS_BARRIER();
    asm volatile("; MARK_R1_E2");
    {
        const int c = 64 * h + lane;
        const float* mu = A->in[7] + (size_t)i * 1536;
        const float mur = mu[c], muk = mu[512 + c], muv = mu[1024 + c];
        const float kkc = A->in[17][i * 512 + c], kac = A->in[18][i * 512 + c], rkc = A->in[19][i * 512 + c], w0c = A->in[9][i * 512 + c], a0c = A->in[12][i * 512 + c];
        const LAS float* XW = (const LAS float*)(lds + RW_XW); const LAS float* XA = (const LAS float*)(lds + RW_XA);
        float* BON = (float*)(A->ws + WS_BON);
        const int tt0 = 8 * wave; const size_t row0 = rowb + tt0;
        float pr_p = bf2f(pe[0][0]), pk_p = bf2f(pe[0][1]), pv_p = bf2f(pe[0][2]);
        float rr[8], av[8], bv[8], km[8], vv[8], lc[8];
        float run = 0.f;
#pragma unroll
        for (int u = 0; u < 8; ++u) {
            const float pR = bf2f(pe[u + 1][0]), pK = bf2f(pe[u + 1][1]), pV = bf2f(pe[u + 1][2]);
            const float r = pR + (pr_p - pR) * mur, k = pK + (pk_p - pK) * muk, v = pV + (pv_p - pV) * muv; pr_p = pR; pk_p = pK; pv_p = pV;
            const float xw = w0c + XW[(tt0 + u) * 64 + lane], xa = a0c + XA[(tt0 + u) * 64 + lane];
            const float wlog = -0.6065306597126334f * sigmoid_f(xw), as = sigmoid_f(xa);
            float kk = k * kkc; const float n2 = wave_sum(kk * kk); kk = kk * frsq(fmaxf(n2, 1e-24f));
            const float kmod = k * (1.f + (as - 1.f) * kac);
            const float bon = wave_sum(r * kmod * rkc);
            if (lane == 0) BON[(row0 + u) * 8 + h] = bon;
            run += wlog; rr[u] = r; av[u] = -kk; bv[u] = kk * as; km[u] = kmod; vv[u] = v; lc[u] = run;
        }
        LAS float* TOT = (LAS float*)(lds + RW_TOT);
        TOT[wave * 64 + lane] = run;
        LDS_BARRIER();
        float off = 0.f, tot = 0.f;
#pragma unroll
        for (int w2 = 0; w2 < 8; ++w2) { const float tv = TOT[w2 * 64 + lane]; tot += tv; if (w2 < wave) off += tv; }
        if (wave == 0) ((LAS float*)(lds + RW_GAM))[lane] = fexp(tot);
        float fR[8], fA[8], fB[8], fK[8];
        float eprev = fexp(off);
#pragma unroll
        for (int u = 0; u < 8; ++u) { const float cum = off + lc[u], e1 = fexp(cum), ei = frcp(e1); fR[u] = rr[u] * e1; fA[u] = av[u] * eprev; fB[u] = bv[u] * ei; fK[u] = km[u] * ei; eprev = e1; }
        LAS bf16* At = RBUF(0); LAS bf16* Bt = RBUF(1); LAS bf16* Kt = RBUF(2); LAS bf16* Rt = RBUF(3);
#pragma unroll
        for (int u = 0; u < 8; ++u) { const int o = (tt0 + u) * MS + lane; At[o] = (bf16)f2bf(fA[u]); Bt[o] = (bf16)f2bf(fB[u]); Kt[o] = (bf16)f2bf(fK[u]); Rt[o] = (bf16)f2bf(fR[u]); }
        *(LAS bf16x8_t*)(RBUF(4) + lane * MS + tt0) = pack8(fA); *(LAS bf16x8_t*)(RBUF(5) + lane * MS + tt0) = pack8(fB);
        *(LAS bf16x8_t*)(RBUF(6) + lane * MS + tt0) = pack8(fK); *(LAS bf16x8_t*)(RBUF(7) + lane * MS + tt0) = pack8(vv);
    }
    asm volatile("" ::: "memory");
    if (it + G < NIT) R1_PREFETCH(it + G);
    LDS_BARRIER();
    asm volatile("; MARK_R1_G");
    {
        const LAS bf16* At = RBUF(0); const LAS bf16* Bt = RBUF(1); const LAS bf16* Kt = RBUF(2); const LAS bf16* Rt = RBUF(3);
#pragma unroll
        for (int c = 0; c < 2; ++c) { const int ct = ct0 + c; const f32x4 z = (f32x4){0.f, 0.f, 0.f, 0.f};
            f32x4 aL = mm64(z, Bt, rt, At, ct, lane);
            f32x4 aLT = mm64(z, At, rt, Bt, ct, lane);
            f32x4 aAK = mm64(z, Kt, rt, At, ct, lane);
            f32x4 aRB = mm64(z, Bt, rt, Rt, ct, lane);
            f32x4 aRK = mm64(z, Kt, rt, Rt, ct, lane);
            const int col = 16 * ct + l15;
#pragma unroll
            for (int r = 0; r < 4; ++r) { const int row = 16 * rt + 4 * lg + r;
                if (!(row < col)) { aL[r] = 0.f; aAK[r] = 0.f; }
                if (!(col < row)) aLT[r] = 0.f;
                if (!(row <= col)) { aRB[r] = 0.f; aRK[r] = 0.f; } }
            tstore(RBUF(8), rt, ct, aL, lane); tstore(RBUF(9), rt, ct, aLT, lane); tstore(RBUF(10), rt, ct, aAK, lane); tstore(RBUF(11), rt, ct, aRB, lane); tstore(RBUF(12), rt, ct, aRK, lane);
        }
    }
    LDS_BARRIER();
    asm volatile("; MARK_R1_N");
    {
    {
        for (int e = tid; e < 64 * 16; e += NTHREADS) { const int row = e >> 4, c4 = (e & 15) * 4; v2u w = *(const LAS v2u*)(RBUF(8) + row * MS + c4);
            if ((row >> 2) == (c4 >> 2)) { const unsigned one = 0x3f80u; const int p = row & 3; if (p == 0) w.x = (w.x & 0xffff0000u) | one; else if (p == 1) w.x = (w.x & 0xffffu) | (one << 16); else if (p == 2) w.y = (w.y & 0xffff0000u) | one; else w.y = (w.y & 0xffffu) | (one << 16); }
            *(LAS v2u*)(RBUF(0) + row * MS + c4) = w; }
    }
#define RW_SQUARE(Min, MTin, Mout, MTout) do { _Pragma("unroll") for (int c = 0; c < 2; ++c) { const int ct = ct0 + c; const f32x4 z = (f32x4){0.f, 0.f, 0.f, 0.f}; \
        tstore(RBUF(Mout), rt, ct, mm64(z, RBUF(MTin), rt, RBUF(Min), ct, lane), lane);        \
        tstore(RBUF(MTout), rt, ct, mm64(z, RBUF(Min), rt, RBUF(MTin), ct, lane), lane); } } while (0)
#define RW_YSTEP(Yin, MTin, Yout) do { _Pragma("unroll") for (int c = 0; c < 2; ++c) { const int ct = ct0 + c; \
        const f32x4 y0 = ld4bf(RBUF(Yin) + (16 * ct + l15) * MS + 16 * rt + 4 * lg);            \
        tstore(RBUF(Yout), rt, ct, mm64(y0, RBUF(MTin), rt, RBUF(Yin), ct, lane), lane); } } while (0)
    RW_SQUARE(8, 9, 2, 13);
    LDS_BARRIER();
    RW_YSTEP(0, 13, 1); RW_SQUARE(2, 13, 8, 9);
    LDS_BARRIER();
    RW_YSTEP(1, 9, 0); RW_SQUARE(8, 9, 2, 13);
    LDS_BARRIER();
    RW_YSTEP(0, 13, 1); RW_SQUARE(2, 13, 8, 9);
    LDS_BARRIER();
    RW_YSTEP(1, 9, 0); RW_SQUARE(8, 9, 2, 13);
    LDS_BARRIER();
    RW_YSTEP(0, 13, 1);
    {
#pragma unroll
        for (int c = 0; c < 2; ++c) { const int ct = ct0 + c; tstore(RBUF(9), rt, ct, mm64((f32x4){0.f, 0.f, 0.f, 0.f}, RBUF(10), rt, RBUF(7), ct, lane), lane); }
    }
    LDS_BARRIER();
    }
#undef RW_SQUARE
#undef RW_YSTEP
    asm volatile("; MARK_R1_F1");
    {
    {
#pragma unroll
        for (int c = 0; c < 2; ++c) { const int ct = ct0 + c; const f32x4 z = (f32x4){0.f, 0.f, 0.f, 0.f};
            tstore(RBUF(8), rt, ct, mm64(z, RBUF(1), rt, RBUF(4), ct, lane), lane);
            tstore(RBUF(0), rt, ct, mm64(z, RBUF(1), rt, RBUF(9), ct, lane), lane); }
    }
    LDS_BARRIER();
    {
        const LAS float* GAM = (const LAS float*)(lds + RW_GAM);
#pragma unroll
        for (int c = 0; c < 2; ++c) { const int ct = ct0 + c; const f32x4 z = (f32x4){0.f, 0.f, 0.f, 0.f};
            const f32x4 r0 = ld4bf(RBUF(3) + (16 * ct + l15) * MS + 16 * rt + 4 * lg);
            tstore_g(item, rt, ct, mm64(r0, RBUF(8), rt, RBUF(11), ct, lane), lane);
            f32x4 pp = mm64(z, RBUF(8), rt, RBUF(5), ct, lane);
            const float gm = GAM[16 * ct + l15];
#pragma unroll
            for (int r = 0; r < 4; ++r) pp[r] = gm * (pp[r] + ((16 * rt + 4 * lg + r) == (16 * ct + l15) ? 1.f : 0.f));
            { const int jp = 16 * ct + l15, j0 = 16 * rt + 4 * lg;
              *(GAS v2u*)(item + 8192 + ((((jp >> 5) * 4 + (j0 >> 4)) * 64 + (jp & 31) + 32 * ((j0 >> 2) & 1)) * 8 + 4 * ((j0 >> 3) & 1))) = pack4(pp); }
            f32x4 y0 = mm64(z, RBUF(0), rt, RBUF(11), ct, lane); y0 = mm64(y0, RBUF(7), rt, RBUF(12), ct, lane);
            tstore_g(item + 4096, rt, ct, y0, lane);
            f32x4 q = mm64(z, RBUF(5), rt, RBUF(0), ct, lane); q = mm64(q, RBUF(6), rt, RBUF(7), ct, lane);
            const f32x4 g4 = *(const LAS f32x4*)(GAM + 16 * rt + 4 * lg);
            q = q * g4;
            { const int iv = 16 * ct + l15, j0 = 16 * rt + 4 * lg;
              *(GAS v2u*)(item + 12288 + (((((j0 >> 5) * 2 + (iv >> 5)) * 4 + ((j0 >> 3) & 3)) * 64 + (iv & 31) + 32 * ((j0 >> 2) & 1)) * 4)) = pack4(q); } }
    }
    LDS_BARRIER();
    }
    }
#undef R1_PREFETCH
}

__device__ __forceinline__ void rwkv_state_scan(ArgP A, int b, int h, int lane, bool do_store = true) {
    const int r32 = lane & 31, hi = lane >> 5;
    f32x16 St[2][2];
#pragma unroll
    for (int kb = 0; kb < 2; ++kb)
#pragma unroll
        for (int vb = 0; vb < 2; ++vb)
#pragma unroll
            for (int r = 0; r < 16; ++r) St[kb][vb][r] = 0.f;
    bf16* item0 = (bf16*)(A->ws + WS_RWI) + ((size_t)((b * 64) * 8 + h)) * 16384;
    v4u pfn[8]; v2u qn[16];
#define RW2_LOAD(nn) do { const bf16* it_ = item0 + (size_t)(nn) * 8 * 16384; \
        _Pragma("unroll") for (int f = 0; f < 8; ++f) pfn[f] = *(const GAS v4u*)(it_ + 8192 + (f * 64 + lane) * 8); \
        _Pragma("unroll") for (int f = 0; f < 16; ++f) qn[f] = *(const GAS v2u*)(it_ + 12288 + (f * 64 + lane) * 4); } while (0)
    RW2_LOAD(0);
#pragma unroll 1
    for (int n = 0; n < 64; ++n) {
        bf16* PM = item0 + (size_t)n * 8 * 16384 + 8192;
        a_bf16x8 pf[2][4]; f32x16 Nw[2][2];
#pragma unroll
        for (int f = 0; f < 8; ++f) pf[f >> 2][f & 3] = __builtin_bit_cast(a_bf16x8, pfn[f]);
#pragma unroll
        for (int kb = 0; kb < 2; ++kb)
#pragma unroll
            for (int vb = 0; vb < 2; ++vb)
#pragma unroll
                for (int g = 0; g < 4; ++g) { const v2u w = qn[(kb * 2 + vb) * 4 + g]; Nw[kb][vb][4 * g] = bflo(w.x); Nw[kb][vb][4 * g + 1] = bfhi(w.x); Nw[kb][vb][4 * g + 2] = bflo(w.y); Nw[kb][vb][4 * g + 3] = bfhi(w.y); }
#pragma unroll
        for (int kb = 0; kb < 2; ++kb)
#pragma unroll
            for (int vb = 0; vb < 2; ++vb)
#pragma unroll
                for (int g = 0; g < 4; ++g) { v2u w; w.x = cvtpk(St[kb][vb][4 * g], St[kb][vb][4 * g + 1]); w.y = cvtpk(St[kb][vb][4 * g + 2], St[kb][vb][4 * g + 3]);
                    if (do_store) *(GAS v2u*)(PM + ((((2 * vb + (r32 >> 4)) * 2 + kb) * 64 + g * 16 + (r32 & 15)) * 8 + 4 * hi)) = w; }
        if (n + 1 < 64) RW2_LOAD(n + 1);
        a_bf16x8 sf[4][2];
#pragma unroll
        for (int ks = 0; ks < 4; ++ks)
#pragma unroll
            for (int vb = 0; vb < 2; ++vb) { const int kb = ks >> 1, s8 = 8 * (ks & 1); v4u w; w.x = cvtpk(St[kb][vb][s8], St[kb][vb][s8 + 1]); w.y = cvtpk(St[kb][vb][s8 + 2], St[kb][vb][s8 + 3]);
                w.z = cvtpk(St[kb][vb][s8 + 4], St[kb][vb][s8 + 5]); w.w = cvtpk(St[kb][vb][s8 + 6], St[kb][vb][s8 + 7]); sf[ks][vb] = __builtin_bit_cast(a_bf16x8, w); }
#pragma unroll
        for (int kb = 0; kb < 2; ++kb)
#pragma unroll
            for (int vb = 0; vb < 2; ++vb) {
#pragma unroll
                for (int ks = 0; ks < 4; ++ks) Nw[kb][vb] = __builtin_amdgcn_mfma_f32_32x32x16_bf16(pf[kb][ks], sf[ks][vb], Nw[kb][vb], 0, 0, 0);
            }
#pragma unroll
        for (int kb = 0; kb < 2; ++kb)
#pragma unroll
            for (int vb = 0; vb < 2; ++vb) St[kb][vb] = Nw[kb][vb];
    }
#undef RW2_LOAD
}

__device__ __forceinline__ void rwkv_out_phase(ArgP A, int L, int wt0, int wtstride, int lane) {
    const int i = L >> 1, l15 = lane & 15, lg = lane >> 4;
    const bf16* P = (const bf16*)(A->ws + WS_P); bf16* XNb = (bf16*)(A->ws + WS_XN); const float* BON = (const float*)(A->ws + WS_BON);
    int hcur = -1; v4u g2f[5][4]; f32x4 w4[4], b4[4], m4[4];
#pragma unroll 1
    for (int wt = wt0; wt < BATCH * 64 * 8 * 4; wt += wtstride) {
    const int it_ = wt >> 2, ct = wt & 3, b = it_ >> 9, n = (it_ >> 3) & 63, h = it_ & 7;
    if (h != hcur) { hcur = h;
        const bf16* G2T = (const bf16*)(A->ws + WS_G2T) + (size_t)(64 * h + l15) * 192 + 8 * lg;
#pragma unroll
        for (int q = 0; q < 5; ++q)
#pragma unroll
            for (int it = 0; it < 4; ++it) g2f[q][it] = *(const GAS v4u*)(G2T + (size_t)(16 * it) * 192 + 32 * q);
        const float* lnw = A->in[20] + i * 512 + 64 * h; const float* lnb = A->in[21] + i * 512 + 64 * h; const float* mu = A->in[7] + (size_t)i * 1536 + 1024 + 64 * h;
#pragma unroll
        for (int it = 0; it < 4; ++it) { const int i0 = 16 * it + 4 * lg; w4[it] = *(const GAS f32x4*)(lnw + i0); b4[it] = *(const GAS f32x4*)(lnb + i0); m4[it] = *(const GAS f32x4*)(mu + i0); } }
    const bf16* item = (const bf16*)(A->ws + WS_RWI) + ((size_t)((b * 64 + n) * 8 + h)) * 16384;
    const bf16* RH = item; const bf16* Y0 = item + 4096; const bf16* ST = item + 8192;
    const size_t row = (size_t)b * T + 64 * n + 16 * ct + l15; const int tseq = 64 * n + 16 * ct + l15;
    const bf16x8_t rf0 = *(const GAS bf16x8_t*)(RH + (16 * ct + l15) * 64 + 8 * lg), rf1 = *(const GAS bf16x8_t*)(RH + (16 * ct + l15) * 64 + 32 + 8 * lg);
    const bf16* prow = P + row * NIN_E; v4u gx[5], gy[5];
#pragma unroll
    for (int q = 0; q < 5; ++q) { gx[q] = *(const GAS v4u*)(prow + PC_G1A + 32 * q + 8 * lg); gy[q] = tseq > 0 ? *(const GAS v4u*)(prow - NIN_E + PC_G1B + 32 * q + 8 * lg) : (v4u){0u, 0u, 0u, 0u}; }
    const bf16* pr = prow + PC_V + 64 * h; v2u pvr[4], pvq[4];
#pragma unroll
    for (int it = 0; it < 4; ++it) { const int i0 = 16 * it + 4 * lg; pvr[it] = *(const GAS v2u*)(pr + i0); pvq[it] = tseq > 0 ? *(const GAS v2u*)(pr - NIN_E + i0) : (v2u){0u, 0u}; }
    const float bon = BON[row * 8 + h];
    f32x4 acc[4]; float s1 = 0.f;
#pragma unroll
    for (int it = 0; it < 4; ++it) {
        f32x4 a = ld4bf_g(Y0 + (16 * ct + l15) * 64 + 16 * it + 4 * lg);
        a = mfma16(*(const GAS bf16x8_t*)(ST + ((it * 2 + 0) * 64 + lane) * 8), rf0, a);
        a = mfma16(*(const GAS bf16x8_t*)(ST + ((it * 2 + 1) * 64 + lane) * 8), rf1, a);
        acc[it] = a; s1 += (a[0] + a[1]) + (a[2] + a[3]);
    }
    s1 += __shfl_xor(s1, 16); s1 += __shfl_xor(s1, 32);
    const float mean = s1 * (1.f / 64.f); float s2 = 0.f;
#pragma unroll
    for (int it = 0; it < 4; ++it) { acc[it] = acc[it] - mean; s2 += (acc[it][0] * acc[it][0] + acc[it][1] * acc[it][1]) + (acc[it][2] * acc[it][2] + acc[it][3] * acc[it][3]); }
    s2 += __shfl_xor(s2, 16); s2 += __shfl_xor(s2, 32);
    const float rs = frsq(s2 * (1.f / 64.f) + 64e-5f);
    f32x4 gq[4] = {(f32x4){0.f, 0.f, 0.f, 0.f}, (f32x4){0.f, 0.f, 0.f, 0.f}, (f32x4){0.f, 0.f, 0.f, 0.f}, (f32x4){0.f, 0.f, 0.f, 0.f}};
#pragma unroll
    for (int q = 0; q < 5; ++q) { float x[8], y[8], v[8]; unpack8(gx[q], x); unpack8(gy[q], y);
#pragma unroll
        for (int e = 0; e < 8; ++e) v[e] = sigmoid_f(x[e] + y[e]);
        const bf16x8_t fg = pack8(v);
#pragma unroll
        for (int it = 0; it < 4; ++it) gq[it] = mfma16(__builtin_bit_cast(bf16x8_t, g2f[q][it]), fg, gq[it]); }
#pragma unroll
    for (int it = 0; it < 4; ++it) { const int i0 = 16 * it + 4 * lg;
        const f32x4 pv = (f32x4){bflo(pvr[it].x), bfhi(pvr[it].x), bflo(pvr[it].y), bfhi(pvr[it].y)}, pvp = (f32x4){bflo(pvq[it].x), bfhi(pvq[it].x), bflo(pvq[it].y), bfhi(pvq[it].y)};
        const f32x4 v4 = pv + (pvp - pv) * m4[it];
        const f32x4 o = ((acc[it] * rs) * w4[it] + b4[it] + v4 * bon) * gq[it];
        *(GAS v2u*)(XNb + row * D + 64 * h + i0) = pack4(o); }
    }
}
constexpr size_t WS_GKV = 464 * MiB;
constexpr size_t WS_GDEC = 29 * MiB + 512 * 1024;
constexpr int GL_LA = 0, GL_KR = 16384, GL_VT = GL_KR + MB, GL_TOT = GL_VT + 2 * MB, GL1_END = GL_TOT + 2048;
static_assert(GL1_END <= RING_BYTES, "GLA LDS map");

template <int NCT> __device__ __forceinline__ void gla_lora_tiles(ArgP A, size_t rowb, int h4, int rt, int ct0, LAS float* LAs, int lane) {
    const int l15 = lane & 15, lg = lane >> 4;
    const bf16* P = (const bf16*)(A->ws + WS_P); const bf16* WA2T = (const bf16*)(A->ws + WS_WA2T);
    v4u av = (v4u){0u, 0u, 0u, 0u};
    if (lg < 2) av = *(const GAS v4u*)(P + (rowb + 16 * rt + l15) * NIN_E + PC_WA1 + 8 * lg);
    const bf16x8_t af = __builtin_bit_cast(bf16x8_t, av);
#pragma unroll
    for (int c = 0; c < NCT; ++c) { const int ct = ct0 + c;
        const f32x4 x = mfma16(af, *(const GAS bf16x8_t*)(WA2T + (size_t)(64 * h4 + 16 * ct + l15) * 32 + 8 * lg), (f32x4){0.f, 0.f, 0.f, 0.f});
#pragma unroll
        for (int r = 0; r < 4; ++r) LAs[(16 * rt + 4 * lg + r) * 64 + 16 * ct + l15] = x[r]; }
}

__device__ __forceinline__ void gla_kv_item(ArgP A, int L, int b, int n, int h4, LAS unsigned char* lds, int tid) {
    const int lane = tid & 63, wave = __builtin_amdgcn_readfirstlane(tid >> 6), i = L >> 1, l15 = lane & 15, lg = lane >> 4;
    const bf16* P = (const bf16*)(A->ws + WS_P);
    const size_t rowb = (size_t)b * T + 64 * n; const int itemi = (b * 64 + n) * 4 + h4;
    LAS float* LAs = (LAS float*)(lds + GL_LA); LAS bf16* KrT = (LAS bf16*)(lds + GL_KR); LAS bf16* VTm = (LAS bf16*)(lds + GL_VT); LAS float* TOT = (LAS float*)(lds + GL_TOT);
    gla_lora_tiles<2>(A, rowb, h4, wave >> 1, 2 * (wave & 1), LAs, lane);
    __syncthreads();
    {
        const int c = 64 * h4 + lane, tt0 = 8 * wave; const float bac = A->in[24][i * 256 + c];
        float lc[8], kx[8], qx[8], v0[8], v1[8]; float run = 0.f;
#pragma unroll
        for (int u = 0; u < 8; ++u) { const bf16* pr = P + (rowb + tt0 + u) * NIN_E; const float x = bac + LAs[(tt0 + u) * 64 + lane];
            run += -softplus_f(-x) * (1.0f / 16.0f); lc[u] = run; kx[u] = bf2f(pr[PC_GK + c]); qx[u] = bf2f(pr[PC_GQ + c]); v0[u] = bf2f(pr[PC_GV + 128 * h4 + lane]); v1[u] = bf2f(pr[PC_GV + 128 * h4 + 64 + lane]); }
        TOT[wave * 64 + lane] = run;
        __syncthreads();
        float off = 0.f, tot = 0.f;
#pragma unroll
        for (int w2 = 0; w2 < 8; ++w2) { const float tv = TOT[w2 * 64 + lane]; tot += tv; if (w2 < wave) off += tv; }
        if (wave == 0) ((float*)(A->ws + WS_GDEC))[itemi * 64 + lane] = fexp(tot);
        { bf16* Pw = (bf16*)(A->ws + WS_P); const float etot = fexp(tot);
#pragma unroll
          for (int u = 0; u < 8; ++u) { const float cum = off + lc[u], e1 = fexp(cum), kt = kx[u] * frcp(e1); bf16* pw = Pw + (rowb + tt0 + u) * NIN_E;
              pw[PC_GQ + c] = (bf16)f2bf(qx[u] * 0.125f * e1); pw[PC_GK + c] = (bf16)f2bf(kt); kx[u] = kt * etot; } }
        *(LAS bf16x8_t*)(KrT + lane * MS + tt0) = pack8(kx); *(LAS bf16x8_t*)(VTm + lane * MS + tt0) = pack8(v0); *(LAS bf16x8_t*)(VTm + (64 + lane) * MS + tt0) = pack8(v1);
    }
    __syncthreads();
    {
        bf16* KVg = (bf16*)(A->ws + WS_GKV) + (size_t)itemi * 8192; const int rt = wave >> 1;
#pragma unroll
        for (int c = 0; c < 4; ++c) { const int et = 4 * (wave & 1) + c;
            const f32x4 acc = mm64((f32x4){0.f, 0.f, 0.f, 0.f}, KrT, rt, VTm, et, lane);
            *(GAS v2u*)(KVg + (16 * et + l15) * 64 + 16 * rt + 4 * lg) = pack4(acc); }
    }
    __syncthreads();
}

__device__ __forceinline__ void gla_state_scan(ArgP A, int gt, bool do_store = true) {
    const int bh = gt >> 11, grp = gt & 2047;
    const int b = bh >> 2, h4 = bh & 3;
    bf16* base = (bf16*)(A->ws + WS_GKV) + (size_t)((b * 64) * 4 + h4) * 8192 + (size_t)grp * 4;
    const float* dec = (const float*)(A->ws + WS_GDEC) + (size_t)((b * 64) * 4 + h4) * 64 + (grp & 15) * 4;
    f32x4 S = (f32x4){0.f, 0.f, 0.f, 0.f};
#pragma unroll 1
    for (int n0 = 0; n0 < 64; n0 += 8) {
        v2u kv[8]; f32x4 dc[8];
#pragma unroll
        for (int u = 0; u < 8; ++u) { kv[u] = *(const GAS v2u*)(base + (size_t)(n0 + u) * 4 * 8192); dc[u] = *(const GAS f32x4*)(dec + (size_t)(n0 + u) * 4 * 64); }
#pragma unroll
        for (int u = 0; u < 8; ++u) { if (do_store) *(GAS v2u*)(base + (size_t)(n0 + u) * 4 * 8192) = pack4(S);
            S = S * dc[u] + (f32x4){bflo(kv[u].x), bfhi(kv[u].x), bflo(kv[u].y), bfhi(kv[u].y)}; }
    }
}

constexpr int G3B_SV = 272, G3B_VT = 0, G3B_SC = 64 * G3B_SV, G3B_GRP = G3B_SC + MB;
static_assert(2 * G3B_GRP <= RING_BYTES, "GLA phase-3 LDS map");
__device__ __forceinline__ void gla_out_phase(ArgP A, int L, LAS unsigned char* lds, int tid, int G, int bid) {
    const int lane = tid & 63, wave = __builtin_amdgcn_readfirstlane(tid >> 6), i = L >> 1, l15 = lane & 15, lg = lane >> 4;
    const int gi = wave >> 2, wq = wave & 3;
    const bf16* P = (const bf16*)(A->ws + WS_P); bf16* XNb = (bf16*)(A->ws + WS_XN);
    LAS unsigned char* gb = lds + gi * G3B_GRP; LAS bf16* SC = (LAS bf16*)(gb + G3B_SC);
    const int ct = wq; const int col = 16 * ct + l15;
    int hcur = -1; f32x4 gn4[8];
#pragma unroll 1
    for (int item2 = bid; item2 < BATCH * 64 * 4 / 2; item2 += G) {
    const int itemi = 2 * item2 + gi, h4 = itemi & 3, n = (itemi >> 2) & 63, b = itemi >> 8;
    const size_t rowb = (size_t)b * T + 64 * n;
    if (h4 != hcur) { hcur = h4; const float* gn = A->in[25] + i * 512 + 128 * h4;
#pragma unroll
        for (int et = 0; et < 8; ++et) gn4[et] = *(const GAS f32x4*)(gn + 16 * et + 4 * lg); }
    v4u vreg[4];
    { const int t4 = tid & 255;
#pragma unroll
      for (int q = 0; q < 4; ++q) { const int id = t4 + 256 * q, row = id >> 4, ch = id & 15; vreg[q] = *(const GAS v4u*)(P + (rowb + row) * NIN_E + PC_GV + 128 * h4 + 8 * ch); } }
    const bf16* qrow = P + (rowb + col) * NIN_E + PC_GQ + 64 * h4 + 8 * lg;
    const bf16x8_t qf0 = *(const GAS bf16x8_t*)qrow, qf1 = *(const GAS bf16x8_t*)(qrow + 32);
    v4u kf[4][2];
#pragma unroll
    for (int rt = 0; rt < 4; ++rt) { const bf16* krow = P + (rowb + 16 * rt + l15) * NIN_E + PC_GK + 64 * h4 + 8 * lg;
        if (rt <= ct) { kf[rt][0] = *(const GAS v4u*)krow; kf[rt][1] = *(const GAS v4u*)(krow + 32); } else { kf[rt][0] = (v4u){0u, 0u, 0u, 0u}; kf[rt][1] = (v4u){0u, 0u, 0u, 0u}; } }
    const bf16* Sg = (const bf16*)(A->ws + WS_GKV) + (size_t)itemi * 8192;
    v4u sgf[8][2];
#pragma unroll
    for (int et = 0; et < 8; ++et) { sgf[et][0] = *(const GAS v4u*)(Sg + (16 * et + l15) * 64 + 8 * lg); sgf[et][1] = *(const GAS v4u*)(Sg + (16 * et + l15) * 64 + 32 + 8 * lg); }
    const size_t row = rowb + col; v2u ggr[8];
#pragma unroll
    for (int et = 0; et < 8; ++et) ggr[et] = *(const GAS v2u*)(P + row * NIN_E + PC_GG + 128 * h4 + 16 * et + 4 * lg);
    { const int t4 = tid & 255;
#pragma unroll
      for (int q = 0; q < 4; ++q) { const int id = t4 + 256 * q, vrow = id >> 4, ch = id & 15; *(LAS v4u*)(gb + G3B_VT + vrow * G3B_SV + ch * 16) = vreg[q]; } }
#pragma unroll
    for (int rt = 0; rt < 4; ++rt) { f32x4 acc = (f32x4){0.f, 0.f, 0.f, 0.f};
        if (rt <= ct) {
            acc = mfma16(__builtin_bit_cast(bf16x8_t, kf[rt][0]), qf0, acc); acc = mfma16(__builtin_bit_cast(bf16x8_t, kf[rt][1]), qf1, acc);
#pragma unroll
            for (int r = 0; r < 4; ++r) if (!((16 * rt + 4 * lg + r) <= col)) acc[r] = 0.f; }
        tstore(SC, rt, ct, acc, lane); }
    __syncthreads();
    const int vto = G3B_VT + (8 * lg + (l15 >> 2)) * G3B_SV + 4 * (lane & 3) * 2;
    f32x4 o[8]; float ss = 0.f;
#pragma unroll
    for (int et = 0; et < 8; ++et) { f32x4 acc = (f32x4){0.f, 0.f, 0.f, 0.f};
#pragma unroll
        for (int ks = 0; ks < 2; ++ks) { const LAS unsigned char* vp = gb + vto + ks * 32 * G3B_SV + et * 32;
            const a_s16x4 lo4 = __builtin_bit_cast(a_s16x4, __builtin_amdgcn_ds_read_tr16_b64_v4i16((LAS a_s16x4*)vp));
            const a_s16x4 hi4 = __builtin_bit_cast(a_s16x4, __builtin_amdgcn_ds_read_tr16_b64_v4i16((LAS a_s16x4*)(vp + 4 * G3B_SV)));
            const bf16x8_t vf = (bf16x8_t){lo4[0], lo4[1], lo4[2], lo4[3], hi4[0], hi4[1], hi4[2], hi4[3]};
            acc = mfma16(vf, ldfrag(SC, 16 * ct, 32 * ks, lane), acc); }
        acc = mfma16(__builtin_bit_cast(bf16x8_t, sgf[et][0]), qf0, acc);
        acc = mfma16(__builtin_bit_cast(bf16x8_t, sgf[et][1]), qf1, acc);
        o[et] = acc; ss += (acc[0] * acc[0] + acc[1] * acc[1]) + (acc[2] * acc[2] + acc[3] * acc[3]); }
    ss += __shfl_xor(ss, 16); ss += __shfl_xor(ss, 32);
    const float rs = frsq(ss * (1.f / 128.f) + 1e-5f);
#pragma unroll
    for (int et = 0; et < 8; ++et) { const int e0 = 16 * et + 4 * lg; const f32x4 gg = (f32x4){bflo(ggr[et].x), bfhi(ggr[et].x), bflo(ggr[et].y), bfhi(ggr[et].y)};
        f32x4 v = o[et] * rs * gn4[et]; v[0] *= silu_f(gg[0]); v[1] *= silu_f(gg[1]); v[2] *= silu_f(gg[2]); v[3] *= silu_f(gg[3]);
        *(GAS v2u*)(XNb + row * D + 512 + 128 * h4 + e0) = pack4(v); }
    __syncthreads();
    }
}
constexpr int N_STEPS = 37;
#ifndef MK_ONE_LAUNCH
#define MK_ONE_LAUNCH 1
#endif
__global__ void __launch_bounds__(NTHREADS, 2) hybrid_fwd(Args args) {
    extern __shared__ __attribute__((aligned(16))) unsigned char lds_raw[];
    LAS unsigned char* lds = (LAS unsigned char*)lds_raw;
    ArgP A0 = (ArgP)__builtin_amdgcn_kernarg_segment_ptr();
    { const int tid = threadIdx.x; for (int u = tid; u < (LDS_BYTES - LDSCTL_OFF) / 4; u += NTHREADS) ((LAS unsigned*)(lds + LDSCTL_OFF))[u] = 0u; }
    __syncthreads();
    const int lo = A0->lo, hi = A0->hi;
    if (hi - lo > 1) (void)xcd_barrier_post((unsigned*)(A0->ws + WS_CTL) + CW_BAR, (volatile LAS unsigned*)(lds + MISC_OFF) + 8);
#ifndef PHM
#define PHM 0xff
#endif
#define RUN(s) (lo <= (s) && (s) < hi)
#define EN(b) ((PHM >> (b)) & 1)
#ifndef PROBE_REP
#define PROBE_REP 0
#endif
#define REP(b) _Pragma("unroll 1") for (int rep_ = 0; rep_ < (((PROBE_REP >> (b)) & 1) ? 2 : 1); ++rep_)
#ifndef PROBE_TMASK
#define PROBE_TMASK 0u
#endif
    int nbar_ = 0;
    if (PROBE_TMASK) { if (blockIdx.x == 0 && threadIdx.x == 0) ((unsigned long long*)((unsigned*)(A0->ws + WS_CTL) + 32768))[0] = __builtin_amdgcn_s_memrealtime(); }
#define GRID_BARRIER() do { ArgP Ab_ = FRESH_ARGS(); XcdBarrier b_; b_.bar = (unsigned*)(Ab_->ws + WS_CTL) + CW_BAR; b_.x = xb_xcc_id(); b_.st = (volatile LAS unsigned*)(lds + MISC_OFF) + 8; xcd_barrier(b_); if (PROBE_TMASK) { ++nbar_; if (blockIdx.x == 0 && threadIdx.x == 0) ((unsigned long long*)((unsigned*)(Ab_->ws + WS_CTL) + 32768))[nbar_] = __builtin_amdgcn_s_memrealtime(); } } while (0)
#define SEAM(s) do { if (RUN(s) && RUN((s) + 1)) GRID_BARRIER(); } while (0)
#define PHASE_VARS() ArgP A = FRESH_ARGS(); int L = Lq; FRESH_S(L); int tid = threadIdx.x; FRESH_V(tid); const int lane = tid & 63, wave = __builtin_amdgcn_readfirstlane(tid >> 6); int G = gridDim.x, bid = blockIdx.x; FRESH_S(G); FRESH_S(bid); (void)lane; (void)wave; (void)G; (void)A; (void)bid; \
    bf16* XN = (bf16*)(A->ws + WS_XN); bf16* PB = (bf16*)(A->ws + WS_P); (void)XN; (void)PB

#define BAR2(a, b) do { if (RUN(a) && RUN(b)) GRID_BARRIER(); } while (0)
    if (EN(0) && RUN(0)) REP(0) { int Lq = 0; PHASE_VARS(); const int gw = bid * NWAVES + wave, NGW = G * NWAVES;
        convert_mixer_weights(A, 0, lds, wave, lane, gw, NGW);
        float* ssq0 = (float*)(A->ws + WS_SSQ);
        for (int m = gw; m < M; m += NGW) x_to_bf16_ssq(A->in[0] + (size_t)m * D, (bf16*)A->out + (size_t)m * D, ssq0 + (size_t)m * 16, lane); }
    BAR2(0, 1);
    for (int Lq = 0; Lq < 4; ++Lq) {
        const int s0 = 9 * Lq; const bool even = !(Lq & 1);
        if (EN(1) && RUN(s0 + 1)) REP(1) {
            PHASE_VARS(); bf16* Win = (bf16*)(A->ws + WS_WIN); const float* ssq = (const float*)(A->ws + WS_SSQ);
            if (even) {
                pg8::Gemm g{(bf16*)A->out, Win, M, NIN_E, D}; pg8::StaticOrderC<M, NIN_E> S; S.init(G, bid);
                pg8::fill_row_scales(S, ssq, (LAS float*)(lds + RSTAB_OFF), tid);
                pg8::EpiStoreBf16 E{PB, NIN_E, 0, 1.0f, (const LAS float*)(lds + RSTAB_OFF)};
                pg8::gemm_phase<pg8::EpiStoreBf16, pg8::StaticOrderC<M, NIN_E>, PG8_ALIGN, PG8_SP2>(lds, g, S, E);
            } else {
                pg8::Gemm g{(bf16*)A->out, Win, M, NIN_O, D}; pg8::StaticOrderC<M, NIN_O> S; S.init(G, bid);
                pg8::fill_row_scales(S, ssq, (LAS float*)(lds + RSTAB_OFF), tid);
                pg8::EpiStoreBf16 E{PB, NIN_O, 4, 0.125f * 1.4426950408889634f, (const LAS float*)(lds + RSTAB_OFF)};
                pg8::gemm_phase<pg8::EpiStoreBf16, pg8::StaticOrderC<M, NIN_O>, PG8_ALIGN, PG8_SP2>(lds, g, S, E);
            }
        }
        if (even) {
            BAR2(s0 + 1, s0 + 2);
            if (EN(2) && RUN(s0 + 2)) REP(2) { PHASE_VARS();
                rwkv_chunk_phase(A, L, lds, tid, G, bid);
                REP(8) {
#pragma unroll 1
                for (int it = bid; it < BATCH * 64 * 4; it += G) gla_kv_item(A, L, it >> 8, (it >> 2) & 63, it & 3, lds, tid); } }
            BAR2(s0 + 2, s0 + 3);
            if (EN(3) && RUN(s0 + 3)) {
                PHASE_VARS();
                if (bid < 64) { if (wave == 0) rwkv_state_scan(A, bid >> 3, bid & 7, lane); }
                else { for (int gt = (bid - 64) * NTHREADS + tid; gt < 32 * 2048; gt += (G - 64) * NTHREADS) gla_state_scan(A, gt);
                       convert_ffn_weights(A, L, lds, wave, lane, (bid - 64) * NWAVES + wave, (G - 64) * NWAVES); }
            }
            BAR2(s0 + 3, s0 + 4);
            if (EN(3) && RUN(s0 + 4)) {
                PHASE_VARS();
                REP(9) {
                gla_out_phase(A, L, lds, tid, G, bid); }
                rwkv_out_phase(A, L, bid * NWAVES + wave, G * NWAVES, lane);
            }
            BAR2(s0 + 4, s0 + 5);
        } else {
            BAR2(s0 + 1, s0 + 3);
            if (EN(4) && RUN(s0 + 3) && ((PROBE_REP >> 16) & 1)) { PHASE_VARS(); attn_phase_mfma<true>(A, L, lds, tid, G, bid); }
            if (EN(4) && RUN(s0 + 3)) REP(4) { PHASE_VARS(); attn_phase_mfma(A, L, lds, tid, G, bid); convert_ffn_weights(A, L, lds, wave, lane, bid * NWAVES + wave, G * NWAVES); }
            BAR2(s0 + 3, s0 + 5);
        }
        if (EN(5) && RUN(s0 + 5)) {
            PHASE_VARS(); bf16* Wout = (bf16*)(A->ws + WS_WOUT);
            pg8::Gemm g{XN, Wout, M, D, D}; pg8::StaticOrderC<M, D> S; S.init(G, bid);
            if ((PROBE_REP >> 5) & 1) { pg8::EpiResBf16<false, true> E0{(bf16*)A->out, D, (float*)(A->ws + WS_SSQ) + (size_t)M * 16, nullptr};
                pg8::gemm_phase<pg8::EpiResBf16<false, true>, pg8::StaticOrderC<M, D>, PG8_ALIGN, PG8_SP2>(lds, g, S, E0); }
            pg8::EpiResBf16<false> E{(bf16*)A->out, D, (float*)(A->ws + WS_SSQ) + (size_t)M * 16, nullptr};
            pg8::gemm_phase<pg8::EpiResBf16<false>, pg8::StaticOrderC<M, D>, PG8_ALIGN, PG8_SP2>(lds, g, S, E);
        }
        BAR2(s0 + 5, s0 + 7);
        if (EN(6) && RUN(s0 + 7)) REP(6) {
            PHASE_VARS(); bf16* Wgu = (bf16*)(A->ws + WS_WGU);
            pg8::Gemm g{(bf16*)A->out, Wgu, M, NGU, D}; pg8::StaticOrderC<M, NGU> S; S.init(G, bid);
            pg8::fill_row_scales(S, (const float*)(A->ws + WS_SSQ) + (size_t)M * 16, (LAS float*)(lds + RSTAB_OFF), tid);
            if ((PROBE_REP >> 18) & 1) { pg8::EpiNull En; pg8::gemm_phase<pg8::EpiNull, pg8::StaticOrderC<M, NGU>, PG8_ALIGN, PG8_SP2>(lds, g, S, En); }
            if ((PROBE_REP >> 15) & 1) { pg8::EpiSwigluT<true> E0{PB, FF, (const LAS float*)(lds + RSTAB_OFF)};
                pg8::gemm_phase<pg8::EpiSwigluT<true>, pg8::StaticOrderC<M, NGU>, PG8_ALIGN, PG8_SP2>(lds, g, S, E0); }
            pg8::EpiSwiglu E{PB, FF, (const LAS float*)(lds + RSTAB_OFF)};
            pg8::gemm_phase<pg8::EpiSwiglu, pg8::StaticOrderC<M, NGU>, PG8_ALIGN, PG8_SP2>(lds, g, S, E);
        }
        BAR2(s0 + 7, s0 + 8);
        if (EN(7) && RUN(s0 + 8)) {
            PHASE_VARS(); bf16* Wdn = (bf16*)(A->ws + WS_WDN);
            pg8::Gemm g{PB, Wdn, M, D, FF}; pg8::StaticOrderC<M, D> S; S.init(G, bid);
            if ((PROBE_REP >> 7) & 1) { pg8::EpiResBf16<false, true> E0{(bf16*)A->out, D, (float*)(A->ws + WS_SSQ), nullptr};
                pg8::gemm_phase<pg8::EpiResBf16<false, true>, pg8::StaticOrderC<M, D>, PG8_ALIGN, PG8_SP2>(lds, g, S, E0); }
            if (L < 3) { pg8::EpiResBf16<false> E{(bf16*)A->out, D, (float*)(A->ws + WS_SSQ), nullptr};
                pg8::gemm_phase<pg8::EpiResBf16<false>, pg8::StaticOrderC<M, D>, PG8_ALIGN, PG8_SP2>(lds, g, S, E);
                convert_mixer_weights(A, L + 1, lds, wave, lane, bid * NWAVES + wave, G * NWAVES); }
            else { pg8::EpiResBf16<true> E{(bf16*)A->out, D, (float*)(A->ws + WS_SSQ), XN};
                pg8::gemm_phase<pg8::EpiResBf16<true>, pg8::StaticOrderC<M, D>, PG8_ALIGN, PG8_SP2>(lds, g, S, E); }
        }
        BAR2(s0 + 8, Lq < 3 ? s0 + 10 : 36);
    }
    if (RUN(36)) REP(17) {
        int Lq = 0; PHASE_VARS();
        const int gw = bid * NWAVES + wave, NGW = G * NWAVES;
        float pscale_ = 1.0f;
        if (PROBE_TMASK) { const unsigned long long* ts = (const unsigned long long*)((const unsigned*)(A->ws + WS_CTL) + 32768); unsigned long long acc_ = 0;
            for (int k = 1; k <= 25; ++k) if ((PROBE_TMASK >> k) & 1u) acc_ += ts[k] - ts[k - 1];
            pscale_ = 1.0f + __builtin_sqrtf((float)acc_ * 0.01f * 1e-4f); }
        for (int m = gw; m < M; m += NGW) rms_row_bf16_to_f32(XN + (size_t)m * D, A->in[4], A->out + (size_t)m * D, lane, pscale_);
    }
#undef RUN
#undef SEAM
}

extern "C" void kernel_launch(void* const* d_in, const int* in_sizes, int n_in, void* d_out, int out_size, void* d_ws, size_t ws_size, hipStream_t stream) {
    static int grid = 0;
    if (grid == 0) {
        if (n_in != 36 || in_sizes[0] != M * D || out_size != M * D || ws_size < WS_END) { fprintf(stderr, "kernel_launch: unexpected shapes (n_in %d, in0 %d, out %d, ws %zu); nothing launched\n", n_in, n_in > 0 ? in_sizes[0] : -1, out_size, ws_size); grid = -1; return; }
        int dev = 0, cus = 0, per_cu = 0;
        if (hipGetDevice(&dev) != hipSuccess || hipDeviceGetAttribute(&cus, hipDeviceAttributeMultiprocessorCount, dev) != hipSuccess) { grid = -1; return; }
        if (hipFuncSetAttribute((const void*)hybrid_fwd, hipFuncAttributeMaxDynamicSharedMemorySize, LDS_BYTES) != hipSuccess) { fprintf(stderr, "kernel_launch: hipFuncSetAttribute failed\n"); grid = -1; return; }
        if (hipOccupancyMaxActiveBlocksPerMultiprocessor(&per_cu, (const void*)hybrid_fwd, NTHREADS, LDS_BYTES) != hipSuccess || per_cu < 1) fprintf(stderr, "kernel_launch: occupancy query reports %d\n", per_cu);
        (void)hipGetLastError();
        if (cus < 128) { fprintf(stderr, "kernel_launch: built for a 256-CU device (phase 3 of the even layers needs more than 64 workgroups); nothing launched\n"); grid = -1; return; }
        grid = cus;
    }
    if (grid < 0) return;
    if (hipMemsetAsync((char*)d_ws + WS_CTL, 0, CTL_ZERO_BYTES, stream) != hipSuccess) return;
    Args a{};
    for (int i = 0; i < 36; ++i) a.in[i] = (const float*)d_in[i];
    a.out = (float*)d_out; a.ws = (unsigned char*)d_ws;
#if MK_ONE_LAUNCH
    a.lo = 0; a.hi = N_STEPS;
    hipLaunchKernelGGL(hybrid_fwd, dim3(grid), dim3(NTHREADS), LDS_BYTES, stream, a);
#else
    for (int s = 0; s < N_STEPS; ++s) {
        if (s < 36 && ((s % 9) == 2 || (s % 9) == 4) && ((s / 9) & 1)) continue;
        a.lo = s; a.hi = s + 1;
        hipLaunchKernelGGL(hybrid_fwd, dim3(grid), dim3(NTHREADS), LDS_BYTES, stream, a);
    }
#endif
}
```

```cpp
#include <hip/hip_runtime.h>
#include <cstdio>
#include <cstdint>
__device__ __forceinline__ float silu_f(float x) { return x * __builtin_amdgcn_rcpf(1.0f + __builtin_amdgcn_exp2f(-1.4426950408889634f * x)); }
namespace pg8 {
#define PG8_LAS __attribute__((address_space(3)))
typedef unsigned short bf16_t;
typedef short bf16x8 __attribute__((ext_vector_type(8)));
typedef float f32x4 __attribute__((ext_vector_type(4)));
typedef unsigned u32x4 __attribute__((ext_vector_type(4)));
constexpr int BM = 256, BK = 64, HALF = 128, HTB = HALF * BK * 2  , STAGE_BYTES = 8 * HTB, NXCD = 8, WGM = 4;

__host__ __device__ __forceinline__ int lds_byte(int r, int c) { const int st = (r >> 4) * 2 + (c >> 5), rr = r & 15, cc = c & 31, ob = rr * 64 + cc * 2; return st * 1024 + (ob ^ (((ob >> 9) & 1) << 5)); }
__host__ __device__ __forceinline__ void stage_rc(int b, int& R, int& C) { const int st = b / 1024, sb = b % 1024, swz = sb ^ (((sb >> 9) & 1) << 5); R = (st >> 1) * 16 + swz / 64; C = (st & 1) * 32 + (swz % 64) / 2; }
__host__ __device__ __forceinline__ int perm32(int rho) { const int n = rho >> 4, i = rho & 15; return 8 * (i >> 2) + 4 * n + (i & 3); }

struct Unit { int pm, pn, idx; };
struct Gemm { const bf16_t* A; const bf16_t* Bt; int M, N, K; };

struct StaticOrder {
    int nM, nN, nwg, G, c;
    __host__ __device__ void init(int M, int N, int G_, int c_) { nM = M / BM; nN = N / BM; nwg = nM * nN; G = G_; c = c_; }
    __host__ __device__ bool next(int i, Unit& u) const {
        const long L = (long)i * G + c; if (L >= nwg) return false;
        int wgid = (int)L; { const int q = nwg / NXCD, r = nwg % NXCD, xcd = wgid % NXCD, off = wgid / NXCD; wgid = (xcd < r ? xcd * (q + 1) : r * (q + 1) + (xcd - r) * q) + off; }
        const int nig = WGM * nN, gid = wgid / nig, fm = gid * WGM, gsz = (nM - fm) < WGM ? (nM - fm) : WGM;
        u.pm = fm + ((wgid % nig) % gsz); u.pn = (wgid % nig) / gsz; return true;
    }
    __device__ __forceinline__ void a_ready(const Unit&) const {}
    __device__ __forceinline__ void done(const Unit&) const {}
};

__device__ __forceinline__ unsigned cvt_pk_bf16(float lo, float hi) { unsigned r; asm volatile("v_cvt_pk_bf16_f32 %0, %1, %2" : "=v"(r) : "v"(lo), "v"(hi)); return r; }
typedef float f32x2 __attribute__((ext_vector_type(2)));
__device__ __forceinline__ float row_ssq(const float* ssq, int row) { const f32x4* p = (const f32x4*)(ssq + (size_t)row * 16); const f32x4 a = p[0], b = p[1], c = p[2], d = p[3];
    return (((a[0] + a[1]) + (a[2] + a[3])) + ((b[0] + b[1]) + (b[2] + b[3]))) + (((c[0] + c[1]) + (c[2] + c[3])) + ((d[0] + d[1]) + (d[2] + d[3]))); }
struct EpiStoreBf16 {
    static constexpr bool PERM = true, AFTER_DRAIN = false;
    bf16_t* O; int ldc; int qtiles; float qscale; const PG8_LAS float* rstab;
    __device__ __forceinline__ void operator()(const f32x4 (&acc)[2][2][4][2], const Unit& u, int wr, int wc, int fr, int fq) const {
        const int row0 = u.pm * BM + wr * 64 + fr, col0 = u.pn * BM + wc * 32 + 8 * fq;
        const float sc = u.pn < qtiles ? qscale : 1.0f;
        const PG8_LAS float* rt_ = rstab + u.idx * BM + wr * 64 + fr;
#pragma unroll
        for (int ai = 0; ai < 2; ++ai)
#pragma unroll
            for (int m = 0; m < 4; ++m) { const int row = row0 + ai * HALF + m * 16; bf16_t* rowp = O + (size_t)row * ldc + col0;
                const float rs = sc * rt_[ai * HALF + m * 16];
#pragma unroll
                for (int bj = 0; bj < 2; ++bj) { const f32x4 v0 = acc[ai][bj][m][0] * rs, v1 = acc[ai][bj][m][1] * rs;
                    u32x4 w; w.x = cvt_pk_bf16(v0[0], v0[1]); w.y = cvt_pk_bf16(v0[2], v0[3]); w.z = cvt_pk_bf16(v1[0], v1[1]); w.w = cvt_pk_bf16(v1[2], v1[3]);
                    *(u32x4*)(rowp + bj * HALF) = w; } }
    }
};
template <bool LAST, bool NOSTORE = false> struct EpiResBf16 {
    static constexpr bool PERM = false, AFTER_DRAIN = false;
    bf16_t* xr; int ldc; float* ssq; bf16_t* xf;
    __device__ __forceinline__ void operator()(const f32x4 (&acc)[2][2][4][2], const Unit& u, int wr, int wc, int fr, int fq) const {
        typedef unsigned u32x2 __attribute__((ext_vector_type(2)));
        const int row0 = u.pm * BM + wr * 64 + fr, col0 = u.pn * BM + wc * 32 + 4 * fq;
#pragma unroll
        for (int ai = 0; ai < 2; ++ai)
#pragma unroll
            for (int m = 0; m < 4; ++m) { const int row = row0 + ai * HALF + m * 16; const size_t off = (size_t)row * ldc + col0; float s = 0.f;
#pragma unroll
                for (int bj = 0; bj < 2; ++bj)
#pragma unroll
                    for (int n = 0; n < 2; ++n) { const u32x2 bw = *(const u32x2*)(xr + off + bj * HALF + n * 16);
                        const f32x4 b = (f32x4){__builtin_bit_cast(float, bw.x << 16), __builtin_bit_cast(float, bw.x & 0xffff0000u), __builtin_bit_cast(float, bw.y << 16), __builtin_bit_cast(float, bw.y & 0xffff0000u)};
                        const f32x4 v = b + acc[ai][bj][m][n];
                        s += (v[0] * v[0] + v[1] * v[1]) + (v[2] * v[2] + v[3] * v[3]);
                        u32x2 w; w.x = cvt_pk_bf16(v[0], v[1]); w.y = cvt_pk_bf16(v[2], v[3]); if (!NOSTORE) *(u32x2*)((LAST ? xf : xr) + off + bj * HALF + n * 16) = w; else asm volatile("" :: "v"(w.x), "v"(w.y)); }
                s += __shfl_xor(s, 16); s += __shfl_xor(s, 32);
                if (fq == 0 && !NOSTORE) ssq[(size_t)row * 16 + u.pn * 4 + wc] = s;
                if (m & 1) asm volatile("" ::: "memory"); }
    }
};
template <bool NOSTORE = false> struct EpiSwigluT {
    static constexpr bool PERM = true, AFTER_DRAIN = false;
    bf16_t* H; int ldc; const PG8_LAS float* rstab;
    __device__ __forceinline__ void operator()(const f32x4 (&acc)[2][2][4][2], const Unit& u, int wr, int wc, int fr, int fq) const {
        const int row0 = u.pm * BM + wr * 64 + fr, colh = u.pn * HALF + wc * 32 + 8 * fq;
        const PG8_LAS float* rt_ = rstab + u.idx * BM + wr * 64 + fr;
#pragma unroll
        for (int ai = 0; ai < 2; ++ai)
#pragma unroll
            for (int m = 0; m < 4; ++m) { const int row = row0 + ai * HALF + m * 16; bf16_t* rowp = H + (size_t)row * ldc + colh;
                const float rs = rt_[ai * HALF + m * 16];
                const f32x4 g0 = acc[ai][0][m][0] * rs, g1 = acc[ai][0][m][1] * rs, u0 = acc[ai][1][m][0] * rs, u1 = acc[ai][1][m][1] * rs;
                float h[8];
#pragma unroll
                for (int e = 0; e < 4; ++e) { h[e] = silu_f(g0[e]) * u0[e]; h[4 + e] = silu_f(g1[e]) * u1[e]; }
                u32x4 w; w.x = cvt_pk_bf16(h[0], h[1]); w.y = cvt_pk_bf16(h[2], h[3]); w.z = cvt_pk_bf16(h[4], h[5]); w.w = cvt_pk_bf16(h[6], h[7]);
                if (!NOSTORE) *(u32x4*)rowp = w; else asm volatile("" :: "v"(w.x), "v"(w.y), "v"(w.z), "v"(w.w)); }
    }
};
typedef EpiSwigluT<false> EpiSwiglu;
struct EpiNull {
    static constexpr bool PERM = true, AFTER_DRAIN = false;
    __device__ __forceinline__ void operator()(const f32x4 (&acc)[2][2][4][2], const Unit& u, int wr, int wc, int fr, int fq) const {
#pragma unroll
        for (int ai = 0; ai < 2; ++ai)
#pragma unroll
            for (int bj = 0; bj < 2; ++bj)
#pragma unroll
                for (int m = 0; m < 4; ++m)
#pragma unroll
                    for (int n = 0; n < 2; ++n) asm volatile("" :: "v"(acc[ai][bj][m][n]));
    }
};
template <int M_, int N_> struct StaticOrderC {
    static constexpr int nM = M_ / BM, nN = N_ / BM, nwg = nM * nN;
    int G, c;
    __device__ __forceinline__ void init(int G_, int c_) { G = G_; c = c_; }
    __device__ __forceinline__ bool next(int i, Unit& u) const {
        const int L = i * G + c; if (L >= nwg) return false;
        int wgid = L; { constexpr int q = nwg / NXCD, r = nwg % NXCD; const int xcd = wgid % NXCD, off = wgid / NXCD; wgid = (xcd < r ? xcd * (q + 1) : r * (q + 1) + (xcd - r) * q) + off; }
        constexpr int nig = WGM * nN; const int gid = wgid / nig, fm = gid * WGM, gsz = (nM - fm) < WGM ? (nM - fm) : WGM;
        u.pm = fm + ((wgid % nig) % gsz); u.pn = (wgid % nig) / gsz; u.idx = i; return true;
    }
    __device__ __forceinline__ void a_ready(const Unit&) const {}
    __device__ __forceinline__ void done(const Unit&) const {}
};
template <class Sched> __device__ __forceinline__ void fill_row_scales(const Sched& S, const float* ssq, PG8_LAS float* tab, int tid) {
    Unit u; const int r = tid >> 1, hf = tid & 1;
    for (int i = 0; S.next(i, u); ++i) { const f32x4* p = (const f32x4*)(ssq + (size_t)(u.pm * BM + r) * 16 + hf * 8); const f32x4 a = p[0], b = p[1];
        float sum = ((a[0] + a[1]) + (a[2] + a[3])) + ((b[0] + b[1]) + (b[2] + b[3])); sum += __shfl_xor(sum, 1);
        if (hf == 0) tab[i * BM + r] = __builtin_amdgcn_rsqf(sum * (1.0f / 1024.0f) + 1e-6f); }
    __syncthreads();
}
template <class Epi, class Sched, bool ALIGN_EPI = false, bool SP2 = false>
__device__ __forceinline__ void gemm_phase(PG8_LAS unsigned char* lds, const Gemm g, const Sched& S, const Epi& E) {
    int tid_ = threadIdx.x; asm volatile("" : "+v"(tid_));
    float zz_ = 0.f; asm volatile("" : "+v"(zz_));
    const int tid = tid_, wid = __builtin_amdgcn_readfirstlane(tid >> 6), lane = tid & 63, wr = wid >> 2, wc = wid & 3, fr = lane & 15, fq = lane >> 4;
    const int K = g.K, nt = K / BK;
    unsigned voffA[2], voffB[2];
#pragma unroll
    for (int i = 0; i < 2; ++i) { int R, C; stage_rc(tid * 16 + i * 8192, R, C); const int Rb = Epi::PERM ? ((R & ~31) + perm32(R & 31)) : R;
        voffA[i] = (unsigned)(R * K + C) * 2u; voffB[i] = (unsigned)(Rb * K + C) * 2u; }
    const size_t kstep = (size_t)(BK * 2);
    const size_t hstep = (size_t)HALF * K * 2;
    const size_t tstep = 2 * hstep;
    const unsigned ldsw = (unsigned)wid * 1024u;
    const int aoff = lds_byte(wr * 64 + fr, fq * 8), boff = lds_byte(wc * 32 + fr, fq * 8);
#define PG8_SA(b, h) (((b) * 2 + (h)) * HTB)
#define PG8_SB(b, h) ((4 + (b) * 2 + (h)) * HTB)
#define PG8_STAGE(bufoff, gbase, voff) do { _Pragma("unroll") for (int _i = 0; _i < 2; ++_i) \
        __builtin_amdgcn_global_load_lds((const unsigned*)((const char*)(gbase) + (voff)[_i]), (PG8_LAS unsigned*)(lds + (bufoff) + ldsw + _i * 8192), 16, 0, 0); } while (0)
#define PG8_LDA(dst, b, h) do { _Pragma("unroll") for (int m = 0; m < 4; ++m) _Pragma("unroll") for (int k = 0; k < 2; ++k) dst[m][k] = *(const PG8_LAS bf16x8*)(lds + PG8_SA(b, h) + aoff + m * 2048 + k * 1024); } while (0)
#define PG8_LDB(dst, b, h) do { _Pragma("unroll") for (int n = 0; n < 2; ++n) _Pragma("unroll") for (int k = 0; k < 2; ++k) dst[n][k] = *(const PG8_LAS bf16x8*)(lds + PG8_SB(b, h) + boff + n * 2048 + k * 1024); } while (0)
#define PG8_MMA(ai, bj, At, Bt) do { __builtin_amdgcn_s_setprio(1); _Pragma("unroll") for (int m = 0; m < 4; ++m) _Pragma("unroll") for (int n = 0; n < 2; ++n) _Pragma("unroll") for (int k = 0; k < 2; ++k) \
        acc[ai][bj][m][n] = __builtin_amdgcn_mfma_f32_16x16x32_bf16(Bt[n][k], At[m][k], acc[ai][bj][m][n], 0, 0, 0); __builtin_amdgcn_s_setprio(0); } while (0)
#define PG8_WAIT_V(n) asm volatile("s_waitcnt vmcnt(" #n ")" ::: "memory")
#define PG8_WAIT_L(n) asm volatile("s_waitcnt lgkmcnt(" #n ")" ::: "memory")
#define PG8_BAR __builtin_amdgcn_s_barrier()
#define PG8_SCHED __builtin_amdgcn_sched_barrier(0)
    Unit cur, nxt; int ui = 0;
    if (!S.next(0, cur)) return;
    f32x4 acc[2][2][4][2];
#pragma unroll
    for (int a = 0; a < 2; ++a)
#pragma unroll
        for (int b = 0; b < 2; ++b)
#pragma unroll
            for (int m = 0; m < 4; ++m)
#pragma unroll
                for (int n = 0; n < 2; ++n) acc[a][b][m][n] = (f32x4){zz_, zz_, zz_, zz_};
    bf16x8 At[4][2], B0[2][2], B1[2][2];
    const char* cA = (const char*)g.A + (size_t)cur.pm * tstep; const char* cB = (const char*)g.Bt + (size_t)cur.pn * tstep;
    S.a_ready(cur);
    if constexpr (SP2) {
        PG8_STAGE(PG8_SB(0, 0), cB, voffB); PG8_STAGE(PG8_SB(0, 1), cB + hstep, voffB); PG8_STAGE(PG8_SA(0, 0), cA, voffA); PG8_STAGE(PG8_SA(0, 1), cA + hstep, voffA);
        if (wr == 1) PG8_BAR;
        PG8_WAIT_V(2); PG8_BAR;
        PG8_STAGE(PG8_SB(1, 0), cB + kstep, voffB); PG8_STAGE(PG8_SA(1, 0), cA + kstep, voffA); PG8_STAGE(PG8_SB(1, 1), cB + hstep + kstep, voffB);
        PG8_WAIT_V(6); PG8_BAR;
    } else {
        PG8_STAGE(PG8_SB(0, 0), cB, voffB); PG8_STAGE(PG8_SA(0, 0), cA, voffA); PG8_STAGE(PG8_SB(0, 1), cB + hstep, voffB); PG8_STAGE(PG8_SA(0, 1), cA + hstep, voffA);
        if (wr == 1) PG8_BAR;
        PG8_WAIT_V(4); PG8_BAR;
        PG8_STAGE(PG8_SB(1, 0), cB + kstep, voffB); PG8_STAGE(PG8_SA(1, 0), cA + kstep, voffA); PG8_STAGE(PG8_SB(1, 1), cB + hstep + kstep, voffB);
        PG8_WAIT_V(6); PG8_BAR;
    }
    for (;;) {
        const bool has_next = S.next(ui + 1, nxt);
        const char* nA = has_next ? (const char*)g.A + (size_t)nxt.pm * tstep : cA; const char* nB = has_next ? (const char*)g.Bt + (size_t)nxt.pn * tstep : cB;
        for (int t = 0; t < nt; t += 2) {
            const bool last = (t == nt - 2);
            const char* a1 = cA + (size_t)(t + 1) * kstep;
            const char* a2 = last ? nA : cA + (size_t)(t + 2) * kstep; const char* b2 = last ? nB : cB + (size_t)(t + 2) * kstep;
            const char* a3 = a2 + kstep; const char* b3 = b2 + kstep;
            if (last && has_next) S.a_ready(nxt);
            if constexpr (SP2) {
            PG8_LDB(B0, 0, 0); PG8_LDB(B1, 0, 1); PG8_SCHED; PG8_LDA(At, 0, 0); PG8_STAGE(PG8_SA(1, 1), a1 + hstep, voffA);
            PG8_WAIT_V(8); PG8_WAIT_L(0); PG8_BAR; PG8_MMA(0, 0, At, B0); PG8_MMA(0, 1, At, B1); PG8_BAR; PG8_SCHED;
            PG8_LDA(At, 0, 1); PG8_STAGE(PG8_SB(0, 0), b2, voffB); PG8_STAGE(PG8_SB(0, 1), b2 + hstep, voffB); PG8_STAGE(PG8_SA(0, 0), a2, voffA);
            PG8_WAIT_V(8); PG8_WAIT_L(0); PG8_BAR; PG8_MMA(1, 0, At, B0); PG8_MMA(1, 1, At, B1); PG8_BAR; PG8_SCHED;
            PG8_LDB(B0, 1, 0); PG8_LDB(B1, 1, 1); PG8_SCHED; PG8_LDA(At, 1, 0); PG8_STAGE(PG8_SA(0, 1), a2 + hstep, voffA);
            PG8_WAIT_V(8); PG8_WAIT_L(0); PG8_BAR; PG8_MMA(0, 0, At, B0); PG8_MMA(0, 1, At, B1); PG8_BAR; PG8_SCHED;
            PG8_LDA(At, 1, 1); PG8_STAGE(PG8_SB(1, 0), b3, voffB); PG8_STAGE(PG8_SB(1, 1), b3 + hstep, voffB); PG8_STAGE(PG8_SA(1, 0), a3, voffA);
            PG8_WAIT_V(8); PG8_WAIT_L(0); PG8_BAR; PG8_MMA(1, 0, At, B0); PG8_MMA(1, 1, At, B1); PG8_BAR; PG8_SCHED;
            } else {
            PG8_LDB(B0, 0, 0); PG8_SCHED; PG8_LDA(At, 0, 0); PG8_STAGE(PG8_SA(1, 1), a1 + hstep, voffA);
            PG8_WAIT_L(8); PG8_BAR; PG8_WAIT_L(0); PG8_MMA(0, 0, At, B0); PG8_BAR; PG8_SCHED;
            PG8_LDB(B1, 0, 1); PG8_STAGE(PG8_SB(0, 0), b2, voffB);
            PG8_BAR; PG8_WAIT_L(0); PG8_MMA(0, 1, At, B1); PG8_BAR;
            PG8_LDA(At, 0, 1); PG8_STAGE(PG8_SA(0, 0), a2, voffA);
            PG8_BAR; PG8_WAIT_L(0); PG8_MMA(1, 0, At, B0); PG8_BAR; PG8_SCHED;
            PG8_STAGE(PG8_SB(0, 1), b2 + hstep, voffB);
            PG8_WAIT_V(6); PG8_BAR; PG8_MMA(1, 1, At, B1); PG8_BAR;
            PG8_LDB(B0, 1, 0); PG8_SCHED; PG8_LDA(At, 1, 0); PG8_STAGE(PG8_SA(0, 1), a2 + hstep, voffA);
            PG8_WAIT_L(8); PG8_BAR; PG8_WAIT_L(0); PG8_MMA(0, 0, At, B0); PG8_BAR; PG8_SCHED;
            PG8_LDB(B1, 1, 1); PG8_STAGE(PG8_SB(1, 0), b3, voffB);
            PG8_BAR; PG8_WAIT_L(0); PG8_MMA(0, 1, At, B1); PG8_BAR;
            PG8_LDA(At, 1, 1); PG8_STAGE(PG8_SA(1, 0), a3, voffA);
            PG8_BAR; PG8_WAIT_L(0); PG8_MMA(1, 0, At, B0); PG8_BAR; PG8_SCHED;
            PG8_STAGE(PG8_SB(1, 1), b3 + hstep, voffB);
            PG8_WAIT_V(6); PG8_BAR; PG8_MMA(1, 1, At, B1); PG8_BAR;
            }
        }
        if constexpr (ALIGN_EPI) { if (wr == 0) PG8_BAR; }
        if constexpr (!Epi::AFTER_DRAIN) { E(acc, cur, wr, wc, fr, fq); S.done(cur); }
        if (!has_next) break;
#pragma unroll
        for (int a = 0; a < 2; ++a)
#pragma unroll
            for (int b = 0; b < 2; ++b)
#pragma unroll
                for (int m = 0; m < 4; ++m)
#pragma unroll
                    for (int n = 0; n < 2; ++n) acc[a][b][m][n] = (f32x4){zz_, zz_, zz_, zz_};
        cur = nxt; cA = nA; cB = nB; ++ui;
        if constexpr (ALIGN_EPI) { if (wr == 1) PG8_BAR; }
    }
    PG8_WAIT_V(0);
    if constexpr (!ALIGN_EPI) { if (wr == 0) PG8_BAR; }
    PG8_BAR;
    if constexpr (Epi::AFTER_DRAIN) { E.fused(acc, cur, wr, wc, fr, fq, lds, wid, lane); S.done(cur); }
#undef PG8_SA
#undef PG8_SB
#undef PG8_STAGE
#undef PG8_LDA
#undef PG8_LDB
#undef PG8_MMA
#undef PG8_WAIT_V
#undef PG8_WAIT_L
#undef PG8_BAR
#undef PG8_SCHED
}
}
#ifndef PG8_SP2
#define PG8_SP2 true
#endif
#ifndef PG8_ALIGN
#define PG8_ALIGN true
#endif
constexpr int NWAVES = 8, NTHREADS = NWAVES * 64;
constexpr int BATCH = 8, T = 4096, D = 1024, M = BATCH * T;
constexpr int NIN_E = 3840, NIN_O = 3072, FF = 2816, NGU = 2 * FF;
constexpr int PC_R = 0, PC_K = 512, PC_V = 1024, PC_GQ = 1536, PC_GK = 1792, PC_GV = 2048, PC_GG = 2560;
constexpr int PC_W1A = 3072, PC_W1B = 3136, PC_A1A = 3200, PC_A1B = 3264, PC_G1A = 3328, PC_G1B = 3488, PC_WA1 = 3648, PC_PAD = 3664;
constexpr int NLORA = 304;
constexpr size_t MiB = 1u << 20;
constexpr size_t WS_CTL = 0, CTL_ZERO_BYTES = 1 * MiB;
constexpr size_t WS_WIN = 2 * MiB, WS_WOUT = 10 * MiB, WS_WGU = 12 * MiB, WS_WDN = 23 * MiB;
constexpr size_t WS_W2T = 29 * MiB, WS_A2T = WS_W2T + 65536, WS_G2T = WS_A2T + 65536, WS_WA2T = WS_G2T + 196608;
constexpr size_t WS_SSQ = 496 * MiB;
constexpr size_t WS_XFIN = 336 * MiB;
constexpr size_t WS_XN = 32 * MiB;
constexpr size_t WS_P = 96 * MiB;
constexpr size_t WS_END = 500 * MiB;
constexpr int CW_BAR = 4096;
constexpr int RING_BYTES = 135168, LDS_BYTES = 163840, LDSCTL_OFF = LDS_BYTES - 1024, MISC_OFF = LDSCTL_OFF + 320, RSTAB_OFF = RING_BYTES + 448;

#define GAS __attribute__((address_space(1)))
#define LAS __attribute__((address_space(3)))
typedef unsigned short bf16;
typedef unsigned v4u __attribute__((ext_vector_type(4)));
typedef unsigned v2u __attribute__((ext_vector_type(2)));
typedef float f32x4 __attribute__((ext_vector_type(4)));
#define LDS_WAIT() asm volatile("s_waitcnt lgkmcnt(0)" ::: "memory")
#define VM_WAIT() asm volatile("s_waitcnt vmcnt(0)" ::: "memory")
#define LDS_BARRIER() do { asm volatile("s_waitcnt lgkmcnt(0)\n\ts_barrier" ::: "memory"); } while (0)
__device__ __forceinline__ unsigned f2bf(float f) { unsigned u = __builtin_bit_cast(unsigned, f); return (u + 0x7fffu + ((u >> 16) & 1u)) >> 16; }
__device__ __forceinline__ unsigned pk2(float lo, float hi) { return f2bf(lo) | (f2bf(hi) << 16); }
__device__ __forceinline__ float bf2f(bf16 u) { return __builtin_bit_cast(float, (unsigned)u << 16); }
__device__ __forceinline__ float bflo(unsigned w) { return __builtin_bit_cast(float, w << 16); }
__device__ __forceinline__ float bfhi(unsigned w) { return __builtin_bit_cast(float, w & 0xffff0000u); }
__device__ __forceinline__ float wave_sum(float v) {
#define WS_DPP(x, ctrl, rmask) __builtin_bit_cast(float, __builtin_amdgcn_update_dpp(0, __builtin_bit_cast(int, x), ctrl, rmask, 0xf, true))
    v += WS_DPP(v, 0x111, 0xf);
    v += WS_DPP(v, 0x112, 0xf);
    v += WS_DPP(v, 0x114, 0xf);
    v += WS_DPP(v, 0x118, 0xf);
    v += WS_DPP(v, 0x142, 0xa);
    v += WS_DPP(v, 0x143, 0xc);
#undef WS_DPP
    return __builtin_bit_cast(float, __builtin_amdgcn_readlane(__builtin_bit_cast(int, v), 63));
}
__device__ __forceinline__ float wave_max(float v) {
#pragma unroll
    for (int o = 1; o < 64; o <<= 1) v = fmaxf(v, __shfl_xor(v, o));
    return v;
}
__device__ __forceinline__ float fexp(float x) { return __builtin_amdgcn_exp2f(x * 1.4426950408889634f); }
__device__ __forceinline__ float flog(float x) { return __builtin_amdgcn_logf(x) * 0.6931471805599453f; }
__device__ __forceinline__ float frcp(float x) { return __builtin_amdgcn_rcpf(x); }
__device__ __forceinline__ float frsq(float x) { return __builtin_amdgcn_rsqf(x); }
__device__ __forceinline__ float fsqrt(float x) { return __builtin_amdgcn_sqrtf(x); }
__device__ __forceinline__ float sigmoid_f(float x) { return frcp(1.0f + fexp(-x)); }
__device__ __forceinline__ float softplus_f(float x) { return fmaxf(x, 0.f) + flog(1.0f + fexp(-fabsf(x))); }
__device__ __forceinline__ float tanh_f(float x) { return 1.0f - 2.0f * frcp(1.0f + fexp(2.0f * x)); }
#define XB_TMO      128
#define XB_XCNT(j)  (256  + 64 * (j))
#define XB_XSUB(j)  (1280 + 64 * (j))
#define XB_XGEN(j)  (2304 + 64 * (j))
#define XB_TOP      3328
#define XB_TOPGEN   3392
#define XCD_BAR_WORDS 3456
#define XB_SPIN_CAP (1u << 23)

__device__ __forceinline__ unsigned xb_ld(unsigned* p)              { return __hip_atomic_load(p, __ATOMIC_RELAXED, __HIP_MEMORY_SCOPE_AGENT); }
__device__ __forceinline__ unsigned xb_add(unsigned* p, unsigned v) { return __hip_atomic_fetch_add(p, v, __ATOMIC_RELAXED, __HIP_MEMORY_SCOPE_AGENT); }
__device__ __forceinline__ unsigned xb_xcc_id() { return (unsigned)__builtin_amdgcn_s_getreg((3 << 11) | 20) & 0xFu; }
#define XB_SPIN(cond, bar) do { unsigned _sp = 0; while (cond) { __builtin_amdgcn_s_sleep(1); \
    if ((++_sp & 255u) == 0u) { if (xb_ld(&(bar)[XB_TMO])) break; if (_sp > XB_SPIN_CAP) { atomicAdd(&(bar)[XB_TMO], 1u); break; } } } } while (0)

struct XcdBarrier {
    unsigned* bar; unsigned x;
    volatile LAS unsigned* st;
};

__device__ __forceinline__ XcdBarrier xcd_barrier_post(unsigned* bar, volatile LAS unsigned* st) {
    XcdBarrier b; b.bar = bar; b.x = xb_xcc_id(); b.st = st;
    if (threadIdx.x == 0) (void)xb_add(&bar[XB_XCNT(b.x)], 1u);
    return b;
}
__device__ __forceinline__ void xcd_barrier_complete(unsigned* bar, unsigned x, unsigned& nloc, unsigned& nx) {
    const unsigned G = gridDim.x * gridDim.y * gridDim.z;
    unsigned sum, cnt, mine, sp = 0u;
    for (;;) {
        sum = 0u; cnt = 0u; mine = 0u;
#pragma unroll
        for (unsigned j = 0; j < 16; ++j) { const unsigned c = xb_ld(&bar[XB_XCNT(j)]); sum += c; cnt += (c > 0u) ? 1u : 0u; mine = (j == x) ? c : mine; }
        if (sum == G) break;
        __builtin_amdgcn_s_sleep(1);
        if ((++sp & 255u) == 0u) { if (xb_ld(&bar[XB_TMO])) break; if (sp > XB_SPIN_CAP) { atomicAdd(&bar[XB_TMO], 1u); break; } }
    }
    nloc = mine > 0u ? mine : 1u; nx = cnt > 0u ? cnt : 1u;
}

__device__ __forceinline__ void xcd_barrier(const XcdBarrier& b) {
    asm volatile("s_waitcnt vmcnt(0)" ::: "memory");
    __syncthreads();
    if (threadIdx.x == 0) {
        unsigned blo_ = __builtin_amdgcn_readfirstlane((unsigned)(unsigned long long)b.bar), bhi_ = __builtin_amdgcn_readfirstlane((unsigned)((unsigned long long)b.bar >> 32)), bx = __builtin_amdgcn_readfirstlane(b.x); asm volatile("" : "+s"(blo_), "+s"(bhi_), "+s"(bx)); unsigned* bar = (unsigned*)(((unsigned long long)bhi_ << 32) | blo_);
        __builtin_amdgcn_s_waitcnt(0);
        unsigned nloc = b.st[0], nx = b.st[1];
        if (nloc == 0u) { xcd_barrier_complete(bar, bx, nloc, nx); b.st[0] = nloc; b.st[1] = nx; }
        const unsigned old = xb_add(&bar[XB_XSUB(bx)], 1u);
        const unsigned gen = old / nloc;
        if (old + 1u == (gen + 1u) * nloc) {
            __builtin_amdgcn_fence(__ATOMIC_RELEASE, "agent");
            asm volatile("s_waitcnt vmcnt(0)" ::: "memory");
            const unsigned og = xb_add(&bar[XB_TOP], 1u);
            const unsigned tg = og / nx;
            if (og + 1u == (tg + 1u) * nx) xb_add(&bar[XB_TOPGEN], 1u);
            else XB_SPIN(xb_ld(&bar[XB_TOPGEN]) == tg, bar);
            __builtin_amdgcn_fence(__ATOMIC_ACQUIRE, "agent");
            xb_add(&bar[XB_XGEN(bx)], 1u);
            asm volatile("s_waitcnt vmcnt(0)" ::: "memory");
        } else {
            XB_SPIN(xb_ld(&bar[XB_XGEN(bx)]) == gen, bar);
            __builtin_amdgcn_fence(__ATOMIC_ACQUIRE, "agent");
            asm volatile("s_waitcnt vmcnt(0)" ::: "memory");
        }
    }
    __syncthreads();
}
__device__ __forceinline__ void tr_item(const float* __restrict__ W, int Kreal, int N, bf16* WT, int ldd, int dst_row0, LAS float* scr, int k0, int n0, int lane,
                                        const float* __restrict__ mu, float sc0, float sc1, const float* __restrict__ gk = nullptr) {
    const int rr = lane >> 3, c4 = lane & 7, nn = n0 + 4 * c4; const bool nv = nn < N;
#pragma unroll
    for (int i = 0; i < 8; ++i) { const int kk = 8 * i + rr; f32x4 v = (nv && k0 + kk < Kreal) ? *(const GAS f32x4*)(W + (size_t)(k0 + kk) * N + nn) : (f32x4){0.f, 0.f, 0.f, 0.f};
        float sc = 1.0f; if (mu) sc = sc0 + sc1 * mu[k0 + kk]; if (gk) sc *= gk[k0 + kk]; v = v * sc;
        LAS float* d = scr + kk * 33 + 4 * c4; d[0] = v.x; d[1] = v.y; d[2] = v.z; d[3] = v.w; }
    LDS_WAIT(); asm volatile("" ::: "memory");
    const int c = lane & 7;
#pragma unroll
    for (int j = 0; j < 4; ++j) { const int n = (lane >> 3) + 8 * j; const LAS float* s = scr + (8 * c) * 33 + n;
        v4u o; o.x = pk2(s[0 * 33], s[1 * 33]); o.y = pk2(s[2 * 33], s[3 * 33]); o.z = pk2(s[4 * 33], s[5 * 33]); o.w = pk2(s[6 * 33], s[7 * 33]);
        if (n0 + n < N) *(GAS v4u*)(WT + (size_t)(dst_row0 + n) * ldd + k0 + 8 * c) = o; }
    LDS_WAIT(); asm volatile("" ::: "memory");
}
__device__ __forceinline__ void rms_row_bf16_to_f32(const bf16* xrow, const float* g, float* orow, int lane, float oscale = 1.0f) {
    const GAS v4u* xr = (const GAS v4u*)xrow + 2 * lane; const v4u a = xr[0], b = xr[1]; float v[16]; float s = 0.f;
    v[0] = bflo(a.x); v[1] = bfhi(a.x); v[2] = bflo(a.y); v[3] = bfhi(a.y); v[4] = bflo(a.z); v[5] = bfhi(a.z); v[6] = bflo(a.w); v[7] = bfhi(a.w);
    v[8] = bflo(b.x); v[9] = bfhi(b.x); v[10] = bflo(b.y); v[11] = bfhi(b.y); v[12] = bflo(b.z); v[13] = bfhi(b.z); v[14] = bflo(b.w); v[15] = bfhi(b.w);
#pragma unroll
    for (int e = 0; e < 16; ++e) s += v[e] * v[e];
    const float rs = frsq(wave_sum(s) * (1.f / D) + 1e-6f) * oscale;
    const GAS f32x4* gr = (const GAS f32x4*)g + 4 * lane; GAS f32x4* o = (GAS f32x4*)orow + 4 * lane;
#pragma unroll
    for (int q = 0; q < 4; ++q) { const f32x4 gv = gr[q]; o[q] = (f32x4){v[4 * q] * rs * gv.x, v[4 * q + 1] * rs * gv.y, v[4 * q + 2] * rs * gv.z, v[4 * q + 3] * rs * gv.w}; }
}
struct Args { const float* in[36]; float* out; unsigned char* ws; int lo, hi; };
typedef const __attribute__((address_space(4))) Args* ArgP;
#define FRESH_ARGS() ({ ArgP p_ = (ArgP)__builtin_amdgcn_kernarg_segment_ptr(); asm volatile("" : "+s"(p_)); p_; })
#define FRESH_V(x) asm volatile("" : "+v"(x))
#define FRESH_S(x) asm volatile("" : "+s"(x))

#define TR_JOB(items, nblk, Wp, Kd, Nd, DST, LDD, ROW0, MU, S0, S1, GK) if (r < (items)) { const int kb = r / (nblk), nb = r % (nblk), n0 = 32 * nb; tr_item(Wp, Kd, Nd, DST, LDD, ROW0, scr, 64 * kb, n0, lane, MU, S0, S1, GK); continue; } r -= (items);
__device__ __forceinline__ void convert_mixer_weights(ArgP A, int L, LAS unsigned char* lds, int wave, int lane, int gw, int NGW) {
    const int i = L >> 1; const bool even = !(L & 1);
    bf16* Win = (bf16*)(A->ws + WS_WIN); bf16* Wout = (bf16*)(A->ws + WS_WOUT);
    LAS float* scr = (LAS float*)(lds + wave * 16384);
    const float* gmix = A->in[2] + (size_t)L * D;
    const float* w_in = even ? A->in[5] + (size_t)i * D * 3072 : A->in[26] + (size_t)i * D * 3072;
    const float* w_out = even ? A->in[6] + (size_t)i * D * D : A->in[27] + (size_t)i * D * D;
    const float* mu_w = A->in[8] + (size_t)i * 3 * D, *mu_a = mu_w + D, *mu_g = mu_w + 2 * D;
    const float* w1 = A->in[10] + (size_t)i * D * 64, *a1 = A->in[13] + (size_t)i * D * 64, *g1 = A->in[15] + (size_t)i * D * 160, *wa1 = A->in[22] + (size_t)i * D * 16;
    const float* w2s = A->in[11] + (size_t)i * 64 * 512, *a2s = A->in[14] + (size_t)i * 64 * 512, *g2s = A->in[16] + (size_t)i * 160 * 512;
    bf16* W2T = (bf16*)(A->ws + WS_W2T); bf16* A2T = (bf16*)(A->ws + WS_A2T); bf16* G2T = (bf16*)(A->ws + WS_G2T);
    const int I_IN = 16 * 96, I_L64 = 16 * 2, I_L160 = 16 * 5, I_L16 = 16 * 1, I_OUT = 16 * 32;
    const int n_lora = even ? (4 * I_L64 + 2 * I_L160 + I_L16 + 16 + 16 + 48) : 0;
    const int NITEMS = I_IN + n_lora + I_OUT;
    for (int it = gw; it < NITEMS; it += NGW) {
        int r = it;
        TR_JOB(I_IN, 96, w_in, D, 3072, Win, D, n0, nullptr, 1.f, 0.f, gmix)
        if (even) {
            TR_JOB(I_L64, 2, w1, D, 64, Win, D, PC_W1A + n0, mu_w, 1.f, -1.f, gmix)
            TR_JOB(I_L64, 2, w1, D, 64, Win, D, PC_W1B + n0, mu_w, 0.f, 1.f, gmix)
            TR_JOB(I_L64, 2, a1, D, 64, Win, D, PC_A1A + n0, mu_a, 1.f, -1.f, gmix)
            TR_JOB(I_L64, 2, a1, D, 64, Win, D, PC_A1B + n0, mu_a, 0.f, 1.f, gmix)
            TR_JOB(I_L160, 5, g1, D, 160, Win, D, PC_G1A + n0, mu_g, 1.f, -1.f, gmix)
            TR_JOB(I_L160, 5, g1, D, 160, Win, D, PC_G1B + n0, mu_g, 0.f, 1.f, gmix)
            TR_JOB(I_L16, 1, wa1, D, 16, Win, D, PC_WA1 + n0, nullptr, 1.f, 0.f, gmix)
            TR_JOB(16, 16, w2s, 64, 512, W2T, 64, n0, nullptr, 1.f, 0.f, nullptr)
            TR_JOB(16, 16, a2s, 64, 512, A2T, 64, n0, nullptr, 1.f, 0.f, nullptr)
            TR_JOB(48, 16, g2s, 160, 512, G2T, 192, n0, nullptr, 1.f, 0.f, nullptr)
        }
        TR_JOB(I_OUT, 32, w_out, D, D, Wout, D, n0, nullptr, 1.f, 0.f, nullptr)
    }
    if (even) {
        const int gt = gw * 64 + lane, NT = NGW * 64;
        { unsigned z_ = 0u; asm volatile("" : "+v"(z_));
        for (int e = gt; e < (NIN_E - PC_PAD) * D / 8; e += NT) ((GAS v4u*)(Win + (size_t)PC_PAD * D))[e] = (v4u){z_, z_, z_, z_}; }
        bf16* WA2T = (bf16*)(A->ws + WS_WA2T); const float* wa2 = A->in[23] + (size_t)i * 16 * 256;
        for (int e = gt; e < 256 * 32; e += NT) { const int nn = e >> 5, k = e & 31; WA2T[e] = k < 16 ? (bf16)f2bf(wa2[k * 256 + nn]) : (bf16)0; }
    }
}
__device__ __forceinline__ void convert_ffn_weights(ArgP A, int L, LAS unsigned char* lds, int wave, int lane, int gw, int NGW) {
    bf16* Wgu = (bf16*)(A->ws + WS_WGU); bf16* Wdn = (bf16*)(A->ws + WS_WDN);
    LAS float* scr = (LAS float*)(lds + wave * 16384);
    const float* gffn = A->in[3] + (size_t)L * D;
    const float* wg = A->in[33] + (size_t)L * D * FF, *wu = A->in[34] + (size_t)L * D * FF, *wd = A->in[35] + (size_t)L * FF * D;
    const int I_GU = 16 * 88, I_DN = 44 * 32;
    for (int it = gw; it < 2 * I_GU + I_DN; it += NGW) {
        int r = it;
        TR_JOB(I_GU, 88, wg, D, FF, Wgu, D, 256 * (n0 >> 7) + (n0 & 127), nullptr, 1.f, 0.f, gffn)
        TR_JOB(I_GU, 88, wu, D, FF, Wgu, D, 256 * (n0 >> 7) + (n0 & 127) + 128, nullptr, 1.f, 0.f, gffn)
        TR_JOB(I_DN, 32, wd, FF, D, Wdn, FF, n0, nullptr, 1.f, 0.f, nullptr)
    }
}
#undef TR_JOB
__device__ __forceinline__ void x_to_bf16_ssq(const float* xrow, bf16* orow, float* ssq_row, int lane) {
    const GAS f32x4* xr = (const GAS f32x4*)xrow + lane; f32x4 v[4]; float s = 0.f;
#pragma unroll
    for (int j = 0; j < 4; ++j) { v[j] = xr[64 * j]; s += (v[j].x * v[j].x + v[j].y * v[j].y) + (v[j].z * v[j].z + v[j].w * v[j].w); }
    s = wave_sum(s); if (lane < 16) ssq_row[lane] = lane == 0 ? s : 0.f;
    GAS v2u* o8 = (GAS v2u*)orow + lane;
#pragma unroll
    for (int j = 0; j < 4; ++j) { v2u o; o.x = pk2(v[j].x, v[j].y); o.y = pk2(v[j].z, v[j].w); o8[64 * j] = o; }
}

__device__ __forceinline__ int t5_bucket(int d) {
    if (d < 16) return d;
    const float r = (float)d / 16.0f; int l = 16 + (int)(flog(r) / 2.0794415416798357f * 16.0f);
    return l < 31 ? l : 31;
}
typedef short a_bf16x8 __attribute__((ext_vector_type(8)));
typedef float f32x16 __attribute__((ext_vector_type(16)));
typedef short a_s16x4 __attribute__((ext_vector_type(4)));
constexpr int AT_K1 = 0, AT_K2 = 8192, AT_V = 16384, AT_ST = 32768, AT_NST = 4, AT_BIAS = AT_NST * AT_ST, AT_COMB = 0;
static_assert(AT_BIAS + 132 * 4 <= LDSCTL_OFF && 4 * 64 * 64 * 4 <= AT_BIAS, "attention LDS map");
__device__ __forceinline__ int crow16(int r, int hi) { return (r & 3) + 8 * (r >> 2) + 4 * hi; }
typedef float f32x2_t __attribute__((ext_vector_type(2))); typedef __bf16 bf16x2_t __attribute__((ext_vector_type(2)));
__device__ __forceinline__ unsigned cvtpk(float lo, float hi) { const f32x2_t v = {lo, hi}; const bf16x2_t b = __builtin_convertvector(v, bf16x2_t); return __builtin_bit_cast(unsigned, b); }

template <bool HALFSYNC = false> __device__ __forceinline__ void attn_unit_mfma(ArgP A, int L, int b, int h, int qb, float lam, float lam_init, LAS unsigned char* lds, int tid) {
    const int lane = tid & 63, wave = __builtin_amdgcn_readfirstlane(tid >> 6), r32 = lane & 31, hi = lane >> 5;
    const int smap = wave >> 2, qs = wave & 3;
    const int i = L >> 1;
    const bf16* QKV = (const bf16*)(A->ws + WS_P); bf16* O = (bf16*)(A->ws + WS_XN);
    const int q0 = qb * 128, qw0 = q0 + 32 * qs, nt = (q0 + 128) / 64;
    const size_t rowb = (size_t)b * T;
    if (tid < 129) { const float far = A->in[1][31 * 8 + h]; ((LAS float*)(lds + AT_BIAS))[tid] = tid < 128 ? (A->in[1][t5_bucket(tid) * 8 + h] - far) * 1.4426950408889634f : 0.f; }
    a_bf16x8 qf[4];
    { const bf16* qrow = QKV + (rowb + qw0 + r32) * NIN_O + h * 128 + smap * 64 + 8 * hi;
#pragma unroll
      for (int ks = 0; ks < 4; ++ks) qf[ks] = *(const GAS a_bf16x8*)(qrow + 16 * ks); }
    const int kr = 8 * wave + (lane >> 3), kcs = (lane & 7) ^ ((kr >> 1) & 7);
    const bf16* kg = QKV + (rowb + kr) * NIN_O + 1024 + h * 128 + 8 * kcs;
    const int vr0 = 8 * wave + (lane >> 4), vr1 = vr0 + 4;
    const bf16* vg0 = QKV + (rowb + vr0) * NIN_O + 2048 + h * 128 + 8 * ((lane & 15) ^ (((vr0 & 3) << 2) | ((vr0 >> 2) & 3)));
    const bf16* vg1 = QKV + (rowb + vr1) * NIN_O + 2048 + h * 128 + 8 * ((lane & 15) ^ (((vr1 & 3) << 2) | ((vr1 >> 2) & 3)));
#define AT_DMA(kt, stoff) do { const size_t go_ = (size_t)(kt) * 64 * NIN_O; LAS unsigned char* sb_ = lds + (stoff) + wave * 1024; \
        __builtin_amdgcn_global_load_lds((const unsigned*)(kg + go_), (LAS unsigned*)(sb_ + AT_K1), 16, 0, 0); __builtin_amdgcn_global_load_lds((const unsigned*)(kg + go_ + 64), (LAS unsigned*)(sb_ + AT_K2), 16, 0, 0); \
        __builtin_amdgcn_global_load_lds((const unsigned*)(vg0 + go_), (LAS unsigned*)(sb_ + AT_V + wave * 1024), 16, 0, 0); __builtin_amdgcn_global_load_lds((const unsigned*)(vg1 + go_), (LAS unsigned*)(sb_ + AT_V + wave * 1024 + 1024), 16, 0, 0); } while (0)
    AT_DMA(0, 0); AT_DMA(1, AT_ST);
    __syncthreads();
    f32x16 o[4];
#pragma unroll
    for (int d = 0; d < 4; ++d)
#pragma unroll
        for (int r = 0; r < 16; ++r) o[d][r] = 0.f;
    float m = -1e30f, l = 0.f;
    const int kfo = (smap ? AT_K2 : AT_K1) + r32 * 128, khg = hi ^ ((r32 >> 1) & 7);
    int vfo[2][4];
    { const int q = (lane & 15) >> 2, pp = lane & 3, blk = (lane >> 4) & 1;
#pragma unroll
      for (int t = 0; t < 2; ++t)
#pragma unroll
          for (int d = 0; d < 4; ++d) vfo[t][d] = AT_V + 256 * (4 * hi + q + 8 * t) + 16 * (((d ^ q) << 2) | ((2 * blk + (pp >> 1)) ^ ((hi + 2 * t) & 3))) + 8 * (pp & 1); }
    const LAS float* bdl = (const LAS float*)(lds + AT_BIAS);
    const int qme = qw0 + r32;
#define AT_VREAD(VF, kk) do { _Pragma("unroll") for (int d = 0; d < 4; ++d) { \
                VF[2 * d] = __builtin_bit_cast(a_s16x4, __builtin_amdgcn_ds_read_tr16_b64_v4i16((LAS a_s16x4*)(sbv + vfo[0][d] + (kk) * 4096))); VF[2 * d + 1] = __builtin_bit_cast(a_s16x4, __builtin_amdgcn_ds_read_tr16_b64_v4i16((LAS a_s16x4*)(sbv + vfo[1][d] + (kk) * 4096))); } } while (0)
#define AT_PV(VF, PF, kk) do { _Pragma("unroll") for (int d = 0; d < 4; ++d) { const a_bf16x8 vf_ = (a_bf16x8){VF[2 * d][0], VF[2 * d][1], VF[2 * d][2], VF[2 * d][3], VF[2 * d + 1][0], VF[2 * d + 1][1], VF[2 * d + 1][2], VF[2 * d + 1][3]}; \
                o[d] = __builtin_amdgcn_mfma_f32_32x32x16_bf16(vf_, PF[kk], o[d], 0, 0, 0); } } while (0)
    int pbase = 0;
#pragma unroll 1
    for (int kt0 = 0; kt0 < nt; kt0 += 2) {
        const int nbase = pbase ? 0 : 2 * AT_ST;
#pragma unroll 1
      for (int sub = 0; sub < 2; ++sub) { const int kt = kt0 + sub; const int stoff = pbase + sub * AT_ST;
        if (kt + 2 < nt) AT_DMA(kt + 2, nbase + sub * AT_ST);
        const int key0 = 64 * kt;
        if (key0 <= qw0 + 31) {
            const LAS unsigned char* sb = lds + stoff; const LAS unsigned char* sbv = sb;
            f32x16 p[2]; a_bf16x8 kf[8];
#pragma unroll
            for (int f = 0; f < 8; ++f) kf[f] = *(const LAS a_bf16x8*)(sb + kfo + (f >> 2) * 4096 + ((khg ^ (2 * (f & 3))) * 16));
            __builtin_amdgcn_sched_barrier(0);
            __builtin_amdgcn_s_setprio(1);
#pragma unroll
            for (int blk = 0; blk < 2; ++blk) {
#pragma unroll
                for (int r = 0; r < 16; ++r) p[blk][r] = 0.f;
#pragma unroll
                for (int ks = 0; ks < 4; ++ks) p[blk] = __builtin_amdgcn_mfma_f32_32x32x16_bf16(kf[blk * 4 + ks], qf[ks], p[blk], 0, 0, 0);
            }
            __builtin_amdgcn_s_setprio(0);
            if (key0 + 63 + 128 > qw0) {
#pragma unroll
                for (int blk = 0; blk < 2; ++blk) { float bvv[16];
#pragma unroll
                    for (int r = 0; r < 16; ++r) { const unsigned ud = (unsigned)(qme - (key0 + 32 * blk + crow16(r, hi))); bvv[r] = bdl[ud < 128u ? ud : 128u]; }
                    asm volatile("" : "+v"(bvv[0]), "+v"(bvv[1]), "+v"(bvv[2]), "+v"(bvv[3]), "+v"(bvv[4]), "+v"(bvv[5]), "+v"(bvv[6]), "+v"(bvv[7]), "+v"(bvv[8]), "+v"(bvv[9]), "+v"(bvv[10]), "+v"(bvv[11]), "+v"(bvv[12]), "+v"(bvv[13]), "+v"(bvv[14]), "+v"(bvv[15]));
#pragma unroll
                    for (int r = 0; r < 16; ++r) { const int dist = qme - (key0 + 32 * blk + crow16(r, hi)); p[blk][r] = dist < 0 ? -1e30f : p[blk][r] + bvv[r]; } }
            }
            float mx = p[0][0];
#pragma unroll
            for (int r = 1; r < 16; ++r) mx = fmaxf(mx, p[0][r]);
#pragma unroll
            for (int r = 0; r < 16; ++r) mx = fmaxf(mx, p[1][r]);
            { const auto sw_ = __builtin_amdgcn_permlane32_swap(__builtin_bit_cast(unsigned, mx), __builtin_bit_cast(unsigned, mx), false, false);
              mx = fmaxf(__builtin_bit_cast(float, sw_[0]), __builtin_bit_cast(float, sw_[1])); }
            if (__any(mx > m + 8.0f)) {
                const float mn = fmaxf(m, mx), al = __builtin_amdgcn_exp2f(m - mn); m = mn; l *= al;
#pragma unroll
                for (int d = 0; d < 4; ++d)
#pragma unroll
                    for (int r = 0; r < 16; ++r) o[d][r] *= al;
            }
            float ls = 0.f;
#define AT_EXPPK(PF, kk) do { const int blk_ = (kk) >> 1, s8_ = 8 * ((kk) & 1); float e_[8]; _Pragma("unroll") for (int j = 0; j < 8; ++j) { e_[j] = __builtin_amdgcn_exp2f(p[blk_][s8_ + j] - m); ls += e_[j]; } \
                v4u w_; w_.x = cvtpk(e_[0], e_[1]); w_.y = cvtpk(e_[2], e_[3]); w_.z = cvtpk(e_[4], e_[5]); w_.w = cvtpk(e_[6], e_[7]); PF[kk] = __builtin_bit_cast(a_bf16x8, w_); } while (0)
            {
                a_bf16x8 pf[4]; a_s16x4 vA[8], vB[8];
                AT_VREAD(vA, 0); AT_EXPPK(pf, 0);
                __builtin_amdgcn_sched_barrier(0);
                AT_VREAD(vB, 1); AT_PV(vA, pf, 0); AT_EXPPK(pf, 1);
                __builtin_amdgcn_sched_barrier(0);
                AT_VREAD(vA, 2); AT_PV(vB, pf, 1); AT_EXPPK(pf, 2);
                __builtin_amdgcn_sched_barrier(0);
                AT_VREAD(vB, 3); AT_PV(vA, pf, 2); AT_EXPPK(pf, 3);
                __builtin_amdgcn_sched_barrier(0);
                AT_PV(vB, pf, 3);
            }
            l += ls;
#undef AT_EXPPK
        }
      }
        __syncthreads();
        pbase = nbase;
    }
#undef AT_VREAD
#undef AT_PV
#undef AT_DMA
    l += __shfl_xor(l, 32);
    LAS float* comb = (LAS float*)(lds + AT_COMB) + qs * 4096;
    if (smap == 1) { const float sc = lam * frcp(l);
#pragma unroll
        for (int d = 0; d < 4; ++d)
#pragma unroll
            for (int r = 0; r < 16; ++r) comb[(d * 16 + r) * 64 + lane] = o[d][r] * sc; }
    __syncthreads();
    if (smap == 0) {
        const float il = frcp(l); float ss = 0.f;
#pragma unroll
        for (int d = 0; d < 4; ++d)
#pragma unroll
            for (int r = 0; r < 16; ++r) { const float v = o[d][r] * il - comb[(d * 16 + r) * 64 + lane]; o[d][r] = v; ss += v * v; }
        ss += __shfl_xor(ss, 32);
        const float rs = frsq(ss * (1.f / 128.f) + 1e-5f) * (1.0f - lam_init);
        const float* sl = A->in[32] + i * 128;
        bf16* orow = O + (rowb + qw0 + r32) * D + h * 128;
#pragma unroll
        for (int d = 0; d < 4; ++d)
#pragma unroll
            for (int g4 = 0; g4 < 4; ++g4) { const int dc = 32 * d + 8 * g4 + 4 * hi; const f32x4 s4 = *(const GAS f32x4*)(sl + dc);
                v2u w; w.x = cvtpk(o[d][4 * g4] * rs * s4.x, o[d][4 * g4 + 1] * rs * s4.y); w.y = cvtpk(o[d][4 * g4 + 2] * rs * s4.z, o[d][4 * g4 + 3] * rs * s4.w);
                *(GAS v2u*)(orow + dc) = w; }
    }
    __syncthreads();
}

template <bool HALFSYNC = false> __device__ __forceinline__ void attn_phase_mfma(ArgP A, int L, LAS unsigned char* lds, int tid, int G, int bid) {
    const int lane = tid & 63, i = L >> 1;
    const float lam_init = 0.8f - 0.6f * fexp(-0.3f * (float)L);
    const float lam = fexp(wave_sum(A->in[28][i * 64 + lane] * A->in[29][i * 64 + lane])) - fexp(wave_sum(A->in[30][i * 64 + lane] * A->in[31][i * 64 + lane])) + lam_init;
    if (G == 256) {
        const int v = (bid & 7) * 32 + (bid >> 3), bh = v >> 2, j = v & 3;
#pragma unroll 1
        for (int u = 0; u < 8; ++u) { const int qb = 8 * (u >> 1) + ((u & 1) ? 7 - j : j); attn_unit_mfma<HALFSYNC>(A, L, bh >> 3, bh & 7, qb, lam, lam_init, lds, tid); }
    } else {
#pragma unroll 1
        for (int u = bid; u < 64 * 32; u += G) attn_unit_mfma<HALFSYNC>(A, L, (u >> 5) >> 3, (u >> 5) & 7, 31 - (u & 31), lam, lam_init, lds, tid);
    }
}
typedef short bf16x8_t __attribute__((ext_vector_type(8)));
constexpr int MS = 72, MB = 64 * MS * 2;
constexpr int RW_XW = 8 * MB, RW_XA = RW_XW + 16384;
constexpr int RW_TOT = 14 * MB, RW_GAM = RW_TOT + 2048, RW_END = RW_GAM + 256;
static_assert(RW_XA + 16384 <= 12 * MB && RW_END <= RING_BYTES, "RWKV LDS map");
constexpr size_t WS_RWI = 336 * MiB;
constexpr size_t WS_BON = 30 * MiB;
#define RBUF(k) ((LAS bf16*)(lds + (k) * MB))
__device__ __forceinline__ f32x4 mfma16(bf16x8_t a, bf16x8_t b, f32x4 c) { return __builtin_amdgcn_mfma_f32_16x16x32_bf16(a, b, c, 0, 0, 0); }
__device__ __forceinline__ bf16x8_t ldfrag(const LAS bf16* Mx, int row0, int k0, int lane) { return *(const LAS bf16x8_t*)(Mx + (row0 + (lane & 15)) * MS + k0 + 8 * (lane >> 4)); }
__device__ __forceinline__ f32x4 mm64(f32x4 acc, const LAS bf16* Am, int ra, const LAS bf16* BTm, int cb, int lane) {
    acc = mfma16(ldfrag(Am, 16 * ra, 0, lane), ldfrag(BTm, 16 * cb, 0, lane), acc);
    return mfma16(ldfrag(Am, 16 * ra, 32, lane), ldfrag(BTm, 16 * cb, 32, lane), acc);
}
__device__ __forceinline__ v2u pack4(f32x4 a) { v2u w; w.x = cvtpk(a[0], a[1]); w.y = cvtpk(a[2], a[3]); return w; }
__device__ __forceinline__ void tstore(LAS bf16* Dm, int rt, int ct, f32x4 acc, int lane) { *(LAS v2u*)(Dm + (16 * ct + (lane & 15)) * MS + 16 * rt + 4 * (lane >> 4)) = pack4(acc); }
__device__ __forceinline__ void tstore_g(bf16* Dg, int rt, int ct, f32x4 acc, int lane) { *(GAS v2u*)(Dg + (16 * ct + (lane & 15)) * 64 + 16 * rt + 4 * (lane >> 4)) = pack4(acc); }
__device__ __forceinline__ f32x4 ld4bf(const LAS bf16* p) { const v2u w = *(const LAS v2u*)p; return (f32x4){bflo(w.x), bfhi(w.x), bflo(w.y), bfhi(w.y)}; }
__device__ __forceinline__ f32x4 ld4bf_g(const bf16* p) { const v2u w = *(const GAS v2u*)p; return (f32x4){bflo(w.x), bfhi(w.x), bflo(w.y), bfhi(w.y)}; }
__device__ __forceinline__ void unpack8(v4u w, float (&f)[8]) { f[0] = bflo(w.x); f[1] = bfhi(w.x); f[2] = bflo(w.y); f[3] = bfhi(w.y); f[4] = bflo(w.z); f[5] = bfhi(w.z); f[6] = bflo(w.w); f[7] = bfhi(w.w); }
__device__ __forceinline__ bf16x8_t pack8(const float (&f)[8]) { v4u w; w.x = cvtpk(f[0], f[1]); w.y = cvtpk(f[2], f[3]); w.z = cvtpk(f[4], f[5]); w.w = cvtpk(f[6], f[7]); return __builtin_bit_cast(bf16x8_t, w); }

__device__ __forceinline__ void rwkv_chunk_phase(ArgP A, int L, LAS unsigned char* lds, int tid, int G, int bid) {
    const int lane = tid & 63, wave = __builtin_amdgcn_readfirstlane(tid >> 6), i = L >> 1;
    const int l15 = lane & 15, lg = lane >> 4;
    const bf16* P = (const bf16*)(A->ws + WS_P); bf16* XNb = (bf16*)(A->ws + WS_XN);
    const int rt = wave >> 1, ct0 = 2 * (wave & 1);
    constexpr int NIT = BATCH * 64 * 8;
    v4u pw[2][2], pa[2][2]; unsigned short pe[9][3];
#define R1_PREFETCH(itx) do { const int b_ = (itx) >> 9, n_ = ((itx) >> 3) & 63, h_ = (itx) & 7; const size_t rowb_ = (size_t)b_ * T + 64 * n_; \
        { const int tt_ = 16 * rt + l15; const bf16* prow_ = P + (rowb_ + tt_) * NIN_E; const bool hp_ = (64 * n_ + tt_) > 0; const v4u z4_ = (v4u){0u, 0u, 0u, 0u}; \
          _Pragma("unroll") for (int q = 0; q < 2; ++q) { const int kc_ = 32 * q + 8 * lg; pw[q][0] = *(const GAS v4u*)(prow_ + PC_W1A + kc_); pw[q][1] = hp_ ? *(const GAS v4u*)(prow_ - NIN_E + PC_W1B + kc_) : z4_; \
              pa[q][0] = *(const GAS v4u*)(prow_ + PC_A1A + kc_); pa[q][1] = hp_ ? *(const GAS v4u*)(prow_ - NIN_E + PC_A1B + kc_) : z4_; } \
          } \
        { const int c_ = 64 * h_ + lane; const size_t row0_ = rowb_ + 8 * wave; const bool hp_ = (64 * n_ + 8 * wave) > 0; \
          _Pragma("unroll") for (int u = 0; u < 9; ++u) { const bf16* pp_ = P + (row0_ + u - 1) * NIN_E; const bool ok_ = u > 0 || hp_; \
              pe[u][0] = ok_ ? pp_[PC_R + c_] : (unsigned short)0; pe[u][1] = ok_ ? pp_[PC_K + c_] : (unsigned short)0; pe[u][2] = ok_ ? pp_[PC_V + c_] : (unsigned short)0; } } } while (0)
    if (bid < NIT) R1_PREFETCH(bid);
#pragma unroll 1
    for (int it = bid; it < NIT; it += G) {
    const int b = it >> 9, n = (it >> 3) & 63, h = it & 7;
    const size_t rowb = (size_t)b * T + 64 * n;
    bf16* item = (bf16*)(A->ws + WS_RWI) + ((size_t)((b * 64 + n) * 8 + h)) * 16384;
    asm volatile("; MARK_R1_E1");
    {
        const bf16* W2T = (const bf16*)(A->ws + WS_W2T); const bf16* A2T = (const bf16*)(A->ws + WS_A2T);
        f32x4 xw[2], xa[2];
#pragma unroll
        for (int c = 0; c < 2; ++c) { xw[c] = (f32x4){0.f, 0.f, 0.f, 0.f}; xa[c] = (f32x4){0.f, 0.f, 0.f, 0.f}; }
#pragma unroll
        for (int q = 0; q < 2; ++q) {
            const int kc = 32 * q + 8 * lg; float x[8], y[8], v[8];
            unpack8(pw[q][0], x); unpack8(pw[q][1], y);
#pragma unroll
            for (int e = 0; e < 8; ++e) v[e] = tanh_f(x[e] + y[e]);
            const bf16x8_t fw = pack8(v);
            unpack8(pa[q][0], x); unpack8(pa[q][1], y);
#pragma unroll
            for (int e = 0; e < 8; ++e) v[e] = x[e] + y[e];
            const bf16x8_t fa = pack8(v);
#pragma unroll
            for (int c = 0; c < 2; ++c) { const size_t wo = (size_t)(64 * h + 16 * (ct0 + c) + l15) * 64 + kc;
                xw[c] = mfma16(fw, *(const GAS bf16x8_t*)(W2T + wo), xw[c]); xa[c] = mfma16(fa, *(const GAS bf16x8_t*)(A2T + wo), xa[c]); }
        }
        LAS float* XW = (LAS float*)(lds + RW_XW); LAS float* XA = (LAS float*)(lds + RW_XA);
#pragma unroll
        for (int c = 0; c < 2; ++c)
#pragma unroll
            for (int r = 0; r < 4; ++r) { const int o = (16 * rt + 4 * lg + r) * 64 + 16 * (ct0 + c) + l15; XW[o] = xw[c][r]; XA[o] = xa[c][r]; }
    }
    LDS_BARRIER();
    asm volatile("; MARK_R1_E2");
    {
        const int c = 64 * h + lane;
        const float* mu = A->in[7] + (size_t)i * 1536;
        const float mur = mu[c], muk = mu[512 + c], muv = mu[1024 + c];
        const float kkc = A->in[17][i * 512 + c], kac = A->in[18][i * 512 + c], rkc = A->in[19][i * 512 + c], w0c = A->in[9][i * 512 + c], a0c = A->in[12][i * 512 + c];
        const LAS float* XW = (const LAS float*)(lds + RW_XW); const LAS float* XA = (const LAS float*)(lds + RW_XA);
        float* BON = (float*)(A->ws + WS_BON);
        const int tt0 = 8 * wave; const size_t row0 = rowb + tt0;
        float pr_p = bf2f(pe[0][0]), pk_p = bf2f(pe[0][1]), pv_p = bf2f(pe[0][2]);
        float rr[8], av[8], bv[8], km[8], vv[8], lc[8];
        float run = 0.f;
#pragma unroll
        for (int u = 0; u < 8; ++u) {
            const float pR = bf2f(pe[u + 1][0]), pK = bf2f(pe[u + 1][1]), pV = bf2f(pe[u + 1][2]);
            const float r = pR + (pr_p - pR) * mur, k = pK + (pk_p - pK) * muk, v = pV + (pv_p - pV) * muv; pr_p = pR; pk_p = pK; pv_p = pV;
            const float xw = w0c + XW[(tt0 + u) * 64 + lane], xa = a0c + XA[(tt0 + u) * 64 + lane];
            const float wlog = -0.6065306597126334f * sigmoid_f(xw), as = sigmoid_f(xa);
            float kk = k * kkc; const float n2 = wave_sum(kk * kk); kk = kk * frsq(fmaxf(n2, 1e-24f));
            const float kmod = k * (1.f + (as - 1.f) * kac);
            const float bon = wave_sum(r * kmod * rkc);
            if (lane == 0) BON[(row0 + u) * 8 + h] = bon;
            run += wlog; rr[u] = r; av[u] = -kk; bv[u] = kk * as; km[u] = kmod; vv[u] = v; lc[u] = run;
        }
        LAS float* TOT = (LAS float*)(lds + RW_TOT);
        TOT[wave * 64 + lane] = run;
        LDS_BARRIER();
        float off = 0.f, tot = 0.f;
#pragma unroll
        for (int w2 = 0; w2 < 8; ++w2) { const float tv = TOT[w2 * 64 + lane]; tot += tv; if (w2 < wave) off += tv; }
        if (wave == 0) ((LAS float*)(lds + RW_GAM))[lane] = fexp(tot);
        float fR[8], fA[8], fB[8], fK[8];
        float eprev = fexp(off);
#pragma unroll
        for (int u = 0; u < 8; ++u) { const float cum = off + lc[u], e1 = fexp(cum), ei = frcp(e1); fR[u] = rr[u] * e1; fA[u] = av[u] * eprev; fB[u] = bv[u] * ei; fK[u] = km[u] * ei; eprev = e1; }
        LAS bf16* At = RBUF(0); LAS bf16* Bt = RBUF(1); LAS bf16* Kt = RBUF(2); LAS bf16* Rt = RBUF(3);
#pragma unroll
        for (int u = 0; u < 8; ++u) { const int o = (tt0 + u) * MS + lane; At[o] = (bf16)f2bf(fA[u]); Bt[o] = (bf16)f2bf(fB[u]); Kt[o] = (bf16)f2bf(fK[u]); Rt[o] = (bf16)f2bf(fR[u]); }
        *(LAS bf16x8_t*)(RBUF(4) + lane * MS + tt0) = pack8(fA); *(LAS bf16x8_t*)(RBUF(5) + lane * MS + tt0) = pack8(fB);
        *(LAS bf16x8_t*)(RBUF(6) + lane * MS + tt0) = pack8(fK); *(LAS bf16x8_t*)(RBUF(7) + lane * MS + tt0) = pack8(vv);
    }
    asm volatile("" ::: "memory");
    if (it + G < NIT) R1_PREFETCH(it + G);
    LDS_BARRIER();
    asm volatile("; MARK_R1_G");
    {
        const LAS bf16* At = RBUF(0); const LAS bf16* Bt = RBUF(1); const LAS bf16* Kt = RBUF(2); const LAS bf16* Rt = RBUF(3);
#pragma unroll
        for (int c = 0; c < 2; ++c) { const int ct = ct0 + c; const f32x4 z = (f32x4){0.f, 0.f, 0.f, 0.f};
            f32x4 aL = mm64(z, Bt, rt, At, ct, lane);
            f32x4 aLT = mm64(z, At, rt, Bt, ct, lane);
            f32x4 aAK = mm64(z, Kt, rt, At, ct, lane);
            f32x4 aRB = mm64(z, Bt, rt, Rt, ct, lane);
            f32x4 aRK = mm64(z, Kt, rt, Rt, ct, lane);
            const int col = 16 * ct + l15;
#pragma unroll
            for (int r = 0; r < 4; ++r) { const int row = 16 * rt + 4 * lg + r;
                if (!(row < col)) { aL[r] = 0.f; aAK[r] = 0.f; }
                if (!(col < row)) aLT[r] = 0.f;
                if (!(row <= col)) { aRB[r] = 0.f; aRK[r] = 0.f; } }
            tstore(RBUF(8), rt, ct, aL, lane); tstore(RBUF(9), rt, ct, aLT, lane); tstore(RBUF(10), rt, ct, aAK, lane); tstore(RBUF(11), rt, ct, aRB, lane); tstore(RBUF(12), rt, ct, aRK, lane);
        }
    }
    LDS_BARRIER();
    asm volatile("; MARK_R1_N");
    {
    {
        for (int e = tid; e < 64 * 16; e += NTHREADS) { const int row = e >> 4, c4 = (e & 15) * 4; v2u w = *(const LAS v2u*)(RBUF(8) + row * MS + c4);
            if ((row >> 2) == (c4 >> 2)) { const unsigned one = 0x3f80u; const int p = row & 3; if (p == 0) w.x = (w.x & 0xffff0000u) | one; else if (p == 1) w.x = (w.x & 0xffffu) | (one << 16); else if (p == 2) w.y = (w.y & 0xffff0000u) | one; else w.y = (w.y & 0xffffu) | (one << 16); }
            *(LAS v2u*)(RBUF(0) + row * MS + c4) = w; }
    }
#define RW_SQUARE(Min, MTin, Mout, MTout) do { _Pragma("unroll") for (int c = 0; c < 2; ++c) { const int ct = ct0 + c; const f32x4 z = (f32x4){0.f, 0.f, 0.f, 0.f}; \
        tstore(RBUF(Mout), rt, ct, mm64(z, RBUF(MTin), rt, RBUF(Min), ct, lane), lane);        \
        tstore(RBUF(MTout), rt, ct, mm64(z, RBUF(Min), rt, RBUF(MTin), ct, lane), lane); } } while (0)
#define RW_YSTEP(Yin, MTin, Yout) do { _Pragma("unroll") for (int c = 0; c < 2; ++c) { const int ct = ct0 + c; \
        const f32x4 y0 = ld4bf(RBUF(Yin) + (16 * ct + l15) * MS + 16 * rt + 4 * lg);            \
        tstore(RBUF(Yout), rt, ct, mm64(y0, RBUF(MTin), rt, RBUF(Yin), ct, lane), lane); } } while (0)
    RW_SQUARE(8, 9, 2, 13);
    LDS_BARRIER();
    RW_YSTEP(0, 13, 1); RW_SQUARE(2, 13, 8, 9);
    LDS_BARRIER();
    RW_YSTEP(1, 9, 0); RW_SQUARE(8, 9, 2, 13);
    LDS_BARRIER();
    RW_YSTEP(0, 13, 1); RW_SQUARE(2, 13, 8, 9);
    LDS_BARRIER();
    RW_YSTEP(1, 9, 0); RW_SQUARE(8, 9, 2, 13);
    LDS_BARRIER();
    RW_YSTEP(0, 13, 1);
    {
#pragma unroll
        for (int c = 0; c < 2; ++c) { const int ct = ct0 + c; tstore(RBUF(9), rt, ct, mm64((f32x4){0.f, 0.f, 0.f, 0.f}, RBUF(10), rt, RBUF(7), ct, lane), lane); }
    }
    LDS_BARRIER();
    }
#undef RW_SQUARE
#undef RW_YSTEP
    asm volatile("; MARK_R1_F1");
    {
    {
#pragma unroll
        for (int c = 0; c < 2; ++c) { const int ct = ct0 + c; const f32x4 z = (f32x4){0.f, 0.f, 0.f, 0.f};
            tstore(RBUF(8), rt, ct, mm64(z, RBUF(1), rt, RBUF(4), ct, lane), lane);
            tstore(RBUF(0), rt, ct, mm64(z, RBUF(1), rt, RBUF(9), ct, lane), lane); }
    }
    LDS_BARRIER();
    {
        const LAS float* GAM = (const LAS float*)(lds + RW_GAM);
#pragma unroll
        for (int c = 0; c < 2; ++c) { const int ct = ct0 + c; const f32x4 z = (f32x4){0.f, 0.f, 0.f, 0.f};
            const f32x4 r0 = ld4bf(RBUF(3) + (16 * ct + l15) * MS + 16 * rt + 4 * lg);
            tstore_g(item, rt, ct, mm64(r0, RBUF(8), rt, RBUF(11), ct, lane), lane);
            f32x4 pp = mm64(z, RBUF(8), rt, RBUF(5), ct, lane);
            const float gm = GAM[16 * ct + l15];
#pragma unroll
            for (int r = 0; r < 4; ++r) pp[r] = gm * (pp[r] + ((16 * rt + 4 * lg + r) == (16 * ct + l15) ? 1.f : 0.f));
            *(GAS v2u*)(item + 8192 + (((ct * 2 + (rt >> 1)) * 64 + lane) * 8 + 4 * (rt & 1))) = pack4(pp);
            f32x4 y0 = mm64(z, RBUF(0), rt, RBUF(11), ct, lane); y0 = mm64(y0, RBUF(7), rt, RBUF(12), ct, lane);
            tstore_g(item + 4096, rt, ct, y0, lane);
            f32x4 q = mm64(z, RBUF(5), rt, RBUF(0), ct, lane); q = mm64(q, RBUF(6), rt, RBUF(7), ct, lane);
            const f32x4 g4 = *(const LAS f32x4*)(GAM + 16 * rt + 4 * lg);
            q = q * g4;
            *(GAS v2u*)(item + 12288 + (((ct * 4 + rt) * 64 + lane) * 4)) = pack4(q); }
    }
    LDS_BARRIER();
    }
    }
#undef R1_PREFETCH
}

constexpr int R2_NS = 8, R2_STB = 16384;
static_assert(R2_NS * R2_STB <= RING_BYTES, "scan ring");
__device__ __forceinline__ void rwkv_state_scan(ArgP A, int b, int h, LAS unsigned char* lds, int wave, int lane) {
    const int l15 = lane & 15, lg = lane >> 4, dw = wave & 3;
    unsigned char* item0 = (unsigned char*)(A->ws + WS_RWI) + ((size_t)((b * 64) * 8 + h)) * 32768;
#define R2_DMA(nn) do { const unsigned char* g_ = item0 + (size_t)(nn) * 8 * 32768 + 16384 + dw * 4096 + lane * 16; LAS unsigned char* s_ = lds + ((nn) & (R2_NS - 1)) * R2_STB + dw * 4096; \
        _Pragma("unroll") for (int p = 0; p < 4; ++p) __builtin_amdgcn_global_load_lds((const unsigned*)(g_ + p * 1024), (LAS unsigned*)(s_ + p * 1024), 16, 0, 0); } while (0)
    if (wave >= 4) {
#pragma unroll
        for (int n = 0; n < R2_NS - 1; ++n) R2_DMA(n); }
    f32x4 S[4]; float zz_ = 0.f; asm volatile("" : "+v"(zz_));
#pragma unroll
    for (int t = 0; t < 4; ++t) S[t] = (f32x4){zz_, zz_, zz_, zz_};
#pragma unroll 1
    for (int n = 0; n < 64; ++n) {
        if (wave >= 4) { if (n <= 64 - (R2_NS - 1)) asm volatile("s_waitcnt vmcnt(24)" ::: "memory"); else asm volatile("s_waitcnt vmcnt(0)" ::: "memory"); }
        __builtin_amdgcn_s_barrier();
        if (wave >= 4) { if (n + R2_NS - 1 < 64) R2_DMA(n + R2_NS - 1); }
        else {
            const LAS unsigned char* st = lds + (n & (R2_NS - 1)) * R2_STB;
            v4u pf[8]; v2u qv[4];
#pragma unroll
            for (int f = 0; f < 8; ++f) pf[f] = *(const LAS v4u*)(st + (f * 64 + lane) * 16);
#pragma unroll
            for (int t = 0; t < 4; ++t) qv[t] = *(const LAS v2u*)(st + 8192 + ((dw * 4 + t) * 64 + lane) * 8);
            unsigned pk[4][2];
#pragma unroll
            for (int t = 0; t < 4; ++t) { pk[t][0] = cvtpk(S[t][0], S[t][1]); pk[t][1] = cvtpk(S[t][2], S[t][3]); }
            bf16* SN = (bf16*)(item0 + (size_t)n * 8 * 32768 + 24576);
#pragma unroll
            for (int t = 0; t < 4; ++t) *(GAS v2u*)(SN + (((dw * 2 + (t >> 1)) * 64 + (2 * (t & 1) + (lg >> 1)) * 16 + l15) * 8 + 4 * (lg & 1))) = (v2u){pk[t][0], pk[t][1]};
            const bf16x8_t b0 = __builtin_bit_cast(bf16x8_t, (v4u){pk[0][0], pk[0][1], pk[1][0], pk[1][1]}), b1 = __builtin_bit_cast(bf16x8_t, (v4u){pk[2][0], pk[2][1], pk[3][0], pk[3][1]});
#pragma unroll
            for (int t = 0; t < 4; ++t) { f32x4 acc = (f32x4){bflo(qv[t].x), bfhi(qv[t].x), bflo(qv[t].y), bfhi(qv[t].y)};
                acc = mfma16(__builtin_bit_cast(bf16x8_t, pf[2 * t]), b0, acc); acc = mfma16(__builtin_bit_cast(bf16x8_t, pf[2 * t + 1]), b1, acc); S[t] = acc; }
        }
    }
#undef R2_DMA
}

__device__ __forceinline__ void rwkv_out_phase(ArgP A, int L, int wt0, int wtstride, int lane) {
    const int i = L >> 1, l15 = lane & 15, lg = lane >> 4;
    const bf16* P = (const bf16*)(A->ws + WS_P); bf16* XNb = (bf16*)(A->ws + WS_XN); const float* BON = (const float*)(A->ws + WS_BON);
    int hcur = -1; v4u g2f[5][4]; f32x4 w4[4], b4[4], m4[4];
#pragma unroll 1
    for (int wt = wt0; wt < BATCH * 64 * 8 * 4; wt += wtstride) {
    const int it_ = wt >> 2, ct = wt & 3, b = it_ >> 9, n = (it_ >> 3) & 63, h = it_ & 7;
    if (h != hcur) { hcur = h;
        const bf16* G2T = (const bf16*)(A->ws + WS_G2T) + (size_t)(64 * h + l15) * 192 + 8 * lg;
#pragma unroll
        for (int q = 0; q < 5; ++q)
#pragma unroll
            for (int it = 0; it < 4; ++it) g2f[q][it] = *(const GAS v4u*)(G2T + (size_t)(16 * it) * 192 + 32 * q);
        const float* lnw = A->in[20] + i * 512 + 64 * h; const float* lnb = A->in[21] + i * 512 + 64 * h; const float* mu = A->in[7] + (size_t)i * 1536 + 1024 + 64 * h;
#pragma unroll
        for (int it = 0; it < 4; ++it) { const int i0 = 16 * it + 4 * lg; w4[it] = *(const GAS f32x4*)(lnw + i0); b4[it] = *(const GAS f32x4*)(lnb + i0); m4[it] = *(const GAS f32x4*)(mu + i0); } }
    const bf16* item = (const bf16*)(A->ws + WS_RWI) + ((size_t)((b * 64 + n) * 8 + h)) * 16384;
    const bf16* RH = item; const bf16* Y0 = item + 4096; const bf16* ST = item + 12288;
    const size_t row = (size_t)b * T + 64 * n + 16 * ct + l15; const int tseq = 64 * n + 16 * ct + l15;
    const bf16x8_t rf0 = *(const GAS bf16x8_t*)(RH + (16 * ct + l15) * 64 + 8 * lg), rf1 = *(const GAS bf16x8_t*)(RH + (16 * ct + l15) * 64 + 32 + 8 * lg);
    const bf16* prow = P + row * NIN_E; v4u gx[5], gy[5];
#pragma unroll
    for (int q = 0; q < 5; ++q) { gx[q] = *(const GAS v4u*)(prow + PC_G1A + 32 * q + 8 * lg); gy[q] = tseq > 0 ? *(const GAS v4u*)(prow - NIN_E + PC_G1B + 32 * q + 8 * lg) : (v4u){0u, 0u, 0u, 0u}; }
    const bf16* pr = prow + PC_V + 64 * h; v2u pvr[4], pvq[4];
#pragma unroll
    for (int it = 0; it < 4; ++it) { const int i0 = 16 * it + 4 * lg; pvr[it] = *(const GAS v2u*)(pr + i0); pvq[it] = tseq > 0 ? *(const GAS v2u*)(pr - NIN_E + i0) : (v2u){0u, 0u}; }
    const float bon = BON[row * 8 + h];
    f32x4 acc[4]; float s1 = 0.f;
#pragma unroll
    for (int it = 0; it < 4; ++it) {
        f32x4 a = ld4bf_g(Y0 + (16 * ct + l15) * 64 + 16 * it + 4 * lg);
        a = mfma16(*(const GAS bf16x8_t*)(ST + ((it * 2 + 0) * 64 + lane) * 8), rf0, a);
        a = mfma16(*(const GAS bf16x8_t*)(ST + ((it * 2 + 1) * 64 + lane) * 8), rf1, a);
        acc[it] = a; s1 += (a[0] + a[1]) + (a[2] + a[3]);
    }
    s1 += __shfl_xor(s1, 16); s1 += __shfl_xor(s1, 32);
    const float mean = s1 * (1.f / 64.f); float s2 = 0.f;
#pragma unroll
    for (int it = 0; it < 4; ++it) { acc[it] = acc[it] - mean; s2 += (acc[it][0] * acc[it][0] + acc[it][1] * acc[it][1]) + (acc[it][2] * acc[it][2] + acc[it][3] * acc[it][3]); }
    s2 += __shfl_xor(s2, 16); s2 += __shfl_xor(s2, 32);
    const float rs = frsq(s2 * (1.f / 64.f) + 64e-5f);
    f32x4 gq[4] = {(f32x4){0.f, 0.f, 0.f, 0.f}, (f32x4){0.f, 0.f, 0.f, 0.f}, (f32x4){0.f, 0.f, 0.f, 0.f}, (f32x4){0.f, 0.f, 0.f, 0.f}};
#pragma unroll
    for (int q = 0; q < 5; ++q) { float x[8], y[8], v[8]; unpack8(gx[q], x); unpack8(gy[q], y);
#pragma unroll
        for (int e = 0; e < 8; ++e) v[e] = sigmoid_f(x[e] + y[e]);
        const bf16x8_t fg = pack8(v);
#pragma unroll
        for (int it = 0; it < 4; ++it) gq[it] = mfma16(__builtin_bit_cast(bf16x8_t, g2f[q][it]), fg, gq[it]); }
#pragma unroll
    for (int it = 0; it < 4; ++it) { const int i0 = 16 * it + 4 * lg;
        const f32x4 pv = (f32x4){bflo(pvr[it].x), bfhi(pvr[it].x), bflo(pvr[it].y), bfhi(pvr[it].y)}, pvp = (f32x4){bflo(pvq[it].x), bfhi(pvq[it].x), bflo(pvq[it].y), bfhi(pvq[it].y)};
        const f32x4 v4 = pv + (pvp - pv) * m4[it];
        const f32x4 o = ((acc[it] * rs) * w4[it] + b4[it] + v4 * bon) * gq[it];
        *(GAS v2u*)(XNb + row * D + 64 * h + i0) = pack4(o); }
    }
}
constexpr size_t WS_GKV = 464 * MiB;
constexpr size_t WS_GDEC = 29 * MiB + 512 * 1024;
constexpr int GL_LA = 0, GL_KR = 16384, GL_VT = GL_KR + MB, GL_TOT = GL_VT + 2 * MB, GL1_END = GL_TOT + 2048;
static_assert(GL1_END <= RING_BYTES, "GLA LDS map");

template <int NCT> __device__ __forceinline__ void gla_lora_tiles(ArgP A, size_t rowb, int h4, int rt, int ct0, LAS float* LAs, int lane) {
    const int l15 = lane & 15, lg = lane >> 4;
    const bf16* P = (const bf16*)(A->ws + WS_P); const bf16* WA2T = (const bf16*)(A->ws + WS_WA2T);
    v4u av = (v4u){0u, 0u, 0u, 0u};
    if (lg < 2) av = *(const GAS v4u*)(P + (rowb + 16 * rt + l15) * NIN_E + PC_WA1 + 8 * lg);
    const bf16x8_t af = __builtin_bit_cast(bf16x8_t, av);
#pragma unroll
    for (int c = 0; c < NCT; ++c) { const int ct = ct0 + c;
        const f32x4 x = mfma16(af, *(const GAS bf16x8_t*)(WA2T + (size_t)(64 * h4 + 16 * ct + l15) * 32 + 8 * lg), (f32x4){0.f, 0.f, 0.f, 0.f});
#pragma unroll
        for (int r = 0; r < 4; ++r) LAs[(16 * rt + 4 * lg + r) * 64 + 16 * ct + l15] = x[r]; }
}

__device__ __forceinline__ void gla_kv_item(ArgP A, int L, int b, int n, int h4, LAS unsigned char* lds, int tid) {
    const int lane = tid & 63, wave = __builtin_amdgcn_readfirstlane(tid >> 6), i = L >> 1, l15 = lane & 15, lg = lane >> 4;
    const bf16* P = (const bf16*)(A->ws + WS_P);
    const size_t rowb = (size_t)b * T + 64 * n; const int itemi = (b * 64 + n) * 4 + h4;
    LAS float* LAs = (LAS float*)(lds + GL_LA); LAS bf16* KrT = (LAS bf16*)(lds + GL_KR); LAS bf16* VTm = (LAS bf16*)(lds + GL_VT); LAS float* TOT = (LAS float*)(lds + GL_TOT);
    gla_lora_tiles<2>(A, rowb, h4, wave >> 1, 2 * (wave & 1), LAs, lane);
    __syncthreads();
    {
        const int c = 64 * h4 + lane, tt0 = 8 * wave; const float bac = A->in[24][i * 256 + c];
        float lc[8], kx[8], qx[8], v0[8], v1[8]; float run = 0.f;
#pragma unroll
        for (int u = 0; u < 8; ++u) { const bf16* pr = P + (rowb + tt0 + u) * NIN_E; const float x = bac + LAs[(tt0 + u) * 64 + lane];
            run += -softplus_f(-x) * (1.0f / 16.0f); lc[u] = run; kx[u] = bf2f(pr[PC_GK + c]); qx[u] = bf2f(pr[PC_GQ + c]); v0[u] = bf2f(pr[PC_GV + 128 * h4 + lane]); v1[u] = bf2f(pr[PC_GV + 128 * h4 + 64 + lane]); }
        TOT[wave * 64 + lane] = run;
        __syncthreads();
        float off = 0.f, tot = 0.f;
#pragma unroll
        for (int w2 = 0; w2 < 8; ++w2) { const float tv = TOT[w2 * 64 + lane]; tot += tv; if (w2 < wave) off += tv; }
        if (wave == 0) ((float*)(A->ws + WS_GDEC))[itemi * 64 + lane] = fexp(tot);
        { bf16* Pw = (bf16*)(A->ws + WS_P); const float etot = fexp(tot);
#pragma unroll
          for (int u = 0; u < 8; ++u) { const float cum = off + lc[u], e1 = fexp(cum), kt = kx[u] * frcp(e1); bf16* pw = Pw + (rowb + tt0 + u) * NIN_E;
              pw[PC_GQ + c] = (bf16)f2bf(qx[u] * 0.125f * e1); pw[PC_GK + c] = (bf16)f2bf(kt); kx[u] = kt * etot; } }
        *(LAS bf16x8_t*)(KrT + lane * MS + tt0) = pack8(kx); *(LAS bf16x8_t*)(VTm + lane * MS + tt0) = pack8(v0); *(LAS bf16x8_t*)(VTm + (64 + lane) * MS + tt0) = pack8(v1);
    }
    __syncthreads();
    {
        bf16* KVg = (bf16*)(A->ws + WS_GKV) + (size_t)itemi * 8192; const int rt = wave >> 1;
#pragma unroll
        for (int c = 0; c < 4; ++c) { const int et = 4 * (wave & 1) + c;
            const f32x4 acc = mm64((f32x4){0.f, 0.f, 0.f, 0.f}, KrT, rt, VTm, et, lane);
            *(GAS v2u*)(KVg + (16 * et + l15) * 64 + 16 * rt + 4 * lg) = pack4(acc); }
    }
    __syncthreads();
}

__device__ __forceinline__ void gla_state_scan(ArgP A, int gt, bool do_store = true) {
    const int bh = gt >> 11, grp = gt & 2047;
    const int b = bh >> 2, h4 = bh & 3;
    bf16* base = (bf16*)(A->ws + WS_GKV) + (size_t)((b * 64) * 4 + h4) * 8192 + (size_t)grp * 4;
    const float* dec = (const float*)(A->ws + WS_GDEC) + (size_t)((b * 64) * 4 + h4) * 64 + (grp & 15) * 4;
    f32x4 S = (f32x4){0.f, 0.f, 0.f, 0.f};
#pragma unroll 1
    for (int n0 = 0; n0 < 64; n0 += 8) {
        v2u kv[8]; f32x4 dc[8];
#pragma unroll
        for (int u = 0; u < 8; ++u) { kv[u] = *(const GAS v2u*)(base + (size_t)(n0 + u) * 4 * 8192); dc[u] = *(const GAS f32x4*)(dec + (size_t)(n0 + u) * 4 * 64); }
#pragma unroll
        for (int u = 0; u < 8; ++u) { if (do_store) *(GAS v2u*)(base + (size_t)(n0 + u) * 4 * 8192) = pack4(S);
            S = S * dc[u] + (f32x4){bflo(kv[u].x), bfhi(kv[u].x), bflo(kv[u].y), bfhi(kv[u].y)}; }
    }
}

constexpr int G3B_SV = 272, G3B_VT = 0, G3B_SC = 64 * G3B_SV, G3B_GRP = G3B_SC + MB;
static_assert(2 * G3B_GRP <= RING_BYTES, "GLA phase-3 LDS map");
__device__ __forceinline__ void gla_out_phase(ArgP A, int L, LAS unsigned char* lds, int tid, int G, int bid) {
    const int lane = tid & 63, wave = __builtin_amdgcn_readfirstlane(tid >> 6), i = L >> 1, l15 = lane & 15, lg = lane >> 4;
    const int gi = wave >> 2, wq = wave & 3;
    const bf16* P = (const bf16*)(A->ws + WS_P); bf16* XNb = (bf16*)(A->ws + WS_XN);
    LAS unsigned char* gb = lds + gi * G3B_GRP; LAS bf16* SC = (LAS bf16*)(gb + G3B_SC);
    const int ct = wq; const int col = 16 * ct + l15;
    int hcur = -1; f32x4 gn4[8];
#pragma unroll 1
    for (int item2 = bid; item2 < BATCH * 64 * 4 / 2; item2 += G) {
    const int itemi = 2 * item2 + gi, h4 = itemi & 3, n = (itemi >> 2) & 63, b = itemi >> 8;
    const size_t rowb = (size_t)b * T + 64 * n;
    if (h4 != hcur) { hcur = h4; const float* gn = A->in[25] + i * 512 + 128 * h4;
#pragma unroll
        for (int et = 0; et < 8; ++et) gn4[et] = *(const GAS f32x4*)(gn + 16 * et + 4 * lg); }
    v4u vreg[4];
    { const int t4 = tid & 255;
#pragma unroll
      for (int q = 0; q < 4; ++q) { const int id = t4 + 256 * q, row = id >> 4, ch = id & 15; vreg[q] = *(const GAS v4u*)(P + (rowb + row) * NIN_E + PC_GV + 128 * h4 + 8 * ch); } }
    const bf16* qrow = P + (rowb + col) * NIN_E + PC_GQ + 64 * h4 + 8 * lg;
    const bf16x8_t qf0 = *(const GAS bf16x8_t*)qrow, qf1 = *(const GAS bf16x8_t*)(qrow + 32);
    v4u kf[4][2];
#pragma unroll
    for (int rt = 0; rt < 4; ++rt) { const bf16* krow = P + (rowb + 16 * rt + l15) * NIN_E + PC_GK + 64 * h4 + 8 * lg;
        if (rt <= ct) { kf[rt][0] = *(const GAS v4u*)krow; kf[rt][1] = *(const GAS v4u*)(krow + 32); } else { kf[rt][0] = (v4u){0u, 0u, 0u, 0u}; kf[rt][1] = (v4u){0u, 0u, 0u, 0u}; } }
    const bf16* Sg = (const bf16*)(A->ws + WS_GKV) + (size_t)itemi * 8192;
    v4u sgf[8][2];
#pragma unroll
    for (int et = 0; et < 8; ++et) { sgf[et][0] = *(const GAS v4u*)(Sg + (16 * et + l15) * 64 + 8 * lg); sgf[et][1] = *(const GAS v4u*)(Sg + (16 * et + l15) * 64 + 32 + 8 * lg); }
    const size_t row = rowb + col; v2u ggr[8];
#pragma unroll
    for (int et = 0; et < 8; ++et) ggr[et] = *(const GAS v2u*)(P + row * NIN_E + PC_GG + 128 * h4 + 16 * et + 4 * lg);
    { const int t4 = tid & 255;
#pragma unroll
      for (int q = 0; q < 4; ++q) { const int id = t4 + 256 * q, vrow = id >> 4, ch = id & 15; *(LAS v4u*)(gb + G3B_VT + vrow * G3B_SV + ch * 16) = vreg[q]; } }
#pragma unroll
    for (int rt = 0; rt < 4; ++rt) { f32x4 acc = (f32x4){0.f, 0.f, 0.f, 0.f};
        if (rt <= ct) {
            acc = mfma16(__builtin_bit_cast(bf16x8_t, kf[rt][0]), qf0, acc); acc = mfma16(__builtin_bit_cast(bf16x8_t, kf[rt][1]), qf1, acc);
#pragma unroll
            for (int r = 0; r < 4; ++r) if (!((16 * rt + 4 * lg + r) <= col)) acc[r] = 0.f; }
        tstore(SC, rt, ct, acc, lane); }
    __syncthreads();
    const int vto = G3B_VT + (8 * lg + (l15 >> 2)) * G3B_SV + 4 * (lane & 3) * 2;
    f32x4 o[8]; float ss = 0.f;
#pragma unroll
    for (int et = 0; et < 8; ++et) { f32x4 acc = (f32x4){0.f, 0.f, 0.f, 0.f};
#pragma unroll
        for (int ks = 0; ks < 2; ++ks) { const LAS unsigned char* vp = gb + vto + ks * 32 * G3B_SV + et * 32;
            const a_s16x4 lo4 = __builtin_bit_cast(a_s16x4, __builtin_amdgcn_ds_read_tr16_b64_v4i16((LAS a_s16x4*)vp));
            const a_s16x4 hi4 = __builtin_bit_cast(a_s16x4, __builtin_amdgcn_ds_read_tr16_b64_v4i16((LAS a_s16x4*)(vp + 4 * G3B_SV)));
            const bf16x8_t vf = (bf16x8_t){lo4[0], lo4[1], lo4[2], lo4[3], hi4[0], hi4[1], hi4[2], hi4[3]};
            acc = mfma16(vf, ldfrag(SC, 16 * ct, 32 * ks, lane), acc); }
        acc = mfma16(__builtin_bit_cast(bf16x8_t, sgf[et][0]), qf0, acc);
        acc = mfma16(__builtin_bit_cast(bf16x8_t, sgf[et][1]), qf1, acc);
        o[et] = acc; ss += (acc[0] * acc[0] + acc[1] * acc[1]) + (acc[2] * acc[2] + acc[3] * acc[3]); }
    ss += __shfl_xor(ss, 16); ss += __shfl_xor(ss, 32);
    const float rs = frsq(ss * (1.f / 128.f) + 1e-5f);
#pragma unroll
    for (int et = 0; et < 8; ++et) { const int e0 = 16 * et + 4 * lg; const f32x4 gg = (f32x4){bflo(ggr[et].x), bfhi(ggr[et].x), bflo(ggr[et].y), bfhi(ggr[et].y)};
        f32x4 v = o[et] * rs * gn4[et]; v[0] *= silu_f(gg[0]); v[1] *= silu_f(gg[1]); v[2] *= silu_f(gg[2]); v[3] *= silu_f(gg[3]);
        *(GAS v2u*)(XNb + row * D + 512 + 128 * h4 + e0) = pack4(v); }
    __syncthreads();
    }
}
constexpr int N_STEPS = 37;
#ifndef MK_ONE_LAUNCH
#define MK_ONE_LAUNCH 1
#endif
__global__ void __launch_bounds__(NTHREADS, 2) hybrid_fwd(Args args) {
    extern __shared__ __attribute__((aligned(16))) unsigned char lds_raw[];
    LAS unsigned char* lds = (LAS unsigned char*)lds_raw;
    ArgP A0 = (ArgP)__builtin_amdgcn_kernarg_segment_ptr();
    { const int tid = threadIdx.x; for (int u = tid; u < (LDS_BYTES - LDSCTL_OFF) / 4; u += NTHREADS) ((LAS unsigned*)(lds + LDSCTL_OFF))[u] = 0u; }
    __syncthreads();
    const int lo = A0->lo, hi = A0->hi;
    if (hi - lo > 1) (void)xcd_barrier_post((unsigned*)(A0->ws + WS_CTL) + CW_BAR, (volatile LAS unsigned*)(lds + MISC_OFF) + 8);
#ifndef PHM
#define PHM 0xff
#endif
#define RUN(s) (lo <= (s) && (s) < hi)
#define EN(b) ((PHM >> (b)) & 1)
#ifndef PROBE_REP
#define PROBE_REP 0
#endif
#define REP(b) _Pragma("unroll 1") for (int rep_ = 0; rep_ < (((PROBE_REP >> (b)) & 1) ? 2 : 1); ++rep_)
#ifndef PROBE_TMASK
#define PROBE_TMASK 0u
#endif
#ifndef PROBE_TAMP
#define PROBE_TAMP 4
#endif
#ifndef PROBE_TCLK
#define PROBE_TCLK 0
#endif
#ifndef PROBE_BLOCK
#define PROBE_BLOCK 0
#endif
#ifndef PROBE_SUBA
#define PROBE_SUBA 0
#define PROBE_SUBB 0
#endif
#define PROBE_STAMP(i) do { if (PROBE_TMASK && ((i) == PROBE_SUBA || (i) == PROBE_SUBB) && L == 0 && bid == PROBE_BLOCK && tid == 0) { ArgP As_ = A; ((unsigned long long*)((unsigned*)(As_->ws + WS_CTL) + 32768))[i] = __builtin_amdgcn_s_memrealtime(); } } while (0)
    int nbar_ = 0;
    if (PROBE_TMASK) { if (blockIdx.x == PROBE_BLOCK && threadIdx.x == 0) { ((unsigned long long*)((unsigned*)(A0->ws + WS_CTL) + 32768))[0] = __builtin_amdgcn_s_memrealtime(); ((unsigned long long*)((unsigned*)(A0->ws + WS_CTL) + 32768))[64] = __builtin_amdgcn_s_memtime(); } }
#define GRID_BARRIER() do { ArgP Ab_ = FRESH_ARGS(); XcdBarrier b_; b_.bar = (unsigned*)(Ab_->ws + WS_CTL) + CW_BAR; b_.x = xb_xcc_id(); b_.st = (volatile LAS unsigned*)(lds + MISC_OFF) + 8; xcd_barrier(b_); if (PROBE_TMASK) { ++nbar_; if (blockIdx.x == PROBE_BLOCK && threadIdx.x == 0) { ((unsigned long long*)((unsigned*)(Ab_->ws + WS_CTL) + 32768))[nbar_] = __builtin_amdgcn_s_memrealtime(); ((unsigned long long*)((unsigned*)(Ab_->ws + WS_CTL) + 32768))[64 + nbar_] = __builtin_amdgcn_s_memtime(); } } } while (0)
#define SEAM(s) do { if (RUN(s) && RUN((s) + 1)) GRID_BARRIER(); } while (0)
#define PHASE_VARS() ArgP A = FRESH_ARGS(); int L = Lq; FRESH_S(L); int tid = threadIdx.x; FRESH_V(tid); const int lane = tid & 63, wave = __builtin_amdgcn_readfirstlane(tid >> 6); int G = gridDim.x, bid = blockIdx.x; FRESH_S(G); FRESH_S(bid); (void)lane; (void)wave; (void)G; (void)A; (void)bid; \
    bf16* XN = (bf16*)(A->ws + WS_XN); bf16* PB = (bf16*)(A->ws + WS_P); (void)XN; (void)PB

#define BAR2(a, b) do { if (RUN(a) && RUN(b)) GRID_BARRIER(); } while (0)
    if (EN(0) && RUN(0)) REP(0) { int Lq = 0; PHASE_VARS(); const int gw = bid * NWAVES + wave, NGW = G * NWAVES;
        convert_mixer_weights(A, 0, lds, wave, lane, gw, NGW); PROBE_STAMP(45);
        float* ssq0 = (float*)(A->ws + WS_SSQ);
        for (int m = gw; m < M; m += NGW) x_to_bf16_ssq(A->in[0] + (size_t)m * D, (bf16*)A->out + (size_t)m * D, ssq0 + (size_t)m * 16, lane); }
    BAR2(0, 1);
    for (int Lq = 0; Lq < 4; ++Lq) {
        const int s0 = 9 * Lq; const bool even = !(Lq & 1);
        if (EN(1) && RUN(s0 + 1)) REP(1) {
            PHASE_VARS(); bf16* Win = (bf16*)(A->ws + WS_WIN); const float* ssq = (const float*)(A->ws + WS_SSQ);
            if (even) {
                pg8::Gemm g{(bf16*)A->out, Win, M, NIN_E, D}; pg8::StaticOrderC<M, NIN_E> S; S.init(G, bid);
                pg8::fill_row_scales(S, ssq, (LAS float*)(lds + RSTAB_OFF), tid);
                pg8::EpiStoreBf16 E{PB, NIN_E, 0, 1.0f, (const LAS float*)(lds + RSTAB_OFF)};
                pg8::gemm_phase<pg8::EpiStoreBf16, pg8::StaticOrderC<M, NIN_E>, PG8_ALIGN, PG8_SP2>(lds, g, S, E);
            } else {
                pg8::Gemm g{(bf16*)A->out, Win, M, NIN_O, D}; pg8::StaticOrderC<M, NIN_O> S; S.init(G, bid);
                pg8::fill_row_scales(S, ssq, (LAS float*)(lds + RSTAB_OFF), tid);
                pg8::EpiStoreBf16 E{PB, NIN_O, 4, 0.125f * 1.4426950408889634f, (const LAS float*)(lds + RSTAB_OFF)};
                pg8::gemm_phase<pg8::EpiStoreBf16, pg8::StaticOrderC<M, NIN_O>, PG8_ALIGN, PG8_SP2>(lds, g, S, E);
            }
        }
        if (even) {
            BAR2(s0 + 1, s0 + 2);
            if (EN(2) && RUN(s0 + 2)) REP(2) { PHASE_VARS();
                rwkv_chunk_phase(A, L, lds, tid, G, bid); PROBE_STAMP(44);
                REP(8) {
#pragma unroll 1
                for (int it = bid; it < BATCH * 64 * 4; it += G) gla_kv_item(A, L, it >> 8, (it >> 2) & 63, it & 3, lds, tid); } }
            BAR2(s0 + 2, s0 + 3);
            if (EN(3) && RUN(s0 + 3)) {
                PHASE_VARS();
                if (bid < 64) { rwkv_state_scan(A, bid >> 3, bid & 7, lds, wave, lane); PROBE_STAMP(40); }
                else { for (int gt = (bid - 64) * NTHREADS + tid; gt < 32 * 2048; gt += (G - 64) * NTHREADS) gla_state_scan(A, gt);
                       PROBE_STAMP(41);
                       convert_ffn_weights(A, L, lds, wave, lane, (bid - 64) * NWAVES + wave, (G - 64) * NWAVES); PROBE_STAMP(42); }
            }
            BAR2(s0 + 3, s0 + 4);
            if (EN(3) && RUN(s0 + 4)) {
                PHASE_VARS();
                REP(9) {
                gla_out_phase(A, L, lds, tid, G, bid); }
                PROBE_STAMP(43);
                rwkv_out_phase(A, L, bid * NWAVES + wave, G * NWAVES, lane);
            }
            BAR2(s0 + 4, s0 + 5);
        } else {
            BAR2(s0 + 1, s0 + 3);
            if (EN(4) && RUN(s0 + 3) && ((PROBE_REP >> 16) & 1)) { PHASE_VARS(); attn_phase_mfma<true>(A, L, lds, tid, G, bid); }
            if (EN(4) && RUN(s0 + 3)) REP(4) { PHASE_VARS(); attn_phase_mfma(A, L, lds, tid, G, bid); convert_ffn_weights(A, L, lds, wave, lane, bid * NWAVES + wave, G * NWAVES); }
            BAR2(s0 + 3, s0 + 5);
        }
        if (EN(5) && RUN(s0 + 5)) {
            PHASE_VARS(); bf16* Wout = (bf16*)(A->ws + WS_WOUT);
            pg8::Gemm g{XN, Wout, M, D, D}; pg8::StaticOrderC<M, D> S; S.init(G, bid);
            if ((PROBE_REP >> 5) & 1) { pg8::EpiResBf16<false, true> E0{(bf16*)A->out, D, (float*)(A->ws + WS_SSQ) + (size_t)M * 16, nullptr};
                pg8::gemm_phase<pg8::EpiResBf16<false, true>, pg8::StaticOrderC<M, D>, PG8_ALIGN, PG8_SP2>(lds, g, S, E0); }
            pg8::EpiResBf16<false> E{(bf16*)A->out, D, (float*)(A->ws + WS_SSQ) + (size_t)M * 16, nullptr};
            pg8::gemm_phase<pg8::EpiResBf16<false>, pg8::StaticOrderC<M, D>, PG8_ALIGN, PG8_SP2>(lds, g, S, E);
        }
        BAR2(s0 + 5, s0 + 7);
        if (EN(6) && RUN(s0 + 7)) REP(6) {
            PHASE_VARS(); bf16* Wgu = (bf16*)(A->ws + WS_WGU);
            pg8::Gemm g{(bf16*)A->out, Wgu, M, NGU, D}; pg8::StaticOrderC<M, NGU> S; S.init(G, bid);
            pg8::fill_row_scales(S, (const float*)(A->ws + WS_SSQ) + (size_t)M * 16, (LAS float*)(lds + RSTAB_OFF), tid);
            if ((PROBE_REP >> 18) & 1) { pg8::EpiNull En; pg8::gemm_phase<pg8::EpiNull, pg8::StaticOrderC<M, NGU>, PG8_ALIGN, PG8_SP2>(lds, g, S, En); }
            if ((PROBE_REP >> 15) & 1) { pg8::EpiSwigluT<true> E0{PB, FF, (const LAS float*)(lds + RSTAB_OFF)};
                pg8::gemm_phase<pg8::EpiSwigluT<true>, pg8::StaticOrderC<M, NGU>, PG8_ALIGN, PG8_SP2>(lds, g, S, E0); }
            pg8::EpiSwiglu E{PB, FF, (const LAS float*)(lds + RSTAB_OFF)};
            pg8::gemm_phase<pg8::EpiSwiglu, pg8::StaticOrderC<M, NGU>, PG8_ALIGN, PG8_SP2>(lds, g, S, E);
        }
        BAR2(s0 + 7, s0 + 8);
        if (EN(7) && RUN(s0 + 8)) {
            PHASE_VARS(); bf16* Wdn = (bf16*)(A->ws + WS_WDN);
            pg8::Gemm g{PB, Wdn, M, D, FF}; pg8::StaticOrderC<M, D> S; S.init(G, bid);
            if ((PROBE_REP >> 7) & 1) { pg8::EpiResBf16<false, true> E0{(bf16*)A->out, D, (float*)(A->ws + WS_SSQ), nullptr};
                pg8::gemm_phase<pg8::EpiResBf16<false, true>, pg8::StaticOrderC<M, D>, PG8_ALIGN, PG8_SP2>(lds, g, S, E0); }
            if (L < 3) { pg8::EpiResBf16<false> E{(bf16*)A->out, D, (float*)(A->ws + WS_SSQ), nullptr};
                pg8::gemm_phase<pg8::EpiResBf16<false>, pg8::StaticOrderC<M, D>, PG8_ALIGN, PG8_SP2>(lds, g, S, E);
                convert_mixer_weights(A, L + 1, lds, wave, lane, bid * NWAVES + wave, G * NWAVES); }
            else { pg8::EpiResBf16<true> E{(bf16*)A->out, D, (float*)(A->ws + WS_SSQ), XN};
                pg8::gemm_phase<pg8::EpiResBf16<true>, pg8::StaticOrderC<M, D>, PG8_ALIGN, PG8_SP2>(lds, g, S, E); }
        }
        BAR2(s0 + 8, Lq < 3 ? s0 + 10 : 36);
    }
    if (RUN(36)) REP(17) {
        int Lq = 0; PHASE_VARS();
        const int gw = bid * NWAVES + wave, NGW = G * NWAVES;
        const float pscale_ = 1.0f;
        if (PROBE_TMASK) { if (blockIdx.x == PROBE_BLOCK && threadIdx.x == 0) {
            const unsigned long long* ts = (const unsigned long long*)((const unsigned*)(A->ws + WS_CTL) + 32768); unsigned long long acc_ = 0, cyc_ = 0;
            for (int k = 1; k <= 25; ++k) if ((PROBE_TMASK >> k) & 1u) { acc_ += ts[k] - ts[k - 1]; cyc_ += ts[64 + k] - ts[64 + k - 1]; }
            if (PROBE_SUBA) acc_ = ts[PROBE_SUBA] - ts[PROBE_SUBB];
            const unsigned long long target_ = PROBE_TCLK ? (cyc_ * 100000ull) / (acc_ + 1ull) : acc_ * (unsigned long long)PROBE_TAMP;
            const unsigned long long t0_ = __builtin_amdgcn_s_memrealtime();
            while (__builtin_amdgcn_s_memrealtime() - t0_ < target_ && __builtin_amdgcn_s_memrealtime() - t0_ < 4000000ull) __builtin_amdgcn_s_sleep(16); } }
        for (int m = gw; m < M; m += NGW) rms_row_bf16_to_f32(XN + (size_t)m * D, A->in[4], A->out + (size_t)m * D, lane, pscale_);
    }
#undef RUN
#undef SEAM
}

extern "C" void kernel_launch(void* const* d_in, const int* in_sizes, int n_in, void* d_out, int out_size, void* d_ws, size_t ws_size, hipStream_t stream) {
    static int grid = 0;
    if (grid == 0) {
        if (n_in != 36 || in_sizes[0] != M * D || out_size != M * D || ws_size < WS_END) { fprintf(stderr, "kernel_launch: unexpected shapes (n_in %d, in0 %d, out %d, ws %zu); nothing launched\n", n_in, n_in > 0 ? in_sizes[0] : -1, out_size, ws_size); grid = -1; return; }
        int dev = 0, cus = 0, per_cu = 0;
        if (hipGetDevice(&dev) != hipSuccess || hipDeviceGetAttribute(&cus, hipDeviceAttributeMultiprocessorCount, dev) != hipSuccess) { grid = -1; return; }
        if (hipFuncSetAttribute((const void*)hybrid_fwd, hipFuncAttributeMaxDynamicSharedMemorySize, LDS_BYTES) != hipSuccess) { fprintf(stderr, "kernel_launch: hipFuncSetAttribute failed\n"); grid = -1; return; }
        if (hipOccupancyMaxActiveBlocksPerMultiprocessor(&per_cu, (const void*)hybrid_fwd, NTHREADS, LDS_BYTES) != hipSuccess || per_cu < 1) fprintf(stderr, "kernel_launch: occupancy query reports %d\n", per_cu);
        (void)hipGetLastError();
        if (cus < 128) { fprintf(stderr, "kernel_launch: built for a 256-CU device (phase 3 of the even layers needs more than 64 workgroups); nothing launched\n"); grid = -1; return; }
        grid = cus;
    }
    if (grid < 0) return;
    if (hipMemsetAsync((char*)d_ws + WS_CTL, 0, CTL_ZERO_BYTES, stream) != hipSuccess) return;
    Args a{};
    for (int i = 0; i < 36; ++i) a.in[i] = (const float*)d_in[i];
    a.out = (float*)d_out; a.ws = (unsigned char*)d_ws;
#if MK_ONE_LAUNCH
    a.lo = 0; a.hi = N_STEPS;
    hipLaunchKernelGGL(hybrid_fwd, dim3(grid), dim3(NTHREADS), LDS_BYTES, stream, a);
#else
    for (int s = 0; s < N_STEPS; ++s) {
        if (s < 36 && ((s % 9) == 2 || (s % 9) == 4) && ((s / 9) & 1)) continue;
        a.lo = s; a.hi = s + 1;
        hipLaunchKernelGGL(hybrid_fwd, dim3(grid), dim3(NTHREADS), LDS_BYTES, stream, a);
    }
#endif
}
```

```cpp
#include <hip/hip_runtime.h>
#include <cstdio>
#include <cstdint>
__device__ __forceinline__ float silu_f(float x) { return x * __builtin_amdgcn_rcpf(1.0f + __builtin_amdgcn_exp2f(-1.4426950408889634f * x)); }
namespace pg8 {
#define PG8_LAS __attribute__((address_space(3)))
typedef unsigned short bf16_t;
typedef short bf16x8 __attribute__((ext_vector_type(8)));
typedef float f32x4 __attribute__((ext_vector_type(4)));
typedef unsigned u32x4 __attribute__((ext_vector_type(4)));
constexpr int BM = 256, BK = 64, HALF = 128, HTB = HALF * BK * 2  , STAGE_BYTES = 8 * HTB, NXCD = 8, WGM = 4;

__host__ __device__ __forceinline__ int lds_byte(int r, int c) { const int st = (r >> 4) * 2 + (c >> 5), rr = r & 15, cc = c & 31, ob = rr * 64 + cc * 2; return st * 1024 + (ob ^ (((ob >> 9) & 1) << 5)); }
__host__ __device__ __forceinline__ void stage_rc(int b, int& R, int& C) { const int st = b / 1024, sb = b % 1024, swz = sb ^ (((sb >> 9) & 1) << 5); R = (st >> 1) * 16 + swz / 64; C = (st & 1) * 32 + (swz % 64) / 2; }
__host__ __device__ __forceinline__ int perm32(int rho) { const int n = rho >> 4, i = rho & 15; return 8 * (i >> 2) + 4 * n + (i & 3); }

struct Unit { int pm, pn, idx; };
struct Gemm { const bf16_t* A; const bf16_t* Bt; int M, N, K; };

struct StaticOrder {
    int nM, nN, nwg, G, c;
    __host__ __device__ void init(int M, int N, int G_, int c_) { nM = M / BM; nN = N / BM; nwg = nM * nN; G = G_; c = c_; }
    __host__ __device__ bool next(int i, Unit& u) const {
        const long L = (long)i * G + c; if (L >= nwg) return false;
        int wgid = (int)L; { const int q = nwg / NXCD, r = nwg % NXCD, xcd = wgid % NXCD, off = wgid / NXCD; wgid = (xcd < r ? xcd * (q + 1) : r * (q + 1) + (xcd - r) * q) + off; }
        const int nig = WGM * nN, gid = wgid / nig, fm = gid * WGM, gsz = (nM - fm) < WGM ? (nM - fm) : WGM;
        u.pm = fm + ((wgid % nig) % gsz); u.pn = (wgid % nig) / gsz; return true;
    }
    __device__ __forceinline__ void a_ready(const Unit&) const {}
    __device__ __forceinline__ void done(const Unit&) const {}
};

__device__ __forceinline__ unsigned cvt_pk_bf16(float lo, float hi) { unsigned r; asm volatile("v_cvt_pk_bf16_f32 %0, %1, %2" : "=v"(r) : "v"(lo), "v"(hi)); return r; }
typedef float f32x2 __attribute__((ext_vector_type(2)));
__device__ __forceinline__ float row_ssq(const float* ssq, int row) { const f32x4* p = (const f32x4*)(ssq + (size_t)row * 16); const f32x4 a = p[0], b = p[1], c = p[2], d = p[3];
    return (((a[0] + a[1]) + (a[2] + a[3])) + ((b[0] + b[1]) + (b[2] + b[3]))) + (((c[0] + c[1]) + (c[2] + c[3])) + ((d[0] + d[1]) + (d[2] + d[3]))); }
struct EpiStoreBf16 {
    static constexpr bool PERM = true, AFTER_DRAIN = false;
    bf16_t* O; int ldc; int qtiles; float qscale; const PG8_LAS float* rstab;
    __device__ __forceinline__ void operator()(const f32x4 (&acc)[2][2][4][2], const Unit& u, int wr, int wc, int fr, int fq) const {
        const int row0 = u.pm * BM + wr * 64 + fr, col0 = u.pn * BM + wc * 32 + 8 * fq;
        const float sc = u.pn < qtiles ? qscale : 1.0f;
        const PG8_LAS float* rt_ = rstab + u.idx * BM + wr * 64 + fr;
#pragma unroll
        for (int ai = 0; ai < 2; ++ai)
#pragma unroll
            for (int m = 0; m < 4; ++m) { const int row = row0 + ai * HALF + m * 16; bf16_t* rowp = O + (size_t)row * ldc + col0;
                const float rs = sc * rt_[ai * HALF + m * 16];
#pragma unroll
                for (int bj = 0; bj < 2; ++bj) { const f32x4 v0 = acc[ai][bj][m][0] * rs, v1 = acc[ai][bj][m][1] * rs;
                    u32x4 w; w.x = cvt_pk_bf16(v0[0], v0[1]); w.y = cvt_pk_bf16(v0[2], v0[3]); w.z = cvt_pk_bf16(v1[0], v1[1]); w.w = cvt_pk_bf16(v1[2], v1[3]);
                    *(u32x4*)(rowp + bj * HALF) = w; } }
    }
};
template <bool LAST, bool NOSTORE = false> struct EpiResBf16 {
    static constexpr bool PERM = false, AFTER_DRAIN = false;
    bf16_t* xr; int ldc; float* ssq; bf16_t* xf;
    __device__ __forceinline__ void operator()(const f32x4 (&acc)[2][2][4][2], const Unit& u, int wr, int wc, int fr, int fq) const {
        typedef unsigned u32x2 __attribute__((ext_vector_type(2)));
        const int row0 = u.pm * BM + wr * 64 + fr, col0 = u.pn * BM + wc * 32 + 4 * fq;
#pragma unroll
        for (int ai = 0; ai < 2; ++ai)
#pragma unroll
            for (int m = 0; m < 4; ++m) { const int row = row0 + ai * HALF + m * 16; const size_t off = (size_t)row * ldc + col0; float s = 0.f;
#pragma unroll
                for (int bj = 0; bj < 2; ++bj)
#pragma unroll
                    for (int n = 0; n < 2; ++n) { const u32x2 bw = *(const u32x2*)(xr + off + bj * HALF + n * 16);
                        const f32x4 b = (f32x4){__builtin_bit_cast(float, bw.x << 16), __builtin_bit_cast(float, bw.x & 0xffff0000u), __builtin_bit_cast(float, bw.y << 16), __builtin_bit_cast(float, bw.y & 0xffff0000u)};
                        const f32x4 v = b + acc[ai][bj][m][n];
                        s += (v[0] * v[0] + v[1] * v[1]) + (v[2] * v[2] + v[3] * v[3]);
                        u32x2 w; w.x = cvt_pk_bf16(v[0], v[1]); w.y = cvt_pk_bf16(v[2], v[3]); if (!NOSTORE) *(u32x2*)((LAST ? xf : xr) + off + bj * HALF + n * 16) = w; else asm volatile("" :: "v"(w.x), "v"(w.y)); }
                s += __shfl_xor(s, 16); s += __shfl_xor(s, 32);
                if (fq == 0 && !NOSTORE) ssq[(size_t)row * 16 + u.pn * 4 + wc] = s;
                if (m & 1) asm volatile("" ::: "memory"); }
    }
};
template <bool NOSTORE = false> struct EpiSwigluT {
    static constexpr bool PERM = true, AFTER_DRAIN = false;
    bf16_t* H; int ldc; const PG8_LAS float* rstab;
    __device__ __forceinline__ void operator()(const f32x4 (&acc)[2][2][4][2], const Unit& u, int wr, int wc, int fr, int fq) const {
        const int row0 = u.pm * BM + wr * 64 + fr, colh = u.pn * HALF + wc * 32 + 8 * fq;
        const PG8_LAS float* rt_ = rstab + u.idx * BM + wr * 64 + fr;
#pragma unroll
        for (int ai = 0; ai < 2; ++ai)
#pragma unroll
            for (int m = 0; m < 4; ++m) { const int row = row0 + ai * HALF + m * 16; bf16_t* rowp = H + (size_t)row * ldc + colh;
                const float rs = rt_[ai * HALF + m * 16];
                const f32x4 g0 = acc[ai][0][m][0] * rs, g1 = acc[ai][0][m][1] * rs, u0 = acc[ai][1][m][0] * rs, u1 = acc[ai][1][m][1] * rs;
                float h[8];
#pragma unroll
                for (int e = 0; e < 4; ++e) { h[e] = silu_f(g0[e]) * u0[e]; h[4 + e] = silu_f(g1[e]) * u1[e]; }
                u32x4 w; w.x = cvt_pk_bf16(h[0], h[1]); w.y = cvt_pk_bf16(h[2], h[3]); w.z = cvt_pk_bf16(h[4], h[5]); w.w = cvt_pk_bf16(h[6], h[7]);
                if (!NOSTORE) *(u32x4*)rowp = w; else asm volatile("" :: "v"(w.x), "v"(w.y), "v"(w.z), "v"(w.w)); }
    }
};
typedef EpiSwigluT<false> EpiSwiglu;
struct EpiNull {
    static constexpr bool PERM = true, AFTER_DRAIN = false;
    __device__ __forceinline__ void operator()(const f32x4 (&acc)[2][2][4][2], const Unit& u, int wr, int wc, int fr, int fq) const {
#pragma unroll
        for (int ai = 0; ai < 2; ++ai)
#pragma unroll
            for (int bj = 0; bj < 2; ++bj)
#pragma unroll
                for (int m = 0; m < 4; ++m)
#pragma unroll
                    for (int n = 0; n < 2; ++n) asm volatile("" :: "v"(acc[ai][bj][m][n]));
    }
};
template <int M_, int N_> struct StaticOrderC {
    static constexpr int nM = M_ / BM, nN = N_ / BM, nwg = nM * nN;
    int G, c;
    __device__ __forceinline__ void init(int G_, int c_) { G = G_; c = c_; }
    __device__ __forceinline__ bool next(int i, Unit& u) const {
        const int L = i * G + c; if (L >= nwg) return false;
        int wgid = L; { constexpr int q = nwg / NXCD, r = nwg % NXCD; const int xcd = wgid % NXCD, off = wgid / NXCD; wgid = (xcd < r ? xcd * (q + 1) : r * (q + 1) + (xcd - r) * q) + off; }
        constexpr int nig = WGM * nN; const int gid = wgid / nig, fm = gid * WGM, gsz = (nM - fm) < WGM ? (nM - fm) : WGM;
        u.pm = fm + ((wgid % nig) % gsz); u.pn = (wgid % nig) / gsz; u.idx = i; return true;
    }
    __device__ __forceinline__ void a_ready(const Unit&) const {}
    __device__ __forceinline__ void done(const Unit&) const {}
};
template <class Sched> __device__ __forceinline__ void fill_row_scales(const Sched& S, const float* ssq, PG8_LAS float* tab, int tid) {
    Unit u; const int r = tid >> 1, hf = tid & 1;
    for (int i = 0; S.next(i, u); ++i) { const f32x4* p = (const f32x4*)(ssq + (size_t)(u.pm * BM + r) * 16 + hf * 8); const f32x4 a = p[0], b = p[1];
        float sum = ((a[0] + a[1]) + (a[2] + a[3])) + ((b[0] + b[1]) + (b[2] + b[3])); sum += __shfl_xor(sum, 1);
        if (hf == 0) tab[i * BM + r] = __builtin_amdgcn_rsqf(sum * (1.0f / 1024.0f) + 1e-6f); }
    __syncthreads();
}
template <class Epi, class Sched, bool ALIGN_EPI = false, bool SP2 = false>
__device__ __forceinline__ void gemm_phase(PG8_LAS unsigned char* lds, const Gemm g, const Sched& S, const Epi& E) {
    int tid_ = threadIdx.x; asm volatile("" : "+v"(tid_));
    float zz_ = 0.f; asm volatile("" : "+v"(zz_));
    const int tid = tid_, wid = __builtin_amdgcn_readfirstlane(tid >> 6), lane = tid & 63, wr = wid >> 2, wc = wid & 3, fr = lane & 15, fq = lane >> 4;
    const int K = g.K, nt = K / BK;
    unsigned voffA[2], voffB[2];
#pragma unroll
    for (int i = 0; i < 2; ++i) { int R, C; stage_rc(tid * 16 + i * 8192, R, C); const int Rb = Epi::PERM ? ((R & ~31) + perm32(R & 31)) : R;
        voffA[i] = (unsigned)(R * K + C) * 2u; voffB[i] = (unsigned)(Rb * K + C) * 2u; }
    const size_t kstep = (size_t)(BK * 2);
    const size_t hstep = (size_t)HALF * K * 2;
    const size_t tstep = 2 * hstep;
    const unsigned ldsw = (unsigned)wid * 1024u;
    const int aoff = lds_byte(wr * 64 + fr, fq * 8), boff = lds_byte(wc * 32 + fr, fq * 8);
#define PG8_SA(b, h) (((b) * 2 + (h)) * HTB)
#define PG8_SB(b, h) ((4 + (b) * 2 + (h)) * HTB)
#define PG8_STAGE(bufoff, gbase, voff) do { _Pragma("unroll") for (int _i = 0; _i < 2; ++_i) \
        __builtin_amdgcn_global_load_lds((const unsigned*)((const char*)(gbase) + (voff)[_i]), (PG8_LAS unsigned*)(lds + (bufoff) + ldsw + _i * 8192), 16, 0, 0); } while (0)
#define PG8_LDA(dst, b, h) do { _Pragma("unroll") for (int m = 0; m < 4; ++m) _Pragma("unroll") for (int k = 0; k < 2; ++k) dst[m][k] = *(const PG8_LAS bf16x8*)(lds + PG8_SA(b, h) + aoff + m * 2048 + k * 1024); } while (0)
#define PG8_LDB(dst, b, h) do { _Pragma("unroll") for (int n = 0; n < 2; ++n) _Pragma("unroll") for (int k = 0; k < 2; ++k) dst[n][k] = *(const PG8_LAS bf16x8*)(lds + PG8_SB(b, h) + boff + n * 2048 + k * 1024); } while (0)
#define PG8_MMA(ai, bj, At, Bt) do { __builtin_amdgcn_s_setprio(1); _Pragma("unroll") for (int m = 0; m < 4; ++m) _Pragma("unroll") for (int n = 0; n < 2; ++n) _Pragma("unroll") for (int k = 0; k < 2; ++k) \
        acc[ai][bj][m][n] = __builtin_amdgcn_mfma_f32_16x16x32_bf16(Bt[n][k], At[m][k], acc[ai][bj][m][n], 0, 0, 0); __builtin_amdgcn_s_setprio(0); } while (0)
#define PG8_WAIT_V(n) asm volatile("s_waitcnt vmcnt(" #n ")" ::: "memory")
#define PG8_WAIT_L(n) asm volatile("s_waitcnt lgkmcnt(" #n ")" ::: "memory")
#define PG8_BAR __builtin_amdgcn_s_barrier()
#define PG8_SCHED __builtin_amdgcn_sched_barrier(0)
    Unit cur, nxt; int ui = 0;
    if (!S.next(0, cur)) return;
    f32x4 acc[2][2][4][2];
#pragma unroll
    for (int a = 0; a < 2; ++a)
#pragma unroll
        for (int b = 0; b < 2; ++b)
#pragma unroll
            for (int m = 0; m < 4; ++m)
#pragma unroll
                for (int n = 0; n < 2; ++n) acc[a][b][m][n] = (f32x4){zz_, zz_, zz_, zz_};
    bf16x8 At[4][2], B0[2][2], B1[2][2];
    const char* cA = (const char*)g.A + (size_t)cur.pm * tstep; const char* cB = (const char*)g.Bt + (size_t)cur.pn * tstep;
    S.a_ready(cur);
    if constexpr (SP2) {
        PG8_STAGE(PG8_SB(0, 0), cB, voffB); PG8_STAGE(PG8_SB(0, 1), cB + hstep, voffB); PG8_STAGE(PG8_SA(0, 0), cA, voffA); PG8_STAGE(PG8_SA(0, 1), cA + hstep, voffA);
        if (wr == 1) PG8_BAR;
        PG8_WAIT_V(2); PG8_BAR;
        PG8_STAGE(PG8_SB(1, 0), cB + kstep, voffB); PG8_STAGE(PG8_SA(1, 0), cA + kstep, voffA); PG8_STAGE(PG8_SB(1, 1), cB + hstep + kstep, voffB);
        PG8_WAIT_V(6); PG8_BAR;
    } else {
        PG8_STAGE(PG8_SB(0, 0), cB, voffB); PG8_STAGE(PG8_SA(0, 0), cA, voffA); PG8_STAGE(PG8_SB(0, 1), cB + hstep, voffB); PG8_STAGE(PG8_SA(0, 1), cA + hstep, voffA);
        if (wr == 1) PG8_BAR;
        PG8_WAIT_V(4); PG8_BAR;
        PG8_STAGE(PG8_SB(1, 0), cB + kstep, voffB); PG8_STAGE(PG8_SA(1, 0), cA + kstep, voffA); PG8_STAGE(PG8_SB(1, 1), cB + hstep + kstep, voffB);
        PG8_WAIT_V(6); PG8_BAR;
    }
    for (;;) {
        const bool has_next = S.next(ui + 1, nxt);
        const char* nA = has_next ? (const char*)g.A + (size_t)nxt.pm * tstep : cA; const char* nB = has_next ? (const char*)g.Bt + (size_t)nxt.pn * tstep : cB;
        for (int t = 0; t < nt; t += 2) {
            const bool last = (t == nt - 2);
            const char* a1 = cA + (size_t)(t + 1) * kstep;
            const char* a2 = last ? nA : cA + (size_t)(t + 2) * kstep; const char* b2 = last ? nB : cB + (size_t)(t + 2) * kstep;
            const char* a3 = a2 + kstep; const char* b3 = b2 + kstep;
            if (last && has_next) S.a_ready(nxt);
            if constexpr (SP2) {
            PG8_LDB(B0, 0, 0); PG8_LDB(B1, 0, 1); PG8_SCHED; PG8_LDA(At, 0, 0); PG8_STAGE(PG8_SA(1, 1), a1 + hstep, voffA);
            PG8_WAIT_V(8); PG8_WAIT_L(0); PG8_BAR; PG8_MMA(0, 0, At, B0); PG8_MMA(0, 1, At, B1); PG8_BAR; PG8_SCHED;
            PG8_LDA(At, 0, 1); PG8_STAGE(PG8_SB(0, 0), b2, voffB); PG8_STAGE(PG8_SB(0, 1), b2 + hstep, voffB); PG8_STAGE(PG8_SA(0, 0), a2, voffA);
            PG8_WAIT_V(8); PG8_WAIT_L(0); PG8_BAR; PG8_MMA(1, 0, At, B0); PG8_MMA(1, 1, At, B1); PG8_BAR; PG8_SCHED;
            PG8_LDB(B0, 1, 0); PG8_LDB(B1, 1, 1); PG8_SCHED; PG8_LDA(At, 1, 0); PG8_STAGE(PG8_SA(0, 1), a2 + hstep, voffA);
            PG8_WAIT_V(8); PG8_WAIT_L(0); PG8_BAR; PG8_MMA(0, 0, At, B0); PG8_MMA(0, 1, At, B1); PG8_BAR; PG8_SCHED;
            PG8_LDA(At, 1, 1); PG8_STAGE(PG8_SB(1, 0), b3, voffB); PG8_STAGE(PG8_SB(1, 1), b3 + hstep, voffB); PG8_STAGE(PG8_SA(1, 0), a3, voffA);
            PG8_WAIT_V(8); PG8_WAIT_L(0); PG8_BAR; PG8_MMA(1, 0, At, B0); PG8_MMA(1, 1, At, B1); PG8_BAR; PG8_SCHED;
            } else {
            PG8_LDB(B0, 0, 0); PG8_SCHED; PG8_LDA(At, 0, 0); PG8_STAGE(PG8_SA(1, 1), a1 + hstep, voffA);
            PG8_WAIT_L(8); PG8_BAR; PG8_WAIT_L(0); PG8_MMA(0, 0, At, B0); PG8_BAR; PG8_SCHED;
            PG8_LDB(B1, 0, 1); PG8_STAGE(PG8_SB(0, 0), b2, voffB);
            PG8_BAR; PG8_WAIT_L(0); PG8_MMA(0, 1, At, B1); PG8_BAR;
            PG8_LDA(At, 0, 1); PG8_STAGE(PG8_SA(0, 0), a2, voffA);
            PG8_BAR; PG8_WAIT_L(0); PG8_MMA(1, 0, At, B0); PG8_BAR; PG8_SCHED;
            PG8_STAGE(PG8_SB(0, 1), b2 + hstep, voffB);
            PG8_WAIT_V(6); PG8_BAR; PG8_MMA(1, 1, At, B1); PG8_BAR;
            PG8_LDB(B0, 1, 0); PG8_SCHED; PG8_LDA(At, 1, 0); PG8_STAGE(PG8_SA(0, 1), a2 + hstep, voffA);
            PG8_WAIT_L(8); PG8_BAR; PG8_WAIT_L(0); PG8_MMA(0, 0, At, B0); PG8_BAR; PG8_SCHED;
            PG8_LDB(B1, 1, 1); PG8_STAGE(PG8_SB(1, 0), b3, voffB);
            PG8_BAR; PG8_WAIT_L(0); PG8_MMA(0, 1, At, B1); PG8_BAR;
            PG8_LDA(At, 1, 1); PG8_STAGE(PG8_SA(1, 0), a3, voffA);
            PG8_BAR; PG8_WAIT_L(0); PG8_MMA(1, 0, At, B0); PG8_BAR; PG8_SCHED;
            PG8_STAGE(PG8_SB(1, 1), b3 + hstep, voffB);
            PG8_WAIT_V(6); PG8_BAR; PG8_MMA(1, 1, At, B1); PG8_BAR;
            }
        }
        if constexpr (ALIGN_EPI) { if (wr == 0) PG8_BAR; }
        if constexpr (!Epi::AFTER_DRAIN) { E(acc, cur, wr, wc, fr, fq); S.done(cur); }
        if (!has_next) break;
#pragma unroll
        for (int a = 0; a < 2; ++a)
#pragma unroll
            for (int b = 0; b < 2; ++b)
#pragma unroll
                for (int m = 0; m < 4; ++m)
#pragma unroll
                    for (int n = 0; n < 2; ++n) acc[a][b][m][n] = (f32x4){zz_, zz_, zz_, zz_};
        cur = nxt; cA = nA; cB = nB; ++ui;
        if constexpr (ALIGN_EPI) { if (wr == 1) PG8_BAR; }
    }
    PG8_WAIT_V(0);
    if constexpr (!ALIGN_EPI) { if (wr == 0) PG8_BAR; }
    PG8_BAR;
    if constexpr (Epi::AFTER_DRAIN) { E.fused(acc, cur, wr, wc, fr, fq, lds, wid, lane); S.done(cur); }
#undef PG8_SA
#undef PG8_SB
#undef PG8_STAGE
#undef PG8_LDA
#undef PG8_LDB
#undef PG8_MMA
#undef PG8_WAIT_V
#undef PG8_WAIT_L
#undef PG8_BAR
#undef PG8_SCHED
}
}
#ifndef PG8_SP2
#define PG8_SP2 true
#endif
#ifndef PG8_ALIGN
#define PG8_ALIGN true
#endif
constexpr int NWAVES = 8, NTHREADS = NWAVES * 64;
constexpr int BATCH = 8, T = 4096, D = 1024, M = BATCH * T;
constexpr int NIN_E = 3840, NIN_O = 3072, FF = 2816, NGU = 2 * FF;
constexpr int PC_R = 0, PC_K = 512, PC_V = 1024, PC_GQ = 1536, PC_GK = 1792, PC_GV = 2048, PC_GG = 2560;
constexpr int PC_W1A = 3072, PC_W1B = 3136, PC_A1A = 3200, PC_A1B = 3264, PC_G1A = 3328, PC_G1B = 3488, PC_WA1 = 3648, PC_PAD = 3664;
constexpr int NLORA = 304;
constexpr size_t MiB = 1u << 20;
constexpr size_t WS_CTL = 0, CTL_ZERO_BYTES = 1 * MiB;
constexpr size_t WS_WIN = 2 * MiB, WS_WOUT = 10 * MiB, WS_WGU = 12 * MiB, WS_WDN = 23 * MiB;
constexpr size_t WS_W2T = 29 * MiB, WS_A2T = WS_W2T + 65536, WS_G2T = WS_A2T + 65536, WS_WA2T = WS_G2T + 196608;
constexpr size_t WS_SSQ = 496 * MiB;
constexpr size_t WS_XFIN = 336 * MiB;
constexpr size_t WS_XN = 32 * MiB;
constexpr size_t WS_P = 96 * MiB;
constexpr size_t WS_END = 500 * MiB;
constexpr int CW_BAR = 4096;
constexpr int RING_BYTES = 135168, LDS_BYTES = 163840, LDSCTL_OFF = LDS_BYTES - 1024, MISC_OFF = LDSCTL_OFF + 320, RSTAB_OFF = RING_BYTES + 448;

#define GAS __attribute__((address_space(1)))
#define LAS __attribute__((address_space(3)))
typedef unsigned short bf16;
typedef unsigned v4u __attribute__((ext_vector_type(4)));
typedef unsigned v2u __attribute__((ext_vector_type(2)));
typedef float f32x4 __attribute__((ext_vector_type(4)));
#define LDS_WAIT() asm volatile("s_waitcnt lgkmcnt(0)" ::: "memory")
#define VM_WAIT() asm volatile("s_waitcnt vmcnt(0)" ::: "memory")
#define LDS_BARRIER() do { asm volatile("s_waitcnt lgkmcnt(0)\n\ts_barrier" ::: "memory"); } while (0)
__device__ __forceinline__ unsigned f2bf(float f) { unsigned u = __builtin_bit_cast(unsigned, f); return (u + 0x7fffu + ((u >> 16) & 1u)) >> 16; }
__device__ __forceinline__ unsigned pk2(float lo, float hi) { return f2bf(lo) | (f2bf(hi) << 16); }
__device__ __forceinline__ float bf2f(bf16 u) { return __builtin_bit_cast(float, (unsigned)u << 16); }
__device__ __forceinline__ float bflo(unsigned w) { return __builtin_bit_cast(float, w << 16); }
__device__ __forceinline__ float bfhi(unsigned w) { return __builtin_bit_cast(float, w & 0xffff0000u); }
__device__ __forceinline__ float wave_sum(float v) {
#define WS_DPP(x, ctrl, rmask) __builtin_bit_cast(float, __builtin_amdgcn_update_dpp(0, __builtin_bit_cast(int, x), ctrl, rmask, 0xf, true))
    v += WS_DPP(v, 0x111, 0xf);
    v += WS_DPP(v, 0x112, 0xf);
    v += WS_DPP(v, 0x114, 0xf);
    v += WS_DPP(v, 0x118, 0xf);
    v += WS_DPP(v, 0x142, 0xa);
    v += WS_DPP(v, 0x143, 0xc);
#undef WS_DPP
    return __builtin_bit_cast(float, __builtin_amdgcn_readlane(__builtin_bit_cast(int, v), 63));
}
__device__ __forceinline__ float wave_max(float v) {
#pragma unroll
    for (int o = 1; o < 64; o <<= 1) v = fmaxf(v, __shfl_xor(v, o));
    return v;
}
__device__ __forceinline__ float fexp(float x) { return __builtin_amdgcn_exp2f(x * 1.4426950408889634f); }
__device__ __forceinline__ float flog(float x) { return __builtin_amdgcn_logf(x) * 0.6931471805599453f; }
__device__ __forceinline__ float frcp(float x) { return __builtin_amdgcn_rcpf(x); }
__device__ __forceinline__ float frsq(float x) { return __builtin_amdgcn_rsqf(x); }
__device__ __forceinline__ float fsqrt(float x) { return __builtin_amdgcn_sqrtf(x); }
__device__ __forceinline__ float sigmoid_f(float x) { return frcp(1.0f + fexp(-x)); }
__device__ __forceinline__ float softplus_f(float x) { return fmaxf(x, 0.f) + flog(1.0f + fexp(-fabsf(x))); }
__device__ __forceinline__ float tanh_f(float x) { return 1.0f - 2.0f * frcp(1.0f + fexp(2.0f * x)); }
#define XB_TMO      128
#define XB_XCNT(j)  (256  + 64 * (j))
#define XB_XSUB(j)  (1280 + 64 * (j))
#define XB_XGEN(j)  (2304 + 64 * (j))
#define XB_TOP      3328
#define XB_TOPGEN   3392
#define XCD_BAR_WORDS 3456
#define XB_SPIN_CAP (1u << 23)

__device__ __forceinline__ unsigned xb_ld(unsigned* p)              { return __hip_atomic_load(p, __ATOMIC_RELAXED, __HIP_MEMORY_SCOPE_AGENT); }
__device__ __forceinline__ unsigned xb_add(unsigned* p, unsigned v) { return __hip_atomic_fetch_add(p, v, __ATOMIC_RELAXED, __HIP_MEMORY_SCOPE_AGENT); }
__device__ __forceinline__ unsigned xb_xcc_id() { return (unsigned)__builtin_amdgcn_s_getreg((3 << 11) | 20) & 0xFu; }
#define XB_SPIN(cond, bar) do { unsigned _sp = 0; while (cond) { __builtin_amdgcn_s_sleep(1); \
    if ((++_sp & 255u) == 0u) { if (xb_ld(&(bar)[XB_TMO])) break; if (_sp > XB_SPIN_CAP) { atomicAdd(&(bar)[XB_TMO], 1u); break; } } } } while (0)

struct XcdBarrier {
    unsigned* bar; unsigned x;
    volatile LAS unsigned* st;
};

__device__ __forceinline__ XcdBarrier xcd_barrier_post(unsigned* bar, volatile LAS unsigned* st) {
    XcdBarrier b; b.bar = bar; b.x = xb_xcc_id(); b.st = st;
    if (threadIdx.x == 0) (void)xb_add(&bar[XB_XCNT(b.x)], 1u);
    return b;
}
__device__ __forceinline__ void xcd_barrier_complete(unsigned* bar, unsigned x, unsigned& nloc, unsigned& nx) {
    const unsigned G = gridDim.x * gridDim.y * gridDim.z;
    unsigned sum, cnt, mine, sp = 0u;
    for (;;) {
        sum = 0u; cnt = 0u; mine = 0u;
#pragma unroll
        for (unsigned j = 0; j < 16; ++j) { const unsigned c = xb_ld(&bar[XB_XCNT(j)]); sum += c; cnt += (c > 0u) ? 1u : 0u; mine = (j == x) ? c : mine; }
        if (sum == G) break;
        __builtin_amdgcn_s_sleep(1);
        if ((++sp & 255u) == 0u) { if (xb_ld(&bar[XB_TMO])) break; if (sp > XB_SPIN_CAP) { atomicAdd(&bar[XB_TMO], 1u); break; } }
    }
    nloc = mine > 0u ? mine : 1u; nx = cnt > 0u ? cnt : 1u;
}

__device__ __forceinline__ void xcd_barrier(const XcdBarrier& b) {
    asm volatile("s_waitcnt vmcnt(0)" ::: "memory");
    __syncthreads();
    if (threadIdx.x == 0) {
        unsigned blo_ = __builtin_amdgcn_readfirstlane((unsigned)(unsigned long long)b.bar), bhi_ = __builtin_amdgcn_readfirstlane((unsigned)((unsigned long long)b.bar >> 32)), bx = __builtin_amdgcn_readfirstlane(b.x); asm volatile("" : "+s"(blo_), "+s"(bhi_), "+s"(bx)); unsigned* bar = (unsigned*)(((unsigned long long)bhi_ << 32) | blo_);
        __builtin_amdgcn_s_waitcnt(0);
        unsigned nloc = b.st[0], nx = b.st[1];
        if (nloc == 0u) { xcd_barrier_complete(bar, bx, nloc, nx); b.st[0] = nloc; b.st[1] = nx; }
        const unsigned old = xb_add(&bar[XB_XSUB(bx)], 1u);
        const unsigned gen = old / nloc;
        if (old + 1u == (gen + 1u) * nloc) {
            __builtin_amdgcn_fence(__ATOMIC_RELEASE, "agent");
            asm volatile("s_waitcnt vmcnt(0)" ::: "memory");
            const unsigned og = xb_add(&bar[XB_TOP], 1u);
            const unsigned tg = og / nx;
            if (og + 1u == (tg + 1u) * nx) xb_add(&bar[XB_TOPGEN], 1u);
            else XB_SPIN(xb_ld(&bar[XB_TOPGEN]) == tg, bar);
            __builtin_amdgcn_fence(__ATOMIC_ACQUIRE, "agent");
            xb_add(&bar[XB_XGEN(bx)], 1u);
            asm volatile("s_waitcnt vmcnt(0)" ::: "memory");
        } else {
            XB_SPIN(xb_ld(&bar[XB_XGEN(bx)]) == gen, bar);
            __builtin_amdgcn_fence(__ATOMIC_ACQUIRE, "agent");
            asm volatile("s_waitcnt vmcnt(0)" ::: "memory");
        }
    }
    __syncthreads();
}
__device__ __forceinline__ void tr_item(const float* __restrict__ W, int Kreal, int N, bf16* WT, int ldd, int dst_row0, LAS float* scr, int k0, int n0, int lane,
                                        const float* __restrict__ mu, float sc0, float sc1, const float* __restrict__ gk = nullptr) {
    const int rr = lane >> 3, c4 = lane & 7, nn = n0 + 4 * c4; const bool nv = nn < N;
#pragma unroll
    for (int i = 0; i < 8; ++i) { const int kk = 8 * i + rr; f32x4 v = (nv && k0 + kk < Kreal) ? *(const GAS f32x4*)(W + (size_t)(k0 + kk) * N + nn) : (f32x4){0.f, 0.f, 0.f, 0.f};
        float sc = 1.0f; if (mu) sc = sc0 + sc1 * mu[k0 + kk]; if (gk) sc *= gk[k0 + kk]; v = v * sc;
        LAS float* d = scr + kk * 33 + 4 * c4; d[0] = v.x; d[1] = v.y; d[2] = v.z; d[3] = v.w; }
    LDS_WAIT(); asm volatile("" ::: "memory");
    const int c = lane & 7;
#pragma unroll
    for (int j = 0; j < 4; ++j) { const int n = (lane >> 3) + 8 * j; const LAS float* s = scr + (8 * c) * 33 + n;
        v4u o; o.x = pk2(s[0 * 33], s[1 * 33]); o.y = pk2(s[2 * 33], s[3 * 33]); o.z = pk2(s[4 * 33], s[5 * 33]); o.w = pk2(s[6 * 33], s[7 * 33]);
        if (n0 + n < N) *(GAS v4u*)(WT + (size_t)(dst_row0 + n) * ldd + k0 + 8 * c) = o; }
    LDS_WAIT(); asm volatile("" ::: "memory");
}
__device__ __forceinline__ void rms_row_bf16_to_f32(const bf16* xrow, const float* g, float* orow, int lane, float oscale = 1.0f) {
    const GAS v4u* xr = (const GAS v4u*)xrow + 2 * lane; const v4u a = xr[0], b = xr[1]; float v[16]; float s = 0.f;
    v[0] = bflo(a.x); v[1] = bfhi(a.x); v[2] = bflo(a.y); v[3] = bfhi(a.y); v[4] = bflo(a.z); v[5] = bfhi(a.z); v[6] = bflo(a.w); v[7] = bfhi(a.w);
    v[8] = bflo(b.x); v[9] = bfhi(b.x); v[10] = bflo(b.y); v[11] = bfhi(b.y); v[12] = bflo(b.z); v[13] = bfhi(b.z); v[14] = bflo(b.w); v[15] = bfhi(b.w);
#pragma unroll
    for (int e = 0; e < 16; ++e) s += v[e] * v[e];
    const float rs = frsq(wave_sum(s) * (1.f / D) + 1e-6f) * oscale;
    const GAS f32x4* gr = (const GAS f32x4*)g + 4 * lane; GAS f32x4* o = (GAS f32x4*)orow + 4 * lane;
#pragma unroll
    for (int q = 0; q < 4; ++q) { const f32x4 gv = gr[q]; o[q] = (f32x4){v[4 * q] * rs * gv.x, v[4 * q + 1] * rs * gv.y, v[4 * q + 2] * rs * gv.z, v[4 * q + 3] * rs * gv.w}; }
}
struct Args { const float* in[36]; float* out; unsigned char* ws; int lo, hi; };
typedef const __attribute__((address_space(4))) Args* ArgP;
#define FRESH_ARGS() ({ ArgP p_ = (ArgP)__builtin_amdgcn_kernarg_segment_ptr(); asm volatile("" : "+s"(p_)); p_; })
#define FRESH_V(x) asm volatile("" : "+v"(x))
#define FRESH_S(x) asm volatile("" : "+s"(x))

#define TR_JOB(items, nblk, Wp, Kd, Nd, DST, LDD, ROW0, MU, S0, S1, GK) if (r < (items)) { const int kb = r / (nblk), nb = r % (nblk), n0 = 32 * nb; tr_item(Wp, Kd, Nd, DST, LDD, ROW0, scr, 64 * kb, n0, lane, MU, S0, S1, GK); continue; } r -= (items);
__device__ __forceinline__ void convert_mixer_weights(ArgP A, int L, LAS unsigned char* lds, int wave, int lane, int gw, int NGW) {
    const int i = L >> 1; const bool even = !(L & 1);
    bf16* Win = (bf16*)(A->ws + WS_WIN); bf16* Wout = (bf16*)(A->ws + WS_WOUT);
    LAS float* scr = (LAS float*)(lds + wave * 16384);
    const float* gmix = A->in[2] + (size_t)L * D;
    const float* w_in = even ? A->in[5] + (size_t)i * D * 3072 : A->in[26] + (size_t)i * D * 3072;
    const float* w_out = even ? A->in[6] + (size_t)i * D * D : A->in[27] + (size_t)i * D * D;
    const float* mu_w = A->in[8] + (size_t)i * 3 * D, *mu_a = mu_w + D, *mu_g = mu_w + 2 * D;
    const float* w1 = A->in[10] + (size_t)i * D * 64, *a1 = A->in[13] + (size_t)i * D * 64, *g1 = A->in[15] + (size_t)i * D * 160, *wa1 = A->in[22] + (size_t)i * D * 16;
    const float* w2s = A->in[11] + (size_t)i * 64 * 512, *a2s = A->in[14] + (size_t)i * 64 * 512, *g2s = A->in[16] + (size_t)i * 160 * 512;
    bf16* W2T = (bf16*)(A->ws + WS_W2T); bf16* A2T = (bf16*)(A->ws + WS_A2T); bf16* G2T = (bf16*)(A->ws + WS_G2T);
    const int I_IN = 16 * 96, I_L64 = 16 * 2, I_L160 = 16 * 5, I_L16 = 16 * 1, I_OUT = 16 * 32;
    const int n_lora = even ? (4 * I_L64 + 2 * I_L160 + I_L16 + 16 + 16 + 48) : 0;
    const int NITEMS = I_IN + n_lora + I_OUT;
    for (int it = gw; it < NITEMS; it += NGW) {
        int r = it;
        TR_JOB(I_IN, 96, w_in, D, 3072, Win, D, n0, nullptr, 1.f, 0.f, gmix)
        if (even) {
            TR_JOB(I_L64, 2, w1, D, 64, Win, D, PC_W1A + n0, mu_w, 1.f, -1.f, gmix)
            TR_JOB(I_L64, 2, w1, D, 64, Win, D, PC_W1B + n0, mu_w, 0.f, 1.f, gmix)
            TR_JOB(I_L64, 2, a1, D, 64, Win, D, PC_A1A + n0, mu_a, 1.f, -1.f, gmix)
            TR_JOB(I_L64, 2, a1, D, 64, Win, D, PC_A1B + n0, mu_a, 0.f, 1.f, gmix)
            TR_JOB(I_L160, 5, g1, D, 160, Win, D, PC_G1A + n0, mu_g, 1.f, -1.f, gmix)
            TR_JOB(I_L160, 5, g1, D, 160, Win, D, PC_G1B + n0, mu_g, 0.f, 1.f, gmix)
            TR_JOB(I_L16, 1, wa1, D, 16, Win, D, PC_WA1 + n0, nullptr, 1.f, 0.f, gmix)
            TR_JOB(16, 16, w2s, 64, 512, W2T, 64, n0, nullptr, 1.f, 0.f, nullptr)
            TR_JOB(16, 16, a2s, 64, 512, A2T, 64, n0, nullptr, 1.f, 0.f, nullptr)
            TR_JOB(48, 16, g2s, 160, 512, G2T, 192, n0, nullptr, 1.f, 0.f, nullptr)
        }
        TR_JOB(I_OUT, 32, w_out, D, D, Wout, D, n0, nullptr, 1.f, 0.f, nullptr)
    }
    if (even) {
        const int gt = gw * 64 + lane, NT = NGW * 64;
        { unsigned z_ = 0u; asm volatile("" : "+v"(z_));
        for (int e = gt; e < (NIN_E - PC_PAD) * D / 8; e += NT) ((GAS v4u*)(Win + (size_t)PC_PAD * D))[e] = (v4u){z_, z_, z_, z_}; }
        bf16* WA2T = (bf16*)(A->ws + WS_WA2T); const float* wa2 = A->in[23] + (size_t)i * 16 * 256;
        for (int e = gt; e < 256 * 32; e += NT) { const int nn = e >> 5, k = e & 31; WA2T[e] = k < 16 ? (bf16)f2bf(wa2[k * 256 + nn]) : (bf16)0; }
    }
}
__device__ __forceinline__ void convert_ffn_weights(ArgP A, int L, LAS unsigned char* lds, int wave, int lane, int gw, int NGW) {
    bf16* Wgu = (bf16*)(A->ws + WS_WGU); bf16* Wdn = (bf16*)(A->ws + WS_WDN);
    LAS float* scr = (LAS float*)(lds + wave * 16384);
    const float* gffn = A->in[3] + (size_t)L * D;
    const float* wg = A->in[33] + (size_t)L * D * FF, *wu = A->in[34] + (size_t)L * D * FF, *wd = A->in[35] + (size_t)L * FF * D;
    const int I_GU = 16 * 88, I_DN = 44 * 32;
    for (int it = gw; it < 2 * I_GU + I_DN; it += NGW) {
        int r = it;
        TR_JOB(I_GU, 88, wg, D, FF, Wgu, D, 256 * (n0 >> 7) + (n0 & 127), nullptr, 1.f, 0.f, gffn)
        TR_JOB(I_GU, 88, wu, D, FF, Wgu, D, 256 * (n0 >> 7) + (n0 & 127) + 128, nullptr, 1.f, 0.f, gffn)
        TR_JOB(I_DN, 32, wd, FF, D, Wdn, FF, n0, nullptr, 1.f, 0.f, nullptr)
    }
}
#undef TR_JOB
__device__ __forceinline__ void x_to_bf16_ssq(const float* xrow, bf16* orow, float* ssq_row, int lane) {
    const GAS f32x4* xr = (const GAS f32x4*)xrow + lane; f32x4 v[4]; float s = 0.f;
#pragma unroll
    for (int j = 0; j < 4; ++j) { v[j] = xr[64 * j]; s += (v[j].x * v[j].x + v[j].y * v[j].y) + (v[j].z * v[j].z + v[j].w * v[j].w); }
    s = wave_sum(s); if (lane < 16) ssq_row[lane] = lane == 0 ? s : 0.f;
    GAS v2u* o8 = (GAS v2u*)orow + lane;
#pragma unroll
    for (int j = 0; j < 4; ++j) { v2u o; o.x = pk2(v[j].x, v[j].y); o.y = pk2(v[j].z, v[j].w); o8[64 * j] = o; }
}

__device__ __forceinline__ int t5_bucket(int d) {
    if (d < 16) return d;
    const float r = (float)d / 16.0f; int l = 16 + (int)(flog(r) / 2.0794415416798357f * 16.0f);
    return l < 31 ? l : 31;
}
typedef short a_bf16x8 __attribute__((ext_vector_type(8)));
typedef float f32x16 __attribute__((ext_vector_type(16)));
typedef short a_s16x4 __attribute__((ext_vector_type(4)));
constexpr int AT_K1 = 0, AT_K2 = 8192, AT_V = 16384, AT_ST = 32768, AT_NST = 4, AT_BIAS = AT_NST * AT_ST, AT_COMB = 0;
static_assert(AT_BIAS + 132 * 4 <= LDSCTL_OFF && 4 * 64 * 64 * 4 <= AT_BIAS, "attention LDS map");
__device__ __forceinline__ int crow16(int r, int hi) { return (r & 3) + 8 * (r >> 2) + 4 * hi; }
typedef float f32x2_t __attribute__((ext_vector_type(2))); typedef __bf16 bf16x2_t __attribute__((ext_vector_type(2)));
__device__ __forceinline__ unsigned cvtpk(float lo, float hi) { const f32x2_t v = {lo, hi}; const bf16x2_t b = __builtin_convertvector(v, bf16x2_t); return __builtin_bit_cast(unsigned, b); }

template <bool HALFSYNC = false> __device__ __forceinline__ void attn_unit_mfma(ArgP A, int L, int b, int h, int qb, float lam, float lam_init, LAS unsigned char* lds, int tid) {
    const int lane = tid & 63, wave = __builtin_amdgcn_readfirstlane(tid >> 6), r32 = lane & 31, hi = lane >> 5;
    const int smap = wave >> 2, qs = wave & 3;
    const int i = L >> 1;
    const bf16* QKV = (const bf16*)(A->ws + WS_P); bf16* O = (bf16*)(A->ws + WS_XN);
    const int q0 = qb * 128, qw0 = q0 + 32 * qs, nt = (q0 + 128) / 64;
    const size_t rowb = (size_t)b * T;
    if (tid < 129) { const float far = A->in[1][31 * 8 + h]; ((LAS float*)(lds + AT_BIAS))[tid] = tid < 128 ? (A->in[1][t5_bucket(tid) * 8 + h] - far) * 1.4426950408889634f : 0.f; }
    a_bf16x8 qf[4];
    { const bf16* qrow = QKV + (rowb + qw0 + r32) * NIN_O + h * 128 + smap * 64 + 8 * hi;
#pragma unroll
      for (int ks = 0; ks < 4; ++ks) qf[ks] = *(const GAS a_bf16x8*)(qrow + 16 * ks); }
    const int kr = 8 * wave + (lane >> 3), kcs = (lane & 7) ^ ((kr >> 1) & 7);
    const bf16* kg = QKV + (rowb + kr) * NIN_O + 1024 + h * 128 + 8 * kcs;
    const int vr0 = 8 * wave + (lane >> 4), vr1 = vr0 + 4;
    const bf16* vg0 = QKV + (rowb + vr0) * NIN_O + 2048 + h * 128 + 8 * ((lane & 15) ^ (((vr0 & 3) << 2) | ((vr0 >> 2) & 3)));
    const bf16* vg1 = QKV + (rowb + vr1) * NIN_O + 2048 + h * 128 + 8 * ((lane & 15) ^ (((vr1 & 3) << 2) | ((vr1 >> 2) & 3)));
#define AT_DMA(kt, stoff) do { const size_t go_ = (size_t)(kt) * 64 * NIN_O; LAS unsigned char* sb_ = lds + (stoff) + wave * 1024; \
        __builtin_amdgcn_global_load_lds((const unsigned*)(kg + go_), (LAS unsigned*)(sb_ + AT_K1), 16, 0, 0); __builtin_amdgcn_global_load_lds((const unsigned*)(kg + go_ + 64), (LAS unsigned*)(sb_ + AT_K2), 16, 0, 0); \
        __builtin_amdgcn_global_load_lds((const unsigned*)(vg0 + go_), (LAS unsigned*)(sb_ + AT_V + wave * 1024), 16, 0, 0); __builtin_amdgcn_global_load_lds((const unsigned*)(vg1 + go_), (LAS unsigned*)(sb_ + AT_V + wave * 1024 + 1024), 16, 0, 0); } while (0)
    AT_DMA(0, 0); AT_DMA(1, AT_ST);
    __syncthreads();
    f32x16 o[4];
#pragma unroll
    for (int d = 0; d < 4; ++d)
#pragma unroll
        for (int r = 0; r < 16; ++r) o[d][r] = 0.f;
    float m = -1e30f, l = 0.f;
    const int kfo = (smap ? AT_K2 : AT_K1) + r32 * 128, khg = hi ^ ((r32 >> 1) & 7);
    int vfo[2][4];
    { const int q = (lane & 15) >> 2, pp = lane & 3, blk = (lane >> 4) & 1;
#pragma unroll
      for (int t = 0; t < 2; ++t)
#pragma unroll
          for (int d = 0; d < 4; ++d) vfo[t][d] = AT_V + 256 * (4 * hi + q + 8 * t) + 16 * (((d ^ q) << 2) | ((2 * blk + (pp >> 1)) ^ ((hi + 2 * t) & 3))) + 8 * (pp & 1); }
    const LAS float* bdl = (const LAS float*)(lds + AT_BIAS);
    const int qme = qw0 + r32;
#define AT_VREAD(VF, kk) do { _Pragma("unroll") for (int d = 0; d < 4; ++d) { \
                VF[2 * d] = __builtin_bit_cast(a_s16x4, __builtin_amdgcn_ds_read_tr16_b64_v4i16((LAS a_s16x4*)(sbv + vfo[0][d] + (kk) * 4096))); VF[2 * d + 1] = __builtin_bit_cast(a_s16x4, __builtin_amdgcn_ds_read_tr16_b64_v4i16((LAS a_s16x4*)(sbv + vfo[1][d] + (kk) * 4096))); } } while (0)
#define AT_PV(VF, PF, kk) do { _Pragma("unroll") for (int d = 0; d < 4; ++d) { const a_bf16x8 vf_ = (a_bf16x8){VF[2 * d][0], VF[2 * d][1], VF[2 * d][2], VF[2 * d][3], VF[2 * d + 1][0], VF[2 * d + 1][1], VF[2 * d + 1][2], VF[2 * d + 1][3]}; \
                o[d] = __builtin_amdgcn_mfma_f32_32x32x16_bf16(vf_, PF[kk], o[d], 0, 0, 0); } } while (0)
    int pbase = 0;
#pragma unroll 1
    for (int kt0 = 0; kt0 < nt; kt0 += 2) {
        const int nbase = pbase ? 0 : 2 * AT_ST;
#pragma unroll 1
      for (int sub = 0; sub < 2; ++sub) { const int kt = kt0 + sub; const int stoff = pbase + sub * AT_ST;
        if (sub == 0 && kt + 2 < nt) { AT_DMA(kt + 2, nbase); AT_DMA(kt + 3, nbase + AT_ST); }
        const int key0 = 64 * kt;
        if (key0 <= qw0 + 31) {
            const LAS unsigned char* sb = lds + stoff; const LAS unsigned char* sbv = sb;
            f32x16 p[2]; a_bf16x8 kf[8];
#pragma unroll
            for (int f = 0; f < 8; ++f) kf[f] = *(const LAS a_bf16x8*)(sb + kfo + (f >> 2) * 4096 + ((khg ^ (2 * (f & 3))) * 16));
            __builtin_amdgcn_sched_barrier(0);
            __builtin_amdgcn_s_setprio(1);
#pragma unroll
            for (int blk = 0; blk < 2; ++blk) {
#pragma unroll
                for (int r = 0; r < 16; ++r) p[blk][r] = 0.f;
#pragma unroll
                for (int ks = 0; ks < 4; ++ks) p[blk] = __builtin_amdgcn_mfma_f32_32x32x16_bf16(kf[blk * 4 + ks], qf[ks], p[blk], 0, 0, 0);
            }
            __builtin_amdgcn_s_setprio(0);
            if (key0 + 63 + 128 > qw0) {
#pragma unroll
                for (int blk = 0; blk < 2; ++blk) { float bvv[16];
#pragma unroll
                    for (int r = 0; r < 16; ++r) { const unsigned ud = (unsigned)(qme - (key0 + 32 * blk + crow16(r, hi))); bvv[r] = bdl[ud < 128u ? ud : 128u]; }
                    asm volatile("" : "+v"(bvv[0]), "+v"(bvv[1]), "+v"(bvv[2]), "+v"(bvv[3]), "+v"(bvv[4]), "+v"(bvv[5]), "+v"(bvv[6]), "+v"(bvv[7]), "+v"(bvv[8]), "+v"(bvv[9]), "+v"(bvv[10]), "+v"(bvv[11]), "+v"(bvv[12]), "+v"(bvv[13]), "+v"(bvv[14]), "+v"(bvv[15]));
#pragma unroll
                    for (int r = 0; r < 16; ++r) { const int dist = qme - (key0 + 32 * blk + crow16(r, hi)); p[blk][r] = dist < 0 ? -1e30f : p[blk][r] + bvv[r]; } }
            }
            float mx = p[0][0];
#pragma unroll
            for (int r = 1; r < 16; ++r) mx = fmaxf(mx, p[0][r]);
#pragma unroll
            for (int r = 0; r < 16; ++r) mx = fmaxf(mx, p[1][r]);
            { const auto sw_ = __builtin_amdgcn_permlane32_swap(__builtin_bit_cast(unsigned, mx), __builtin_bit_cast(unsigned, mx), false, false);
              mx = fmaxf(__builtin_bit_cast(float, sw_[0]), __builtin_bit_cast(float, sw_[1])); }
            if (__any(mx > m + 8.0f)) {
                const float mn = fmaxf(m, mx), al = __builtin_amdgcn_exp2f(m - mn); m = mn; l *= al;
#pragma unroll
                for (int d = 0; d < 4; ++d)
#pragma unroll
                    for (int r = 0; r < 16; ++r) o[d][r] *= al;
            }
            float ls = 0.f;
#define AT_EXPPK(PF, kk) do { const int blk_ = (kk) >> 1, s8_ = 8 * ((kk) & 1); float e_[8]; _Pragma("unroll") for (int j = 0; j < 8; ++j) { e_[j] = __builtin_amdgcn_exp2f(p[blk_][s8_ + j] - m); ls += e_[j]; } \
                v4u w_; w_.x = cvtpk(e_[0], e_[1]); w_.y = cvtpk(e_[2], e_[3]); w_.z = cvtpk(e_[4], e_[5]); w_.w = cvtpk(e_[6], e_[7]); PF[kk] = __builtin_bit_cast(a_bf16x8, w_); } while (0)
            {
                a_bf16x8 pf[4]; a_s16x4 vA[8], vB[8];
                AT_VREAD(vA, 0); AT_EXPPK(pf, 0);
                __builtin_amdgcn_sched_barrier(0);
                AT_VREAD(vB, 1); AT_PV(vA, pf, 0); AT_EXPPK(pf, 1);
                __builtin_amdgcn_sched_barrier(0);
                AT_VREAD(vA, 2); AT_PV(vB, pf, 1); AT_EXPPK(pf, 2);
                __builtin_amdgcn_sched_barrier(0);
                AT_VREAD(vB, 3); AT_PV(vA, pf, 2); AT_EXPPK(pf, 3);
                __builtin_amdgcn_sched_barrier(0);
                AT_PV(vB, pf, 3);
            }
            l += ls;
#undef AT_EXPPK
        }
      }
        __syncthreads();
        pbase = nbase;
    }
#undef AT_VREAD
#undef AT_PV
#undef AT_DMA
    l += __shfl_xor(l, 32);
    LAS float* comb = (LAS float*)(lds + AT_COMB) + qs * 4096;
    if (smap == 1) { const float sc = lam * frcp(l);
#pragma unroll
        for (int d = 0; d < 4; ++d)
#pragma unroll
            for (int r = 0; r < 16; ++r) comb[(d * 16 + r) * 64 + lane] = o[d][r] * sc; }
    __syncthreads();
    if (smap == 0) {
        const float il = frcp(l); float ss = 0.f;
#pragma unroll
        for (int d = 0; d < 4; ++d)
#pragma unroll
            for (int r = 0; r < 16; ++r) { const float v = o[d][r] * il - comb[(d * 16 + r) * 64 + lane]; o[d][r] = v; ss += v * v; }
        ss += __shfl_xor(ss, 32);
        const float rs = frsq(ss * (1.f / 128.f) + 1e-5f) * (1.0f - lam_init);
        const float* sl = A->in[32] + i * 128;
        bf16* orow = O + (rowb + qw0 + r32) * D + h * 128;
#pragma unroll
        for (int d = 0; d < 4; ++d)
#pragma unroll
            for (int g4 = 0; g4 < 4; ++g4) { const int dc = 32 * d + 8 * g4 + 4 * hi; const f32x4 s4 = *(const GAS f32x4*)(sl + dc);
                v2u w; w.x = cvtpk(o[d][4 * g4] * rs * s4.x, o[d][4 * g4 + 1] * rs * s4.y); w.y = cvtpk(o[d][4 * g4 + 2] * rs * s4.z, o[d][4 * g4 + 3] * rs * s4.w);
                *(GAS v2u*)(orow + dc) = w; }
    }
    __syncthreads();
}

template <bool HALFSYNC = false> __device__ __forceinline__ void attn_phase_mfma(ArgP A, int L, LAS unsigned char* lds, int tid, int G, int bid) {
    const int lane = tid & 63, i = L >> 1;
    const float lam_init = 0.8f - 0.6f * fexp(-0.3f * (float)L);
    const float lam = fexp(wave_sum(A->in[28][i * 64 + lane] * A->in[29][i * 64 + lane])) - fexp(wave_sum(A->in[30][i * 64 + lane] * A->in[31][i * 64 + lane])) + lam_init;
    if (G == 256) {
        const int v = (bid & 7) * 32 + (bid >> 3), bh = v >> 2, j = v & 3;
#pragma unroll 1
        for (int u = 0; u < 8; ++u) { const int qb = 8 * (u >> 1) + ((u & 1) ? 7 - j : j); attn_unit_mfma<HALFSYNC>(A, L, bh >> 3, bh & 7, qb, lam, lam_init, lds, tid); }
    } else {
#pragma unroll 1
        for (int u = bid; u < 64 * 32; u += G) attn_unit_mfma<HALFSYNC>(A, L, (u >> 5) >> 3, (u >> 5) & 7, 31 - (u & 31), lam, lam_init, lds, tid);
    }
}
typedef short bf16x8_t __attribute__((ext_vector_type(8)));
constexpr int MS = 72, MB = 64 * MS * 2;
constexpr int RW_XW = 8 * MB, RW_XA = RW_XW + 16384;
constexpr int RW_TOT = 14 * MB, RW_GAM = RW_TOT + 2048, RW_END = RW_GAM + 256;
static_assert(RW_XA + 16384 <= 12 * MB && RW_END <= RING_BYTES, "RWKV LDS map");
constexpr size_t WS_RWI = 336 * MiB;
constexpr size_t WS_BON = 30 * MiB;
#define RBUF(k) ((LAS bf16*)(lds + (k) * MB))
__device__ __forceinline__ f32x4 mfma16(bf16x8_t a, bf16x8_t b, f32x4 c) { return __builtin_amdgcn_mfma_f32_16x16x32_bf16(a, b, c, 0, 0, 0); }
__device__ __forceinline__ bf16x8_t ldfrag(const LAS bf16* Mx, int row0, int k0, int lane) { return *(const LAS bf16x8_t*)(Mx + (row0 + (lane & 15)) * MS + k0 + 8 * (lane >> 4)); }
__device__ __forceinline__ f32x4 mm64(f32x4 acc, const LAS bf16* Am, int ra, const LAS bf16* BTm, int cb, int lane) {
    acc = mfma16(ldfrag(Am, 16 * ra, 0, lane), ldfrag(BTm, 16 * cb, 0, lane), acc);
    return mfma16(ldfrag(Am, 16 * ra, 32, lane), ldfrag(BTm, 16 * cb, 32, lane), acc);
}
__device__ __forceinline__ v2u pack4(f32x4 a) { v2u w; w.x = cvtpk(a[0], a[1]); w.y = cvtpk(a[2], a[3]); return w; }
__device__ __forceinline__ void tstore(LAS bf16* Dm, int rt, int ct, f32x4 acc, int lane) { *(LAS v2u*)(Dm + (16 * ct + (lane & 15)) * MS + 16 * rt + 4 * (lane >> 4)) = pack4(acc); }
__device__ __forceinline__ void tstore_g(bf16* Dg, int rt, int ct, f32x4 acc, int lane) { *(GAS v2u*)(Dg + (16 * ct + (lane & 15)) * 64 + 16 * rt + 4 * (lane >> 4)) = pack4(acc); }
__device__ __forceinline__ f32x4 ld4bf(const LAS bf16* p) { const v2u w = *(const LAS v2u*)p; return (f32x4){bflo(w.x), bfhi(w.x), bflo(w.y), bfhi(w.y)}; }
__device__ __forceinline__ f32x4 ld4bf_g(const bf16* p) { const v2u w = *(const GAS v2u*)p; return (f32x4){bflo(w.x), bfhi(w.x), bflo(w.y), bfhi(w.y)}; }
__device__ __forceinline__ void unpack8(v4u w, float (&f)[8]) { f[0] = bflo(w.x); f[1] = bfhi(w.x); f[2] = bflo(w.y); f[3] = bfhi(w.y); f[4] = bflo(w.z); f[5] = bfhi(w.z); f[6] = bflo(w.w); f[7] = bfhi(w.w); }
__device__ __forceinline__ bf16x8_t pack8(const float (&f)[8]) { v4u w; w.x = cvtpk(f[0], f[1]); w.y = cvtpk(f[2], f[3]); w.z = cvtpk(f[4], f[5]); w.w = cvtpk(f[6], f[7]); return __builtin_bit_cast(bf16x8_t, w); }

__device__ __forceinline__ void rwkv_chunk_phase(ArgP A, int L, LAS unsigned char* lds, int tid, int G, int bid) {
    const int lane = tid & 63, wave = __builtin_amdgcn_readfirstlane(tid >> 6), i = L >> 1;
    const int l15 = lane & 15, lg = lane >> 4;
    const bf16* P = (const bf16*)(A->ws + WS_P); bf16* XNb = (bf16*)(A->ws + WS_XN);
    const int rt = wave >> 1, ct0 = 2 * (wave & 1);
    constexpr int NIT = BATCH * 64 * 8;
    v4u pw[2][2], pa[2][2]; unsigned short pe[9][3];
#define R1_PREFETCH(itx) do { const int b_ = (itx) >> 9, n_ = ((itx) >> 3) & 63, h_ = (itx) & 7; const size_t rowb_ = (size_t)b_ * T + 64 * n_; \
        { const int tt_ = 16 * rt + l15; const bf16* prow_ = P + (rowb_ + tt_) * NIN_E; const bool hp_ = (64 * n_ + tt_) > 0; const v4u z4_ = (v4u){0u, 0u, 0u, 0u}; \
          _Pragma("unroll") for (int q = 0; q < 2; ++q) { const int kc_ = 32 * q + 8 * lg; pw[q][0] = *(const GAS v4u*)(prow_ + PC_W1A + kc_); pw[q][1] = hp_ ? *(const GAS v4u*)(prow_ - NIN_E + PC_W1B + kc_) : z4_; \
              pa[q][0] = *(const GAS v4u*)(prow_ + PC_A1A + kc_); pa[q][1] = hp_ ? *(const GAS v4u*)(prow_ - NIN_E + PC_A1B + kc_) : z4_; } \
          } \
        { const int c_ = 64 * h_ + lane; const size_t row0_ = rowb_ + 8 * wave; const bool hp_ = (64 * n_ + 8 * wave) > 0; \
          _Pragma("unroll") for (int u = 0; u < 9; ++u) { const bf16* pp_ = P + (row0_ + u - 1) * NIN_E; const bool ok_ = u > 0 || hp_; \
              pe[u][0] = ok_ ? pp_[PC_R + c_] : (unsigned short)0; pe[u][1] = ok_ ? pp_[PC_K + c_] : (unsigned short)0; pe[u][2] = ok_ ? pp_[PC_V + c_] : (unsigned short)0; } } } while (0)
    if (bid < NIT) R1_PREFETCH(bid);
#pragma unroll 1
    for (int it = bid; it < NIT; it += G) {
    const int b = it >> 9, n = (it >> 3) & 63, h = it & 7;
    const size_t rowb = (size_t)b * T + 64 * n;
    bf16* item = (bf16*)(A->ws + WS_RWI) + ((size_t)((b * 8 + h) * 64 + n)) * 16384;
    asm volatile("; MARK_R1_E1");
    {
        const bf16* W2T = (const bf16*)(A->ws + WS_W2T); const bf16* A2T = (const bf16*)(A->ws + WS_A2T);
        f32x4 xw[2], xa[2];
#pragma unroll
        for (int c = 0; c < 2; ++c) { xw[c] = (f32x4){0.f, 0.f, 0.f, 0.f}; xa[c] = (f32x4){0.f, 0.f, 0.f, 0.f}; }
#pragma unroll
        for (int q = 0; q < 2; ++q) {
            const int kc = 32 * q + 8 * lg; float x[8], y[8], v[8];
            unpack8(pw[q][0], x); unpack8(pw[q][1], y);
#pragma unroll
            for (int e = 0; e < 8; ++e) v[e] = tanh_f(x[e] + y[e]);
            const bf16x8_t fw = pack8(v);
            unpack8(pa[q][0], x); unpack8(pa[q][1], y);
#pragma unroll
            for (int e = 0; e < 8; ++e) v[e] = x[e] + y[e];
            const bf16x8_t fa = pack8(v);
#pragma unroll
            for (int c = 0; c < 2; ++c) { const size_t wo = (size_t)(64 * h + 16 * (ct0 + c) + l15) * 64 + kc;
                xw[c] = mfma16(fw, *(const GAS bf16x8_t*)(W2T + wo), xw[c]); xa[c] = mfma16(fa, *(const GAS bf16x8_t*)(A2T + wo), xa[c]); }
        }
        LAS float* XW = (LAS float*)(lds + RW_XW); LAS float* XA = (LAS float*)(lds + RW_XA);
#pragma unroll
        for (int c = 0; c < 2; ++c)
#pragma unroll
            for (int r = 0; r < 4; ++r) { const int o = (16 * rt + 4 * lg + r) * 64 + 16 * (ct0 + c) + l15; XW[o] = xw[c][r]; XA[o] = xa[c][r]; }
    }
    LDS_BARRIER();
    asm volatile("; MARK_R1_E2");
    {
        const int c = 64 * h + lane;
        const float* mu = A->in[7] + (size_t)i * 1536;
        const float mur = mu[c], muk = mu[512 + c], muv = mu[1024 + c];
        const float kkc = A->in[17][i * 512 + c], kac = A->in[18][i * 512 + c], rkc = A->in[19][i * 512 + c], w0c = A->in[9][i * 512 + c], a0c = A->in[12][i * 512 + c];
        const LAS float* XW = (const LAS float*)(lds + RW_XW); const LAS float* XA = (const LAS float*)(lds + RW_XA);
        float* BON = (float*)(A->ws + WS_BON);
        const int tt0 = 8 * wave; const size_t row0 = rowb + tt0;
        float pr_p = bf2f(pe[0][0]), pk_p = bf2f(pe[0][1]), pv_p = bf2f(pe[0][2]);
        float rr[8], av[8], bv[8], km[8], vv[8], lc[8];
        float run = 0.f;
#pragma unroll
        for (int u = 0; u < 8; ++u) {
            const float pR = bf2f(pe[u + 1][0]), pK = bf2f(pe[u + 1][1]), pV = bf2f(pe[u + 1][2]);
            const float r = pR + (pr_p - pR) * mur, k = pK + (pk_p - pK) * muk, v = pV + (pv_p - pV) * muv; pr_p = pR; pk_p = pK; pv_p = pV;
            const float xw = w0c + XW[(tt0 + u) * 64 + lane], xa = a0c + XA[(tt0 + u) * 64 + lane];
            const float wlog = -0.6065306597126334f * sigmoid_f(xw), as = sigmoid_f(xa);
            float kk = k * kkc; const float n2 = wave_sum(kk * kk); kk = kk * frsq(fmaxf(n2, 1e-24f));
            const float kmod = k * (1.f + (as - 1.f) * kac);
            const float bon = wave_sum(r * kmod * rkc);
            if (lane == 0) BON[(row0 + u) * 8 + h] = bon;
            run += wlog; rr[u] = r; av[u] = -kk; bv[u] = kk * as; km[u] = kmod; vv[u] = v; lc[u] = run;
        }
        LAS float* TOT = (LAS float*)(lds + RW_TOT);
        TOT[wave * 64 + lane] = run;
        LDS_BARRIER();
        float off = 0.f, tot = 0.f;
#pragma unroll
        for (int w2 = 0; w2 < 8; ++w2) { const float tv = TOT[w2 * 64 + lane]; tot += tv; if (w2 < wave) off += tv; }
        if (wave == 0) ((LAS float*)(lds + RW_GAM))[lane] = fexp(tot);
        float fR[8], fA[8], fB[8], fK[8];
        float eprev = fexp(off);
#pragma unroll
        for (int u = 0; u < 8; ++u) { const float cum = off + lc[u], e1 = fexp(cum), ei = frcp(e1); fR[u] = rr[u] * e1; fA[u] = av[u] * eprev; fB[u] = bv[u] * ei; fK[u] = km[u] * ei; eprev = e1; }
        LAS bf16* At = RBUF(0); LAS bf16* Bt = RBUF(1); LAS bf16* Kt = RBUF(2); LAS bf16* Rt = RBUF(3);
#pragma unroll
        for (int u = 0; u < 8; ++u) { const int o = (tt0 + u) * MS + lane; At[o] = (bf16)f2bf(fA[u]); Bt[o] = (bf16)f2bf(fB[u]); Kt[o] = (bf16)f2bf(fK[u]); Rt[o] = (bf16)f2bf(fR[u]); }
        *(LAS bf16x8_t*)(RBUF(4) + lane * MS + tt0) = pack8(fA); *(LAS bf16x8_t*)(RBUF(5) + lane * MS + tt0) = pack8(fB);
        *(LAS bf16x8_t*)(RBUF(6) + lane * MS + tt0) = pack8(fK); *(LAS bf16x8_t*)(RBUF(7) + lane * MS + tt0) = pack8(vv);
    }
    asm volatile("" ::: "memory");
    if (it + G < NIT) R1_PREFETCH(it + G);
    LDS_BARRIER();
    asm volatile("; MARK_R1_G");
    {
        const LAS bf16* At = RBUF(0); const LAS bf16* Bt = RBUF(1); const LAS bf16* Kt = RBUF(2); const LAS bf16* Rt = RBUF(3);
#pragma unroll
        for (int c = 0; c < 2; ++c) { const int ct = ct0 + c; const f32x4 z = (f32x4){0.f, 0.f, 0.f, 0.f};
            f32x4 aL = mm64(z, Bt, rt, At, ct, lane);
            f32x4 aLT = mm64(z, At, rt, Bt, ct, lane);
            f32x4 aAK = mm64(z, Kt, rt, At, ct, lane);
            f32x4 aRB = mm64(z, Bt, rt, Rt, ct, lane);
            f32x4 aRK = mm64(z, Kt, rt, Rt, ct, lane);
            const int col = 16 * ct + l15;
#pragma unroll
            for (int r = 0; r < 4; ++r) { const int row = 16 * rt + 4 * lg + r;
                if (!(row < col)) { aL[r] = 0.f; aAK[r] = 0.f; }
                if (!(col < row)) aLT[r] = 0.f;
                if (!(row <= col)) { aRB[r] = 0.f; aRK[r] = 0.f; } }
            tstore(RBUF(8), rt, ct, aL, lane); tstore(RBUF(9), rt, ct, aLT, lane); tstore(RBUF(10), rt, ct, aAK, lane); tstore(RBUF(11), rt, ct, aRB, lane); tstore(RBUF(12), rt, ct, aRK, lane);
        }
    }
    LDS_BARRIER();
    asm volatile("; MARK_R1_N");
    {
    {
        for (int e = tid; e < 64 * 16; e += NTHREADS) { const int row = e >> 4, c4 = (e & 15) * 4; v2u w = *(const LAS v2u*)(RBUF(8) + row * MS + c4);
            if ((row >> 2) == (c4 >> 2)) { const unsigned one = 0x3f80u; const int p = row & 3; if (p == 0) w.x = (w.x & 0xffff0000u) | one; else if (p == 1) w.x = (w.x & 0xffffu) | (one << 16); else if (p == 2) w.y = (w.y & 0xffff0000u) | one; else w.y = (w.y & 0xffffu) | (one << 16); }
            *(LAS v2u*)(RBUF(0) + row * MS + c4) = w; }
    }
#define RW_SQUARE(Min, MTin, Mout, MTout) do { _Pragma("unroll") for (int c = 0; c < 2; ++c) { const int ct = ct0 + c; const f32x4 z = (f32x4){0.f, 0.f, 0.f, 0.f}; \
        tstore(RBUF(Mout), rt, ct, mm64(z, RBUF(MTin), rt, RBUF(Min), ct, lane), lane);        \
        tstore(RBUF(MTout), rt, ct, mm64(z, RBUF(Min), rt, RBUF(MTin), ct, lane), lane); } } while (0)
#define RW_YSTEP(Yin, MTin, Yout) do { _Pragma("unroll") for (int c = 0; c < 2; ++c) { const int ct = ct0 + c; \
        const f32x4 y0 = ld4bf(RBUF(Yin) + (16 * ct + l15) * MS + 16 * rt + 4 * lg);            \
        tstore(RBUF(Yout), rt, ct, mm64(y0, RBUF(MTin), rt, RBUF(Yin), ct, lane), lane); } } while (0)
    RW_SQUARE(8, 9, 2, 13);
    LDS_BARRIER();
    RW_YSTEP(0, 13, 1); RW_SQUARE(2, 13, 8, 9);
    LDS_BARRIER();
    RW_YSTEP(1, 9, 0); RW_SQUARE(8, 9, 2, 13);
    LDS_BARRIER();
    RW_YSTEP(0, 13, 1); RW_SQUARE(2, 13, 8, 9);
    LDS_BARRIER();
    RW_YSTEP(1, 9, 0); RW_SQUARE(8, 9, 2, 13);
    LDS_BARRIER();
    RW_YSTEP(0, 13, 1);
    {
#pragma unroll
        for (int c = 0; c < 2; ++c) { const int ct = ct0 + c; tstore(RBUF(9), rt, ct, mm64((f32x4){0.f, 0.f, 0.f, 0.f}, RBUF(10), rt, RBUF(7), ct, lane), lane); }
    }
    LDS_BARRIER();
    }
#undef RW_SQUARE
#undef RW_YSTEP
    asm volatile("; MARK_R1_F1");
    {
    {
#pragma unroll
        for (int c = 0; c < 2; ++c) { const int ct = ct0 + c; const f32x4 z = (f32x4){0.f, 0.f, 0.f, 0.f};
            tstore(RBUF(8), rt, ct, mm64(z, RBUF(1), rt, RBUF(4), ct, lane), lane);
            tstore(RBUF(0), rt, ct, mm64(z, RBUF(1), rt, RBUF(9), ct, lane), lane); }
    }
    LDS_BARRIER();
    {
        const LAS float* GAM = (const LAS float*)(lds + RW_GAM);
#pragma unroll
        for (int c = 0; c < 2; ++c) { const int ct = ct0 + c; const f32x4 z = (f32x4){0.f, 0.f, 0.f, 0.f};
            const f32x4 r0 = ld4bf(RBUF(3) + (16 * ct + l15) * MS + 16 * rt + 4 * lg);
            tstore_g(item, rt, ct, mm64(r0, RBUF(8), rt, RBUF(11), ct, lane), lane);
            f32x4 pp = mm64(z, RBUF(8), rt, RBUF(5), ct, lane);
            const float gm = GAM[16 * ct + l15];
#pragma unroll
            for (int r = 0; r < 4; ++r) pp[r] = gm * (pp[r] + ((16 * rt + 4 * lg + r) == (16 * ct + l15) ? 1.f : 0.f));
            *(GAS v2u*)(item + 8192 + (((ct * 2 + (rt >> 1)) * 64 + lane) * 8 + 4 * (rt & 1))) = pack4(pp);
            f32x4 y0 = mm64(z, RBUF(0), rt, RBUF(11), ct, lane); y0 = mm64(y0, RBUF(7), rt, RBUF(12), ct, lane);
            tstore_g(item + 4096, rt, ct, y0, lane);
            f32x4 q = mm64(z, RBUF(5), rt, RBUF(0), ct, lane); q = mm64(q, RBUF(6), rt, RBUF(7), ct, lane);
            const f32x4 g4 = *(const LAS f32x4*)(GAM + 16 * rt + 4 * lg);
            q = q * g4;
            *(GAS v2u*)(item + 12288 + (((ct * 4 + rt) * 64 + lane) * 4)) = pack4(q); }
    }
    LDS_BARRIER();
    }
    }
#undef R1_PREFETCH
}

constexpr int R2_NS = 8, R2_STB = 16384;
static_assert(R2_NS * R2_STB <= RING_BYTES, "scan ring");
__device__ __forceinline__ void rwkv_state_scan(ArgP A, int b, int h, LAS unsigned char* lds, int wave, int lane) {
    const int l15 = lane & 15, lg = lane >> 4, dw = wave & 3;
    unsigned char* item0 = (unsigned char*)(A->ws + WS_RWI) + ((size_t)((b * 8 + h) * 64)) * 32768;
#define R2_DMA(nn) do { const unsigned char* g_ = item0 + (size_t)(nn) * 32768 + 16384 + dw * 4096 + lane * 16; LAS unsigned char* s_ = lds + ((nn) & (R2_NS - 1)) * R2_STB + dw * 4096; \
        _Pragma("unroll") for (int p = 0; p < 4; ++p) __builtin_amdgcn_global_load_lds((const unsigned*)(g_ + p * 1024), (LAS unsigned*)(s_ + p * 1024), 16, 0, 0); } while (0)
    if (wave >= 4) {
#pragma unroll
        for (int n = 0; n < R2_NS - 1; ++n) R2_DMA(n); }
    f32x4 S[4]; float zz_ = 0.f; asm volatile("" : "+v"(zz_));
#pragma unroll
    for (int t = 0; t < 4; ++t) S[t] = (f32x4){zz_, zz_, zz_, zz_};
#pragma unroll 1
    for (int n = 0; n < 64; ++n) {
        if (wave >= 4) { if (n <= 64 - (R2_NS - 1)) asm volatile("s_waitcnt vmcnt(24)" ::: "memory"); else asm volatile("s_waitcnt vmcnt(0)" ::: "memory"); }
        __builtin_amdgcn_s_barrier();
#ifdef PROBE_R2HALF
        if (n == PROBE_R2HALF && b == 0 && h == 0 && wave == 0 && lane == 0) { unsigned long long* t_ = (unsigned long long*)((unsigned*)(A->ws + WS_CTL) + 32768) + 41; if (*t_ == 0ull) *t_ = __builtin_amdgcn_s_memrealtime(); }
#endif
        if (wave >= 4) { if (n + R2_NS - 1 < 64) R2_DMA(n + R2_NS - 1); }
        else {
            const LAS unsigned char* st = lds + (n & (R2_NS - 1)) * R2_STB;
            v4u pf[8]; v2u qv[4];
#pragma unroll
            for (int f = 0; f < 8; ++f) pf[f] = *(const LAS v4u*)(st + (f * 64 + lane) * 16);
#pragma unroll
            for (int t = 0; t < 4; ++t) qv[t] = *(const LAS v2u*)(st + 8192 + ((dw * 4 + t) * 64 + lane) * 8);
            unsigned pk[4][2];
#pragma unroll
            for (int t = 0; t < 4; ++t) { pk[t][0] = cvtpk(S[t][0], S[t][1]); pk[t][1] = cvtpk(S[t][2], S[t][3]); }
            bf16* SN = (bf16*)(item0 + (size_t)n * 32768 + 24576);
#pragma unroll
            for (int t = 0; t < 4; ++t) *(GAS v2u*)(SN + (((dw * 2 + (t >> 1)) * 64 + (2 * (t & 1) + (lg >> 1)) * 16 + l15) * 8 + 4 * (lg & 1))) = (v2u){pk[t][0], pk[t][1]};
            const bf16x8_t b0 = __builtin_bit_cast(bf16x8_t, (v4u){pk[0][0], pk[0][1], pk[1][0], pk[1][1]}), b1 = __builtin_bit_cast(bf16x8_t, (v4u){pk[2][0], pk[2][1], pk[3][0], pk[3][1]});
#pragma unroll
            for (int t = 0; t < 4; ++t) { f32x4 acc = (f32x4){bflo(qv[t].x), bfhi(qv[t].x), bflo(qv[t].y), bfhi(qv[t].y)};
                acc = mfma16(__builtin_bit_cast(bf16x8_t, pf[2 * t]), b0, acc); acc = mfma16(__builtin_bit_cast(bf16x8_t, pf[2 * t + 1]), b1, acc); S[t] = acc; }
        }
    }
#undef R2_DMA
}

__device__ __forceinline__ void rwkv_out_phase(ArgP A, int L, int wt0, int wtstride, int lane) {
    const int i = L >> 1, l15 = lane & 15, lg = lane >> 4;
    const bf16* P = (const bf16*)(A->ws + WS_P); bf16* XNb = (bf16*)(A->ws + WS_XN); const float* BON = (const float*)(A->ws + WS_BON);
    int hcur = -1; v4u g2f[5][4]; f32x4 w4[4], b4[4], m4[4];
#pragma unroll 1
    for (int wt = wt0; wt < BATCH * 64 * 8 * 4; wt += wtstride) {
    const int it_ = wt >> 2, ct = wt & 3, b = it_ >> 9, n = (it_ >> 3) & 63, h = it_ & 7;
    if (h != hcur) { hcur = h;
        const bf16* G2T = (const bf16*)(A->ws + WS_G2T) + (size_t)(64 * h + l15) * 192 + 8 * lg;
#pragma unroll
        for (int q = 0; q < 5; ++q)
#pragma unroll
            for (int it = 0; it < 4; ++it) g2f[q][it] = *(const GAS v4u*)(G2T + (size_t)(16 * it) * 192 + 32 * q);
        const float* lnw = A->in[20] + i * 512 + 64 * h; const float* lnb = A->in[21] + i * 512 + 64 * h; const float* mu = A->in[7] + (size_t)i * 1536 + 1024 + 64 * h;
#pragma unroll
        for (int it = 0; it < 4; ++it) { const int i0 = 16 * it + 4 * lg; w4[it] = *(const GAS f32x4*)(lnw + i0); b4[it] = *(const GAS f32x4*)(lnb + i0); m4[it] = *(const GAS f32x4*)(mu + i0); } }
    const bf16* item = (const bf16*)(A->ws + WS_RWI) + ((size_t)((b * 8 + h) * 64 + n)) * 16384;
    const bf16* RH = item; const bf16* Y0 = item + 4096; const bf16* ST = item + 12288;
    const size_t row = (size_t)b * T + 64 * n + 16 * ct + l15; const int tseq = 64 * n + 16 * ct + l15;
    const bf16x8_t rf0 = *(const GAS bf16x8_t*)(RH + (16 * ct + l15) * 64 + 8 * lg), rf1 = *(const GAS bf16x8_t*)(RH + (16 * ct + l15) * 64 + 32 + 8 * lg);
    const bf16* prow = P + row * NIN_E; v4u gx[5], gy[5];
#pragma unroll
    for (int q = 0; q < 5; ++q) { gx[q] = *(const GAS v4u*)(prow + PC_G1A + 32 * q + 8 * lg); gy[q] = tseq > 0 ? *(const GAS v4u*)(prow - NIN_E + PC_G1B + 32 * q + 8 * lg) : (v4u){0u, 0u, 0u, 0u}; }
    const bf16* pr = prow + PC_V + 64 * h; v2u pvr[4], pvq[4];
#pragma unroll
    for (int it = 0; it < 4; ++it) { const int i0 = 16 * it + 4 * lg; pvr[it] = *(const GAS v2u*)(pr + i0); pvq[it] = tseq > 0 ? *(const GAS v2u*)(pr - NIN_E + i0) : (v2u){0u, 0u}; }
    const float bon = BON[row * 8 + h];
    f32x4 acc[4]; float s1 = 0.f;
#pragma unroll
    for (int it = 0; it < 4; ++it) {
        f32x4 a = ld4bf_g(Y0 + (16 * ct + l15) * 64 + 16 * it + 4 * lg);
        a = mfma16(*(const GAS bf16x8_t*)(ST + ((it * 2 + 0) * 64 + lane) * 8), rf0, a);
        a = mfma16(*(const GAS bf16x8_t*)(ST + ((it * 2 + 1) * 64 + lane) * 8), rf1, a);
        acc[it] = a; s1 += (a[0] + a[1]) + (a[2] + a[3]);
    }
    s1 += __shfl_xor(s1, 16); s1 += __shfl_xor(s1, 32);
    const float mean = s1 * (1.f / 64.f); float s2 = 0.f;
#pragma unroll
    for (int it = 0; it < 4; ++it) { acc[it] = acc[it] - mean; s2 += (acc[it][0] * acc[it][0] + acc[it][1] * acc[it][1]) + (acc[it][2] * acc[it][2] + acc[it][3] * acc[it][3]); }
    s2 += __shfl_xor(s2, 16); s2 += __shfl_xor(s2, 32);
    const float rs = frsq(s2 * (1.f / 64.f) + 64e-5f);
    f32x4 gq[4] = {(f32x4){0.f, 0.f, 0.f, 0.f}, (f32x4){0.f, 0.f, 0.f, 0.f}, (f32x4){0.f, 0.f, 0.f, 0.f}, (f32x4){0.f, 0.f, 0.f, 0.f}};
#pragma unroll
    for (int q = 0; q < 5; ++q) { float x[8], y[8], v[8]; unpack8(gx[q], x); unpack8(gy[q], y);
#pragma unroll
        for (int e = 0; e < 8; ++e) v[e] = sigmoid_f(x[e] + y[e]);
        const bf16x8_t fg = pack8(v);
#pragma unroll
        for (int it = 0; it < 4; ++it) gq[it] = mfma16(__builtin_bit_cast(bf16x8_t, g2f[q][it]), fg, gq[it]); }
#pragma unroll
    for (int it = 0; it < 4; ++it) { const int i0 = 16 * it + 4 * lg;
        const f32x4 pv = (f32x4){bflo(pvr[it].x), bfhi(pvr[it].x), bflo(pvr[it].y), bfhi(pvr[it].y)}, pvp = (f32x4){bflo(pvq[it].x), bfhi(pvq[it].x), bflo(pvq[it].y), bfhi(pvq[it].y)};
        const f32x4 v4 = pv + (pvp - pv) * m4[it];
        const f32x4 o = ((acc[it] * rs) * w4[it] + b4[it] + v4 * bon) * gq[it];
        *(GAS v2u*)(XNb + row * D + 64 * h + i0) = pack4(o); }
    }
}
constexpr size_t WS_GKV = 464 * MiB;
constexpr size_t WS_GDEC = 29 * MiB + 512 * 1024;
constexpr int GL_LA = 0, GL_KR = 16384, GL_VT = GL_KR + MB, GL_TOT = GL_VT + 2 * MB, GL1_END = GL_TOT + 2048;
static_assert(GL1_END <= RING_BYTES, "GLA LDS map");

template <int NCT> __device__ __forceinline__ void gla_lora_tiles(ArgP A, size_t rowb, int h4, int rt, int ct0, LAS float* LAs, int lane) {
    const int l15 = lane & 15, lg = lane >> 4;
    const bf16* P = (const bf16*)(A->ws + WS_P); const bf16* WA2T = (const bf16*)(A->ws + WS_WA2T);
    v4u av = (v4u){0u, 0u, 0u, 0u};
    if (lg < 2) av = *(const GAS v4u*)(P + (rowb + 16 * rt + l15) * NIN_E + PC_WA1 + 8 * lg);
    const bf16x8_t af = __builtin_bit_cast(bf16x8_t, av);
#pragma unroll
    for (int c = 0; c < NCT; ++c) { const int ct = ct0 + c;
        const f32x4 x = mfma16(af, *(const GAS bf16x8_t*)(WA2T + (size_t)(64 * h4 + 16 * ct + l15) * 32 + 8 * lg), (f32x4){0.f, 0.f, 0.f, 0.f});
#pragma unroll
        for (int r = 0; r < 4; ++r) LAs[(16 * rt + 4 * lg + r) * 64 + 16 * ct + l15] = x[r]; }
}

__device__ __forceinline__ void gla_kv_item(ArgP A, int L, int b, int n, int h4, LAS unsigned char* lds, int tid) {
    const int lane = tid & 63, wave = __builtin_amdgcn_readfirstlane(tid >> 6), i = L >> 1, l15 = lane & 15, lg = lane >> 4;
    const bf16* P = (const bf16*)(A->ws + WS_P);
    const size_t rowb = (size_t)b * T + 64 * n; const int itemi = (b * 64 + n) * 4 + h4;
    LAS float* LAs = (LAS float*)(lds + GL_LA); LAS bf16* KrT = (LAS bf16*)(lds + GL_KR); LAS bf16* VTm = (LAS bf16*)(lds + GL_VT); LAS float* TOT = (LAS float*)(lds + GL_TOT);
    gla_lora_tiles<2>(A, rowb, h4, wave >> 1, 2 * (wave & 1), LAs, lane);
    __syncthreads();
    {
        const int c = 64 * h4 + lane, tt0 = 8 * wave; const float bac = A->in[24][i * 256 + c];
        float lc[8], kx[8], qx[8], v0[8], v1[8]; float run = 0.f;
#pragma unroll
        for (int u = 0; u < 8; ++u) { const bf16* pr = P + (rowb + tt0 + u) * NIN_E; const float x = bac + LAs[(tt0 + u) * 64 + lane];
            run += -softplus_f(-x) * (1.0f / 16.0f); lc[u] = run; kx[u] = bf2f(pr[PC_GK + c]); qx[u] = bf2f(pr[PC_GQ + c]); v0[u] = bf2f(pr[PC_GV + 128 * h4 + lane]); v1[u] = bf2f(pr[PC_GV + 128 * h4 + 64 + lane]); }
        TOT[wave * 64 + lane] = run;
        __syncthreads();
        float off = 0.f, tot = 0.f;
#pragma unroll
        for (int w2 = 0; w2 < 8; ++w2) { const float tv = TOT[w2 * 64 + lane]; tot += tv; if (w2 < wave) off += tv; }
        if (wave == 0) ((float*)(A->ws + WS_GDEC))[itemi * 64 + lane] = fexp(tot);
        { bf16* Pw = (bf16*)(A->ws + WS_P); const float etot = fexp(tot);
#pragma unroll
          for (int u = 0; u < 8; ++u) { const float cum = off + lc[u], e1 = fexp(cum), kt = kx[u] * frcp(e1); bf16* pw = Pw + (rowb + tt0 + u) * NIN_E;
              pw[PC_GQ + c] = (bf16)f2bf(qx[u] * 0.125f * e1); pw[PC_GK + c] = (bf16)f2bf(kt); kx[u] = kt * etot; } }
        *(LAS bf16x8_t*)(KrT + lane * MS + tt0) = pack8(kx); *(LAS bf16x8_t*)(VTm + lane * MS + tt0) = pack8(v0); *(LAS bf16x8_t*)(VTm + (64 + lane) * MS + tt0) = pack8(v1);
    }
    __syncthreads();
    {
        bf16* KVg = (bf16*)(A->ws + WS_GKV) + (size_t)itemi * 8192; const int rt = wave >> 1;
#pragma unroll
        for (int c = 0; c < 4; ++c) { const int et = 4 * (wave & 1) + c;
            const f32x4 acc = mm64((f32x4){0.f, 0.f, 0.f, 0.f}, KrT, rt, VTm, et, lane);
            *(GAS v2u*)(KVg + (16 * et + l15) * 64 + 16 * rt + 4 * lg) = pack4(acc); }
    }
    __syncthreads();
}

__device__ __forceinline__ void gla_state_scan(ArgP A, int gt, bool do_store = true) {
    const int bh = gt >> 11, grp = gt & 2047;
    const int b = bh >> 2, h4 = bh & 3;
    bf16* base = (bf16*)(A->ws + WS_GKV) + (size_t)((b * 64) * 4 + h4) * 8192 + (size_t)grp * 4;
    const float* dec = (const float*)(A->ws + WS_GDEC) + (size_t)((b * 64) * 4 + h4) * 64 + (grp & 15) * 4;
    f32x4 S = (f32x4){0.f, 0.f, 0.f, 0.f};
#pragma unroll 1
    for (int n0 = 0; n0 < 64; n0 += 8) {
        v2u kv[8]; f32x4 dc[8];
#pragma unroll
        for (int u = 0; u < 8; ++u) { kv[u] = *(const GAS v2u*)(base + (size_t)(n0 + u) * 4 * 8192); dc[u] = *(const GAS f32x4*)(dec + (size_t)(n0 + u) * 4 * 64); }
#pragma unroll
        for (int u = 0; u < 8; ++u) { if (do_store) *(GAS v2u*)(base + (size_t)(n0 + u) * 4 * 8192) = pack4(S);
            S = S * dc[u] + (f32x4){bflo(kv[u].x), bfhi(kv[u].x), bflo(kv[u].y), bfhi(kv[u].y)}; }
    }
}

constexpr int G3B_SV = 272, G3B_VT = 0, G3B_SC = 64 * G3B_SV, G3B_GRP = G3B_SC + MB;
static_assert(2 * G3B_GRP <= RING_BYTES, "GLA phase-3 LDS map");
__device__ __forceinline__ void gla_out_phase(ArgP A, int L, LAS unsigned char* lds, int tid, int G, int bid) {
    const int lane = tid & 63, wave = __builtin_amdgcn_readfirstlane(tid >> 6), i = L >> 1, l15 = lane & 15, lg = lane >> 4;
    const int gi = wave >> 2, wq = wave & 3;
    const bf16* P = (const bf16*)(A->ws + WS_P); bf16* XNb = (bf16*)(A->ws + WS_XN);
    LAS unsigned char* gb = lds + gi * G3B_GRP; LAS bf16* SC = (LAS bf16*)(gb + G3B_SC);
    const int ct = wq; const int col = 16 * ct + l15;
    int hcur = -1; f32x4 gn4[8];
#pragma unroll 1
    for (int item2 = bid; item2 < BATCH * 64 * 4 / 2; item2 += G) {
    const int itemi = 2 * item2 + gi, h4 = itemi & 3, n = (itemi >> 2) & 63, b = itemi >> 8;
    const size_t rowb = (size_t)b * T + 64 * n;
    if (h4 != hcur) { hcur = h4; const float* gn = A->in[25] + i * 512 + 128 * h4;
#pragma unroll
        for (int et = 0; et < 8; ++et) gn4[et] = *(const GAS f32x4*)(gn + 16 * et + 4 * lg); }
    v4u vreg[4];
    { const int t4 = tid & 255;
#pragma unroll
      for (int q = 0; q < 4; ++q) { const int id = t4 + 256 * q, row = id >> 4, ch = id & 15; vreg[q] = *(const GAS v4u*)(P + (rowb + row) * NIN_E + PC_GV + 128 * h4 + 8 * ch); } }
    const bf16* qrow = P + (rowb + col) * NIN_E + PC_GQ + 64 * h4 + 8 * lg;
    const bf16x8_t qf0 = *(const GAS bf16x8_t*)qrow, qf1 = *(const GAS bf16x8_t*)(qrow + 32);
    v4u kf[4][2];
#pragma unroll
    for (int rt = 0; rt < 4; ++rt) { const bf16* krow = P + (rowb + 16 * rt + l15) * NIN_E + PC_GK + 64 * h4 + 8 * lg;
        if (rt <= ct) { kf[rt][0] = *(const GAS v4u*)krow; kf[rt][1] = *(const GAS v4u*)(krow + 32); } else { kf[rt][0] = (v4u){0u, 0u, 0u, 0u}; kf[rt][1] = (v4u){0u, 0u, 0u, 0u}; } }
    const bf16* Sg = (const bf16*)(A->ws + WS_GKV) + (size_t)itemi * 8192;
    v4u sgf[8][2];
#pragma unroll
    for (int et = 0; et < 8; ++et) { sgf[et][0] = *(const GAS v4u*)(Sg + (16 * et + l15) * 64 + 8 * lg); sgf[et][1] = *(const GAS v4u*)(Sg + (16 * et + l15) * 64 + 32 + 8 * lg); }
    const size_t row = rowb + col; v2u ggr[8];
#pragma unroll
    for (int et = 0; et < 8; ++et) ggr[et] = *(const GAS v2u*)(P + row * NIN_E + PC_GG + 128 * h4 + 16 * et + 4 * lg);
    { const int t4 = tid & 255;
#pragma unroll
      for (int q = 0; q < 4; ++q) { const int id = t4 + 256 * q, vrow = id >> 4, ch = id & 15; *(LAS v4u*)(gb + G3B_VT + vrow * G3B_SV + ch * 16) = vreg[q]; } }
#pragma unroll
    for (int rt = 0; rt < 4; ++rt) { f32x4 acc = (f32x4){0.f, 0.f, 0.f, 0.f};
        if (rt <= ct) {
            acc = mfma16(__builtin_bit_cast(bf16x8_t, kf[rt][0]), qf0, acc); acc = mfma16(__builtin_bit_cast(bf16x8_t, kf[rt][1]), qf1, acc);
#pragma unroll
            for (int r = 0; r < 4; ++r) if (!((16 * rt + 4 * lg + r) <= col)) acc[r] = 0.f; }
        tstore(SC, rt, ct, acc, lane); }
    __syncthreads();
    const int vto = G3B_VT + (8 * lg + (l15 >> 2)) * G3B_SV + 4 * (lane & 3) * 2;
    f32x4 o[8]; float ss = 0.f;
#pragma unroll
    for (int et = 0; et < 8; ++et) { f32x4 acc = (f32x4){0.f, 0.f, 0.f, 0.f};
#pragma unroll
        for (int ks = 0; ks < 2; ++ks) { const LAS unsigned char* vp = gb + vto + ks * 32 * G3B_SV + et * 32;
            const a_s16x4 lo4 = __builtin_bit_cast(a_s16x4, __builtin_amdgcn_ds_read_tr16_b64_v4i16((LAS a_s16x4*)vp));
            const a_s16x4 hi4 = __builtin_bit_cast(a_s16x4, __builtin_amdgcn_ds_read_tr16_b64_v4i16((LAS a_s16x4*)(vp + 4 * G3B_SV)));
            const bf16x8_t vf = (bf16x8_t){lo4[0], lo4[1], lo4[2], lo4[3], hi4[0], hi4[1], hi4[2], hi4[3]};
            acc = mfma16(vf, ldfrag(SC, 16 * ct, 32 * ks, lane), acc); }
        acc = mfma16(__builtin_bit_cast(bf16x8_t, sgf[et][0]), qf0, acc);
        acc = mfma16(__builtin_bit_cast(bf16x8_t, sgf[et][1]), qf1, acc);
        o[et] = acc; ss += (acc[0] * acc[0] + acc[1] * acc[1]) + (acc[2] * acc[2] + acc[3] * acc[3]); }
    ss += __shfl_xor(ss, 16); ss += __shfl_xor(ss, 32);
    const float rs = frsq(ss * (1.f / 128.f) + 1e-5f);
#pragma unroll
    for (int et = 0; et < 8; ++et) { const int e0 = 16 * et + 4 * lg; const f32x4 gg = (f32x4){bflo(ggr[et].x), bfhi(ggr[et].x), bflo(ggr[et].y), bfhi(ggr[et].y)};
        f32x4 v = o[et] * rs * gn4[et]; v[0] *= silu_f(gg[0]); v[1] *= silu_f(gg[1]); v[2] *= silu_f(gg[2]); v[3] *= silu_f(gg[3]);
        *(GAS v2u*)(XNb + row * D + 512 + 128 * h4 + e0) = pack4(v); }
    __syncthreads();
    }
}
constexpr int N_STEPS = 37;
#ifndef MK_ONE_LAUNCH
#define MK_ONE_LAUNCH 1
#endif
__global__ void __launch_bounds__(NTHREADS, 2) hybrid_fwd(Args args) {
    extern __shared__ __attribute__((aligned(16))) unsigned char lds_raw[];
    LAS unsigned char* lds = (LAS unsigned char*)lds_raw;
    ArgP A0 = (ArgP)__builtin_amdgcn_kernarg_segment_ptr();
    { const int tid = threadIdx.x; for (int u = tid; u < (LDS_BYTES - LDSCTL_OFF) / 4; u += NTHREADS) ((LAS unsigned*)(lds + LDSCTL_OFF))[u] = 0u; }
    __syncthreads();
    const int lo = A0->lo, hi = A0->hi;
    if (hi - lo > 1) (void)xcd_barrier_post((unsigned*)(A0->ws + WS_CTL) + CW_BAR, (volatile LAS unsigned*)(lds + MISC_OFF) + 8);
#ifndef PHM
#define PHM 0xff
#endif
#define RUN(s) (lo <= (s) && (s) < hi)
#define EN(b) ((PHM >> (b)) & 1)
#ifndef PROBE_REP
#define PROBE_REP 0
#endif
#define REP(b) _Pragma("unroll 1") for (int rep_ = 0; rep_ < (((PROBE_REP >> (b)) & 1) ? 2 : 1); ++rep_)
#ifndef PROBE_TMASK
#define PROBE_TMASK 0u
#endif
#ifndef PROBE_TAMP
#define PROBE_TAMP 4
#endif
#ifndef PROBE_TCLK
#define PROBE_TCLK 0
#endif
#ifndef PROBE_BLOCK
#define PROBE_BLOCK 0
#endif
#ifndef PROBE_SUBA
#define PROBE_SUBA 0
#define PROBE_SUBB 0
#endif
#define PROBE_STAMP(i) do { if (PROBE_TMASK && ((i) == PROBE_SUBA || (i) == PROBE_SUBB) && L == 0 && bid == PROBE_BLOCK && tid == 0) { ArgP As_ = A; ((unsigned long long*)((unsigned*)(As_->ws + WS_CTL) + 32768))[i] = __builtin_amdgcn_s_memrealtime(); } } while (0)
    int nbar_ = 0;
    if (PROBE_TMASK) { if (blockIdx.x == PROBE_BLOCK && threadIdx.x == 0) { ((unsigned long long*)((unsigned*)(A0->ws + WS_CTL) + 32768))[0] = __builtin_amdgcn_s_memrealtime(); ((unsigned long long*)((unsigned*)(A0->ws + WS_CTL) + 32768))[64] = __builtin_amdgcn_s_memtime(); } }
#define GRID_BARRIER() do { ArgP Ab_ = FRESH_ARGS(); XcdBarrier b_; b_.bar = (unsigned*)(Ab_->ws + WS_CTL) + CW_BAR; b_.x = xb_xcc_id(); b_.st = (volatile LAS unsigned*)(lds + MISC_OFF) + 8; xcd_barrier(b_); if (PROBE_TMASK) { ++nbar_; if (blockIdx.x == PROBE_BLOCK && threadIdx.x == 0) { ((unsigned long long*)((unsigned*)(Ab_->ws + WS_CTL) + 32768))[nbar_] = __builtin_amdgcn_s_memrealtime(); ((unsigned long long*)((unsigned*)(Ab_->ws + WS_CTL) + 32768))[64 + nbar_] = __builtin_amdgcn_s_memtime(); } } } while (0)
#define SEAM(s) do { if (RUN(s) && RUN((s) + 1)) GRID_BARRIER(); } while (0)
#define PHASE_VARS() ArgP A = FRESH_ARGS(); int L = Lq; FRESH_S(L); int tid = threadIdx.x; FRESH_V(tid); const int lane = tid & 63, wave = __builtin_amdgcn_readfirstlane(tid >> 6); int G = gridDim.x, bid = blockIdx.x; FRESH_S(G); FRESH_S(bid); (void)lane; (void)wave; (void)G; (void)A; (void)bid; \
    bf16* XN = (bf16*)(A->ws + WS_XN); bf16* PB = (bf16*)(A->ws + WS_P); (void)XN; (void)PB

#define BAR2(a, b) do { if (RUN(a) && RUN(b)) GRID_BARRIER(); } while (0)
    if (EN(0) && RUN(0)) REP(0) { int Lq = 0; PHASE_VARS(); const int gw = bid * NWAVES + wave, NGW = G * NWAVES;
        convert_mixer_weights(A, 0, lds, wave, lane, gw, NGW); PROBE_STAMP(45);
        float* ssq0 = (float*)(A->ws + WS_SSQ);
        for (int m = gw; m < M; m += NGW) x_to_bf16_ssq(A->in[0] + (size_t)m * D, (bf16*)A->out + (size_t)m * D, ssq0 + (size_t)m * 16, lane); }
    BAR2(0, 1);
    for (int Lq = 0; Lq < 4; ++Lq) {
        const int s0 = 9 * Lq; const bool even = !(Lq & 1);
        if (EN(1) && RUN(s0 + 1)) REP(1) {
            PHASE_VARS(); bf16* Win = (bf16*)(A->ws + WS_WIN); const float* ssq = (const float*)(A->ws + WS_SSQ);
            if (even) {
                pg8::Gemm g{(bf16*)A->out, Win, M, NIN_E, D}; pg8::StaticOrderC<M, NIN_E> S; S.init(G, bid);
                pg8::fill_row_scales(S, ssq, (LAS float*)(lds + RSTAB_OFF), tid);
                pg8::EpiStoreBf16 E{PB, NIN_E, 0, 1.0f, (const LAS float*)(lds + RSTAB_OFF)};
                pg8::gemm_phase<pg8::EpiStoreBf16, pg8::StaticOrderC<M, NIN_E>, PG8_ALIGN, PG8_SP2>(lds, g, S, E);
            } else {
                pg8::Gemm g{(bf16*)A->out, Win, M, NIN_O, D}; pg8::StaticOrderC<M, NIN_O> S; S.init(G, bid);
                pg8::fill_row_scales(S, ssq, (LAS float*)(lds + RSTAB_OFF), tid);
                pg8::EpiStoreBf16 E{PB, NIN_O, 4, 0.125f * 1.4426950408889634f, (const LAS float*)(lds + RSTAB_OFF)};
                pg8::gemm_phase<pg8::EpiStoreBf16, pg8::StaticOrderC<M, NIN_O>, PG8_ALIGN, PG8_SP2>(lds, g, S, E);
            }
        }
        if (even) {
            BAR2(s0 + 1, s0 + 2);
            if (EN(2) && RUN(s0 + 2)) REP(2) { PHASE_VARS();
                rwkv_chunk_phase(A, L, lds, tid, G, bid); PROBE_STAMP(44);
                REP(8) {
#pragma unroll 1
                for (int it = bid; it < BATCH * 64 * 4; it += G) gla_kv_item(A, L, it >> 8, (it >> 2) & 63, it & 3, lds, tid); } }
            BAR2(s0 + 2, s0 + 3);
            if (EN(3) && RUN(s0 + 3)) {
                PHASE_VARS();
                if (bid < 64) { rwkv_state_scan(A, bid >> 3, bid & 7, lds, wave, lane); PROBE_STAMP(40); }
                else { for (int gt = (bid - 64) * NTHREADS + tid; gt < 32 * 2048; gt += (G - 64) * NTHREADS) gla_state_scan(A, gt);
                       PROBE_STAMP(41);
                       convert_ffn_weights(A, L, lds, wave, lane, (bid - 64) * NWAVES + wave, (G - 64) * NWAVES); PROBE_STAMP(42); }
            }
            BAR2(s0 + 3, s0 + 4);
            if (EN(3) && RUN(s0 + 4)) {
                PHASE_VARS();
                REP(9) {
                gla_out_phase(A, L, lds, tid, G, bid); }
                PROBE_STAMP(43);
                rwkv_out_phase(A, L, bid * NWAVES + wave, G * NWAVES, lane);
            }
            BAR2(s0 + 4, s0 + 5);
        } else {
            BAR2(s0 + 1, s0 + 3);
            if (EN(4) && RUN(s0 + 3) && ((PROBE_REP >> 16) & 1)) { PHASE_VARS(); attn_phase_mfma<true>(A, L, lds, tid, G, bid); }
            if (EN(4) && RUN(s0 + 3)) REP(4) { PHASE_VARS(); attn_phase_mfma(A, L, lds, tid, G, bid); convert_ffn_weights(A, L, lds, wave, lane, bid * NWAVES + wave, G * NWAVES); }
            BAR2(s0 + 3, s0 + 5);
        }
        if (EN(5) && RUN(s0 + 5)) {
            PHASE_VARS(); bf16* Wout = (bf16*)(A->ws + WS_WOUT);
            pg8::Gemm g{XN, Wout, M, D, D}; pg8::StaticOrderC<M, D> S; S.init(G, bid);
            if ((PROBE_REP >> 5) & 1) { pg8::EpiResBf16<false, true> E0{(bf16*)A->out, D, (float*)(A->ws + WS_SSQ) + (size_t)M * 16, nullptr};
                pg8::gemm_phase<pg8::EpiResBf16<false, true>, pg8::StaticOrderC<M, D>, PG8_ALIGN, PG8_SP2>(lds, g, S, E0); }
            pg8::EpiResBf16<false> E{(bf16*)A->out, D, (float*)(A->ws + WS_SSQ) + (size_t)M * 16, nullptr};
            pg8::gemm_phase<pg8::EpiResBf16<false>, pg8::StaticOrderC<M, D>, PG8_ALIGN, PG8_SP2>(lds, g, S, E);
        }
        BAR2(s0 + 5, s0 + 7);
        if (EN(6) && RUN(s0 + 7)) REP(6) {
            PHASE_VARS(); bf16* Wgu = (bf16*)(A->ws + WS_WGU);
            pg8::Gemm g{(bf16*)A->out, Wgu, M, NGU, D}; pg8::StaticOrderC<M, NGU> S; S.init(G, bid);
            pg8::fill_row_scales(S, (const float*)(A->ws + WS_SSQ) + (size_t)M * 16, (LAS float*)(lds + RSTAB_OFF), tid);
            if ((PROBE_REP >> 18) & 1) { pg8::EpiNull En; pg8::gemm_phase<pg8::EpiNull, pg8::StaticOrderC<M, NGU>, PG8_ALIGN, PG8_SP2>(lds, g, S, En); }
            if ((PROBE_REP >> 15) & 1) { pg8::EpiSwigluT<true> E0{PB, FF, (const LAS float*)(lds + RSTAB_OFF)};
                pg8::gemm_phase<pg8::EpiSwigluT<true>, pg8::StaticOrderC<M, NGU>, PG8_ALIGN, PG8_SP2>(lds, g, S, E0); }
            pg8::EpiSwiglu E{PB, FF, (const LAS float*)(lds + RSTAB_OFF)};
            pg8::gemm_phase<pg8::EpiSwiglu, pg8::StaticOrderC<M, NGU>, PG8_ALIGN, PG8_SP2>(lds, g, S, E);
        }
        BAR2(s0 + 7, s0 + 8);
        if (EN(7) && RUN(s0 + 8)) {
            PHASE_VARS(); bf16* Wdn = (bf16*)(A->ws + WS_WDN);
            pg8::Gemm g{PB, Wdn, M, D, FF}; pg8::StaticOrderC<M, D> S; S.init(G, bid);
            if ((PROBE_REP >> 7) & 1) { pg8::EpiResBf16<false, true> E0{(bf16*)A->out, D, (float*)(A->ws + WS_SSQ), nullptr};
                pg8::gemm_phase<pg8::EpiResBf16<false, true>, pg8::StaticOrderC<M, D>, PG8_ALIGN, PG8_SP2>(lds, g, S, E0); }
            if (L < 3) { pg8::EpiResBf16<false> E{(bf16*)A->out, D, (float*)(A->ws + WS_SSQ), nullptr};
                pg8::gemm_phase<pg8::EpiResBf16<false>, pg8::StaticOrderC<M, D>, PG8_ALIGN, PG8_SP2>(lds, g, S, E);
                convert_mixer_weights(A, L + 1, lds, wave, lane, bid * NWAVES + wave, G * NWAVES); }
            else { pg8::EpiResBf16<true> E{(bf16*)A->out, D, (float*)(A->ws + WS_SSQ), XN};
                pg8::gemm_phase<pg8::EpiResBf16<true>, pg8::StaticOrderC<M, D>, PG8_ALIGN, PG8_SP2>(lds, g, S, E); }
        }
        BAR2(s0 + 8, Lq < 3 ? s0 + 10 : 36);
    }
    if (RUN(36)) REP(17) {
        int Lq = 0; PHASE_VARS();
        const int gw = bid * NWAVES + wave, NGW = G * NWAVES;
        const float pscale_ = 1.0f;
        for (int m = gw; m < M; m += NGW) rms_row_bf16_to_f32(XN + (size_t)m * D, A->in[4], A->out + (size_t)m * D, lane, pscale_);
        if (PROBE_TMASK) { if (blockIdx.x == PROBE_BLOCK && threadIdx.x == 0) {
            const unsigned long long* ts = (const unsigned long long*)((const unsigned*)(A->ws + WS_CTL) + 32768); unsigned long long acc_ = 0, cyc_ = 0;
            for (int k = 1; k <= 25; ++k) if ((PROBE_TMASK >> k) & 1u) { acc_ += ts[k] - ts[k - 1]; cyc_ += ts[64 + k] - ts[64 + k - 1]; }
            if (PROBE_SUBA == 99) acc_ = __builtin_amdgcn_s_memrealtime() - ts[25]; else if (PROBE_SUBA) acc_ = ts[PROBE_SUBA] - ts[PROBE_SUBB];
            const unsigned long long target_ = PROBE_TCLK ? (cyc_ * 100000ull) / (acc_ + 1ull) : acc_ * (unsigned long long)PROBE_TAMP;
            const unsigned long long t0_ = __builtin_amdgcn_s_memrealtime();
            while (__builtin_amdgcn_s_memrealtime() - t0_ < target_ && __builtin_amdgcn_s_memrealtime() - t0_ < 4000000ull) __builtin_amdgcn_s_sleep(16); } }
    }
#undef RUN
#undef SEAM
}

extern "C" void kernel_launch(void* const* d_in, const int* in_sizes, int n_in, void* d_out, int out_size, void* d_ws, size_t ws_size, hipStream_t stream) {
    static int grid = 0;
    if (grid == 0) {
        if (n_in != 36 || in_sizes[0] != M * D || out_size != M * D || ws_size < WS_END) { fprintf(stderr, "kernel_launch: unexpected shapes (n_in %d, in0 %d, out %d, ws %zu); nothing launched\n", n_in, n_in > 0 ? in_sizes[0] : -1, out_size, ws_size); grid = -1; return; }
        int dev = 0, cus = 0, per_cu = 0;
        if (hipGetDevice(&dev) != hipSuccess || hipDeviceGetAttribute(&cus, hipDeviceAttributeMultiprocessorCount, dev) != hipSuccess) { grid = -1; return; }
        if (hipFuncSetAttribute((const void*)hybrid_fwd, hipFuncAttributeMaxDynamicSharedMemorySize, LDS_BYTES) != hipSuccess) { fprintf(stderr, "kernel_launch: hipFuncSetAttribute failed\n"); grid = -1; return; }
        if (hipOccupancyMaxActiveBlocksPerMultiprocessor(&per_cu, (const void*)hybrid_fwd, NTHREADS, LDS_BYTES) != hipSuccess || per_cu < 1) fprintf(stderr, "kernel_launch: occupancy query reports %d\n", per_cu);
        (void)hipGetLastError();
        if (cus < 128) { fprintf(stderr, "kernel_launch: built for a 256-CU device (phase 3 of the even layers needs more than 64 workgroups); nothing launched\n"); grid = -1; return; }
        grid = cus;
    }
    if (grid < 0) return;
    if (hipMemsetAsync((char*)d_ws + WS_CTL, 0, CTL_ZERO_BYTES, stream) != hipSuccess) return;
    Args a{};
    for (int i = 0; i < 36; ++i) a.in[i] = (const float*)d_in[i];
    a.out = (float*)d_out; a.ws = (unsigned char*)d_ws;
#if MK_ONE_LAUNCH
    a.lo = 0; a.hi = N_STEPS;
    hipLaunchKernelGGL(hybrid_fwd, dim3(grid), dim3(NTHREADS), LDS_BYTES, stream, a);
#else
    for (int s = 0; s < N_STEPS; ++s) {
        if (s < 36 && ((s % 9) == 2 || (s % 9) == 4) && ((s / 9) & 1)) continue;
        a.lo = s; a.hi = s + 1;
        hipLaunchKernelGGL(hybrid_fwd, dim3(grid), dim3(NTHREADS), LDS_BYTES, stream, a);
    }
#endif
}
```

```cpp
#include <hip/hip_runtime.h>
#include <cstdio>
#include <cstdint>
__device__ __forceinline__ float silu_f(float x) { return x * __builtin_amdgcn_rcpf(1.0f + __builtin_amdgcn_exp2f(-1.4426950408889634f * x)); }
namespace pg8 {
#define PG8_LAS __attribute__((address_space(3)))
typedef unsigned short bf16_t;
typedef short bf16x8 __attribute__((ext_vector_type(8)));
typedef float f32x4 __attribute__((ext_vector_type(4)));
typedef unsigned u32x4 __attribute__((ext_vector_type(4)));
constexpr int BM = 256, BK = 64, HALF = 128, HTB = HALF * BK * 2  , STAGE_BYTES = 8 * HTB, NXCD = 8, WGM = 4;

__host__ __device__ __forceinline__ int lds_byte(int r, int c) { const int st = (r >> 4) * 2 + (c >> 5), rr = r & 15, cc = c & 31, ob = rr * 64 + cc * 2; return st * 1024 + (ob ^ (((ob >> 9) & 1) << 5)); }
__host__ __device__ __forceinline__ void stage_rc(int b, int& R, int& C) { const int st = b / 1024, sb = b % 1024, swz = sb ^ (((sb >> 9) & 1) << 5); R = (st >> 1) * 16 + swz / 64; C = (st & 1) * 32 + (swz % 64) / 2; }
__host__ __device__ __forceinline__ int perm32(int rho) { const int n = rho >> 4, i = rho & 15; return 8 * (i >> 2) + 4 * n + (i & 3); }

struct Unit { int pm, pn, idx; };
struct Gemm { const bf16_t* A; const bf16_t* Bt; int M, N, K; };

struct StaticOrder {
    int nM, nN, nwg, G, c;
    __host__ __device__ void init(int M, int N, int G_, int c_) { nM = M / BM; nN = N / BM; nwg = nM * nN; G = G_; c = c_; }
    __host__ __device__ bool next(int i, Unit& u) const {
        const long L = (long)i * G + c; if (L >= nwg) return false;
        int wgid = (int)L; { const int q = nwg / NXCD, r = nwg % NXCD, xcd = wgid % NXCD, off = wgid / NXCD; wgid = (xcd < r ? xcd * (q + 1) : r * (q + 1) + (xcd - r) * q) + off; }
        const int nig = WGM * nN, gid = wgid / nig, fm = gid * WGM, gsz = (nM - fm) < WGM ? (nM - fm) : WGM;
        u.pm = fm + ((wgid % nig) % gsz); u.pn = (wgid % nig) / gsz; return true;
    }
    __device__ __forceinline__ void a_ready(const Unit&) const {}
    __device__ __forceinline__ void done(const Unit&) const {}
};

__device__ __forceinline__ unsigned cvt_pk_bf16(float lo, float hi) { unsigned r; asm volatile("v_cvt_pk_bf16_f32 %0, %1, %2" : "=v"(r) : "v"(lo), "v"(hi)); return r; }
typedef float f32x2 __attribute__((ext_vector_type(2)));
__device__ __forceinline__ float row_ssq(const float* ssq, int row) { const f32x4* p = (const f32x4*)(ssq + (size_t)row * 16); const f32x4 a = p[0], b = p[1], c = p[2], d = p[3];
    return (((a[0] + a[1]) + (a[2] + a[3])) + ((b[0] + b[1]) + (b[2] + b[3]))) + (((c[0] + c[1]) + (c[2] + c[3])) + ((d[0] + d[1]) + (d[2] + d[3]))); }
struct EpiStoreBf16 {
    static constexpr bool PERM = true, AFTER_DRAIN = false;
    bf16_t* O; int ldc; int qtiles; float qscale; const PG8_LAS float* rstab;
    __device__ __forceinline__ void operator()(const f32x4 (&acc)[2][2][4][2], const Unit& u, int wr, int wc, int fr, int fq) const {
        const int row0 = u.pm * BM + wr * 64 + fr, col0 = u.pn * BM + wc * 32 + 8 * fq;
        const float sc = u.pn < qtiles ? qscale : 1.0f;
        const PG8_LAS float* rt_ = rstab + u.idx * BM + wr * 64 + fr;
#pragma unroll
        for (int ai = 0; ai < 2; ++ai)
#pragma unroll
            for (int m = 0; m < 4; ++m) { const int row = row0 + ai * HALF + m * 16; bf16_t* rowp = O + (size_t)row * ldc + col0;
                const float rs = sc * rt_[ai * HALF + m * 16];
#pragma unroll
                for (int bj = 0; bj < 2; ++bj) { const f32x4 v0 = acc[ai][bj][m][0] * rs, v1 = acc[ai][bj][m][1] * rs;
                    u32x4 w; w.x = cvt_pk_bf16(v0[0], v0[1]); w.y = cvt_pk_bf16(v0[2], v0[3]); w.z = cvt_pk_bf16(v1[0], v1[1]); w.w = cvt_pk_bf16(v1[2], v1[3]);
                    *(u32x4*)(rowp + bj * HALF) = w; } }
    }
};
template <bool LAST, bool NOSTORE = false> struct EpiResBf16 {
    static constexpr bool PERM = false, AFTER_DRAIN = false;
    bf16_t* xr; int ldc; float* ssq; bf16_t* xf;
    __device__ __forceinline__ void operator()(const f32x4 (&acc)[2][2][4][2], const Unit& u, int wr, int wc, int fr, int fq) const {
        typedef unsigned u32x2 __attribute__((ext_vector_type(2)));
        const int row0 = u.pm * BM + wr * 64 + fr, col0 = u.pn * BM + wc * 32 + 4 * fq;
#pragma unroll
        for (int ai = 0; ai < 2; ++ai)
#pragma unroll
            for (int m = 0; m < 4; ++m) { const int row = row0 + ai * HALF + m * 16; const size_t off = (size_t)row * ldc + col0; float s = 0.f;
#pragma unroll
                for (int bj = 0; bj < 2; ++bj)
#pragma unroll
                    for (int n = 0; n < 2; ++n) { const u32x2 bw = *(const u32x2*)(xr + off + bj * HALF + n * 16);
                        const f32x4 b = (f32x4){__builtin_bit_cast(float, bw.x << 16), __builtin_bit_cast(float, bw.x & 0xffff0000u), __builtin_bit_cast(float, bw.y << 16), __builtin_bit_cast(float, bw.y & 0xffff0000u)};
                        const f32x4 v = b + acc[ai][bj][m][n];
                        s += (v[0] * v[0] + v[1] * v[1]) + (v[2] * v[2] + v[3] * v[3]);
                        u32x2 w; w.x = cvt_pk_bf16(v[0], v[1]); w.y = cvt_pk_bf16(v[2], v[3]); if (!NOSTORE) *(u32x2*)((LAST ? xf : xr) + off + bj * HALF + n * 16) = w; else asm volatile("" :: "v"(w.x), "v"(w.y)); }
                s += __shfl_xor(s, 16); s += __shfl_xor(s, 32);
                if (fq == 0 && !NOSTORE) ssq[(size_t)row * 16 + u.pn * 4 + wc] = s;
                if (m & 1) asm volatile("" ::: "memory"); }
    }
};
template <bool NOSTORE = false> struct EpiSwigluT {
    static constexpr bool PERM = true, AFTER_DRAIN = false;
    bf16_t* H; int ldc; const PG8_LAS float* rstab;
    __device__ __forceinline__ void operator()(const f32x4 (&acc)[2][2][4][2], const Unit& u, int wr, int wc, int fr, int fq) const {
        const int row0 = u.pm * BM + wr * 64 + fr, colh = u.pn * HALF + wc * 32 + 8 * fq;
        const PG8_LAS float* rt_ = rstab + u.idx * BM + wr * 64 + fr;
#pragma unroll
        for (int ai = 0; ai < 2; ++ai)
#pragma unroll
            for (int m = 0; m < 4; ++m) { const int row = row0 + ai * HALF + m * 16; bf16_t* rowp = H + (size_t)row * ldc + colh;
                const float rs = rt_[ai * HALF + m * 16];
                const f32x4 g0 = acc[ai][0][m][0] * rs, g1 = acc[ai][0][m][1] * rs, u0 = acc[ai][1][m][0] * rs, u1 = acc[ai][1][m][1] * rs;
                float h[8];
#pragma unroll
                for (int e = 0; e < 4; ++e) { h[e] = silu_f(g0[e]) * u0[e]; h[4 + e] = silu_f(g1[e]) * u1[e]; }
                u32x4 w; w.x = cvt_pk_bf16(h[0], h[1]); w.y = cvt_pk_bf16(h[2], h[3]); w.z = cvt_pk_bf16(h[4], h[5]); w.w = cvt_pk_bf16(h[6], h[7]);
                if (!NOSTORE) *(u32x4*)rowp = w; else asm volatile("" :: "v"(w.x), "v"(w.y), "v"(w.z), "v"(w.w)); }
    }
};
typedef EpiSwigluT<false> EpiSwiglu;
struct EpiNull {
    static constexpr bool PERM = true, AFTER_DRAIN = false;
    __device__ __forceinline__ void operator()(const f32x4 (&acc)[2][2][4][2], const Unit& u, int wr, int wc, int fr, int fq) const {
#pragma unroll
        for (int ai = 0; ai < 2; ++ai)
#pragma unroll
            for (int bj = 0; bj < 2; ++bj)
#pragma unroll
                for (int m = 0; m < 4; ++m)
#pragma unroll
                    for (int n = 0; n < 2; ++n) asm volatile("" :: "v"(acc[ai][bj][m][n]));
    }
};
template <int M_, int N_> struct StaticOrderC {
    static constexpr int nM = M_ / BM, nN = N_ / BM, nwg = nM * nN;
    int G, c;
    __device__ __forceinline__ void init(int G_, int c_) { G = G_; c = c_; }
    __device__ __forceinline__ bool next(int i, Unit& u) const {
        const int L = i * G + c; if (L >= nwg) return false;
        int wgid = L; { constexpr int q = nwg / NXCD, r = nwg % NXCD; const int xcd = wgid % NXCD, off = wgid / NXCD; wgid = (xcd < r ? xcd * (q + 1) : r * (q + 1) + (xcd - r) * q) + off; }
        constexpr int nig = WGM * nN; const int gid = wgid / nig, fm = gid * WGM, gsz = (nM - fm) < WGM ? (nM - fm) : WGM;
        u.pm = fm + ((wgid % nig) % gsz); u.pn = (wgid % nig) / gsz; u.idx = i; return true;
    }
    __device__ __forceinline__ void a_ready(const Unit&) const {}
    __device__ __forceinline__ void done(const Unit&) const {}
};
template <class Sched> __device__ __forceinline__ void fill_row_scales(const Sched& S, const float* ssq, PG8_LAS float* tab, int tid) {
    Unit u; const int r = tid >> 1, hf = tid & 1;
    for (int i = 0; S.next(i, u); ++i) { const f32x4* p = (const f32x4*)(ssq + (size_t)(u.pm * BM + r) * 16 + hf * 8); const f32x4 a = p[0], b = p[1];
        float sum = ((a[0] + a[1]) + (a[2] + a[3])) + ((b[0] + b[1]) + (b[2] + b[3])); sum += __shfl_xor(sum, 1);
        if (hf == 0) tab[i * BM + r] = __builtin_amdgcn_rsqf(sum * (1.0f / 1024.0f) + 1e-6f); }
    __syncthreads();
}
template <class Epi, class Sched, bool ALIGN_EPI = false, bool SP2 = false>
__device__ __forceinline__ void gemm_phase(PG8_LAS unsigned char* lds, const Gemm g, const Sched& S, const Epi& E) {
    int tid_ = threadIdx.x; asm volatile("" : "+v"(tid_));
    float zz_ = 0.f; asm volatile("" : "+v"(zz_));
    const int tid = tid_, wid = __builtin_amdgcn_readfirstlane(tid >> 6), lane = tid & 63, wr = wid >> 2, wc = wid & 3, fr = lane & 15, fq = lane >> 4;
    const int K = g.K, nt = K / BK;
    unsigned voffA[2], voffB[2];
#pragma unroll
    for (int i = 0; i < 2; ++i) { int R, C; stage_rc(tid * 16 + i * 8192, R, C); const int Rb = Epi::PERM ? ((R & ~31) + perm32(R & 31)) : R;
        voffA[i] = (unsigned)(R * K + C) * 2u; voffB[i] = (unsigned)(Rb * K + C) * 2u; }
    const size_t kstep = (size_t)(BK * 2);
    const size_t hstep = (size_t)HALF * K * 2;
    const size_t tstep = 2 * hstep;
    const unsigned ldsw = (unsigned)wid * 1024u;
    const int aoff = lds_byte(wr * 64 + fr, fq * 8), boff = lds_byte(wc * 32 + fr, fq * 8);
#define PG8_SA(b, h) (((b) * 2 + (h)) * HTB)
#define PG8_SB(b, h) ((4 + (b) * 2 + (h)) * HTB)
#define PG8_STAGE(bufoff, gbase, voff) do { _Pragma("unroll") for (int _i = 0; _i < 2; ++_i) \
        __builtin_amdgcn_global_load_lds((const unsigned*)((const char*)(gbase) + (voff)[_i]), (PG8_LAS unsigned*)(lds + (bufoff) + ldsw + _i * 8192), 16, 0, 0); } while (0)
#define PG8_LDA(dst, b, h) do { _Pragma("unroll") for (int m = 0; m < 4; ++m) _Pragma("unroll") for (int k = 0; k < 2; ++k) dst[m][k] = *(const PG8_LAS bf16x8*)(lds + PG8_SA(b, h) + aoff + m * 2048 + k * 1024); } while (0)
#define PG8_LDB(dst, b, h) do { _Pragma("unroll") for (int n = 0; n < 2; ++n) _Pragma("unroll") for (int k = 0; k < 2; ++k) dst[n][k] = *(const PG8_LAS bf16x8*)(lds + PG8_SB(b, h) + boff + n * 2048 + k * 1024); } while (0)
#define PG8_MMA(ai, bj, At, Bt) do { __builtin_amdgcn_s_setprio(1); _Pragma("unroll") for (int m = 0; m < 4; ++m) _Pragma("unroll") for (int n = 0; n < 2; ++n) _Pragma("unroll") for (int k = 0; k < 2; ++k) \
        acc[ai][bj][m][n] = __builtin_amdgcn_mfma_f32_16x16x32_bf16(Bt[n][k], At[m][k], acc[ai][bj][m][n], 0, 0, 0); __builtin_amdgcn_s_setprio(0); } while (0)
#define PG8_WAIT_V(n) asm volatile("s_waitcnt vmcnt(" #n ")" ::: "memory")
#define PG8_WAIT_L(n) asm volatile("s_waitcnt lgkmcnt(" #n ")" ::: "memory")
#define PG8_BAR __builtin_amdgcn_s_barrier()
#define PG8_SCHED __builtin_amdgcn_sched_barrier(0)
    Unit cur, nxt; int ui = 0;
    if (!S.next(0, cur)) return;
    f32x4 acc[2][2][4][2];
#pragma unroll
    for (int a = 0; a < 2; ++a)
#pragma unroll
        for (int b = 0; b < 2; ++b)
#pragma unroll
            for (int m = 0; m < 4; ++m)
#pragma unroll
                for (int n = 0; n < 2; ++n) acc[a][b][m][n] = (f32x4){zz_, zz_, zz_, zz_};
    bf16x8 At[4][2], B0[2][2], B1[2][2];
    const char* cA = (const char*)g.A + (size_t)cur.pm * tstep; const char* cB = (const char*)g.Bt + (size_t)cur.pn * tstep;
    S.a_ready(cur);
    if constexpr (SP2) {
        PG8_STAGE(PG8_SB(0, 0), cB, voffB); PG8_STAGE(PG8_SB(0, 1), cB + hstep, voffB); PG8_STAGE(PG8_SA(0, 0), cA, voffA); PG8_STAGE(PG8_SA(0, 1), cA + hstep, voffA);
        if (wr == 1) PG8_BAR;
        PG8_WAIT_V(2); PG8_BAR;
        PG8_STAGE(PG8_SB(1, 0), cB + kstep, voffB); PG8_STAGE(PG8_SA(1, 0), cA + kstep, voffA); PG8_STAGE(PG8_SB(1, 1), cB + hstep + kstep, voffB);
        PG8_WAIT_V(6); PG8_BAR;
    } else {
        PG8_STAGE(PG8_SB(0, 0), cB, voffB); PG8_STAGE(PG8_SA(0, 0), cA, voffA); PG8_STAGE(PG8_SB(0, 1), cB + hstep, voffB); PG8_STAGE(PG8_SA(0, 1), cA + hstep, voffA);
        if (wr == 1) PG8_BAR;
        PG8_WAIT_V(4); PG8_BAR;
        PG8_STAGE(PG8_SB(1, 0), cB + kstep, voffB); PG8_STAGE(PG8_SA(1, 0), cA + kstep, voffA); PG8_STAGE(PG8_SB(1, 1), cB + hstep + kstep, voffB);
        PG8_WAIT_V(6); PG8_BAR;
    }
    for (;;) {
        const bool has_next = S.next(ui + 1, nxt);
        const char* nA = has_next ? (const char*)g.A + (size_t)nxt.pm * tstep : cA; const char* nB = has_next ? (const char*)g.Bt + (size_t)nxt.pn * tstep : cB;
        for (int t = 0; t < nt; t += 2) {
            const bool last = (t == nt - 2);
            const char* a1 = cA + (size_t)(t + 1) * kstep;
            const char* a2 = last ? nA : cA + (size_t)(t + 2) * kstep; const char* b2 = last ? nB : cB + (size_t)(t + 2) * kstep;
            const char* a3 = a2 + kstep; const char* b3 = b2 + kstep;
            if (last && has_next) S.a_ready(nxt);
            if constexpr (SP2) {
            PG8_LDB(B0, 0, 0); PG8_LDB(B1, 0, 1); PG8_SCHED; PG8_LDA(At, 0, 0); PG8_STAGE(PG8_SA(1, 1), a1 + hstep, voffA);
            PG8_WAIT_V(8); PG8_WAIT_L(0); PG8_BAR; PG8_MMA(0, 0, At, B0); PG8_MMA(0, 1, At, B1); PG8_BAR; PG8_SCHED;
            PG8_LDA(At, 0, 1); PG8_STAGE(PG8_SB(0, 0), b2, voffB); PG8_STAGE(PG8_SB(0, 1), b2 + hstep, voffB); PG8_STAGE(PG8_SA(0, 0), a2, voffA);
            PG8_WAIT_V(8); PG8_WAIT_L(0); PG8_BAR; PG8_MMA(1, 0, At, B0); PG8_MMA(1, 1, At, B1); PG8_BAR; PG8_SCHED;
            PG8_LDB(B0, 1, 0); PG8_LDB(B1, 1, 1); PG8_SCHED; PG8_LDA(At, 1, 0); PG8_STAGE(PG8_SA(0, 1), a2 + hstep, voffA);
            PG8_WAIT_V(8); PG8_WAIT_L(0); PG8_BAR; PG8_MMA(0, 0, At, B0); PG8_MMA(0, 1, At, B1); PG8_BAR; PG8_SCHED;
            PG8_LDA(At, 1, 1); PG8_STAGE(PG8_SB(1, 0), b3, voffB); PG8_STAGE(PG8_SB(1, 1), b3 + hstep, voffB); PG8_STAGE(PG8_SA(1, 0), a3, voffA);
            PG8_WAIT_V(8); PG8_WAIT_L(0); PG8_BAR; PG8_MMA(1, 0, At, B0); PG8_MMA(1, 1, At, B1); PG8_BAR; PG8_SCHED;
            } else {
            PG8_LDB(B0, 0, 0); PG8_SCHED; PG8_LDA(At, 0, 0); PG8_STAGE(PG8_SA(1, 1), a1 + hstep, voffA);
            PG8_WAIT_L(8); PG8_BAR; PG8_WAIT_L(0); PG8_MMA(0, 0, At, B0); PG8_BAR; PG8_SCHED;
            PG8_LDB(B1, 0, 1); PG8_STAGE(PG8_SB(0, 0), b2, voffB);
            PG8_BAR; PG8_WAIT_L(0); PG8_MMA(0, 1, At, B1); PG8_BAR;
            PG8_LDA(At, 0, 1); PG8_STAGE(PG8_SA(0, 0), a2, voffA);
            PG8_BAR; PG8_WAIT_L(0); PG8_MMA(1, 0, At, B0); PG8_BAR; PG8_SCHED;
            PG8_STAGE(PG8_SB(0, 1), b2 + hstep, voffB);
            PG8_WAIT_V(6); PG8_BAR; PG8_MMA(1, 1, At, B1); PG8_BAR;
            PG8_LDB(B0, 1, 0); PG8_SCHED; PG8_LDA(At, 1, 0); PG8_STAGE(PG8_SA(0, 1), a2 + hstep, voffA);
            PG8_WAIT_L(8); PG8_BAR; PG8_WAIT_L(0); PG8_MMA(0, 0, At, B0); PG8_BAR; PG8_SCHED;
            PG8_LDB(B1, 1, 1); PG8_STAGE(PG8_SB(1, 0), b3, voffB);
            PG8_BAR; PG8_WAIT_L(0); PG8_MMA(0, 1, At, B1); PG8_BAR;
            PG8_LDA(At, 1, 1); PG8_STAGE(PG8_SA(1, 0), a3, voffA);
            PG8_BAR; PG8_WAIT_L(0); PG8_MMA(1, 0, At, B0); PG8_BAR; PG8_SCHED;
            PG8_STAGE(PG8_SB(1, 1), b3 + hstep, voffB);
            PG8_WAIT_V(6); PG8_BAR; PG8_MMA(1, 1, At, B1); PG8_BAR;
            }
        }
        if constexpr (ALIGN_EPI) { if (wr == 0) PG8_BAR; }
        if constexpr (!Epi::AFTER_DRAIN) { E(acc, cur, wr, wc, fr, fq); S.done(cur); }
        if (!has_next) break;
#pragma unroll
        for (int a = 0; a < 2; ++a)
#pragma unroll
            for (int b = 0; b < 2; ++b)
#pragma unroll
                for (int m = 0; m < 4; ++m)
#pragma unroll
                    for (int n = 0; n < 2; ++n) acc[a][b][m][n] = (f32x4){zz_, zz_, zz_, zz_};
        cur = nxt; cA = nA; cB = nB; ++ui;
        if constexpr (ALIGN_EPI) { if (wr == 1) PG8_BAR; }
    }
    PG8_WAIT_V(0);
    if constexpr (!ALIGN_EPI) { if (wr == 0) PG8_BAR; }
    PG8_BAR;
    if constexpr (Epi::AFTER_DRAIN) { E.fused(acc, cur, wr, wc, fr, fq, lds, wid, lane); S.done(cur); }
#undef PG8_SA
#undef PG8_SB
#undef PG8_STAGE
#undef PG8_LDA
#undef PG8_LDB
#undef PG8_MMA
#undef PG8_WAIT_V
#undef PG8_WAIT_L
#undef PG8_BAR
#undef PG8_SCHED
}
}
#ifndef PG8_SP2
#define PG8_SP2 true
#endif
#ifndef PG8_ALIGN
#define PG8_ALIGN true
#endif
constexpr int NWAVES = 8, NTHREADS = NWAVES * 64;
constexpr int BATCH = 8, T = 4096, D = 1024, M = BATCH * T;
constexpr int NIN_E = 3840, NIN_O = 3072, FF = 2816, NGU = 2 * FF;
constexpr int PC_R = 0, PC_K = 512, PC_V = 1024, PC_GQ = 1536, PC_GK = 1792, PC_GV = 2048, PC_GG = 2560;
constexpr int PC_W1A = 3072, PC_W1B = 3136, PC_A1A = 3200, PC_A1B = 3264, PC_G1A = 3328, PC_G1B = 3488, PC_WA1 = 3648, PC_PAD = 3664;
constexpr int NLORA = 304;
constexpr size_t MiB = 1u << 20;
constexpr size_t WS_CTL = 0, CTL_ZERO_BYTES = 1 * MiB;
constexpr size_t WS_WIN = 2 * MiB, WS_WOUT = 10 * MiB, WS_WGU = 12 * MiB, WS_WDN = 23 * MiB;
constexpr size_t WS_W2T = 29 * MiB, WS_A2T = WS_W2T + 65536, WS_G2T = WS_A2T + 65536, WS_WA2T = WS_G2T + 196608;
constexpr size_t WS_SSQ = 496 * MiB;
constexpr size_t WS_XFIN = 336 * MiB;
constexpr size_t WS_XN = 32 * MiB;
constexpr size_t WS_P = 96 * MiB;
constexpr size_t WS_END = 500 * MiB;
constexpr int CW_BAR = 4096;
constexpr int RING_BYTES = 135168, LDS_BYTES = 163840, LDSCTL_OFF = LDS_BYTES - 1024, MISC_OFF = LDSCTL_OFF + 320, RSTAB_OFF = RING_BYTES + 448;

#define GAS __attribute__((address_space(1)))
#define LAS __attribute__((address_space(3)))
typedef unsigned short bf16;
typedef unsigned v4u __attribute__((ext_vector_type(4)));
typedef unsigned v2u __attribute__((ext_vector_type(2)));
typedef float f32x4 __attribute__((ext_vector_type(4)));
#define LDS_WAIT() asm volatile("s_waitcnt lgkmcnt(0)" ::: "memory")
#define VM_WAIT() asm volatile("s_waitcnt vmcnt(0)" ::: "memory")
#define LDS_BARRIER() do { asm volatile("s_waitcnt lgkmcnt(0)\n\ts_barrier" ::: "memory"); } while (0)
__device__ __forceinline__ unsigned f2bf(float f) { unsigned u = __builtin_bit_cast(unsigned, f); return (u + 0x7fffu + ((u >> 16) & 1u)) >> 16; }
__device__ __forceinline__ unsigned pk2(float lo, float hi) { return f2bf(lo) | (f2bf(hi) << 16); }
__device__ __forceinline__ float bf2f(bf16 u) { return __builtin_bit_cast(float, (unsigned)u << 16); }
__device__ __forceinline__ float bflo(unsigned w) { return __builtin_bit_cast(float, w << 16); }
__device__ __forceinline__ float bfhi(unsigned w) { return __builtin_bit_cast(float, w & 0xffff0000u); }
__device__ __forceinline__ float wave_sum(float v) {
#define WS_DPP(x, ctrl, rmask) __builtin_bit_cast(float, __builtin_amdgcn_update_dpp(0, __builtin_bit_cast(int, x), ctrl, rmask, 0xf, true))
    v += WS_DPP(v, 0x111, 0xf);
    v += WS_DPP(v, 0x112, 0xf);
    v += WS_DPP(v, 0x114, 0xf);
    v += WS_DPP(v, 0x118, 0xf);
    v += WS_DPP(v, 0x142, 0xa);
    v += WS_DPP(v, 0x143, 0xc);
#undef WS_DPP
    return __builtin_bit_cast(float, __builtin_amdgcn_readlane(__builtin_bit_cast(int, v), 63));
}
__device__ __forceinline__ float wave_max(float v) {
#pragma unroll
    for (int o = 1; o < 64; o <<= 1) v = fmaxf(v, __shfl_xor(v, o));
    return v;
}
__device__ __forceinline__ float fexp(float x) { return __builtin_amdgcn_exp2f(x * 1.4426950408889634f); }
__device__ __forceinline__ float flog(float x) { return __builtin_amdgcn_logf(x) * 0.6931471805599453f; }
__device__ __forceinline__ float frcp(float x) { return __builtin_amdgcn_rcpf(x); }
__device__ __forceinline__ float frsq(float x) { return __builtin_amdgcn_rsqf(x); }
__device__ __forceinline__ float fsqrt(float x) { return __builtin_amdgcn_sqrtf(x); }
__device__ __forceinline__ float sigmoid_f(float x) { return frcp(1.0f + fexp(-x)); }
__device__ __forceinline__ float softplus_f(float x) { return fmaxf(x, 0.f) + flog(1.0f + fexp(-fabsf(x))); }
__device__ __forceinline__ float tanh_f(float x) { return 1.0f - 2.0f * frcp(1.0f + fexp(2.0f * x)); }
#define XB_TMO      128
#define XB_XCNT(j)  (256  + 64 * (j))
#define XB_XSUB(j)  (1280 + 64 * (j))
#define XB_XGEN(j)  (2304 + 64 * (j))
#define XB_TOP      3328
#define XB_TOPGEN   3392
#define XCD_BAR_WORDS 3456
#define XB_SPIN_CAP (1u << 23)

__device__ __forceinline__ unsigned xb_ld(unsigned* p)              { return __hip_atomic_load(p, __ATOMIC_RELAXED, __HIP_MEMORY_SCOPE_AGENT); }
__device__ __forceinline__ unsigned xb_add(unsigned* p, unsigned v) { return __hip_atomic_fetch_add(p, v, __ATOMIC_RELAXED, __HIP_MEMORY_SCOPE_AGENT); }
__device__ __forceinline__ unsigned xb_xcc_id() { return (unsigned)__builtin_amdgcn_s_getreg((3 << 11) | 20) & 0xFu; }
#define XB_SPIN(cond, bar) do { unsigned _sp = 0; while (cond) { __builtin_amdgcn_s_sleep(1); \
    if ((++_sp & 255u) == 0u) { if (xb_ld(&(bar)[XB_TMO])) break; if (_sp > XB_SPIN_CAP) { atomicAdd(&(bar)[XB_TMO], 1u); break; } } } } while (0)

struct XcdBarrier {
    unsigned* bar; unsigned x;
    volatile LAS unsigned* st;
};

__device__ __forceinline__ XcdBarrier xcd_barrier_post(unsigned* bar, volatile LAS unsigned* st) {
    XcdBarrier b; b.bar = bar; b.x = xb_xcc_id(); b.st = st;
    if (threadIdx.x == 0) (void)xb_add(&bar[XB_XCNT(b.x)], 1u);
    return b;
}
__device__ __forceinline__ void xcd_barrier_complete(unsigned* bar, unsigned x, unsigned& nloc, unsigned& nx) {
    const unsigned G = gridDim.x * gridDim.y * gridDim.z;
    unsigned sum, cnt, mine, sp = 0u;
    for (;;) {
        sum = 0u; cnt = 0u; mine = 0u;
#pragma unroll
        for (unsigned j = 0; j < 16; ++j) { const unsigned c = xb_ld(&bar[XB_XCNT(j)]); sum += c; cnt += (c > 0u) ? 1u : 0u; mine = (j == x) ? c : mine; }
        if (sum == G) break;
        __builtin_amdgcn_s_sleep(1);
        if ((++sp & 255u) == 0u) { if (xb_ld(&bar[XB_TMO])) break; if (sp > XB_SPIN_CAP) { atomicAdd(&bar[XB_TMO], 1u); break; } }
    }
    nloc = mine > 0u ? mine : 1u; nx = cnt > 0u ? cnt : 1u;
}

__device__ __forceinline__ void xcd_barrier(const XcdBarrier& b) {
    asm volatile("s_waitcnt vmcnt(0)" ::: "memory");
    __syncthreads();
    if (threadIdx.x == 0) {
        unsigned blo_ = __builtin_amdgcn_readfirstlane((unsigned)(unsigned long long)b.bar), bhi_ = __builtin_amdgcn_readfirstlane((unsigned)((unsigned long long)b.bar >> 32)), bx = __builtin_amdgcn_readfirstlane(b.x); asm volatile("" : "+s"(blo_), "+s"(bhi_), "+s"(bx)); unsigned* bar = (unsigned*)(((unsigned long long)bhi_ << 32) | blo_);
        __builtin_amdgcn_s_waitcnt(0);
        unsigned nloc = b.st[0], nx = b.st[1];
        if (nloc == 0u) { xcd_barrier_complete(bar, bx, nloc, nx); b.st[0] = nloc; b.st[1] = nx; }
        const unsigned old = xb_add(&bar[XB_XSUB(bx)], 1u);
        const unsigned gen = old / nloc;
        if (old + 1u == (gen + 1u) * nloc) {
            __builtin_amdgcn_fence(__ATOMIC_RELEASE, "agent");
            asm volatile("s_waitcnt vmcnt(0)" ::: "memory");
            const unsigned og = xb_add(&bar[XB_TOP], 1u);
            const unsigned tg = og / nx;
            if (og + 1u == (tg + 1u) * nx) xb_add(&bar[XB_TOPGEN], 1u);
            else XB_SPIN(xb_ld(&bar[XB_TOPGEN]) == tg, bar);
            __builtin_amdgcn_fence(__ATOMIC_ACQUIRE, "agent");
            xb_add(&bar[XB_XGEN(bx)], 1u);
            asm volatile("s_waitcnt vmcnt(0)" ::: "memory");
        } else {
            XB_SPIN(xb_ld(&bar[XB_XGEN(bx)]) == gen, bar);
            __builtin_amdgcn_fence(__ATOMIC_ACQUIRE, "agent");
            asm volatile("s_waitcnt vmcnt(0)" ::: "memory");
        }
    }
    __syncthreads();
}
__device__ __forceinline__ void tr_item(const float* __restrict__ W, int Kreal, int N, bf16* WT, int ldd, int dst_row0, LAS float* scr, int k0, int n0, int lane,
                                        const float* __restrict__ mu, float sc0, float sc1, const float* __restrict__ gk = nullptr) {
    const int rr = lane >> 3, c4 = lane & 7, nn = n0 + 4 * c4; const bool nv = nn < N;
#pragma unroll
    for (int i = 0; i < 8; ++i) { const int kk = 8 * i + rr; f32x4 v = (nv && k0 + kk < Kreal) ? *(const GAS f32x4*)(W + (size_t)(k0 + kk) * N + nn) : (f32x4){0.f, 0.f, 0.f, 0.f};
        float sc = 1.0f; if (mu) sc = sc0 + sc1 * mu[k0 + kk]; if (gk) sc *= gk[k0 + kk]; v = v * sc;
        LAS float* d = scr + kk * 33 + 4 * c4; d[0] = v.x; d[1] = v.y; d[2] = v.z; d[3] = v.w; }
    LDS_WAIT(); asm volatile("" ::: "memory");
    const int c = lane & 7;
#pragma unroll
    for (int j = 0; j < 4; ++j) { const int n = (lane >> 3) + 8 * j; const LAS float* s = scr + (8 * c) * 33 + n;
        v4u o; o.x = pk2(s[0 * 33], s[1 * 33]); o.y = pk2(s[2 * 33], s[3 * 33]); o.z = pk2(s[4 * 33], s[5 * 33]); o.w = pk2(s[6 * 33], s[7 * 33]);
        if (n0 + n < N) *(GAS v4u*)(WT + (size_t)(dst_row0 + n) * ldd + k0 + 8 * c) = o; }
    LDS_WAIT(); asm volatile("" ::: "memory");
}
__device__ __forceinline__ void rms_row_bf16_to_f32(const bf16* xrow, const float* g, float* orow, int lane, float oscale = 1.0f) {
    const GAS v4u* xr = (const GAS v4u*)xrow + 2 * lane; const v4u a = xr[0], b = xr[1]; float v[16]; float s = 0.f;
    v[0] = bflo(a.x); v[1] = bfhi(a.x); v[2] = bflo(a.y); v[3] = bfhi(a.y); v[4] = bflo(a.z); v[5] = bfhi(a.z); v[6] = bflo(a.w); v[7] = bfhi(a.w);
    v[8] = bflo(b.x); v[9] = bfhi(b.x); v[10] = bflo(b.y); v[11] = bfhi(b.y); v[12] = bflo(b.z); v[13] = bfhi(b.z); v[14] = bflo(b.w); v[15] = bfhi(b.w);
#pragma unroll
    for (int e = 0; e < 16; ++e) s += v[e] * v[e];
    const float rs = frsq(wave_sum(s) * (1.f / D) + 1e-6f) * oscale;
    const GAS f32x4* gr = (const GAS f32x4*)g + 4 * lane; GAS f32x4* o = (GAS f32x4*)orow + 4 * lane;
#pragma unroll
    for (int q = 0; q < 4; ++q) { const f32x4 gv = gr[q]; o[q] = (f32x4){v[4 * q] * rs * gv.x, v[4 * q + 1] * rs * gv.y, v[4 * q + 2] * rs * gv.z, v[4 * q + 3] * rs * gv.w}; }
}
struct Args { const float* in[36]; float* out; unsigned char* ws; int lo, hi; };
typedef const __attribute__((address_space(4))) Args* ArgP;
#define FRESH_ARGS() ({ ArgP p_ = (ArgP)__builtin_amdgcn_kernarg_segment_ptr(); asm volatile("" : "+s"(p_)); p_; })
#define FRESH_V(x) asm volatile("" : "+v"(x))
#define FRESH_S(x) asm volatile("" : "+s"(x))

#define TR_JOB(items, nblk, Wp, Kd, Nd, DST, LDD, ROW0, MU, S0, S1, GK) if (r < (items)) { const int kb = r / (nblk), nb = r % (nblk), n0 = 32 * nb; tr_item(Wp, Kd, Nd, DST, LDD, ROW0, scr, 64 * kb, n0, lane, MU, S0, S1, GK); continue; } r -= (items);
__device__ __forceinline__ void convert_mixer_weights(ArgP A, int L, LAS unsigned char* lds, int wave, int lane, int gw, int NGW) {
    const int i = L >> 1; const bool even = !(L & 1);
    bf16* Win = (bf16*)(A->ws + WS_WIN); bf16* Wout = (bf16*)(A->ws + WS_WOUT);
    LAS float* scr = (LAS float*)(lds + wave * 16384);
    const float* gmix = A->in[2] + (size_t)L * D;
    const float* w_in = even ? A->in[5] + (size_t)i * D * 3072 : A->in[26] + (size_t)i * D * 3072;
    const float* w_out = even ? A->in[6] + (size_t)i * D * D : A->in[27] + (size_t)i * D * D;
    const float* mu_w = A->in[8] + (size_t)i * 3 * D, *mu_a = mu_w + D, *mu_g = mu_w + 2 * D;
    const float* w1 = A->in[10] + (size_t)i * D * 64, *a1 = A->in[13] + (size_t)i * D * 64, *g1 = A->in[15] + (size_t)i * D * 160, *wa1 = A->in[22] + (size_t)i * D * 16;
    const float* w2s = A->in[11] + (size_t)i * 64 * 512, *a2s = A->in[14] + (size_t)i * 64 * 512, *g2s = A->in[16] + (size_t)i * 160 * 512;
    bf16* W2T = (bf16*)(A->ws + WS_W2T); bf16* A2T = (bf16*)(A->ws + WS_A2T); bf16* G2T = (bf16*)(A->ws + WS_G2T);
    const int I_IN = 16 * 96, I_L64 = 16 * 2, I_L160 = 16 * 5, I_L16 = 16 * 1, I_OUT = 16 * 32;
    const int n_lora = even ? (4 * I_L64 + 2 * I_L160 + I_L16 + 16 + 16 + 48) : 0;
    const int NITEMS = I_IN + n_lora + I_OUT;
    for (int it = gw; it < NITEMS; it += NGW) {
        int r = it;
        TR_JOB(I_IN, 96, w_in, D, 3072, Win, D, n0, nullptr, 1.f, 0.f, gmix)
        if (even) {
            TR_JOB(I_L64, 2, w1, D, 64, Win, D, PC_W1A + n0, mu_w, 1.f, -1.f, gmix)
            TR_JOB(I_L64, 2, w1, D, 64, Win, D, PC_W1B + n0, mu_w, 0.f, 1.f, gmix)
            TR_JOB(I_L64, 2, a1, D, 64, Win, D, PC_A1A + n0, mu_a, 1.f, -1.f, gmix)
            TR_JOB(I_L64, 2, a1, D, 64, Win, D, PC_A1B + n0, mu_a, 0.f, 1.f, gmix)
            TR_JOB(I_L160, 5, g1, D, 160, Win, D, PC_G1A + n0, mu_g, 1.f, -1.f, gmix)
            TR_JOB(I_L160, 5, g1, D, 160, Win, D, PC_G1B + n0, mu_g, 0.f, 1.f, gmix)
            TR_JOB(I_L16, 1, wa1, D, 16, Win, D, PC_WA1 + n0, nullptr, 1.f, 0.f, gmix)
            TR_JOB(16, 16, w2s, 64, 512, W2T, 64, n0, nullptr, 1.f, 0.f, nullptr)
            TR_JOB(16, 16, a2s, 64, 512, A2T, 64, n0, nullptr, 1.f, 0.f, nullptr)
            TR_JOB(48, 16, g2s, 160, 512, G2T, 192, n0, nullptr, 1.f, 0.f, nullptr)
        }
        TR_JOB(I_OUT, 32, w_out, D, D, Wout, D, n0, nullptr, 1.f, 0.f, nullptr)
    }
    if (even) {
        const int gt = gw * 64 + lane, NT = NGW * 64;
        { unsigned z_ = 0u; asm volatile("" : "+v"(z_));
        for (int e = gt; e < (NIN_E - PC_PAD) * D / 8; e += NT) ((GAS v4u*)(Win + (size_t)PC_PAD * D))[e] = (v4u){z_, z_, z_, z_}; }
        bf16* WA2T = (bf16*)(A->ws + WS_WA2T); const float* wa2 = A->in[23] + (size_t)i * 16 * 256;
        for (int e = gt; e < 256 * 32; e += NT) { const int nn = e >> 5, k = e & 31; WA2T[e] = k < 16 ? (bf16)f2bf(wa2[k * 256 + nn]) : (bf16)0; }
    }
}
__device__ __forceinline__ void convert_ffn_weights(ArgP A, int L, LAS unsigned char* lds, int wave, int lane, int gw, int NGW) {
    bf16* Wgu = (bf16*)(A->ws + WS_WGU); bf16* Wdn = (bf16*)(A->ws + WS_WDN);
    LAS float* scr = (LAS float*)(lds + wave * 16384);
    const float* gffn = A->in[3] + (size_t)L * D;
    const float* wg = A->in[33] + (size_t)L * D * FF, *wu = A->in[34] + (size_t)L * D * FF, *wd = A->in[35] + (size_t)L * FF * D;
    const int I_GU = 16 * 88, I_DN = 44 * 32;
    for (int it = gw; it < 2 * I_GU + I_DN; it += NGW) {
        int r = it;
        TR_JOB(I_GU, 88, wg, D, FF, Wgu, D, 256 * (n0 >> 7) + (n0 & 127), nullptr, 1.f, 0.f, gffn)
        TR_JOB(I_GU, 88, wu, D, FF, Wgu, D, 256 * (n0 >> 7) + (n0 & 127) + 128, nullptr, 1.f, 0.f, gffn)
        TR_JOB(I_DN, 32, wd, FF, D, Wdn, FF, n0, nullptr, 1.f, 0.f, nullptr)
    }
}
#undef TR_JOB
__device__ __forceinline__ void x_to_bf16_ssq(const float* xrow, bf16* orow, float* ssq_row, int lane) {
    const GAS f32x4* xr = (const GAS f32x4*)xrow + lane; f32x4 v[4]; float s = 0.f;
#pragma unroll
    for (int j = 0; j < 4; ++j) { v[j] = xr[64 * j]; s += (v[j].x * v[j].x + v[j].y * v[j].y) + (v[j].z * v[j].z + v[j].w * v[j].w); }
    s = wave_sum(s); if (lane < 16) ssq_row[lane] = lane == 0 ? s : 0.f;
    GAS v2u* o8 = (GAS v2u*)orow + lane;
#pragma unroll
    for (int j = 0; j < 4; ++j) { v2u o; o.x = pk2(v[j].x, v[j].y); o.y = pk2(v[j].z, v[j].w); o8[64 * j] = o; }
}

__device__ __forceinline__ int t5_bucket(int d) {
    if (d < 16) return d;
    const float r = (float)d / 16.0f; int l = 16 + (int)(flog(r) / 2.0794415416798357f * 16.0f);
    return l < 31 ? l : 31;
}
typedef short a_bf16x8 __attribute__((ext_vector_type(8)));
typedef float f32x16 __attribute__((ext_vector_type(16)));
typedef short a_s16x4 __attribute__((ext_vector_type(4)));
constexpr int AT_K1 = 0, AT_K2 = 8192, AT_V = 16384, AT_ST = 32768, AT_NST = 4, AT_BIAS = AT_NST * AT_ST, AT_COMB = 0;
static_assert(AT_BIAS + 132 * 4 <= LDSCTL_OFF && 4 * 64 * 64 * 4 <= AT_BIAS, "attention LDS map");
__device__ __forceinline__ int crow16(int r, int hi) { return (r & 3) + 8 * (r >> 2) + 4 * hi; }
typedef float f32x2_t __attribute__((ext_vector_type(2))); typedef __bf16 bf16x2_t __attribute__((ext_vector_type(2)));
__device__ __forceinline__ unsigned cvtpk(float lo, float hi) { const f32x2_t v = {lo, hi}; const bf16x2_t b = __builtin_convertvector(v, bf16x2_t); return __builtin_bit_cast(unsigned, b); }

template <bool HALFSYNC = false> __device__ __forceinline__ void attn_unit_mfma(ArgP A, int L, int b, int h, int qb, float lam, float lam_init, LAS unsigned char* lds, int tid) {
    const int lane = tid & 63, wave = __builtin_amdgcn_readfirstlane(tid >> 6), r32 = lane & 31, hi = lane >> 5;
    const int smap = wave >> 2, qs = wave & 3;
    const int i = L >> 1;
    const bf16* QKV = (const bf16*)(A->ws + WS_P); bf16* O = (bf16*)(A->ws + WS_XN);
    const int q0 = qb * 128, qw0 = q0 + 32 * qs, nt = (q0 + 128) / 64;
    const size_t rowb = (size_t)b * T;
    if (tid < 129) { const float far = A->in[1][31 * 8 + h]; ((LAS float*)(lds + AT_BIAS))[tid] = tid < 128 ? (A->in[1][t5_bucket(tid) * 8 + h] - far) * 1.4426950408889634f : 0.f; }
    a_bf16x8 qf[4];
    { const bf16* qrow = QKV + (rowb + qw0 + r32) * NIN_O + h * 128 + smap * 64 + 8 * hi;
#pragma unroll
      for (int ks = 0; ks < 4; ++ks) qf[ks] = *(const GAS a_bf16x8*)(qrow + 16 * ks); }
    const int kr = 8 * wave + (lane >> 3), kcs = (lane & 7) ^ ((kr >> 1) & 7);
    const bf16* kg = QKV + (rowb + kr) * NIN_O + 1024 + h * 128 + 8 * kcs;
    const int vr0 = 8 * wave + (lane >> 4), vr1 = vr0 + 4;
    const bf16* vg0 = QKV + (rowb + vr0) * NIN_O + 2048 + h * 128 + 8 * ((lane & 15) ^ (((vr0 & 3) << 2) | ((vr0 >> 2) & 3)));
    const bf16* vg1 = QKV + (rowb + vr1) * NIN_O + 2048 + h * 128 + 8 * ((lane & 15) ^ (((vr1 & 3) << 2) | ((vr1 >> 2) & 3)));
#define AT_DMA(kt, stoff) do { const size_t go_ = (size_t)(kt) * 64 * NIN_O; LAS unsigned char* sb_ = lds + (stoff) + wave * 1024; \
        __builtin_amdgcn_global_load_lds((const unsigned*)(kg + go_), (LAS unsigned*)(sb_ + AT_K1), 16, 0, 0); __builtin_amdgcn_global_load_lds((const unsigned*)(kg + go_ + 64), (LAS unsigned*)(sb_ + AT_K2), 16, 0, 0); \
        __builtin_amdgcn_global_load_lds((const unsigned*)(vg0 + go_), (LAS unsigned*)(sb_ + AT_V + wave * 1024), 16, 0, 0); __builtin_amdgcn_global_load_lds((const unsigned*)(vg1 + go_), (LAS unsigned*)(sb_ + AT_V + wave * 1024 + 1024), 16, 0, 0); } while (0)
    AT_DMA(0, 0); AT_DMA(1, AT_ST);
    __syncthreads();
    f32x16 o[4];
#pragma unroll
    for (int d = 0; d < 4; ++d)
#pragma unroll
        for (int r = 0; r < 16; ++r) o[d][r] = 0.f;
    float m = -1e30f, l = 0.f;
    const int kfo = (smap ? AT_K2 : AT_K1) + r32 * 128, khg = hi ^ ((r32 >> 1) & 7);
    int vfo[2][4];
    { const int q = (lane & 15) >> 2, pp = lane & 3, blk = (lane >> 4) & 1;
#pragma unroll
      for (int t = 0; t < 2; ++t)
#pragma unroll
          for (int d = 0; d < 4; ++d) vfo[t][d] = AT_V + 256 * (4 * hi + q + 8 * t) + 16 * (((d ^ q) << 2) | ((2 * blk + (pp >> 1)) ^ ((hi + 2 * t) & 3))) + 8 * (pp & 1); }
    const LAS float* bdl = (const LAS float*)(lds + AT_BIAS);
    const int qme = qw0 + r32;
#define AT_VREAD(VF, kk) do { _Pragma("unroll") for (int d = 0; d < 4; ++d) { \
                VF[2 * d] = __builtin_bit_cast(a_s16x4, __builtin_amdgcn_ds_read_tr16_b64_v4i16((LAS a_s16x4*)(sbv + vfo[0][d] + (kk) * 4096))); VF[2 * d + 1] = __builtin_bit_cast(a_s16x4, __builtin_amdgcn_ds_read_tr16_b64_v4i16((LAS a_s16x4*)(sbv + vfo[1][d] + (kk) * 4096))); } } while (0)
#define AT_PV(VF, PF, kk) do { _Pragma("unroll") for (int d = 0; d < 4; ++d) { const a_bf16x8 vf_ = (a_bf16x8){VF[2 * d][0], VF[2 * d][1], VF[2 * d][2], VF[2 * d][3], VF[2 * d + 1][0], VF[2 * d + 1][1], VF[2 * d + 1][2], VF[2 * d + 1][3]}; \
                o[d] = __builtin_amdgcn_mfma_f32_32x32x16_bf16(vf_, PF[kk], o[d], 0, 0, 0); } } while (0)
    int pbase = 0;
#pragma unroll 1
    for (int kt0 = 0; kt0 < nt; kt0 += 2) {
        const int nbase = pbase ? 0 : 2 * AT_ST;
#pragma unroll 1
      for (int sub = 0; sub < 2; ++sub) { const int kt = kt0 + sub; const int stoff = pbase + sub * AT_ST;
        if (sub == 0 && kt + 2 < nt) { AT_DMA(kt + 2, nbase); AT_DMA(kt + 3, nbase + AT_ST); }
        const int key0 = 64 * kt;
        if (key0 <= qw0 + 31) {
            const LAS unsigned char* sb = lds + stoff; const LAS unsigned char* sbv = sb;
            f32x16 p[2]; a_bf16x8 kf[8];
#pragma unroll
            for (int f = 0; f < 8; ++f) kf[f] = *(const LAS a_bf16x8*)(sb + kfo + (f >> 2) * 4096 + ((khg ^ (2 * (f & 3))) * 16));
            __builtin_amdgcn_sched_barrier(0);
            __builtin_amdgcn_s_setprio(1);
#pragma unroll
            for (int blk = 0; blk < 2; ++blk) {
#pragma unroll
                for (int r = 0; r < 16; ++r) p[blk][r] = 0.f;
#pragma unroll
                for (int ks = 0; ks < 4; ++ks) p[blk] = __builtin_amdgcn_mfma_f32_32x32x16_bf16(kf[blk * 4 + ks], qf[ks], p[blk], 0, 0, 0);
            }
            __builtin_amdgcn_s_setprio(0);
            if (key0 + 63 + 128 > qw0) {
#pragma unroll
                for (int blk = 0; blk < 2; ++blk) { float bvv[16];
#pragma unroll
                    for (int r = 0; r < 16; ++r) { const unsigned ud = (unsigned)(qme - (key0 + 32 * blk + crow16(r, hi))); bvv[r] = bdl[ud < 128u ? ud : 128u]; }
                    asm volatile("" : "+v"(bvv[0]), "+v"(bvv[1]), "+v"(bvv[2]), "+v"(bvv[3]), "+v"(bvv[4]), "+v"(bvv[5]), "+v"(bvv[6]), "+v"(bvv[7]), "+v"(bvv[8]), "+v"(bvv[9]), "+v"(bvv[10]), "+v"(bvv[11]), "+v"(bvv[12]), "+v"(bvv[13]), "+v"(bvv[14]), "+v"(bvv[15]));
#pragma unroll
                    for (int r = 0; r < 16; ++r) { const int dist = qme - (key0 + 32 * blk + crow16(r, hi)); p[blk][r] = dist < 0 ? -1e30f : p[blk][r] + bvv[r]; } }
            }
            float mx = p[0][0];
#pragma unroll
            for (int r = 1; r < 16; ++r) mx = fmaxf(mx, p[0][r]);
#pragma unroll
            for (int r = 0; r < 16; ++r) mx = fmaxf(mx, p[1][r]);
            { const auto sw_ = __builtin_amdgcn_permlane32_swap(__builtin_bit_cast(unsigned, mx), __builtin_bit_cast(unsigned, mx), false, false);
              mx = fmaxf(__builtin_bit_cast(float, sw_[0]), __builtin_bit_cast(float, sw_[1])); }
            if (__any(mx > m + 8.0f)) {
                const float mn = fmaxf(m, mx), al = __builtin_amdgcn_exp2f(m - mn); m = mn; l *= al;
#pragma unroll
                for (int d = 0; d < 4; ++d)
#pragma unroll
                    for (int r = 0; r < 16; ++r) o[d][r] *= al;
            }
            float ls = 0.f;
#define AT_EXPPK(PF, kk) do { const int blk_ = (kk) >> 1, s8_ = 8 * ((kk) & 1); float e_[8]; _Pragma("unroll") for (int j = 0; j < 8; ++j) { e_[j] = __builtin_amdgcn_exp2f(p[blk_][s8_ + j] - m); ls += e_[j]; } \
                v4u w_; w_.x = cvtpk(e_[0], e_[1]); w_.y = cvtpk(e_[2], e_[3]); w_.z = cvtpk(e_[4], e_[5]); w_.w = cvtpk(e_[6], e_[7]); PF[kk] = __builtin_bit_cast(a_bf16x8, w_); } while (0)
            {
                a_bf16x8 pf[4]; a_s16x4 vA[8], vB[8];
                AT_VREAD(vA, 0); AT_EXPPK(pf, 0);
                __builtin_amdgcn_sched_barrier(0);
                AT_VREAD(vB, 1); AT_PV(vA, pf, 0); AT_EXPPK(pf, 1);
                __builtin_amdgcn_sched_barrier(0);
                AT_VREAD(vA, 2); AT_PV(vB, pf, 1); AT_EXPPK(pf, 2);
                __builtin_amdgcn_sched_barrier(0);
                AT_VREAD(vB, 3); AT_PV(vA, pf, 2); AT_EXPPK(pf, 3);
                __builtin_amdgcn_sched_barrier(0);
                AT_PV(vB, pf, 3);
            }
            l += ls;
#undef AT_EXPPK
        }
      }
        __syncthreads();
        pbase = nbase;
    }
#undef AT_VREAD
#undef AT_PV
#undef AT_DMA
    l += __shfl_xor(l, 32);
    LAS float* comb = (LAS float*)(lds + AT_COMB) + qs * 4096;
    if (smap == 1) { const float sc = lam * frcp(l);
#pragma unroll
        for (int d = 0; d < 4; ++d)
#pragma unroll
            for (int r = 0; r < 16; ++r) comb[(d * 16 + r) * 64 + lane] = o[d][r] * sc; }
    __syncthreads();
    if (smap == 0) {
        const float il = frcp(l); float ss = 0.f;
#pragma unroll
        for (int d = 0; d < 4; ++d)
#pragma unroll
            for (int r = 0; r < 16; ++r) { const float v = o[d][r] * il - comb[(d * 16 + r) * 64 + lane]; o[d][r] = v; ss += v * v; }
        ss += __shfl_xor(ss, 32);
        const float rs = frsq(ss * (1.f / 128.f) + 1e-5f) * (1.0f - lam_init);
        const float* sl = A->in[32] + i * 128;
        bf16* orow = O + (rowb + qw0 + r32) * D + h * 128;
#pragma unroll
        for (int d = 0; d < 4; ++d)
#pragma unroll
            for (int g4 = 0; g4 < 4; ++g4) { const int dc = 32 * d + 8 * g4 + 4 * hi; const f32x4 s4 = *(const GAS f32x4*)(sl + dc);
                v2u w; w.x = cvtpk(o[d][4 * g4] * rs * s4.x, o[d][4 * g4 + 1] * rs * s4.y); w.y = cvtpk(o[d][4 * g4 + 2] * rs * s4.z, o[d][4 * g4 + 3] * rs * s4.w);
                *(GAS v2u*)(orow + dc) = w; }
    }
    __syncthreads();
}

template <bool HALFSYNC = false> __device__ __forceinline__ void attn_phase_mfma(ArgP A, int L, LAS unsigned char* lds, int tid, int G, int bid) {
    const int lane = tid & 63, i = L >> 1;
    const float lam_init = 0.8f - 0.6f * fexp(-0.3f * (float)L);
    const float lam = fexp(wave_sum(A->in[28][i * 64 + lane] * A->in[29][i * 64 + lane])) - fexp(wave_sum(A->in[30][i * 64 + lane] * A->in[31][i * 64 + lane])) + lam_init;
    if (G == 256) {
        const int v = (bid & 7) * 32 + (bid >> 3), bh = v >> 2, j = v & 3;
#pragma unroll 1
        for (int u = 0; u < 8; ++u) { const int qb = 8 * (u >> 1) + ((u & 1) ? 7 - j : j); attn_unit_mfma<HALFSYNC>(A, L, bh >> 3, bh & 7, qb, lam, lam_init, lds, tid); }
    } else {
#pragma unroll 1
        for (int u = bid; u < 64 * 32; u += G) attn_unit_mfma<HALFSYNC>(A, L, (u >> 5) >> 3, (u >> 5) & 7, 31 - (u & 31), lam, lam_init, lds, tid);
    }
}
typedef short bf16x8_t __attribute__((ext_vector_type(8)));
constexpr int MS = 72, MB = 64 * MS * 2;
constexpr int RW_XW = 8 * MB, RW_XA = RW_XW + 16384;
constexpr int RW_TOT = 14 * MB, RW_GAM = RW_TOT + 2048, RW_END = RW_GAM + 256;
static_assert(RW_XA + 16384 <= 12 * MB && RW_END <= RING_BYTES, "RWKV LDS map");
constexpr size_t WS_RWI = 336 * MiB;
constexpr size_t WS_BON = 30 * MiB;
#define RBUF(k) ((LAS bf16*)(lds + (k) * MB))
__device__ __forceinline__ f32x4 mfma16(bf16x8_t a, bf16x8_t b, f32x4 c) { return __builtin_amdgcn_mfma_f32_16x16x32_bf16(a, b, c, 0, 0, 0); }
__device__ __forceinline__ bf16x8_t ldfrag(const LAS bf16* Mx, int row0, int k0, int lane) { return *(const LAS bf16x8_t*)(Mx + (row0 + (lane & 15)) * MS + k0 + 8 * (lane >> 4)); }
__device__ __forceinline__ f32x4 mm64(f32x4 acc, const LAS bf16* Am, int ra, const LAS bf16* BTm, int cb, int lane) {
    acc = mfma16(ldfrag(Am, 16 * ra, 0, lane), ldfrag(BTm, 16 * cb, 0, lane), acc);
    return mfma16(ldfrag(Am, 16 * ra, 32, lane), ldfrag(BTm, 16 * cb, 32, lane), acc);
}
__device__ __forceinline__ v2u pack4(f32x4 a) { v2u w; w.x = cvtpk(a[0], a[1]); w.y = cvtpk(a[2], a[3]); return w; }
__device__ __forceinline__ void tstore(LAS bf16* Dm, int rt, int ct, f32x4 acc, int lane) { *(LAS v2u*)(Dm + (16 * ct + (lane & 15)) * MS + 16 * rt + 4 * (lane >> 4)) = pack4(acc); }
__device__ __forceinline__ void tstore_g(bf16* Dg, int rt, int ct, f32x4 acc, int lane) { *(GAS v2u*)(Dg + (16 * ct + (lane & 15)) * 64 + 16 * rt + 4 * (lane >> 4)) = pack4(acc); }
__device__ __forceinline__ f32x4 ld4bf(const LAS bf16* p) { const v2u w = *(const LAS v2u*)p; return (f32x4){bflo(w.x), bfhi(w.x), bflo(w.y), bfhi(w.y)}; }
__device__ __forceinline__ f32x4 ld4bf_g(const bf16* p) { const v2u w = *(const GAS v2u*)p; return (f32x4){bflo(w.x), bfhi(w.x), bflo(w.y), bfhi(w.y)}; }
__device__ __forceinline__ void unpack8(v4u w, float (&f)[8]) { f[0] = bflo(w.x); f[1] = bfhi(w.x); f[2] = bflo(w.y); f[3] = bfhi(w.y); f[4] = bflo(w.z); f[5] = bfhi(w.z); f[6] = bflo(w.w); f[7] = bfhi(w.w); }
__device__ __forceinline__ bf16x8_t pack8(const float (&f)[8]) { v4u w; w.x = cvtpk(f[0], f[1]); w.y = cvtpk(f[2], f[3]); w.z = cvtpk(f[4], f[5]); w.w = cvtpk(f[6], f[7]); return __builtin_bit_cast(bf16x8_t, w); }

__device__ __forceinline__ void rwkv_chunk_phase(ArgP A, int L, LAS unsigned char* lds, int tid, int G, int bid) {
    const int lane = tid & 63, wave = __builtin_amdgcn_readfirstlane(tid >> 6), i = L >> 1;
    const int l15 = lane & 15, lg = lane >> 4;
    const bf16* P = (const bf16*)(A->ws + WS_P); bf16* XNb = (bf16*)(A->ws + WS_XN);
    const int rt = wave >> 1, ct0 = 2 * (wave & 1);
    constexpr int NIT = BATCH * 64 * 8;
    v4u pw[2][2], pa[2][2]; unsigned short pe[9][3];
#ifdef PROBE_R1
#define R1_STAMP(k) do { if (tid == 0 && bid == PROBE_BLOCK) { LAS unsigned long long* t_ = (LAS unsigned long long*)(lds + LDSCTL_OFF + 640); const unsigned long long now_ = __builtin_amdgcn_s_memrealtime(); t_[1 + (k)] += now_ - t_[0]; t_[0] = now_; } } while (0)
#else
#define R1_STAMP(k) do { } while (0)
#endif
#define R1_PREFETCH(itx) do { const int b_ = (itx) >> 9, n_ = ((itx) >> 3) & 63, h_ = (itx) & 7; const size_t rowb_ = (size_t)b_ * T + 64 * n_; \
        { const int tt_ = 16 * rt + l15; const bf16* prow_ = P + (rowb_ + tt_) * NIN_E; const bool hp_ = (64 * n_ + tt_) > 0; const v4u z4_ = (v4u){0u, 0u, 0u, 0u}; \
          _Pragma("unroll") for (int q = 0; q < 2; ++q) { const int kc_ = 32 * q + 8 * lg; pw[q][0] = *(const GAS v4u*)(prow_ + PC_W1A + kc_); pw[q][1] = hp_ ? *(const GAS v4u*)(prow_ - NIN_E + PC_W1B + kc_) : z4_; \
              pa[q][0] = *(const GAS v4u*)(prow_ + PC_A1A + kc_); pa[q][1] = hp_ ? *(const GAS v4u*)(prow_ - NIN_E + PC_A1B + kc_) : z4_; } \
          } \
        { const int c_ = 64 * h_ + lane; const size_t row0_ = rowb_ + 8 * wave; const bool hp_ = (64 * n_ + 8 * wave) > 0; \
          _Pragma("unroll") for (int u = 0; u < 9; ++u) { const bf16* pp_ = P + (row0_ + u - 1) * NIN_E; const bool ok_ = u > 0 || hp_; \
              pe[u][0] = ok_ ? pp_[PC_R + c_] : (unsigned short)0; pe[u][1] = ok_ ? pp_[PC_K + c_] : (unsigned short)0; pe[u][2] = ok_ ? pp_[PC_V + c_] : (unsigned short)0; } } } while (0)
    if (bid < NIT) R1_PREFETCH(bid);
#ifdef PROBE_R1
    if (tid == 0 && bid == PROBE_BLOCK) ((LAS unsigned long long*)(lds + LDSCTL_OFF + 640))[0] = __builtin_amdgcn_s_memrealtime();
#endif
#pragma unroll 1
    for (int it = bid; it < NIT; it += G) {
    R1_STAMP(0);
    const int b = it >> 9, n = (it >> 3) & 63, h = it & 7;
    const size_t rowb = (size_t)b * T + 64 * n;
    bf16* item = (bf16*)(A->ws + WS_RWI) + ((size_t)((b * 8 + h) * 64 + n)) * 16384;
    asm volatile("; MARK_R1_E1");
    {
        const bf16* W2T = (const bf16*)(A->ws + WS_W2T); const bf16* A2T = (const bf16*)(A->ws + WS_A2T);
        f32x4 xw[2], xa[2];
#pragma unroll
        for (int c = 0; c < 2; ++c) { xw[c] = (f32x4){0.f, 0.f, 0.f, 0.f}; xa[c] = (f32x4){0.f, 0.f, 0.f, 0.f}; }
#pragma unroll
        for (int q = 0; q < 2; ++q) {
            const int kc = 32 * q + 8 * lg; float x[8], y[8], v[8];
            unpack8(pw[q][0], x); unpack8(pw[q][1], y);
#pragma unroll
            for (int e = 0; e < 8; ++e) v[e] = tanh_f(x[e] + y[e]);
            const bf16x8_t fw = pack8(v);
            unpack8(pa[q][0], x); unpack8(pa[q][1], y);
#pragma unroll
            for (int e = 0; e < 8; ++e) v[e] = x[e] + y[e];
            const bf16x8_t fa = pack8(v);
#pragma unroll
            for (int c = 0; c < 2; ++c) { const size_t wo = (size_t)(64 * h + 16 * (ct0 + c) + l15) * 64 + kc;
                xw[c] = mfma16(fw, *(const GAS bf16x8_t*)(W2T + wo), xw[c]); xa[c] = mfma16(fa, *(const GAS bf16x8_t*)(A2T + wo), xa[c]); }
        }
        LAS float* XW = (LAS float*)(lds + RW_XW); LAS float* XA = (LAS float*)(lds + RW_XA);
#pragma unroll
        for (int c = 0; c < 2; ++c)
#pragma unroll
            for (int r = 0; r < 4; ++r) { const int o = (16 * rt + 4 * lg + r) * 64 + 16 * (ct0 + c) + l15; XW[o] = xw[c][r]; XA[o] = xa[c][r]; }
    }
    LDS_BARRIER();
    R1_STAMP(1);
    asm volatile("; MARK_R1_E2");
    {
        const int c = 64 * h + lane;
        const float* mu = A->in[7] + (size_t)i * 1536;
        const float mur = mu[c], muk = mu[512 + c], muv = mu[1024 + c];
        const float kkc = A->in[17][i * 512 + c], kac = A->in[18][i * 512 + c], rkc = A->in[19][i * 512 + c], w0c = A->in[9][i * 512 + c], a0c = A->in[12][i * 512 + c];
        const LAS float* XW = (const LAS float*)(lds + RW_XW); const LAS float* XA = (const LAS float*)(lds + RW_XA);
        float* BON = (float*)(A->ws + WS_BON);
        const int tt0 = 8 * wave; const size_t row0 = rowb + tt0;
        float pr_p = bf2f(pe[0][0]), pk_p = bf2f(pe[0][1]), pv_p = bf2f(pe[0][2]);
        float rr[8], av[8], bv[8], km[8], vv[8], lc[8];
        float run = 0.f;
#pragma unroll
        for (int u = 0; u < 8; ++u) {
            const float pR = bf2f(pe[u + 1][0]), pK = bf2f(pe[u + 1][1]), pV = bf2f(pe[u + 1][2]);
            const float r = pR + (pr_p - pR) * mur, k = pK + (pk_p - pK) * muk, v = pV + (pv_p - pV) * muv; pr_p = pR; pk_p = pK; pv_p = pV;
            const float xw = w0c + XW[(tt0 + u) * 64 + lane], xa = a0c + XA[(tt0 + u) * 64 + lane];
            const float wlog = -0.6065306597126334f * sigmoid_f(xw), as = sigmoid_f(xa);
            float kk = k * kkc; const float n2 = wave_sum(kk * kk); kk = kk * frsq(fmaxf(n2, 1e-24f));
            const float kmod = k * (1.f + (as - 1.f) * kac);
            const float bon = wave_sum(r * kmod * rkc);
            if (lane == 0) BON[(row0 + u) * 8 + h] = bon;
            run += wlog; rr[u] = r; av[u] = -kk; bv[u] = kk * as; km[u] = kmod; vv[u] = v; lc[u] = run;
        }
        LAS float* TOT = (LAS float*)(lds + RW_TOT);
        TOT[wave * 64 + lane] = run;
        LDS_BARRIER();
        float off = 0.f, tot = 0.f;
#pragma unroll
        for (int w2 = 0; w2 < 8; ++w2) { const float tv = TOT[w2 * 64 + lane]; tot += tv; if (w2 < wave) off += tv; }
        if (wave == 0) ((LAS float*)(lds + RW_GAM))[lane] = fexp(tot);
        float fR[8], fA[8], fB[8], fK[8];
        float eprev = fexp(off);
#pragma unroll
        for (int u = 0; u < 8; ++u) { const float cum = off + lc[u], e1 = fexp(cum), ei = frcp(e1); fR[u] = rr[u] * e1; fA[u] = av[u] * eprev; fB[u] = bv[u] * ei; fK[u] = km[u] * ei; eprev = e1; }
        LAS bf16* At = RBUF(0); LAS bf16* Bt = RBUF(1); LAS bf16* Kt = RBUF(2); LAS bf16* Rt = RBUF(3);
#pragma unroll
        for (int u = 0; u < 8; ++u) { const int o = (tt0 + u) * MS + lane; At[o] = (bf16)f2bf(fA[u]); Bt[o] = (bf16)f2bf(fB[u]); Kt[o] = (bf16)f2bf(fK[u]); Rt[o] = (bf16)f2bf(fR[u]); }
        *(LAS bf16x8_t*)(RBUF(4) + lane * MS + tt0) = pack8(fA); *(LAS bf16x8_t*)(RBUF(5) + lane * MS + tt0) = pack8(fB);
        *(LAS bf16x8_t*)(RBUF(6) + lane * MS + tt0) = pack8(fK); *(LAS bf16x8_t*)(RBUF(7) + lane * MS + tt0) = pack8(vv);
    }
    asm volatile("" ::: "memory");
    if (it + G < NIT) R1_PREFETCH(it + G);
    LDS_BARRIER();
    R1_STAMP(2);
    asm volatile("; MARK_R1_G");
    {
        const LAS bf16* At = RBUF(0); const LAS bf16* Bt = RBUF(1); const LAS bf16* Kt = RBUF(2); const LAS bf16* Rt = RBUF(3);
        unsigned zu_ = 0u; asm volatile("" : "+v"(zu_));
#define R1_FRAG1(x) __builtin_bit_cast(bf16x8_t, (v4u){cvtpk((x)[0], (x)[1]), cvtpk((x)[2], (x)[3]), zu_, zu_})
#define R1_FRAG2(x, y) __builtin_bit_cast(bf16x8_t, (v4u){cvtpk((x)[0], (x)[1]), cvtpk((x)[2], (x)[3]), cvtpk((y)[0], (y)[1]), cvtpk((y)[2], (y)[3])})
#pragma unroll
        for (int c = 0; c < 2; ++c) { const int ct = ct0 + c; const f32x4 z = (f32x4){0.f, 0.f, 0.f, 0.f};
            f32x4 aL = mm64(z, Bt, rt, At, ct, lane);
            f32x4 aAKT = mm64(z, At, rt, Kt, ct, lane);
            f32x4 aRB = mm64(z, Bt, rt, Rt, ct, lane);
            f32x4 aRK = mm64(z, Kt, rt, Rt, ct, lane);
            const int col = 16 * ct + l15;
#pragma unroll
            for (int r = 0; r < 4; ++r) { const int row = 16 * rt + 4 * lg + r;
                if (!(row < col)) aL[r] = 0.f;
                if (!(col < row)) aAKT[r] = 0.f;
                if (!(row <= col)) { aRB[r] = 0.f; aRK[r] = 0.f; } }
            tstore(RBUF(8), rt, ct, aL, lane); tstore(RBUF(10), rt, ct, aAKT, lane); tstore(RBUF(11), rt, ct, aRB, lane); tstore(RBUF(12), rt, ct, aRK, lane);
            if (rt == ct) {
                f32x4 Mx = mm64(z, At, rt, Bt, ct, lane), MTx = aL, YT;
#pragma unroll
                for (int r = 0; r < 4; ++r) { if (!(l15 < 4 * lg + r)) Mx[r] = 0.f; YT[r] = (4 * lg + r) == l15 ? 1.f : 0.f; }
#pragma unroll
                for (int m = 0; m < 4; ++m) { const bf16x8_t fM = R1_FRAG1(Mx), fMT = R1_FRAG1(MTx), fY = R1_FRAG1(YT);
                    YT = mfma16(fM, fY, YT);
                    if (m < 3) { Mx = mfma16(fMT, fM, z); MTx = mfma16(fM, fMT, z); } }
                ((LAS v2u*)(lds + 9 * MB))[rt * 64 + lane] = pack4(YT);
            }
        }
    }
    LDS_BARRIER();
    R1_STAMP(3);
    asm volatile("; MARK_R1_N");
    {
        const int cw = wave & 3; const bool second = wave >= 4;
        const LAS bf16* RT = (second ? RBUF(10) : RBUF(4)) + (16 * cw + l15) * MS + 4 * lg;
        const LAS bf16* Lr = RBUF(8) + l15 * MS + 4 * lg;
        const LAS v2u* DFp = (const LAS v2u*)(lds + 9 * MB) + lane;
        unsigned zu_ = 0u; asm volatile("" : "+v"(zu_));
        const f32x4 z = (f32x4){0.f, 0.f, 0.f, 0.f};
        f32x4 R[4]; v2u df[4], l10, l20a, l20b, l30a, l30b, l32;
#pragma unroll
        for (int b4 = 0; b4 < 4; ++b4) { R[b4] = ld4bf(RT + 16 * b4); df[b4] = DFp[b4 * 64]; }
        l10 = *(const LAS v2u*)(Lr + 16 * MS);
        l20a = *(const LAS v2u*)(Lr + 32 * MS); l20b = *(const LAS v2u*)(Lr + 32 * MS + 16);
        l30a = *(const LAS v2u*)(Lr + 48 * MS); l30b = *(const LAS v2u*)(Lr + 48 * MS + 16); l32 = *(const LAS v2u*)(Lr + 48 * MS + 32);
#define R1_DF(b4) __builtin_bit_cast(bf16x8_t, (v4u){df[b4].x, df[b4].y, zu_, zu_})
#define R1_LF(a, b) __builtin_bit_cast(bf16x8_t, (v4u){(a).x, (a).y, (b).x, (b).y})
        const v2u zz2 = (v2u){zu_, zu_};
        f32x4 Z0, Z1, Z2, Z3, acc;
        Z0 = mfma16(R1_DF(0), R1_FRAG1(R[0]), z);
        acc = mfma16(R1_LF(l10, zz2), R1_FRAG1(Z0), R[1]); Z1 = mfma16(R1_DF(1), R1_FRAG1(acc), z);
        acc = mfma16(R1_LF(l20a, l20b), R1_FRAG2(Z0, Z1), R[2]); Z2 = mfma16(R1_DF(2), R1_FRAG1(acc), z);
        acc = mfma16(R1_LF(l30a, l30b), R1_FRAG2(Z0, Z1), R[3]); acc = mfma16(R1_LF(l32, zz2), R1_FRAG1(Z2), acc); Z3 = mfma16(R1_DF(3), R1_FRAG1(acc), z);
        if (!second) {
            LAS bf16* O = RBUF(13) + (16 * cw + l15) * MS + 4 * lg;
            *(LAS v2u*)(O) = pack4(Z0); *(LAS v2u*)(O + 16) = pack4(Z1); *(LAS v2u*)(O + 32) = pack4(Z2); *(LAS v2u*)(O + 48) = pack4(Z3);
        } else {
            LAS bf16* O = RBUF(1) + (4 * lg) * MS + 16 * cw + l15;
#define R1_ST4(Zx, b4) do { const v2u w_ = pack4(Zx); O[(16 * (b4) + 0) * MS] = (bf16)(w_.x & 0xffffu); O[(16 * (b4) + 1) * MS] = (bf16)(w_.x >> 16); O[(16 * (b4) + 2) * MS] = (bf16)(w_.y & 0xffffu); O[(16 * (b4) + 3) * MS] = (bf16)(w_.y >> 16); } while (0)
            R1_ST4(Z0, 0); R1_ST4(Z1, 1); R1_ST4(Z2, 2); R1_ST4(Z3, 3);
#undef R1_ST4
        }
#undef R1_DF
#undef R1_LF
    }
#undef R1_FRAG1
#undef R1_FRAG2
    LDS_BARRIER();
    R1_STAMP(4);
    asm volatile("; MARK_R1_F1");
    {
    {
#pragma unroll
        for (int c = 0; c < 2; ++c) { const int ct = ct0 + c; const f32x4 z = (f32x4){0.f, 0.f, 0.f, 0.f};
            tstore(RBUF(0), rt, ct, mm64(z, RBUF(1), rt, RBUF(7), ct, lane), lane); }
    }
    LDS_BARRIER();
    R1_STAMP(5);
    {
        const LAS float* GAM = (const LAS float*)(lds + RW_GAM);
#pragma unroll
        for (int c = 0; c < 2; ++c) { const int ct = ct0 + c; const f32x4 z = (f32x4){0.f, 0.f, 0.f, 0.f};
            const f32x4 r0 = ld4bf(RBUF(3) + (16 * ct + l15) * MS + 16 * rt + 4 * lg);
            tstore_g(item, rt, ct, mm64(r0, RBUF(13), rt, RBUF(11), ct, lane), lane);
            f32x4 pp = mm64(z, RBUF(13), rt, RBUF(5), ct, lane);
            const float gm = GAM[16 * ct + l15];
#pragma unroll
            for (int r = 0; r < 4; ++r) pp[r] = gm * (pp[r] + ((16 * rt + 4 * lg + r) == (16 * ct + l15) ? 1.f : 0.f));
            *(GAS v2u*)(item + 8192 + (((ct * 2 + (rt >> 1)) * 64 + lane) * 8 + 4 * (rt & 1))) = pack4(pp);
            f32x4 y0 = mm64(z, RBUF(0), rt, RBUF(11), ct, lane); y0 = mm64(y0, RBUF(7), rt, RBUF(12), ct, lane);
            tstore_g(item + 4096, rt, ct, y0, lane);
            f32x4 q = mm64(z, RBUF(5), rt, RBUF(0), ct, lane); q = mm64(q, RBUF(6), rt, RBUF(7), ct, lane);
            const f32x4 g4 = *(const LAS f32x4*)(GAM + 16 * rt + 4 * lg);
            q = q * g4;
            *(GAS v2u*)(item + 12288 + (((ct * 4 + rt) * 64 + lane) * 4)) = pack4(q); }
    }
    LDS_BARRIER();
    R1_STAMP(6);
    }
    }
#ifdef PROBE_R1
    if (tid == 0 && bid == PROBE_BLOCK) { const LAS unsigned long long* t_ = (const LAS unsigned long long*)(lds + LDSCTL_OFF + 640); unsigned long long* g_ = (unsigned long long*)((unsigned*)(A->ws + WS_CTL) + 32768) + 48;
        for (int k = 0; k < 7; ++k) g_[k] = t_[1 + k]; }
#endif
#undef R1_PREFETCH
}

constexpr int R2_NS = 8, R2_STB = 16384;
static_assert(R2_NS * R2_STB <= RING_BYTES, "scan ring");
__device__ __forceinline__ void rwkv_state_scan(ArgP A, int b, int h, LAS unsigned char* lds, int wave, int lane) {
    const int l15 = lane & 15, lg = lane >> 4, dw = wave & 3;
    unsigned char* item0 = (unsigned char*)(A->ws + WS_RWI) + ((size_t)((b * 8 + h) * 64)) * 32768;
#define R2_DMA(nn) do { const unsigned char* g_ = item0 + (size_t)(nn) * 32768 + 16384 + dw * 4096 + lane * 16; LAS unsigned char* s_ = lds + ((nn) & (R2_NS - 1)) * R2_STB + dw * 4096; \
        _Pragma("unroll") for (int p = 0; p < 4; ++p) __builtin_amdgcn_global_load_lds((const unsigned*)(g_ + p * 1024), (LAS unsigned*)(s_ + p * 1024), 16, 0, 0); } while (0)
    if (wave >= 4) {
#pragma unroll
        for (int n = 0; n < R2_NS - 1; ++n) R2_DMA(n); }
    f32x4 S[4]; float zz_ = 0.f; asm volatile("" : "+v"(zz_));
#pragma unroll
    for (int t = 0; t < 4; ++t) S[t] = (f32x4){zz_, zz_, zz_, zz_};
#pragma unroll 1
    for (int n = 0; n < 64; ++n) {
        if (wave >= 4) { if (n <= 64 - (R2_NS - 1)) asm volatile("s_waitcnt vmcnt(24)" ::: "memory"); else asm volatile("s_waitcnt vmcnt(0)" ::: "memory"); }
        __builtin_amdgcn_s_barrier();
#ifdef PROBE_R2HALF
        if (n == PROBE_R2HALF && b == 0 && h == 0 && wave == 0 && lane == 0) { unsigned long long* t_ = (unsigned long long*)((unsigned*)(A->ws + WS_CTL) + 32768) + 41; if (*t_ == 0ull) *t_ = __builtin_amdgcn_s_memrealtime(); }
#endif
        if (wave >= 4) { if (n + R2_NS - 1 < 64) R2_DMA(n + R2_NS - 1); }
        else {
            const LAS unsigned char* st = lds + (n & (R2_NS - 1)) * R2_STB;
            v4u pf[8]; v2u qv[4];
#pragma unroll
            for (int f = 0; f < 8; ++f) pf[f] = *(const LAS v4u*)(st + (f * 64 + lane) * 16);
#pragma unroll
            for (int t = 0; t < 4; ++t) qv[t] = *(const LAS v2u*)(st + 8192 + ((dw * 4 + t) * 64 + lane) * 8);
            unsigned pk[4][2];
#pragma unroll
            for (int t = 0; t < 4; ++t) { pk[t][0] = cvtpk(S[t][0], S[t][1]); pk[t][1] = cvtpk(S[t][2], S[t][3]); }
            bf16* SN = (bf16*)(item0 + (size_t)n * 32768 + 24576);
#pragma unroll
            for (int t = 0; t < 4; ++t) *(GAS v2u*)(SN + (((dw * 2 + (t >> 1)) * 64 + (2 * (t & 1) + (lg >> 1)) * 16 + l15) * 8 + 4 * (lg & 1))) = (v2u){pk[t][0], pk[t][1]};
            const bf16x8_t b0 = __builtin_bit_cast(bf16x8_t, (v4u){pk[0][0], pk[0][1], pk[1][0], pk[1][1]}), b1 = __builtin_bit_cast(bf16x8_t, (v4u){pk[2][0], pk[2][1], pk[3][0], pk[3][1]});
#pragma unroll
            for (int t = 0; t < 4; ++t) { f32x4 acc = (f32x4){bflo(qv[t].x), bfhi(qv[t].x), bflo(qv[t].y), bfhi(qv[t].y)};
                acc = mfma16(__builtin_bit_cast(bf16x8_t, pf[2 * t]), b0, acc); acc = mfma16(__builtin_bit_cast(bf16x8_t, pf[2 * t + 1]), b1, acc); S[t] = acc; }
        }
    }
#undef R2_DMA
}

__device__ __forceinline__ void rwkv_out_phase(ArgP A, int L, int wt0, int wtstride, int lane) {
    const int i = L >> 1, l15 = lane & 15, lg = lane >> 4;
    const bf16* P = (const bf16*)(A->ws + WS_P); bf16* XNb = (bf16*)(A->ws + WS_XN); const float* BON = (const float*)(A->ws + WS_BON);
    int hcur = -1; v4u g2f[5][4]; f32x4 w4[4], b4[4], m4[4];
#pragma unroll 1
    for (int wt = wt0; wt < BATCH * 64 * 8 * 4; wt += wtstride) {
    const int it_ = wt >> 2, ct = wt & 3, b = it_ >> 9, n = (it_ >> 3) & 63, h = it_ & 7;
    if (h != hcur) { hcur = h;
        const bf16* G2T = (const bf16*)(A->ws + WS_G2T) + (size_t)(64 * h + l15) * 192 + 8 * lg;
#pragma unroll
        for (int q = 0; q < 5; ++q)
#pragma unroll
            for (int it = 0; it < 4; ++it) g2f[q][it] = *(const GAS v4u*)(G2T + (size_t)(16 * it) * 192 + 32 * q);
        const float* lnw = A->in[20] + i * 512 + 64 * h; const float* lnb = A->in[21] + i * 512 + 64 * h; const float* mu = A->in[7] + (size_t)i * 1536 + 1024 + 64 * h;
#pragma unroll
        for (int it = 0; it < 4; ++it) { const int i0 = 16 * it + 4 * lg; w4[it] = *(const GAS f32x4*)(lnw + i0); b4[it] = *(const GAS f32x4*)(lnb + i0); m4[it] = *(const GAS f32x4*)(mu + i0); } }
    const bf16* item = (const bf16*)(A->ws + WS_RWI) + ((size_t)((b * 8 + h) * 64 + n)) * 16384;
    const bf16* RH = item; const bf16* Y0 = item + 4096; const bf16* ST = item + 12288;
    const size_t row = (size_t)b * T + 64 * n + 16 * ct + l15; const int tseq = 64 * n + 16 * ct + l15;
    const bf16x8_t rf0 = *(const GAS bf16x8_t*)(RH + (16 * ct + l15) * 64 + 8 * lg), rf1 = *(const GAS bf16x8_t*)(RH + (16 * ct + l15) * 64 + 32 + 8 * lg);
    const bf16* prow = P + row * NIN_E; v4u gx[5], gy[5];
#pragma unroll
    for (int q = 0; q < 5; ++q) { gx[q] = *(const GAS v4u*)(prow + PC_G1A + 32 * q + 8 * lg); gy[q] = tseq > 0 ? *(const GAS v4u*)(prow - NIN_E + PC_G1B + 32 * q + 8 * lg) : (v4u){0u, 0u, 0u, 0u}; }
    const bf16* pr = prow + PC_V + 64 * h; v2u pvr[4], pvq[4];
#pragma unroll
    for (int it = 0; it < 4; ++it) { const int i0 = 16 * it + 4 * lg; pvr[it] = *(const GAS v2u*)(pr + i0); pvq[it] = tseq > 0 ? *(const GAS v2u*)(pr - NIN_E + i0) : (v2u){0u, 0u}; }
    const float bon = BON[row * 8 + h];
    f32x4 acc[4]; float s1 = 0.f;
#pragma unroll
    for (int it = 0; it < 4; ++it) {
        f32x4 a = ld4bf_g(Y0 + (16 * ct + l15) * 64 + 16 * it + 4 * lg);
        a = mfma16(*(const GAS bf16x8_t*)(ST + ((it * 2 + 0) * 64 + lane) * 8), rf0, a);
        a = mfma16(*(const GAS bf16x8_t*)(ST + ((it * 2 + 1) * 64 + lane) * 8), rf1, a);
        acc[it] = a; s1 += (a[0] + a[1]) + (a[2] + a[3]);
    }
    s1 += __shfl_xor(s1, 16); s1 += __shfl_xor(s1, 32);
    const float mean = s1 * (1.f / 64.f); float s2 = 0.f;
#pragma unroll
    for (int it = 0; it < 4; ++it) { acc[it] = acc[it] - mean; s2 += (acc[it][0] * acc[it][0] + acc[it][1] * acc[it][1]) + (acc[it][2] * acc[it][2] + acc[it][3] * acc[it][3]); }
    s2 += __shfl_xor(s2, 16); s2 += __shfl_xor(s2, 32);
    const float rs = frsq(s2 * (1.f / 64.f) + 64e-5f);
    f32x4 gq[4] = {(f32x4){0.f, 0.f, 0.f, 0.f}, (f32x4){0.f, 0.f, 0.f, 0.f}, (f32x4){0.f, 0.f, 0.f, 0.f}, (f32x4){0.f, 0.f, 0.f, 0.f}};
#pragma unroll
    for (int q = 0; q < 5; ++q) { float x[8], y[8], v[8]; unpack8(gx[q], x); unpack8(gy[q], y);
#pragma unroll
        for (int e = 0; e < 8; ++e) v[e] = sigmoid_f(x[e] + y[e]);
        const bf16x8_t fg = pack8(v);
#pragma unroll
        for (int it = 0; it < 4; ++it) gq[it] = mfma16(__builtin_bit_cast(bf16x8_t, g2f[q][it]), fg, gq[it]); }
#pragma unroll
    for (int it = 0; it < 4; ++it) { const int i0 = 16 * it + 4 * lg;
        const f32x4 pv = (f32x4){bflo(pvr[it].x), bfhi(pvr[it].x), bflo(pvr[it].y), bfhi(pvr[it].y)}, pvp = (f32x4){bflo(pvq[it].x), bfhi(pvq[it].x), bflo(pvq[it].y), bfhi(pvq[it].y)};
        const f32x4 v4 = pv + (pvp - pv) * m4[it];
        const f32x4 o = ((acc[it] * rs) * w4[it] + b4[it] + v4 * bon) * gq[it];
        *(GAS v2u*)(XNb + row * D + 64 * h + i0) = pack4(o); }
    }
}
constexpr size_t WS_GKV = 464 * MiB;
constexpr size_t WS_GDEC = 29 * MiB + 512 * 1024;
constexpr int GL_LA = 0, GL_KR = 16384, GL_VT = GL_KR + MB, GL_TOT = GL_VT + 2 * MB, GL1_END = GL_TOT + 2048;
static_assert(GL1_END <= RING_BYTES, "GLA LDS map");

template <int NCT> __device__ __forceinline__ void gla_lora_tiles(ArgP A, size_t rowb, int h4, int rt, int ct0, LAS float* LAs, int lane) {
    const int l15 = lane & 15, lg = lane >> 4;
    const bf16* P = (const bf16*)(A->ws + WS_P); const bf16* WA2T = (const bf16*)(A->ws + WS_WA2T);
    v4u av = (v4u){0u, 0u, 0u, 0u};
    if (lg < 2) av = *(const GAS v4u*)(P + (rowb + 16 * rt + l15) * NIN_E + PC_WA1 + 8 * lg);
    const bf16x8_t af = __builtin_bit_cast(bf16x8_t, av);
#pragma unroll
    for (int c = 0; c < NCT; ++c) { const int ct = ct0 + c;
        const f32x4 x = mfma16(af, *(const GAS bf16x8_t*)(WA2T + (size_t)(64 * h4 + 16 * ct + l15) * 32 + 8 * lg), (f32x4){0.f, 0.f, 0.f, 0.f});
#pragma unroll
        for (int r = 0; r < 4; ++r) LAs[(16 * rt + 4 * lg + r) * 64 + 16 * ct + l15] = x[r]; }
}

__device__ __forceinline__ void gla_kv_item(ArgP A, int L, int b, int n, int h4, LAS unsigned char* lds, int tid) {
    const int lane = tid & 63, wave = __builtin_amdgcn_readfirstlane(tid >> 6), i = L >> 1, l15 = lane & 15, lg = lane >> 4;
    const bf16* P = (const bf16*)(A->ws + WS_P);
    const size_t rowb = (size_t)b * T + 64 * n; const int itemi = (b * 64 + n) * 4 + h4;
    LAS float* LAs = (LAS float*)(lds + GL_LA); LAS bf16* KrT = (LAS bf16*)(lds + GL_KR); LAS bf16* VTm = (LAS bf16*)(lds + GL_VT); LAS float* TOT = (LAS float*)(lds + GL_TOT);
    gla_lora_tiles<2>(A, rowb, h4, wave >> 1, 2 * (wave & 1), LAs, lane);
    __syncthreads();
    {
        const int c = 64 * h4 + lane, tt0 = 8 * wave; const float bac = A->in[24][i * 256 + c];
        float lc[8], kx[8], qx[8], v0[8], v1[8]; float run = 0.f;
#pragma unroll
        for (int u = 0; u < 8; ++u) { const bf16* pr = P + (rowb + tt0 + u) * NIN_E; const float x = bac + LAs[(tt0 + u) * 64 + lane];
            run += -softplus_f(-x) * (1.0f / 16.0f); lc[u] = run; kx[u] = bf2f(pr[PC_GK + c]); qx[u] = bf2f(pr[PC_GQ + c]); v0[u] = bf2f(pr[PC_GV + 128 * h4 + lane]); v1[u] = bf2f(pr[PC_GV + 128 * h4 + 64 + lane]); }
        TOT[wave * 64 + lane] = run;
        __syncthreads();
        float off = 0.f, tot = 0.f;
#pragma unroll
        for (int w2 = 0; w2 < 8; ++w2) { const float tv = TOT[w2 * 64 + lane]; tot += tv; if (w2 < wave) off += tv; }
        if (wave == 0) ((float*)(A->ws + WS_GDEC))[itemi * 64 + lane] = fexp(tot);
        { bf16* Pw = (bf16*)(A->ws + WS_P); const float etot = fexp(tot);
#pragma unroll
          for (int u = 0; u < 8; ++u) { const float cum = off + lc[u], e1 = fexp(cum), kt = kx[u] * frcp(e1); bf16* pw = Pw + (rowb + tt0 + u) * NIN_E;
              pw[PC_GQ + c] = (bf16)f2bf(qx[u] * 0.125f * e1); pw[PC_GK + c] = (bf16)f2bf(kt); kx[u] = kt * etot; } }
        *(LAS bf16x8_t*)(KrT + lane * MS + tt0) = pack8(kx); *(LAS bf16x8_t*)(VTm + lane * MS + tt0) = pack8(v0); *(LAS bf16x8_t*)(VTm + (64 + lane) * MS + tt0) = pack8(v1);
    }
    __syncthreads();
    {
        bf16* KVg = (bf16*)(A->ws + WS_GKV) + (size_t)itemi * 8192; const int rt = wave >> 1;
#pragma unroll
        for (int c = 0; c < 4; ++c) { const int et = 4 * (wave & 1) + c;
            const f32x4 acc = mm64((f32x4){0.f, 0.f, 0.f, 0.f}, KrT, rt, VTm, et, lane);
            *(GAS v2u*)(KVg + (16 * et + l15) * 64 + 16 * rt + 4 * lg) = pack4(acc); }
    }
    __syncthreads();
}

__device__ __forceinline__ void gla_state_scan(ArgP A, int gt, bool do_store = true) {
    const int bh = gt >> 11, grp = gt & 2047;
    const int b = bh >> 2, h4 = bh & 3;
    bf16* base = (bf16*)(A->ws + WS_GKV) + (size_t)((b * 64) * 4 + h4) * 8192 + (size_t)grp * 4;
    const float* dec = (const float*)(A->ws + WS_GDEC) + (size_t)((b * 64) * 4 + h4) * 64 + (grp & 15) * 4;
    f32x4 S = (f32x4){0.f, 0.f, 0.f, 0.f};
#pragma unroll 1
    for (int n0 = 0; n0 < 64; n0 += 8) {
        v2u kv[8]; f32x4 dc[8];
#pragma unroll
        for (int u = 0; u < 8; ++u) { kv[u] = *(const GAS v2u*)(base + (size_t)(n0 + u) * 4 * 8192); dc[u] = *(const GAS f32x4*)(dec + (size_t)(n0 + u) * 4 * 64); }
#pragma unroll
        for (int u = 0; u < 8; ++u) { if (do_store) *(GAS v2u*)(base + (size_t)(n0 + u) * 4 * 8192) = pack4(S);
            S = S * dc[u] + (f32x4){bflo(kv[u].x), bfhi(kv[u].x), bflo(kv[u].y), bfhi(kv[u].y)}; }
    }
}

constexpr int G3B_SV = 272, G3B_VT = 0, G3B_SC = 64 * G3B_SV, G3B_GRP = G3B_SC + MB;
static_assert(2 * G3B_GRP <= RING_BYTES, "GLA phase-3 LDS map");
__device__ __forceinline__ void gla_out_phase(ArgP A, int L, LAS unsigned char* lds, int tid, int G, int bid) {
    const int lane = tid & 63, wave = __builtin_amdgcn_readfirstlane(tid >> 6), i = L >> 1, l15 = lane & 15, lg = lane >> 4;
    const int gi = wave >> 2, wq = wave & 3;
    const bf16* P = (const bf16*)(A->ws + WS_P); bf16* XNb = (bf16*)(A->ws + WS_XN);
    LAS unsigned char* gb = lds + gi * G3B_GRP; LAS bf16* SC = (LAS bf16*)(gb + G3B_SC);
    const int ct = wq; const int col = 16 * ct + l15;
    int hcur = -1; f32x4 gn4[8];
#pragma unroll 1
    for (int item2 = bid; item2 < BATCH * 64 * 4 / 2; item2 += G) {
    const int itemi = 2 * item2 + gi, h4 = itemi & 3, n = (itemi >> 2) & 63, b = itemi >> 8;
    const size_t rowb = (size_t)b * T + 64 * n;
    if (h4 != hcur) { hcur = h4; const float* gn = A->in[25] + i * 512 + 128 * h4;
#pragma unroll
        for (int et = 0; et < 8; ++et) gn4[et] = *(const GAS f32x4*)(gn + 16 * et + 4 * lg); }
    v4u vreg[4];
    { const int t4 = tid & 255;
#pragma unroll
      for (int q = 0; q < 4; ++q) { const int id = t4 + 256 * q, row = id >> 4, ch = id & 15; vreg[q] = *(const GAS v4u*)(P + (rowb + row) * NIN_E + PC_GV + 128 * h4 + 8 * ch); } }
    const bf16* qrow = P + (rowb + col) * NIN_E + PC_GQ + 64 * h4 + 8 * lg;
    const bf16x8_t qf0 = *(const GAS bf16x8_t*)qrow, qf1 = *(const GAS bf16x8_t*)(qrow + 32);
    v4u kf[4][2];
#pragma unroll
    for (int rt = 0; rt < 4; ++rt) { const bf16* krow = P + (rowb + 16 * rt + l15) * NIN_E + PC_GK + 64 * h4 + 8 * lg;
        if (rt <= ct) { kf[rt][0] = *(const GAS v4u*)krow; kf[rt][1] = *(const GAS v4u*)(krow + 32); } else { kf[rt][0] = (v4u){0u, 0u, 0u, 0u}; kf[rt][1] = (v4u){0u, 0u, 0u, 0u}; } }
    const bf16* Sg = (const bf16*)(A->ws + WS_GKV) + (size_t)itemi * 8192;
    v4u sgf[8][2];
#pragma unroll
    for (int et = 0; et < 8; ++et) { sgf[et][0] = *(const GAS v4u*)(Sg + (16 * et + l15) * 64 + 8 * lg); sgf[et][1] = *(const GAS v4u*)(Sg + (16 * et + l15) * 64 + 32 + 8 * lg); }
    const size_t row = rowb + col; v2u ggr[8];
#pragma unroll
    for (int et = 0; et < 8; ++et) ggr[et] = *(const GAS v2u*)(P + row * NIN_E + PC_GG + 128 * h4 + 16 * et + 4 * lg);
    { const int t4 = tid & 255;
#pragma unroll
      for (int q = 0; q < 4; ++q) { const int id = t4 + 256 * q, vrow = id >> 4, ch = id & 15; *(LAS v4u*)(gb + G3B_VT + vrow * G3B_SV + ch * 16) = vreg[q]; } }
#pragma unroll
    for (int rt = 0; rt < 4; ++rt) { f32x4 acc = (f32x4){0.f, 0.f, 0.f, 0.f};
        if (rt <= ct) {
            acc = mfma16(__builtin_bit_cast(bf16x8_t, kf[rt][0]), qf0, acc); acc = mfma16(__builtin_bit_cast(bf16x8_t, kf[rt][1]), qf1, acc);
#pragma unroll
            for (int r = 0; r < 4; ++r) if (!((16 * rt + 4 * lg + r) <= col)) acc[r] = 0.f; }
        tstore(SC, rt, ct, acc, lane); }
    __syncthreads();
    const int vto = G3B_VT + (8 * lg + (l15 >> 2)) * G3B_SV + 4 * (lane & 3) * 2;
    f32x4 o[8]; float ss = 0.f;
#pragma unroll
    for (int et = 0; et < 8; ++et) { f32x4 acc = (f32x4){0.f, 0.f, 0.f, 0.f};
#pragma unroll
        for (int ks = 0; ks < 2; ++ks) { const LAS unsigned char* vp = gb + vto + ks * 32 * G3B_SV + et * 32;
            const a_s16x4 lo4 = __builtin_bit_cast(a_s16x4, __builtin_amdgcn_ds_read_tr16_b64_v4i16((LAS a_s16x4*)vp));
            const a_s16x4 hi4 = __builtin_bit_cast(a_s16x4, __builtin_amdgcn_ds_read_tr16_b64_v4i16((LAS a_s16x4*)(vp + 4 * G3B_SV)));
            const bf16x8_t vf = (bf16x8_t){lo4[0], lo4[1], lo4[2], lo4[3], hi4[0], hi4[1], hi4[2], hi4[3]};
            acc = mfma16(vf, ldfrag(SC, 16 * ct, 32 * ks, lane), acc); }
        acc = mfma16(__builtin_bit_cast(bf16x8_t, sgf[et][0]), qf0, acc);
        acc = mfma16(__builtin_bit_cast(bf16x8_t, sgf[et][1]), qf1, acc);
        o[et] = acc; ss += (acc[0] * acc[0] + acc[1] * acc[1]) + (acc[2] * acc[2] + acc[3] * acc[3]); }
    ss += __shfl_xor(ss, 16); ss += __shfl_xor(ss, 32);
    const float rs = frsq(ss * (1.f / 128.f) + 1e-5f);
#pragma unroll
    for (int et = 0; et < 8; ++et) { const int e0 = 16 * et + 4 * lg; const f32x4 gg = (f32x4){bflo(ggr[et].x), bfhi(ggr[et].x), bflo(ggr[et].y), bfhi(ggr[et].y)};
        f32x4 v = o[et] * rs * gn4[et]; v[0] *= silu_f(gg[0]); v[1] *= silu_f(gg[1]); v[2] *= silu_f(gg[2]); v[3] *= silu_f(gg[3]);
        *(GAS v2u*)(XNb + row * D + 512 + 128 * h4 + e0) = pack4(v); }
    __syncthreads();
    }
}
constexpr int N_STEPS = 37;
#ifndef MK_ONE_LAUNCH
#define MK_ONE_LAUNCH 1
#endif
__global__ void __launch_bounds__(NTHREADS, 2) hybrid_fwd(Args args) {
    extern __shared__ __attribute__((aligned(16))) unsigned char lds_raw[];
    LAS unsigned char* lds = (LAS unsigned char*)lds_raw;
    ArgP A0 = (ArgP)__builtin_amdgcn_kernarg_segment_ptr();
    { const int tid = threadIdx.x; for (int u = tid; u < (LDS_BYTES - LDSCTL_OFF) / 4; u += NTHREADS) ((LAS unsigned*)(lds + LDSCTL_OFF))[u] = 0u; }
    __syncthreads();
    const int lo = A0->lo, hi = A0->hi;
    if (hi - lo > 1) (void)xcd_barrier_post((unsigned*)(A0->ws + WS_CTL) + CW_BAR, (volatile LAS unsigned*)(lds + MISC_OFF) + 8);
#ifndef PHM
#define PHM 0xff
#endif
#define RUN(s) (lo <= (s) && (s) < hi)
#define EN(b) ((PHM >> (b)) & 1)
#ifndef PROBE_REP
#define PROBE_REP 0
#endif
#define REP(b) _Pragma("unroll 1") for (int rep_ = 0; rep_ < (((PROBE_REP >> (b)) & 1) ? 2 : 1); ++rep_)
#ifndef PROBE_TMASK
#define PROBE_TMASK 0u
#endif
#ifndef PROBE_TAMP
#define PROBE_TAMP 4
#endif
#ifndef PROBE_TCLK
#define PROBE_TCLK 0
#endif
#ifndef PROBE_BLOCK
#define PROBE_BLOCK 0
#endif
#ifndef PROBE_SUBA
#define PROBE_SUBA 0
#define PROBE_SUBB 0
#endif
#define PROBE_STAMP(i) do { if (PROBE_TMASK && ((i) == PROBE_SUBA || (i) == PROBE_SUBB) && L == 0 && bid == PROBE_BLOCK && tid == 0) { ArgP As_ = A; ((unsigned long long*)((unsigned*)(As_->ws + WS_CTL) + 32768))[i] = __builtin_amdgcn_s_memrealtime(); } } while (0)
    int nbar_ = 0;
    if (PROBE_TMASK) { if (blockIdx.x == PROBE_BLOCK && threadIdx.x == 0) { ((unsigned long long*)((unsigned*)(A0->ws + WS_CTL) + 32768))[0] = __builtin_amdgcn_s_memrealtime(); ((unsigned long long*)((unsigned*)(A0->ws + WS_CTL) + 32768))[64] = __builtin_amdgcn_s_memtime(); } }
#define GRID_BARRIER() do { ArgP Ab_ = FRESH_ARGS(); XcdBarrier b_; b_.bar = (unsigned*)(Ab_->ws + WS_CTL) + CW_BAR; b_.x = xb_xcc_id(); b_.st = (volatile LAS unsigned*)(lds + MISC_OFF) + 8; xcd_barrier(b_); if (PROBE_TMASK) { ++nbar_; if (blockIdx.x == PROBE_BLOCK && threadIdx.x == 0) { ((unsigned long long*)((unsigned*)(Ab_->ws + WS_CTL) + 32768))[nbar_] = __builtin_amdgcn_s_memrealtime(); ((unsigned long long*)((unsigned*)(Ab_->ws + WS_CTL) + 32768))[64 + nbar_] = __builtin_amdgcn_s_memtime(); } } } while (0)
#define SEAM(s) do { if (RUN(s) && RUN((s) + 1)) GRID_BARRIER(); } while (0)
#define PHASE_VARS() ArgP A = FRESH_ARGS(); int L = Lq; FRESH_S(L); int tid = threadIdx.x; FRESH_V(tid); const int lane = tid & 63, wave = __builtin_amdgcn_readfirstlane(tid >> 6); int G = gridDim.x, bid = blockIdx.x; FRESH_S(G); FRESH_S(bid); (void)lane; (void)wave; (void)G; (void)A; (void)bid; \
    bf16* XN = (bf16*)(A->ws + WS_XN); bf16* PB = (bf16*)(A->ws + WS_P); (void)XN; (void)PB

#define BAR2(a, b) do { if (RUN(a) && RUN(b)) GRID_BARRIER(); } while (0)
    if (EN(0) && RUN(0)) REP(0) { int Lq = 0; PHASE_VARS(); const int gw = bid * NWAVES + wave, NGW = G * NWAVES;
        convert_mixer_weights(A, 0, lds, wave, lane, gw, NGW); PROBE_STAMP(45);
        float* ssq0 = (float*)(A->ws + WS_SSQ);
        for (int m = gw; m < M; m += NGW) x_to_bf16_ssq(A->in[0] + (size_t)m * D, (bf16*)A->out + (size_t)m * D, ssq0 + (size_t)m * 16, lane); }
    BAR2(0, 1);
    for (int Lq = 0; Lq < 4; ++Lq) {
        const int s0 = 9 * Lq; const bool even = !(Lq & 1);
        if (EN(1) && RUN(s0 + 1)) REP(1) {
            PHASE_VARS(); bf16* Win = (bf16*)(A->ws + WS_WIN); const float* ssq = (const float*)(A->ws + WS_SSQ);
            if (even) {
                pg8::Gemm g{(bf16*)A->out, Win, M, NIN_E, D}; pg8::StaticOrderC<M, NIN_E> S; S.init(G, bid);
                pg8::fill_row_scales(S, ssq, (LAS float*)(lds + RSTAB_OFF), tid);
                pg8::EpiStoreBf16 E{PB, NIN_E, 0, 1.0f, (const LAS float*)(lds + RSTAB_OFF)};
                pg8::gemm_phase<pg8::EpiStoreBf16, pg8::StaticOrderC<M, NIN_E>, PG8_ALIGN, PG8_SP2>(lds, g, S, E);
            } else {
                pg8::Gemm g{(bf16*)A->out, Win, M, NIN_O, D}; pg8::StaticOrderC<M, NIN_O> S; S.init(G, bid);
                pg8::fill_row_scales(S, ssq, (LAS float*)(lds + RSTAB_OFF), tid);
                pg8::EpiStoreBf16 E{PB, NIN_O, 4, 0.125f * 1.4426950408889634f, (const LAS float*)(lds + RSTAB_OFF)};
                pg8::gemm_phase<pg8::EpiStoreBf16, pg8::StaticOrderC<M, NIN_O>, PG8_ALIGN, PG8_SP2>(lds, g, S, E);
            }
        }
        if (even) {
            BAR2(s0 + 1, s0 + 2);
            if (EN(2) && RUN(s0 + 2)) REP(2) { PHASE_VARS();
                rwkv_chunk_phase(A, L, lds, tid, G, bid); PROBE_STAMP(44);
                REP(8) {
#pragma unroll 1
                for (int it = bid; it < BATCH * 64 * 4; it += G) gla_kv_item(A, L, it >> 8, (it >> 2) & 63, it & 3, lds, tid); } }
            BAR2(s0 + 2, s0 + 3);
            if (EN(3) && RUN(s0 + 3)) {
                PHASE_VARS();
                if (bid < 64) { rwkv_state_scan(A, bid >> 3, bid & 7, lds, wave, lane); PROBE_STAMP(40); }
                else { for (int gt = (bid - 64) * NTHREADS + tid; gt < 32 * 2048; gt += (G - 64) * NTHREADS) gla_state_scan(A, gt);
                       PROBE_STAMP(41);
                       convert_ffn_weights(A, L, lds, wave, lane, (bid - 64) * NWAVES + wave, (G - 64) * NWAVES); PROBE_STAMP(42); }
            }
            BAR2(s0 + 3, s0 + 4);
            if (EN(3) && RUN(s0 + 4)) {
                PHASE_VARS();
                REP(9) {
                gla_out_phase(A, L, lds, tid, G, bid); }
                PROBE_STAMP(43);
                rwkv_out_phase(A, L, bid * NWAVES + wave, G * NWAVES, lane);
            }
            BAR2(s0 + 4, s0 + 5);
        } else {
            BAR2(s0 + 1, s0 + 3);
            #ifdef PROBE_AVAR
            if (EN(4) && RUN(s0 + 3)) { PHASE_VARS(); attn_phase_mfma<PROBE_AVAR>(A, L, lds, tid, G, bid); }
#endif
            if (EN(4) && RUN(s0 + 3)) REP(4) { PHASE_VARS(); attn_phase_mfma(A, L, lds, tid, G, bid); convert_ffn_weights(A, L, lds, wave, lane, bid * NWAVES + wave, G * NWAVES); }
            BAR2(s0 + 3, s0 + 5);
        }
        if (EN(5) && RUN(s0 + 5)) {
            PHASE_VARS(); bf16* Wout = (bf16*)(A->ws + WS_WOUT);
            pg8::Gemm g{XN, Wout, M, D, D}; pg8::StaticOrderC<M, D> S; S.init(G, bid);
            if ((PROBE_REP >> 5) & 1) { pg8::EpiResBf16<false, true> E0{(bf16*)A->out, D, (float*)(A->ws + WS_SSQ) + (size_t)M * 16, nullptr};
                pg8::gemm_phase<pg8::EpiResBf16<false, true>, pg8::StaticOrderC<M, D>, PG8_ALIGN, PG8_SP2>(lds, g, S, E0); }
            pg8::EpiResBf16<false> E{(bf16*)A->out, D, (float*)(A->ws + WS_SSQ) + (size_t)M * 16, nullptr};
            pg8::gemm_phase<pg8::EpiResBf16<false>, pg8::StaticOrderC<M, D>, PG8_ALIGN, PG8_SP2>(lds, g, S, E);
        }
        BAR2(s0 + 5, s0 + 7);
        if (EN(6) && RUN(s0 + 7)) REP(6) {
            PHASE_VARS(); bf16* Wgu = (bf16*)(A->ws + WS_WGU);
            pg8::Gemm g{(bf16*)A->out, Wgu, M, NGU, D}; pg8::StaticOrderC<M, NGU> S; S.init(G, bid);
            pg8::fill_row_scales(S, (const float*)(A->ws + WS_SSQ) + (size_t)M * 16, (LAS float*)(lds + RSTAB_OFF), tid);
            if ((PROBE_REP >> 18) & 1) { pg8::EpiNull En; pg8::gemm_phase<pg8::EpiNull, pg8::StaticOrderC<M, NGU>, PG8_ALIGN, PG8_SP2>(lds, g, S, En); }
            if ((PROBE_REP >> 15) & 1) { pg8::EpiSwigluT<true> E0{PB, FF, (const LAS float*)(lds + RSTAB_OFF)};
                pg8::gemm_phase<pg8::EpiSwigluT<true>, pg8::StaticOrderC<M, NGU>, PG8_ALIGN, PG8_SP2>(lds, g, S, E0); }
            pg8::EpiSwiglu E{PB, FF, (const LAS float*)(lds + RSTAB_OFF)};
            pg8::gemm_phase<pg8::EpiSwiglu, pg8::StaticOrderC<M, NGU>, PG8_ALIGN, PG8_SP2>(lds, g, S, E);
        }
        BAR2(s0 + 7, s0 + 8);
        if (EN(7) && RUN(s0 + 8)) {
            PHASE_VARS(); bf16* Wdn = (bf16*)(A->ws + WS_WDN);
            pg8::Gemm g{PB, Wdn, M, D, FF}; pg8::StaticOrderC<M, D> S; S.init(G, bid);
            if ((PROBE_REP >> 7) & 1) { pg8::EpiResBf16<false, true> E0{(bf16*)A->out, D, (float*)(A->ws + WS_SSQ), nullptr};
                pg8::gemm_phase<pg8::EpiResBf16<false, true>, pg8::StaticOrderC<M, D>, PG8_ALIGN, PG8_SP2>(lds, g, S, E0); }
            if (L < 3) { pg8::EpiResBf16<false> E{(bf16*)A->out, D, (float*)(A->ws + WS_SSQ), nullptr};
                pg8::gemm_phase<pg8::EpiResBf16<false>, pg8::StaticOrderC<M, D>, PG8_ALIGN, PG8_SP2>(lds, g, S, E);
                convert_mixer_weights(A, L + 1, lds, wave, lane, bid * NWAVES + wave, G * NWAVES); }
            else { pg8::EpiResBf16<true> E{(bf16*)A->out, D, (float*)(A->ws + WS_SSQ), XN};
                pg8::gemm_phase<pg8::EpiResBf16<true>, pg8::StaticOrderC<M, D>, PG8_ALIGN, PG8_SP2>(lds, g, S, E); }
        }
        BAR2(s0 + 8, Lq < 3 ? s0 + 10 : 36);
    }
    if (RUN(36)) REP(17) {
        int Lq = 0; PHASE_VARS();
        const int gw = bid * NWAVES + wave, NGW = G * NWAVES;
        const float pscale_ = 1.0f;
        for (int m = gw; m < M; m += NGW) rms_row_bf16_to_f32(XN + (size_t)m * D, A->in[4], A->out + (size_t)m * D, lane, pscale_);
        if (PROBE_TMASK) { if (blockIdx.x == PROBE_BLOCK && threadIdx.x == 0) {
            const unsigned long long* ts = (const unsigned long long*)((const unsigned*)(A->ws + WS_CTL) + 32768); unsigned long long acc_ = 0, cyc_ = 0;
            for (int k = 1; k <= 25; ++k) if ((PROBE_TMASK >> k) & 1u) { acc_ += ts[k] - ts[k - 1]; cyc_ += ts[64 + k] - ts[64 + k - 1]; }
            if (PROBE_SUBA == 99) acc_ = __builtin_amdgcn_s_memrealtime() - ts[25]; else if (PROBE_SUBA) acc_ = ts[PROBE_SUBA] - ts[PROBE_SUBB];
            const unsigned long long target_ = PROBE_TCLK ? (cyc_ * 100000ull) / (acc_ + 1ull) : acc_ * (unsigned long long)PROBE_TAMP;
            const unsigned long long t0_ = __builtin_amdgcn_s_memrealtime();
            while (__builtin_amdgcn_s_memrealtime() - t0_ < target_ && __builtin_amdgcn_s_memrealtime() - t0_ < 4000000ull) __builtin_amdgcn_s_sleep(16); } }
    }
#undef RUN
#undef SEAM
}

extern "C" void kernel_launch(void* const* d_in, const int* in_sizes, int n_in, void* d_out, int out_size, void* d_ws, size_t ws_size, hipStream_t stream) {
    static int grid = 0;
    if (grid == 0) {
        if (n_in != 36 || in_sizes[0] != M * D || out_size != M * D || ws_size < WS_END) { fprintf(stderr, "kernel_launch: unexpected shapes (n_in %d, in0 %d, out %d, ws %zu); nothing launched\n", n_in, n_in > 0 ? in_sizes[0] : -1, out_size, ws_size); grid = -1; return; }
        int dev = 0, cus = 0, per_cu = 0;
        if (hipGetDevice(&dev) != hipSuccess || hipDeviceGetAttribute(&cus, hipDeviceAttributeMultiprocessorCount, dev) != hipSuccess) { grid = -1; return; }
        if (hipFuncSetAttribute((const void*)hybrid_fwd, hipFuncAttributeMaxDynamicSharedMemorySize, LDS_BYTES) != hipSuccess) { fprintf(stderr, "kernel_launch: hipFuncSetAttribute failed\n"); grid = -1; return; }
        if (hipOccupancyMaxActiveBlocksPerMultiprocessor(&per_cu, (const void*)hybrid_fwd, NTHREADS, LDS_BYTES) != hipSuccess || per_cu < 1) fprintf(stderr, "kernel_launch: occupancy query reports %d\n", per_cu);
        (void)hipGetLastError();
        if (cus < 128) { fprintf(stderr, "kernel_launch: built for a 256-CU device (phase 3 of the even layers needs more than 64 workgroups); nothing launched\n"); grid = -1; return; }
        grid = cus;
    }
    if (grid < 0) return;
    if (hipMemsetAsync((char*)d_ws + WS_CTL, 0, CTL_ZERO_BYTES, stream) != hipSuccess) return;
    Args a{};
    for (int i = 0; i < 36; ++i) a.in[i] = (const float*)d_in[i];
    a.out = (float*)d_out; a.ws = (unsigned char*)d_ws;
#if MK_ONE_LAUNCH
    a.lo = 0; a.hi = N_STEPS;
    hipLaunchKernelGGL(hybrid_fwd, dim3(grid), dim3(NTHREADS), LDS_BYTES, stream, a);
#else
    for (int s = 0; s < N_STEPS; ++s) {
        if (s < 36 && ((s % 9) == 2 || (s % 9) == 4) && ((s / 9) & 1)) continue;
        a.lo = s; a.hi = s + 1;
        hipLaunchKernelGGL(hybrid_fwd, dim3(grid), dim3(NTHREADS), LDS_BYTES, stream, a);
    }
#endif
}
```

```cpp
#include <hip/hip_runtime.h>
#include <cstdio>
#include <cstdint>
__device__ __forceinline__ float silu_f(float x) { return x * __builtin_amdgcn_rcpf(1.0f + __builtin_amdgcn_exp2f(-1.4426950408889634f * x)); }
namespace pg8 {
#define PG8_LAS __attribute__((address_space(3)))
typedef unsigned short bf16_t;
typedef short bf16x8 __attribute__((ext_vector_type(8)));
typedef float f32x4 __attribute__((ext_vector_type(4)));
typedef unsigned u32x4 __attribute__((ext_vector_type(4)));
constexpr int BM = 256, BK = 64, HALF = 128, HTB = HALF * BK * 2  , STAGE_BYTES = 8 * HTB, NXCD = 8, WGM = 4;

__host__ __device__ __forceinline__ int lds_byte(int r, int c) { const int st = (r >> 4) * 2 + (c >> 5), rr = r & 15, cc = c & 31, ob = rr * 64 + cc * 2; return st * 1024 + (ob ^ (((ob >> 9) & 1) << 5)); }
__host__ __device__ __forceinline__ void stage_rc(int b, int& R, int& C) { const int st = b / 1024, sb = b % 1024, swz = sb ^ (((sb >> 9) & 1) << 5); R = (st >> 1) * 16 + swz / 64; C = (st & 1) * 32 + (swz % 64) / 2; }
__host__ __device__ __forceinline__ int perm32(int rho) { const int n = rho >> 4, i = rho & 15; return 8 * (i >> 2) + 4 * n + (i & 3); }

struct Unit { int pm, pn, idx; };
struct Gemm { const bf16_t* A; const bf16_t* Bt; int M, N, K; };

struct StaticOrder {
    int nM, nN, nwg, G, c;
    __host__ __device__ void init(int M, int N, int G_, int c_) { nM = M / BM; nN = N / BM; nwg = nM * nN; G = G_; c = c_; }
    __host__ __device__ bool next(int i, Unit& u) const {
        const long L = (long)i * G + c; if (L >= nwg) return false;
        int wgid = (int)L; { const int q = nwg / NXCD, r = nwg % NXCD, xcd = wgid % NXCD, off = wgid / NXCD; wgid = (xcd < r ? xcd * (q + 1) : r * (q + 1) + (xcd - r) * q) + off; }
        const int nig = WGM * nN, gid = wgid / nig, fm = gid * WGM, gsz = (nM - fm) < WGM ? (nM - fm) : WGM;
        u.pm = fm + ((wgid % nig) % gsz); u.pn = (wgid % nig) / gsz; return true;
    }
    __device__ __forceinline__ void a_ready(const Unit&) const {}
    __device__ __forceinline__ void done(const Unit&) const {}
};

__device__ __forceinline__ unsigned cvt_pk_bf16(float lo, float hi) { unsigned r; asm volatile("v_cvt_pk_bf16_f32 %0, %1, %2" : "=v"(r) : "v"(lo), "v"(hi)); return r; }
typedef float f32x2 __attribute__((ext_vector_type(2)));
__device__ __forceinline__ float row_ssq(const float* ssq, int row) { const f32x4* p = (const f32x4*)(ssq + (size_t)row * 16); const f32x4 a = p[0], b = p[1], c = p[2], d = p[3];
    return (((a[0] + a[1]) + (a[2] + a[3])) + ((b[0] + b[1]) + (b[2] + b[3]))) + (((c[0] + c[1]) + (c[2] + c[3])) + ((d[0] + d[1]) + (d[2] + d[3]))); }
struct EpiStoreBf16 {
    static constexpr bool PERM = true, AFTER_DRAIN = false;
    bf16_t* O; int ldc; int qtiles; float qscale; const PG8_LAS float* rstab;
    __device__ __forceinline__ void operator()(const f32x4 (&acc)[2][2][4][2], const Unit& u, int wr, int wc, int fr, int fq) const {
        const int row0 = u.pm * BM + wr * 64 + fr, col0 = u.pn * BM + wc * 32 + 8 * fq;
        const float sc = u.pn < qtiles ? qscale : 1.0f;
        const PG8_LAS float* rt_ = rstab + u.idx * BM + wr * 64 + fr;
#pragma unroll
        for (int ai = 0; ai < 2; ++ai)
#pragma unroll
            for (int m = 0; m < 4; ++m) { const int row = row0 + ai * HALF + m * 16; bf16_t* rowp = O + (size_t)row * ldc + col0;
                const float rs = sc * rt_[ai * HALF + m * 16];
#pragma unroll
                for (int bj = 0; bj < 2; ++bj) { const f32x4 v0 = acc[ai][bj][m][0] * rs, v1 = acc[ai][bj][m][1] * rs;
                    u32x4 w; w.x = cvt_pk_bf16(v0[0], v0[1]); w.y = cvt_pk_bf16(v0[2], v0[3]); w.z = cvt_pk_bf16(v1[0], v1[1]); w.w = cvt_pk_bf16(v1[2], v1[3]);
                    *(u32x4*)(rowp + bj * HALF) = w; } }
    }
};
template <bool LAST, bool NOSTORE = false> struct EpiResBf16 {
    static constexpr bool PERM = false, AFTER_DRAIN = false;
    bf16_t* xr; int ldc; float* ssq; bf16_t* xf;
    __device__ __forceinline__ void operator()(const f32x4 (&acc)[2][2][4][2], const Unit& u, int wr, int wc, int fr, int fq) const {
        typedef unsigned u32x2 __attribute__((ext_vector_type(2)));
        const int row0 = u.pm * BM + wr * 64 + fr, col0 = u.pn * BM + wc * 32 + 4 * fq;
#pragma unroll
        for (int ai = 0; ai < 2; ++ai)
#pragma unroll
            for (int m = 0; m < 4; ++m) { const int row = row0 + ai * HALF + m * 16; const size_t off = (size_t)row * ldc + col0; float s = 0.f;
#pragma unroll
                for (int bj = 0; bj < 2; ++bj)
#pragma unroll
                    for (int n = 0; n < 2; ++n) { const u32x2 bw = *(const u32x2*)(xr + off + bj * HALF + n * 16);
                        const f32x4 b = (f32x4){__builtin_bit_cast(float, bw.x << 16), __builtin_bit_cast(float, bw.x & 0xffff0000u), __builtin_bit_cast(float, bw.y << 16), __builtin_bit_cast(float, bw.y & 0xffff0000u)};
                        const f32x4 v = b + acc[ai][bj][m][n];
                        s += (v[0] * v[0] + v[1] * v[1]) + (v[2] * v[2] + v[3] * v[3]);
                        u32x2 w; w.x = cvt_pk_bf16(v[0], v[1]); w.y = cvt_pk_bf16(v[2], v[3]); if (!NOSTORE) *(u32x2*)((LAST ? xf : xr) + off + bj * HALF + n * 16) = w; else asm volatile("" :: "v"(w.x), "v"(w.y)); }
                s += __shfl_xor(s, 16); s += __shfl_xor(s, 32);
                if (fq == 0 && !NOSTORE) ssq[(size_t)row * 16 + u.pn * 4 + wc] = s;
                if (m & 1) asm volatile("" ::: "memory"); }
    }
};
template <bool NOSTORE = false> struct EpiSwigluT {
    static constexpr bool PERM = true, AFTER_DRAIN = false;
    bf16_t* H; int ldc; const PG8_LAS float* rstab;
    __device__ __forceinline__ void operator()(const f32x4 (&acc)[2][2][4][2], const Unit& u, int wr, int wc, int fr, int fq) const {
        const int row0 = u.pm * BM + wr * 64 + fr, colh = u.pn * HALF + wc * 32 + 8 * fq;
        const PG8_LAS float* rt_ = rstab + u.idx * BM + wr * 64 + fr;
#pragma unroll
        for (int ai = 0; ai < 2; ++ai)
#pragma unroll
            for (int m = 0; m < 4; ++m) { const int row = row0 + ai * HALF + m * 16; bf16_t* rowp = H + (size_t)row * ldc + colh;
                const float rs = rt_[ai * HALF + m * 16];
                const f32x4 g0 = acc[ai][0][m][0] * rs, g1 = acc[ai][0][m][1] * rs, u0 = acc[ai][1][m][0] * rs, u1 = acc[ai][1][m][1] * rs;
                float h[8];
#pragma unroll
                for (int e = 0; e < 4; ++e) { h[e] = silu_f(g0[e]) * u0[e]; h[4 + e] = silu_f(g1[e]) * u1[e]; }
                u32x4 w; w.x = cvt_pk_bf16(h[0], h[1]); w.y = cvt_pk_bf16(h[2], h[3]); w.z = cvt_pk_bf16(h[4], h[5]); w.w = cvt_pk_bf16(h[6], h[7]);
                if (!NOSTORE) *(u32x4*)rowp = w; else asm volatile("" :: "v"(w.x), "v"(w.y), "v"(w.z), "v"(w.w)); }
    }
};
typedef EpiSwigluT<false> EpiSwiglu;
struct EpiNull {
    static constexpr bool PERM = true, AFTER_DRAIN = false;
    __device__ __forceinline__ void operator()(const f32x4 (&acc)[2][2][4][2], const Unit& u, int wr, int wc, int fr, int fq) const {
#pragma unroll
        for (int ai = 0; ai < 2; ++ai)
#pragma unroll
            for (int bj = 0; bj < 2; ++bj)
#pragma unroll
                for (int m = 0; m < 4; ++m)
#pragma unroll
                    for (int n = 0; n < 2; ++n) asm volatile("" :: "v"(acc[ai][bj][m][n]));
    }
};
template <int M_, int N_> struct StaticOrderC {
    static constexpr int nM = M_ / BM, nN = N_ / BM, nwg = nM * nN;
    int G, c;
    __device__ __forceinline__ void init(int G_, int c_) { G = G_; c = c_; }
    __device__ __forceinline__ bool next(int i, Unit& u) const {
        const int L = i * G + c; if (L >= nwg) return false;
        int wgid = L; { constexpr int q = nwg / NXCD, r = nwg % NXCD; const int xcd = wgid % NXCD, off = wgid / NXCD; wgid = (xcd < r ? xcd * (q + 1) : r * (q + 1) + (xcd - r) * q) + off; }
        constexpr int nig = WGM * nN; const int gid = wgid / nig, fm = gid * WGM, gsz = (nM - fm) < WGM ? (nM - fm) : WGM;
        u.pm = fm + ((wgid % nig) % gsz); u.pn = (wgid % nig) / gsz; u.idx = i; return true;
    }
    __device__ __forceinline__ void a_ready(const Unit&) const {}
    __device__ __forceinline__ void done(const Unit&) const {}
};
template <class Sched> __device__ __forceinline__ void fill_row_scales(const Sched& S, const float* ssq, PG8_LAS float* tab, int tid) {
    Unit u; const int r = tid >> 1, hf = tid & 1;
    for (int i = 0; S.next(i, u); ++i) { const f32x4* p = (const f32x4*)(ssq + (size_t)(u.pm * BM + r) * 16 + hf * 8); const f32x4 a = p[0], b = p[1];
        float sum = ((a[0] + a[1]) + (a[2] + a[3])) + ((b[0] + b[1]) + (b[2] + b[3])); sum += __shfl_xor(sum, 1);
        if (hf == 0) tab[i * BM + r] = __builtin_amdgcn_rsqf(sum * (1.0f / 1024.0f) + 1e-6f); }
    __syncthreads();
}
template <class Epi, class Sched, bool ALIGN_EPI = false, bool SP2 = false>
__device__ __forceinline__ void gemm_phase(PG8_LAS unsigned char* lds, const Gemm g, const Sched& S, const Epi& E) {
    int tid_ = threadIdx.x; asm volatile("" : "+v"(tid_));
    float zz_ = 0.f; asm volatile("" : "+v"(zz_));
    const int tid = tid_, wid = __builtin_amdgcn_readfirstlane(tid >> 6), lane = tid & 63, wr = wid >> 2, wc = wid & 3, fr = lane & 15, fq = lane >> 4;
    const int K = g.K, nt = K / BK;
    unsigned voffA[2], voffB[2];
#pragma unroll
    for (int i = 0; i < 2; ++i) { int R, C; stage_rc(tid * 16 + i * 8192, R, C); const int Rb = Epi::PERM ? ((R & ~31) + perm32(R & 31)) : R;
        voffA[i] = (unsigned)(R * K + C) * 2u; voffB[i] = (unsigned)(Rb * K + C) * 2u; }
    const size_t kstep = (size_t)(BK * 2);
    const size_t hstep = (size_t)HALF * K * 2;
    const size_t tstep = 2 * hstep;
    const unsigned ldsw = (unsigned)wid * 1024u;
    const int aoff = lds_byte(wr * 64 + fr, fq * 8), boff = lds_byte(wc * 32 + fr, fq * 8);
#define PG8_SA(b, h) (((b) * 2 + (h)) * HTB)
#define PG8_SB(b, h) ((4 + (b) * 2 + (h)) * HTB)
#define PG8_STAGE(bufoff, gbase, voff) do { _Pragma("unroll") for (int _i = 0; _i < 2; ++_i) \
        __builtin_amdgcn_global_load_lds((const unsigned*)((const char*)(gbase) + (voff)[_i]), (PG8_LAS unsigned*)(lds + (bufoff) + ldsw + _i * 8192), 16, 0, 0); } while (0)
#define PG8_LDA(dst, b, h) do { _Pragma("unroll") for (int m = 0; m < 4; ++m) _Pragma("unroll") for (int k = 0; k < 2; ++k) dst[m][k] = *(const PG8_LAS bf16x8*)(lds + PG8_SA(b, h) + aoff + m * 2048 + k * 1024); } while (0)
#define PG8_LDB(dst, b, h) do { _Pragma("unroll") for (int n = 0; n < 2; ++n) _Pragma("unroll") for (int k = 0; k < 2; ++k) dst[n][k] = *(const PG8_LAS bf16x8*)(lds + PG8_SB(b, h) + boff + n * 2048 + k * 1024); } while (0)
#define PG8_MMA(ai, bj, At, Bt) do { __builtin_amdgcn_s_setprio(1); _Pragma("unroll") for (int m = 0; m < 4; ++m) _Pragma("unroll") for (int n = 0; n < 2; ++n) _Pragma("unroll") for (int k = 0; k < 2; ++k) \
        acc[ai][bj][m][n] = __builtin_amdgcn_mfma_f32_16x16x32_bf16(Bt[n][k], At[m][k], acc[ai][bj][m][n], 0, 0, 0); __builtin_amdgcn_s_setprio(0); } while (0)
#define PG8_WAIT_V(n) asm volatile("s_waitcnt vmcnt(" #n ")" ::: "memory")
#define PG8_WAIT_L(n) asm volatile("s_waitcnt lgkmcnt(" #n ")" ::: "memory")
#define PG8_BAR __builtin_amdgcn_s_barrier()
#define PG8_SCHED __builtin_amdgcn_sched_barrier(0)
    Unit cur, nxt; int ui = 0;
    if (!S.next(0, cur)) return;
    f32x4 acc[2][2][4][2];
#pragma unroll
    for (int a = 0; a < 2; ++a)
#pragma unroll
        for (int b = 0; b < 2; ++b)
#pragma unroll
            for (int m = 0; m < 4; ++m)
#pragma unroll
                for (int n = 0; n < 2; ++n) acc[a][b][m][n] = (f32x4){zz_, zz_, zz_, zz_};
    bf16x8 At[4][2], B0[2][2], B1[2][2];
    const char* cA = (const char*)g.A + (size_t)cur.pm * tstep; const char* cB = (const char*)g.Bt + (size_t)cur.pn * tstep;
    S.a_ready(cur);
    if constexpr (SP2) {
        PG8_STAGE(PG8_SB(0, 0), cB, voffB); PG8_STAGE(PG8_SB(0, 1), cB + hstep, voffB); PG8_STAGE(PG8_SA(0, 0), cA, voffA); PG8_STAGE(PG8_SA(0, 1), cA + hstep, voffA);
        if (wr == 1) PG8_BAR;
        PG8_WAIT_V(2); PG8_BAR;
        PG8_STAGE(PG8_SB(1, 0), cB + kstep, voffB); PG8_STAGE(PG8_SA(1, 0), cA + kstep, voffA); PG8_STAGE(PG8_SB(1, 1), cB + hstep + kstep, voffB);
        PG8_WAIT_V(6); PG8_BAR;
    } else {
        PG8_STAGE(PG8_SB(0, 0), cB, voffB); PG8_STAGE(PG8_SA(0, 0), cA, voffA); PG8_STAGE(PG8_SB(0, 1), cB + hstep, voffB); PG8_STAGE(PG8_SA(0, 1), cA + hstep, voffA);
        if (wr == 1) PG8_BAR;
        PG8_WAIT_V(4); PG8_BAR;
        PG8_STAGE(PG8_SB(1, 0), cB + kstep, voffB); PG8_STAGE(PG8_SA(1, 0), cA + kstep, voffA); PG8_STAGE(PG8_SB(1, 1), cB + hstep + kstep, voffB);
        PG8_WAIT_V(6); PG8_BAR;
    }
    for (;;) {
        const bool has_next = S.next(ui + 1, nxt);
        const char* nA = has_next ? (const char*)g.A + (size_t)nxt.pm * tstep : cA; const char* nB = has_next ? (const char*)g.Bt + (size_t)nxt.pn * tstep : cB;
        for (int t = 0; t < nt; t += 2) {
            const bool last = (t == nt - 2);
            const char* a1 = cA + (size_t)(t + 1) * kstep;
            const char* a2 = last ? nA : cA + (size_t)(t + 2) * kstep; const char* b2 = last ? nB : cB + (size_t)(t + 2) * kstep;
            const char* a3 = a2 + kstep; const char* b3 = b2 + kstep;
            if (last && has_next) S.a_ready(nxt);
            if constexpr (SP2) {
            PG8_LDB(B0, 0, 0); PG8_LDB(B1, 0, 1); PG8_SCHED; PG8_LDA(At, 0, 0); PG8_STAGE(PG8_SA(1, 1), a1 + hstep, voffA);
            PG8_WAIT_V(8); PG8_WAIT_L(0); PG8_BAR; PG8_MMA(0, 0, At, B0); PG8_MMA(0, 1, At, B1); PG8_BAR; PG8_SCHED;
            PG8_LDA(At, 0, 1); PG8_STAGE(PG8_SB(0, 0), b2, voffB); PG8_STAGE(PG8_SB(0, 1), b2 + hstep, voffB); PG8_STAGE(PG8_SA(0, 0), a2, voffA);
            PG8_WAIT_V(8); PG8_WAIT_L(0); PG8_BAR; PG8_MMA(1, 0, At, B0); PG8_MMA(1, 1, At, B1); PG8_BAR; PG8_SCHED;
            PG8_LDB(B0, 1, 0); PG8_LDB(B1, 1, 1); PG8_SCHED; PG8_LDA(At, 1, 0); PG8_STAGE(PG8_SA(0, 1), a2 + hstep, voffA);
            PG8_WAIT_V(8); PG8_WAIT_L(0); PG8_BAR; PG8_MMA(0, 0, At, B0); PG8_MMA(0, 1, At, B1); PG8_BAR; PG8_SCHED;
            PG8_LDA(At, 1, 1); PG8_STAGE(PG8_SB(1, 0), b3, voffB); PG8_STAGE(PG8_SB(1, 1), b3 + hstep, voffB); PG8_STAGE(PG8_SA(1, 0), a3, voffA);
            PG8_WAIT_V(8); PG8_WAIT_L(0); PG8_BAR; PG8_MMA(1, 0, At, B0); PG8_MMA(1, 1, At, B1); PG8_BAR; PG8_SCHED;
            } else {
            PG8_LDB(B0, 0, 0); PG8_SCHED; PG8_LDA(At, 0, 0); PG8_STAGE(PG8_SA(1, 1), a1 + hstep, voffA);
            PG8_WAIT_L(8); PG8_BAR; PG8_WAIT_L(0); PG8_MMA(0, 0, At, B0); PG8_BAR; PG8_SCHED;
            PG8_LDB(B1, 0, 1); PG8_STAGE(PG8_SB(0, 0), b2, voffB);
            PG8_BAR; PG8_WAIT_L(0); PG8_MMA(0, 1, At, B1); PG8_BAR;
            PG8_LDA(At, 0, 1); PG8_STAGE(PG8_SA(0, 0), a2, voffA);
            PG8_BAR; PG8_WAIT_L(0); PG8_MMA(1, 0, At, B0); PG8_BAR; PG8_SCHED;
            PG8_STAGE(PG8_SB(0, 1), b2 + hstep, voffB);
            PG8_WAIT_V(6); PG8_BAR; PG8_MMA(1, 1, At, B1); PG8_BAR;
            PG8_LDB(B0, 1, 0); PG8_SCHED; PG8_LDA(At, 1, 0); PG8_STAGE(PG8_SA(0, 1), a2 + hstep, voffA);
            PG8_WAIT_L(8); PG8_BAR; PG8_WAIT_L(0); PG8_MMA(0, 0, At, B0); PG8_BAR; PG8_SCHED;
            PG8_LDB(B1, 1, 1); PG8_STAGE(PG8_SB(1, 0), b3, voffB);
            PG8_BAR; PG8_WAIT_L(0); PG8_MMA(0, 1, At, B1); PG8_BAR;
            PG8_LDA(At, 1, 1); PG8_STAGE(PG8_SA(1, 0), a3, voffA);
            PG8_BAR; PG8_WAIT_L(0); PG8_MMA(1, 0, At, B0); PG8_BAR; PG8_SCHED;
            PG8_STAGE(PG8_SB(1, 1), b3 + hstep, voffB);
            PG8_WAIT_V(6); PG8_BAR; PG8_MMA(1, 1, At, B1); PG8_BAR;
            }
        }
        if constexpr (ALIGN_EPI) { if (wr == 0) PG8_BAR; }
        if constexpr (!Epi::AFTER_DRAIN) { E(acc, cur, wr, wc, fr, fq); S.done(cur); }
        if (!has_next) break;
#pragma unroll
        for (int a = 0; a < 2; ++a)
#pragma unroll
            for (int b = 0; b < 2; ++b)
#pragma unroll
                for (int m = 0; m < 4; ++m)
#pragma unroll
                    for (int n = 0; n < 2; ++n) acc[a][b][m][n] = (f32x4){zz_, zz_, zz_, zz_};
        cur = nxt; cA = nA; cB = nB; ++ui;
        if constexpr (ALIGN_EPI) { if (wr == 1) PG8_BAR; }
    }
    PG8_WAIT_V(0);
    if constexpr (!ALIGN_EPI) { if (wr == 0) PG8_BAR; }
    PG8_BAR;
    if constexpr (Epi::AFTER_DRAIN) { E.fused(acc, cur, wr, wc, fr, fq, lds, wid, lane); S.done(cur); }
#undef PG8_SA
#undef PG8_SB
#undef PG8_STAGE
#undef PG8_LDA
#undef PG8_LDB
#undef PG8_MMA
#undef PG8_WAIT_V
#undef PG8_WAIT_L
#undef PG8_BAR
#undef PG8_SCHED
}
}
#ifndef PG8_SP2
#define PG8_SP2 true
#endif
#ifndef PG8_ALIGN
#define PG8_ALIGN true
#endif
constexpr int NWAVES = 8, NTHREADS = NWAVES * 64;
constexpr int BATCH = 8, T = 4096, D = 1024, M = BATCH * T;
constexpr int NIN_E = 3840, NIN_O = 3072, FF = 2816, NGU = 2 * FF;
constexpr int PC_R = 0, PC_K = 512, PC_V = 1024, PC_GQ = 1536, PC_GK = 1792, PC_GV = 2048, PC_GG = 2560;
constexpr int PC_W1A = 3072, PC_W1B = 3136, PC_A1A = 3200, PC_A1B = 3264, PC_G1A = 3328, PC_G1B = 3488, PC_WA1 = 3648, PC_PAD = 3664;
constexpr int NLORA = 304;
constexpr size_t MiB = 1u << 20;
constexpr size_t WS_CTL = 0, CTL_ZERO_BYTES = 1 * MiB;
constexpr size_t WS_WIN = 2 * MiB, WS_WOUT = 10 * MiB, WS_WGU = 12 * MiB, WS_WDN = 23 * MiB;
constexpr size_t WS_W2T = 29 * MiB, WS_A2T = WS_W2T + 65536, WS_G2T = WS_A2T + 65536, WS_WA2T = WS_G2T + 196608;
constexpr size_t WS_SSQ = 496 * MiB;
constexpr size_t WS_XFIN = 336 * MiB;
constexpr size_t WS_XN = 32 * MiB;
constexpr size_t WS_P = 96 * MiB;
constexpr size_t WS_END = 500 * MiB;
constexpr int CW_BAR = 4096;
constexpr int RING_BYTES = 135168, LDS_BYTES = 163840, LDSCTL_OFF = LDS_BYTES - 1024, MISC_OFF = LDSCTL_OFF + 320, RSTAB_OFF = RING_BYTES + 448;

#define GAS __attribute__((address_space(1)))
#define LAS __attribute__((address_space(3)))
typedef unsigned short bf16;
typedef unsigned v4u __attribute__((ext_vector_type(4)));
typedef unsigned v2u __attribute__((ext_vector_type(2)));
typedef float f32x4 __attribute__((ext_vector_type(4)));
#define LDS_WAIT() asm volatile("s_waitcnt lgkmcnt(0)" ::: "memory")
#define VM_WAIT() asm volatile("s_waitcnt vmcnt(0)" ::: "memory")
#define LDS_BARRIER() do { asm volatile("s_waitcnt lgkmcnt(0)\n\ts_barrier" ::: "memory"); } while (0)
__device__ __forceinline__ unsigned f2bf(float f) { unsigned u = __builtin_bit_cast(unsigned, f); return (u + 0x7fffu + ((u >> 16) & 1u)) >> 16; }
__device__ __forceinline__ unsigned pk2(float lo, float hi) { return f2bf(lo) | (f2bf(hi) << 16); }
__device__ __forceinline__ float bf2f(bf16 u) { return __builtin_bit_cast(float, (unsigned)u << 16); }
__device__ __forceinline__ float bflo(unsigned w) { return __builtin_bit_cast(float, w << 16); }
__device__ __forceinline__ float bfhi(unsigned w) { return __builtin_bit_cast(float, w & 0xffff0000u); }
__device__ __forceinline__ float wave_sum(float v) {
#define WS_DPP(x, ctrl, rmask) __builtin_bit_cast(float, __builtin_amdgcn_update_dpp(0, __builtin_bit_cast(int, x), ctrl, rmask, 0xf, true))
    v += WS_DPP(v, 0x111, 0xf);
    v += WS_DPP(v, 0x112, 0xf);
    v += WS_DPP(v, 0x114, 0xf);
    v += WS_DPP(v, 0x118, 0xf);
    v += WS_DPP(v, 0x142, 0xa);
    v += WS_DPP(v, 0x143, 0xc);
#undef WS_DPP
    return __builtin_bit_cast(float, __builtin_amdgcn_readlane(__builtin_bit_cast(int, v), 63));
}
__device__ __forceinline__ float wave_max(float v) {
#pragma unroll
    for (int o = 1; o < 64; o <<= 1) v = fmaxf(v, __shfl_xor(v, o));
    return v;
}
__device__ __forceinline__ float fexp(float x) { return __builtin_amdgcn_exp2f(x * 1.4426950408889634f); }
__device__ __forceinline__ float flog(float x) { return __builtin_amdgcn_logf(x) * 0.6931471805599453f; }
__device__ __forceinline__ float frcp(float x) { return __builtin_amdgcn_rcpf(x); }
__device__ __forceinline__ float frsq(float x) { return __builtin_amdgcn_rsqf(x); }
__device__ __forceinline__ float fsqrt(float x) { return __builtin_amdgcn_sqrtf(x); }
__device__ __forceinline__ float sigmoid_f(float x) { return frcp(1.0f + fexp(-x)); }
__device__ __forceinline__ float softplus_f(float x) { return fmaxf(x, 0.f) + flog(1.0f + fexp(-fabsf(x))); }
__device__ __forceinline__ float tanh_f(float x) { return 1.0f - 2.0f * frcp(1.0f + fexp(2.0f * x)); }
#define XB_TMO      128
#define XB_XCNT(j)  (256  + 64 * (j))
#define XB_XSUB(j)  (1280 + 64 * (j))
#define XB_XGEN(j)  (2304 + 64 * (j))
#define XB_TOP      3328
#define XB_TOPGEN   3392
#define XCD_BAR_WORDS 3456
#define XB_SPIN_CAP (1u << 23)

__device__ __forceinline__ unsigned xb_ld(unsigned* p)              { return __hip_atomic_load(p, __ATOMIC_RELAXED, __HIP_MEMORY_SCOPE_AGENT); }
__device__ __forceinline__ unsigned xb_add(unsigned* p, unsigned v) { return __hip_atomic_fetch_add(p, v, __ATOMIC_RELAXED, __HIP_MEMORY_SCOPE_AGENT); }
__device__ __forceinline__ unsigned xb_xcc_id() { return (unsigned)__builtin_amdgcn_s_getreg((3 << 11) | 20) & 0xFu; }
#define XB_SPIN(cond, bar) do { unsigned _sp = 0; while (cond) { __builtin_amdgcn_s_sleep(1); \
    if ((++_sp & 255u) == 0u) { if (xb_ld(&(bar)[XB_TMO])) break; if (_sp > XB_SPIN_CAP) { atomicAdd(&(bar)[XB_TMO], 1u); break; } } } } while (0)

struct XcdBarrier {
    unsigned* bar; unsigned x;
    volatile LAS unsigned* st;
};

__device__ __forceinline__ XcdBarrier xcd_barrier_post(unsigned* bar, volatile LAS unsigned* st) {
    XcdBarrier b; b.bar = bar; b.x = xb_xcc_id(); b.st = st;
    if (threadIdx.x == 0) (void)xb_add(&bar[XB_XCNT(b.x)], 1u);
    return b;
}
__device__ __forceinline__ void xcd_barrier_complete(unsigned* bar, unsigned x, unsigned& nloc, unsigned& nx) {
    const unsigned G = gridDim.x * gridDim.y * gridDim.z;
    unsigned sum, cnt, mine, sp = 0u;
    for (;;) {
        sum = 0u; cnt = 0u; mine = 0u;
#pragma unroll
        for (unsigned j = 0; j < 16; ++j) { const unsigned c = xb_ld(&bar[XB_XCNT(j)]); sum += c; cnt += (c > 0u) ? 1u : 0u; mine = (j == x) ? c : mine; }
        if (sum == G) break;
        __builtin_amdgcn_s_sleep(1);
        if ((++sp & 255u) == 0u) { if (xb_ld(&bar[XB_TMO])) break; if (sp > XB_SPIN_CAP) { atomicAdd(&bar[XB_TMO], 1u); break; } }
    }
    nloc = mine > 0u ? mine : 1u; nx = cnt > 0u ? cnt : 1u;
}

__device__ __forceinline__ void xcd_barrier(const XcdBarrier& b) {
    asm volatile("s_waitcnt vmcnt(0)" ::: "memory");
    __syncthreads();
    if (threadIdx.x == 0) {
        unsigned blo_ = __builtin_amdgcn_readfirstlane((unsigned)(unsigned long long)b.bar), bhi_ = __builtin_amdgcn_readfirstlane((unsigned)((unsigned long long)b.bar >> 32)), bx = __builtin_amdgcn_readfirstlane(b.x); asm volatile("" : "+s"(blo_), "+s"(bhi_), "+s"(bx)); unsigned* bar = (unsigned*)(((unsigned long long)bhi_ << 32) | blo_);
        __builtin_amdgcn_s_waitcnt(0);
        unsigned nloc = b.st[0], nx = b.st[1];
        if (nloc == 0u) { xcd_barrier_complete(bar, bx, nloc, nx); b.st[0] = nloc; b.st[1] = nx; }
        const unsigned old = xb_add(&bar[XB_XSUB(bx)], 1u);
        const unsigned gen = old / nloc;
        if (old + 1u == (gen + 1u) * nloc) {
            __builtin_amdgcn_fence(__ATOMIC_RELEASE, "agent");
            asm volatile("s_waitcnt vmcnt(0)" ::: "memory");
            const unsigned og = xb_add(&bar[XB_TOP], 1u);
            const unsigned tg = og / nx;
            if (og + 1u == (tg + 1u) * nx) xb_add(&bar[XB_TOPGEN], 1u);
            else XB_SPIN(xb_ld(&bar[XB_TOPGEN]) == tg, bar);
            __builtin_amdgcn_fence(__ATOMIC_ACQUIRE, "agent");
            xb_add(&bar[XB_XGEN(bx)], 1u);
            asm volatile("s_waitcnt vmcnt(0)" ::: "memory");
        } else {
            XB_SPIN(xb_ld(&bar[XB_XGEN(bx)]) == gen, bar);
            __builtin_amdgcn_fence(__ATOMIC_ACQUIRE, "agent");
            asm volatile("s_waitcnt vmcnt(0)" ::: "memory");
        }
    }
    __syncthreads();
}
__device__ __forceinline__ void tr_item(const float* __restrict__ W, int Kreal, int N, bf16* WT, int ldd, int dst_row0, LAS float* scr, int k0, int n0, int lane,
                                        const float* __restrict__ mu, float sc0, float sc1, const float* __restrict__ gk = nullptr) {
    const int rr = lane >> 3, c4 = lane & 7, nn = n0 + 4 * c4; const bool nv = nn < N;
#pragma unroll
    for (int i = 0; i < 8; ++i) { const int kk = 8 * i + rr; f32x4 v = (nv && k0 + kk < Kreal) ? *(const GAS f32x4*)(W + (size_t)(k0 + kk) * N + nn) : (f32x4){0.f, 0.f, 0.f, 0.f};
        float sc = 1.0f; if (mu) sc = sc0 + sc1 * mu[k0 + kk]; if (gk) sc *= gk[k0 + kk]; v = v * sc;
        LAS float* d = scr + kk * 33 + 4 * c4; d[0] = v.x; d[1] = v.y; d[2] = v.z; d[3] = v.w; }
    LDS_WAIT(); asm volatile("" ::: "memory");
    const int c = lane & 7;
#pragma unroll
    for (int j = 0; j < 4; ++j) { const int n = (lane >> 3) + 8 * j; const LAS float* s = scr + (8 * c) * 33 + n;
        v4u o; o.x = pk2(s[0 * 33], s[1 * 33]); o.y = pk2(s[2 * 33], s[3 * 33]); o.z = pk2(s[4 * 33], s[5 * 33]); o.w = pk2(s[6 * 33], s[7 * 33]);
        if (n0 + n < N) *(GAS v4u*)(WT + (size_t)(dst_row0 + n) * ldd + k0 + 8 * c) = o; }
    LDS_WAIT(); asm volatile("" ::: "memory");
}
__device__ __forceinline__ void rms_rows4_bf16_to_f32(const bf16* x, const float* g, float* o, int m0, int mstride, int lane) {
    v2u a[4][4];
#pragma unroll
    for (int u = 0; u < 4; ++u) { const int m = m0 + u * mstride; if (m < M) { const GAS v2u* xr = (const GAS v2u*)(x + (size_t)m * D) + lane;
#pragma unroll
        for (int q = 0; q < 4; ++q) a[u][q] = xr[64 * q]; } }
    f32x4 gv[4];
#pragma unroll
    for (int q = 0; q < 4; ++q) gv[q] = ((const GAS f32x4*)g)[lane + 64 * q];
#pragma unroll
    for (int u = 0; u < 4; ++u) { const int m = m0 + u * mstride; if (m < M) { f32x4 v[4]; float s = 0.f;
#pragma unroll
        for (int q = 0; q < 4; ++q) { v[q] = (f32x4){bflo(a[u][q].x), bfhi(a[u][q].x), bflo(a[u][q].y), bfhi(a[u][q].y)}; s += (v[q].x * v[q].x + v[q].y * v[q].y) + (v[q].z * v[q].z + v[q].w * v[q].w); }
        const float rs = frsq(wave_sum(s) * (1.f / D) + 1e-6f);
        GAS f32x4* orow = (GAS f32x4*)(o + (size_t)m * D) + lane;
#pragma unroll
        for (int q = 0; q < 4; ++q) orow[64 * q] = v[q] * rs * gv[q]; } }
}
struct Args { const float* in[36]; float* out; unsigned char* ws; int lo, hi; };
typedef const __attribute__((address_space(4))) Args* ArgP;
#define FRESH_ARGS() ({ ArgP p_ = (ArgP)__builtin_amdgcn_kernarg_segment_ptr(); asm volatile("" : "+s"(p_)); p_; })
#define FRESH_V(x) asm volatile("" : "+v"(x))
#define FRESH_S(x) asm volatile("" : "+s"(x))

#define TR_JOB(items, nblk, Wp, Kd, Nd, DST, LDD, ROW0, MU, S0, S1, GK) if (r < (items)) { const int kb = r / (nblk), nb = r % (nblk), n0 = 32 * nb; tr_item(Wp, Kd, Nd, DST, LDD, ROW0, scr, 64 * kb, n0, lane, MU, S0, S1, GK); continue; } r -= (items);
__device__ __forceinline__ void convert_mixer_weights(ArgP A, int L, LAS unsigned char* lds, int wave, int lane, int gw, int NGW) {
    const int i = L >> 1; const bool even = !(L & 1);
    bf16* Win = (bf16*)(A->ws + WS_WIN); bf16* Wout = (bf16*)(A->ws + WS_WOUT);
    LAS float* scr = (LAS float*)(lds + wave * 16384);
    const float* gmix = A->in[2] + (size_t)L * D;
    const float* w_in = even ? A->in[5] + (size_t)i * D * 3072 : A->in[26] + (size_t)i * D * 3072;
    const float* w_out = even ? A->in[6] + (size_t)i * D * D : A->in[27] + (size_t)i * D * D;
    const float* mu_w = A->in[8] + (size_t)i * 3 * D, *mu_a = mu_w + D, *mu_g = mu_w + 2 * D;
    const float* w1 = A->in[10] + (size_t)i * D * 64, *a1 = A->in[13] + (size_t)i * D * 64, *g1 = A->in[15] + (size_t)i * D * 160, *wa1 = A->in[22] + (size_t)i * D * 16;
    const float* w2s = A->in[11] + (size_t)i * 64 * 512, *a2s = A->in[14] + (size_t)i * 64 * 512, *g2s = A->in[16] + (size_t)i * 160 * 512;
    bf16* W2T = (bf16*)(A->ws + WS_W2T); bf16* A2T = (bf16*)(A->ws + WS_A2T); bf16* G2T = (bf16*)(A->ws + WS_G2T);
    const int I_IN = 16 * 96, I_L64 = 16 * 2, I_L160 = 16 * 5, I_L16 = 16 * 1, I_OUT = 16 * 32;
    const int n_lora = even ? (4 * I_L64 + 2 * I_L160 + I_L16 + 16 + 16 + 48) : 0;
    const int NITEMS = I_IN + n_lora + I_OUT;
    for (int it = gw; it < NITEMS; it += NGW) {
        int r = it;
        TR_JOB(I_IN, 96, w_in, D, 3072, Win, D, n0, nullptr, 1.f, 0.f, gmix)
        if (even) {
            TR_JOB(I_L64, 2, w1, D, 64, Win, D, PC_W1A + n0, mu_w, 1.f, -1.f, gmix)
            TR_JOB(I_L64, 2, w1, D, 64, Win, D, PC_W1B + n0, mu_w, 0.f, 1.f, gmix)
            TR_JOB(I_L64, 2, a1, D, 64, Win, D, PC_A1A + n0, mu_a, 1.f, -1.f, gmix)
            TR_JOB(I_L64, 2, a1, D, 64, Win, D, PC_A1B + n0, mu_a, 0.f, 1.f, gmix)
            TR_JOB(I_L160, 5, g1, D, 160, Win, D, PC_G1A + n0, mu_g, 1.f, -1.f, gmix)
            TR_JOB(I_L160, 5, g1, D, 160, Win, D, PC_G1B + n0, mu_g, 0.f, 1.f, gmix)
            TR_JOB(I_L16, 1, wa1, D, 16, Win, D, PC_WA1 + n0, nullptr, 1.f, 0.f, gmix)
            TR_JOB(16, 16, w2s, 64, 512, W2T, 64, n0, nullptr, 1.f, 0.f, nullptr)
            TR_JOB(16, 16, a2s, 64, 512, A2T, 64, n0, nullptr, 1.f, 0.f, nullptr)
            TR_JOB(48, 16, g2s, 160, 512, G2T, 192, n0, nullptr, 1.f, 0.f, nullptr)
        }
        TR_JOB(I_OUT, 32, w_out, D, D, Wout, D, n0, nullptr, 1.f, 0.f, nullptr)
    }
    if (even) {
        const int gt = gw * 64 + lane, NT = NGW * 64;
        { unsigned z_ = 0u; asm volatile("" : "+v"(z_));
        for (int e = gt; e < (NIN_E - PC_PAD) * D / 8; e += NT) ((GAS v4u*)(Win + (size_t)PC_PAD * D))[e] = (v4u){z_, z_, z_, z_}; }
        bf16* WA2T = (bf16*)(A->ws + WS_WA2T); const float* wa2 = A->in[23] + (size_t)i * 16 * 256;
        for (int e = gt; e < 256 * 32; e += NT) { const int nn = e >> 5, k = e & 31; WA2T[e] = k < 16 ? (bf16)f2bf(wa2[k * 256 + nn]) : (bf16)0; }
    }
}
__device__ __forceinline__ void convert_ffn_weights(ArgP A, int L, LAS unsigned char* lds, int wave, int lane, int gw, int NGW) {
    bf16* Wgu = (bf16*)(A->ws + WS_WGU); bf16* Wdn = (bf16*)(A->ws + WS_WDN);
    LAS float* scr = (LAS float*)(lds + wave * 16384);
    const float* gffn = A->in[3] + (size_t)L * D;
    const float* wg = A->in[33] + (size_t)L * D * FF, *wu = A->in[34] + (size_t)L * D * FF, *wd = A->in[35] + (size_t)L * FF * D;
    const int I_GU = 16 * 88, I_DN = 44 * 32;
    for (int it = gw; it < 2 * I_GU + I_DN; it += NGW) {
        int r = it;
        TR_JOB(I_GU, 88, wg, D, FF, Wgu, D, 256 * (n0 >> 7) + (n0 & 127), nullptr, 1.f, 0.f, gffn)
        TR_JOB(I_GU, 88, wu, D, FF, Wgu, D, 256 * (n0 >> 7) + (n0 & 127) + 128, nullptr, 1.f, 0.f, gffn)
        TR_JOB(I_DN, 32, wd, FF, D, Wdn, FF, n0, nullptr, 1.f, 0.f, nullptr)
    }
}
#undef TR_JOB
__device__ __forceinline__ void x_to_bf16_ssq4(const float* x, bf16* o, float* ssq, int m0, int mstride, int lane) {
    f32x4 v[4][4];
#pragma unroll
    for (int u = 0; u < 4; ++u) { const int m = m0 + u * mstride; if (m < M) { const GAS f32x4* xr = (const GAS f32x4*)(x + (size_t)m * D) + lane;
#pragma unroll
        for (int j = 0; j < 4; ++j) v[u][j] = xr[64 * j]; } }
#pragma unroll
    for (int u = 0; u < 4; ++u) { const int m = m0 + u * mstride; if (m < M) { float s = 0.f;
#pragma unroll
        for (int j = 0; j < 4; ++j) s += (v[u][j].x * v[u][j].x + v[u][j].y * v[u][j].y) + (v[u][j].z * v[u][j].z + v[u][j].w * v[u][j].w);
        s = wave_sum(s); if (lane < 16) ssq[(size_t)m * 16 + lane] = lane == 0 ? s : 0.f;
        GAS v2u* o8 = (GAS v2u*)(o + (size_t)m * D) + lane;
#pragma unroll
        for (int j = 0; j < 4; ++j) { v2u w; w.x = pk2(v[u][j].x, v[u][j].y); w.y = pk2(v[u][j].z, v[u][j].w); o8[64 * j] = w; } } }
}

__device__ __forceinline__ int t5_bucket(int d) {
    if (d < 16) return d;
    const float r = (float)d / 16.0f; int l = 16 + (int)(flog(r) / 2.0794415416798357f * 16.0f);
    return l < 31 ? l : 31;
}
typedef short a_bf16x8 __attribute__((ext_vector_type(8)));
typedef float f32x16 __attribute__((ext_vector_type(16)));
typedef short a_s16x4 __attribute__((ext_vector_type(4)));
constexpr int AT_K1 = 0, AT_K2 = 8192, AT_V = 16384, AT_ST = 32768, AT_NST = 4, AT_BIAS = AT_NST * AT_ST, AT_COMB = 0;
static_assert(AT_BIAS + 132 * 4 <= LDSCTL_OFF && 4 * 64 * 64 * 4 <= AT_BIAS, "attention LDS map");
__device__ __forceinline__ int crow16(int r, int hi) { return (r & 3) + 8 * (r >> 2) + 4 * hi; }
typedef float f32x2_t __attribute__((ext_vector_type(2))); typedef __bf16 bf16x2_t __attribute__((ext_vector_type(2)));
__device__ __forceinline__ unsigned cvtpk(float lo, float hi) { const f32x2_t v = {lo, hi}; const bf16x2_t b = __builtin_convertvector(v, bf16x2_t); return __builtin_bit_cast(unsigned, b); }

template <bool HALFSYNC = false> __device__ __forceinline__ void attn_unit_mfma(ArgP A, int L, int b, int h, int qb, float lam, float lam_init, LAS unsigned char* lds, int tid) {
    const int lane = tid & 63, wave = __builtin_amdgcn_readfirstlane(tid >> 6), r32 = lane & 31, hi = lane >> 5;
    const int smap = wave >> 2, qs = wave & 3;
    const int i = L >> 1;
    const bf16* QKV = (const bf16*)(A->ws + WS_P); bf16* O = (bf16*)(A->ws + WS_XN);
    const int q0 = qb * 128, qw0 = q0 + 32 * qs, nt = (q0 + 128) / 64;
    const size_t rowb = (size_t)b * T;
    if (tid < 129) { const float far = A->in[1][31 * 8 + h]; ((LAS float*)(lds + AT_BIAS))[tid] = tid < 128 ? (A->in[1][t5_bucket(tid) * 8 + h] - far) * 1.4426950408889634f : 0.f; }
    a_bf16x8 qf[4];
    { const bf16* qrow = QKV + (rowb + qw0 + r32) * NIN_O + h * 128 + smap * 64 + 8 * hi;
#pragma unroll
      for (int ks = 0; ks < 4; ++ks) qf[ks] = *(const GAS a_bf16x8*)(qrow + 16 * ks); }
    const int kr = 8 * wave + (lane >> 3), kcs = (lane & 7) ^ ((kr >> 1) & 7);
    const bf16* kg = QKV + (rowb + kr) * NIN_O + 1024 + h * 128 + 8 * kcs;
    const int vr0 = 8 * wave + (lane >> 4), vr1 = vr0 + 4;
    const bf16* vg0 = QKV + (rowb + vr0) * NIN_O + 2048 + h * 128 + 8 * ((lane & 15) ^ (((vr0 & 3) << 2) | ((vr0 >> 2) & 3)));
    const bf16* vg1 = QKV + (rowb + vr1) * NIN_O + 2048 + h * 128 + 8 * ((lane & 15) ^ (((vr1 & 3) << 2) | ((vr1 >> 2) & 3)));
#define AT_DMA(kt, stoff) do { const size_t go_ = (size_t)(kt) * 64 * NIN_O; LAS unsigned char* sb_ = lds + (stoff) + wave * 1024; \
        __builtin_amdgcn_global_load_lds((const unsigned*)(kg + go_), (LAS unsigned*)(sb_ + AT_K1), 16, 0, 0); __builtin_amdgcn_global_load_lds((const unsigned*)(kg + go_ + 64), (LAS unsigned*)(sb_ + AT_K2), 16, 0, 0); \
        __builtin_amdgcn_global_load_lds((const unsigned*)(vg0 + go_), (LAS unsigned*)(sb_ + AT_V + wave * 1024), 16, 0, 0); __builtin_amdgcn_global_load_lds((const unsigned*)(vg1 + go_), (LAS unsigned*)(sb_ + AT_V + wave * 1024 + 1024), 16, 0, 0); } while (0)
    AT_DMA(0, 0); AT_DMA(1, AT_ST);
    __syncthreads();
    f32x16 o[4];
#pragma unroll
    for (int d = 0; d < 4; ++d)
#pragma unroll
        for (int r = 0; r < 16; ++r) o[d][r] = 0.f;
    float m = -1e30f, l = 0.f;
    const int kfo = (smap ? AT_K2 : AT_K1) + r32 * 128, khg = hi ^ ((r32 >> 1) & 7);
    int vfo[2][4];
    { const int q = (lane & 15) >> 2, pp = lane & 3, blk = (lane >> 4) & 1;
#pragma unroll
      for (int t = 0; t < 2; ++t)
#pragma unroll
          for (int d = 0; d < 4; ++d) vfo[t][d] = AT_V + 256 * (4 * hi + q + 8 * t) + 16 * (((d ^ q) << 2) | ((2 * blk + (pp >> 1)) ^ ((hi + 2 * t) & 3))) + 8 * (pp & 1); }
    const LAS float* bdl = (const LAS float*)(lds + AT_BIAS);
    const int qme = qw0 + r32;
#define AT_VREAD(VF, kk) do { _Pragma("unroll") for (int d = 0; d < 4; ++d) { \
                VF[2 * d] = __builtin_bit_cast(a_s16x4, __builtin_amdgcn_ds_read_tr16_b64_v4i16((LAS a_s16x4*)(sbv + vfo[0][d] + (kk) * 4096))); VF[2 * d + 1] = __builtin_bit_cast(a_s16x4, __builtin_amdgcn_ds_read_tr16_b64_v4i16((LAS a_s16x4*)(sbv + vfo[1][d] + (kk) * 4096))); } } while (0)
#define AT_PV(VF, PF, kk) do { _Pragma("unroll") for (int d = 0; d < 4; ++d) { const a_bf16x8 vf_ = (a_bf16x8){VF[2 * d][0], VF[2 * d][1], VF[2 * d][2], VF[2 * d][3], VF[2 * d + 1][0], VF[2 * d + 1][1], VF[2 * d + 1][2], VF[2 * d + 1][3]}; \
                o[d] = __builtin_amdgcn_mfma_f32_32x32x16_bf16(vf_, PF[kk], o[d], 0, 0, 0); } } while (0)
    int pbase = 0;
#pragma unroll 1
    for (int kt0 = 0; kt0 < nt; kt0 += 2) {
        const int nbase = pbase ? 0 : 2 * AT_ST;
#pragma unroll 1
      for (int sub = 0; sub < 2; ++sub) { const int kt = kt0 + sub; const int stoff = pbase + sub * AT_ST;
        if (sub == 0 && kt + 2 < nt) { AT_DMA(kt + 2, nbase); AT_DMA(kt + 3, nbase + AT_ST); }
        const int key0 = 64 * kt;
        if (key0 <= qw0 + 31) {
            const LAS unsigned char* sb = lds + stoff; const LAS unsigned char* sbv = sb;
            f32x16 p[2]; a_bf16x8 kf[8];
#pragma unroll
            for (int f = 0; f < 8; ++f) kf[f] = *(const LAS a_bf16x8*)(sb + kfo + (f >> 2) * 4096 + ((khg ^ (2 * (f & 3))) * 16));
            __builtin_amdgcn_sched_barrier(0);
            __builtin_amdgcn_s_setprio(1);
#pragma unroll
            for (int blk = 0; blk < 2; ++blk) {
#pragma unroll
                for (int r = 0; r < 16; ++r) p[blk][r] = 0.f;
#pragma unroll
                for (int ks = 0; ks < 4; ++ks) p[blk] = __builtin_amdgcn_mfma_f32_32x32x16_bf16(kf[blk * 4 + ks], qf[ks], p[blk], 0, 0, 0);
            }
            __builtin_amdgcn_s_setprio(0);
            if (key0 + 63 + 128 > qw0) {
#pragma unroll
                for (int blk = 0; blk < 2; ++blk) { float bvv[16];
#pragma unroll
                    for (int r = 0; r < 16; ++r) { const unsigned ud = (unsigned)(qme - (key0 + 32 * blk + crow16(r, hi))); bvv[r] = bdl[ud < 128u ? ud : 128u]; }
                    asm volatile("" : "+v"(bvv[0]), "+v"(bvv[1]), "+v"(bvv[2]), "+v"(bvv[3]), "+v"(bvv[4]), "+v"(bvv[5]), "+v"(bvv[6]), "+v"(bvv[7]), "+v"(bvv[8]), "+v"(bvv[9]), "+v"(bvv[10]), "+v"(bvv[11]), "+v"(bvv[12]), "+v"(bvv[13]), "+v"(bvv[14]), "+v"(bvv[15]));
#pragma unroll
                    for (int r = 0; r < 16; ++r) { const int dist = qme - (key0 + 32 * blk + crow16(r, hi)); p[blk][r] = dist < 0 ? -1e30f : p[blk][r] + bvv[r]; } }
            }
            float mx = p[0][0];
#pragma unroll
            for (int r = 1; r < 16; ++r) mx = fmaxf(mx, p[0][r]);
#pragma unroll
            for (int r = 0; r < 16; ++r) mx = fmaxf(mx, p[1][r]);
            { const auto sw_ = __builtin_amdgcn_permlane32_swap(__builtin_bit_cast(unsigned, mx), __builtin_bit_cast(unsigned, mx), false, false);
              mx = fmaxf(__builtin_bit_cast(float, sw_[0]), __builtin_bit_cast(float, sw_[1])); }
            if (__any(mx > m + 8.0f)) {
                const float mn = fmaxf(m, mx), al = __builtin_amdgcn_exp2f(m - mn); m = mn; l *= al;
#pragma unroll
                for (int d = 0; d < 4; ++d)
#pragma unroll
                    for (int r = 0; r < 16; ++r) o[d][r] *= al;
            }
            float ls = 0.f;
#define AT_EXPPK(PF, kk) do { const int blk_ = (kk) >> 1, s8_ = 8 * ((kk) & 1); float e_[8]; _Pragma("unroll") for (int j = 0; j < 8; ++j) { e_[j] = __builtin_amdgcn_exp2f(p[blk_][s8_ + j] - m); ls += e_[j]; } \
                v4u w_; w_.x = cvtpk(e_[0], e_[1]); w_.y = cvtpk(e_[2], e_[3]); w_.z = cvtpk(e_[4], e_[5]); w_.w = cvtpk(e_[6], e_[7]); PF[kk] = __builtin_bit_cast(a_bf16x8, w_); } while (0)
            {
                a_bf16x8 pf[4]; a_s16x4 vA[8], vB[8];
                AT_VREAD(vA, 0); AT_EXPPK(pf, 0);
                __builtin_amdgcn_sched_barrier(0);
                AT_VREAD(vB, 1); AT_PV(vA, pf, 0); AT_EXPPK(pf, 1);
                __builtin_amdgcn_sched_barrier(0);
                AT_VREAD(vA, 2); AT_PV(vB, pf, 1); AT_EXPPK(pf, 2);
                __builtin_amdgcn_sched_barrier(0);
                AT_VREAD(vB, 3); AT_PV(vA, pf, 2); AT_EXPPK(pf, 3);
                __builtin_amdgcn_sched_barrier(0);
                AT_PV(vB, pf, 3);
            }
            l += ls;
#undef AT_EXPPK
        }
      }
        __syncthreads();
        pbase = nbase;
    }
#undef AT_VREAD
#undef AT_PV
#undef AT_DMA
    l += __shfl_xor(l, 32);
    LAS float* comb = (LAS float*)(lds + AT_COMB) + qs * 4096;
    if (smap == 1) { const float sc = lam * frcp(l);
#pragma unroll
        for (int d = 0; d < 4; ++d)
#pragma unroll
            for (int r = 0; r < 16; ++r) comb[(d * 16 + r) * 64 + lane] = o[d][r] * sc; }
    __syncthreads();
    if (smap == 0) {
        const float il = frcp(l); float ss = 0.f;
#pragma unroll
        for (int d = 0; d < 4; ++d)
#pragma unroll
            for (int r = 0; r < 16; ++r) { const float v = o[d][r] * il - comb[(d * 16 + r) * 64 + lane]; o[d][r] = v; ss += v * v; }
        ss += __shfl_xor(ss, 32);
        const float rs = frsq(ss * (1.f / 128.f) + 1e-5f) * (1.0f - lam_init);
        const float* sl = A->in[32] + i * 128;
        bf16* orow = O + (rowb + qw0 + r32) * D + h * 128;
#pragma unroll
        for (int d = 0; d < 4; ++d)
#pragma unroll
            for (int g4 = 0; g4 < 4; ++g4) { const int dc = 32 * d + 8 * g4 + 4 * hi; const f32x4 s4 = *(const GAS f32x4*)(sl + dc);
                v2u w; w.x = cvtpk(o[d][4 * g4] * rs * s4.x, o[d][4 * g4 + 1] * rs * s4.y); w.y = cvtpk(o[d][4 * g4 + 2] * rs * s4.z, o[d][4 * g4 + 3] * rs * s4.w);
                *(GAS v2u*)(orow + dc) = w; }
    }
    __syncthreads();
}

template <bool HALFSYNC = false> __device__ __forceinline__ void attn_phase_mfma(ArgP A, int L, LAS unsigned char* lds, int tid, int G, int bid) {
    const int lane = tid & 63, i = L >> 1;
    const float lam_init = 0.8f - 0.6f * fexp(-0.3f * (float)L);
    const float lam = fexp(wave_sum(A->in[28][i * 64 + lane] * A->in[29][i * 64 + lane])) - fexp(wave_sum(A->in[30][i * 64 + lane] * A->in[31][i * 64 + lane])) + lam_init;
    if (G == 256) {
        const int v = (bid & 7) * 32 + (bid >> 3), bh = v >> 2, j = v & 3;
#pragma unroll 1
        for (int u = 0; u < 8; ++u) { const int qb = 8 * (u >> 1) + ((u & 1) ? 7 - j : j); attn_unit_mfma<HALFSYNC>(A, L, bh >> 3, bh & 7, qb, lam, lam_init, lds, tid); }
    } else {
#pragma unroll 1
        for (int u = bid; u < 64 * 32; u += G) attn_unit_mfma<HALFSYNC>(A, L, (u >> 5) >> 3, (u >> 5) & 7, 31 - (u & 31), lam, lam_init, lds, tid);
    }
}
typedef short bf16x8_t __attribute__((ext_vector_type(8)));
constexpr int MS = 72, MB = 64 * MS * 2;
constexpr int RW_XW = 8 * MB, RW_XA = RW_XW + 16384;
constexpr int RW_TOT = 14 * MB, RW_GAM = RW_TOT + 2048, RW_END = RW_GAM + 256;
static_assert(RW_XA + 16384 <= 12 * MB && RW_END <= RING_BYTES, "RWKV LDS map");
constexpr size_t WS_RWI = 336 * MiB;
constexpr size_t WS_BON = 30 * MiB;
#define RBUF(k) ((LAS bf16*)(lds + (k) * MB))
__device__ __forceinline__ f32x4 mfma16(bf16x8_t a, bf16x8_t b, f32x4 c) { return __builtin_amdgcn_mfma_f32_16x16x32_bf16(a, b, c, 0, 0, 0); }
__device__ __forceinline__ bf16x8_t ldfrag(const LAS bf16* Mx, int row0, int k0, int lane) { return *(const LAS bf16x8_t*)(Mx + (row0 + (lane & 15)) * MS + k0 + 8 * (lane >> 4)); }
__device__ __forceinline__ f32x4 mm64(f32x4 acc, const LAS bf16* Am, int ra, const LAS bf16* BTm, int cb, int lane) {
    acc = mfma16(ldfrag(Am, 16 * ra, 0, lane), ldfrag(BTm, 16 * cb, 0, lane), acc);
    return mfma16(ldfrag(Am, 16 * ra, 32, lane), ldfrag(BTm, 16 * cb, 32, lane), acc);
}
__device__ __forceinline__ v2u pack4(f32x4 a) { v2u w; w.x = cvtpk(a[0], a[1]); w.y = cvtpk(a[2], a[3]); return w; }
__device__ __forceinline__ void tstore(LAS bf16* Dm, int rt, int ct, f32x4 acc, int lane) { *(LAS v2u*)(Dm + (16 * ct + (lane & 15)) * MS + 16 * rt + 4 * (lane >> 4)) = pack4(acc); }
__device__ __forceinline__ void tstore_g(bf16* Dg, int rt, int ct, f32x4 acc, int lane) { *(GAS v2u*)(Dg + (16 * ct + (lane & 15)) * 64 + 16 * rt + 4 * (lane >> 4)) = pack4(acc); }
__device__ __forceinline__ f32x4 ld4bf(const LAS bf16* p) { const v2u w = *(const LAS v2u*)p; return (f32x4){bflo(w.x), bfhi(w.x), bflo(w.y), bfhi(w.y)}; }
__device__ __forceinline__ f32x4 ld4bf_g(const bf16* p) { const v2u w = *(const GAS v2u*)p; return (f32x4){bflo(w.x), bfhi(w.x), bflo(w.y), bfhi(w.y)}; }
__device__ __forceinline__ void unpack8(v4u w, float (&f)[8]) { f[0] = bflo(w.x); f[1] = bfhi(w.x); f[2] = bflo(w.y); f[3] = bfhi(w.y); f[4] = bflo(w.z); f[5] = bfhi(w.z); f[6] = bflo(w.w); f[7] = bfhi(w.w); }
__device__ __forceinline__ bf16x8_t pack8(const float (&f)[8]) { v4u w; w.x = cvtpk(f[0], f[1]); w.y = cvtpk(f[2], f[3]); w.z = cvtpk(f[4], f[5]); w.w = cvtpk(f[6], f[7]); return __builtin_bit_cast(bf16x8_t, w); }

__device__ __forceinline__ void rwkv_chunk_phase(ArgP A, int L, LAS unsigned char* lds, int tid, int G, int bid) {
    const int lane = tid & 63, wave = __builtin_amdgcn_readfirstlane(tid >> 6), i = L >> 1;
    const int l15 = lane & 15, lg = lane >> 4;
    const bf16* P = (const bf16*)(A->ws + WS_P); bf16* XNb = (bf16*)(A->ws + WS_XN);
    const int rt = wave >> 1, ct0 = 2 * (wave & 1);
    constexpr int NIT = BATCH * 64 * 8;
    v4u pw[2][2], pa[2][2]; unsigned short pe[9][3];
#ifdef PROBE_R1
#define R1_STAMP(k) do { if (tid == 0 && bid == PROBE_BLOCK) { LAS unsigned long long* t_ = (LAS unsigned long long*)(lds + LDSCTL_OFF + 640); const unsigned long long now_ = __builtin_amdgcn_s_memrealtime(); t_[1 + (k)] += now_ - t_[0]; t_[0] = now_; } } while (0)
#else
#define R1_STAMP(k) do { } while (0)
#endif
#define R1_PREFETCH(itx) do { const int b_ = (itx) >> 9, n_ = ((itx) >> 3) & 63, h_ = (itx) & 7; const size_t rowb_ = (size_t)b_ * T + 64 * n_; \
        { const int tt_ = 16 * rt + l15; const bf16* prow_ = P + (rowb_ + tt_) * NIN_E; const bool hp_ = (64 * n_ + tt_) > 0; const v4u z4_ = (v4u){0u, 0u, 0u, 0u}; \
          _Pragma("unroll") for (int q = 0; q < 2; ++q) { const int kc_ = 32 * q + 8 * lg; pw[q][0] = *(const GAS v4u*)(prow_ + PC_W1A + kc_); pw[q][1] = hp_ ? *(const GAS v4u*)(prow_ - NIN_E + PC_W1B + kc_) : z4_; \
              pa[q][0] = *(const GAS v4u*)(prow_ + PC_A1A + kc_); pa[q][1] = hp_ ? *(const GAS v4u*)(prow_ - NIN_E + PC_A1B + kc_) : z4_; } \
          } \
        { const int c_ = 64 * h_ + lane; const size_t row0_ = rowb_ + 8 * wave; const bool hp_ = (64 * n_ + 8 * wave) > 0; \
          _Pragma("unroll") for (int u = 0; u < 9; ++u) { const bf16* pp_ = P + (row0_ + u - 1) * NIN_E; const bool ok_ = u > 0 || hp_; \
              pe[u][0] = ok_ ? pp_[PC_R + c_] : (unsigned short)0; pe[u][1] = ok_ ? pp_[PC_K + c_] : (unsigned short)0; pe[u][2] = ok_ ? pp_[PC_V + c_] : (unsigned short)0; } } } while (0)
    if (bid < NIT) R1_PREFETCH(bid);
#ifdef PROBE_R1
    if (tid == 0 && bid == PROBE_BLOCK) ((LAS unsigned long long*)(lds + LDSCTL_OFF + 640))[0] = __builtin_amdgcn_s_memrealtime();
#endif
#pragma unroll 1
    for (int it = bid; it < NIT; it += G) {
    R1_STAMP(0);
    const int b = it >> 9, n = (it >> 3) & 63, h = it & 7;
    const size_t rowb = (size_t)b * T + 64 * n;
    bf16* item = (bf16*)(A->ws + WS_RWI) + ((size_t)((b * 8 + h) * 64 + n)) * 16384;
    asm volatile("; MARK_R1_E1");
    {
        const bf16* W2T = (const bf16*)(A->ws + WS_W2T); const bf16* A2T = (const bf16*)(A->ws + WS_A2T);
        f32x4 xw[2], xa[2];
#pragma unroll
        for (int c = 0; c < 2; ++c) { xw[c] = (f32x4){0.f, 0.f, 0.f, 0.f}; xa[c] = (f32x4){0.f, 0.f, 0.f, 0.f}; }
#pragma unroll
        for (int q = 0; q < 2; ++q) {
            const int kc = 32 * q + 8 * lg; float x[8], y[8], v[8];
            unpack8(pw[q][0], x); unpack8(pw[q][1], y);
#pragma unroll
            for (int e = 0; e < 8; ++e) v[e] = tanh_f(x[e] + y[e]);
            const bf16x8_t fw = pack8(v);
            unpack8(pa[q][0], x); unpack8(pa[q][1], y);
#pragma unroll
            for (int e = 0; e < 8; ++e) v[e] = x[e] + y[e];
            const bf16x8_t fa = pack8(v);
#pragma unroll
            for (int c = 0; c < 2; ++c) { const size_t wo = (size_t)(64 * h + 16 * (ct0 + c) + l15) * 64 + kc;
                xw[c] = mfma16(fw, *(const GAS bf16x8_t*)(W2T + wo), xw[c]); xa[c] = mfma16(fa, *(const GAS bf16x8_t*)(A2T + wo), xa[c]); }
        }
        LAS float* XW = (LAS float*)(lds + RW_XW); LAS float* XA = (LAS float*)(lds + RW_XA);
#pragma unroll
        for (int c = 0; c < 2; ++c)
#pragma unroll
            for (int r = 0; r < 4; ++r) { const int o = (16 * rt + 4 * lg + r) * 64 + 16 * (ct0 + c) + l15; XW[o] = xw[c][r]; XA[o] = xa[c][r]; }
    }
    LDS_BARRIER();
    R1_STAMP(1);
    asm volatile("; MARK_R1_E2");
    {
        const int c = 64 * h + lane;
        const float* mu = A->in[7] + (size_t)i * 1536;
        const float mur = mu[c], muk = mu[512 + c], muv = mu[1024 + c];
        const float kkc = A->in[17][i * 512 + c], kac = A->in[18][i * 512 + c], rkc = A->in[19][i * 512 + c], w0c = A->in[9][i * 512 + c], a0c = A->in[12][i * 512 + c];
        const LAS float* XW = (const LAS float*)(lds + RW_XW); const LAS float* XA = (const LAS float*)(lds + RW_XA);
        float* BON = (float*)(A->ws + WS_BON);
        const int tt0 = 8 * wave; const size_t row0 = rowb + tt0;
        float pr_p = bf2f(pe[0][0]), pk_p = bf2f(pe[0][1]), pv_p = bf2f(pe[0][2]);
        float rr[8], av[8], bv[8], km[8], vv[8], lc[8];
        float run = 0.f;
#pragma unroll
        for (int u = 0; u < 8; ++u) {
            const float pR = bf2f(pe[u + 1][0]), pK = bf2f(pe[u + 1][1]), pV = bf2f(pe[u + 1][2]);
            const float r = pR + (pr_p - pR) * mur, k = pK + (pk_p - pK) * muk, v = pV + (pv_p - pV) * muv; pr_p = pR; pk_p = pK; pv_p = pV;
            const float xw = w0c + XW[(tt0 + u) * 64 + lane], xa = a0c + XA[(tt0 + u) * 64 + lane];
            const float wlog = -0.6065306597126334f * sigmoid_f(xw), as = sigmoid_f(xa);
            float kk = k * kkc; const float n2 = wave_sum(kk * kk); kk = kk * frsq(fmaxf(n2, 1e-24f));
            const float kmod = k * (1.f + (as - 1.f) * kac);
            const float bon = wave_sum(r * kmod * rkc);
            if (lane == 0) BON[(row0 + u) * 8 + h] = bon;
            run += wlog; rr[u] = r; av[u] = -kk; bv[u] = kk * as; km[u] = kmod; vv[u] = v; lc[u] = run;
        }
        LAS float* TOT = (LAS float*)(lds + RW_TOT);
        TOT[wave * 64 + lane] = run;
        LDS_BARRIER();
        float off = 0.f, tot = 0.f;
#pragma unroll
        for (int w2 = 0; w2 < 8; ++w2) { const float tv = TOT[w2 * 64 + lane]; tot += tv; if (w2 < wave) off += tv; }
        if (wave == 0) ((LAS float*)(lds + RW_GAM))[lane] = fexp(tot);
        float fR[8], fA[8], fB[8], fK[8];
        float eprev = fexp(off);
#pragma unroll
        for (int u = 0; u < 8; ++u) { const float cum = off + lc[u], e1 = fexp(cum), ei = frcp(e1); fR[u] = rr[u] * e1; fA[u] = av[u] * eprev; fB[u] = bv[u] * ei; fK[u] = km[u] * ei; eprev = e1; }
        LAS bf16* At = RBUF(0); LAS bf16* Bt = RBUF(1); LAS bf16* Kt = RBUF(2); LAS bf16* Rt = RBUF(3);
#pragma unroll
        for (int u = 0; u < 8; ++u) { const int o = (tt0 + u) * MS + lane; At[o] = (bf16)f2bf(fA[u]); Bt[o] = (bf16)f2bf(fB[u]); Kt[o] = (bf16)f2bf(fK[u]); Rt[o] = (bf16)f2bf(fR[u]); }
        *(LAS bf16x8_t*)(RBUF(4) + lane * MS + tt0) = pack8(fA); *(LAS bf16x8_t*)(RBUF(5) + lane * MS + tt0) = pack8(fB);
        *(LAS bf16x8_t*)(RBUF(6) + lane * MS + tt0) = pack8(fK); *(LAS bf16x8_t*)(RBUF(7) + lane * MS + tt0) = pack8(vv);
    }
    asm volatile("" ::: "memory");
    if (it + G < NIT) R1_PREFETCH(it + G);
    LDS_BARRIER();
    R1_STAMP(2);
    asm volatile("; MARK_R1_G");
    {
        const LAS bf16* At = RBUF(0); const LAS bf16* Bt = RBUF(1); const LAS bf16* Kt = RBUF(2); const LAS bf16* Rt = RBUF(3);
        unsigned zu_ = 0u; asm volatile("" : "+v"(zu_));
#define R1_FRAG1(x) __builtin_bit_cast(bf16x8_t, (v4u){cvtpk((x)[0], (x)[1]), cvtpk((x)[2], (x)[3]), zu_, zu_})
#define R1_FRAG2(x, y) __builtin_bit_cast(bf16x8_t, (v4u){cvtpk((x)[0], (x)[1]), cvtpk((x)[2], (x)[3]), cvtpk((y)[0], (y)[1]), cvtpk((y)[2], (y)[3])})
#pragma unroll
        for (int c = 0; c < 2; ++c) { const int ct = ct0 + c; const f32x4 z = (f32x4){0.f, 0.f, 0.f, 0.f};
            f32x4 aL = mm64(z, Bt, rt, At, ct, lane);
            f32x4 aAKT = mm64(z, At, rt, Kt, ct, lane);
            f32x4 aRB = mm64(z, Bt, rt, Rt, ct, lane);
            f32x4 aRK = mm64(z, Kt, rt, Rt, ct, lane);
            const int col = 16 * ct + l15;
#pragma unroll
            for (int r = 0; r < 4; ++r) { const int row = 16 * rt + 4 * lg + r;
                if (!(row < col)) aL[r] = 0.f;
                if (!(col < row)) aAKT[r] = 0.f;
                if (!(row <= col)) { aRB[r] = 0.f; aRK[r] = 0.f; } }
            tstore(RBUF(8), rt, ct, aL, lane); tstore(RBUF(10), rt, ct, aAKT, lane); tstore(RBUF(11), rt, ct, aRB, lane); tstore(RBUF(12), rt, ct, aRK, lane);
            if (rt == ct) {
                f32x4 Mx = mm64(z, At, rt, Bt, ct, lane), MTx = aL, YT;
#pragma unroll
                for (int r = 0; r < 4; ++r) { if (!(l15 < 4 * lg + r)) Mx[r] = 0.f; YT[r] = (4 * lg + r) == l15 ? 1.f : 0.f; }
#pragma unroll
                for (int m = 0; m < 4; ++m) { const bf16x8_t fM = R1_FRAG1(Mx), fMT = R1_FRAG1(MTx), fY = R1_FRAG1(YT);
                    YT = mfma16(fM, fY, YT);
                    if (m < 3) { Mx = mfma16(fMT, fM, z); MTx = mfma16(fM, fMT, z); } }
                ((LAS v2u*)(lds + 9 * MB))[rt * 64 + lane] = pack4(YT);
            }
        }
    }
    LDS_BARRIER();
    R1_STAMP(3);
    asm volatile("; MARK_R1_N");
    {
        const int cw = wave & 3; const bool second = wave >= 4;
        const LAS bf16* RT = (second ? RBUF(10) : RBUF(4)) + (16 * cw + l15) * MS + 4 * lg;
        const LAS bf16* Lr = RBUF(8) + l15 * MS + 4 * lg;
        const LAS v2u* DFp = (const LAS v2u*)(lds + 9 * MB) + lane;
        unsigned zu_ = 0u; asm volatile("" : "+v"(zu_));
        const f32x4 z = (f32x4){0.f, 0.f, 0.f, 0.f};
        f32x4 R[4]; v2u df[4], l10, l20a, l20b, l30a, l30b, l32;
#pragma unroll
        for (int b4 = 0; b4 < 4; ++b4) { R[b4] = ld4bf(RT + 16 * b4); df[b4] = DFp[b4 * 64]; }
        l10 = *(const LAS v2u*)(Lr + 16 * MS);
        l20a = *(const LAS v2u*)(Lr + 32 * MS); l20b = *(const LAS v2u*)(Lr + 32 * MS + 16);
        l30a = *(const LAS v2u*)(Lr + 48 * MS); l30b = *(const LAS v2u*)(Lr + 48 * MS + 16); l32 = *(const LAS v2u*)(Lr + 48 * MS + 32);
#define R1_DF(b4) __builtin_bit_cast(bf16x8_t, (v4u){df[b4].x, df[b4].y, zu_, zu_})
#define R1_LF(a, b) __builtin_bit_cast(bf16x8_t, (v4u){(a).x, (a).y, (b).x, (b).y})
        const v2u zz2 = (v2u){zu_, zu_};
        f32x4 Z0, Z1, Z2, Z3, acc;
        Z0 = mfma16(R1_DF(0), R1_FRAG1(R[0]), z);
        acc = mfma16(R1_LF(l10, zz2), R1_FRAG1(Z0), R[1]); Z1 = mfma16(R1_DF(1), R1_FRAG1(acc), z);
        acc = mfma16(R1_LF(l20a, l20b), R1_FRAG2(Z0, Z1), R[2]); Z2 = mfma16(R1_DF(2), R1_FRAG1(acc), z);
        acc = mfma16(R1_LF(l30a, l30b), R1_FRAG2(Z0, Z1), R[3]); acc = mfma16(R1_LF(l32, zz2), R1_FRAG1(Z2), acc); Z3 = mfma16(R1_DF(3), R1_FRAG1(acc), z);
        if (!second) {
            LAS bf16* O = RBUF(13) + (16 * cw + l15) * MS + 4 * lg;
            *(LAS v2u*)(O) = pack4(Z0); *(LAS v2u*)(O + 16) = pack4(Z1); *(LAS v2u*)(O + 32) = pack4(Z2); *(LAS v2u*)(O + 48) = pack4(Z3);
        } else {
            LAS bf16* O = RBUF(1) + (4 * lg) * MS + 16 * cw + l15;
#define R1_ST4(Zx, b4) do { const v2u w_ = pack4(Zx); O[(16 * (b4) + 0) * MS] = (bf16)(w_.x & 0xffffu); O[(16 * (b4) + 1) * MS] = (bf16)(w_.x >> 16); O[(16 * (b4) + 2) * MS] = (bf16)(w_.y & 0xffffu); O[(16 * (b4) + 3) * MS] = (bf16)(w_.y >> 16); } while (0)
            R1_ST4(Z0, 0); R1_ST4(Z1, 1); R1_ST4(Z2, 2); R1_ST4(Z3, 3);
#undef R1_ST4
        }
#undef R1_DF
#undef R1_LF
    }
#undef R1_FRAG1
#undef R1_FRAG2
    LDS_BARRIER();
    R1_STAMP(4);
    asm volatile("; MARK_R1_F1");
    {
    {
#pragma unroll
        for (int c = 0; c < 2; ++c) { const int ct = ct0 + c; const f32x4 z = (f32x4){0.f, 0.f, 0.f, 0.f};
            tstore(RBUF(0), rt, ct, mm64(z, RBUF(1), rt, RBUF(7), ct, lane), lane); }
    }
    LDS_BARRIER();
    R1_STAMP(5);
    {
        const LAS float* GAM = (const LAS float*)(lds + RW_GAM);
#pragma unroll
        for (int c = 0; c < 2; ++c) { const int ct = ct0 + c; const f32x4 z = (f32x4){0.f, 0.f, 0.f, 0.f};
            const f32x4 r0 = ld4bf(RBUF(3) + (16 * ct + l15) * MS + 16 * rt + 4 * lg);
            tstore_g(item, rt, ct, mm64(r0, RBUF(13), rt, RBUF(11), ct, lane), lane);
            f32x4 pp = mm64(z, RBUF(13), rt, RBUF(5), ct, lane);
            const float gm = GAM[16 * ct + l15];
#pragma unroll
            for (int r = 0; r < 4; ++r) pp[r] = gm * (pp[r] + ((16 * rt + 4 * lg + r) == (16 * ct + l15) ? 1.f : 0.f));
            *(GAS v2u*)(item + 8192 + (((ct * 2 + (rt >> 1)) * 64 + lane) * 8 + 4 * (rt & 1))) = pack4(pp);
            f32x4 y0 = mm64(z, RBUF(0), rt, RBUF(11), ct, lane); y0 = mm64(y0, RBUF(7), rt, RBUF(12), ct, lane);
            tstore_g(item + 4096, rt, ct, y0, lane);
            f32x4 q = mm64(z, RBUF(5), rt, RBUF(0), ct, lane); q = mm64(q, RBUF(6), rt, RBUF(7), ct, lane);
            const f32x4 g4 = *(const LAS f32x4*)(GAM + 16 * rt + 4 * lg);
            q = q * g4;
            *(GAS v2u*)(item + 12288 + (((ct * 4 + rt) * 64 + lane) * 4)) = pack4(q); }
    }
    LDS_BARRIER();
    R1_STAMP(6);
    }
    }
#ifdef PROBE_R1
    if (tid == 0 && bid == PROBE_BLOCK) { const LAS unsigned long long* t_ = (const LAS unsigned long long*)(lds + LDSCTL_OFF + 640); unsigned long long* g_ = (unsigned long long*)((unsigned*)(A->ws + WS_CTL) + 32768) + 48;
        for (int k = 0; k < 7; ++k) g_[k] = t_[1 + k]; }
#endif
#undef R1_PREFETCH
}

constexpr int R2_NS = 8, R2_STB = 16384;
static_assert(R2_NS * R2_STB <= RING_BYTES, "scan ring");
__device__ __forceinline__ void rwkv_state_scan(ArgP A, int b, int h, LAS unsigned char* lds, int wave, int lane) {
    const int l15 = lane & 15, lg = lane >> 4, dw = wave & 3;
    unsigned char* item0 = (unsigned char*)(A->ws + WS_RWI) + ((size_t)((b * 8 + h) * 64)) * 32768;
#define R2_DMA(nn) do { const unsigned char* g_ = item0 + (size_t)(nn) * 32768 + 16384 + dw * 4096 + lane * 16; LAS unsigned char* s_ = lds + ((nn) & (R2_NS - 1)) * R2_STB + dw * 4096; \
        _Pragma("unroll") for (int p = 0; p < 4; ++p) __builtin_amdgcn_global_load_lds((const unsigned*)(g_ + p * 1024), (LAS unsigned*)(s_ + p * 1024), 16, 0, 0); } while (0)
    if (wave >= 4) {
#pragma unroll
        for (int n = 0; n < R2_NS - 1; ++n) R2_DMA(n); }
    f32x4 S[4]; float zz_ = 0.f; asm volatile("" : "+v"(zz_));
#pragma unroll
    for (int t = 0; t < 4; ++t) S[t] = (f32x4){zz_, zz_, zz_, zz_};
#pragma unroll 1
    for (int n = 0; n < 64; ++n) {
        if (wave >= 4) { if (n <= 64 - (R2_NS - 1)) asm volatile("s_waitcnt vmcnt(24)" ::: "memory"); else asm volatile("s_waitcnt vmcnt(0)" ::: "memory"); }
        __builtin_amdgcn_s_barrier();
#ifdef PROBE_R2HALF
        if (n == PROBE_R2HALF && b == 0 && h == 0 && wave == 0 && lane == 0) { unsigned long long* t_ = (unsigned long long*)((unsigned*)(A->ws + WS_CTL) + 32768) + 41; if (*t_ == 0ull) *t_ = __builtin_amdgcn_s_memrealtime(); }
#endif
        if (wave >= 4) { if (n + R2_NS - 1 < 64) R2_DMA(n + R2_NS - 1); }
        else {
            const LAS unsigned char* st = lds + (n & (R2_NS - 1)) * R2_STB;
            v4u pf[8]; v2u qv[4];
#pragma unroll
            for (int f = 0; f < 8; ++f) pf[f] = *(const LAS v4u*)(st + (f * 64 + lane) * 16);
#pragma unroll
            for (int t = 0; t < 4; ++t) qv[t] = *(const LAS v2u*)(st + 8192 + ((dw * 4 + t) * 64 + lane) * 8);
            unsigned pk[4][2];
#pragma unroll
            for (int t = 0; t < 4; ++t) { pk[t][0] = cvtpk(S[t][0], S[t][1]); pk[t][1] = cvtpk(S[t][2], S[t][3]); }
            bf16* SN = (bf16*)(item0 + (size_t)n * 32768 + 24576);
#pragma unroll
            for (int t = 0; t < 4; ++t) *(GAS v2u*)(SN + (((dw * 2 + (t >> 1)) * 64 + (2 * (t & 1) + (lg >> 1)) * 16 + l15) * 8 + 4 * (lg & 1))) = (v2u){pk[t][0], pk[t][1]};
            const bf16x8_t b0 = __builtin_bit_cast(bf16x8_t, (v4u){pk[0][0], pk[0][1], pk[1][0], pk[1][1]}), b1 = __builtin_bit_cast(bf16x8_t, (v4u){pk[2][0], pk[2][1], pk[3][0], pk[3][1]});
#pragma unroll
            for (int t = 0; t < 4; ++t) { f32x4 acc = (f32x4){bflo(qv[t].x), bfhi(qv[t].x), bflo(qv[t].y), bfhi(qv[t].y)};
                acc = mfma16(__builtin_bit_cast(bf16x8_t, pf[2 * t]), b0, acc); acc = mfma16(__builtin_bit_cast(bf16x8_t, pf[2 * t + 1]), b1, acc); S[t] = acc; }
        }
    }
#undef R2_DMA
}

#ifdef PROBE_R3
#define R3_STAMP(k) do { asm volatile("" ::: "memory"); if (wave == 0 && lane == 0 && bid == PROBE_BLOCK) { LAS unsigned long long* t_ = (LAS unsigned long long*)(lds + LDSCTL_OFF + 640); const unsigned long long now_ = __builtin_amdgcn_s_memrealtime(); t_[1 + (k)] += now_ - t_[0]; t_[0] = now_; } asm volatile("" ::: "memory"); } while (0)
#else
#define R3_STAMP(k) do { } while (0)
#endif
__device__ __forceinline__ void rwkv_out_phase(ArgP A, int L, LAS unsigned char* lds, int bid, int G, int wave, int lane) {
    const int i = L >> 1, l15 = lane & 15, lg = lane >> 4, h = wave;
    const bf16* P = (const bf16*)(A->ws + WS_P); bf16* XNb = (bf16*)(A->ws + WS_XN); const float* BON = (const float*)(A->ws + WS_BON);
    v4u g2f[5][4]; LAS float* prm = (LAS float*)lds + wave * 192;
    { const bf16* G2T = (const bf16*)(A->ws + WS_G2T) + (size_t)(64 * h + l15) * 192 + 8 * lg;
#pragma unroll
      for (int q = 0; q < 5; ++q)
#pragma unroll
          for (int it = 0; it < 4; ++it) g2f[q][it] = *(const GAS v4u*)(G2T + (size_t)(16 * it) * 192 + 32 * q);
      const float* lnw = A->in[20] + i * 512 + 64 * h; const float* lnb = A->in[21] + i * 512 + 64 * h; const float* mu = A->in[7] + (size_t)i * 1536 + 1024 + 64 * h;
      prm[lane] = lnw[lane]; prm[64 + lane] = lnb[lane]; prm[128 + lane] = mu[lane]; }
#ifdef PROBE_R3
    if (wave == 0 && lane == 0 && bid == PROBE_BLOCK) ((LAS unsigned long long*)(lds + LDSCTL_OFF + 640))[0] = __builtin_amdgcn_s_memrealtime();
#endif
#pragma unroll 1
    for (int task = bid; task < BATCH * 64; task += G) {
    const int b = task >> 6, n = task & 63;
    const bf16* item = (const bf16*)(A->ws + WS_RWI) + ((size_t)((b * 8 + h) * 64 + n)) * 16384;
    const bf16* RH = item; const bf16* Y0 = item + 4096; const bf16* ST = item + 12288;
    v4u stf[8];
#pragma unroll
    for (int f = 0; f < 8; ++f) stf[f] = *(const GAS v4u*)(ST + (f * 64 + lane) * 8);
#pragma unroll 1
    for (int ct = 0; ct < 4; ++ct) {
    R3_STAMP(0);
    asm volatile("; MARK_R3_CT");
    const size_t row = (size_t)b * T + 64 * n + 16 * ct + l15; const int tseq = 64 * n + 16 * ct + l15;
    const bf16x8_t rf0 = *(const GAS bf16x8_t*)(RH + (16 * ct + l15) * 64 + 8 * lg), rf1 = *(const GAS bf16x8_t*)(RH + (16 * ct + l15) * 64 + 32 + 8 * lg);
    const bf16* prow = P + row * NIN_E; v4u gx[5], gy[5];
#pragma unroll
    for (int q = 0; q < 5; ++q) { gx[q] = *(const GAS v4u*)(prow + PC_G1A + 32 * q + 8 * lg); gy[q] = tseq > 0 ? *(const GAS v4u*)(prow - NIN_E + PC_G1B + 32 * q + 8 * lg) : (v4u){0u, 0u, 0u, 0u}; }
    const bf16* pr = prow + PC_V + 64 * h; v2u pvr[4], pvq[4];
#pragma unroll
    for (int it = 0; it < 4; ++it) { const int i0 = 16 * it + 4 * lg; pvr[it] = *(const GAS v2u*)(pr + i0); pvq[it] = tseq > 0 ? *(const GAS v2u*)(pr - NIN_E + i0) : (v2u){0u, 0u}; }
    const float bon = BON[row * 8 + h];
    R3_STAMP(1);
#ifdef PROBE_R3
    asm volatile("s_waitcnt vmcnt(0)" ::: "memory");
#endif
    R3_STAMP(2);
    int po_ = 4 * lg; asm volatile("" : "+v"(po_));
    f32x4 acc[4]; float s1 = 0.f;
#pragma unroll
    for (int it = 0; it < 4; ++it) {
        f32x4 a = ld4bf_g(Y0 + (16 * ct + l15) * 64 + 16 * it + 4 * lg);
        a = mfma16(__builtin_bit_cast(bf16x8_t, stf[it * 2 + 0]), rf0, a);
        a = mfma16(__builtin_bit_cast(bf16x8_t, stf[it * 2 + 1]), rf1, a);
        acc[it] = a; s1 += (a[0] + a[1]) + (a[2] + a[3]);
    }
    s1 += __shfl_xor(s1, 16); s1 += __shfl_xor(s1, 32);
    const float mean = s1 * (1.f / 64.f); float s2 = 0.f;
#pragma unroll
    for (int it = 0; it < 4; ++it) { acc[it] = acc[it] - mean; s2 += (acc[it][0] * acc[it][0] + acc[it][1] * acc[it][1]) + (acc[it][2] * acc[it][2] + acc[it][3] * acc[it][3]); }
    s2 += __shfl_xor(s2, 16); s2 += __shfl_xor(s2, 32);
    const float rs = frsq(s2 * (1.f / 64.f) + 64e-5f);
    f32x4 gq[4] = {(f32x4){0.f, 0.f, 0.f, 0.f}, (f32x4){0.f, 0.f, 0.f, 0.f}, (f32x4){0.f, 0.f, 0.f, 0.f}, (f32x4){0.f, 0.f, 0.f, 0.f}};
#pragma unroll
    for (int q = 0; q < 5; ++q) { float x[8], y[8], v[8]; unpack8(gx[q], x); unpack8(gy[q], y);
#pragma unroll
        for (int e = 0; e < 8; ++e) v[e] = sigmoid_f(x[e] + y[e]);
        const bf16x8_t fg = pack8(v);
#pragma unroll
        for (int it = 0; it < 4; ++it) gq[it] = mfma16(__builtin_bit_cast(bf16x8_t, g2f[q][it]), fg, gq[it]); }
    R3_STAMP(3);
#pragma unroll
    for (int it = 0; it < 4; ++it) { const int i0 = 16 * it + 4 * lg;
        const f32x4 pv = (f32x4){bflo(pvr[it].x), bfhi(pvr[it].x), bflo(pvr[it].y), bfhi(pvr[it].y)}, pvp = (f32x4){bflo(pvq[it].x), bfhi(pvq[it].x), bflo(pvq[it].y), bfhi(pvq[it].y)};
        const f32x4 w4 = *(const LAS f32x4*)(prm + 16 * it + po_), b4 = *(const LAS f32x4*)(prm + 64 + 16 * it + po_), m4 = *(const LAS f32x4*)(prm + 128 + 16 * it + po_);
        const f32x4 v4 = pv + (pvp - pv) * m4;
        const f32x4 o = ((acc[it] * rs) * w4 + b4 + v4 * bon) * gq[it];
        *(GAS v2u*)(XNb + row * D + 64 * h + i0) = pack4(o); }
    asm volatile("; MARK_R3_END");
    }
    }
#ifdef PROBE_R3
    if (wave == 0 && lane == 0 && bid == PROBE_BLOCK) { const LAS unsigned long long* t_ = (const LAS unsigned long long*)(lds + LDSCTL_OFF + 640); unsigned long long* g_ = (unsigned long long*)((unsigned*)(A->ws + WS_CTL) + 32768) + 48;
        for (int k = 0; k < 4; ++k) g_[k] = t_[1 + k]; }
#endif
}
constexpr size_t WS_GKV = 464 * MiB;
constexpr size_t WS_GDEC = 29 * MiB + 512 * 1024;
constexpr int GL_LA = 0, GL_KR = 16384, GL_VT = GL_KR + MB, GL_TOT = GL_VT + 2 * MB, GL1_END = GL_TOT + 2048;
static_assert(GL1_END <= RING_BYTES, "GLA LDS map");

template <int NCT> __device__ __forceinline__ void gla_lora_tiles(ArgP A, size_t rowb, int h4, int rt, int ct0, LAS float* LAs, int lane) {
    const int l15 = lane & 15, lg = lane >> 4;
    const bf16* P = (const bf16*)(A->ws + WS_P); const bf16* WA2T = (const bf16*)(A->ws + WS_WA2T);
    v4u av = (v4u){0u, 0u, 0u, 0u};
    if (lg < 2) av = *(const GAS v4u*)(P + (rowb + 16 * rt + l15) * NIN_E + PC_WA1 + 8 * lg);
    const bf16x8_t af = __builtin_bit_cast(bf16x8_t, av);
#pragma unroll
    for (int c = 0; c < NCT; ++c) { const int ct = ct0 + c;
        const f32x4 x = mfma16(af, *(const GAS bf16x8_t*)(WA2T + (size_t)(64 * h4 + 16 * ct + l15) * 32 + 8 * lg), (f32x4){0.f, 0.f, 0.f, 0.f});
#pragma unroll
        for (int r = 0; r < 4; ++r) LAs[(16 * rt + 4 * lg + r) * 64 + 16 * ct + l15] = x[r]; }
}

__device__ __forceinline__ void gla_kv_item(ArgP A, int L, int b, int n, int h4, LAS unsigned char* lds, int tid) {
    const int lane = tid & 63, wave = __builtin_amdgcn_readfirstlane(tid >> 6), i = L >> 1, l15 = lane & 15, lg = lane >> 4;
    const bf16* P = (const bf16*)(A->ws + WS_P);
    const size_t rowb = (size_t)b * T + 64 * n; const int itemi = (b * 64 + n) * 4 + h4;
    LAS float* LAs = (LAS float*)(lds + GL_LA); LAS bf16* KrT = (LAS bf16*)(lds + GL_KR); LAS bf16* VTm = (LAS bf16*)(lds + GL_VT); LAS float* TOT = (LAS float*)(lds + GL_TOT);
    gla_lora_tiles<2>(A, rowb, h4, wave >> 1, 2 * (wave & 1), LAs, lane);
    __syncthreads();
    {
        const int c = 64 * h4 + lane, tt0 = 8 * wave; const float bac = A->in[24][i * 256 + c];
        float lc[8], kx[8], qx[8], v0[8], v1[8]; float run = 0.f;
#pragma unroll
        for (int u = 0; u < 8; ++u) { const bf16* pr = P + (rowb + tt0 + u) * NIN_E; const float x = bac + LAs[(tt0 + u) * 64 + lane];
            run += -softplus_f(-x) * (1.0f / 16.0f); lc[u] = run; kx[u] = bf2f(pr[PC_GK + c]); qx[u] = bf2f(pr[PC_GQ + c]); v0[u] = bf2f(pr[PC_GV + 128 * h4 + lane]); v1[u] = bf2f(pr[PC_GV + 128 * h4 + 64 + lane]); }
        TOT[wave * 64 + lane] = run;
        __syncthreads();
        float off = 0.f, tot = 0.f;
#pragma unroll
        for (int w2 = 0; w2 < 8; ++w2) { const float tv = TOT[w2 * 64 + lane]; tot += tv; if (w2 < wave) off += tv; }
        if (wave == 0) ((float*)(A->ws + WS_GDEC))[itemi * 64 + lane] = fexp(tot);
        { bf16* Pw = (bf16*)(A->ws + WS_P); const float etot = fexp(tot);
#pragma unroll
          for (int u = 0; u < 8; ++u) { const float cum = off + lc[u], e1 = fexp(cum), kt = kx[u] * frcp(e1); bf16* pw = Pw + (rowb + tt0 + u) * NIN_E;
              pw[PC_GQ + c] = (bf16)f2bf(qx[u] * 0.125f * e1); pw[PC_GK + c] = (bf16)f2bf(kt); kx[u] = kt * etot; } }
        *(LAS bf16x8_t*)(KrT + lane * MS + tt0) = pack8(kx); *(LAS bf16x8_t*)(VTm + lane * MS + tt0) = pack8(v0); *(LAS bf16x8_t*)(VTm + (64 + lane) * MS + tt0) = pack8(v1);
    }
    __syncthreads();
    {
        bf16* KVg = (bf16*)(A->ws + WS_GKV) + (size_t)itemi * 8192; const int rt = wave >> 1;
#pragma unroll
        for (int c = 0; c < 4; ++c) { const int et = 4 * (wave & 1) + c;
            const f32x4 acc = mm64((f32x4){0.f, 0.f, 0.f, 0.f}, KrT, rt, VTm, et, lane);
            *(GAS v2u*)(KVg + (16 * et + l15) * 64 + 16 * rt + 4 * lg) = pack4(acc); }
    }
    __syncthreads();
}

__device__ __forceinline__ void gla_state_scan(ArgP A, int gt, bool do_store = true) {
    const int bh = gt >> 11, grp = gt & 2047;
    const int b = bh >> 2, h4 = bh & 3;
    bf16* base = (bf16*)(A->ws + WS_GKV) + (size_t)((b * 64) * 4 + h4) * 8192 + (size_t)grp * 4;
    const float* dec = (const float*)(A->ws + WS_GDEC) + (size_t)((b * 64) * 4 + h4) * 64 + (grp & 15) * 4;
    f32x4 S = (f32x4){0.f, 0.f, 0.f, 0.f};
#pragma unroll 1
    for (int n0 = 0; n0 < 64; n0 += 8) {
        v2u kv[8]; f32x4 dc[8];
#pragma unroll
        for (int u = 0; u < 8; ++u) { kv[u] = *(const GAS v2u*)(base + (size_t)(n0 + u) * 4 * 8192); dc[u] = *(const GAS f32x4*)(dec + (size_t)(n0 + u) * 4 * 64); }
#pragma unroll
        for (int u = 0; u < 8; ++u) { if (do_store) *(GAS v2u*)(base + (size_t)(n0 + u) * 4 * 8192) = pack4(S);
            S = S * dc[u] + (f32x4){bflo(kv[u].x), bfhi(kv[u].x), bflo(kv[u].y), bfhi(kv[u].y)}; }
    }
}

constexpr int G3B_SV = 272, G3B_VT = 0, G3B_SC = 64 * G3B_SV, G3B_GRP = G3B_SC + MB;
static_assert(2 * G3B_GRP <= RING_BYTES, "GLA phase-3 LDS map");
__device__ __forceinline__ void gla_out_phase(ArgP A, int L, LAS unsigned char* lds, int tid, int G, int bid) {
    const int lane = tid & 63, wave = __builtin_amdgcn_readfirstlane(tid >> 6), i = L >> 1, l15 = lane & 15, lg = lane >> 4;
    const int gi = wave >> 2, wq = wave & 3;
    const bf16* P = (const bf16*)(A->ws + WS_P); bf16* XNb = (bf16*)(A->ws + WS_XN);
    LAS unsigned char* gb = lds + gi * G3B_GRP; LAS bf16* SC = (LAS bf16*)(gb + G3B_SC);
    const int ct = wq; const int col = 16 * ct + l15;
    int hcur = -1; f32x4 gn4[8];
#pragma unroll 1
    for (int item2 = bid; item2 < BATCH * 64 * 4 / 2; item2 += G) {
    const int itemi = 2 * item2 + gi, h4 = itemi & 3, n = (itemi >> 2) & 63, b = itemi >> 8;
    const size_t rowb = (size_t)b * T + 64 * n;
    if (h4 != hcur) { hcur = h4; const float* gn = A->in[25] + i * 512 + 128 * h4;
#pragma unroll
        for (int et = 0; et < 8; ++et) gn4[et] = *(const GAS f32x4*)(gn + 16 * et + 4 * lg); }
    v4u vreg[4];
    { const int t4 = tid & 255;
#pragma unroll
      for (int q = 0; q < 4; ++q) { const int id = t4 + 256 * q, row = id >> 4, ch = id & 15; vreg[q] = *(const GAS v4u*)(P + (rowb + row) * NIN_E + PC_GV + 128 * h4 + 8 * ch); } }
    const bf16* qrow = P + (rowb + col) * NIN_E + PC_GQ + 64 * h4 + 8 * lg;
    const bf16x8_t qf0 = *(const GAS bf16x8_t*)qrow, qf1 = *(const GAS bf16x8_t*)(qrow + 32);
    v4u kf[4][2];
#pragma unroll
    for (int rt = 0; rt < 4; ++rt) { const bf16* krow = P + (rowb + 16 * rt + l15) * NIN_E + PC_GK + 64 * h4 + 8 * lg;
        if (rt <= ct) { kf[rt][0] = *(const GAS v4u*)krow; kf[rt][1] = *(const GAS v4u*)(krow + 32); } else { kf[rt][0] = (v4u){0u, 0u, 0u, 0u}; kf[rt][1] = (v4u){0u, 0u, 0u, 0u}; } }
    const bf16* Sg = (const bf16*)(A->ws + WS_GKV) + (size_t)itemi * 8192;
    v4u sgf[8][2];
#pragma unroll
    for (int et = 0; et < 8; ++et) { sgf[et][0] = *(const GAS v4u*)(Sg + (16 * et + l15) * 64 + 8 * lg); sgf[et][1] = *(const GAS v4u*)(Sg + (16 * et + l15) * 64 + 32 + 8 * lg); }
    const size_t row = rowb + col; v2u ggr[8];
#pragma unroll
    for (int et = 0; et < 8; ++et) ggr[et] = *(const GAS v2u*)(P + row * NIN_E + PC_GG + 128 * h4 + 16 * et + 4 * lg);
    { const int t4 = tid & 255;
#pragma unroll
      for (int q = 0; q < 4; ++q) { const int id = t4 + 256 * q, vrow = id >> 4, ch = id & 15; *(LAS v4u*)(gb + G3B_VT + vrow * G3B_SV + ch * 16) = vreg[q]; } }
#pragma unroll
    for (int rt = 0; rt < 4; ++rt) { f32x4 acc = (f32x4){0.f, 0.f, 0.f, 0.f};
        if (rt <= ct) {
            acc = mfma16(__builtin_bit_cast(bf16x8_t, kf[rt][0]), qf0, acc); acc = mfma16(__builtin_bit_cast(bf16x8_t, kf[rt][1]), qf1, acc);
#pragma unroll
            for (int r = 0; r < 4; ++r) if (!((16 * rt + 4 * lg + r) <= col)) acc[r] = 0.f; }
        tstore(SC, rt, ct, acc, lane); }
    __syncthreads();
    const int vto = G3B_VT + (8 * lg + (l15 >> 2)) * G3B_SV + 4 * (lane & 3) * 2;
    f32x4 o[8]; float ss = 0.f;
#pragma unroll
    for (int et = 0; et < 8; ++et) { f32x4 acc = (f32x4){0.f, 0.f, 0.f, 0.f};
#pragma unroll
        for (int ks = 0; ks < 2; ++ks) { const LAS unsigned char* vp = gb + vto + ks * 32 * G3B_SV + et * 32;
            const a_s16x4 lo4 = __builtin_bit_cast(a_s16x4, __builtin_amdgcn_ds_read_tr16_b64_v4i16((LAS a_s16x4*)vp));
            const a_s16x4 hi4 = __builtin_bit_cast(a_s16x4, __builtin_amdgcn_ds_read_tr16_b64_v4i16((LAS a_s16x4*)(vp + 4 * G3B_SV)));
            const bf16x8_t vf = (bf16x8_t){lo4[0], lo4[1], lo4[2], lo4[3], hi4[0], hi4[1], hi4[2], hi4[3]};
            acc = mfma16(vf, ldfrag(SC, 16 * ct, 32 * ks, lane), acc); }
        acc = mfma16(__builtin_bit_cast(bf16x8_t, sgf[et][0]), qf0, acc);
        acc = mfma16(__builtin_bit_cast(bf16x8_t, sgf[et][1]), qf1, acc);
        o[et] = acc; ss += (acc[0] * acc[0] + acc[1] * acc[1]) + (acc[2] * acc[2] + acc[3] * acc[3]); }
    ss += __shfl_xor(ss, 16); ss += __shfl_xor(ss, 32);
    const float rs = frsq(ss * (1.f / 128.f) + 1e-5f);
#pragma unroll
    for (int et = 0; et < 8; ++et) { const int e0 = 16 * et + 4 * lg; const f32x4 gg = (f32x4){bflo(ggr[et].x), bfhi(ggr[et].x), bflo(ggr[et].y), bfhi(ggr[et].y)};
        f32x4 v = o[et] * rs * gn4[et]; v[0] *= silu_f(gg[0]); v[1] *= silu_f(gg[1]); v[2] *= silu_f(gg[2]); v[3] *= silu_f(gg[3]);
        *(GAS v2u*)(XNb + row * D + 512 + 128 * h4 + e0) = pack4(v); }
    __syncthreads();
    }
}
constexpr int N_STEPS = 37;
#ifndef MK_ONE_LAUNCH
#define MK_ONE_LAUNCH 1
#endif
__global__ void __launch_bounds__(NTHREADS, 2) hybrid_fwd(Args args) {
    extern __shared__ __attribute__((aligned(16))) unsigned char lds_raw[];
    LAS unsigned char* lds = (LAS unsigned char*)lds_raw;
    ArgP A0 = (ArgP)__builtin_amdgcn_kernarg_segment_ptr();
    { const int tid = threadIdx.x; for (int u = tid; u < (LDS_BYTES - LDSCTL_OFF) / 4; u += NTHREADS) ((LAS unsigned*)(lds + LDSCTL_OFF))[u] = 0u; }
    __syncthreads();
    const int lo = A0->lo, hi = A0->hi;
    if (hi - lo > 1) (void)xcd_barrier_post((unsigned*)(A0->ws + WS_CTL) + CW_BAR, (volatile LAS unsigned*)(lds + MISC_OFF) + 8);
#ifndef PHM
#define PHM 0xff
#endif
#define RUN(s) (lo <= (s) && (s) < hi)
#define EN(b) ((PHM >> (b)) & 1)
#ifndef PROBE_REP
#define PROBE_REP 0
#endif
#define REP(b) _Pragma("unroll 1") for (int rep_ = 0; rep_ < (((PROBE_REP >> (b)) & 1) ? 2 : 1); ++rep_)
#ifndef PROBE_TMASK
#define PROBE_TMASK 0u
#endif
#ifndef PROBE_TAMP
#define PROBE_TAMP 4
#endif
#ifndef PROBE_TCLK
#define PROBE_TCLK 0
#endif
#ifndef PROBE_BLOCK
#define PROBE_BLOCK 0
#endif
#ifndef PROBE_SUBA
#define PROBE_SUBA 0
#define PROBE_SUBB 0
#endif
#define PROBE_STAMP(i) do { if (PROBE_TMASK && ((i) == PROBE_SUBA || (i) == PROBE_SUBB) && L == 0 && bid == PROBE_BLOCK && tid == 0) { ArgP As_ = A; ((unsigned long long*)((unsigned*)(As_->ws + WS_CTL) + 32768))[i] = __builtin_amdgcn_s_memrealtime(); } } while (0)
    int nbar_ = 0;
    if (PROBE_TMASK) { if (blockIdx.x == PROBE_BLOCK && threadIdx.x == 0) { ((unsigned long long*)((unsigned*)(A0->ws + WS_CTL) + 32768))[0] = __builtin_amdgcn_s_memrealtime(); ((unsigned long long*)((unsigned*)(A0->ws + WS_CTL) + 32768))[64] = __builtin_amdgcn_s_memtime(); } }
#define GRID_BARRIER() do { ArgP Ab_ = FRESH_ARGS(); XcdBarrier b_; b_.bar = (unsigned*)(Ab_->ws + WS_CTL) + CW_BAR; b_.x = xb_xcc_id(); b_.st = (volatile LAS unsigned*)(lds + MISC_OFF) + 8; xcd_barrier(b_); if (PROBE_TMASK) { ++nbar_; if (blockIdx.x == PROBE_BLOCK && threadIdx.x == 0) { ((unsigned long long*)((unsigned*)(Ab_->ws + WS_CTL) + 32768))[nbar_] = __builtin_amdgcn_s_memrealtime(); ((unsigned long long*)((unsigned*)(Ab_->ws + WS_CTL) + 32768))[64 + nbar_] = __builtin_amdgcn_s_memtime(); } } } while (0)
#define SEAM(s) do { if (RUN(s) && RUN((s) + 1)) GRID_BARRIER(); } while (0)
#define PHASE_VARS() ArgP A = FRESH_ARGS(); int L = Lq; FRESH_S(L); int tid = threadIdx.x; FRESH_V(tid); const int lane = tid & 63, wave = __builtin_amdgcn_readfirstlane(tid >> 6); int G = gridDim.x, bid = blockIdx.x; FRESH_S(G); FRESH_S(bid); (void)lane; (void)wave; (void)G; (void)A; (void)bid; \
    bf16* XN = (bf16*)(A->ws + WS_XN); bf16* PB = (bf16*)(A->ws + WS_P); (void)XN; (void)PB

#define BAR2(a, b) do { if (RUN(a) && RUN(b)) GRID_BARRIER(); } while (0)
    if (EN(0) && RUN(0)) REP(0) { int Lq = 0; PHASE_VARS(); const int gw = bid * NWAVES + wave, NGW = G * NWAVES;
        convert_mixer_weights(A, 0, lds, wave, lane, gw, NGW); PROBE_STAMP(45);
        float* ssq0 = (float*)(A->ws + WS_SSQ);
        for (int m = gw; m < M; m += 4 * NGW) x_to_bf16_ssq4(A->in[0], (bf16*)A->out, ssq0, m, NGW, lane); }
    BAR2(0, 1);
    for (int Lq = 0; Lq < 4; ++Lq) {
        const int s0 = 9 * Lq; const bool even = !(Lq & 1);
        if (EN(1) && RUN(s0 + 1)) REP(1) {
            PHASE_VARS(); bf16* Win = (bf16*)(A->ws + WS_WIN); const float* ssq = (const float*)(A->ws + WS_SSQ);
            if (even) {
                pg8::Gemm g{(bf16*)A->out, Win, M, NIN_E, D}; pg8::StaticOrderC<M, NIN_E> S; S.init(G, bid);
                pg8::fill_row_scales(S, ssq, (LAS float*)(lds + RSTAB_OFF), tid);
                pg8::EpiStoreBf16 E{PB, NIN_E, 0, 1.0f, (const LAS float*)(lds + RSTAB_OFF)};
                pg8::gemm_phase<pg8::EpiStoreBf16, pg8::StaticOrderC<M, NIN_E>, PG8_ALIGN, PG8_SP2>(lds, g, S, E);
            } else {
                pg8::Gemm g{(bf16*)A->out, Win, M, NIN_O, D}; pg8::StaticOrderC<M, NIN_O> S; S.init(G, bid);
                pg8::fill_row_scales(S, ssq, (LAS float*)(lds + RSTAB_OFF), tid);
                pg8::EpiStoreBf16 E{PB, NIN_O, 4, 0.125f * 1.4426950408889634f, (const LAS float*)(lds + RSTAB_OFF)};
                pg8::gemm_phase<pg8::EpiStoreBf16, pg8::StaticOrderC<M, NIN_O>, PG8_ALIGN, PG8_SP2>(lds, g, S, E);
            }
        }
        if (even) {
            BAR2(s0 + 1, s0 + 2);
            if (EN(2) && RUN(s0 + 2)) REP(2) { PHASE_VARS();
                rwkv_chunk_phase(A, L, lds, tid, G, bid); PROBE_STAMP(44);
                REP(8) {
#pragma unroll 1
                for (int it = bid; it < BATCH * 64 * 4; it += G) gla_kv_item(A, L, it >> 8, (it >> 2) & 63, it & 3, lds, tid); } }
            BAR2(s0 + 2, s0 + 3);
            if (EN(3) && RUN(s0 + 3)) {
                PHASE_VARS();
                if (bid < 64) { rwkv_state_scan(A, bid >> 3, bid & 7, lds, wave, lane); PROBE_STAMP(40); }
                else { for (int gt = (bid - 64) * NTHREADS + tid; gt < 32 * 2048; gt += (G - 64) * NTHREADS) gla_state_scan(A, gt);
                       PROBE_STAMP(41);
                       convert_ffn_weights(A, L, lds, wave, lane, (bid - 64) * NWAVES + wave, (G - 64) * NWAVES); PROBE_STAMP(42); }
            }
            BAR2(s0 + 3, s0 + 4);
            if (EN(3) && RUN(s0 + 4)) {
                PHASE_VARS();
                REP(9) {
                gla_out_phase(A, L, lds, tid, G, bid); }
                PROBE_STAMP(43);
                rwkv_out_phase(A, L, lds, bid, G, wave, lane);
            }
            BAR2(s0 + 4, s0 + 5);
        } else {
            BAR2(s0 + 1, s0 + 3);
            #ifdef PROBE_AVAR
            if (EN(4) && RUN(s0 + 3)) { PHASE_VARS(); attn_phase_mfma<PROBE_AVAR>(A, L, lds, tid, G, bid); }
#endif
            if (EN(4) && RUN(s0 + 3)) REP(4) { PHASE_VARS(); attn_phase_mfma(A, L, lds, tid, G, bid); convert_ffn_weights(A, L, lds, wave, lane, bid * NWAVES + wave, G * NWAVES); }
            BAR2(s0 + 3, s0 + 5);
        }
        if (EN(5) && RUN(s0 + 5)) {
            PHASE_VARS(); bf16* Wout = (bf16*)(A->ws + WS_WOUT);
            pg8::Gemm g{XN, Wout, M, D, D}; pg8::StaticOrderC<M, D> S; S.init(G, bid);
            if ((PROBE_REP >> 5) & 1) { pg8::EpiResBf16<false, true> E0{(bf16*)A->out, D, (float*)(A->ws + WS_SSQ) + (size_t)M * 16, nullptr};
                pg8::gemm_phase<pg8::EpiResBf16<false, true>, pg8::StaticOrderC<M, D>, PG8_ALIGN, PG8_SP2>(lds, g, S, E0); }
            pg8::EpiResBf16<false> E{(bf16*)A->out, D, (float*)(A->ws + WS_SSQ) + (size_t)M * 16, nullptr};
            pg8::gemm_phase<pg8::EpiResBf16<false>, pg8::StaticOrderC<M, D>, PG8_ALIGN, PG8_SP2>(lds, g, S, E);
        }
        BAR2(s0 + 5, s0 + 7);
        if (EN(6) && RUN(s0 + 7)) REP(6) {
            PHASE_VARS(); bf16* Wgu = (bf16*)(A->ws + WS_WGU);
            pg8::Gemm g{(bf16*)A->out, Wgu, M, NGU, D}; pg8::StaticOrderC<M, NGU> S; S.init(G, bid);
            pg8::fill_row_scales(S, (const float*)(A->ws + WS_SSQ) + (size_t)M * 16, (LAS float*)(lds + RSTAB_OFF), tid);
            if ((PROBE_REP >> 18) & 1) { pg8::EpiNull En; pg8::gemm_phase<pg8::EpiNull, pg8::StaticOrderC<M, NGU>, PG8_ALIGN, PG8_SP2>(lds, g, S, En); }
            if ((PROBE_REP >> 15) & 1) { pg8::EpiSwigluT<true> E0{PB, FF, (const LAS float*)(lds + RSTAB_OFF)};
                pg8::gemm_phase<pg8::EpiSwigluT<true>, pg8::StaticOrderC<M, NGU>, PG8_ALIGN, PG8_SP2>(lds, g, S, E0); }
            pg8::EpiSwiglu E{PB, FF, (const LAS float*)(lds + RSTAB_OFF)};
            pg8::gemm_phase<pg8::EpiSwiglu, pg8::StaticOrderC<M, NGU>, PG8_ALIGN, PG8_SP2>(lds, g, S, E);
        }
        BAR2(s0 + 7, s0 + 8);
        if (EN(7) && RUN(s0 + 8)) {
            PHASE_VARS(); bf16* Wdn = (bf16*)(A->ws + WS_WDN);
            pg8::Gemm g{PB, Wdn, M, D, FF}; pg8::StaticOrderC<M, D> S; S.init(G, bid);
            if ((PROBE_REP >> 7) & 1) { pg8::EpiResBf16<false, true> E0{(bf16*)A->out, D, (float*)(A->ws + WS_SSQ), nullptr};
                pg8::gemm_phase<pg8::EpiResBf16<false, true>, pg8::StaticOrderC<M, D>, PG8_ALIGN, PG8_SP2>(lds, g, S, E0); }
            if (L < 3) { pg8::EpiResBf16<false> E{(bf16*)A->out, D, (float*)(A->ws + WS_SSQ), nullptr};
                pg8::gemm_phase<pg8::EpiResBf16<false>, pg8::StaticOrderC<M, D>, PG8_ALIGN, PG8_SP2>(lds, g, S, E);
                convert_mixer_weights(A, L + 1, lds, wave, lane, bid * NWAVES + wave, G * NWAVES); }
            else { pg8::EpiResBf16<true> E{(bf16*)A->out, D, (float*)(A->ws + WS_SSQ), XN};
                pg8::gemm_phase<pg8::EpiResBf16<true>, pg8::StaticOrderC<M, D>, PG8_ALIGN, PG8_SP2>(lds, g, S, E); }
        }
        BAR2(s0 + 8, Lq < 3 ? s0 + 10 : 36);
    }
    if (RUN(36)) REP(17) {
        int Lq = 0; PHASE_VARS();
        const int gw = bid * NWAVES + wave, NGW = G * NWAVES;
        for (int m = gw; m < M; m += 4 * NGW) rms_rows4_bf16_to_f32(XN, A->in[4], A->out, m, NGW, lane);
        if (PROBE_TMASK) { if (blockIdx.x == PROBE_BLOCK && threadIdx.x == 0) {
            const unsigned long long* ts = (const unsigned long long*)((const unsigned*)(A->ws + WS_CTL) + 32768); unsigned long long acc_ = 0, cyc_ = 0;
            for (int k = 1; k <= 25; ++k) if ((PROBE_TMASK >> k) & 1u) { acc_ += ts[k] - ts[k - 1]; cyc_ += ts[64 + k] - ts[64 + k - 1]; }
            if (PROBE_SUBA == 99) acc_ = __builtin_amdgcn_s_memrealtime() - ts[25]; else if (PROBE_SUBA) acc_ = ts[PROBE_SUBA] - ts[PROBE_SUBB];
            const unsigned long long target_ = PROBE_TCLK ? (cyc_ * 100000ull) / (acc_ + 1ull) : acc_ * (unsigned long long)PROBE_TAMP;
            const unsigned long long t0_ = __builtin_amdgcn_s_memrealtime();
            while (__builtin_amdgcn_s_memrealtime() - t0_ < target_ && __builtin_amdgcn_s_memrealtime() - t0_ < 4000000ull) __builtin_amdgcn_s_sleep(16); } }
    }
#undef RUN
#undef SEAM
}

extern "C" void kernel_launch(void* const* d_in, const int* in_sizes, int n_in, void* d_out, int out_size, void* d_ws, size_t ws_size, hipStream_t stream) {
    static int grid = 0;
    if (grid == 0) {
        if (n_in != 36 || in_sizes[0] != M * D || out_size != M * D || ws_size < WS_END) { fprintf(stderr, "kernel_launch: unexpected shapes (n_in %d, in0 %d, out %d, ws %zu); nothing launched\n", n_in, n_in > 0 ? in_sizes[0] : -1, out_size, ws_size); grid = -1; return; }
        int dev = 0, cus = 0, per_cu = 0;
        if (hipGetDevice(&dev) != hipSuccess || hipDeviceGetAttribute(&cus, hipDeviceAttributeMultiprocessorCount, dev) != hipSuccess) { grid = -1; return; }
        if (hipFuncSetAttribute((const void*)hybrid_fwd, hipFuncAttributeMaxDynamicSharedMemorySize, LDS_BYTES) != hipSuccess) { fprintf(stderr, "kernel_launch: hipFuncSetAttribute failed\n"); grid = -1; return; }
        if (hipOccupancyMaxActiveBlocksPerMultiprocessor(&per_cu, (const void*)hybrid_fwd, NTHREADS, LDS_BYTES) != hipSuccess || per_cu < 1) fprintf(stderr, "kernel_launch: occupancy query reports %d\n", per_cu);
        (void)hipGetLastError();
        if (cus < 128) { fprintf(stderr, "kernel_launch: built for a 256-CU device (phase 3 of the even layers needs more than 64 workgroups); nothing launched\n"); grid = -1; return; }
        grid = cus;
    }
    if (grid < 0) return;
    if (hipMemsetAsync((char*)d_ws + WS_CTL, 0, CTL_ZERO_BYTES, stream) != hipSuccess) return;
    Args a{};
    for (int i = 0; i < 36; ++i) a.in[i] = (const float*)d_in[i];
    a.out = (float*)d_out; a.ws = (unsigned char*)d_ws;
#if MK_ONE_LAUNCH
    a.lo = 0; a.hi = N_STEPS;
    hipLaunchKernelGGL(hybrid_fwd, dim3(grid), dim3(NTHREADS), LDS_BYTES, stream, a);
#else
    for (int s = 0; s < N_STEPS; ++s) {
        if (s < 36 && ((s % 9) == 2 || (s % 9) == 4) && ((s / 9) & 1)) continue;
        a.lo = s; a.hi = s + 1;
        hipLaunchKernelGGL(hybrid_fwd, dim3(grid), dim3(NTHREADS), LDS_BYTES, stream, a);
    }
#endif
}
```

```cpp
#include <hip/hip_runtime.h>
#include <cstdio>
#include <cstdint>
__device__ __forceinline__ float silu_f(float x) { return x * __builtin_amdgcn_rcpf(1.0f + __builtin_amdgcn_exp2f(-1.4426950408889634f * x)); }
__device__ __forceinline__ float xsum16(float x) { unsigned a = __builtin_bit_cast(unsigned, x), b = a; asm volatile("" : "+v"(b));
    const auto s_ = __builtin_amdgcn_permlane16_swap(a, b, false, false); unsigned r0 = s_[0], r1 = s_[1]; asm volatile("" : "+v"(r0), "+v"(r1)); return __builtin_bit_cast(float, r0) + __builtin_bit_cast(float, r1); }
__device__ __forceinline__ float xsum32(float x) { unsigned a = __builtin_bit_cast(unsigned, x), b = a; asm volatile("" : "+v"(b));
    const auto s_ = __builtin_amdgcn_permlane32_swap(a, b, false, false); unsigned r0 = s_[0], r1 = s_[1]; asm volatile("" : "+v"(r0), "+v"(r1)); return __builtin_bit_cast(float, r0) + __builtin_bit_cast(float, r1); }
__device__ __forceinline__ float xmax32(float x) { unsigned a = __builtin_bit_cast(unsigned, x), b = a; asm volatile("" : "+v"(b));
    const auto s_ = __builtin_amdgcn_permlane32_swap(a, b, false, false); unsigned r0 = s_[0], r1 = s_[1]; asm volatile("" : "+v"(r0), "+v"(r1)); return fmaxf(__builtin_bit_cast(float, r0), __builtin_bit_cast(float, r1)); }
namespace pg8 {
#define PG8_LAS __attribute__((address_space(3)))
typedef unsigned short bf16_t;
typedef short bf16x8 __attribute__((ext_vector_type(8)));
typedef float f32x4 __attribute__((ext_vector_type(4)));
typedef unsigned u32x4 __attribute__((ext_vector_type(4)));
constexpr int BM = 256, BK = 64, HALF = 128, HTB = HALF * BK * 2  , STAGE_BYTES = 8 * HTB, NXCD = 8, WGM = 4;

__host__ __device__ __forceinline__ int lds_byte(int r, int c) { const int st = (r >> 4) * 2 + (c >> 5), rr = r & 15, cc = c & 31, ob = rr * 64 + cc * 2; return st * 1024 + (ob ^ (((ob >> 9) & 1) << 5)); }
__host__ __device__ __forceinline__ void stage_rc(int b, int& R, int& C) { const int st = b / 1024, sb = b % 1024, swz = sb ^ (((sb >> 9) & 1) << 5); R = (st >> 1) * 16 + swz / 64; C = (st & 1) * 32 + (swz % 64) / 2; }
__host__ __device__ __forceinline__ int perm32(int rho) { const int n = rho >> 4, i = rho & 15; return 8 * (i >> 2) + 4 * n + (i & 3); }

struct Unit { int pm, pn, idx; };
struct Gemm { const bf16_t* A; const bf16_t* Bt; int M, N, K; };

struct StaticOrder {
    int nM, nN, nwg, G, c;
    __host__ __device__ void init(int M, int N, int G_, int c_) { nM = M / BM; nN = N / BM; nwg = nM * nN; G = G_; c = c_; }
    __host__ __device__ bool next(int i, Unit& u) const {
        const long L = (long)i * G + c; if (L >= nwg) return false;
        int wgid = (int)L; { const int q = nwg / NXCD, r = nwg % NXCD, xcd = wgid % NXCD, off = wgid / NXCD; wgid = (xcd < r ? xcd * (q + 1) : r * (q + 1) + (xcd - r) * q) + off; }
        const int nig = WGM * nN, gid = wgid / nig, fm = gid * WGM, gsz = (nM - fm) < WGM ? (nM - fm) : WGM;
        u.pm = fm + ((wgid % nig) % gsz); u.pn = (wgid % nig) / gsz; return true;
    }
    __device__ __forceinline__ void a_ready(const Unit&) const {}
    __device__ __forceinline__ void done(const Unit&) const {}
};

__device__ __forceinline__ unsigned cvt_pk_bf16(float lo, float hi) { unsigned r; asm volatile("v_cvt_pk_bf16_f32 %0, %1, %2" : "=v"(r) : "v"(lo), "v"(hi)); return r; }
typedef float f32x2 __attribute__((ext_vector_type(2)));
__device__ __forceinline__ float row_ssq(const float* ssq, int row) { const f32x4* p = (const f32x4*)(ssq + (size_t)row * 16); const f32x4 a = p[0], b = p[1], c = p[2], d = p[3];
    return (((a[0] + a[1]) + (a[2] + a[3])) + ((b[0] + b[1]) + (b[2] + b[3]))) + (((c[0] + c[1]) + (c[2] + c[3])) + ((d[0] + d[1]) + (d[2] + d[3]))); }
struct EpiStoreBf16 {
    static constexpr bool PERM = true, AFTER_DRAIN = false;
    bf16_t* O; int ldc; int qtiles; float qscale; const PG8_LAS float* rstab; int ncols;
    __device__ __forceinline__ void operator()(const f32x4 (&acc)[2][2][4][2], const Unit& u, int wr, int wc, int fr, int fq) const {
        const int row0 = u.pm * BM + wr * 64 + fr, col0 = u.pn * BM + wc * 32 + 8 * fq;
        const float sc = u.pn < qtiles ? qscale : 1.0f;
        const bool st0 = col0 < ncols, st1 = col0 + HALF < ncols;
        const PG8_LAS float* rt_ = rstab + u.idx * BM + wr * 64 + fr;
#pragma unroll
        for (int ai = 0; ai < 2; ++ai)
#pragma unroll
            for (int m = 0; m < 4; ++m) { const int row = row0 + ai * HALF + m * 16; bf16_t* rowp = O + (size_t)row * ldc + col0;
                const float rs = sc * rt_[ai * HALF + m * 16];
#pragma unroll
                for (int bj = 0; bj < 2; ++bj) { const f32x4 v0 = acc[ai][bj][m][0] * rs, v1 = acc[ai][bj][m][1] * rs;
                    u32x4 w; w.x = cvt_pk_bf16(v0[0], v0[1]); w.y = cvt_pk_bf16(v0[2], v0[3]); w.z = cvt_pk_bf16(v1[0], v1[1]); w.w = cvt_pk_bf16(v1[2], v1[3]);
                    if (bj ? st1 : st0) *(u32x4*)(rowp + bj * HALF) = w; } }
    }
};
template <bool LAST, bool NOSTORE = false> struct EpiResBf16 {
    static constexpr bool PERM = true, AFTER_DRAIN = false;
    bf16_t* xr; int ldc; float* ssq; bf16_t* xf;
    __device__ __forceinline__ void operator()(const f32x4 (&acc)[2][2][4][2], const Unit& u, int wr, int wc, int fr, int fq) const {
        const int row0 = u.pm * BM + wr * 64 + fr, col0 = u.pn * BM + wc * 32 + 8 * fq;
#pragma unroll
        for (int ai = 0; ai < 2; ++ai)
#pragma unroll
            for (int m = 0; m < 4; ++m) { const int row = row0 + ai * HALF + m * 16; const size_t off = (size_t)row * ldc + col0; float s = 0.f;
#pragma unroll
                for (int bj = 0; bj < 2; ++bj) { const u32x4 bw = *(const u32x4*)(xr + off + bj * HALF);
                    const f32x4 b0 = (f32x4){__builtin_bit_cast(float, bw.x << 16), __builtin_bit_cast(float, bw.x & 0xffff0000u), __builtin_bit_cast(float, bw.y << 16), __builtin_bit_cast(float, bw.y & 0xffff0000u)};
                    const f32x4 b1 = (f32x4){__builtin_bit_cast(float, bw.z << 16), __builtin_bit_cast(float, bw.z & 0xffff0000u), __builtin_bit_cast(float, bw.w << 16), __builtin_bit_cast(float, bw.w & 0xffff0000u)};
                    const f32x4 v0 = b0 + acc[ai][bj][m][0], v1 = b1 + acc[ai][bj][m][1];
                    s += ((v0[0] * v0[0] + v0[1] * v0[1]) + (v0[2] * v0[2] + v0[3] * v0[3])) + ((v1[0] * v1[0] + v1[1] * v1[1]) + (v1[2] * v1[2] + v1[3] * v1[3]));
                    u32x4 w; w.x = cvt_pk_bf16(v0[0], v0[1]); w.y = cvt_pk_bf16(v0[2], v0[3]); w.z = cvt_pk_bf16(v1[0], v1[1]); w.w = cvt_pk_bf16(v1[2], v1[3]);
                    if (!NOSTORE) *(u32x4*)((LAST ? xf : xr) + off + bj * HALF) = w; else asm volatile("" :: "v"(w.x), "v"(w.y), "v"(w.z), "v"(w.w)); }
                s = xsum32(xsum16(s));
                if (fq == 0 && !NOSTORE) ssq[(size_t)row * 16 + u.pn * 4 + wc] = s;
                if (m & 1) asm volatile("" ::: "memory"); }
    }
};
template <bool NOSTORE = false> struct EpiSwigluT {
    static constexpr bool PERM = true, AFTER_DRAIN = false;
    bf16_t* H; int ldc; const PG8_LAS float* rstab;
    __device__ __forceinline__ void operator()(const f32x4 (&acc)[2][2][4][2], const Unit& u, int wr, int wc, int fr, int fq) const {
        const int row0 = u.pm * BM + wr * 64 + fr, colh = u.pn * HALF + wc * 32 + 8 * fq;
        const PG8_LAS float* rt_ = rstab + u.idx * BM + wr * 64 + fr;
#pragma unroll
        for (int ai = 0; ai < 2; ++ai)
#pragma unroll
            for (int m = 0; m < 4; ++m) { const int row = row0 + ai * HALF + m * 16; bf16_t* rowp = H + (size_t)row * ldc + colh;
                const float rs = rt_[ai * HALF + m * 16];
                const f32x4 g0 = acc[ai][0][m][0] * rs, g1 = acc[ai][0][m][1] * rs, u0 = acc[ai][1][m][0] * rs, u1 = acc[ai][1][m][1] * rs;
                float h[8];
#pragma unroll
                for (int e = 0; e < 4; ++e) { h[e] = silu_f(g0[e]) * u0[e]; h[4 + e] = silu_f(g1[e]) * u1[e]; }
                u32x4 w; w.x = cvt_pk_bf16(h[0], h[1]); w.y = cvt_pk_bf16(h[2], h[3]); w.z = cvt_pk_bf16(h[4], h[5]); w.w = cvt_pk_bf16(h[6], h[7]);
                if (!NOSTORE) *(u32x4*)rowp = w; else asm volatile("" :: "v"(w.x), "v"(w.y), "v"(w.z), "v"(w.w)); }
    }
};
typedef EpiSwigluT<false> EpiSwiglu;
struct EpiNull {
    static constexpr bool PERM = true, AFTER_DRAIN = false;
    __device__ __forceinline__ void operator()(const f32x4 (&acc)[2][2][4][2], const Unit& u, int wr, int wc, int fr, int fq) const {
#pragma unroll
        for (int ai = 0; ai < 2; ++ai)
#pragma unroll
            for (int bj = 0; bj < 2; ++bj)
#pragma unroll
                for (int m = 0; m < 4; ++m)
#pragma unroll
                    for (int n = 0; n < 2; ++n) asm volatile("" :: "v"(acc[ai][bj][m][n]));
    }
};
template <int M_, int N_> struct StaticOrderC {
    static constexpr int nM = M_ / BM, nN = N_ / BM, nwg = nM * nN;
    int G, c;
    __device__ __forceinline__ void init(int G_, int c_) { G = G_; c = c_; }
    __device__ __forceinline__ bool next(int i, Unit& u) const {
        const int L = i * G + c; if (L >= nwg) return false;
        int wgid = L; { constexpr int q = nwg / NXCD, r = nwg % NXCD; const int xcd = wgid % NXCD, off = wgid / NXCD; wgid = (xcd < r ? xcd * (q + 1) : r * (q + 1) + (xcd - r) * q) + off; }
        constexpr int nig = WGM * nN; const int gid = wgid / nig, fm = gid * WGM, gsz = (nM - fm) < WGM ? (nM - fm) : WGM;
        u.pm = fm + ((wgid % nig) % gsz); u.pn = (wgid % nig) / gsz; u.idx = i; return true;
    }
    __device__ __forceinline__ void a_ready(const Unit&) const {}
    __device__ __forceinline__ void done(const Unit&) const {}
};
template <class Sched> __device__ __forceinline__ void fill_row_scales(const Sched& S, const float* ssq, PG8_LAS float* tab, int tid) {
    Unit u; const int r = tid >> 1, hf = tid & 1;
    for (int i = 0; S.next(i, u); ++i) { const f32x4* p = (const f32x4*)(ssq + (size_t)(u.pm * BM + r) * 16 + hf * 8); const f32x4 a = p[0], b = p[1];
        float sum = ((a[0] + a[1]) + (a[2] + a[3])) + ((b[0] + b[1]) + (b[2] + b[3])); sum += __shfl_xor(sum, 1);
        if (hf == 0) tab[i * BM + r] = __builtin_amdgcn_rsqf(sum * (1.0f / 1024.0f) + 1e-6f); }
    __syncthreads();
}
template <class Epi, class Sched, bool ALIGN_EPI = false, bool SP2 = false>
__device__ __forceinline__ void gemm_phase(PG8_LAS unsigned char* lds, const Gemm g, const Sched& S, const Epi& E) {
    int tid_ = threadIdx.x; asm volatile("" : "+v"(tid_));
    float zz_ = 0.f; asm volatile("" : "+v"(zz_));
    const int tid = tid_, wid = __builtin_amdgcn_readfirstlane(tid >> 6), lane = tid & 63, wr = wid >> 2, wc = wid & 3, fr = lane & 15, fq = lane >> 4;
    const int K = g.K, nt = K / BK;
    unsigned voffA[2], voffB[2];
#pragma unroll
    for (int i = 0; i < 2; ++i) { int R, C; stage_rc(tid * 16 + i * 8192, R, C); const int Rb = Epi::PERM ? ((R & ~31) + perm32(R & 31)) : R;
        voffA[i] = (unsigned)(R * K + C) * 2u; voffB[i] = (unsigned)(Rb * K + C) * 2u; }
    const size_t kstep = (size_t)(BK * 2);
    const size_t hstep = (size_t)HALF * K * 2;
    const size_t tstep = 2 * hstep;
    const unsigned ldsw = (unsigned)wid * 1024u;
    const int aoff = lds_byte(wr * 64 + fr, fq * 8), boff = lds_byte(wc * 32 + fr, fq * 8);
#define PG8_SA(b, h) (((b) * 2 + (h)) * HTB)
#define PG8_SB(b, h) ((4 + (b) * 2 + (h)) * HTB)
#define PG8_STAGE(bufoff, gbase, voff) do { _Pragma("unroll") for (int _i = 0; _i < 2; ++_i) \
        __builtin_amdgcn_global_load_lds((const unsigned*)((const char*)(gbase) + (voff)[_i]), (PG8_LAS unsigned*)(lds + (bufoff) + ldsw + _i * 8192), 16, 0, 0); } while (0)
#define PG8_LDA(dst, b, h) do { _Pragma("unroll") for (int m = 0; m < 4; ++m) _Pragma("unroll") for (int k = 0; k < 2; ++k) dst[m][k] = *(const PG8_LAS bf16x8*)(lds + PG8_SA(b, h) + aoff + m * 2048 + k * 1024); } while (0)
#define PG8_LDB(dst, b, h) do { _Pragma("unroll") for (int n = 0; n < 2; ++n) _Pragma("unroll") for (int k = 0; k < 2; ++k) dst[n][k] = *(const PG8_LAS bf16x8*)(lds + PG8_SB(b, h) + boff + n * 2048 + k * 1024); } while (0)
#define PG8_MMA(ai, bj, At, Bt) do { __builtin_amdgcn_s_setprio(1); _Pragma("unroll") for (int m = 0; m < 4; ++m) _Pragma("unroll") for (int n = 0; n < 2; ++n) _Pragma("unroll") for (int k = 0; k < 2; ++k) \
        acc[ai][bj][m][n] = __builtin_amdgcn_mfma_f32_16x16x32_bf16(Bt[n][k], At[m][k], acc[ai][bj][m][n], 0, 0, 0); __builtin_amdgcn_s_setprio(0); } while (0)
#define PG8_WAIT_V(n) asm volatile("s_waitcnt vmcnt(" #n ")" ::: "memory")
#define PG8_WAIT_L(n) asm volatile("s_waitcnt lgkmcnt(" #n ")" ::: "memory")
#define PG8_BAR __builtin_amdgcn_s_barrier()
#define PG8_SCHED __builtin_amdgcn_sched_barrier(0)
    Unit cur, nxt; int ui = 0;
    if (!S.next(0, cur)) return;
    f32x4 acc[2][2][4][2];
#pragma unroll
    for (int a = 0; a < 2; ++a)
#pragma unroll
        for (int b = 0; b < 2; ++b)
#pragma unroll
            for (int m = 0; m < 4; ++m)
#pragma unroll
                for (int n = 0; n < 2; ++n) acc[a][b][m][n] = (f32x4){zz_, zz_, zz_, zz_};
    bf16x8 At[4][2], B0[2][2], B1[2][2];
    const char* cA = (const char*)g.A + (size_t)cur.pm * tstep; const char* cB = (const char*)g.Bt + (size_t)cur.pn * tstep;
    S.a_ready(cur);
    if constexpr (SP2) {
        PG8_STAGE(PG8_SB(0, 0), cB, voffB); PG8_STAGE(PG8_SB(0, 1), cB + hstep, voffB); PG8_STAGE(PG8_SA(0, 0), cA, voffA); PG8_STAGE(PG8_SA(0, 1), cA + hstep, voffA);
        if (wr == 1) PG8_BAR;
        PG8_WAIT_V(2); PG8_BAR;
        PG8_STAGE(PG8_SB(1, 0), cB + kstep, voffB); PG8_STAGE(PG8_SA(1, 0), cA + kstep, voffA); PG8_STAGE(PG8_SB(1, 1), cB + hstep + kstep, voffB);
        PG8_WAIT_V(6); PG8_BAR;
    } else {
        PG8_STAGE(PG8_SB(0, 0), cB, voffB); PG8_STAGE(PG8_SA(0, 0), cA, voffA); PG8_STAGE(PG8_SB(0, 1), cB + hstep, voffB); PG8_STAGE(PG8_SA(0, 1), cA + hstep, voffA);
        if (wr == 1) PG8_BAR;
        PG8_WAIT_V(4); PG8_BAR;
        PG8_STAGE(PG8_SB(1, 0), cB + kstep, voffB); PG8_STAGE(PG8_SA(1, 0), cA + kstep, voffA); PG8_STAGE(PG8_SB(1, 1), cB + hstep + kstep, voffB);
        PG8_WAIT_V(6); PG8_BAR;
    }
    for (;;) {
        const bool has_next = S.next(ui + 1, nxt);
        const char* nA = has_next ? (const char*)g.A + (size_t)nxt.pm * tstep : cA; const char* nB = has_next ? (const char*)g.Bt + (size_t)nxt.pn * tstep : cB;
        for (int t = 0; t < nt; t += 2) {
            const bool last = (t == nt - 2);
            const char* a1 = cA + (size_t)(t + 1) * kstep;
            const char* a2 = last ? nA : cA + (size_t)(t + 2) * kstep; const char* b2 = last ? nB : cB + (size_t)(t + 2) * kstep;
            const char* a3 = a2 + kstep; const char* b3 = b2 + kstep;
            if (last && has_next) S.a_ready(nxt);
            if constexpr (SP2) {
            PG8_LDB(B0, 0, 0); PG8_LDB(B1, 0, 1); PG8_SCHED; PG8_LDA(At, 0, 0); PG8_STAGE(PG8_SA(1, 1), a1 + hstep, voffA);
            PG8_WAIT_V(8); PG8_WAIT_L(0); PG8_BAR; PG8_MMA(0, 0, At, B0); PG8_MMA(0, 1, At, B1); PG8_BAR; PG8_SCHED;
            PG8_LDA(At, 0, 1); PG8_STAGE(PG8_SB(0, 0), b2, voffB); PG8_STAGE(PG8_SB(0, 1), b2 + hstep, voffB); PG8_STAGE(PG8_SA(0, 0), a2, voffA);
            PG8_WAIT_V(8); PG8_WAIT_L(0); PG8_BAR; PG8_MMA(1, 0, At, B0); PG8_MMA(1, 1, At, B1); PG8_BAR; PG8_SCHED;
            PG8_LDB(B0, 1, 0); PG8_LDB(B1, 1, 1); PG8_SCHED; PG8_LDA(At, 1, 0); PG8_STAGE(PG8_SA(0, 1), a2 + hstep, voffA);
            PG8_WAIT_V(8); PG8_WAIT_L(0); PG8_BAR; PG8_MMA(0, 0, At, B0); PG8_MMA(0, 1, At, B1); PG8_BAR; PG8_SCHED;
            PG8_LDA(At, 1, 1); PG8_STAGE(PG8_SB(1, 0), b3, voffB); PG8_STAGE(PG8_SB(1, 1), b3 + hstep, voffB); PG8_STAGE(PG8_SA(1, 0), a3, voffA);
            PG8_WAIT_V(8); PG8_WAIT_L(0); PG8_BAR; PG8_MMA(1, 0, At, B0); PG8_MMA(1, 1, At, B1); PG8_BAR; PG8_SCHED;
            } else {
            PG8_LDB(B0, 0, 0); PG8_SCHED; PG8_LDA(At, 0, 0); PG8_STAGE(PG8_SA(1, 1), a1 + hstep, voffA);
            PG8_WAIT_L(8); PG8_BAR; PG8_WAIT_L(0); PG8_MMA(0, 0, At, B0); PG8_BAR; PG8_SCHED;
            PG8_LDB(B1, 0, 1); PG8_STAGE(PG8_SB(0, 0), b2, voffB);
            PG8_BAR; PG8_WAIT_L(0); PG8_MMA(0, 1, At, B1); PG8_BAR;
            PG8_LDA(At, 0, 1); PG8_STAGE(PG8_SA(0, 0), a2, voffA);
            PG8_BAR; PG8_WAIT_L(0); PG8_MMA(1, 0, At, B0); PG8_BAR; PG8_SCHED;
            PG8_STAGE(PG8_SB(0, 1), b2 + hstep, voffB);
            PG8_WAIT_V(6); PG8_BAR; PG8_MMA(1, 1, At, B1); PG8_BAR;
            PG8_LDB(B0, 1, 0); PG8_SCHED; PG8_LDA(At, 1, 0); PG8_STAGE(PG8_SA(0, 1), a2 + hstep, voffA);
            PG8_WAIT_L(8); PG8_BAR; PG8_WAIT_L(0); PG8_MMA(0, 0, At, B0); PG8_BAR; PG8_SCHED;
            PG8_LDB(B1, 1, 1); PG8_STAGE(PG8_SB(1, 0), b3, voffB);
            PG8_BAR; PG8_WAIT_L(0); PG8_MMA(0, 1, At, B1); PG8_BAR;
            PG8_LDA(At, 1, 1); PG8_STAGE(PG8_SA(1, 0), a3, voffA);
            PG8_BAR; PG8_WAIT_L(0); PG8_MMA(1, 0, At, B0); PG8_BAR; PG8_SCHED;
            PG8_STAGE(PG8_SB(1, 1), b3 + hstep, voffB);
            PG8_WAIT_V(6); PG8_BAR; PG8_MMA(1, 1, At, B1); PG8_BAR;
            }
        }
        if constexpr (ALIGN_EPI) { if (wr == 0) PG8_BAR; }
        if constexpr (!Epi::AFTER_DRAIN) { E(acc, cur, wr, wc, fr, fq); S.done(cur); }
        if (!has_next) break;
#pragma unroll
        for (int a = 0; a < 2; ++a)
#pragma unroll
            for (int b = 0; b < 2; ++b)
#pragma unroll
                for (int m = 0; m < 4; ++m)
#pragma unroll
                    for (int n = 0; n < 2; ++n) acc[a][b][m][n] = (f32x4){zz_, zz_, zz_, zz_};
        cur = nxt; cA = nA; cB = nB; ++ui;
        if constexpr (ALIGN_EPI) { if (wr == 1) PG8_BAR; }
    }
    PG8_WAIT_V(0);
    if constexpr (!ALIGN_EPI) { if (wr == 0) PG8_BAR; }
    PG8_BAR;
    if constexpr (Epi::AFTER_DRAIN) { E.fused(acc, cur, wr, wc, fr, fq, lds, wid, lane); S.done(cur); }
#undef PG8_SA
#undef PG8_SB
#undef PG8_STAGE
#undef PG8_LDA
#undef PG8_LDB
#undef PG8_MMA
#undef PG8_WAIT_V
#undef PG8_WAIT_L
#undef PG8_BAR
#undef PG8_SCHED
}
}
#ifndef PG8_SP2
#define PG8_SP2 true
#endif
#ifndef PG8_ALIGN
#define PG8_ALIGN true
#endif
constexpr int NWAVES = 8, NTHREADS = NWAVES * 64;
constexpr int BATCH = 8, T = 4096, D = 1024, M = BATCH * T;
constexpr int NIN_E = 3840, NIN_O = 3072, FF = 2816, NGU = 2 * FF;
constexpr int PC_R = 0, PC_K = 512, PC_V = 1024, PC_GQ = 1536, PC_GK = 1792, PC_GV = 2048, PC_GG = 2560;
constexpr int PC_W1A = 3072, PC_W1B = 3136, PC_A1A = 3200, PC_A1B = 3264, PC_G1A = 3328, PC_G1B = 3488, PC_WA1 = 3648, PC_PAD = 3664;
constexpr int NLORA = 304;
constexpr size_t MiB = 1u << 20;
constexpr size_t WS_CTL = 0, CTL_ZERO_BYTES = 1 * MiB;
constexpr size_t WS_WIN = 2 * MiB, WS_WOUT = 10 * MiB, WS_WGU = 12 * MiB, WS_WDN = 23 * MiB;
constexpr size_t WS_W2T = 29 * MiB, WS_A2T = WS_W2T + 65536, WS_G2T = WS_A2T + 65536, WS_WA2T = WS_G2T + 196608;
constexpr size_t WS_SSQ = 496 * MiB;
constexpr size_t WS_XFIN = 336 * MiB;
constexpr size_t WS_XN = 32 * MiB;
constexpr size_t WS_P = 96 * MiB;
constexpr size_t WS_END = 500 * MiB;
constexpr int CW_BAR = 4096;
constexpr int RING_BYTES = 135168, LDS_BYTES = 163840, LDSCTL_OFF = LDS_BYTES - 1024, MISC_OFF = LDSCTL_OFF + 320, RSTAB_OFF = RING_BYTES + 448;

#define GAS __attribute__((address_space(1)))
#define LAS __attribute__((address_space(3)))
typedef unsigned short bf16;
typedef unsigned v4u __attribute__((ext_vector_type(4)));
typedef unsigned v2u __attribute__((ext_vector_type(2)));
typedef float f32x4 __attribute__((ext_vector_type(4)));
#define LDS_WAIT() asm volatile("s_waitcnt lgkmcnt(0)" ::: "memory")
#define VM_WAIT() asm volatile("s_waitcnt vmcnt(0)" ::: "memory")
#define LDS_BARRIER() do { asm volatile("s_waitcnt lgkmcnt(0)\n\ts_barrier" ::: "memory"); } while (0)
__device__ __forceinline__ unsigned f2bf(float f) { unsigned u = __builtin_bit_cast(unsigned, f); return (u + 0x7fffu + ((u >> 16) & 1u)) >> 16; }
__device__ __forceinline__ unsigned pk2(float lo, float hi) { return f2bf(lo) | (f2bf(hi) << 16); }
__device__ __forceinline__ float bf2f(bf16 u) { return __builtin_bit_cast(float, (unsigned)u << 16); }
__device__ __forceinline__ float bflo(unsigned w) { return __builtin_bit_cast(float, w << 16); }
__device__ __forceinline__ float bfhi(unsigned w) { return __builtin_bit_cast(float, w & 0xffff0000u); }
__device__ __forceinline__ float wave_sum(float v) {
#define WS_DPP(x, ctrl, rmask) __builtin_bit_cast(float, __builtin_amdgcn_update_dpp(0, __builtin_bit_cast(int, x), ctrl, rmask, 0xf, true))
    v += WS_DPP(v, 0x111, 0xf);
    v += WS_DPP(v, 0x112, 0xf);
    v += WS_DPP(v, 0x114, 0xf);
    v += WS_DPP(v, 0x118, 0xf);
    v += WS_DPP(v, 0x142, 0xa);
    v += WS_DPP(v, 0x143, 0xc);
#undef WS_DPP
    return __builtin_bit_cast(float, __builtin_amdgcn_readlane(__builtin_bit_cast(int, v), 63));
}
__device__ __forceinline__ float wave_max(float v) {
#pragma unroll
    for (int o = 1; o < 64; o <<= 1) v = fmaxf(v, __shfl_xor(v, o));
    return v;
}
__device__ __forceinline__ float fexp(float x) { return __builtin_amdgcn_exp2f(x * 1.4426950408889634f); }
__device__ __forceinline__ float flog(float x) { return __builtin_amdgcn_logf(x) * 0.6931471805599453f; }
__device__ __forceinline__ float frcp(float x) { return __builtin_amdgcn_rcpf(x); }
__device__ __forceinline__ float frsq(float x) { return __builtin_amdgcn_rsqf(x); }
__device__ __forceinline__ float fsqrt(float x) { return __builtin_amdgcn_sqrtf(x); }
__device__ __forceinline__ float sigmoid_f(float x) { return frcp(1.0f + fexp(-x)); }
__device__ __forceinline__ float softplus_f(float x) { return fmaxf(x, 0.f) + flog(1.0f + fexp(-fabsf(x))); }
__device__ __forceinline__ float tanh_f(float x) { return 1.0f - 2.0f * frcp(1.0f + fexp(2.0f * x)); }
#define XB_TMO      128
#define XB_XCNT(j)  (256  + 64 * (j))
#define XB_XSUB(j)  (1280 + 64 * (j))
#define XB_XGEN(j)  (2304 + 64 * (j))
#define XB_TOP      3328
#define XB_TOPGEN   3392
#define XCD_BAR_WORDS 3456
#define XB_SPIN_CAP (1u << 23)

__device__ __forceinline__ unsigned xb_ld(unsigned* p)              { return __hip_atomic_load(p, __ATOMIC_RELAXED, __HIP_MEMORY_SCOPE_AGENT); }
__device__ __forceinline__ unsigned xb_add(unsigned* p, unsigned v) { return __hip_atomic_fetch_add(p, v, __ATOMIC_RELAXED, __HIP_MEMORY_SCOPE_AGENT); }
__device__ __forceinline__ unsigned xb_xcc_id() { return (unsigned)__builtin_amdgcn_s_getreg((3 << 11) | 20) & 0xFu; }
#define XB_SPIN(cond, bar) do { unsigned _sp = 0; while (cond) { __builtin_amdgcn_s_sleep(1); \
    if ((++_sp & 255u) == 0u) { if (xb_ld(&(bar)[XB_TMO])) break; if (_sp > XB_SPIN_CAP) { atomicAdd(&(bar)[XB_TMO], 1u); break; } } } } while (0)

struct XcdBarrier {
    unsigned* bar; unsigned x;
    volatile LAS unsigned* st;
};

__device__ __forceinline__ XcdBarrier xcd_barrier_post(unsigned* bar, volatile LAS unsigned* st) {
    XcdBarrier b; b.bar = bar; b.x = xb_xcc_id(); b.st = st;
    if (threadIdx.x == 0) (void)xb_add(&bar[XB_XCNT(b.x)], 1u);
    return b;
}
__device__ __forceinline__ void xcd_barrier_complete(unsigned* bar, unsigned x, unsigned& nloc, unsigned& nx) {
    const unsigned G = gridDim.x * gridDim.y * gridDim.z;
    unsigned sum, cnt, mine, sp = 0u;
    for (;;) {
        sum = 0u; cnt = 0u; mine = 0u;
#pragma unroll
        for (unsigned j = 0; j < 16; ++j) { const unsigned c = xb_ld(&bar[XB_XCNT(j)]); sum += c; cnt += (c > 0u) ? 1u : 0u; mine = (j == x) ? c : mine; }
        if (sum == G) break;
        __builtin_amdgcn_s_sleep(1);
        if ((++sp & 255u) == 0u) { if (xb_ld(&bar[XB_TMO])) break; if (sp > XB_SPIN_CAP) { atomicAdd(&bar[XB_TMO], 1u); break; } }
    }
    nloc = mine > 0u ? mine : 1u; nx = cnt > 0u ? cnt : 1u;
}

__device__ __forceinline__ void xcd_barrier(const XcdBarrier& b) {
    asm volatile("s_waitcnt vmcnt(0)" ::: "memory");
    __syncthreads();
    if (threadIdx.x == 0) {
        unsigned blo_ = __builtin_amdgcn_readfirstlane((unsigned)(unsigned long long)b.bar), bhi_ = __builtin_amdgcn_readfirstlane((unsigned)((unsigned long long)b.bar >> 32)), bx = __builtin_amdgcn_readfirstlane(b.x); asm volatile("" : "+s"(blo_), "+s"(bhi_), "+s"(bx)); unsigned* bar = (unsigned*)(((unsigned long long)bhi_ << 32) | blo_);
        __builtin_amdgcn_s_waitcnt(0);
        unsigned nloc = b.st[0], nx = b.st[1];
        if (nloc == 0u) { xcd_barrier_complete(bar, bx, nloc, nx); b.st[0] = nloc; b.st[1] = nx; }
        const unsigned old = xb_add(&bar[XB_XSUB(bx)], 1u);
        const unsigned gen = old / nloc;
        if (old + 1u == (gen + 1u) * nloc) {
            __builtin_amdgcn_fence(__ATOMIC_RELEASE, "agent");
            asm volatile("s_waitcnt vmcnt(0)" ::: "memory");
            const unsigned og = xb_add(&bar[XB_TOP], 1u);
            const unsigned tg = og / nx;
            if (og + 1u == (tg + 1u) * nx) xb_add(&bar[XB_TOPGEN], 1u);
            else XB_SPIN(xb_ld(&bar[XB_TOPGEN]) == tg, bar);
            __builtin_amdgcn_fence(__ATOMIC_ACQUIRE, "agent");
            xb_add(&bar[XB_XGEN(bx)], 1u);
            asm volatile("s_waitcnt vmcnt(0)" ::: "memory");
        } else {
            XB_SPIN(xb_ld(&bar[XB_XGEN(bx)]) == gen, bar);
            __builtin_amdgcn_fence(__ATOMIC_ACQUIRE, "agent");
            asm volatile("s_waitcnt vmcnt(0)" ::: "memory");
        }
    }
    __syncthreads();
}
__device__ __forceinline__ void tr_item(const float* __restrict__ W, int Kreal, int N, bf16* WT, int ldd, int dst_row0, LAS float* scr, int k0, int n0, int lane,
                                        const float* __restrict__ mu, float sc0, float sc1, const float* __restrict__ gk = nullptr) {
    const int rr = lane >> 3, c4 = lane & 7, nn = n0 + 4 * c4; const bool nv = nn < N;
#pragma unroll
    for (int i = 0; i < 8; ++i) { const int kk = 8 * i + rr; f32x4 v = (nv && k0 + kk < Kreal) ? *(const GAS f32x4*)(W + (size_t)(k0 + kk) * N + nn) : (f32x4){0.f, 0.f, 0.f, 0.f};
        float sc = 1.0f; if (mu) sc = sc0 + sc1 * mu[k0 + kk]; if (gk) sc *= gk[k0 + kk]; v = v * sc;
        LAS float* d = scr + kk * 33 + 4 * c4; d[0] = v.x; d[1] = v.y; d[2] = v.z; d[3] = v.w; }
    LDS_WAIT(); asm volatile("" ::: "memory");
    const int c = lane & 7;
#pragma unroll
    for (int j = 0; j < 4; ++j) { const int n = (lane >> 3) + 8 * j; const LAS float* s = scr + (8 * c) * 33 + n;
        v4u o; o.x = pk2(s[0 * 33], s[1 * 33]); o.y = pk2(s[2 * 33], s[3 * 33]); o.z = pk2(s[4 * 33], s[5 * 33]); o.w = pk2(s[6 * 33], s[7 * 33]);
        if (n0 + n < N) *(GAS v4u*)(WT + (size_t)(dst_row0 + n) * ldd + k0 + 8 * c) = o; }
    LDS_WAIT(); asm volatile("" ::: "memory");
}
__device__ __forceinline__ void rms_rows4_bf16_to_f32(const bf16* x, const float* g, float* o, int m0, int mstride, int lane) {
    v2u a[4][4];
#pragma unroll
    for (int u = 0; u < 4; ++u) { const int m = m0 + u * mstride; if (m < M) { const GAS v2u* xr = (const GAS v2u*)(x + (size_t)m * D) + lane;
#pragma unroll
        for (int q = 0; q < 4; ++q) a[u][q] = xr[64 * q]; } }
    f32x4 gv[4];
#pragma unroll
    for (int q = 0; q < 4; ++q) gv[q] = ((const GAS f32x4*)g)[lane + 64 * q];
#pragma unroll
    for (int u = 0; u < 4; ++u) { const int m = m0 + u * mstride; if (m < M) { f32x4 v[4]; float s = 0.f;
#pragma unroll
        for (int q = 0; q < 4; ++q) { v[q] = (f32x4){bflo(a[u][q].x), bfhi(a[u][q].x), bflo(a[u][q].y), bfhi(a[u][q].y)}; s += (v[q].x * v[q].x + v[q].y * v[q].y) + (v[q].z * v[q].z + v[q].w * v[q].w); }
        const float rs = frsq(wave_sum(s) * (1.f / D) + 1e-6f);
        GAS f32x4* orow = (GAS f32x4*)(o + (size_t)m * D) + lane;
#pragma unroll
        for (int q = 0; q < 4; ++q) orow[64 * q] = v[q] * rs * gv[q]; } }
}
struct Args { const float* in[36]; float* out; unsigned char* ws; int lo, hi; };
typedef const __attribute__((address_space(4))) Args* ArgP;
#define FRESH_ARGS() ({ ArgP p_ = (ArgP)__builtin_amdgcn_kernarg_segment_ptr(); asm volatile("" : "+s"(p_)); p_; })
#define FRESH_V(x) asm volatile("" : "+v"(x))
#define FRESH_S(x) asm volatile("" : "+s"(x))

#define TR_JOB(items, nblk, Wp, Kd, Nd, DST, LDD, ROW0, MU, S0, S1, GK) if (r < (items)) { const int kb = r / (nblk), nb = r % (nblk), n0 = 32 * nb; tr_item(Wp, Kd, Nd, DST, LDD, ROW0, scr, 64 * kb, n0, lane, MU, S0, S1, GK); continue; } r -= (items);
__device__ __forceinline__ void convert_mixer_weights(ArgP A, int L, LAS unsigned char* lds, int wave, int lane, int gw, int NGW) {
    const int i = L >> 1; const bool even = !(L & 1);
    bf16* Win = (bf16*)(A->ws + WS_WIN); bf16* Wout = (bf16*)(A->ws + WS_WOUT);
    LAS float* scr = (LAS float*)(lds + wave * 16384);
    const float* gmix = A->in[2] + (size_t)L * D;
    const float* w_in = even ? A->in[5] + (size_t)i * D * 3072 : A->in[26] + (size_t)i * D * 3072;
    const float* w_out = even ? A->in[6] + (size_t)i * D * D : A->in[27] + (size_t)i * D * D;
    const float* mu_w = A->in[8] + (size_t)i * 3 * D, *mu_a = mu_w + D, *mu_g = mu_w + 2 * D;
    const float* w1 = A->in[10] + (size_t)i * D * 64, *a1 = A->in[13] + (size_t)i * D * 64, *g1 = A->in[15] + (size_t)i * D * 160, *wa1 = A->in[22] + (size_t)i * D * 16;
    const float* w2s = A->in[11] + (size_t)i * 64 * 512, *a2s = A->in[14] + (size_t)i * 64 * 512, *g2s = A->in[16] + (size_t)i * 160 * 512;
    bf16* W2T = (bf16*)(A->ws + WS_W2T); bf16* A2T = (bf16*)(A->ws + WS_A2T); bf16* G2T = (bf16*)(A->ws + WS_G2T);
    const int I_IN = 16 * 96, I_L64 = 16 * 2, I_L160 = 16 * 5, I_L16 = 16 * 1, I_OUT = 16 * 32;
    const int n_lora = even ? (4 * I_L64 + 2 * I_L160 + I_L16 + 16 + 16 + 48) : 0;
    const int NITEMS = I_IN + n_lora + I_OUT;
    for (int it = gw; it < NITEMS; it += NGW) {
        int r = it;
        TR_JOB(I_IN, 96, w_in, D, 3072, Win, D, n0, nullptr, 1.f, 0.f, gmix)
        if (even) {
            TR_JOB(I_L64, 2, w1, D, 64, Win, D, PC_W1A + n0, mu_w, 1.f, -1.f, gmix)
            TR_JOB(I_L64, 2, w1, D, 64, Win, D, PC_W1B + n0, mu_w, 0.f, 1.f, gmix)
            TR_JOB(I_L64, 2, a1, D, 64, Win, D, PC_A1A + n0, mu_a, 1.f, -1.f, gmix)
            TR_JOB(I_L64, 2, a1, D, 64, Win, D, PC_A1B + n0, mu_a, 0.f, 1.f, gmix)
            TR_JOB(I_L160, 5, g1, D, 160, Win, D, PC_G1A + n0, mu_g, 1.f, -1.f, gmix)
            TR_JOB(I_L160, 5, g1, D, 160, Win, D, PC_G1B + n0, mu_g, 0.f, 1.f, gmix)
            TR_JOB(I_L16, 1, wa1, D, 16, Win, D, PC_WA1 + n0, nullptr, 1.f, 0.f, gmix)
            TR_JOB(16, 16, w2s, 64, 512, W2T, 64, n0, nullptr, 1.f, 0.f, nullptr)
            TR_JOB(16, 16, a2s, 64, 512, A2T, 64, n0, nullptr, 1.f, 0.f, nullptr)
            TR_JOB(48, 16, g2s, 160, 512, G2T, 192, n0, nullptr, 1.f, 0.f, nullptr)
        }
        TR_JOB(I_OUT, 32, w_out, D, D, Wout, D, n0, nullptr, 1.f, 0.f, nullptr)
    }
    if (even) {
        const int gt = gw * 64 + lane, NT = NGW * 64;
        { unsigned z_ = 0u; asm volatile("" : "+v"(z_));
        for (int e = gt; e < (NIN_E - PC_PAD) * D / 8; e += NT) ((GAS v4u*)(Win + (size_t)PC_PAD * D))[e] = (v4u){z_, z_, z_, z_}; }
        bf16* WA2T = (bf16*)(A->ws + WS_WA2T); const float* wa2 = A->in[23] + (size_t)i * 16 * 256;
        for (int e = gt; e < 256 * 32; e += NT) { const int nn = e >> 5, k = e & 31; WA2T[e] = k < 16 ? (bf16)f2bf(wa2[k * 256 + nn]) : (bf16)0; }
    }
}
__device__ __forceinline__ void convert_ffn_weights(ArgP A, int L, LAS unsigned char* lds, int wave, int lane, int gw, int NGW) {
    bf16* Wgu = (bf16*)(A->ws + WS_WGU); bf16* Wdn = (bf16*)(A->ws + WS_WDN);
    LAS float* scr = (LAS float*)(lds + wave * 16384);
    const float* gffn = A->in[3] + (size_t)L * D;
    const float* wg = A->in[33] + (size_t)L * D * FF, *wu = A->in[34] + (size_t)L * D * FF, *wd = A->in[35] + (size_t)L * FF * D;
    const int I_GU = 16 * 88, I_DN = 44 * 32;
    for (int it = gw; it < 2 * I_GU + I_DN; it += NGW) {
        int r = it;
        TR_JOB(I_GU, 88, wg, D, FF, Wgu, D, 256 * (n0 >> 7) + (n0 & 127), nullptr, 1.f, 0.f, gffn)
        TR_JOB(I_GU, 88, wu, D, FF, Wgu, D, 256 * (n0 >> 7) + (n0 & 127) + 128, nullptr, 1.f, 0.f, gffn)
        TR_JOB(I_DN, 32, wd, FF, D, Wdn, FF, n0, nullptr, 1.f, 0.f, nullptr)
    }
}
#undef TR_JOB
__device__ __forceinline__ void x_to_bf16_ssq4(const float* x, bf16* o, float* ssq, int m0, int mstride, int lane) {
    f32x4 v[4][4];
#pragma unroll
    for (int u = 0; u < 4; ++u) { const int m = m0 + u * mstride; if (m < M) { const GAS f32x4* xr = (const GAS f32x4*)(x + (size_t)m * D) + lane;
#pragma unroll
        for (int j = 0; j < 4; ++j) v[u][j] = xr[64 * j]; } }
#pragma unroll
    for (int u = 0; u < 4; ++u) { const int m = m0 + u * mstride; if (m < M) { float s = 0.f;
#pragma unroll
        for (int j = 0; j < 4; ++j) s += (v[u][j].x * v[u][j].x + v[u][j].y * v[u][j].y) + (v[u][j].z * v[u][j].z + v[u][j].w * v[u][j].w);
        s = wave_sum(s); if (lane < 16) ssq[(size_t)m * 16 + lane] = lane == 0 ? s : 0.f;
        GAS v2u* o8 = (GAS v2u*)(o + (size_t)m * D) + lane;
#pragma unroll
        for (int j = 0; j < 4; ++j) { v2u w; w.x = pk2(v[u][j].x, v[u][j].y); w.y = pk2(v[u][j].z, v[u][j].w); o8[64 * j] = w; } } }
}

__device__ __forceinline__ int t5_bucket(int d) {
    if (d < 16) return d;
    const float r = (float)d / 16.0f; int l = 16 + (int)(flog(r) / 2.0794415416798357f * 16.0f);
    return l < 31 ? l : 31;
}
#ifndef AT_PRIO
#define AT_PRIO 0
#endif
#ifndef AT_STATIC_PRIO
#define AT_STATIC_PRIO 1
#endif
typedef short a_bf16x8 __attribute__((ext_vector_type(8)));
typedef float f32x16 __attribute__((ext_vector_type(16)));
typedef short a_s16x4 __attribute__((ext_vector_type(4)));
constexpr int AT_K1 = 0, AT_K2 = 8192, AT_V = 16384, AT_ST = 32768, AT_NST = 4, AT_BIAS = AT_NST * AT_ST, AT_COMB = 2 * AT_ST;
static_assert(AT_BIAS + 1024 + 512 <= RSTAB_OFF && AT_COMB + 4 * 64 * 64 * 4 <= AT_BIAS, "attention LDS map");
__device__ __forceinline__ int crow16(int r, int hi) { return (r & 3) + 8 * (r >> 2) + 4 * hi; }
typedef float f32x2_t __attribute__((ext_vector_type(2))); typedef __bf16 bf16x2_t __attribute__((ext_vector_type(2)));
__device__ __forceinline__ unsigned cvtpk(float lo, float hi) { const f32x2_t v = {lo, hi}; const bf16x2_t b = __builtin_convertvector(v, bf16x2_t); return __builtin_bit_cast(unsigned, b); }

template <bool HALFSYNC = false> __device__ __forceinline__ void attn_unit_mfma(ArgP A, int L, int b, int h, int qb, float lam, float lam_init, LAS unsigned char* lds, int tid, bool pre, bool nxt) {
    const int lane = tid & 63, wave = __builtin_amdgcn_readfirstlane(tid >> 6), r32 = lane & 31, hi = lane >> 5;
    const int smap = wave >> 2, qs = wave & 3;
    const int i = L >> 1;
    const bf16* QKV = (const bf16*)(A->ws + WS_P); bf16* O = (bf16*)(A->ws + WS_XN);
    const int q0 = qb * 128, qw0 = q0 + 32 * qs, nt = (q0 + 128) / 64;
    const size_t rowb = (size_t)b * T;
    if (!pre && tid < 129) { const float far = A->in[1][31 * 8 + h]; ((LAS float*)(lds + AT_BIAS))[tid] = tid < 128 ? (A->in[1][t5_bucket(tid) * 8 + h] - far) * 1.4426950408889634f : 0.f; }
    if (!pre && tid >= 256 && tid < 384) ((LAS float*)(lds + AT_BIAS + 1024))[tid - 256] = A->in[32][i * 128 + tid - 256];
    a_bf16x8 qf[4];
    { const bf16* qrow = QKV + (rowb + qw0 + r32) * NIN_O + h * 128 + smap * 64 + 8 * hi;
#pragma unroll
      for (int ks = 0; ks < 4; ++ks) qf[ks] = *(const GAS a_bf16x8*)(qrow + 16 * ks); }
    const int kr = 8 * wave + (lane >> 3), kcs = (lane & 7) ^ ((kr >> 1) & 7);
    const bf16* kg = QKV + (rowb + kr) * NIN_O + 1024 + h * 128 + 8 * kcs;
    const int vr0 = 8 * wave + (lane >> 4), vr1 = vr0 + 4;
    const bf16* vg0 = QKV + (rowb + vr0) * NIN_O + 2048 + h * 128 + 8 * ((lane & 15) ^ (((vr0 & 3) << 2) | ((vr0 >> 2) & 3)));
    const bf16* vg1 = QKV + (rowb + vr1) * NIN_O + 2048 + h * 128 + 8 * ((lane & 15) ^ (((vr1 & 3) << 2) | ((vr1 >> 2) & 3)));
#define AT_DMA(kt, stoff) do { const size_t go_ = (size_t)(kt) * 64 * NIN_O; LAS unsigned char* sb_ = lds + (stoff) + wave * 1024; \
        __builtin_amdgcn_global_load_lds((const unsigned*)(kg + go_), (LAS unsigned*)(sb_ + AT_K1), 16, 0, 0); __builtin_amdgcn_global_load_lds((const unsigned*)(kg + go_ + 64), (LAS unsigned*)(sb_ + AT_K2), 16, 0, 0); \
        __builtin_amdgcn_global_load_lds((const unsigned*)(vg0 + go_), (LAS unsigned*)(sb_ + AT_V + wave * 1024), 16, 0, 0); __builtin_amdgcn_global_load_lds((const unsigned*)(vg1 + go_), (LAS unsigned*)(sb_ + AT_V + wave * 1024 + 1024), 16, 0, 0); } while (0)
    if (!pre) { AT_DMA(0, 0); AT_DMA(1, AT_ST); }
    __syncthreads();
#ifdef AT_STATIC_PRIO
    if (wave >= 4) __builtin_amdgcn_s_setprio(AT_STATIC_PRIO);
#endif
    f32x16 o[4];
#pragma unroll
    for (int d = 0; d < 4; ++d)
#pragma unroll
        for (int r = 0; r < 16; ++r) o[d][r] = 0.f;
    float m = -1e30f, l = 0.f;
    const int kfo = (smap ? AT_K2 : AT_K1) + r32 * 128, khg = hi ^ ((r32 >> 1) & 7);
    int vfo[2][4];
    { const int q = (lane & 15) >> 2, pp = lane & 3, blk = (lane >> 4) & 1;
#pragma unroll
      for (int t = 0; t < 2; ++t)
#pragma unroll
          for (int d = 0; d < 4; ++d) vfo[t][d] = AT_V + 256 * (4 * hi + q + 8 * t) + 16 * (((d ^ q) << 2) | ((2 * blk + (pp >> 1)) ^ ((hi + 2 * t) & 3))) + 8 * (pp & 1); }
    const LAS float* bdl = (const LAS float*)(lds + AT_BIAS);
    const int qme = qw0 + r32;
#define AT_VREAD(VF, kk) do { _Pragma("unroll") for (int d = 0; d < 4; ++d) { \
                VF[2 * d] = __builtin_bit_cast(a_s16x4, __builtin_amdgcn_ds_read_tr16_b64_v4i16((LAS a_s16x4*)(sbv + vfo[0][d] + (kk) * 4096))); VF[2 * d + 1] = __builtin_bit_cast(a_s16x4, __builtin_amdgcn_ds_read_tr16_b64_v4i16((LAS a_s16x4*)(sbv + vfo[1][d] + (kk) * 4096))); } } while (0)
#define AT_PV(VF, PF, kk) do { _Pragma("unroll") for (int d = 0; d < 4; ++d) { const a_bf16x8 vf_ = (a_bf16x8){VF[2 * d][0], VF[2 * d][1], VF[2 * d][2], VF[2 * d][3], VF[2 * d + 1][0], VF[2 * d + 1][1], VF[2 * d + 1][2], VF[2 * d + 1][3]}; \
                o[d] = __builtin_amdgcn_mfma_f32_32x32x16_bf16(vf_, PF[kk], o[d], 0, 0, 0); } } while (0)
    int pbase = 0;
#pragma unroll 1
    for (int kt0 = 0; kt0 < nt; kt0 += 2) {
        const int nbase = pbase ? 0 : 2 * AT_ST;
#pragma unroll 1
      for (int sub = 0; sub < 2; ++sub) { const int kt = kt0 + sub; const int stoff = pbase + sub * AT_ST;
        if (kt + 2 < nt) AT_DMA(kt + 2, nbase + sub * AT_ST);
        const int key0 = 64 * kt;
        if (key0 <= qw0 + 31) {
            const LAS unsigned char* sb = lds + stoff; const LAS unsigned char* sbv = sb;
            f32x16 p[2]; a_bf16x8 kf[8];
#pragma unroll
            for (int f = 0; f < 4; ++f) kf[f] = *(const LAS a_bf16x8*)(sb + kfo + ((khg ^ (2 * f)) * 16));
            __builtin_amdgcn_sched_barrier(0);
#pragma unroll
            for (int r = 0; r < 16; ++r) p[0][r] = 0.f;
            p[0] = __builtin_amdgcn_mfma_f32_32x32x16_bf16(kf[0], qf[0], p[0], 0, 0, 0);
            __builtin_amdgcn_sched_barrier(0);
#pragma unroll
            for (int f = 4; f < 8; ++f) kf[f] = *(const LAS a_bf16x8*)(sb + kfo + 4096 + ((khg ^ (2 * (f & 3))) * 16));
            __builtin_amdgcn_sched_barrier(0);
#pragma unroll
            for (int ks = 1; ks < 4; ++ks) p[0] = __builtin_amdgcn_mfma_f32_32x32x16_bf16(kf[ks], qf[ks], p[0], 0, 0, 0);
            __builtin_amdgcn_sched_barrier(0);
#pragma unroll
            for (int r = 0; r < 16; ++r) p[1][r] = 0.f;
#pragma unroll
            for (int ks = 0; ks < 4; ++ks) p[1] = __builtin_amdgcn_mfma_f32_32x32x16_bf16(kf[4 + ks], qf[ks], p[1], 0, 0, 0);
            if (AT_PRIO) __builtin_amdgcn_s_setprio(0);
            if (key0 + 63 + 128 > qw0) {
#pragma unroll
                for (int blk = 0; blk < 2; ++blk) { float bvv[16];
#pragma unroll
                    for (int r = 0; r < 16; ++r) { const unsigned ud = (unsigned)(qme - (key0 + 32 * blk + crow16(r, hi))); bvv[r] = bdl[ud < 128u ? ud : 128u]; }
                    asm volatile("" : "+v"(bvv[0]), "+v"(bvv[1]), "+v"(bvv[2]), "+v"(bvv[3]), "+v"(bvv[4]), "+v"(bvv[5]), "+v"(bvv[6]), "+v"(bvv[7]), "+v"(bvv[8]), "+v"(bvv[9]), "+v"(bvv[10]), "+v"(bvv[11]), "+v"(bvv[12]), "+v"(bvv[13]), "+v"(bvv[14]), "+v"(bvv[15]));
#pragma unroll
                    for (int r = 0; r < 16; ++r) { const int dist = qme - (key0 + 32 * blk + crow16(r, hi)); p[blk][r] = dist < 0 ? -1e30f : p[blk][r] + bvv[r]; } }
            }
            float mx = p[0][0];
#pragma unroll
            for (int r = 1; r < 16; ++r) mx = fmaxf(mx, p[0][r]);
#pragma unroll
            for (int r = 0; r < 16; ++r) mx = fmaxf(mx, p[1][r]);
            mx = xmax32(mx);
            if (__any(mx > m + 8.0f)) {
                const float mn = fmaxf(m, mx), al = __builtin_amdgcn_exp2f(m - mn); m = mn; l *= al;
#pragma unroll
                for (int d = 0; d < 4; ++d)
#pragma unroll
                    for (int r = 0; r < 16; ++r) o[d][r] *= al;
            }
            float ls = 0.f;
#define AT_EXPPK(PF, kk) do { const int blk_ = (kk) >> 1, s8_ = 8 * ((kk) & 1); float e_[8]; _Pragma("unroll") for (int j = 0; j < 8; ++j) { e_[j] = __builtin_amdgcn_exp2f(p[blk_][s8_ + j] - m); ls += e_[j]; } \
                v4u w_; w_.x = cvtpk(e_[0], e_[1]); w_.y = cvtpk(e_[2], e_[3]); w_.z = cvtpk(e_[4], e_[5]); w_.w = cvtpk(e_[6], e_[7]); PF[kk] = __builtin_bit_cast(a_bf16x8, w_); } while (0)
            {
                a_bf16x8 pf[4]; a_s16x4 vA[8], vB[8];
                AT_VREAD(vA, 0); AT_EXPPK(pf, 0);
                __builtin_amdgcn_sched_barrier(0);
                AT_VREAD(vB, 1); AT_PV(vA, pf, 0); AT_EXPPK(pf, 1);
                __builtin_amdgcn_sched_barrier(0);
                AT_VREAD(vA, 2); AT_PV(vB, pf, 1); AT_EXPPK(pf, 2);
                __builtin_amdgcn_sched_barrier(0);
                AT_VREAD(vB, 3); AT_PV(vA, pf, 2); AT_EXPPK(pf, 3);
                __builtin_amdgcn_sched_barrier(0);
                AT_PV(vB, pf, 3);
            }
            l += ls;
#undef AT_EXPPK
        }
      }
        __syncthreads();
        pbase = nbase;
    }
    if (nxt) { AT_DMA(0, 0); AT_DMA(1, AT_ST); }
#undef AT_VREAD
#undef AT_PV
#undef AT_DMA
#ifdef AT_STATIC_PRIO
    __builtin_amdgcn_s_setprio(0);
#endif
    l += __shfl_xor(l, 32);
    LAS float* comb = (LAS float*)(lds + AT_COMB) + qs * 4096;
    if (smap == 1) { const float sc = lam * frcp(l);
#pragma unroll
        for (int d = 0; d < 4; ++d)
#pragma unroll
            for (int r = 0; r < 16; ++r) comb[(d * 16 + r) * 64 + lane] = o[d][r] * sc; }
    LDS_BARRIER();
    if (smap == 0) {
        const float il = frcp(l); float ss = 0.f;
#pragma unroll
        for (int d = 0; d < 4; ++d)
#pragma unroll
            for (int r = 0; r < 16; ++r) { const float v = o[d][r] * il - comb[(d * 16 + r) * 64 + lane]; o[d][r] = v; ss += v * v; }
        ss += __shfl_xor(ss, 32);
        const float rs = frsq(ss * (1.f / 128.f) + 1e-5f) * (1.0f - lam_init);
        const LAS float* sl = (const LAS float*)(lds + AT_BIAS + 1024);
        bf16* orow = O + (rowb + qw0 + r32) * D + h * 128;
#pragma unroll
        for (int d = 0; d < 4; ++d)
#pragma unroll
            for (int gp = 0; gp < 2; ++gp) { v2u w[2];
#pragma unroll
                for (int e = 0; e < 2; ++e) { const int g4 = 2 * gp + e; const f32x4 s4 = *(const LAS f32x4*)(sl + 32 * d + 8 * g4 + 4 * hi);
                    w[e].x = cvtpk(o[d][4 * g4] * rs * s4.x, o[d][4 * g4 + 1] * rs * s4.y); w[e].y = cvtpk(o[d][4 * g4 + 2] * rs * s4.z, o[d][4 * g4 + 3] * rs * s4.w); }
                const auto sx = __builtin_amdgcn_permlane32_swap(w[0].x, w[1].x, false, false); const auto sy = __builtin_amdgcn_permlane32_swap(w[0].y, w[1].y, false, false);
                *(GAS v4u*)(orow + 32 * d + 8 * (2 * gp + hi)) = (v4u){sx[0], sy[0], sx[1], sy[1]}; }
    }
    LDS_BARRIER();
}

template <bool HALFSYNC = false> __device__ __forceinline__ void attn_phase_mfma(ArgP A, int L, LAS unsigned char* lds, int tid, int G, int bid) {
    const int lane = tid & 63, i = L >> 1;
    const float lam_init = 0.8f - 0.6f * fexp(-0.3f * (float)L);
    const float lam = fexp(wave_sum(A->in[28][i * 64 + lane] * A->in[29][i * 64 + lane])) - fexp(wave_sum(A->in[30][i * 64 + lane] * A->in[31][i * 64 + lane])) + lam_init;
    if (G == 256) {
        const int v = (bid & 7) * 32 + (bid >> 3), bh = v >> 2, j = v & 3;
#pragma unroll 1
        for (int u = 0; u < 8; ++u) { const int qb = 8 * (u >> 1) + ((u & 1) ? 7 - j : j); attn_unit_mfma<HALFSYNC>(A, L, bh >> 3, bh & 7, qb, lam, lam_init, lds, tid, u > 0, u < 7); }
    } else {
#pragma unroll 1
        for (int u = bid; u < 64 * 32; u += G) attn_unit_mfma<HALFSYNC>(A, L, (u >> 5) >> 3, (u >> 5) & 7, 31 - (u & 31), lam, lam_init, lds, tid, false, false);
    }
}
typedef short bf16x8_t __attribute__((ext_vector_type(8)));
constexpr int MS = 72, MB = 64 * MS * 2;
constexpr int RW_XW = 8 * MB, RW_XA = RW_XW + 16384;
constexpr int RW_TOT = 14 * MB, RW_GAM = RW_TOT + 2048, RW_END = RW_GAM + 256;
constexpr int RW_WF = 131584, RW_CH = RW_WF + 16384, RW_CEND = RW_CH + 2048;
static_assert(RW_XA + 16384 <= 12 * MB && RW_END <= RING_BYTES && RW_END <= RW_WF && RW_CEND <= LDSCTL_OFF, "RWKV LDS map");
constexpr size_t WS_RWI = 336 * MiB;
constexpr size_t WS_BON = 30 * MiB;
#define RBUF(k) ((LAS bf16*)(lds + (k) * MB))
__device__ __forceinline__ f32x4 mfma16(bf16x8_t a, bf16x8_t b, f32x4 c) { return __builtin_amdgcn_mfma_f32_16x16x32_bf16(a, b, c, 0, 0, 0); }
__device__ __forceinline__ bf16x8_t ldfrag(const LAS bf16* Mx, int row0, int k0, int lane) { return *(const LAS bf16x8_t*)(Mx + (row0 + (lane & 15)) * MS + k0 + 8 * (lane >> 4)); }
__device__ __forceinline__ f32x4 mm64(f32x4 acc, const LAS bf16* Am, int ra, const LAS bf16* BTm, int cb, int lane) {
    acc = mfma16(ldfrag(Am, 16 * ra, 0, lane), ldfrag(BTm, 16 * cb, 0, lane), acc);
    return mfma16(ldfrag(Am, 16 * ra, 32, lane), ldfrag(BTm, 16 * cb, 32, lane), acc);
}
__device__ __forceinline__ v2u pack4(f32x4 a) { v2u w; w.x = cvtpk(a[0], a[1]); w.y = cvtpk(a[2], a[3]); return w; }
__device__ __forceinline__ void tstore(LAS bf16* Dm, int rt, int ct, f32x4 acc, int lane) { *(LAS v2u*)(Dm + (16 * ct + (lane & 15)) * MS + 16 * rt + 4 * (lane >> 4)) = pack4(acc); }
__device__ __forceinline__ void tstore_g(bf16* Dg, int rt, int ct, f32x4 acc, int lane) { *(GAS v2u*)(Dg + (16 * ct + (lane & 15)) * 64 + 16 * rt + 4 * (lane >> 4)) = pack4(acc); }
__device__ __forceinline__ f32x4 ld4bf(const LAS bf16* p) { const v2u w = *(const LAS v2u*)p; return (f32x4){bflo(w.x), bfhi(w.x), bflo(w.y), bfhi(w.y)}; }
__device__ __forceinline__ f32x4 ld4bf_g(const bf16* p) { const v2u w = *(const GAS v2u*)p; return (f32x4){bflo(w.x), bfhi(w.x), bflo(w.y), bfhi(w.y)}; }
__device__ __forceinline__ void unpack8(v4u w, float (&f)[8]) { f[0] = bflo(w.x); f[1] = bfhi(w.x); f[2] = bflo(w.y); f[3] = bfhi(w.y); f[4] = bflo(w.z); f[5] = bfhi(w.z); f[6] = bflo(w.w); f[7] = bfhi(w.w); }
__device__ __forceinline__ bf16x8_t pack8(const float (&f)[8]) { v4u w; w.x = cvtpk(f[0], f[1]); w.y = cvtpk(f[2], f[3]); w.z = cvtpk(f[4], f[5]); w.w = cvtpk(f[6], f[7]); return __builtin_bit_cast(bf16x8_t, w); }

__device__ __forceinline__ void rwkv_chunk_phase(ArgP A, int L, LAS unsigned char* lds, int tid, int G, int bid) {
    const int lane = tid & 63, wave = __builtin_amdgcn_readfirstlane(tid >> 6), i = L >> 1;
    const int l15 = lane & 15, lg = lane >> 4;
    const bf16* P = (const bf16*)(A->ws + WS_P); bf16* XNb = (bf16*)(A->ws + WS_XN);
    const int rt = wave >> 1, ct0 = 2 * (wave & 1);
    constexpr int NIT = BATCH * 64 * 8;
    v4u pw[2][2], pa[2][2]; unsigned pe[9][3];
#ifdef PROBE_R1
#define R1_STAMP(k) do { if (tid == 0 && bid == PROBE_BLOCK) { LAS unsigned long long* t_ = (LAS unsigned long long*)(lds + LDSCTL_OFF + 640); const unsigned long long now_ = __builtin_amdgcn_s_memrealtime(); t_[1 + (k)] += now_ - t_[0]; t_[0] = now_; } } while (0)
#else
#define R1_STAMP(k) do { } while (0)
#endif
#define R1_PREFETCH(itx) do { const int b_ = (itx) >> 9, n_ = ((itx) >> 3) & 63, h_ = (itx) & 7; const size_t rowb_ = (size_t)b_ * T + 64 * n_; \
        { const int tt_ = 16 * rt + l15; const bf16* prow_ = P + (rowb_ + tt_) * NIN_E; const bool hp_ = (64 * n_ + tt_) > 0; const v4u z4_ = (v4u){0u, 0u, 0u, 0u}; \
          _Pragma("unroll") for (int q = 0; q < 2; ++q) { const int kc_ = 32 * q + 8 * lg; pw[q][0] = *(const GAS v4u*)(prow_ + PC_W1A + kc_); pw[q][1] = hp_ ? *(const GAS v4u*)(prow_ - NIN_E + PC_W1B + kc_) : z4_; \
              pa[q][0] = *(const GAS v4u*)(prow_ + PC_A1A + kc_); pa[q][1] = hp_ ? *(const GAS v4u*)(prow_ - NIN_E + PC_A1B + kc_) : z4_; } \
          } \
        { const int c_ = 64 * h_ + lane; const size_t row0_ = rowb_ + 8 * wave; const bool hp_ = (64 * n_ + 8 * wave) > 0; \
          _Pragma("unroll") for (int u = 0; u < 9; ++u) { const bf16* pp_ = P + (row0_ + u - 1) * NIN_E; const bool ok_ = u > 0 || hp_; \
              pe[u][0] = ok_ ? (unsigned)pp_[PC_R + c_] : 0u; pe[u][1] = ok_ ? (unsigned)pp_[PC_K + c_] : 0u; pe[u][2] = ok_ ? (unsigned)pp_[PC_V + c_] : 0u; } } } while (0)
    if (bid < NIT) R1_PREFETCH(bid);
#ifdef PROBE_R1
    if (tid == 0 && bid == PROBE_BLOCK) ((LAS unsigned long long*)(lds + LDSCTL_OFF + 640))[0] = __builtin_amdgcn_s_memrealtime();
#endif
    int hcur = -1;
#pragma unroll 1
    for (int it = bid; it < NIT; it += G) {
    R1_STAMP(0);
    const int b = it >> 9, n = (it >> 3) & 63, h = it & 7;
    if (h != hcur) { hcur = h;
        if (wave < 2) { const bf16* W2T = (const bf16*)(A->ws + WS_W2T); const bf16* A2T = (const bf16*)(A->ws + WS_A2T);
#pragma unroll
            for (int q = 0; q < 2; ++q)
#pragma unroll
                for (int c = 0; c < 2; ++c) { const size_t wo = (size_t)(64 * h + 16 * (2 * wave + c) + l15) * 64 + 32 * q + 8 * lg;
                    *(LAS v4u*)(lds + RW_WF + ((((wave * 2 + q) * 2 + c) * 2 + 0) * 64 + lane) * 16) = *(const GAS v4u*)(W2T + wo); *(LAS v4u*)(lds + RW_WF + ((((wave * 2 + q) * 2 + c) * 2 + 1) * 64 + lane) * 16) = *(const GAS v4u*)(A2T + wo); } }
        else if (wave == 2) { const int c = 64 * h + lane; const float* mu = A->in[7] + (size_t)i * 1536; LAS float* CH = (LAS float*)(lds + RW_CH);
            CH[lane] = mu[c]; CH[64 + lane] = mu[512 + c]; CH[128 + lane] = mu[1024 + c];
            CH[192 + lane] = A->in[17][i * 512 + c]; CH[256 + lane] = A->in[18][i * 512 + c]; CH[320 + lane] = A->in[19][i * 512 + c]; CH[384 + lane] = A->in[9][i * 512 + c]; CH[448 + lane] = A->in[12][i * 512 + c]; }
        __syncthreads(); }
    const size_t rowb = (size_t)b * T + 64 * n;
    bf16* item = (bf16*)(A->ws + WS_RWI) + ((size_t)((b * 8 + h) * 64 + n)) * 16384;
    asm volatile("; MARK_R1_E1");
    {
        const LAS unsigned char* WF = lds + RW_WF + (wave & 1) * 8192 + lane * 16;
        f32x4 xw[2], xa[2];
#pragma unroll
        for (int c = 0; c < 2; ++c) { xw[c] = (f32x4){0.f, 0.f, 0.f, 0.f}; xa[c] = (f32x4){0.f, 0.f, 0.f, 0.f}; }
#pragma unroll
        for (int q = 0; q < 2; ++q) {
            float x[8], y[8], v[8];
            unpack8(pw[q][0], x); unpack8(pw[q][1], y);
#pragma unroll
            for (int e = 0; e < 8; ++e) v[e] = tanh_f(x[e] + y[e]);
            const bf16x8_t fw = pack8(v);
            unpack8(pa[q][0], x); unpack8(pa[q][1], y);
#pragma unroll
            for (int e = 0; e < 8; ++e) v[e] = x[e] + y[e];
            const bf16x8_t fa = pack8(v);
#pragma unroll
            for (int c = 0; c < 2; ++c) { xw[c] = mfma16(fw, *(const LAS bf16x8_t*)(WF + ((q * 2 + c) * 2 + 0) * 1024), xw[c]); xa[c] = mfma16(fa, *(const LAS bf16x8_t*)(WF + ((q * 2 + c) * 2 + 1) * 1024), xa[c]); }
        }
        LAS float* XW = (LAS float*)(lds + RW_XW); LAS float* XA = (LAS float*)(lds + RW_XA);
#pragma unroll
        for (int c = 0; c < 2; ++c)
#pragma unroll
            for (int r = 0; r < 4; ++r) { const int o = (16 * rt + 4 * lg + r) * 64 + 16 * (ct0 + c) + l15; XA[o] = xa[c][r]; }
        LAS float* TOT = (LAS float*)(lds + RW_TOT);
#pragma unroll
        for (int c = 0; c < 2; ++c) { const int ch = 16 * (ct0 + c) + l15; const float w0c = ((const LAS float*)(lds + RW_CH))[384 + ch]; float s4 = 0.f;
#pragma unroll
            for (int r = 0; r < 4; ++r) { const float wl = -0.6065306597126334f * sigmoid_f(w0c + xw[c][r]); XW[(16 * rt + 4 * lg + r) * 64 + ch] = wl; s4 += wl; }
            s4 = xsum16(s4);
            if (!(lg & 1)) TOT[(2 * rt + (lg >> 1)) * 64 + ch] = s4; }
    }
    LDS_BARRIER();
    R1_STAMP(1);
    asm volatile("; MARK_R1_E2");
    {
        const LAS float* CH = (const LAS float*)(lds + RW_CH) + lane;
        const float mur = CH[0], muk = CH[64], muv = CH[128], kkc = CH[192], kac = CH[256], rkc = CH[320], w0c = CH[384], a0c = CH[448];
        const LAS float* XW = (const LAS float*)(lds + RW_XW); const LAS float* XA = (const LAS float*)(lds + RW_XA);
        float* BON = (float*)(A->ws + WS_BON);
        const int tt0 = 8 * wave; const size_t row0 = rowb + tt0;
        float pr_p = bflo(pe[0][0]), pk_p = bflo(pe[0][1]), pv_p = bflo(pe[0][2]);
        float rr[8], av[8], bv[8], km[8], vv[8], lc[8], red[16];
        float run = 0.f;
#pragma unroll
        for (int u = 0; u < 8; ++u) {
            const float pR = bflo(pe[u + 1][0]), pK = bflo(pe[u + 1][1]), pV = bflo(pe[u + 1][2]);
            const float r = pR + (pr_p - pR) * mur, k = pK + (pk_p - pK) * muk, v = pV + (pv_p - pV) * muv; pr_p = pR; pk_p = pK; pv_p = pV;
            const float wlog = XW[(tt0 + u) * 64 + lane], xa = a0c + XA[(tt0 + u) * 64 + lane];
            const float as = sigmoid_f(xa);
            const float kk = k * kkc, kmod = k * (1.f + (as - 1.f) * kac);
            red[2 * u] = kk * kk; red[2 * u + 1] = r * kmod * rkc;
            run += wlog; rr[u] = r; av[u] = kk; bv[u] = as; km[u] = kmod; vv[u] = v; lc[u] = run;
        }
        R1_STAMP(7);
        {
#define E2_DPP(x, ctrl) __builtin_bit_cast(float, __builtin_amdgcn_update_dpp(0, __builtin_bit_cast(int, x), ctrl, 0xf, 0xf, true))
            const bool b0 = (lane & 1) != 0, b1 = (lane & 2) != 0; float w8[8], x4[4];
#pragma unroll
            for (int m = 0; m < 8; ++m) { const float keep = b0 ? red[2 * m + 1] : red[2 * m], send = b0 ? red[2 * m] : red[2 * m + 1]; w8[m] = keep + E2_DPP(send, 0xB1); }
#pragma unroll
            for (int m = 0; m < 4; ++m) { const float keep = b1 ? w8[2 * m + 1] : w8[2 * m], send = b1 ? w8[2 * m] : w8[2 * m + 1]; x4[m] = keep + E2_DPP(send, 0x4E); }
#pragma unroll
            for (int m = 0; m < 4; ++m) { x4[m] += E2_DPP(x4[m], 0x114); x4[m] += E2_DPP(x4[m], 0x118);
                x4[m] = xsum32(xsum16(x4[m])); }
#undef E2_DPP
            float bsel = 0.f;
#pragma unroll
            for (int u = 0; u < 8; ++u) {
                const float n2 = __builtin_bit_cast(float, __builtin_amdgcn_readlane(__builtin_bit_cast(int, x4[(2 * u) >> 2]), 12 + ((2 * u) & 3)));
                const float bon = __builtin_bit_cast(float, __builtin_amdgcn_readlane(__builtin_bit_cast(int, x4[(2 * u + 1) >> 2]), 12 + ((2 * u + 1) & 3)));
                const float kk = av[u] * frsq(fmaxf(n2, 1e-24f));
                const float as = bv[u]; av[u] = -kk; bv[u] = kk * as;
                bsel = lane == u ? bon : bsel; }
            if (lane < 8) BON[(row0 + lane) * 8 + h] = bsel;
        }
        R1_STAMP(8);
        const LAS float* TOT = (const LAS float*)(lds + RW_TOT);
        R1_STAMP(9);
        float off = 0.f, tot = 0.f;
#pragma unroll
        for (int w2 = 0; w2 < 8; ++w2) { const float tv = TOT[w2 * 64 + lane]; tot += tv; if (w2 < wave) off += tv; }
        if (wave == 0) ((LAS float*)(lds + RW_GAM))[lane] = fexp(tot);
        float fR[8], fA[8], fB[8], fK[8];
        float eprev = fexp(off);
#pragma unroll
        for (int u = 0; u < 8; ++u) { const float cum = off + lc[u], e1 = fexp(cum), ei = frcp(e1); fR[u] = rr[u] * e1; fA[u] = av[u] * eprev; fB[u] = bv[u] * ei; fK[u] = km[u] * ei; eprev = e1; }
        LAS bf16* At = RBUF(0); LAS bf16* Bt = RBUF(1); LAS bf16* Kt = RBUF(2); LAS bf16* Rt = RBUF(3);
#pragma unroll
        for (int u = 0; u < 8; ++u) { const int o = (tt0 + u) * MS + lane; const unsigned ab_ = cvtpk(fA[u], fB[u]), kr_ = cvtpk(fK[u], fR[u]);
            At[o] = (bf16)(ab_ & 0xffffu); Bt[o] = (bf16)(ab_ >> 16); Kt[o] = (bf16)(kr_ & 0xffffu); Rt[o] = (bf16)(kr_ >> 16); }
        *(LAS bf16x8_t*)(RBUF(4) + lane * MS + tt0) = pack8(fA); *(LAS bf16x8_t*)(RBUF(5) + lane * MS + tt0) = pack8(fB);
        *(LAS bf16x8_t*)(RBUF(6) + lane * MS + tt0) = pack8(fK); *(LAS bf16x8_t*)(RBUF(7) + lane * MS + tt0) = pack8(vv);
    }
    R1_STAMP(10);
    asm volatile("" ::: "memory");
    { const int itn_ = it + G < NIT ? it + G : it; R1_PREFETCH(itn_); }
    R1_STAMP(11);
    LDS_BARRIER();
    R1_STAMP(2);
    asm volatile("; MARK_R1_G");
    {
        const LAS bf16* At = RBUF(0); const LAS bf16* Bt = RBUF(1); const LAS bf16* Kt = RBUF(2); const LAS bf16* Rt = RBUF(3);
        unsigned zu_ = 0u; asm volatile("" : "+v"(zu_));
#define R1_FRAG1(x) __builtin_bit_cast(bf16x8_t, (v4u){cvtpk((x)[0], (x)[1]), cvtpk((x)[2], (x)[3]), zu_, zu_})
#define R1_FRAG2(x, y) __builtin_bit_cast(bf16x8_t, (v4u){cvtpk((x)[0], (x)[1]), cvtpk((x)[2], (x)[3]), cvtpk((y)[0], (y)[1]), cvtpk((y)[2], (y)[3])})
#pragma unroll
        for (int c = 0; c < 2; ++c) { const int ct = ct0 + c; const f32x4 z = (f32x4){0.f, 0.f, 0.f, 0.f};
            f32x4 aL = mm64(z, Bt, rt, At, ct, lane);
            f32x4 aAKT = mm64(z, At, rt, Kt, ct, lane);
            f32x4 aRB = mm64(z, Bt, rt, Rt, ct, lane);
            f32x4 aRK = mm64(z, Kt, rt, Rt, ct, lane);
            const int col = 16 * ct + l15;
#pragma unroll
            for (int r = 0; r < 4; ++r) { const int row = 16 * rt + 4 * lg + r;
                if (!(row < col)) aL[r] = 0.f;
                if (!(col < row)) aAKT[r] = 0.f;
                if (!(row <= col)) { aRB[r] = 0.f; aRK[r] = 0.f; } }
            tstore(RBUF(8), rt, ct, aL, lane); tstore(RBUF(10), rt, ct, aAKT, lane); tstore(RBUF(11), rt, ct, aRB, lane); tstore(RBUF(12), rt, ct, aRK, lane);
            if (rt == ct) {
                f32x4 Mx = mm64(z, At, rt, Bt, ct, lane), MTx = aL, YT;
#pragma unroll
                for (int r = 0; r < 4; ++r) { if (!(l15 < 4 * lg + r)) Mx[r] = 0.f; YT[r] = (4 * lg + r) == l15 ? 1.f : 0.f; }
#pragma unroll
                for (int m = 0; m < 4; ++m) { const bf16x8_t fM = R1_FRAG1(Mx), fMT = R1_FRAG1(MTx), fY = R1_FRAG1(YT);
                    YT = mfma16(fM, fY, YT);
                    if (m < 3) { Mx = mfma16(fMT, fM, z); MTx = mfma16(fM, fMT, z); } }
                ((LAS v2u*)(lds + 9 * MB))[rt * 64 + lane] = pack4(YT);
            }
        }
    }
    LDS_BARRIER();
    R1_STAMP(3);
    asm volatile("; MARK_R1_N");
    {
        const int cw = wave & 3; const bool second = wave >= 4;
        const LAS bf16* RT = (second ? RBUF(10) : RBUF(4)) + (16 * cw + l15) * MS + 4 * lg;
        const LAS bf16* Lr = RBUF(8) + l15 * MS + 4 * lg;
        const LAS v2u* DFp = (const LAS v2u*)(lds + 9 * MB) + lane;
        unsigned zu_ = 0u; asm volatile("" : "+v"(zu_));
        const f32x4 z = (f32x4){0.f, 0.f, 0.f, 0.f};
        f32x4 R[4]; v2u df[4], l10, l20a, l20b, l30a, l30b, l32;
#pragma unroll
        for (int b4 = 0; b4 < 4; ++b4) { R[b4] = ld4bf(RT + 16 * b4); df[b4] = DFp[b4 * 64]; }
        l10 = *(const LAS v2u*)(Lr + 16 * MS);
        l20a = *(const LAS v2u*)(Lr + 32 * MS); l20b = *(const LAS v2u*)(Lr + 32 * MS + 16);
        l30a = *(const LAS v2u*)(Lr + 48 * MS); l30b = *(const LAS v2u*)(Lr + 48 * MS + 16); l32 = *(const LAS v2u*)(Lr + 48 * MS + 32);
#define R1_DF(b4) __builtin_bit_cast(bf16x8_t, (v4u){df[b4].x, df[b4].y, zu_, zu_})
#define R1_LF(a, b) __builtin_bit_cast(bf16x8_t, (v4u){(a).x, (a).y, (b).x, (b).y})
        const v2u zz2 = (v2u){zu_, zu_};
        f32x4 Z0, Z1, Z2, Z3, acc;
        Z0 = mfma16(R1_DF(0), R1_FRAG1(R[0]), z);
        acc = mfma16(R1_LF(l10, zz2), R1_FRAG1(Z0), R[1]); Z1 = mfma16(R1_DF(1), R1_FRAG1(acc), z);
        acc = mfma16(R1_LF(l20a, l20b), R1_FRAG2(Z0, Z1), R[2]); Z2 = mfma16(R1_DF(2), R1_FRAG1(acc), z);
        acc = mfma16(R1_LF(l30a, l30b), R1_FRAG2(Z0, Z1), R[3]); acc = mfma16(R1_LF(l32, zz2), R1_FRAG1(Z2), acc); Z3 = mfma16(R1_DF(3), R1_FRAG1(acc), z);
        if (!second) {
            LAS bf16* O = RBUF(13) + (16 * cw + l15) * MS + 4 * lg;
            *(LAS v2u*)(O) = pack4(Z0); *(LAS v2u*)(O + 16) = pack4(Z1); *(LAS v2u*)(O + 32) = pack4(Z2); *(LAS v2u*)(O + 48) = pack4(Z3);
        } else {
            LAS bf16* O = RBUF(1) + (4 * lg) * MS + 16 * cw + l15;
#define R1_ST4(Zx, b4) do { const v2u w_ = pack4(Zx); O[(16 * (b4) + 0) * MS] = (bf16)(w_.x & 0xffffu); O[(16 * (b4) + 1) * MS] = (bf16)(w_.x >> 16); O[(16 * (b4) + 2) * MS] = (bf16)(w_.y & 0xffffu); O[(16 * (b4) + 3) * MS] = (bf16)(w_.y >> 16); } while (0)
            R1_ST4(Z0, 0); R1_ST4(Z1, 1); R1_ST4(Z2, 2); R1_ST4(Z3, 3);
#undef R1_ST4
        }
#undef R1_DF
#undef R1_LF
    }
#undef R1_FRAG1
#undef R1_FRAG2
    LDS_BARRIER();
    R1_STAMP(4);
    asm volatile("; MARK_R1_F1");
    {
    {
#pragma unroll
        for (int c = 0; c < 2; ++c) { const int ct = ct0 + c; const f32x4 z = (f32x4){0.f, 0.f, 0.f, 0.f};
            tstore(RBUF(0), rt, ct, mm64(z, RBUF(1), rt, RBUF(7), ct, lane), lane); }
    }
    LDS_BARRIER();
    R1_STAMP(5);
    {
        const LAS float* GAM = (const LAS float*)(lds + RW_GAM);
        const int rp = wave >> 2, cf = wave & 3; const f32x4 z = (f32x4){0.f, 0.f, 0.f, 0.f};
        f32x4 rh[2], pp[2], y0[2], q[2];
#pragma unroll
        for (int e = 0; e < 2; ++e) { const int rf = 2 * rp + e;
            const f32x4 r0 = ld4bf(RBUF(3) + (16 * cf + l15) * MS + 16 * rf + 4 * lg);
            rh[e] = mm64(r0, RBUF(13), rf, RBUF(11), cf, lane);
            pp[e] = mm64(z, RBUF(13), rf, RBUF(5), cf, lane);
            const float gm = GAM[16 * cf + l15];
#pragma unroll
            for (int r = 0; r < 4; ++r) pp[e][r] = gm * (pp[e][r] + ((16 * rf + 4 * lg + r) == (16 * cf + l15) ? 1.f : 0.f));
            y0[e] = mm64(z, RBUF(0), rf, RBUF(11), cf, lane); y0[e] = mm64(y0[e], RBUF(7), rf, RBUF(12), cf, lane);
            q[e] = mm64(z, RBUF(5), rf, RBUF(0), cf, lane); q[e] = mm64(q[e], RBUF(6), rf, RBUF(7), cf, lane);
            q[e] = q[e] * *(const LAS f32x4*)(GAM + 16 * rf + 4 * lg); }
        { const v2u a = pack4(pp[0]), b2 = pack4(pp[1]); *(GAS v4u*)(item + 8192 + ((cf * 2 + rp) * 64 + lane) * 8) = (v4u){a.x, a.y, b2.x, b2.y}; }
        { const v2u a = pack4(q[0]), b2 = pack4(q[1]); *(GAS v4u*)(item + 12288 + ((cf * 2 + rp) * 64 + lane) * 8) = (v4u){a.x, a.y, b2.x, b2.y}; }
        { const int co = 32 * rp + 16 * (lg & 1) + 4 * (lg & 2); bf16* dr = item + (16 * cf + l15) * 64 + co;
          { const v2u a = pack4(rh[0]), b2 = pack4(rh[1]); const auto s0 = __builtin_amdgcn_permlane16_swap(a.x, b2.x, false, false); const auto s1 = __builtin_amdgcn_permlane16_swap(a.y, b2.y, false, false);
            *(GAS v4u*)(dr) = (v4u){s0[0], s1[0], s0[1], s1[1]}; }
          { const v2u a = pack4(y0[0]), b2 = pack4(y0[1]); const auto s0 = __builtin_amdgcn_permlane16_swap(a.x, b2.x, false, false); const auto s1 = __builtin_amdgcn_permlane16_swap(a.y, b2.y, false, false);
            *(GAS v4u*)(dr + 4096) = (v4u){s0[0], s1[0], s0[1], s1[1]}; } }
    }
    LDS_BARRIER();
    R1_STAMP(6);
    }
    }
#ifdef PROBE_R1
    if (tid == 0 && bid == PROBE_BLOCK) { const LAS unsigned long long* t_ = (const LAS unsigned long long*)(lds + LDSCTL_OFF + 640); unsigned long long* g_ = (unsigned long long*)((unsigned*)(A->ws + WS_CTL) + 32768) + 48;
        for (int k = 0; k < 12; ++k) g_[k] = t_[1 + k]; }
#endif
#undef R1_PREFETCH
}

constexpr int R2_NS = 8, R2_STB = 16384;
static_assert(R2_NS * R2_STB <= RING_BYTES, "scan ring");
__device__ __forceinline__ void rwkv_state_scan(ArgP A, int b, int h, LAS unsigned char* lds, int wave, int lane) {
    const int l15 = lane & 15, lg = lane >> 4, dw = wave & 3;
    unsigned char* item0 = (unsigned char*)(A->ws + WS_RWI) + ((size_t)((b * 8 + h) * 64)) * 32768;
#define R2_DMA(nn) do { const unsigned char* g_ = item0 + (size_t)(nn) * 32768 + 16384 + dw * 4096 + lane * 16; LAS unsigned char* s_ = lds + ((nn) & (R2_NS - 1)) * R2_STB + dw * 4096; \
        _Pragma("unroll") for (int p = 0; p < 4; ++p) __builtin_amdgcn_global_load_lds((const unsigned*)(g_ + p * 1024), (LAS unsigned*)(s_ + p * 1024), 16, 0, 0); } while (0)
    if (wave >= 4) {
#pragma unroll
        for (int n = 0; n < R2_NS - 1; ++n) R2_DMA(n); }
    f32x4 S[4]; float zz_ = 0.f; asm volatile("" : "+v"(zz_));
#pragma unroll
    for (int t = 0; t < 4; ++t) S[t] = (f32x4){zz_, zz_, zz_, zz_};
#pragma unroll 1
    for (int n = 0; n < 64; ++n) {
        if (wave >= 4) { if (n <= 64 - (R2_NS - 1)) asm volatile("s_waitcnt vmcnt(24)" ::: "memory"); else asm volatile("s_waitcnt vmcnt(0)" ::: "memory"); }
        __builtin_amdgcn_s_barrier();
#ifdef PROBE_R2HALF
        if (n == PROBE_R2HALF && b == 0 && h == 0 && wave == 0 && lane == 0) { unsigned long long* t_ = (unsigned long long*)((unsigned*)(A->ws + WS_CTL) + 32768) + 41; if (*t_ == 0ull) *t_ = __builtin_amdgcn_s_memrealtime(); }
#endif
        if (wave >= 4) { if (n + R2_NS - 1 < 64) R2_DMA(n + R2_NS - 1); }
        else {
            const LAS unsigned char* st = lds + (n & (R2_NS - 1)) * R2_STB;
            v4u pf[8]; v2u qv[4];
#pragma unroll
            for (int f = 0; f < 8; ++f) pf[f] = *(const LAS v4u*)(st + (f * 64 + lane) * 16);
#pragma unroll
            for (int rp2 = 0; rp2 < 2; ++rp2) { const v4u w_ = *(const LAS v4u*)(st + 8192 + ((dw * 2 + rp2) * 64 + lane) * 16); qv[2 * rp2] = (v2u){w_.x, w_.y}; qv[2 * rp2 + 1] = (v2u){w_.z, w_.w}; }
            unsigned pk[4][2];
#pragma unroll
            for (int t = 0; t < 4; ++t) { pk[t][0] = cvtpk(S[t][0], S[t][1]); pk[t][1] = cvtpk(S[t][2], S[t][3]); }
            bf16* SN = (bf16*)(item0 + (size_t)n * 32768 + 24576);
#pragma unroll
            for (int k2 = 0; k2 < 2; ++k2) { const auto s0 = __builtin_amdgcn_permlane16_swap(pk[2 * k2][0], pk[2 * k2 + 1][0], false, false); const auto s1 = __builtin_amdgcn_permlane16_swap(pk[2 * k2][1], pk[2 * k2 + 1][1], false, false);
                *(GAS v4u*)(SN + ((dw * 2 + k2) * 64 + (2 * (lg & 1) + (lg >> 1)) * 16 + l15) * 8) = (v4u){s0[0], s1[0], s0[1], s1[1]}; }
            const bf16x8_t b0 = __builtin_bit_cast(bf16x8_t, (v4u){pk[0][0], pk[0][1], pk[1][0], pk[1][1]}), b1 = __builtin_bit_cast(bf16x8_t, (v4u){pk[2][0], pk[2][1], pk[3][0], pk[3][1]});
#pragma unroll
            for (int t = 0; t < 4; ++t) { f32x4 acc = (f32x4){bflo(qv[t].x), bfhi(qv[t].x), bflo(qv[t].y), bfhi(qv[t].y)};
                acc = mfma16(__builtin_bit_cast(bf16x8_t, pf[2 * t]), b0, acc); acc = mfma16(__builtin_bit_cast(bf16x8_t, pf[2 * t + 1]), b1, acc); S[t] = acc; }
        }
    }
#undef R2_DMA
}

#ifdef PROBE_R3
#define R3_STAMP(k) do { asm volatile("" ::: "memory"); if (wave == 0 && lane == 0 && bid == PROBE_BLOCK) { LAS unsigned long long* t_ = (LAS unsigned long long*)(lds + LDSCTL_OFF + 640); const unsigned long long now_ = __builtin_amdgcn_s_memrealtime(); t_[1 + (k)] += now_ - t_[0]; t_[0] = now_; } asm volatile("" ::: "memory"); } while (0)
#else
#define R3_STAMP(k) do { } while (0)
#endif
__device__ __forceinline__ void rwkv_out_phase(ArgP A, int L, LAS unsigned char* lds, int bid, int G, int wave, int lane) {
    const int i = L >> 1, l15 = lane & 15, lg = lane >> 4, h = wave;
    const bf16* P = (const bf16*)(A->ws + WS_P); bf16* XNb = (bf16*)(A->ws + WS_XN); const float* BON = (const float*)(A->ws + WS_BON);
    v4u g2f[5][4]; LAS float* prm = (LAS float*)lds + wave * 192;
    const int ca = 8 * (l15 >> 2) + (l15 & 3);
    { const bf16* G2T = (const bf16*)(A->ws + WS_G2T) + (size_t)(64 * h + ca) * 192 + 8 * lg;
#pragma unroll
      for (int q = 0; q < 5; ++q)
#pragma unroll
          for (int it = 0; it < 4; ++it) g2f[q][it] = *(const GAS v4u*)(G2T + (size_t)(32 * (it >> 1) + 4 * (it & 1)) * 192 + 32 * q);
      const float* lnw = A->in[20] + i * 512 + 64 * h; const float* lnb = A->in[21] + i * 512 + 64 * h; const float* mu = A->in[7] + (size_t)i * 1536 + 1024 + 64 * h;
      prm[lane] = lnw[lane]; prm[64 + lane] = lnb[lane]; prm[128 + lane] = mu[lane]; }
#ifdef PROBE_R3
    if (wave == 0 && lane == 0 && bid == PROBE_BLOCK) ((LAS unsigned long long*)(lds + LDSCTL_OFF + 640))[0] = __builtin_amdgcn_s_memrealtime();
#endif
#pragma unroll 1
    for (int task = bid; task < BATCH * 64; task += G) {
    const int b = task >> 6, n = task & 63;
    const bf16* item = (const bf16*)(A->ws + WS_RWI) + ((size_t)((b * 8 + h) * 64 + n)) * 16384;
    const bf16* RH = item; const bf16* Y0 = item + 4096; const bf16* ST = item + 12288;
    v4u stf[8];
#pragma unroll
    for (int f = 0; f < 8; ++f) { const int it = f >> 1, ch = 32 * (it >> 1) + 4 * (it & 1) + ca; stf[f] = *(const GAS v4u*)(ST + ((((ch >> 4) * 2 + (f & 1)) * 64) + lg * 16 + (ch & 15)) * 8); }
#pragma unroll 1
    for (int ct = 0; ct < 4; ++ct) {
    R3_STAMP(0);
    asm volatile("; MARK_R3_CT");
    const size_t row = (size_t)b * T + 64 * n + 16 * ct + l15; const int tseq = 64 * n + 16 * ct + l15;
    const bf16x8_t rf0 = *(const GAS bf16x8_t*)(RH + (16 * ct + l15) * 64 + 8 * lg), rf1 = *(const GAS bf16x8_t*)(RH + (16 * ct + l15) * 64 + 32 + 8 * lg);
    const bf16* prow = P + row * NIN_E; v4u gx[5], gy[5];
#pragma unroll
    for (int q = 0; q < 5; ++q) { gx[q] = *(const GAS v4u*)(prow + PC_G1A + 32 * q + 8 * lg); gy[q] = tseq > 0 ? *(const GAS v4u*)(prow - NIN_E + PC_G1B + 32 * q + 8 * lg) : (v4u){0u, 0u, 0u, 0u}; }
    const bf16* pr = prow + PC_V + 64 * h + 8 * lg; v4u pvr[2], pvq[2], y0r[2];
#pragma unroll
    for (int p2 = 0; p2 < 2; ++p2) { pvr[p2] = *(const GAS v4u*)(pr + 32 * p2); pvq[p2] = tseq > 0 ? *(const GAS v4u*)(pr - NIN_E + 32 * p2) : (v4u){0u, 0u, 0u, 0u}; y0r[p2] = *(const GAS v4u*)(Y0 + (16 * ct + l15) * 64 + 32 * p2 + 8 * lg); }
    const float bon = BON[row * 8 + h];
    R3_STAMP(1);
#ifdef PROBE_R3
    asm volatile("s_waitcnt vmcnt(0)" ::: "memory");
#endif
    R3_STAMP(2);
    int po_ = 4 * lg; asm volatile("" : "+v"(po_));
    f32x4 acc[4]; float s1 = 0.f;
#pragma unroll
    for (int it = 0; it < 4; ++it) {
        const unsigned yx = (it & 1) ? y0r[it >> 1].z : y0r[it >> 1].x, yy = (it & 1) ? y0r[it >> 1].w : y0r[it >> 1].y;
        f32x4 a = (f32x4){bflo(yx), bfhi(yx), bflo(yy), bfhi(yy)};
        a = mfma16(__builtin_bit_cast(bf16x8_t, stf[it * 2 + 0]), rf0, a);
        a = mfma16(__builtin_bit_cast(bf16x8_t, stf[it * 2 + 1]), rf1, a);
        acc[it] = a; s1 += (a[0] + a[1]) + (a[2] + a[3]);
    }
    s1 = xsum32(xsum16(s1));
    const float mean = s1 * (1.f / 64.f); float s2 = 0.f;
#pragma unroll
    for (int it = 0; it < 4; ++it) { acc[it] = acc[it] - mean; s2 += (acc[it][0] * acc[it][0] + acc[it][1] * acc[it][1]) + (acc[it][2] * acc[it][2] + acc[it][3] * acc[it][3]); }
    s2 = xsum32(xsum16(s2));
    const float rs = frsq(s2 * (1.f / 64.f) + 64e-5f);
    f32x4 gq[4] = {(f32x4){0.f, 0.f, 0.f, 0.f}, (f32x4){0.f, 0.f, 0.f, 0.f}, (f32x4){0.f, 0.f, 0.f, 0.f}, (f32x4){0.f, 0.f, 0.f, 0.f}};
#pragma unroll
    for (int q = 0; q < 5; ++q) { float x[8], y[8], v[8]; unpack8(gx[q], x); unpack8(gy[q], y);
#pragma unroll
        for (int e = 0; e < 8; ++e) v[e] = sigmoid_f(x[e] + y[e]);
        const bf16x8_t fg = pack8(v);
#pragma unroll
        for (int it = 0; it < 4; ++it) gq[it] = mfma16(__builtin_bit_cast(bf16x8_t, g2f[q][it]), fg, gq[it]); }
    R3_STAMP(3);
#pragma unroll
    for (int p2 = 0; p2 < 2; ++p2) { v2u ow[2];
#pragma unroll
        for (int e = 0; e < 2; ++e) { const int it = 2 * p2 + e; const int i0 = 32 * p2 + 4 * e + 2 * po_;
            const unsigned vx = e ? pvr[p2].z : pvr[p2].x, vy = e ? pvr[p2].w : pvr[p2].y, qx = e ? pvq[p2].z : pvq[p2].x, qy = e ? pvq[p2].w : pvq[p2].y;
            const f32x4 pv = (f32x4){bflo(vx), bfhi(vx), bflo(vy), bfhi(vy)}, pvp = (f32x4){bflo(qx), bfhi(qx), bflo(qy), bfhi(qy)};
            const f32x4 w4 = *(const LAS f32x4*)(prm + i0), b4 = *(const LAS f32x4*)(prm + 64 + i0), m4 = *(const LAS f32x4*)(prm + 128 + i0);
            const f32x4 v4 = pv + (pvp - pv) * m4;
            const f32x4 o = ((acc[it] * rs) * w4 + b4 + v4 * bon) * gq[it];
            ow[e] = pack4(o); }
        *(GAS v4u*)(XNb + row * D + 64 * h + 32 * p2 + 8 * lg) = (v4u){ow[0].x, ow[0].y, ow[1].x, ow[1].y}; }
    asm volatile("; MARK_R3_END");
    }
    }
#ifdef PROBE_R3
    if (wave == 0 && lane == 0 && bid == PROBE_BLOCK) { const LAS unsigned long long* t_ = (const LAS unsigned long long*)(lds + LDSCTL_OFF + 640); unsigned long long* g_ = (unsigned long long*)((unsigned*)(A->ws + WS_CTL) + 32768) + 48;
        for (int k = 0; k < 4; ++k) g_[k] = t_[1 + k]; }
#endif
}
constexpr size_t WS_GKV = 464 * MiB;
constexpr size_t WS_GDEC = 29 * MiB + 512 * 1024;
constexpr int GL_LA = 0, GL_KR = 16384, GL_VT = GL_KR + MB, GL_TOT = GL_VT + 2 * MB, GL1_END = GL_TOT + 2048;
static_assert(GL1_END <= RING_BYTES, "GLA LDS map");

template <int NCT> __device__ __forceinline__ void gla_lora_tiles(ArgP A, size_t rowb, int h4, int rt, int ct0, LAS float* LAs, int lane) {
    const int l15 = lane & 15, lg = lane >> 4;
    const bf16* P = (const bf16*)(A->ws + WS_P); const bf16* WA2T = (const bf16*)(A->ws + WS_WA2T);
    v4u av = (v4u){0u, 0u, 0u, 0u};
    if (lg < 2) av = *(const GAS v4u*)(P + (rowb + 16 * rt + l15) * NIN_E + PC_WA1 + 8 * lg);
    const bf16x8_t af = __builtin_bit_cast(bf16x8_t, av);
#pragma unroll
    for (int c = 0; c < NCT; ++c) { const int ct = ct0 + c;
        const f32x4 x = mfma16(af, *(const GAS bf16x8_t*)(WA2T + (size_t)(64 * h4 + 16 * ct + l15) * 32 + 8 * lg), (f32x4){0.f, 0.f, 0.f, 0.f});
#pragma unroll
        for (int r = 0; r < 4; ++r) LAs[(16 * rt + 4 * lg + r) * 64 + 16 * ct + l15] = x[r]; }
}

constexpr int GL_QS = GL1_END, GL_KS = GL_QS + 8192, GL_VS = GL_KS + 8192, GL1B_END = GL_VS + 16384;
static_assert(GL1B_END <= RING_BYTES, "GLA phase-1 staging");
__device__ __forceinline__ void gla_kv_phase(ArgP A, int L, LAS unsigned char* lds, int tid, int G, int bid) {
    const int lane = tid & 63, wave = __builtin_amdgcn_readfirstlane(tid >> 6), i = L >> 1, l15 = lane & 15, lg = lane >> 4;
    bf16* P = (bf16*)(A->ws + WS_P);
    LAS float* LAs = (LAS float*)(lds + GL_LA); LAS bf16* KrT = (LAS bf16*)(lds + GL_KR); LAS bf16* VTm = (LAS bf16*)(lds + GL_VT); LAS float* TOT = (LAS float*)(lds + GL_TOT);
    LAS bf16* QS = (LAS bf16*)(lds + GL_QS); LAS bf16* KS = (LAS bf16*)(lds + GL_KS); LAS bf16* VS = (LAS bf16*)(lds + GL_VS);
    constexpr int NIT = BATCH * 64 * 4;
    const int r8 = lane >> 3, c8 = lane & 7, tt0 = 8 * wave;
    v4u gq_, gk_, gv0_, gv1_, pav;
#define G1_PREFETCH(itx) do { const int b_ = (itx) >> 8, n_ = ((itx) >> 2) & 63, h4_ = (itx) & 3; const size_t rowb_ = (size_t)b_ * T + 64 * n_; \
        const bf16* pq_ = P + (rowb_ + tt0 + r8) * NIN_E + 64 * h4_ + 8 * c8; gq_ = *(const GAS v4u*)(pq_ + PC_GQ); gk_ = *(const GAS v4u*)(pq_ + PC_GK); \
        const bf16* pv_ = P + (rowb_ + tt0 + lg) * NIN_E + PC_GV + 128 * h4_ + 8 * l15; gv0_ = *(const GAS v4u*)pv_; gv1_ = *(const GAS v4u*)(pv_ + 4 * NIN_E); \
        pav = (v4u){0u, 0u, 0u, 0u}; if (lg < 2) pav = *(const GAS v4u*)(P + (rowb_ + 16 * (wave >> 1) + l15) * NIN_E + PC_WA1 + 8 * lg); } while (0)
    if (bid < NIT) G1_PREFETCH(bid);
    int hcur = -1; bf16x8_t wa2f[2]; float bac = 0.f;
#pragma unroll 1
    for (int it = bid; it < NIT; it += G) {
    const int b = it >> 8, n = (it >> 2) & 63, h4 = it & 3;
    const size_t rowb = (size_t)b * T + 64 * n; const int itemi = (b * 64 + n) * 4 + h4;
    if (h4 != hcur) { hcur = h4; const bf16* WA2T = (const bf16*)(A->ws + WS_WA2T);
#pragma unroll
        for (int c = 0; c < 2; ++c) wa2f[c] = *(const GAS bf16x8_t*)(WA2T + (size_t)(64 * h4 + 16 * (2 * (wave & 1) + c) + l15) * 32 + 8 * lg);
        bac = A->in[24][i * 256 + 64 * h4 + lane]; }
    *(LAS v4u*)(QS + (tt0 + r8) * 64 + 8 * c8) = gq_; *(LAS v4u*)(KS + (tt0 + r8) * 64 + 8 * c8) = gk_;
    *(LAS v4u*)(VS + (tt0 + lg) * 128 + 8 * l15) = gv0_; *(LAS v4u*)(VS + (tt0 + 4 + lg) * 128 + 8 * l15) = gv1_;
    {
        const int rt = wave >> 1; const bf16x8_t af = __builtin_bit_cast(bf16x8_t, pav);
#pragma unroll
        for (int c = 0; c < 2; ++c) { const int ct = 2 * (wave & 1) + c;
            const f32x4 x = mfma16(af, wa2f[c], (f32x4){0.f, 0.f, 0.f, 0.f});
#pragma unroll
            for (int r = 0; r < 4; ++r) LAs[(16 * rt + 4 * lg + r) * 64 + 16 * ct + l15] = x[r]; }
    }
    LDS_BARRIER();
    { const int itn_ = it + G < NIT ? it + G : it; G1_PREFETCH(itn_); }
    {
        const int c = 64 * h4 + lane;
        float lc[8], kx[8], qx[8], v0[8], v1[8]; float run = 0.f;
#pragma unroll
        for (int u = 0; u < 8; ++u) { const float x = bac + LAs[(tt0 + u) * 64 + lane];
            run += -softplus_f(-x) * (1.0f / 16.0f); lc[u] = run; kx[u] = bf2f(KS[(tt0 + u) * 64 + lane]); qx[u] = bf2f(QS[(tt0 + u) * 64 + lane]); v0[u] = bf2f(VS[(tt0 + u) * 128 + lane]); v1[u] = bf2f(VS[(tt0 + u) * 128 + 64 + lane]); }
        TOT[wave * 64 + lane] = run;
        LDS_BARRIER();
        float off = 0.f, tot = 0.f;
#pragma unroll
        for (int w2 = 0; w2 < 8; ++w2) { const float tv = TOT[w2 * 64 + lane]; tot += tv; if (w2 < wave) off += tv; }
        if (wave == 0) ((float*)(A->ws + WS_GDEC))[itemi * 64 + lane] = fexp(tot);
        { const float etot = fexp(tot);
#pragma unroll
          for (int u = 0; u < 8; ++u) { const float cum = off + lc[u], e1 = fexp(cum), kt = kx[u] * frcp(e1);
              const unsigned qk_ = cvtpk(qx[u] * 0.125f * e1, kt);
              QS[(tt0 + u) * 64 + lane] = (bf16)(qk_ & 0xffffu); KS[(tt0 + u) * 64 + lane] = (bf16)(qk_ >> 16); kx[u] = kt * etot; } }
        *(LAS bf16x8_t*)(KrT + lane * MS + tt0) = pack8(kx); *(LAS bf16x8_t*)(VTm + lane * MS + tt0) = pack8(v0); *(LAS bf16x8_t*)(VTm + (64 + lane) * MS + tt0) = pack8(v1);
        (void)c;
    }
    LDS_WAIT();
    { bf16* pq = P + (rowb + tt0 + r8) * NIN_E + 64 * h4 + 8 * c8;
      *(GAS v4u*)(pq + PC_GQ) = *(const LAS v4u*)(QS + (tt0 + r8) * 64 + 8 * c8); *(GAS v4u*)(pq + PC_GK) = *(const LAS v4u*)(KS + (tt0 + r8) * 64 + 8 * c8); }
    LDS_BARRIER();
    {
        bf16* KVg = (bf16*)(A->ws + WS_GKV) + (size_t)itemi * 8192; const int rt = wave >> 1;
#pragma unroll
        for (int c = 0; c < 4; c += 2) { const int et = 4 * (wave & 1) + c;
            const v2u a = pack4(mm64((f32x4){0.f, 0.f, 0.f, 0.f}, KrT, rt, VTm, et, lane)), b2 = pack4(mm64((f32x4){0.f, 0.f, 0.f, 0.f}, KrT, rt, VTm, et + 1, lane));
            const auto s0 = __builtin_amdgcn_permlane16_swap(a.x, b2.x, false, false); const auto s1 = __builtin_amdgcn_permlane16_swap(a.y, b2.y, false, false);
            *(GAS v4u*)(KVg + (16 * (et + (lg & 1)) + l15) * 64 + 16 * rt + 4 * (lg & 2)) = (v4u){s0[0], s1[0], s0[1], s1[1]}; }
    }
    LDS_BARRIER();
    }
#undef G1_PREFETCH
}

__device__ __forceinline__ void gla_state_scan(ArgP A, int gt, bool do_store = true) {
    const int bh = gt >> 11, grp = gt & 2047;
    const int b = bh >> 2, h4 = bh & 3;
    bf16* base = (bf16*)(A->ws + WS_GKV) + (size_t)((b * 64) * 4 + h4) * 8192 + (size_t)grp * 4;
    const float* dec = (const float*)(A->ws + WS_GDEC) + (size_t)((b * 64) * 4 + h4) * 64 + (grp & 15) * 4;
    f32x4 S = (f32x4){0.f, 0.f, 0.f, 0.f};
#pragma unroll 1
    for (int n0 = 0; n0 < 64; n0 += 8) {
        v2u kv[8]; f32x4 dc[8];
#pragma unroll
        for (int u = 0; u < 8; ++u) { kv[u] = *(const GAS v2u*)(base + (size_t)(n0 + u) * 4 * 8192); dc[u] = *(const GAS f32x4*)(dec + (size_t)(n0 + u) * 4 * 64); }
#pragma unroll
        for (int u = 0; u < 8; ++u) { if (do_store) *(GAS v2u*)(base + (size_t)(n0 + u) * 4 * 8192) = pack4(S);
            S = S * dc[u] + (f32x4){bflo(kv[u].x), bfhi(kv[u].x), bflo(kv[u].y), bfhi(kv[u].y)}; }
    }
}

constexpr int G3B_SV = 272, G3B_VT = 0, G3B_SC = 64 * G3B_SV, G3B_GRP = G3B_SC + MB;
static_assert(2 * G3B_GRP <= RING_BYTES, "GLA phase-3 LDS map");
__device__ __forceinline__ void gla_out_phase(ArgP A, int L, LAS unsigned char* lds, int tid, int G, int bid) {
    const int lane = tid & 63, wave = __builtin_amdgcn_readfirstlane(tid >> 6), i = L >> 1, l15 = lane & 15, lg = lane >> 4;
    const int gi = wave >> 2, wq = wave & 3;
    const bf16* P = (const bf16*)(A->ws + WS_P); bf16* XNb = (bf16*)(A->ws + WS_XN);
    LAS unsigned char* gb = lds + gi * G3B_GRP; LAS bf16* SC = (LAS bf16*)(gb + G3B_SC);
    const int ct = wq; const int col = 16 * ct + l15;
    int hcur = -1; f32x4 gn4[8];
#pragma unroll 1
    for (int item2 = bid; item2 < BATCH * 64 * 4 / 2; item2 += G) {
    const int itemi = 2 * item2 + gi, h4 = itemi & 3, n = (itemi >> 2) & 63, b = itemi >> 8;
    const size_t rowb = (size_t)b * T + 64 * n;
    if (h4 != hcur) { hcur = h4; const float* gn = A->in[25] + i * 512 + 128 * h4;
#pragma unroll
        for (int et = 0; et < 8; ++et) gn4[et] = *(const GAS f32x4*)(gn + 32 * (et >> 1) + 8 * lg + 4 * (et & 1)); }
    v4u vreg[4];
    { const int t4 = tid & 255;
#pragma unroll
      for (int q = 0; q < 4; ++q) { const int id = t4 + 256 * q, row = id >> 4, ch = id & 15; vreg[q] = *(const GAS v4u*)(P + (rowb + row) * NIN_E + PC_GV + 128 * h4 + 8 * ch); } }
    const bf16* qrow = P + (rowb + col) * NIN_E + PC_GQ + 64 * h4 + 8 * lg;
    const bf16x8_t qf0 = *(const GAS bf16x8_t*)qrow, qf1 = *(const GAS bf16x8_t*)(qrow + 32);
    v4u kf[4][2];
#pragma unroll
    for (int rt = 0; rt < 4; ++rt) { const bf16* krow = P + (rowb + 16 * rt + l15) * NIN_E + PC_GK + 64 * h4 + 8 * lg;
        if (rt <= ct) { kf[rt][0] = *(const GAS v4u*)krow; kf[rt][1] = *(const GAS v4u*)(krow + 32); } else { kf[rt][0] = (v4u){0u, 0u, 0u, 0u}; kf[rt][1] = (v4u){0u, 0u, 0u, 0u}; } }
    const bf16* Sg = (const bf16*)(A->ws + WS_GKV) + (size_t)itemi * 8192;
    v4u sgf[8][2];
#pragma unroll
    for (int et = 0; et < 8; ++et) { const int er = 32 * (et >> 1) + 4 * (et & 1) + 8 * (l15 >> 2) + (l15 & 3); sgf[et][0] = *(const GAS v4u*)(Sg + er * 64 + 8 * lg); sgf[et][1] = *(const GAS v4u*)(Sg + er * 64 + 32 + 8 * lg); }
    const size_t row = rowb + col; v4u ggr[4];
#pragma unroll
    for (int p2 = 0; p2 < 4; ++p2) ggr[p2] = *(const GAS v4u*)(P + row * NIN_E + PC_GG + 128 * h4 + 32 * p2 + 8 * lg);
    { const int t4 = tid & 255;
#pragma unroll
      for (int q = 0; q < 4; ++q) { const int id = t4 + 256 * q, vrow = id >> 4, ch = id & 15; *(LAS v4u*)(gb + G3B_VT + vrow * G3B_SV + ch * 16) = vreg[q]; } }
#pragma unroll
    for (int rt = 0; rt < 4; ++rt) { f32x4 acc = (f32x4){0.f, 0.f, 0.f, 0.f};
        if (rt <= ct) {
            acc = mfma16(__builtin_bit_cast(bf16x8_t, kf[rt][0]), qf0, acc); acc = mfma16(__builtin_bit_cast(bf16x8_t, kf[rt][1]), qf1, acc);
#pragma unroll
            for (int r = 0; r < 4; ++r) if (!((16 * rt + 4 * lg + r) <= col)) acc[r] = 0.f; }
        tstore(SC, rt, ct, acc, lane); }
    __syncthreads();
    const int vto = G3B_VT + (8 * lg + (l15 >> 2)) * G3B_SV + 8 * (lane & 3) * 2;
    f32x4 o[8]; float ss = 0.f;
#pragma unroll
    for (int et = 0; et < 8; ++et) { f32x4 acc = (f32x4){0.f, 0.f, 0.f, 0.f};
#pragma unroll
        for (int ks = 0; ks < 2; ++ks) { const LAS unsigned char* vp = gb + vto + ks * 32 * G3B_SV + (et >> 1) * 64 + (et & 1) * 8;
            const a_s16x4 lo4 = __builtin_bit_cast(a_s16x4, __builtin_amdgcn_ds_read_tr16_b64_v4i16((LAS a_s16x4*)vp));
            const a_s16x4 hi4 = __builtin_bit_cast(a_s16x4, __builtin_amdgcn_ds_read_tr16_b64_v4i16((LAS a_s16x4*)(vp + 4 * G3B_SV)));
            const bf16x8_t vf = (bf16x8_t){lo4[0], lo4[1], lo4[2], lo4[3], hi4[0], hi4[1], hi4[2], hi4[3]};
            acc = mfma16(vf, ldfrag(SC, 16 * ct, 32 * ks, lane), acc); }
        acc = mfma16(__builtin_bit_cast(bf16x8_t, sgf[et][0]), qf0, acc);
        acc = mfma16(__builtin_bit_cast(bf16x8_t, sgf[et][1]), qf1, acc);
        o[et] = acc; ss += (acc[0] * acc[0] + acc[1] * acc[1]) + (acc[2] * acc[2] + acc[3] * acc[3]); }
    ss = xsum32(xsum16(ss));
    const float rs = frsq(ss * (1.f / 128.f) + 1e-5f);
#pragma unroll
    for (int p2 = 0; p2 < 4; ++p2) { v2u ow[2];
#pragma unroll
        for (int e = 0; e < 2; ++e) { const int et = 2 * p2 + e; const unsigned gx_ = e ? ggr[p2].z : ggr[p2].x, gy_ = e ? ggr[p2].w : ggr[p2].y;
            const f32x4 gg = (f32x4){bflo(gx_), bfhi(gx_), bflo(gy_), bfhi(gy_)};
            f32x4 v = o[et] * rs * gn4[et]; v[0] *= silu_f(gg[0]); v[1] *= silu_f(gg[1]); v[2] *= silu_f(gg[2]); v[3] *= silu_f(gg[3]);
            ow[e] = pack4(v); }
        *(GAS v4u*)(XNb + row * D + 512 + 128 * h4 + 32 * p2 + 8 * lg) = (v4u){ow[0].x, ow[0].y, ow[1].x, ow[1].y}; }
    __syncthreads();
    }
}
constexpr int N_STEPS = 37;
#ifndef MK_ONE_LAUNCH
#define MK_ONE_LAUNCH 1
#endif
__global__ void __launch_bounds__(NTHREADS, 2) hybrid_fwd(Args args) {
    extern __shared__ __attribute__((aligned(16))) unsigned char lds_raw[];
    LAS unsigned char* lds = (LAS unsigned char*)lds_raw;
    ArgP A0 = (ArgP)__builtin_amdgcn_kernarg_segment_ptr();
    { const int tid = threadIdx.x; for (int u = tid; u < (LDS_BYTES - LDSCTL_OFF) / 4; u += NTHREADS) ((LAS unsigned*)(lds + LDSCTL_OFF))[u] = 0u; }
    __syncthreads();
    const int lo = A0->lo, hi = A0->hi;
    if (hi - lo > 1) (void)xcd_barrier_post((unsigned*)(A0->ws + WS_CTL) + CW_BAR, (volatile LAS unsigned*)(lds + MISC_OFF) + 8);
#ifndef PHM
#define PHM 0xff
#endif
#define RUN(s) (lo <= (s) && (s) < hi)
#define EN(b) ((PHM >> (b)) & 1)
#ifndef PROBE_REP
#define PROBE_REP 0
#endif
#define REP(b) _Pragma("unroll 1") for (int rep_ = 0; rep_ < (((PROBE_REP >> (b)) & 1) ? 2 : 1); ++rep_)
#ifndef PROBE_TMASK
#define PROBE_TMASK 0u
#endif
#ifndef PROBE_TAMP
#define PROBE_TAMP 4
#endif
#ifndef PROBE_TCLK
#define PROBE_TCLK 0
#endif
#ifndef PROBE_BLOCK
#define PROBE_BLOCK 0
#endif
#ifndef PROBE_SUBA
#define PROBE_SUBA 0
#define PROBE_SUBB 0
#endif
#define PROBE_STAMP(i) do { if (PROBE_TMASK && ((i) == PROBE_SUBA || (i) == PROBE_SUBB) && L == 0 && bid == PROBE_BLOCK && tid == 0) { ArgP As_ = A; ((unsigned long long*)((unsigned*)(As_->ws + WS_CTL) + 32768))[i] = __builtin_amdgcn_s_memrealtime(); } } while (0)
    int nbar_ = 0;
    if (PROBE_TMASK) { if (blockIdx.x == PROBE_BLOCK && threadIdx.x == 0) { ((unsigned long long*)((unsigned*)(A0->ws + WS_CTL) + 32768))[0] = __builtin_amdgcn_s_memrealtime(); ((unsigned long long*)((unsigned*)(A0->ws + WS_CTL) + 32768))[64] = __builtin_amdgcn_s_memtime(); } }
#define GRID_BARRIER() do { ArgP Ab_ = FRESH_ARGS(); XcdBarrier b_; b_.bar = (unsigned*)(Ab_->ws + WS_CTL) + CW_BAR; b_.x = xb_xcc_id(); b_.st = (volatile LAS unsigned*)(lds + MISC_OFF) + 8; xcd_barrier(b_); if (PROBE_TMASK) { ++nbar_; if (blockIdx.x == PROBE_BLOCK && threadIdx.x == 0) { ((unsigned long long*)((unsigned*)(Ab_->ws + WS_CTL) + 32768))[nbar_] = __builtin_amdgcn_s_memrealtime(); ((unsigned long long*)((unsigned*)(Ab_->ws + WS_CTL) + 32768))[64 + nbar_] = __builtin_amdgcn_s_memtime(); } } } while (0)
#define SEAM(s) do { if (RUN(s) && RUN((s) + 1)) GRID_BARRIER(); } while (0)
#define PHASE_VARS() ArgP A = FRESH_ARGS(); int L = Lq; FRESH_S(L); int tid = threadIdx.x; FRESH_V(tid); const int lane = tid & 63, wave = __builtin_amdgcn_readfirstlane(tid >> 6); int G = gridDim.x, bid = blockIdx.x; FRESH_S(G); FRESH_S(bid); (void)lane; (void)wave; (void)G; (void)A; (void)bid; \
    bf16* XN = (bf16*)(A->ws + WS_XN); bf16* PB = (bf16*)(A->ws + WS_P); (void)XN; (void)PB

#define BAR2(a, b) do { if (RUN(a) && RUN(b)) GRID_BARRIER(); } while (0)
    if (EN(0) && RUN(0)) REP(0) { int Lq = 0; PHASE_VARS(); const int gw = bid * NWAVES + wave, NGW = G * NWAVES;
        convert_mixer_weights(A, 0, lds, wave, lane, gw, NGW); PROBE_STAMP(45);
        float* ssq0 = (float*)(A->ws + WS_SSQ);
        for (int m = gw; m < M; m += 4 * NGW) x_to_bf16_ssq4(A->in[0], (bf16*)A->out, ssq0, m, NGW, lane); }
    BAR2(0, 1);
    for (int Lq = 0; Lq < 4; ++Lq) {
        const int s0 = 9 * Lq; const bool even = !(Lq & 1);
        if (EN(1) && RUN(s0 + 1)) REP(1) {
            PHASE_VARS(); bf16* Win = (bf16*)(A->ws + WS_WIN); const float* ssq = (const float*)(A->ws + WS_SSQ);
            if (even) {
                pg8::Gemm g{(bf16*)A->out, Win, M, NIN_E, D}; pg8::StaticOrderC<M, NIN_E> S; S.init(G, bid);
                pg8::fill_row_scales(S, ssq, (LAS float*)(lds + RSTAB_OFF), tid);
                pg8::EpiStoreBf16 E{PB, NIN_E, 0, 1.0f, (const LAS float*)(lds + RSTAB_OFF), PC_PAD};
                pg8::gemm_phase<pg8::EpiStoreBf16, pg8::StaticOrderC<M, NIN_E>, PG8_ALIGN, PG8_SP2>(lds, g, S, E);
            } else {
                pg8::Gemm g{(bf16*)A->out, Win, M, NIN_O, D}; pg8::StaticOrderC<M, NIN_O> S; S.init(G, bid);
                pg8::fill_row_scales(S, ssq, (LAS float*)(lds + RSTAB_OFF), tid);
                pg8::EpiStoreBf16 E{PB, NIN_O, 4, 0.125f * 1.4426950408889634f, (const LAS float*)(lds + RSTAB_OFF), NIN_O};
                pg8::gemm_phase<pg8::EpiStoreBf16, pg8::StaticOrderC<M, NIN_O>, PG8_ALIGN, PG8_SP2>(lds, g, S, E);
            }
        }
        if (even) {
            BAR2(s0 + 1, s0 + 2);
            if (EN(2) && RUN(s0 + 2)) REP(2) { PHASE_VARS();
                rwkv_chunk_phase(A, L, lds, tid, G, bid); PROBE_STAMP(44);
                REP(8) {
                gla_kv_phase(A, L, lds, tid, G, bid); } }
            BAR2(s0 + 2, s0 + 3);
            if (EN(3) && RUN(s0 + 3)) {
                PHASE_VARS();
                if (bid < 64) { rwkv_state_scan(A, bid >> 3, bid & 7, lds, wave, lane); PROBE_STAMP(40); }
                else { for (int gt = (bid - 64) * NTHREADS + tid; gt < 32 * 2048; gt += (G - 64) * NTHREADS) gla_state_scan(A, gt);
                       PROBE_STAMP(41);
                       convert_ffn_weights(A, L, lds, wave, lane, (bid - 64) * NWAVES + wave, (G - 64) * NWAVES); PROBE_STAMP(42); }
            }
            BAR2(s0 + 3, s0 + 4);
            if (EN(3) && RUN(s0 + 4)) {
                PHASE_VARS();
                REP(9) {
                gla_out_phase(A, L, lds, tid, G, bid); }
                PROBE_STAMP(43);
                rwkv_out_phase(A, L, lds, bid, G, wave, lane);
            }
            BAR2(s0 + 4, s0 + 5);
        } else {
            BAR2(s0 + 1, s0 + 3);
            #ifdef PROBE_AVAR
            if (EN(4) && RUN(s0 + 3)) { PHASE_VARS(); attn_phase_mfma<PROBE_AVAR>(A, L, lds, tid, G, bid); }
#endif
            if (EN(4) && RUN(s0 + 3)) REP(4) { PHASE_VARS(); attn_phase_mfma(A, L, lds, tid, G, bid); convert_ffn_weights(A, L, lds, wave, lane, bid * NWAVES + wave, G * NWAVES); }
            BAR2(s0 + 3, s0 + 5);
        }
        if (EN(5) && RUN(s0 + 5)) {
            PHASE_VARS(); bf16* Wout = (bf16*)(A->ws + WS_WOUT);
            pg8::Gemm g{XN, Wout, M, D, D}; pg8::StaticOrderC<M, D> S; S.init(G, bid);
            if ((PROBE_REP >> 5) & 1) { pg8::EpiResBf16<false, true> E0{(bf16*)A->out, D, (float*)(A->ws + WS_SSQ) + (size_t)M * 16, nullptr};
                pg8::gemm_phase<pg8::EpiResBf16<false, true>, pg8::StaticOrderC<M, D>, PG8_ALIGN, PG8_SP2>(lds, g, S, E0); }
            pg8::EpiResBf16<false> E{(bf16*)A->out, D, (float*)(A->ws + WS_SSQ) + (size_t)M * 16, nullptr};
            pg8::gemm_phase<pg8::EpiResBf16<false>, pg8::StaticOrderC<M, D>, PG8_ALIGN, PG8_SP2>(lds, g, S, E);
        }
        BAR2(s0 + 5, s0 + 7);
        if (EN(6) && RUN(s0 + 7)) REP(6) {
            PHASE_VARS(); bf16* Wgu = (bf16*)(A->ws + WS_WGU);
            pg8::Gemm g{(bf16*)A->out, Wgu, M, NGU, D}; pg8::StaticOrderC<M, NGU> S; S.init(G, bid);
            pg8::fill_row_scales(S, (const float*)(A->ws + WS_SSQ) + (size_t)M * 16, (LAS float*)(lds + RSTAB_OFF), tid);
            if ((PROBE_REP >> 18) & 1) { pg8::EpiNull En; pg8::gemm_phase<pg8::EpiNull, pg8::StaticOrderC<M, NGU>, PG8_ALIGN, PG8_SP2>(lds, g, S, En); }
            if ((PROBE_REP >> 15) & 1) { pg8::EpiSwigluT<true> E0{PB, FF, (const LAS float*)(lds + RSTAB_OFF)};
                pg8::gemm_phase<pg8::EpiSwigluT<true>, pg8::StaticOrderC<M, NGU>, PG8_ALIGN, PG8_SP2>(lds, g, S, E0); }
            pg8::EpiSwiglu E{PB, FF, (const LAS float*)(lds + RSTAB_OFF)};
            pg8::gemm_phase<pg8::EpiSwiglu, pg8::StaticOrderC<M, NGU>, PG8_ALIGN, PG8_SP2>(lds, g, S, E);
        }
        BAR2(s0 + 7, s0 + 8);
        if (EN(7) && RUN(s0 + 8)) {
            PHASE_VARS(); bf16* Wdn = (bf16*)(A->ws + WS_WDN);
            pg8::Gemm g{PB, Wdn, M, D, FF}; pg8::StaticOrderC<M, D> S; S.init(G, bid);
            if ((PROBE_REP >> 7) & 1) { pg8::EpiResBf16<false, true> E0{(bf16*)A->out, D, (float*)(A->ws + WS_SSQ), nullptr};
                pg8::gemm_phase<pg8::EpiResBf16<false, true>, pg8::StaticOrderC<M, D>, PG8_ALIGN, PG8_SP2>(lds, g, S, E0); }
            if (L < 3) { pg8::EpiResBf16<false> E{(bf16*)A->out, D, (float*)(A->ws + WS_SSQ), nullptr};
                pg8::gemm_phase<pg8::EpiResBf16<false>, pg8::StaticOrderC<M, D>, PG8_ALIGN, PG8_SP2>(lds, g, S, E);
                convert_mixer_weights(A, L + 1, lds, wave, lane, bid * NWAVES + wave, G * NWAVES); }
            else { pg8::EpiResBf16<true> E{(bf16*)A->out, D, (float*)(A->ws + WS_SSQ), XN};
                pg8::gemm_phase<pg8::EpiResBf16<true>, pg8::StaticOrderC<M, D>, PG8_ALIGN, PG8_SP2>(lds, g, S, E); }
        }
        BAR2(s0 + 8, Lq < 3 ? s0 + 10 : 36);
    }
    if (RUN(36)) REP(17) {
        int Lq = 0; PHASE_VARS();
        const int gw = bid * NWAVES + wave, NGW = G * NWAVES;
        for (int m = gw; m < M; m += 4 * NGW) rms_rows4_bf16_to_f32(XN, A->in[4], A->out, m, NGW, lane);
        if (PROBE_TMASK) { if (blockIdx.x == PROBE_BLOCK && threadIdx.x == 0) {
            const unsigned long long* ts = (const unsigned long long*)((const unsigned*)(A->ws + WS_CTL) + 32768); unsigned long long acc_ = 0, cyc_ = 0;
            for (int k = 1; k <= 25; ++k) if ((PROBE_TMASK >> k) & 1u) { acc_ += ts[k] - ts[k - 1]; cyc_ += ts[64 + k] - ts[64 + k - 1]; }
            if (PROBE_SUBA == 99) acc_ = __builtin_amdgcn_s_memrealtime() - ts[25]; else if (PROBE_SUBA) acc_ = ts[PROBE_SUBA] - ts[PROBE_SUBB];
            const unsigned long long target_ = PROBE_TCLK ? (cyc_ * 100000ull) / (acc_ + 1ull) : acc_ * (unsigned long long)PROBE_TAMP;
            const unsigned long long t0_ = __builtin_amdgcn_s_memrealtime();
            while (__builtin_amdgcn_s_memrealtime() - t0_ < target_ && __builtin_amdgcn_s_memrealtime() - t0_ < 4000000ull) __builtin_amdgcn_s_sleep(16); } }
    }
#undef RUN
#undef SEAM
}

extern "C" void kernel_launch(void* const* d_in, const int* in_sizes, int n_in, void* d_out, int out_size, void* d_ws, size_t ws_size, hipStream_t stream) {
    static int grid = 0;
    if (grid == 0) {
        if (n_in != 36 || in_sizes[0] != M * D || out_size != M * D || ws_size < WS_END) { fprintf(stderr, "kernel_launch: unexpected shapes (n_in %d, in0 %d, out %d, ws %zu); nothing launched\n", n_in, n_in > 0 ? in_sizes[0] : -1, out_size, ws_size); grid = -1; return; }
        int dev = 0, cus = 0, per_cu = 0;
        if (hipGetDevice(&dev) != hipSuccess || hipDeviceGetAttribute(&cus, hipDeviceAttributeMultiprocessorCount, dev) != hipSuccess) { grid = -1; return; }
        if (hipFuncSetAttribute((const void*)hybrid_fwd, hipFuncAttributeMaxDynamicSharedMemorySize, LDS_BYTES) != hipSuccess) { fprintf(stderr, "kernel_launch: hipFuncSetAttribute failed\n"); grid = -1; return; }
        if (hipOccupancyMaxActiveBlocksPerMultiprocessor(&per_cu, (const void*)hybrid_fwd, NTHREADS, LDS_BYTES) != hipSuccess || per_cu < 1) fprintf(stderr, "kernel_launch: occupancy query reports %d\n", per_cu);
        (void)hipGetLastError();
        if (cus < 128) { fprintf(stderr, "kernel_launch: built for a 256-CU device (phase 3 of the even layers needs more than 64 workgroups); nothing launched\n"); grid = -1; return; }
        grid = cus;
    }
    if (grid < 0) return;
    if (hipMemsetAsync((char*)d_ws + WS_CTL, 0, CTL_ZERO_BYTES, stream) != hipSuccess) return;
    Args a{};
    for (int i = 0; i < 36; ++i) a.in[i] = (const float*)d_in[i];
    a.out = (float*)d_out; a.ws = (unsigned char*)d_ws;
#if MK_ONE_LAUNCH
    a.lo = 0; a.hi = N_STEPS;
    hipLaunchKernelGGL(hybrid_fwd, dim3(grid), dim3(NTHREADS), LDS_BYTES, stream, a);
#else
    for (int s = 0; s < N_STEPS; ++s) {
        if (s < 36 && ((s % 9) == 2 || (s % 9) == 4) && ((s / 9) & 1)) continue;
        a.lo = s; a.hi = s + 1;
        hipLaunchKernelGGL(hybrid_fwd, dim3(grid), dim3(NTHREADS), LDS_BYTES, stream, a);
    }
#endif
}
```
